# Optimizing an MI355X kernel written in HIP

```python
import math
import jax, jax.numpy as jnp
from jax import lax
import numpy as np

D_MODEL = 1024
BATCH = 8
SEQ = 2048
DEPTH = 2

N_META = 16
ROPE_THETA = 500000.0
LN_EPS = 1e-5
GLA_HEADS = 4
GLA_DK = 64
GLA_DV = 128
GLA_RANK = 16
GLA_TAU = 16.0
GLA_CHUNK = 64
GLA_W = GLA_HEADS * GLA_DV
DSA_HEADS = 8
DSA_KV_HEADS = 2
DSA_GROUP = DSA_HEADS // DSA_KV_HEADS
DSA_HD = 64
DSA_W = DSA_HEADS * DSA_HD
IDX_HEADS = 8
IDX_HD = 64
TOPK_MAX = 256
Q_BLOCK = 128
ROPE_DIM = DSA_HD // 4
MIX_W = GLA_W + DSA_W
IN_SPLITS = (
    GLA_HEADS * GLA_DK,
    GLA_HEADS * GLA_DK,
    GLA_W,
    GLA_RANK,
    GLA_W,
    DSA_HEADS * DSA_HD,
    DSA_KV_HEADS * DSA_HD,
    DSA_KV_HEADS * DSA_HD,
    IDX_HEADS * IDX_HD,
    IDX_HD,
    IDX_HEADS,
    DSA_W,
)
IN_W = sum(IN_SPLITS)
DEEPNORM_ALPHA = (2.0 * DEPTH) ** 0.25
DEEPNORM_BETA = (8.0 * DEPTH) ** -0.25

kernel_name = "hymba_gla_dsa_deepnorm_trunk"


def _layer_norm(x, g, b):
    xf = x.astype(jnp.float32)
    mu = xf.mean(-1, keepdims=True)
    var = jnp.square(xf - mu).mean(-1, keepdims=True)
    return ((xf - mu) * lax.rsqrt(var + LN_EPS) * g.astype(jnp.float32) + b.astype(jnp.float32)).astype(x.dtype)


def _split_cols(p):
    out, o = [], 0
    for w in IN_SPLITS:
        out.append(p[..., o:o + w])
        o += w
    return out


def _rope_tables(n_pos):
    inv = ROPE_THETA ** (-jnp.arange(0, ROPE_DIM, 2, dtype=jnp.float32) / ROPE_DIM)
    ang = jnp.arange(n_pos, dtype=jnp.float32)[:, None] * inv[None, :]
    return jnp.cos(ang), jnp.sin(ang)


def _partial_rope(x, cos, sin):
    half = ROPE_DIM // 2
    shape = (1, cos.shape[0]) + (1,) * (x.ndim - 3) + (half,)
    c = cos.reshape(shape).astype(x.dtype)
    s = sin.reshape(shape).astype(x.dtype)
    x1, x2, rest = x[..., :half], x[..., half:ROPE_DIM], x[..., ROPE_DIM:]
    return jnp.concatenate([x1 * c - x2 * s, x2 * c + x1 * s, rest], axis=-1)


def _gla(q, k, v, g):
    B, L, H, _ = q.shape
    pad = (-N_META) % GLA_CHUNK
    padw = ((0, 0), (pad, 0), (0, 0), (0, 0))
    q, k, v, g = [jnp.pad(a.astype(jnp.float32), padw) for a in (q, k, v, g)]
    n = (L + pad) // GLA_CHUNK

    def to_chunks(a):
        return a.reshape(B, n, GLA_CHUNK, H, a.shape[-1]).transpose(1, 0, 3, 2, 4)

    causal = jnp.tril(jnp.ones((GLA_CHUNK, GLA_CHUNK), dtype=bool))[:, :, None]

    def step(S, inp):
        qi, ki, vi, gi = inp
        b = jnp.cumsum(gi, axis=2)
        o_inter = jnp.einsum('bhtd,bhde->bhte', qi * jnp.exp(b), S)
        diff = b[:, :, :, None, :] - b[:, :, None, :, :]
        decay = jnp.exp(jnp.where(causal, diff, -jnp.inf))
        A = jnp.einsum('bhtd,bhsd,bhtsd->bhts', qi, ki, decay)
        o = o_inter + jnp.einsum('bhts,bhse->bhte', A, vi)
        b_last = b[:, :, -1:, :]
        S_new = jnp.exp(b_last[:, :, 0, :])[..., None] * S + jnp.einsum(
            'bhsd,bhse->bhde', ki * jnp.exp(b_last - b), vi)
        return S_new, o

    S0 = jnp.zeros((B, H, GLA_DK, GLA_DV), jnp.float32)
    _, o = lax.scan(step, S0, (to_chunks(q), to_chunks(k), to_chunks(v), to_chunks(g)))
    o = o.transpose(1, 0, 3, 2, 4).reshape(B, n * GLA_CHUNK, H, GLA_DV)
    return o[:, pad:]


def _dsa(q, k, v, iq, ik, iw, n_real):
    B, L = q.shape[:2]
    topk = min(TOPK_MAX, n_real // 4)
    nb = -(-L // Q_BLOCK)
    Lp = nb * Q_BLOCK

    def blocks(a):
        a = jnp.pad(a, ((0, 0), (0, Lp - L)) + ((0, 0),) * (a.ndim - 2))
        return a.reshape((B, nb, Q_BLOCK) + a.shape[2:]).swapaxes(0, 1)

    kv = jnp.concatenate([k, v], axis=-1)
    key_pos = jnp.arange(L)

    def one_block(inp):
        start, qb, iqb, iwb = inp
        t = start + jnp.arange(Q_BLOCK)
        dots = jnp.einsum('bqjd,bsd->bqjs', iqb, ik).astype(jnp.float32) * (IDX_HD ** -0.5)
        score = jnp.einsum('bqj,bqjs->bqs', iwb.astype(jnp.float32) * (IDX_HEADS ** -0.5), jax.nn.relu(dots))
        causal = key_pos[None, :] <= t[:, None]
        score = jnp.where(causal[None], score, -jnp.inf)
        _, sel = lax.top_k(score, topk)
        kv_sel = jax.vmap(lambda a, i: a[i])(kv, sel)
        k_sel, v_sel = kv_sel[..., :DSA_HD], kv_sel[..., DSA_HD:]
        valid = sel <= t[None, :, None]
        qg = qb.reshape(B, Q_BLOCK, DSA_KV_HEADS, DSA_GROUP, DSA_HD)
        s = jnp.einsum('bqgrd,bqkgd->bqgrk', qg, k_sel).astype(jnp.float32) * (DSA_HD ** -0.5)
        s = jnp.where(valid[:, :, None, None, :], s, -jnp.inf)
        p = jax.nn.softmax(s, axis=-1).astype(v_sel.dtype)
        o = jnp.einsum('bqgrk,bqkgd->bqgrd', p, v_sel)
        return o.reshape(B, Q_BLOCK, DSA_W)

    starts = jnp.arange(nb) * Q_BLOCK
    out = lax.map(one_block, (starts, blocks(q), blocks(iq), blocks(iw)))
    return out.swapaxes(0, 1).reshape(B, Lp, DSA_W)[:, :L]


def _layer(h, cos, sin, n_real, w_in, gla_wg2, gla_bg, gla_norm_g, idx_k_g, idx_k_b, w_out, ln_g, ln_b):
    B, L, _ = h.shape
    proj = jnp.einsum('bld,de->ble', h, w_in)
    g_q, g_k, g_v, g_lr, g_z, a_q, a_k, a_v, i_q, i_k, i_w, a_z = _split_cols(proj)

    gq = g_q.reshape(B, L, GLA_HEADS, GLA_DK) * (GLA_DK ** -0.5)
    gk = g_k.reshape(B, L, GLA_HEADS, GLA_DK)
    gv = g_v.reshape(B, L, GLA_HEADS, GLA_DV)
    glog = jax.nn.log_sigmoid(jnp.einsum('blr,rk->blk', g_lr, gla_wg2).astype(jnp.float32)
                              + gla_bg.astype(jnp.float32)) / GLA_TAU
    glog = glog.reshape(B, L, GLA_HEADS, GLA_DK)
    o_gla = _gla(gq, gk, gv, glog)
    o_gla = o_gla * lax.rsqrt(jnp.mean(jnp.square(o_gla), -1, keepdims=True) + LN_EPS) * gla_norm_g.astype(jnp.float32)
    o_gla = o_gla.reshape(B, L, GLA_W).astype(h.dtype) * jax.nn.silu(g_z)

    aq = _partial_rope(a_q.reshape(B, L, DSA_HEADS, DSA_HD), cos, sin)
    ak = _partial_rope(a_k.reshape(B, L, DSA_KV_HEADS, DSA_HD), cos, sin)
    av = a_v.reshape(B, L, DSA_KV_HEADS, DSA_HD)
    iq = _partial_rope(i_q.reshape(B, L, IDX_HEADS, IDX_HD), cos, sin)
    ik = _partial_rope(_layer_norm(i_k, idx_k_g, idx_k_b), cos, sin)
    o_dsa = _dsa(aq, ak, av, iq, ik, i_w, n_real) * jax.nn.silu(a_z)

    y = jnp.einsum('blm,md->bld', jnp.concatenate([o_gla, o_dsa], axis=-1), w_out)
    return _layer_norm(DEEPNORM_ALPHA * h + y, ln_g, ln_b)


def setup_inputs(seed: int = 0) -> dict:
    key = jax.random.key(seed)
    ks = jax.random.split(key, 13)
    f32 = jnp.float32
    nrm = lambda k, s: jax.random.normal(k, s, f32)
    return {
        "x": nrm(ks[0], (BATCH, SEQ, D_MODEL)),
        "meta_tokens": nrm(ks[1], (N_META, D_MODEL)),
        "ln_in_g": 1.0 + 0.02 * nrm(ks[2], (D_MODEL,)),
        "ln_in_b": 0.02 * nrm(ks[3], (D_MODEL,)),
        "w_in": nrm(ks[4], (DEPTH, D_MODEL, IN_W)) * D_MODEL ** -0.5,
        "gla_wg2": nrm(ks[5], (DEPTH, GLA_RANK, GLA_HEADS * GLA_DK)) * GLA_RANK ** -0.5,
        "gla_bg": 0.1 * nrm(ks[6], (DEPTH, GLA_HEADS * GLA_DK)),
        "gla_norm_g": 1.0 + 0.02 * nrm(ks[7], (DEPTH, GLA_DV)),
        "idx_k_g": 1.0 + 0.02 * nrm(ks[8], (DEPTH, IDX_HD)),
        "idx_k_b": 0.02 * nrm(ks[9], (DEPTH, IDX_HD)),
        "w_out": nrm(ks[10], (DEPTH, MIX_W, D_MODEL)) * (MIX_W ** -0.5) * DEEPNORM_BETA,
        "ln_g": 1.0 + 0.02 * nrm(ks[11], (DEPTH, D_MODEL)),
        "ln_b": 0.02 * nrm(ks[12], (DEPTH, D_MODEL)),
    }


def reference(x, meta_tokens, ln_in_g, ln_in_b, w_in, gla_wg2, gla_bg, gla_norm_g, idx_k_g, idx_k_b, w_out, ln_g, ln_b):
    B, S, _ = x.shape
    meta = jnp.broadcast_to(meta_tokens[None].astype(x.dtype), (B, N_META, D_MODEL))
    h = jnp.concatenate([meta, x], axis=1)
    h = _layer_norm(h, ln_in_g, ln_in_b)
    cos, sin = _rope_tables(N_META + S)
    for i in range(DEPTH):
        h = _layer(h, cos, sin, S, w_in[i], gla_wg2[i], gla_bg[i], gla_norm_g[i],
                   idx_k_g[i], idx_k_b[i], w_out[i], ln_g[i], ln_b[i])
    return h[:, N_META:]
```

```cpp
#include <hip/hip_runtime.h>
#include <hip/hip_cooperative_groups.h>
#include <stdint.h>
namespace cg = cooperative_groups;

#ifndef MULTI_LAUNCH
#define MULTI_LAUNCH 1
#endif

constexpr int D = 1024, NB = 8, SEQ = 2048, NMETA = 16, L = 2064, T = NB * L;
constexpr int DEPTH = 2;
constexpr int INW = 3416, INWP = 3456;
constexpr int TOPK = 256;
constexpr float LN_EPS = 1e-5f;
constexpr float ALPHA = 1.41421356237309515f;

typedef unsigned short bf16_t;

constexpr size_t SZ_H32 = (size_t)T * D * 4;
constexpr size_t SZ_HB = (size_t)T * D * 2;
constexpr size_t SZ_WIN = (size_t)DEPTH * INWP * D * 2;
constexpr size_t SZ_WOUT = (size_t)DEPTH * D * D * 2;
constexpr size_t SZ_GQ = (size_t)T * 256 * 2, SZ_GK = SZ_GQ, SZ_GV = (size_t)T * 512 * 2, SZ_GLOG = (size_t)T * 256 * 4;
constexpr size_t SZ_AQ = (size_t)T * 512 * 2;
constexpr size_t SZ_MIX = (size_t)T * 1024 * 2;
constexpr size_t SZ_AK = (size_t)T * 128 * 2, SZ_AV = SZ_AK, SZ_IQ = (size_t)T * 512 * 2, SZ_IK = (size_t)T * 64 * 2, SZ_IW = (size_t)T * 8 * 4;
constexpr size_t SZ_ROPE = (size_t)L * 8 * 2 * 4;

constexpr size_t OFF_H32 = 0;
constexpr size_t OFF_HB = OFF_H32 + SZ_H32;
constexpr size_t OFF_WIN = OFF_HB + SZ_HB;
constexpr size_t OFF_WOUT = OFF_WIN + SZ_WIN;
constexpr size_t OFF_GQ = OFF_WOUT + SZ_WOUT;
constexpr size_t OFF_GK = OFF_GQ + SZ_GQ;
constexpr size_t OFF_GV = OFF_GK + SZ_GK;
constexpr size_t OFF_GLOG = OFF_GV + SZ_GV;
constexpr size_t OFF_AQ = OFF_GLOG + SZ_GLOG;
constexpr size_t OFF_MIX = OFF_AQ + SZ_AQ;
constexpr size_t OFF_AK = OFF_MIX + SZ_MIX;
constexpr size_t OFF_AV = OFF_AK + SZ_AK;
constexpr size_t OFF_IQ = OFF_AV + SZ_AV;
constexpr size_t OFF_IK = OFF_IQ + SZ_IQ;
constexpr size_t OFF_IW = OFF_IK + SZ_IK;
constexpr size_t OFF_ROPE = OFF_IW + SZ_IW;
constexpr size_t OFF_END = OFF_ROPE + SZ_ROPE;
static_assert(SZ_GQ + SZ_GK + SZ_GV + SZ_GLOG + SZ_AQ == SZ_H32, "Z alias size");
static_assert(OFF_END <= (size_t)256 * 1024 * 1024, "workspace too large");

struct Params {
    const float* x; const float* meta; const float* ln_in_g; const float* ln_in_b;
    const float* w_in; const float* wg2; const float* bg; const float* norm_g;
    const float* ikg; const float* ikb; const float* w_out; const float* ln_g; const float* ln_b;
    float* out; char* ws;
};

__device__ __forceinline__ bf16_t f2bf(float f) {
    unsigned u = __float_as_uint(f);
    u += 0x7FFFu + ((u >> 16) & 1u);
    return (bf16_t)(u >> 16);
}
__device__ __forceinline__ float bf2f(bf16_t h) { return __uint_as_float(((unsigned)h) << 16); }
__device__ __forceinline__ float wave_sum(float v) {
#pragma unroll
    for (int o = 32; o > 0; o >>= 1) v += __shfl_xor(v, o);
    return v;
}
__device__ __forceinline__ float wave_max(float v) {
#pragma unroll
    for (int o = 32; o > 0; o >>= 1) v = fmaxf(v, __shfl_xor(v, o));
    return v;
}
__device__ __forceinline__ float block_sum(float v, float* red) {
    v = wave_sum(v);
    __syncthreads();
    if ((threadIdx.x & 63) == 0) red[threadIdx.x >> 6] = v;
    __syncthreads();
    return red[0] + red[1] + red[2] + red[3];
}
__device__ __forceinline__ float silu_f(float x) { return x / (1.f + __expf(-x)); }
__device__ __forceinline__ float logsigmoid_f(float x) { return fminf(x, 0.f) - log1pf(expf(-fabsf(x))); }

__device__ __forceinline__ int proj_src_col(int n) {
    if (n < 1024) return n;
    if (n < 1536) return n - 1024 + 1040;
    if (n < 2048) return n - 1536 + 1552;
    if (n < 2560) return n - 2048 + 2904;
    if (n < 3072) return n - 2560 + 2320;
    if (n < 3200) return n - 3072 + 2064;
    if (n < 3328) return n - 3200 + 2192;
    if (n < 3392) return n - 3328 + 2832;
    if (n < 3408) return n - 3392 + 1024;
    if (n < 3416) return n - 3408 + 2896;
    return -1;
}

__device__ __forceinline__ void sincos_acc(float a, float& s, float& c) {
    double ad = (double)a;
    double kd = rint(ad * 0.63661977236758134308);
    double r = fma(-kd, 1.57079632679489655800, ad);
    r = fma(-kd, 6.12323399573676603587e-17, r);
    double r2 = r * r;
    double sp = r * (1.0 + r2 * (-1.0 / 6 + r2 * (1.0 / 120 + r2 * (-1.0 / 5040 + r2 * (1.0 / 362880 + r2 * (-1.0 / 39916800))))));
    double cp = 1.0 + r2 * (-0.5 + r2 * (1.0 / 24 + r2 * (-1.0 / 720 + r2 * (1.0 / 40320 + r2 * (-1.0 / 3628800 + r2 * (1.0 / 479001600))))));
    int q = ((int)kd) & 3;
    double ss = (q & 1) ? cp : sp, cc = (q & 1) ? sp : cp;
    if (q == 1 || q == 2) cc = -cc;
    if (q == 2 || q == 3) ss = -ss;
    s = (float)ss; c = (float)cc;
}

__device__ __forceinline__ void phase_prep(const Params& p, char* smem) {
    float* red = (float*)smem;
    const int tid = threadIdx.x;
    bf16_t* WIN = (bf16_t*)(p.ws + OFF_WIN);
    bf16_t* WOUT = (bf16_t*)(p.ws + OFF_WOUT);
    float* H32 = (float*)(p.ws + OFF_H32);
    bf16_t* HB = (bf16_t*)(p.ws + OFF_HB);
    float2* ROPE = (float2*)(p.ws + OFF_ROPE);
    constexpr int NA = DEPTH * INWP, NBI = DEPTH * D, NC = T, ND = (L * 8 + 255) / 256;
    for (int item = blockIdx.x; item < NA + NBI + NC + ND; item += gridDim.x) {
        if (item < NA) {
            const int l = item / INWP, n = item % INWP;
            const int src = proj_src_col(n);
            bf16_t v[4];
#pragma unroll
            for (int j = 0; j < 4; ++j) {
                const int k = tid * 4 + j;
                v[j] = (src >= 0) ? f2bf(p.w_in[((size_t)l * D + k) * INW + src]) : (bf16_t)0;
            }
            uint2 pk; pk.x = v[0] | ((unsigned)v[1] << 16); pk.y = v[2] | ((unsigned)v[3] << 16);
            *(uint2*)&WIN[((size_t)l * INWP + n) * D + tid * 4] = pk;
        } else if (item < NA + NBI) {
            const int it = item - NA; const int l = it / D, n = it % D;
            bf16_t v[4];
#pragma unroll
            for (int j = 0; j < 4; ++j) { const int k = tid * 4 + j; v[j] = f2bf(p.w_out[((size_t)l * D + k) * D + n]); }
            uint2 pk; pk.x = v[0] | ((unsigned)v[1] << 16); pk.y = v[2] | ((unsigned)v[3] << 16);
            *(uint2*)&WOUT[((size_t)l * D + n) * D + tid * 4] = pk;
        } else if (item < NA + NBI + NC) {
            const int t = item - NA - NBI; const int b = t / L, pos = t % L;
            const float* src = (pos < NMETA) ? (p.meta + (size_t)pos * D) : (p.x + ((size_t)b * SEQ + (pos - NMETA)) * D);
            const float4 v = *(const float4*)&src[tid * 4];
            const float mu = block_sum(v.x + v.y + v.z + v.w, red) * (1.f / D);
            const float d0 = v.x - mu, d1 = v.y - mu, d2 = v.z - mu, d3 = v.w - mu;
            const float var = block_sum(d0 * d0 + d1 * d1 + d2 * d2 + d3 * d3, red) * (1.f / D);
            const float rs = rsqrtf(var + LN_EPS);
            const float4 g = *(const float4*)&p.ln_in_g[tid * 4], bb = *(const float4*)&p.ln_in_b[tid * 4];
            float4 o; o.x = d0 * rs * g.x + bb.x; o.y = d1 * rs * g.y + bb.y; o.z = d2 * rs * g.z + bb.z; o.w = d3 * rs * g.w + bb.w;
            *(float4*)&H32[(size_t)t * D + tid * 4] = o;
            uint2 pk; pk.x = f2bf(o.x) | ((unsigned)f2bf(o.y) << 16); pk.y = f2bf(o.z) | ((unsigned)f2bf(o.w) << 16);
            *(uint2*)&HB[(size_t)t * D + tid * 4] = pk;
        } else {
            const int e = (item - NA - NBI - NC) * 256 + tid;
            if (e < L * 8) {
                const int pos = e >> 3, i = e & 7;
                const float inv[8] = {1.0f, 0.19392274f, 0.03760603f, 0.0072926646f, 0.0014142136f, 0.0002742482f, 5.3182957e-05f, 1.0313385e-05f};
                float iv = inv[0];
#pragma unroll
                for (int j = 1; j < 8; ++j) iv = (i == j) ? inv[j] : iv;
                const float ang = (float)pos * iv;
                float s, c; sincos_acc(ang, s, c);
                ROPE[e] = make_float2(c, s);
            }
        }
    }
}

constexpr int GT_AS = 0, GT_BS = 32 * 68, GT_CT = 2 * 32 * 68, GT_FLOATS = 2 * 32 * 68 + 64 * 65;
__device__ __forceinline__ void gemm_tile64(const bf16_t* __restrict__ A, int lda, const bf16_t* __restrict__ Bt, int ldb, int K,
                            int row0, int col0, float* sm) {
    float (*As)[68] = (float (*)[68])(sm + GT_AS);
    float (*Bs)[68] = (float (*)[68])(sm + GT_BS);
    float (*Ct)[65] = (float (*)[65])(sm + GT_CT);
    const int tid = threadIdx.x, ty = tid >> 4, tx = tid & 15;
    const int lr = tid >> 2, lk = (tid & 3) * 8;
    float acc[4][4];
#pragma unroll
    for (int i = 0; i < 4; ++i)
#pragma unroll
        for (int j = 0; j < 4; ++j) acc[i][j] = 0.f;
    for (int k0 = 0; k0 < K; k0 += 32) {
        const uint4 av = *(const uint4*)&A[(size_t)(row0 + lr) * lda + k0 + lk];
        const uint4 bv = *(const uint4*)&Bt[(size_t)(col0 + lr) * ldb + k0 + lk];
        __syncthreads();
        As[lk + 0][lr] = __uint_as_float(av.x << 16); As[lk + 1][lr] = __uint_as_float(av.x & 0xFFFF0000u);
        As[lk + 2][lr] = __uint_as_float(av.y << 16); As[lk + 3][lr] = __uint_as_float(av.y & 0xFFFF0000u);
        As[lk + 4][lr] = __uint_as_float(av.z << 16); As[lk + 5][lr] = __uint_as_float(av.z & 0xFFFF0000u);
        As[lk + 6][lr] = __uint_as_float(av.w << 16); As[lk + 7][lr] = __uint_as_float(av.w & 0xFFFF0000u);
        Bs[lk + 0][lr] = __uint_as_float(bv.x << 16); Bs[lk + 1][lr] = __uint_as_float(bv.x & 0xFFFF0000u);
        Bs[lk + 2][lr] = __uint_as_float(bv.y << 16); Bs[lk + 3][lr] = __uint_as_float(bv.y & 0xFFFF0000u);
        Bs[lk + 4][lr] = __uint_as_float(bv.z << 16); Bs[lk + 5][lr] = __uint_as_float(bv.z & 0xFFFF0000u);
        Bs[lk + 6][lr] = __uint_as_float(bv.w << 16); Bs[lk + 7][lr] = __uint_as_float(bv.w & 0xFFFF0000u);
        __syncthreads();
#pragma unroll 8
        for (int kk = 0; kk < 32; ++kk) {
            const float4 a = *(const float4*)&As[kk][ty * 4];
            const float4 b = *(const float4*)&Bs[kk][tx * 4];
            const float aa[4] = {a.x, a.y, a.z, a.w}, bb[4] = {b.x, b.y, b.z, b.w};
#pragma unroll
            for (int i = 0; i < 4; ++i)
#pragma unroll
                for (int j = 0; j < 4; ++j) acc[i][j] = fmaf(aa[i], bb[j], acc[i][j]);
        }
    }
    __syncthreads();
#pragma unroll
    for (int i = 0; i < 4; ++i)
#pragma unroll
        for (int j = 0; j < 4; ++j) Ct[ty * 4 + i][tx * 4 + j] = acc[i][j];
    __syncthreads();
}

__device__ __forceinline__ void proj_epilogue(const Params& p, int layer, int hb, int row0, const float* Ct, int ctld, float* aux  ) {
    const int tid = threadIdx.x;
    char* ws = p.ws;
    const float2* ROPE = (const float2*)(ws + OFF_ROPE);
    if (hb < 24 || (hb >= 32 && hb < 40) || hb == 50 || hb == 51) {
        for (int e = tid; e < 64 * 64; e += 256) {
            const int r = e >> 6, c = e & 63; const size_t t = row0 + r;
            const float v = Ct[r * ctld + c];
            if (hb < 4) ((bf16_t*)(ws + OFF_GQ))[t * 256 + hb * 64 + c] = f2bf(v * 0.125f);
            else if (hb < 8) ((bf16_t*)(ws + OFF_GK))[t * 256 + (hb - 4) * 64 + c] = f2bf(v);
            else if (hb < 16) ((bf16_t*)(ws + OFF_GV))[t * 512 + (hb - 8) * 64 + c] = f2bf(v);
            else if (hb < 24) ((bf16_t*)(ws + OFF_MIX))[t * 1024 + (hb - 16) * 64 + c] = f2bf(silu_f(v));
            else if (hb < 40) ((bf16_t*)(ws + OFF_MIX))[t * 1024 + 512 + (hb - 32) * 64 + c] = f2bf(silu_f(v));
            else ((bf16_t*)(ws + OFF_AV))[t * 128 + (hb - 50) * 64 + c] = f2bf(v);
        }
    } else if (hb < 53) {
        float* mu = aux; float* rs = aux + 64;
        if (hb == 52) {
            if (tid < 64) {
                float s = 0.f;
                for (int c = 0; c < 64; ++c) s += Ct[tid * ctld + c];
                const float m = s * (1.f / 64);
                float q = 0.f;
                for (int c = 0; c < 64; ++c) { const float d = Ct[tid * ctld + c] - m; q += d * d; }
                mu[tid] = m; rs[tid] = rsqrtf(q * (1.f / 64) + LN_EPS);
            }
            __syncthreads();
        }
        const float* ikg = p.ikg + layer * 64; const float* ikb = p.ikb + layer * 64;
        for (int e = tid; e < 64 * 64; e += 256) {
            const int r = e >> 6, c = e & 63; const size_t t = row0 + r;
            const int pos = (int)(t % L);
            float v = Ct[r * ctld + c];
            if (hb == 52) v = (v - mu[r]) * rs[r] * ikg[c] + ikb[c];
            float o = v;
            if (c < 16) {
                const int pc = (c < 8) ? c + 8 : c - 8;
                float v2 = Ct[r * ctld + pc];
                if (hb == 52) v2 = (v2 - mu[r]) * rs[r] * ikg[pc] + ikb[pc];
                const float2 cs = ROPE[pos * 8 + (c & 7)];
                o = (c < 8) ? (v * cs.x - v2 * cs.y) : (v * cs.x + v2 * cs.y);
            }
            if (hb < 32) ((bf16_t*)(ws + OFF_AQ))[t * 512 + (hb - 24) * 64 + c] = f2bf(o * 0.125f);
            else if (hb < 48) ((bf16_t*)(ws + OFF_IQ))[t * 512 + (hb - 40) * 64 + c] = f2bf(o * 0.125f);
            else if (hb < 50) ((bf16_t*)(ws + OFF_AK))[t * 128 + (hb - 48) * 64 + c] = f2bf(o);
            else ((bf16_t*)(ws + OFF_IK))[t * 64 + c] = f2bf(o);
        }
    } else {
        const float* wg2 = p.wg2 + (size_t)layer * 16 * 256; const float* bg = p.bg + layer * 256;
        float w[16];
#pragma unroll
        for (int rr = 0; rr < 16; ++rr) w[rr] = wg2[rr * 256 + tid];
        const float bgn = bg[tid];
        float* GLOG = (float*)(ws + OFF_GLOG);
        for (int r = 0; r < 64; ++r) {
            float s = 0.f;
#pragma unroll
            for (int rr = 0; rr < 16; ++rr) s = fmaf(Ct[r * ctld + rr], w[rr], s);
            s += bgn;
            GLOG[(size_t)(row0 + r) * 256 + tid] = logsigmoid_f(s) * (1.f / 16.f);
        }
        float* IW = (float*)(ws + OFF_IW);
        for (int e = tid; e < 64 * 8; e += 256) {
            const int r = e >> 3, j = e & 7;
            IW[(size_t)(row0 + r) * 8 + j] = Ct[r * ctld + 16 + j] * 0.353553390593273762f;
        }
    }
}

__device__ __forceinline__ void phase_proj_naive(const Params& p, int layer, char* smem) {
    float* sm = (float*)smem;
    const bf16_t* HB = (const bf16_t*)(p.ws + OFF_HB);
    const bf16_t* WIN = (const bf16_t*)(p.ws + OFF_WIN) + (size_t)layer * INWP * D;
    constexpr int NRT = T / 64, NHB = INWP / 64;
    for (int item = blockIdx.x; item < NRT * NHB; item += gridDim.x) {
        const int rt = item / NHB, hb = item % NHB;
        gemm_tile64(HB, D, WIN, D, D, rt * 64, hb * 64, sm);
        proj_epilogue(p, layer, hb, rt * 64, sm + GT_CT, 65, sm);
        __syncthreads();
    }
}

__device__ __forceinline__ void phase_gla_naive(const Params& p, int layer, char* smem) {
    float (*qs)[64] = (float (*)[64])smem;
    float (*ks)[64] = qs + 8;
    float (*es)[64] = ks + 8;
    float (*part)[8] = (float (*)[8])(es + 8);
    float (*os)[128] = (float (*)[128])(part + 2);
    const int tid = threadIdx.x;
    const bf16_t* GQ = (const bf16_t*)(p.ws + OFF_GQ);
    const bf16_t* GK = (const bf16_t*)(p.ws + OFF_GK);
    const bf16_t* GV = (const bf16_t*)(p.ws + OFF_GV);
    const float* GLOG = (const float*)(p.ws + OFF_GLOG);
    bf16_t* MIX = (bf16_t*)(p.ws + OFF_MIX);
    const float* ng = p.norm_g + layer * 128;
    for (int item = blockIdx.x; item < NB * 4; item += gridDim.x) {
        const int b = item >> 2, h = item & 3;
        float S[64];
#pragma unroll
        for (int d = 0; d < 64; ++d) S[d] = 0.f;
        const int e = tid & 127;
        const float nge = ng[e];
        for (int t0 = 0; t0 < L; t0 += 8) {
            __syncthreads();
            for (int i = tid; i < 8 * 64; i += 256) {
                const int tt = i >> 6, d = i & 63; const size_t row = (size_t)b * L + t0 + tt;
                qs[tt][d] = bf2f(GQ[row * 256 + h * 64 + d]);
                ks[tt][d] = bf2f(GK[row * 256 + h * 64 + d]);
                es[tt][d] = expf(GLOG[row * 256 + h * 64 + d]);
            }
            __syncthreads();
            if (tid < 128) {
#pragma unroll 1
                for (int tt = 0; tt < 8; ++tt) {
                    const size_t row = (size_t)b * L + t0 + tt;
                    const float v = bf2f(GV[row * 512 + h * 128 + e]);
                    float acc = 0.f;
#pragma unroll
                    for (int d = 0; d < 64; ++d) {
                        S[d] = fmaf(es[tt][d], S[d], ks[tt][d] * v);
                        acc = fmaf(qs[tt][d], S[d], acc);
                    }
                    os[tt][e] = acc;
                    const float ss = wave_sum(acc * acc);
                    if ((tid & 63) == 0) part[tid >> 6][tt] = ss;
                }
            }
            __syncthreads();
            if (tid < 128) {
#pragma unroll 1
                for (int tt = 0; tt < 8; ++tt) {
                    const size_t row = (size_t)b * L + t0 + tt;
                    const float tot = part[0][tt] + part[1][tt];
                    const float rinv = rsqrtf(tot * (1.f / 128) + LN_EPS);
                    const size_t idx = row * 1024 + h * 128 + e;
                    MIX[idx] = f2bf(os[tt][e] * rinv * nge * bf2f(MIX[idx]));
                }
            }
        }
    }
}

__device__ __forceinline__ unsigned okey(float x) {
    const unsigned u = __float_as_uint(x);
    return (u & 0x80000000u) ? ~u : (u | 0x80000000u);
}
__device__ __forceinline__ int wave_incl_scan(int v) {
    const int lane = threadIdx.x & 63;
#pragma unroll
    for (int o = 1; o < 64; o <<= 1) { const int n = __shfl_up(v, o); if (lane >= o) v += n; }
    return v;
}
__device__ __forceinline__ int block_excl_scan(int v, int* tmp) {
    const int incl = wave_incl_scan(v);
    __syncthreads();
    if ((threadIdx.x & 63) == 63) tmp[threadIdx.x >> 6] = incl;
    __syncthreads();
    const int w = threadIdx.x >> 6;
    int base = 0;
    for (int i = 0; i < w; ++i) base += tmp[i];
    return base + incl - v;
}

__device__ __forceinline__ void phase_dsa_naive(const Params& p, int layer, char* smem) {
    float* sc = (float*)smem;
    float (*iqs)[64] = (float (*)[64])(sc + 2080);
    float (*aqs)[64] = iqs + 8;
    float (*lg)[256] = (float (*)[256])(aqs + 8);
    unsigned* hist = (unsigned*)(lg + 8);
    int* sel = (int*)(hist + 256);
    int* misc = sel + 256;
    const int tid = threadIdx.x;
    const bf16_t* IQ = (const bf16_t*)(p.ws + OFF_IQ);
    const bf16_t* IK = (const bf16_t*)(p.ws + OFF_IK);
    const float* IW = (const float*)(p.ws + OFF_IW);
    const bf16_t* AQ = (const bf16_t*)(p.ws + OFF_AQ);
    const bf16_t* AK = (const bf16_t*)(p.ws + OFF_AK);
    const bf16_t* AV = (const bf16_t*)(p.ws + OFF_AV);
    bf16_t* MIX = (bf16_t*)(p.ws + OFF_MIX);
    for (int item = blockIdx.x; item < T; item += gridDim.x) {
        const int b = item / L, t = item % L;
        const size_t row = (size_t)item;
        __syncthreads();
        for (int i = tid; i < 512; i += 256) { iqs[i >> 6][i & 63] = bf2f(IQ[row * 512 + i]); aqs[i >> 6][i & 63] = bf2f(AQ[row * 512 + i]); }
        __syncthreads();
        float w[8];
#pragma unroll
        for (int j = 0; j < 8; ++j) w[j] = IW[row * 8 + j];
        for (int s = tid; s <= t; s += 256) {
            const uint4* kp = (const uint4*)&IK[((size_t)b * L + s) * 64];
            float dd[8];
#pragma unroll
            for (int j = 0; j < 8; ++j) dd[j] = 0.f;
#pragma unroll 1
            for (int q = 0; q < 8; ++q) {
                const uint4 u = kp[q];
                float kf[8];
                kf[0] = __uint_as_float(u.x << 16); kf[1] = __uint_as_float(u.x & 0xFFFF0000u);
                kf[2] = __uint_as_float(u.y << 16); kf[3] = __uint_as_float(u.y & 0xFFFF0000u);
                kf[4] = __uint_as_float(u.z << 16); kf[5] = __uint_as_float(u.z & 0xFFFF0000u);
                kf[6] = __uint_as_float(u.w << 16); kf[7] = __uint_as_float(u.w & 0xFFFF0000u);
#pragma unroll
                for (int j = 0; j < 8; ++j) {
                    const float4 a0 = *(const float4*)&iqs[j][q * 8], a1 = *(const float4*)&iqs[j][q * 8 + 4];
                    dd[j] = fmaf(a0.x, kf[0], dd[j]); dd[j] = fmaf(a0.y, kf[1], dd[j]); dd[j] = fmaf(a0.z, kf[2], dd[j]); dd[j] = fmaf(a0.w, kf[3], dd[j]);
                    dd[j] = fmaf(a1.x, kf[4], dd[j]); dd[j] = fmaf(a1.y, kf[5], dd[j]); dd[j] = fmaf(a1.z, kf[6], dd[j]); dd[j] = fmaf(a1.w, kf[7], dd[j]);
                }
            }
            float score = 0.f;
#pragma unroll
            for (int j = 0; j < 8; ++j) score = fmaf(w[j], fmaxf(dd[j], 0.f), score);
            sc[s] = score;
        }
        __syncthreads();
        const int n = t + 1;
        int nsel;
        if (n <= TOPK) {
            if (tid < n) sel[tid] = tid;
            nsel = n;
        } else {
            unsigned prefix = 0; int remaining = TOPK;
            for (int pass = 0; pass < 4; ++pass) {
                const int shift = 24 - 8 * pass;
                hist[tid] = 0;
                __syncthreads();
                for (int s = tid; s < n; s += 256) {
                    const unsigned key = okey(sc[s]);
                    const bool match = (pass == 0) || ((key >> (shift + 8)) == prefix);
                    if (match) atomicAdd(&hist[(key >> shift) & 255u], 1u);
                }
                __syncthreads();
                if (tid == 0) {
                    int cum = 0, d = 255;
                    for (; d > 0; --d) { const int c = (int)hist[d]; if (cum + c >= remaining) break; cum += c; }
                    misc[0] = d; misc[1] = remaining - cum;
                }
                __syncthreads();
                prefix = (prefix << 8) | (unsigned)misc[0]; remaining = misc[1];
                __syncthreads();
            }
            const int s0 = tid * 9;
            int ceq = 0;
#pragma unroll
            for (int q = 0; q < 9; ++q) { const int s = s0 + q; if (s < n && okey(sc[s]) == prefix) ++ceq; }
            int eqrank = block_excl_scan(ceq, misc + 4);
            int csel = 0; unsigned selmask = 0;
#pragma unroll
            for (int q = 0; q < 9; ++q) {
                const int s = s0 + q;
                if (s < n) {
                    const unsigned key = okey(sc[s]);
                    bool take = key > prefix;
                    if (key == prefix) { take = eqrank < remaining; ++eqrank; }
                    if (take) { ++csel; selmask |= 1u << q; }
                }
            }
            int posn = block_excl_scan(csel, misc + 8);
#pragma unroll
            for (int q = 0; q < 9; ++q) if (selmask & (1u << q)) { if (posn < TOPK) sel[posn] = s0 + q; ++posn; }
            nsel = TOPK;
        }
        __syncthreads();
        {
            const int i = tid;
            if (i < nsel) {
                const int kidx = sel[i];
#pragma unroll 1
                for (int g = 0; g < 2; ++g) {
                    const uint4* kp = (const uint4*)&AK[((size_t)b * L + kidx) * 128 + g * 64];
                    float dd[4] = {0.f, 0.f, 0.f, 0.f};
#pragma unroll 1
                    for (int q = 0; q < 8; ++q) {
                        const uint4 u = kp[q];
                        float kf[8];
                        kf[0] = __uint_as_float(u.x << 16); kf[1] = __uint_as_float(u.x & 0xFFFF0000u);
                        kf[2] = __uint_as_float(u.y << 16); kf[3] = __uint_as_float(u.y & 0xFFFF0000u);
                        kf[4] = __uint_as_float(u.z << 16); kf[5] = __uint_as_float(u.z & 0xFFFF0000u);
                        kf[6] = __uint_as_float(u.w << 16); kf[7] = __uint_as_float(u.w & 0xFFFF0000u);
#pragma unroll
                        for (int r = 0; r < 4; ++r) {
                            const float4 a0 = *(const float4*)&aqs[g * 4 + r][q * 8], a1 = *(const float4*)&aqs[g * 4 + r][q * 8 + 4];
                            dd[r] = fmaf(a0.x, kf[0], dd[r]); dd[r] = fmaf(a0.y, kf[1], dd[r]); dd[r] = fmaf(a0.z, kf[2], dd[r]); dd[r] = fmaf(a0.w, kf[3], dd[r]);
                            dd[r] = fmaf(a1.x, kf[4], dd[r]); dd[r] = fmaf(a1.y, kf[5], dd[r]); dd[r] = fmaf(a1.z, kf[6], dd[r]); dd[r] = fmaf(a1.w, kf[7], dd[r]);
                        }
                    }
#pragma unroll
                    for (int r = 0; r < 4; ++r) lg[g * 4 + r][i] = dd[r];
                }
            } else {
#pragma unroll
                for (int h = 0; h < 8; ++h) lg[h][i] = -INFINITY;
            }
        }
        __syncthreads();
        {
            const int wv = tid >> 6, lane = tid & 63;
#pragma unroll
            for (int hh = 0; hh < 2; ++hh) {
                const int h = wv * 2 + hh;
                float v0 = lg[h][lane], v1 = lg[h][lane + 64], v2 = lg[h][lane + 128], v3 = lg[h][lane + 192];
                const float m = wave_max(fmaxf(fmaxf(v0, v1), fmaxf(v2, v3)));
                v0 = expf(v0 - m); v1 = expf(v1 - m); v2 = expf(v2 - m); v3 = expf(v3 - m);
                const float inv = 1.f / wave_sum(v0 + v1 + v2 + v3);
                lg[h][lane] = v0 * inv; lg[h][lane + 64] = v1 * inv; lg[h][lane + 128] = v2 * inv; lg[h][lane + 192] = v3 * inv;
            }
        }
        __syncthreads();
#pragma unroll
        for (int rep = 0; rep < 2; ++rep) {
            const int idx = tid + rep * 256; const int h = idx >> 6, d = idx & 63, g = h >> 2;
            float o = 0.f;
            for (int i = 0; i < nsel; ++i) o = fmaf(lg[h][i], bf2f(AV[((size_t)b * L + sel[i]) * 128 + g * 64 + d]), o);
            const size_t mi = row * 1024 + 512 + idx;
            MIX[mi] = f2bf(o * bf2f(MIX[mi]));
        }
    }
}

__device__ __forceinline__ void phase_outproj_naive(const Params& p, int layer, char* smem) {
    float* sm = (float*)smem;
    const bf16_t* MIX = (const bf16_t*)(p.ws + OFF_MIX);
    const bf16_t* WOUT = (const bf16_t*)(p.ws + OFF_WOUT) + (size_t)layer * D * D;
    const float* H32 = (const float*)(p.ws + OFF_H32);
    float* Z = (float*)(p.ws + OFF_GQ);
    const int tid = threadIdx.x;
    constexpr int NRT = T / 64, NCT = D / 64;
    for (int item = blockIdx.x; item < NRT * NCT; item += gridDim.x) {
        const int rt = item / NCT, ct = item % NCT;
        gemm_tile64(MIX, D, WOUT, D, D, rt * 64, ct * 64, sm);
        const float* Ct = sm + GT_CT;
        for (int e = tid; e < 64 * 64; e += 256) {
            const int r = e >> 6, c = e & 63; const size_t idx = (size_t)(rt * 64 + r) * D + ct * 64 + c;
            Z[idx] = Ct[r * 65 + c] + ALPHA * H32[idx];
        }
        __syncthreads();
    }
}

__device__ __forceinline__ void phase_ln(const Params& p, int layer, char* smem) {
    float* red = (float*)smem;
    const int tid = threadIdx.x;
    const float* Z = (const float*)(p.ws + OFF_GQ);
    float* H32 = (float*)(p.ws + OFF_H32);
    bf16_t* HB = (bf16_t*)(p.ws + OFF_HB);
    const float* g = p.ln_g + layer * D; const float* bb = p.ln_b + layer * D;
    for (int t = blockIdx.x; t < T; t += gridDim.x) {
        const float4 v = *(const float4*)&Z[(size_t)t * D + tid * 4];
        const float mu = block_sum(v.x + v.y + v.z + v.w, red) * (1.f / D);
        const float d0 = v.x - mu, d1 = v.y - mu, d2 = v.z - mu, d3 = v.w - mu;
        const float var = block_sum(d0 * d0 + d1 * d1 + d2 * d2 + d3 * d3, red) * (1.f / D);
        const float rs = rsqrtf(var + LN_EPS);
        const float4 gg = *(const float4*)&g[tid * 4], b4 = *(const float4*)&bb[tid * 4];
        float4 o; o.x = d0 * rs * gg.x + b4.x; o.y = d1 * rs * gg.y + b4.y; o.z = d2 * rs * gg.z + b4.z; o.w = d3 * rs * gg.w + b4.w;
        if (layer == DEPTH - 1) {
            const int b = t / L, pos = t % L;
            if (pos >= NMETA) *(float4*)&p.out[((size_t)b * SEQ + (pos - NMETA)) * D + tid * 4] = o;
        } else {
            *(float4*)&H32[(size_t)t * D + tid * 4] = o;
            uint2 pk; pk.x = f2bf(o.x) | ((unsigned)f2bf(o.y) << 16); pk.y = f2bf(o.z) | ((unsigned)f2bf(o.w) << 16);
            *(uint2*)&HB[(size_t)t * D + tid * 4] = pk;
        }
    }
}

constexpr int SMEM_BYTES = 48 * 1024;

template <int PH>
__global__ void __launch_bounds__(256) k_phase(Params p, int layer) {
    __shared__ __attribute__((aligned(16))) char smem[SMEM_BYTES];
    if (PH == 0) phase_prep(p, smem);
    if (PH == 1) phase_proj_naive(p, layer, smem);
    if (PH == 2) phase_gla_naive(p, layer, smem);
    if (PH == 3) phase_dsa_naive(p, layer, smem);
    if (PH == 4) phase_outproj_naive(p, layer, smem);
    if (PH == 5) phase_ln(p, layer, smem);
}

__global__ void __launch_bounds__(256) k_mega(Params p) {
    __shared__ __attribute__((aligned(16))) char smem[SMEM_BYTES];
    cg::grid_group grid = cg::this_grid();
    phase_prep(p, smem);
    grid.sync();
    for (int layer = 0; layer < DEPTH; ++layer) {
        phase_proj_naive(p, layer, smem);
        grid.sync();
        phase_gla_naive(p, layer, smem);
        phase_dsa_naive(p, layer, smem);
        grid.sync();
        phase_outproj_naive(p, layer, smem);
        grid.sync();
        phase_ln(p, layer, smem);
        grid.sync();
    }
}

extern "C" void kernel_launch(void* const* d_in, const int* in_sizes, int n_in, void* d_out, int out_size, void* d_ws, size_t ws_size,
                              hipStream_t stream) {
    Params p{};
    p.x = (const float*)d_in[0]; p.meta = (const float*)d_in[1]; p.ln_in_g = (const float*)d_in[2]; p.ln_in_b = (const float*)d_in[3];
    p.w_in = (const float*)d_in[4]; p.wg2 = (const float*)d_in[5]; p.bg = (const float*)d_in[6]; p.norm_g = (const float*)d_in[7];
    p.ikg = (const float*)d_in[8]; p.ikb = (const float*)d_in[9]; p.w_out = (const float*)d_in[10]; p.ln_g = (const float*)d_in[11];
    p.ln_b = (const float*)d_in[12];
    p.out = (float*)d_out; p.ws = (char*)d_ws;
#if MULTI_LAUNCH
    const int G = 2048;
    k_phase<0><<<G, 256, 0, stream>>>(p, 0);
    for (int layer = 0; layer < DEPTH; ++layer) {
        k_phase<1><<<G, 256, 0, stream>>>(p, layer);
        k_phase<2><<<32, 256, 0, stream>>>(p, layer);
        k_phase<3><<<G, 256, 0, stream>>>(p, layer);
        k_phase<4><<<G, 256, 0, stream>>>(p, layer);
        k_phase<5><<<G, 256, 0, stream>>>(p, layer);
    }
#else
    static int grid_blocks = 0;
    if (!grid_blocks) {
        int dev = 0, cus = 0, per_cu = 0;
        hipGetDevice(&dev);
        hipDeviceGetAttribute(&cus, hipDeviceAttributeMultiprocessorCount, dev);
        hipOccupancyMaxActiveBlocksPerMultiprocessor(&per_cu, k_mega, 256, 0);
        if (per_cu > 4) per_cu = 4;
        grid_blocks = cus * per_cu;
    }
    void* args[] = {&p};
    hipLaunchCooperativeKernel((void*)k_mega, dim3(grid_blocks), dim3(256), args, 0, stream);
#endif
}
```

```cpp
#include <hip/hip_runtime.h>
#include <hip/hip_cooperative_groups.h>
#include <stdint.h>
namespace cg = cooperative_groups;
#ifndef PROBE_REP_PREP
#define PROBE_REP_PREP 1
#define PROBE_REP_PROJ 1
#define PROBE_REP_GLAA 1
#define PROBE_REP_GLAC 1
#define PROBE_REP_DSA 1
#define PROBE_REP_OUT 1
#define PROBE_REP_LN 1
#define PROBE_DSA_A 1
#define PROBE_DSA_B 1
#define PROBE_DSA_C 1
#endif

constexpr int D = 1024, NB = 8, SEQ = 2048, NMETA = 16, L = 2064, T = NB * L;
constexpr int DEPTH = 2;
constexpr int INW = 3416, INWP = 3584;
constexpr int TP = 16640;
constexpr int NT = 512;
constexpr int TOPK = 256;
constexpr float LN_EPS = 1e-5f;
constexpr float ALPHA = 1.41421356237309515f;

typedef unsigned short bf16_t;
typedef short bf16x8 __attribute__((ext_vector_type(8)));
typedef float f32x4 __attribute__((ext_vector_type(4)));
#define LAS __attribute__((address_space(3)))

constexpr size_t SZ_H32 = (size_t)T * D * 4;
constexpr size_t SZ_HB = (size_t)TP * D * 2;
constexpr size_t SZ_WIN = (size_t)DEPTH * INWP * D * 2;
constexpr size_t SZ_WOUT = (size_t)DEPTH * D * D * 2;
constexpr int LPV = 2112;
constexpr size_t SZ_GQ = (size_t)T * 256 * 2, SZ_GK = SZ_GQ, SZ_GV = (size_t)NB * 4 * 128 * LPV * 2;
constexpr size_t SZ_UT = (size_t)1024 * 128 * 64 * 4, SZ_ST = (size_t)32 * 33 * 128 * 64 * 2, SZ_DL = (size_t)1024 * 64 * 4;
constexpr size_t SZ_AQ = (size_t)T * 512 * 2, SZ_IQ = (size_t)T * 512 * 2;
constexpr size_t SZ_MIX = (size_t)TP * 1024 * 2;
constexpr int LP = 2112;
constexpr size_t SZ_AK = (size_t)T * 128 * 2, SZ_AV = (size_t)NB * 2 * 64 * LP * 2, SZ_IK = (size_t)T * 64 * 2, SZ_IW = (size_t)T * 8 * 4;
constexpr size_t SZ_GLR = (size_t)T * 16 * 4;
constexpr size_t SZ_ROPE = (size_t)L * 8 * 2 * 4;

constexpr size_t OFF_H32 = 0;
constexpr size_t OFF_HB = OFF_H32 + SZ_H32;
constexpr size_t OFF_WIN = OFF_HB + SZ_HB;
constexpr size_t OFF_WOUT = OFF_WIN + SZ_WIN;
constexpr size_t OFF_GQ = OFF_WOUT + SZ_WOUT;
constexpr size_t OFF_GK = OFF_GQ + SZ_GQ;
constexpr size_t OFF_GV = OFF_GK + SZ_GK;
constexpr size_t OFF_AQ = OFF_GV + SZ_GV;
constexpr size_t OFF_IQ = OFF_AQ + SZ_AQ;
constexpr size_t OFF_MIX = OFF_IQ + SZ_IQ;
constexpr size_t OFF_AK = OFF_MIX + SZ_MIX;
constexpr size_t OFF_AV = OFF_AK + SZ_AK;
constexpr size_t OFF_IK = OFF_AV + SZ_AV;
constexpr size_t OFF_IW = OFF_IK + SZ_IK;
constexpr size_t OFF_GLR = OFF_IW + SZ_IW;
constexpr size_t OFF_ROPE = OFF_GLR + SZ_GLR;
constexpr size_t OFF_ST = OFF_ROPE + SZ_ROPE;
constexpr size_t OFF_DL = OFF_ST + SZ_ST;
constexpr size_t OFF_BAR = OFF_DL + SZ_DL;
constexpr size_t OFF_IKR = OFF_BAR + 16384;
constexpr size_t OFF_END = OFF_IKR + (size_t)T * 64 * 4;
constexpr size_t OFF_UT = OFF_HB;
static_assert(SZ_UT <= SZ_HB, "UT alias");
static_assert(SZ_GQ + SZ_GK + SZ_GV + SZ_AQ + SZ_IQ >= SZ_H32, "Z alias size");
static_assert(OFF_END <= (size_t)256 * 1024 * 1024, "workspace too large");

struct Params {
    const float* x; const float* meta; const float* ln_in_g; const float* ln_in_b;
    const float* w_in; const float* wg2; const float* bg; const float* norm_g;
    const float* ikg; const float* ikb; const float* w_out; const float* ln_g; const float* ln_b;
    float* out; char* ws;
};
typedef const Params __attribute__((address_space(4))) * KParamsPtr;
__device__ __forceinline__ Params kparams() {
    unsigned long long a = (unsigned long long)__builtin_amdgcn_kernarg_segment_ptr();
    asm volatile("" : "+s"(a));
    KParamsPtr q = (KParamsPtr)a;
    Params r;
    r.x = q->x; r.meta = q->meta; r.ln_in_g = q->ln_in_g; r.ln_in_b = q->ln_in_b; r.w_in = q->w_in; r.wg2 = q->wg2; r.bg = q->bg; r.norm_g = q->norm_g;
    r.ikg = q->ikg; r.ikb = q->ikb; r.w_out = q->w_out; r.ln_g = q->ln_g; r.ln_b = q->ln_b; r.out = q->out; r.ws = q->ws;
    return r;
}

__device__ __forceinline__ bf16_t f2bf(float f) {
    unsigned u = __float_as_uint(f);
    u += 0x7FFFu + ((u >> 16) & 1u);
    return (bf16_t)(u >> 16);
}
__device__ __forceinline__ unsigned pack2bf(float lo, float hi) { return (unsigned)f2bf(lo) | ((unsigned)f2bf(hi) << 16); }
__device__ __forceinline__ unsigned cvt_pk_bf16(float lo, float hi) { unsigned r; asm volatile("v_cvt_pk_bf16_f32 %0, %1, %2" : "=v"(r) : "v"(lo), "v"(hi)); return r; }
typedef unsigned u32x4 __attribute__((ext_vector_type(4)));
typedef unsigned u32x2 __attribute__((ext_vector_type(2)));
__device__ __forceinline__ float bf2f(bf16_t h) { return __uint_as_float(((unsigned)h) << 16); }
__device__ __forceinline__ int opaque_tid() { int t = threadIdx.x; asm volatile("" : "+v"(t)); return t; }
__device__ __forceinline__ int opaque_int(int v) { asm volatile("" : "+s"(v)); return v; }
__device__ __forceinline__ int opaque_bid() { int t = blockIdx.x; asm volatile("" : "+s"(t)); return t; }
__device__ __forceinline__ float wave_sum(float v) {
#pragma unroll
    for (int o = 32; o > 0; o >>= 1) v += __shfl_xor(v, o);
    return v;
}
__device__ __forceinline__ float wave_max(float v) {
#pragma unroll
    for (int o = 32; o > 0; o >>= 1) v = fmaxf(v, __shfl_xor(v, o));
    return v;
}
__device__ __forceinline__ float block_sum(float v, float* red) {
    v = wave_sum(v);
    const int tq = opaque_tid();
    __syncthreads();
    if ((tq & 63) == 0) red[tq >> 6] = v;
    __syncthreads();
    return ((red[0] + red[1]) + (red[2] + red[3])) + ((red[4] + red[5]) + (red[6] + red[7]));
}
__device__ __forceinline__ float silu_f(float x) { return x / (1.f + __expf(-x)); }
__device__ __forceinline__ float logsigmoid_f(float x) { return fminf(x, 0.f) - log1pf(expf(-fabsf(x))); }
__device__ __forceinline__ float logsigmoid_fast(float x) { return fminf(x, 0.f) - __logf(1.f + __expf(-fabsf(x))); }

__device__ __forceinline__ int proj_src_col(int n) {
    if (n < 1024) return n;
    if (n < 1536) return n - 1024 + 1040;
    if (n < 2048) return n - 1536 + 1552;
    if (n < 2560) return n - 2048 + 2904;
    if (n < 3072) return n - 2560 + 2320;
    if (n < 3200) return n - 3072 + 2064;
    if (n < 3328) return n - 3200 + 2192;
    const int c = n - 3328;
    if (c < 32) return 2832 + c;
    if (c < 48) return 1024 + (c - 32);
    if (c < 56) return 2896 + (c - 48);
    if (c >= 128 && c < 160) return 2832 + 32 + (c - 128);
    return -1;
}

__device__ __forceinline__ void sincos_acc(float a, float& s, float& c) {
    double ad = (double)a;
    double kd = rint(ad * 0.63661977236758134308);
    double r = fma(-kd, 1.57079632679489655800, ad);
    r = fma(-kd, 6.12323399573676603587e-17, r);
    double r2 = r * r;
    double sp = r * (1.0 + r2 * (-1.0 / 6 + r2 * (1.0 / 120 + r2 * (-1.0 / 5040 + r2 * (1.0 / 362880 + r2 * (-1.0 / 39916800))))));
    double cp = 1.0 + r2 * (-0.5 + r2 * (1.0 / 24 + r2 * (-1.0 / 720 + r2 * (1.0 / 40320 + r2 * (-1.0 / 3628800 + r2 * (1.0 / 479001600))))));
    int q = ((int)kd) & 3;
    double ss = (q & 1) ? cp : sp, cc = (q & 1) ? sp : cp;
    if (q == 1 || q == 2) cc = -cc;
    if (q == 2 || q == 3) ss = -ss;
    s = (float)ss; c = (float)cc;
}

__device__ __forceinline__ void ln_row_wave(f32x4 (&v)[4], const float* g, const float* bb, int lane) {
    float sm = 0.f;
#pragma unroll
    for (int i = 0; i < 4; ++i) sm += (v[i][0] + v[i][1]) + (v[i][2] + v[i][3]);
    const float mu = wave_sum(sm) * (1.f / D);
    float qq = 0.f;
#pragma unroll
    for (int i = 0; i < 4; ++i) { v[i] = v[i] - mu; qq += (v[i][0] * v[i][0] + v[i][1] * v[i][1]) + (v[i][2] * v[i][2] + v[i][3] * v[i][3]); }
    const float rs = rsqrtf(wave_sum(qq) * (1.f / D) + LN_EPS);
#pragma unroll
    for (int i = 0; i < 4; ++i) { const f32x4 gg = *(const f32x4*)(g + 4 * lane + 256 * i), b4 = *(const f32x4*)(bb + 4 * lane + 256 * i); v[i] = v[i] * rs * gg + b4; }
}
__device__ __forceinline__ int proj_dst_col(int src) {
    if (src < 1024) return src;
    if (src < 1040) return 3328 + 32 + (src - 1024);
    if (src < 1552) return 1024 + (src - 1040);
    if (src < 2064) return 1536 + (src - 1552);
    if (src < 2192) return 3072 + (src - 2064);
    if (src < 2320) return 3200 + (src - 2192);
    if (src < 2832) return 2560 + (src - 2320);
    if (src < 2864) return 3328 + (src - 2832);
    if (src < 2896) return 3328 + 128 + (src - 2864);
    if (src < 2904) return 3328 + 48 + (src - 2896);
    return 2048 + (src - 2904);
}
__device__ __forceinline__ void phase_prep(const Params& p_in, char* smem) {
    const Params p = kparams(); (void)p_in;
    const int tid = opaque_tid(), wid = tid >> 6, lane = tid & 63;
    bf16_t* WIN = (bf16_t*)(p.ws + OFF_WIN);
    bf16_t* WOUT = (bf16_t*)(p.ws + OFF_WOUT);
    float* H32 = (float*)(p.ws + OFF_H32);
    bf16_t* HB = (bf16_t*)(p.ws + OFF_HB);
    bf16_t* MIX = (bf16_t*)(p.ws + OFF_MIX);
    float2* ROPE = (float2*)(p.ws + OFF_ROPE);
    float (*tile)[65] = (float (*)[65])smem;
    constexpr int NCT_IN = (INW + 63) / 64, NT_IN = DEPTH * 16 * NCT_IN, NT_OUT = DEPTH * 16 * 16;
    for (int item = opaque_bid(); item < NT_IN + NT_OUT; item += gridDim.x) {
        const bool is_in = item < NT_IN;
        const int it = is_in ? item : item - NT_IN;
        const int nct = is_in ? NCT_IN : 16, ldw = is_in ? INW : D;
        const int l = it / (16 * nct), rem = it - l * 16 * nct, kt = rem / nct, ct = rem - kt * nct;
        const float* W = (is_in ? p.w_in : p.w_out) + (size_t)l * D * ldw;
        __syncthreads();
#pragma unroll
        for (int i = 0; i < 8; ++i) {
            const int e = tid + NT * i, kk = e >> 6, nn = e & 63, col = ct * 64 + nn;
            tile[kk][nn] = (col < ldw) ? W[(size_t)(kt * 64 + kk) * ldw + col] : 0.f;
        }
        __syncthreads();
        {
            const int nn = tid >> 3, k8 = (tid & 7) * 8, src = ct * 64 + nn;
            if (src < ldw) {
                const int dst = is_in ? proj_dst_col(src) : src;
                u32x4 o;
#pragma unroll
                for (int q = 0; q < 4; ++q) o[q] = cvt_pk_bf16(tile[k8 + 2 * q][nn], tile[k8 + 2 * q + 1][nn]);
                bf16_t* dstp = (is_in ? WIN + ((size_t)l * INWP + dst) * D : WOUT + ((size_t)l * D + dst) * D) + kt * 64 + k8;
                *(u32x4*)dstp = o;
            }
        }
    }
    {
        const int nw = gridDim.x * 8;
        for (int t = opaque_bid() * 8 + wid; t < TP; t += nw) {
            if (t < T) {
                const int b = t / L, pos = t - b * L;
                const float* src = (pos < NMETA) ? (p.meta + (size_t)pos * D) : (p.x + ((size_t)b * SEQ + (pos - NMETA)) * D);
                f32x4 v[4];
#pragma unroll
                for (int i = 0; i < 4; ++i) v[i] = *(const f32x4*)(src + 4 * lane + 256 * i);
                ln_row_wave(v, p.ln_in_g, p.ln_in_b, lane);
#pragma unroll
                for (int i = 0; i < 4; ++i) {
                    *(f32x4*)(H32 + (size_t)t * D + 4 * lane + 256 * i) = v[i];
                    u32x2 o; o[0] = cvt_pk_bf16(v[i][0], v[i][1]); o[1] = cvt_pk_bf16(v[i][2], v[i][3]);
                    *(u32x2*)(HB + (size_t)t * D + 4 * lane + 256 * i) = o;
                }
            } else {
#pragma unroll
                for (int i = 0; i < 4; ++i) {
                    *(u32x2*)(HB + (size_t)t * D + 4 * lane + 256 * i) = (u32x2){0u, 0u};
                    *(u32x2*)(MIX + (size_t)t * D + 4 * lane + 256 * i) = (u32x2){0u, 0u};
                }
            }
        }
    }
    for (int e = opaque_bid() * NT + tid; e < L * 8; e += gridDim.x * NT) {
        const int pos = e >> 3, i = e & 7;
        const float inv[8] = {1.0f, 0.19392274f, 0.03760603f, 0.0072926646f, 0.0014142136f, 0.0002742482f, 5.3182957e-05f, 1.0313385e-05f};
        float iv = inv[0];
#pragma unroll
        for (int j = 1; j < 8; ++j) iv = (i == j) ? inv[j] : iv;
        const float ang = (float)pos * iv;
        float sn, cs; sincos_acc(ang, sn, cs);
        ROPE[e] = make_float2(cs, sn);
    }
}

namespace pg8 {
constexpr int BM = 256, BK = 64, HALF = 128, HTB = HALF * BK * 2  , STAGE_BYTES = 8 * HTB, NXCD = 8, WGM = 8;
__device__ __forceinline__ int lds_byte(int r, int c) { const int st = (r >> 4) * 2 + (c >> 5), rr = r & 15, cc = c & 31, ob = rr * 64 + cc * 2; return st * 1024 + (ob ^ (((ob >> 9) & 1) << 5)); }
__device__ __forceinline__ void stage_rc(int b, int& R, int& C) { const int st = b / 1024, sb = b % 1024, swz = sb ^ (((sb >> 9) & 1) << 5); R = (st >> 1) * 16 + swz / 64; C = (st & 1) * 32 + (swz % 64) / 2; }
__device__ __forceinline__ int perm32(int rho) { const int n = rho >> 4, i = rho & 15; return 8 * (i >> 2) + 4 * n + (i & 3); }

struct Unit { int pm, pn; };
struct Gemm { const bf16_t* A; const bf16_t* Bt; int M, N, K; };

struct StaticOrder {
    int nM, nN, nwg, G, c;
    __device__ void init(int M, int N, int G_, int c_) { nM = M / BM; nN = N / BM; nwg = nM * nN; G = G_; c = c_; }
    __device__ bool next(int i, Unit& u) const {
        const long Lx = (long)i * G + c; if (Lx >= nwg) return false;
        int wgid = (int)Lx; { const int q = nwg / NXCD, r = nwg % NXCD, xcd = wgid % NXCD, off = wgid / NXCD; wgid = (xcd < r ? xcd * (q + 1) : r * (q + 1) + (xcd - r) * q) + off; }
        const int nig = WGM * nN, gid = wgid / nig, fm = gid * WGM, gsz = (nM - fm) < WGM ? (nM - fm) : WGM;
        u.pm = fm + ((wgid % nig) % gsz); u.pn = (wgid % nig) / gsz; return true;
    }
    __device__ __forceinline__ void a_ready(const Unit&) const {}
    __device__ __forceinline__ void done(const Unit&) const {}
};

template <class Epi, class Sched>
__device__ __forceinline__ void gemm_phase(LAS unsigned char* lds, const Gemm g, const Sched& S, const Epi& E) {
    const int tid = opaque_tid(), wid = __builtin_amdgcn_readfirstlane(tid >> 6), lane = tid & 63, wr = wid >> 2, wc = wid & 3, fr = lane & 15, fq = lane >> 4;
    const int K = g.K, nt = K / BK;
    unsigned voffA[2], voffB[2];
#pragma unroll
    for (int i = 0; i < 2; ++i) { int R, C; stage_rc(tid * 16 + i * 8192, R, C); const int Rb = Epi::PERM ? ((R & ~31) + perm32(R & 31)) : R;
        voffA[i] = (unsigned)(R * K + C) * 2u; voffB[i] = (unsigned)(Rb * K + C) * 2u; }
    const size_t kstep = (size_t)(BK * 2);
    const size_t hstep = (size_t)HALF * K * 2;
    const size_t tstep = 2 * hstep;
    const unsigned ldsw = (unsigned)wid * 1024u;
    const int aoff = lds_byte(wr * 64 + fr, fq * 8), boff = lds_byte(wc * 32 + fr, fq * 8);
#define PG8_SA(b, h) (((b) * 2 + (h)) * HTB)
#define PG8_SB(b, h) ((4 + (b) * 2 + (h)) * HTB)
#define PG8_STAGE(bufoff, gbase, voff) do { _Pragma("unroll") for (int _i = 0; _i < 2; ++_i) \
        __builtin_amdgcn_global_load_lds((const unsigned*)((const char*)(gbase) + (voff)[_i]), (LAS unsigned*)(lds + (bufoff) + ldsw + _i * 8192), 16, 0, 0); } while (0)
#define PG8_LDA(dst, b, h) do { _Pragma("unroll") for (int m = 0; m < 4; ++m) _Pragma("unroll") for (int k = 0; k < 2; ++k) dst[m][k] = *(const LAS bf16x8*)(lds + PG8_SA(b, h) + aoff + m * 2048 + k * 1024); } while (0)
#define PG8_LDB(dst, b, h) do { _Pragma("unroll") for (int n = 0; n < 2; ++n) _Pragma("unroll") for (int k = 0; k < 2; ++k) dst[n][k] = *(const LAS bf16x8*)(lds + PG8_SB(b, h) + boff + n * 2048 + k * 1024); } while (0)
#define PG8_MMA(ai, bj, At, Bt) do { __builtin_amdgcn_s_setprio(1); _Pragma("unroll") for (int m = 0; m < 4; ++m) _Pragma("unroll") for (int n = 0; n < 2; ++n) _Pragma("unroll") for (int k = 0; k < 2; ++k) \
        acc[ai][bj][m][n] = __builtin_amdgcn_mfma_f32_16x16x32_bf16(Bt[n][k], At[m][k], acc[ai][bj][m][n], 0, 0, 0); __builtin_amdgcn_s_setprio(0); } while (0)
#define PG8_WAIT_V(n) asm volatile("s_waitcnt vmcnt(" #n ")" ::: "memory")
#define PG8_WAIT_L(n) asm volatile("s_waitcnt lgkmcnt(" #n ")" ::: "memory")
#define PG8_BAR __builtin_amdgcn_s_barrier()
#define PG8_SCHED __builtin_amdgcn_sched_barrier(0)
    Unit cur, nxt; int ui = 0;
    if (!S.next(0, cur)) return;
    f32x4 acc[2][2][4][2];
#pragma unroll
    for (int a = 0; a < 2; ++a)
#pragma unroll
        for (int b = 0; b < 2; ++b)
#pragma unroll
            for (int m = 0; m < 4; ++m)
#pragma unroll
                for (int n = 0; n < 2; ++n) acc[a][b][m][n] = (f32x4){0.f, 0.f, 0.f, 0.f};
    bf16x8 At[4][2], B0[2][2], B1[2][2];
    const char* cA = (const char*)g.A + (size_t)cur.pm * tstep; const char* cB = (const char*)g.Bt + (size_t)cur.pn * tstep;
    S.a_ready(cur);
    PG8_STAGE(PG8_SB(0, 0), cB, voffB); PG8_STAGE(PG8_SA(0, 0), cA, voffA); PG8_STAGE(PG8_SB(0, 1), cB + hstep, voffB); PG8_STAGE(PG8_SA(0, 1), cA + hstep, voffA);
    if (wr == 1) PG8_BAR;
    PG8_WAIT_V(4); PG8_BAR;
    PG8_STAGE(PG8_SB(1, 0), cB + kstep, voffB); PG8_STAGE(PG8_SA(1, 0), cA + kstep, voffA); PG8_STAGE(PG8_SB(1, 1), cB + hstep + kstep, voffB);
    PG8_WAIT_V(6); PG8_BAR;
    for (;;) {
        const bool has_next = S.next(ui + 1, nxt);
        const char* nA = has_next ? (const char*)g.A + (size_t)nxt.pm * tstep : cA; const char* nB = has_next ? (const char*)g.Bt + (size_t)nxt.pn * tstep : cB;
        for (int t = 0; t < nt; t += 2) {
            const bool last = (t == nt - 2);
            const char* a1 = cA + (size_t)(t + 1) * kstep;
            const char* a2 = last ? nA : cA + (size_t)(t + 2) * kstep; const char* b2 = last ? nB : cB + (size_t)(t + 2) * kstep;
            const char* a3 = a2 + kstep; const char* b3 = b2 + kstep;
            if (last && has_next) S.a_ready(nxt);
            PG8_LDB(B0, 0, 0); PG8_SCHED; PG8_LDA(At, 0, 0); PG8_STAGE(PG8_SA(1, 1), a1 + hstep, voffA);
            PG8_WAIT_L(8); PG8_BAR; PG8_WAIT_L(0); PG8_MMA(0, 0, At, B0); PG8_BAR; PG8_SCHED;
            PG8_LDB(B1, 0, 1); PG8_STAGE(PG8_SB(0, 0), b2, voffB);
            PG8_BAR; PG8_WAIT_L(0); PG8_MMA(0, 1, At, B1); PG8_BAR;
            PG8_LDA(At, 0, 1); PG8_STAGE(PG8_SA(0, 0), a2, voffA);
            PG8_BAR; PG8_WAIT_L(0); PG8_MMA(1, 0, At, B0); PG8_BAR; PG8_SCHED;
            PG8_STAGE(PG8_SB(0, 1), b2 + hstep, voffB);
            PG8_WAIT_V(6); PG8_BAR; PG8_MMA(1, 1, At, B1); PG8_BAR;
            PG8_LDB(B0, 1, 0); PG8_SCHED; PG8_LDA(At, 1, 0); PG8_STAGE(PG8_SA(0, 1), a2 + hstep, voffA);
            PG8_WAIT_L(8); PG8_BAR; PG8_WAIT_L(0); PG8_MMA(0, 0, At, B0); PG8_BAR; PG8_SCHED;
            PG8_LDB(B1, 1, 1); PG8_STAGE(PG8_SB(1, 0), b3, voffB);
            PG8_BAR; PG8_WAIT_L(0); PG8_MMA(0, 1, At, B1); PG8_BAR;
            PG8_LDA(At, 1, 1); PG8_STAGE(PG8_SA(1, 0), a3, voffA);
            PG8_BAR; PG8_WAIT_L(0); PG8_MMA(1, 0, At, B0); PG8_BAR; PG8_SCHED;
            PG8_STAGE(PG8_SB(1, 1), b3 + hstep, voffB);
            PG8_WAIT_V(6); PG8_BAR; PG8_MMA(1, 1, At, B1); PG8_BAR;
        }
        E(acc, cur, wr, wc, fr, fq); S.done(cur);
        if (!has_next) break;
#pragma unroll
        for (int a = 0; a < 2; ++a)
#pragma unroll
            for (int b = 0; b < 2; ++b)
#pragma unroll
                for (int m = 0; m < 4; ++m)
#pragma unroll
                    for (int n = 0; n < 2; ++n) acc[a][b][m][n] = (f32x4){0.f, 0.f, 0.f, 0.f};
        cur = nxt; cA = nA; cB = nB; ++ui;
    }
    PG8_WAIT_V(0);
    if (wr == 0) PG8_BAR;
    PG8_BAR;
#undef PG8_SA
#undef PG8_SB
#undef PG8_STAGE
#undef PG8_LDA
#undef PG8_LDB
#undef PG8_MMA
#undef PG8_WAIT_V
#undef PG8_WAIT_L
#undef PG8_BAR
#undef PG8_SCHED
}
}

struct EpiProj {
    static constexpr bool PERM = true;
    char* ws;
    __device__ __forceinline__ void store8(bf16_t* dst, const f32x4& a, const f32x4& b, float sc) const {
        u32x4 o; o[0] = cvt_pk_bf16(a[0] * sc, a[1] * sc); o[1] = cvt_pk_bf16(a[2] * sc, a[3] * sc); o[2] = cvt_pk_bf16(b[0] * sc, b[1] * sc); o[3] = cvt_pk_bf16(b[2] * sc, b[3] * sc);
        *(u32x4*)dst = o;
    }
    __device__ __forceinline__ void operator()(const f32x4 (&acc)[2][2][4][2], const pg8::Unit& u, int wr, int wc, int fr, int fq) const {
        asm volatile("" : "+v"(fr), "+v"(fq));
        if (u.pn < 13) {
#pragma unroll
            for (int bj = 0; bj < 2; ++bj) {
                const int hb = 4 * u.pn + 2 * bj + (wc >> 1);
                const int cc8 = 32 * (wc & 1) + 8 * fq;
#pragma unroll
                for (int ai = 0; ai < 2; ++ai)
#pragma unroll
                    for (int m = 0; m < 4; ++m) {
                        const int t = 256 * u.pm + 128 * ai + 64 * wr + 16 * m + fr;
                        const f32x4 v0 = acc[ai][bj][m][0], v1 = acc[ai][bj][m][1];
                        if (t < T) {
                            const size_t tt = (size_t)t;
                            if (hb < 4) store8((bf16_t*)(ws + OFF_GQ) + tt * 256 + hb * 64 + cc8, v0, v1, 0.125f);
                            else if (hb < 8) store8((bf16_t*)(ws + OFF_GK) + tt * 256 + (hb - 4) * 64 + cc8, v0, v1, 1.f);
                            else if (hb < 16) {
                                const int bq = t / L, pos = t - bq * L;
                                bf16_t* dst = (bf16_t*)(ws + OFF_GV) + ((size_t)(bq * 4 + ((hb - 8) >> 1)) * 128 + ((hb - 8) & 1) * 64 + cc8) * LPV + 48 + pos;
#pragma unroll
                                for (int j = 0; j < 4; ++j) { dst[(size_t)j * LPV] = f2bf(v0[j]); dst[(size_t)(4 + j) * LPV] = f2bf(v1[j]); }
                            }
                            else if (hb < 24 || (hb >= 32 && hb < 40)) {
                                f32x4 s0, s1;
#pragma unroll
                                for (int j = 0; j < 4; ++j) { s0[j] = silu_f(v0[j]); s1[j] = silu_f(v1[j]); }
                                const int col = (hb < 24) ? (hb - 16) * 64 : 512 + (hb - 32) * 64;
                                store8((bf16_t*)(ws + OFF_MIX) + tt * 1024 + col + cc8, s0, s1, 1.f);
                            }
                            else if (hb < 32) store8((bf16_t*)(ws + OFF_AQ) + tt * 512 + (hb - 24) * 64 + cc8, v0, v1, 0.125f);
                            else if (hb < 48) store8((bf16_t*)(ws + OFF_IQ) + tt * 512 + (hb - 40) * 64 + cc8, v0, v1, 0.125f);
                            else if (hb < 50) store8((bf16_t*)(ws + OFF_AK) + tt * 128 + (hb - 48) * 64 + cc8, v0, v1, 1.f);
                            else {
                                const int bq = t / L, pos = t - bq * L;
                                bf16_t* dst = (bf16_t*)(ws + OFF_AV) + ((size_t)(bq * 2 + (hb - 50)) * 64 + cc8) * LP + pos;
#pragma unroll
                                for (int j = 0; j < 4; ++j) { dst[(size_t)j * LP] = f2bf(v0[j]); dst[(size_t)(4 + j) * LP] = f2bf(v1[j]); }
                            }
                        }
                        asm volatile("" ::: "memory");
                    }
            }
        } else {
#pragma unroll
            for (int ai = 0; ai < 2; ++ai)
#pragma unroll
                for (int m = 0; m < 4; ++m) {
                    const int t = 256 * u.pm + 128 * ai + 64 * wr + 16 * m + fr;
                    if (t < T) {
                        if (wc == 0) {
                            float* dst = (float*)(ws + OFF_IKR) + (size_t)t * 64 + 8 * fq;
                            *(f32x4*)dst = acc[ai][0][m][0]; *(f32x4*)(dst + 4) = acc[ai][0][m][1];
                            *(f32x4*)(dst + 32) = acc[ai][1][m][0]; *(f32x4*)(dst + 36) = acc[ai][1][m][1];
                        } else if (wc == 1) {
                            const f32x4 v0 = acc[ai][0][m][0], v1 = acc[ai][0][m][1];
                            if (fq < 2) {
                                float* dst = (float*)(ws + OFF_GLR) + (size_t)t * 16 + 8 * fq;
                                *(f32x4*)dst = v0; *(f32x4*)(dst + 4) = v1;
                            } else if (fq == 2) {
                                float* dst = (float*)(ws + OFF_IW) + (size_t)t * 8;
                                *(f32x4*)dst = v0 * 0.353553390593273762f; *(f32x4*)(dst + 4) = v1 * 0.353553390593273762f;
                            }
                        }
                    }
                    asm volatile("" ::: "memory");
                }
        }
    }
};

struct EpiOut {
    static constexpr bool PERM = false;
    const float* H32; float* Z;
    __device__ __forceinline__ void operator()(const f32x4 (&acc)[2][2][4][2], const pg8::Unit& u, int wr, int wc, int fr, int fq) const {
        asm volatile("" : "+v"(fr), "+v"(fq));
        const int col0 = u.pn * 256 + wc * 32 + 4 * fq;
#pragma unroll
        for (int ai = 0; ai < 2; ++ai) {
            f32x4 hv[4][2][2];
#pragma unroll
            for (int m = 0; m < 4; ++m) {
                int t = 256 * u.pm + 128 * ai + 64 * wr + 16 * m + fr; t = t < T ? t : T - 1;
                const size_t off = (size_t)t * D + col0;
#pragma unroll
                for (int bj = 0; bj < 2; ++bj)
#pragma unroll
                    for (int n = 0; n < 2; ++n) hv[m][bj][n] = *(const f32x4*)(H32 + off + bj * 128 + n * 16);
            }
#pragma unroll
            for (int m = 0; m < 4; ++m) {
                const int t = 256 * u.pm + 128 * ai + 64 * wr + 16 * m + fr;
                if (t < T) {
                    const size_t off = (size_t)t * D + col0;
#pragma unroll
                    for (int bj = 0; bj < 2; ++bj)
#pragma unroll
                        for (int n = 0; n < 2; ++n) *(f32x4*)(Z + off + bj * 128 + n * 16) = acc[ai][bj][m][n] + hv[m][bj][n] * ALPHA;
                }
            }
            asm volatile("" ::: "memory");
        }
    }
};

__device__ __forceinline__ void phase_proj(const Params& p_in, int layer_in, char* smem) {
    const Params p = kparams(); const int layer = opaque_int(layer_in); (void)p_in;
    pg8::Gemm g; g.A = (const bf16_t*)(p.ws + OFF_HB); g.Bt = (const bf16_t*)(p.ws + OFF_WIN) + (size_t)layer * INWP * D; g.M = TP; g.N = INWP; g.K = D;
    pg8::StaticOrder S; S.init(TP, INWP, gridDim.x, opaque_bid());
    EpiProj E; E.ws = p.ws;
    pg8::gemm_phase((LAS unsigned char*)smem, g, S, E);
}
__device__ __forceinline__ void phase_outproj(const Params& p_in, int layer_in, char* smem) {
    const Params p = kparams(); const int layer = opaque_int(layer_in); (void)p_in;
    pg8::Gemm g; g.A = (const bf16_t*)(p.ws + OFF_MIX); g.Bt = (const bf16_t*)(p.ws + OFF_WOUT) + (size_t)layer * D * D; g.M = TP; g.N = D; g.K = D;
    pg8::StaticOrder S; S.init(TP, D, gridDim.x, opaque_bid());
    EpiOut E; E.H32 = (const float*)(p.ws + OFF_H32); E.Z = (float*)(p.ws + OFF_GQ);
    pg8::gemm_phase((LAS unsigned char*)smem, g, S, E);
}

__device__ __forceinline__ void phase_gla_naive(const Params& p, int layer, char* smem) {
    float (*qs)[64] = (float (*)[64])smem;
    float (*ks)[64] = qs + 8;
    float (*es)[64] = ks + 8;
    float (*part)[8] = (float (*)[8])(es + 8);
    float (*os)[128] = (float (*)[128])(part + 2);
    const int tid = opaque_tid();
    const bf16_t* GQ = (const bf16_t*)(p.ws + OFF_GQ);
    const bf16_t* GK = (const bf16_t*)(p.ws + OFF_GK);
    const bf16_t* GV = (const bf16_t*)(p.ws + OFF_GV);
    const float* GLR = (const float*)(p.ws + OFF_GLR);
    bf16_t* MIX = (bf16_t*)(p.ws + OFF_MIX);
    const float* ng = p.norm_g + layer * 128;
    const float* wg2 = p.wg2 + (size_t)layer * 16 * 256; const float* bg = p.bg + layer * 256;
    for (int item = opaque_bid(); item < NB * 4; item += gridDim.x) {
        const int b = item >> 2, h = item & 3;
        float S[64];
#pragma unroll
        for (int d = 0; d < 64; ++d) S[d] = 0.f;
        const int e = tid & 127;
        const float nge = ng[e];
        const int ltt = tid >> 6, ld = tid & 63;
        float w[16];
#pragma unroll
        for (int rr = 0; rr < 16; ++rr) w[rr] = wg2[rr * 256 + h * 64 + ld];
        const float bgd = bg[h * 64 + ld];
        for (int t0 = 0; t0 < L; t0 += 8) {
            __syncthreads();
            {
                const size_t row = (size_t)b * L + t0 + ltt;
                qs[ltt][ld] = bf2f(GQ[row * 256 + h * 64 + ld]);
                ks[ltt][ld] = bf2f(GK[row * 256 + h * 64 + ld]);
                const float4* gp = (const float4*)&GLR[row * 16];
                const float4 g0 = gp[0], g1 = gp[1], g2 = gp[2], g3 = gp[3];
                float s = bgd;
                s = fmaf(g0.x, w[0], s); s = fmaf(g0.y, w[1], s); s = fmaf(g0.z, w[2], s); s = fmaf(g0.w, w[3], s);
                s = fmaf(g1.x, w[4], s); s = fmaf(g1.y, w[5], s); s = fmaf(g1.z, w[6], s); s = fmaf(g1.w, w[7], s);
                s = fmaf(g2.x, w[8], s); s = fmaf(g2.y, w[9], s); s = fmaf(g2.z, w[10], s); s = fmaf(g2.w, w[11], s);
                s = fmaf(g3.x, w[12], s); s = fmaf(g3.y, w[13], s); s = fmaf(g3.z, w[14], s); s = fmaf(g3.w, w[15], s);
                es[ltt][ld] = expf(logsigmoid_f(s) * (1.f / 16.f));
            }
            __syncthreads();
            if (tid < 128) {
#pragma unroll 1
                for (int tt = 0; tt < 8; ++tt) {
                    const size_t row = (size_t)b * L + t0 + tt;
                    const float v = bf2f(GV[row * 512 + h * 128 + e]);
                    float acc = 0.f;
#pragma unroll
                    for (int d = 0; d < 64; ++d) {
                        S[d] = fmaf(es[tt][d], S[d], ks[tt][d] * v);
                        acc = fmaf(qs[tt][d], S[d], acc);
                    }
                    os[tt][e] = acc;
                    const float ss = wave_sum(acc * acc);
                    if ((tid & 63) == 0) part[tid >> 6][tt] = ss;
                }
            }
            __syncthreads();
            if (tid < 128) {
#pragma unroll 1
                for (int tt = 0; tt < 8; ++tt) {
                    const size_t row = (size_t)b * L + t0 + tt;
                    const float tot = part[0][tt] + part[1][tt];
                    const float rinv = rsqrtf(tot * (1.f / 128) + LN_EPS);
                    const size_t idx = row * 1024 + h * 128 + e;
                    MIX[idx] = f2bf(os[tt][e] * rinv * nge * bf2f(MIX[idx]));
                }
            }
        }
    }
}

__device__ __forceinline__ unsigned okey(float x) {
    const unsigned u = __float_as_uint(x);
    return (u & 0x80000000u) ? ~u : (u | 0x80000000u);
}
__device__ __forceinline__ int wave_incl_scan(int v) {
    const int lane = opaque_tid() & 63;
#pragma unroll
    for (int o = 1; o < 64; o <<= 1) { const int n = __shfl_up(v, o); if (lane >= o) v += n; }
    return v;
}
__device__ __forceinline__ int block_excl_scan(int v, int* tmp) {
    const int incl = wave_incl_scan(v);
    const int tq = opaque_tid();
    __syncthreads();
    if ((tq & 63) == 63) tmp[tq >> 6] = incl;
    __syncthreads();
    const int w = tq >> 6;
    int base = 0;
    for (int i = 0; i < w; ++i) base += tmp[i];
    return base + incl - v;
}
__device__ __forceinline__ void unpack8(const uint4 u, float* kf) {
    kf[0] = __uint_as_float(u.x << 16); kf[1] = __uint_as_float(u.x & 0xFFFF0000u);
    kf[2] = __uint_as_float(u.y << 16); kf[3] = __uint_as_float(u.y & 0xFFFF0000u);
    kf[4] = __uint_as_float(u.z << 16); kf[5] = __uint_as_float(u.z & 0xFFFF0000u);
    kf[6] = __uint_as_float(u.w << 16); kf[7] = __uint_as_float(u.w & 0xFFFF0000u);
}

__device__ __forceinline__ void phase_dsa_naive(const Params& p, int layer, char* smem) {
    float* sc = (float*)smem;
    float (*iqs)[64] = (float (*)[64])(sc + 2080);
    float (*aqs)[64] = iqs + 8;
    float (*lg)[256] = (float (*)[256])(aqs + 8);
    unsigned* hist = (unsigned*)(lg + 8);
    int* sel = (int*)(hist + 256);
    int* misc = sel + 256;
    const int tid = opaque_tid();
    const bf16_t* IQ = (const bf16_t*)(p.ws + OFF_IQ);
    const bf16_t* IK = (const bf16_t*)(p.ws + OFF_IK);
    const float* IW = (const float*)(p.ws + OFF_IW);
    const bf16_t* AQ = (const bf16_t*)(p.ws + OFF_AQ);
    const bf16_t* AK = (const bf16_t*)(p.ws + OFF_AK);
    const bf16_t* AV = (const bf16_t*)(p.ws + OFF_AV);
    bf16_t* MIX = (bf16_t*)(p.ws + OFF_MIX);
    for (int item = opaque_bid(); item < T; item += gridDim.x) {
        const int b = item / L, t = item % L;
        const size_t row = (size_t)item;
        __syncthreads();
        iqs[tid >> 6][tid & 63] = bf2f(IQ[row * 512 + tid]); aqs[tid >> 6][tid & 63] = bf2f(AQ[row * 512 + tid]);
        __syncthreads();
        float w[8];
#pragma unroll
        for (int j = 0; j < 8; ++j) w[j] = IW[row * 8 + j];
        for (int s = tid; s <= t; s += NT) {
            const uint4* kp = (const uint4*)&IK[((size_t)b * L + s) * 64];
            float dd[8];
#pragma unroll
            for (int j = 0; j < 8; ++j) dd[j] = 0.f;
#pragma unroll 1
            for (int q = 0; q < 8; ++q) {
                float kf[8]; unpack8(kp[q], kf);
#pragma unroll
                for (int j = 0; j < 8; ++j) {
                    const float4 a0 = *(const float4*)&iqs[j][q * 8], a1 = *(const float4*)&iqs[j][q * 8 + 4];
                    dd[j] = fmaf(a0.x, kf[0], dd[j]); dd[j] = fmaf(a0.y, kf[1], dd[j]); dd[j] = fmaf(a0.z, kf[2], dd[j]); dd[j] = fmaf(a0.w, kf[3], dd[j]);
                    dd[j] = fmaf(a1.x, kf[4], dd[j]); dd[j] = fmaf(a1.y, kf[5], dd[j]); dd[j] = fmaf(a1.z, kf[6], dd[j]); dd[j] = fmaf(a1.w, kf[7], dd[j]);
                }
            }
            float score = 0.f;
#pragma unroll
            for (int j = 0; j < 8; ++j) score = fmaf(w[j], fmaxf(dd[j], 0.f), score);
            sc[s] = score;
        }
        __syncthreads();
        const int n = t + 1;
        int nsel;
        if (n <= TOPK) {
            if (tid < n) sel[tid] = tid;
            nsel = n;
        } else {
            unsigned prefix = 0; int remaining = TOPK;
            for (int pass = 0; pass < 4; ++pass) {
                const int shift = 24 - 8 * pass;
                if (tid < 256) hist[tid] = 0;
                __syncthreads();
                for (int s = tid; s < n; s += NT) {
                    const unsigned key = okey(sc[s]);
                    const bool match = (pass == 0) || ((key >> (shift + 8)) == prefix);
                    if (match) atomicAdd(&hist[(key >> shift) & 255u], 1u);
                }
                __syncthreads();
                if (tid == 0) {
                    int cum = 0, d = 255;
                    for (; d > 0; --d) { const int c = (int)hist[d]; if (cum + c >= remaining) break; cum += c; }
                    misc[0] = d; misc[1] = remaining - cum;
                }
                __syncthreads();
                prefix = (prefix << 8) | (unsigned)misc[0]; remaining = misc[1];
                __syncthreads();
            }
            const int s0 = tid * 5;
            int ceq = 0;
#pragma unroll
            for (int q = 0; q < 5; ++q) { const int s = s0 + q; if (s < n && okey(sc[s]) == prefix) ++ceq; }
            int eqrank = block_excl_scan(ceq, misc + 8);
            int csel = 0; unsigned selmask = 0;
#pragma unroll
            for (int q = 0; q < 5; ++q) {
                const int s = s0 + q;
                if (s < n) {
                    const unsigned key = okey(sc[s]);
                    bool take = key > prefix;
                    if (key == prefix) { take = eqrank < remaining; ++eqrank; }
                    if (take) { ++csel; selmask |= 1u << q; }
                }
            }
            int posn = block_excl_scan(csel, misc + 16);
#pragma unroll
            for (int q = 0; q < 5; ++q) if (selmask & (1u << q)) { if (posn < TOPK) sel[posn] = s0 + q; ++posn; }
            nsel = TOPK;
        }
        __syncthreads();
        {
            const int i = tid & 255, g = tid >> 8;
            if (i < nsel) {
                const int kidx = sel[i];
                const uint4* kp = (const uint4*)&AK[((size_t)b * L + kidx) * 128 + g * 64];
                float dd[4] = {0.f, 0.f, 0.f, 0.f};
#pragma unroll 1
                for (int q = 0; q < 8; ++q) {
                    float kf[8]; unpack8(kp[q], kf);
#pragma unroll
                    for (int r = 0; r < 4; ++r) {
                        const float4 a0 = *(const float4*)&aqs[g * 4 + r][q * 8], a1 = *(const float4*)&aqs[g * 4 + r][q * 8 + 4];
                        dd[r] = fmaf(a0.x, kf[0], dd[r]); dd[r] = fmaf(a0.y, kf[1], dd[r]); dd[r] = fmaf(a0.z, kf[2], dd[r]); dd[r] = fmaf(a0.w, kf[3], dd[r]);
                        dd[r] = fmaf(a1.x, kf[4], dd[r]); dd[r] = fmaf(a1.y, kf[5], dd[r]); dd[r] = fmaf(a1.z, kf[6], dd[r]); dd[r] = fmaf(a1.w, kf[7], dd[r]);
                    }
                }
#pragma unroll
                for (int r = 0; r < 4; ++r) lg[g * 4 + r][i] = dd[r];
            } else {
#pragma unroll
                for (int r = 0; r < 4; ++r) lg[g * 4 + r][i] = -INFINITY;
            }
        }
        __syncthreads();
        {
            const int h = tid >> 6, lane = tid & 63;
            float v0 = lg[h][lane], v1 = lg[h][lane + 64], v2 = lg[h][lane + 128], v3 = lg[h][lane + 192];
            const float m = wave_max(fmaxf(fmaxf(v0, v1), fmaxf(v2, v3)));
            v0 = expf(v0 - m); v1 = expf(v1 - m); v2 = expf(v2 - m); v3 = expf(v3 - m);
            const float inv = 1.f / wave_sum(v0 + v1 + v2 + v3);
            lg[h][lane] = v0 * inv; lg[h][lane + 64] = v1 * inv; lg[h][lane + 128] = v2 * inv; lg[h][lane + 192] = v3 * inv;
        }
        __syncthreads();
        {
            const int h = tid >> 6, d = tid & 63, g = h >> 2;
            float o = 0.f;
            for (int i = 0; i < nsel; ++i) o = fmaf(lg[h][i], bf2f(AV[((size_t)b * L + sel[i]) * 128 + g * 64 + d]), o);
            const size_t mi = row * 1024 + 512 + tid;
            MIX[mi] = f2bf(o * bf2f(MIX[mi]));
        }
    }
}


constexpr int DS_SC = 0, DS_BITS = 132096, DS_HIST = DS_BITS + 4224, DS_END = DS_HIST + 8 * 1040;
constexpr int DS_MB = 3 * 32768, DS_MBROW = 2112;
static_assert(DS_MB + 16 * DS_MBROW <= DS_BITS, "mask bytes overlap");

__device__ __forceinline__ void phase_dsa(const Params& p_in, int layer_in, char* smem, bool do_store) {
    const Params p = kparams(); const int layer = opaque_int(layer_in); (void)p_in;
    const int tid = opaque_tid(), wid = __builtin_amdgcn_readfirstlane(tid >> 6), lane = tid & 63, fr = lane & 15, fq = lane >> 4;
    LAS unsigned char* lds = (LAS unsigned char*)smem;
    const bf16_t* IQ = (const bf16_t*)(p.ws + OFF_IQ);
    const bf16_t* IK = (const bf16_t*)(p.ws + OFF_IK);
    const float* IW = (const float*)(p.ws + OFF_IW);
    const bf16_t* AQ = (const bf16_t*)(p.ws + OFF_AQ);
    const bf16_t* AK = (const bf16_t*)(p.ws + OFF_AK);
    const bf16_t* AVT = (const bf16_t*)(p.ws + OFF_AV);
    bf16_t* MIX = (bf16_t*)(p.ws + OFF_MIX);
    constexpr int NITEM = NB * 129;
    for (int idx = opaque_bid(); idx < NITEM; idx += gridDim.x) {
        const int b = idx & 7, mm = idx >> 3;
        int qr;
        { const int seg = mm >> 5, jj = mm & 31; qr = (seg == 0) ? jj : (seg == 1) ? 63 - jj : (seg == 2) ? 64 + jj : (seg == 3) ? 127 - jj : 128; }
        const int qt = 128 - qr, t0 = qt * 16;
        const size_t rowq = (size_t)b * L + t0 + fr;
        __syncthreads();
        for (int repA = 0; repA < PROBE_DSA_A; ++repA) {
            bf16x8 qf[8][2];
#pragma unroll
            for (int jh = 0; jh < 8; ++jh)
#pragma unroll
                for (int s2 = 0; s2 < 2; ++s2) qf[jh][s2] = *(const bf16x8*)(IQ + rowq * 512 + jh * 64 + s2 * 32 + fq * 8);
            float w[8];
            { const f32x4 w0 = *(const f32x4*)(IW + rowq * 8), w1 = *(const f32x4*)(IW + rowq * 8 + 4);
              w[0] = w0[0]; w[1] = w0[1]; w[2] = w0[2]; w[3] = w0[3]; w[4] = w1[0]; w[5] = w1[1]; w[6] = w1[2]; w[7] = w1[3]; }
            const int ntile = qt + 1;
            const bf16x8 z8 = {0, 0, 0, 0, 0, 0, 0, 0};
            bf16x8 ka0 = z8, ka1 = z8, kb0 = z8, kb1 = z8, kc0 = z8, kc1 = z8;
            int kt = wid;
            if (kt < ntile) { const bf16_t* kp = IK + ((size_t)b * L + 16 * kt + fr) * 64 + fq * 8; ka0 = *(const bf16x8*)kp; ka1 = *(const bf16x8*)(kp + 32); }
            if (kt + 8 < ntile) { const bf16_t* kp = IK + ((size_t)b * L + 16 * (kt + 8) + fr) * 64 + fq * 8; kb0 = *(const bf16x8*)kp; kb1 = *(const bf16x8*)(kp + 32); }
            for (; kt < ntile; kt += 8) {
                if (kt + 16 < ntile) { const bf16_t* kp = IK + ((size_t)b * L + 16 * (kt + 16) + fr) * 64 + fq * 8; kc0 = *(const bf16x8*)kp; kc1 = *(const bf16x8*)(kp + 32); }
                f32x4 sc = {0.f, 0.f, 0.f, 0.f};
#pragma unroll
                for (int jh = 0; jh < 8; ++jh) {
                    f32x4 d = {0.f, 0.f, 0.f, 0.f};
                    d = __builtin_amdgcn_mfma_f32_16x16x32_bf16(ka0, qf[jh][0], d, 0, 0, 0);
                    d = __builtin_amdgcn_mfma_f32_16x16x32_bf16(ka1, qf[jh][1], d, 0, 0, 0);
#pragma unroll
                    for (int r = 0; r < 4; ++r) sc[r] = fmaf(w[jh], fmaxf(d[r], 0.f), sc[r]);
                }
                u32x4 ko;
#pragma unroll
                for (int r = 0; r < 4; ++r) ko[r] = okey(sc[r]);
                *(LAS u32x4*)(lds + DS_SC + (fr * 2064 + 16 * kt + 4 * fq) * 4) = ko;
                ka0 = kb0; ka1 = kb1; kb0 = kc0; kb1 = kc1;
            }
        }
        __syncthreads();
        for (int repB = 0; repB < PROBE_DSA_B; ++repB) {
            LAS unsigned* hist = (LAS unsigned*)(lds + DS_HIST + wid * 1040);
#pragma unroll 1
            for (int qq = 0; qq < 2; ++qq) {
                const int q = wid * 2 + qq;
                const int n = t0 + q + 1;
                const LAS unsigned* row = (const LAS unsigned*)(lds + DS_SC) + q * 2064;
                LAS unsigned* bits = (LAS unsigned*)(lds + DS_BITS) + q * 66;
                if (n <= TOPK) {
#pragma unroll 1
                    for (int i = 0; i < 33; ++i) {
                        const unsigned long long sm = __ballot(lane + 64 * i < n);
                        if (lane == 0) { bits[2 * i] = (unsigned)sm; bits[2 * i + 1] = (unsigned)(sm >> 32); }
                    }
                } else {
                    unsigned kreg[33];
#pragma unroll
                    for (int i = 0; i < 33; ++i) { kreg[i] = 0u; if (64 * i < n) kreg[i] = (lane < n - 64 * i) ? row[lane + 64 * i] : 0u; }
                    unsigned prefix = 0; int remaining = TOPK;
#pragma unroll 1
                    for (int pass = 0; pass < 4; ++pass) {
                        const int shift = 24 - 8 * pass;
                        *(LAS u32x4*)(hist + lane * 4) = (u32x4){0u, 0u, 0u, 0u};
                        __builtin_amdgcn_wave_barrier(); asm volatile("" ::: "memory");
                        if (pass == 0) {
#pragma unroll
                            for (int i = 0; i < 33; ++i)
                                if (64 * i < n) __hip_atomic_fetch_add(hist + (kreg[i] >> 24), 1u, __ATOMIC_RELAXED, __HIP_MEMORY_SCOPE_WAVEFRONT);
                        } else {
                            const unsigned sh8 = (unsigned)(shift + 8);
#pragma unroll
                            for (int i = 0; i < 33; ++i)
                                if (64 * i < n) {
                                    const unsigned key = kreg[i];
                                    const unsigned bin = ((key >> sh8) == prefix) ? ((key >> shift) & 255u) : 256u;
                                    __hip_atomic_fetch_add(hist + bin, 1u, __ATOMIC_RELAXED, __HIP_MEMORY_SCOPE_WAVEFRONT);
                                }
                        }
                        __builtin_amdgcn_wave_barrier(); asm volatile("s_waitcnt lgkmcnt(0)" ::: "memory");
                        const u32x4 hv = *(const LAS u32x4*)(hist + (63 - lane) * 4);
                        const int c0 = (int)hv[3], c1 = (int)hv[2], c2 = (int)hv[1], c3 = (int)hv[0];
                        const int tot = c0 + c1 + c2 + c3;
                        const int incl = wave_incl_scan(tot), excl = incl - tot;
                        const bool found = (excl < remaining) && (remaining <= incl);
                        int digit = 0, rem_new = 0;
                        if (found) {
                            int cum = excl;
                            if (cum + c0 >= remaining) { digit = 255 - 4 * lane; rem_new = remaining - cum; }
                            else { cum += c0;
                                if (cum + c1 >= remaining) { digit = 254 - 4 * lane; rem_new = remaining - cum; }
                                else { cum += c1;
                                    if (cum + c2 >= remaining) { digit = 253 - 4 * lane; rem_new = remaining - cum; }
                                    else { cum += c2; digit = 252 - 4 * lane; rem_new = remaining - cum; } } }
                        }
                        const unsigned long long fm = __ballot(found);
                        const int src = (int)__builtin_ctzll(fm);
                        digit = __shfl(digit, src); rem_new = __shfl(rem_new, src);
                        prefix = (prefix << 8) | (unsigned)digit; remaining = rem_new;
                    }
                    const unsigned tkey = prefix;
                    int eqcount = 0;
#pragma unroll
                    for (int i = 0; i < 33; ++i) {
                        if (64 * i < n) {
                            const unsigned key = kreg[i];
                            const bool valid = lane < n - 64 * i;
                            const bool gt = valid && (key > tkey), eq = valid && (key == tkey);
                            const unsigned long long em = __ballot(eq);
                            const int rank = eqcount + __popcll(em & ((1ull << lane) - 1ull));
                            const bool sel = gt || (eq && rank < remaining);
                            eqcount += __popcll(em);
                            const unsigned long long sm = __ballot(sel);
                            if (lane == 0) { bits[2 * i] = (unsigned)sm; bits[2 * i + 1] = (unsigned)(sm >> 32); }
                        } else if (lane == 0) { bits[2 * i] = 0u; bits[2 * i + 1] = 0u; }
                    }
                }
            }
        }
        __syncthreads();
        for (int repC = 0; repC < PROBE_DSA_C; ++repC) {
            if (repC > 0) __syncthreads();
            const int h = wid, g = h >> 2;
            const int nstep = (t0 + 16 + 63) >> 6;
            bf16x8 aqf[2];
            aqf[0] = *(const bf16x8*)(AQ + rowq * 512 + h * 64 + fq * 8);
            aqf[1] = *(const bf16x8*)(AQ + rowq * 512 + h * 64 + 32 + fq * 8);
            asm volatile("" : "+v"(aqf[0]), "+v"(aqf[1]));
            const int drow = 8 * wid + (lane >> 3);
            const int kch = (lane & 7) ^ (drow & 7), vch = (lane & 7) ^ ((drow >> 1) & 7);
            const bf16_t* vsrc0 = AVT + ((size_t)b * 128 + drow) * LP + vch * 8;
#define DSA_DMA(st_, buf_) do { \
                int krow_ = b * L + 64 * (st_) + drow; krow_ = krow_ < T ? krow_ : T - 1; \
                const bf16_t* ks_ = AK + (size_t)krow_ * 128 + kch * 8; \
                LAS unsigned char* lb_ = lds + (buf_) * 32768 + wid * 1024; \
                __builtin_amdgcn_global_load_lds((const unsigned*)ks_, (LAS unsigned*)lb_, 16, 0, 0); \
                __builtin_amdgcn_global_load_lds((const unsigned*)(ks_ + 64), (LAS unsigned*)(lb_ + 8192), 16, 0, 0); \
                __builtin_amdgcn_global_load_lds((const unsigned*)(vsrc0 + 64 * (st_)), (LAS unsigned*)(lb_ + 16384), 16, 0, 0); \
                __builtin_amdgcn_global_load_lds((const unsigned*)(vsrc0 + (size_t)64 * LP + 64 * (st_)), (LAS unsigned*)(lb_ + 24576), 16, 0, 0); } while (0)
            DSA_DMA(0, 0);
            DSA_DMA((nstep > 1 ? 1 : 0), 1);
            for (int wi = tid; wi < 16 * 66; wi += NT) {
                const int q = wi / 66, wd = wi - q * 66;
                const unsigned bw = *((const LAS unsigned*)(lds + DS_BITS) + wi);
                const int st = wd >> 1, hh = wd & 1;
#pragma unroll
                for (int f = 0; f < 4; ++f) {
                    const unsigned n0 = (bw >> (4 * f)) & 15u, n1 = (bw >> (16 + 4 * f)) & 15u;
                    u32x2 o; o.x = (n0 * 0x00204081u) & 0x01010101u; o.y = (n1 * 0x00204081u) & 0x01010101u;
                    *(LAS u32x2*)(lds + DS_MB + q * DS_MBROW + 64 * st + 16 * f + 8 * hh) = o;
                }
            }
            asm volatile("s_waitcnt vmcnt(4) lgkmcnt(0)" ::: "memory");
            __builtin_amdgcn_s_barrier();
            asm volatile("" ::: "memory");
            f32x4 O[4];
#pragma unroll
            for (int dt = 0; dt < 4; ++dt) O[dt] = (f32x4){0.f, 0.f, 0.f, 0.f};
            float m = -INFINITY, l = 0.f;
            const float C2 = 1.44269504088896341f;
            int buf = 0;
            for (int st = 0; st < nstep; ++st) {
                {
                    const int sn = (st + 2 < nstep) ? st + 2 : nstep - 1;
                    const int bn = (buf >= 1) ? buf - 1 : 2;
                    DSA_DMA(sn, bn);
                }
                const LAS unsigned char* sb = lds + buf * 32768;
                f32x4 S[4];
#pragma unroll
                for (int kt = 0; kt < 4; ++kt) {
                    S[kt] = (f32x4){0.f, 0.f, 0.f, 0.f};
#pragma unroll
                    for (int s2 = 0; s2 < 2; ++s2) {
                        const int rowk = 16 * kt + fr;
                        const bf16x8 kf = *(const LAS bf16x8*)(sb + g * 8192 + rowk * 128 + 16 * ((4 * s2 + fq) ^ (rowk & 7)));
                        S[kt] = __builtin_amdgcn_mfma_f32_16x16x32_bf16(kf, aqf[s2], S[kt], 0, 0, 0);
                    }
                }
                const u32x4 mb = *(const LAS u32x4*)(lds + DS_MB + fr * DS_MBROW + 64 * st + 16 * fq);
                float pmax = S[0][0];
#pragma unroll
                for (int kt = 0; kt < 4; ++kt)
#pragma unroll
                    for (int r = 0; r < 4; ++r) pmax = fmaxf(pmax, S[kt][r]);
                if (__any(pmax > m + 8.0f)) {
                    float pm = fmaxf(pmax, __shfl_xor(pmax, 16)); pm = fmaxf(pm, __shfl_xor(pm, 32));
                    const float mn = fmaxf(m, pm);
                    const float alpha = __builtin_amdgcn_exp2f((m - mn) * C2);
#pragma unroll
                    for (int dt = 0; dt < 4; ++dt) O[dt] *= alpha;
                    l *= alpha; m = mn;
                }
                const float mc = m * C2;
                unsigned pk[4][2];
#pragma unroll
                for (int kt = 0; kt < 4; ++kt) {
                    float pv[4];
#pragma unroll
                    for (int r = 0; r < 4; ++r) {
                        const float e = __builtin_amdgcn_exp2f(fmaf(S[kt][r], C2, -mc));
                        const float bf = (float)((mb[kt] >> (8 * r)) & 0xFFu);
                        pv[r] = e * bf; l += pv[r];
                    }
                    pk[kt][0] = cvt_pk_bf16(pv[0], pv[1]); pk[kt][1] = cvt_pk_bf16(pv[2], pv[3]);
                }
#pragma unroll
                for (int ks = 0; ks < 2; ++ks) {
                    u32x4 pw; pw[0] = pk[2 * ks][0]; pw[1] = pk[2 * ks][1]; pw[2] = pk[2 * ks + 1][0]; pw[3] = pk[2 * ks + 1][1];
                    const bf16x8 pf = __builtin_bit_cast(bf16x8, pw);
#pragma unroll
                    for (int dt = 0; dt < 4; ++dt) {
                        const int rowv = 16 * dt + fr, sw = (rowv >> 1) & 7;
                        const LAS unsigned char* vp = sb + 16384 + g * 8192 + rowv * 128 + 8 * (fq & 1);
                        const u32x2 va = *(const LAS u32x2*)(vp + 16 * ((4 * ks + (fq >> 1)) ^ sw));
                        const u32x2 vb = *(const LAS u32x2*)(vp + 16 * ((4 * ks + 2 + (fq >> 1)) ^ sw));
                        u32x4 vw; vw[0] = va[0]; vw[1] = va[1]; vw[2] = vb[0]; vw[3] = vb[1];
                        O[dt] = __builtin_amdgcn_mfma_f32_16x16x32_bf16(__builtin_bit_cast(bf16x8, vw), pf, O[dt], 0, 0, 0);
                    }
                }
                asm volatile("s_waitcnt vmcnt(4)" ::: "memory");
                __builtin_amdgcn_s_barrier();
                asm volatile("" ::: "memory");
                buf = (buf == 2) ? 0 : buf + 1;
            }
#undef DSA_DMA
            asm volatile("s_waitcnt vmcnt(0)" ::: "memory");
            l += __shfl_xor(l, 16); l += __shfl_xor(l, 32);
            const float inv = 1.f / fmaxf(l, 1e-30f);
            bf16_t* mp = MIX + rowq * 1024 + 512 + h * 64 + 4 * fq;
            if (do_store && repC == PROBE_DSA_C - 1)
#pragma unroll
            for (int dt = 0; dt < 4; ++dt) {
                const uint2 gz = *(const uint2*)(mp + 16 * dt);
                const float g0 = __uint_as_float(gz.x << 16), g1 = __uint_as_float(gz.x & 0xFFFF0000u), g2 = __uint_as_float(gz.y << 16), g3 = __uint_as_float(gz.y & 0xFFFF0000u);
                uint2 o; o.x = pack2bf(O[dt][0] * inv * g0, O[dt][1] * inv * g1); o.y = pack2bf(O[dt][2] * inv * g2, O[dt][3] * inv * g3);
                *(uint2*)(mp + 16 * dt) = o;
            }
        }
    }
}

__device__ __forceinline__ void rope16(const u32x4 a, const u32x4 b, const float2* rp, u32x4& oa, u32x4& ob) {
    const f32x4 r0 = *(const f32x4*)(rp), r1 = *(const f32x4*)(rp + 2), r2 = *(const f32x4*)(rp + 4), r3 = *(const f32x4*)(rp + 6);
    const float cs[8] = {r0[0], r0[2], r1[0], r1[2], r2[0], r2[2], r3[0], r3[2]};
    const float sn[8] = {r0[1], r0[3], r1[1], r1[3], r2[1], r2[3], r3[1], r3[3]};
    float o1[8], o2[8];
#pragma unroll
    for (int i = 0; i < 4; ++i) {
        const float x1l = __uint_as_float(a[i] << 16), x1h = __uint_as_float(a[i] & 0xFFFF0000u);
        const float x2l = __uint_as_float(b[i] << 16), x2h = __uint_as_float(b[i] & 0xFFFF0000u);
        o1[2 * i] = x1l * cs[2 * i] - x2l * sn[2 * i]; o1[2 * i + 1] = x1h * cs[2 * i + 1] - x2h * sn[2 * i + 1];
        o2[2 * i] = x2l * cs[2 * i] + x1l * sn[2 * i]; o2[2 * i + 1] = x2h * cs[2 * i + 1] + x1h * sn[2 * i + 1];
    }
#pragma unroll
    for (int i = 0; i < 4; ++i) { oa[i] = cvt_pk_bf16(o1[2 * i], o1[2 * i + 1]); ob[i] = cvt_pk_bf16(o2[2 * i], o2[2 * i + 1]); }
}
__device__ __forceinline__ void phase_rope(const Params& p_in, int layer_in, char* smem) {
    const Params p = kparams(); const int layer = opaque_int(layer_in); (void)p_in;
    const int tid = opaque_tid();
    const float2* ROPE = (const float2*)(p.ws + OFF_ROPE);
    const int nthr = gridDim.x * NT, gid = opaque_bid() * NT + tid;
    for (int th = gid; th < T * 18; th += nthr) {
        const int t = th / 18, hh = th - t * 18, pos = t % L;
        bf16_t* base = (hh < 8) ? (bf16_t*)(p.ws + OFF_AQ) + (size_t)t * 512 + hh * 64
                     : (hh < 16) ? (bf16_t*)(p.ws + OFF_IQ) + (size_t)t * 512 + (hh - 8) * 64
                                 : (bf16_t*)(p.ws + OFF_AK) + (size_t)t * 128 + (hh - 16) * 64;
        const u32x4 a = *(const u32x4*)base, b = *(const u32x4*)(base + 8);
        u32x4 oa, ob; rope16(a, b, ROPE + pos * 8, oa, ob);
        *(u32x4*)base = oa; *(u32x4*)(base + 8) = ob;
    }
    const float* IKR = (const float*)(p.ws + OFF_IKR);
    bf16_t* IK = (bf16_t*)(p.ws + OFF_IK);
    const float* ikg = p.ikg + layer * 64; const float* ikb = p.ikb + layer * 64;
    for (int t = gid; t < T; t += nthr) {
        const int pos = t % L;
        f32x4 x[16];
#pragma unroll
        for (int i = 0; i < 16; ++i) x[i] = *(const f32x4*)(IKR + (size_t)t * 64 + 4 * i);
        float sm = 0.f;
#pragma unroll
        for (int i = 0; i < 16; ++i) sm += (x[i][0] + x[i][1]) + (x[i][2] + x[i][3]);
        const float mu = sm * (1.f / 64);
        float qq = 0.f;
#pragma unroll
        for (int i = 0; i < 16; ++i) { const f32x4 d = x[i] - mu; qq += (d[0] * d[0] + d[1] * d[1]) + (d[2] * d[2] + d[3] * d[3]); }
        const float rs = rsqrtf(qq * (1.f / 64) + LN_EPS);
#pragma unroll
        for (int i = 0; i < 16; ++i) { const f32x4 g = *(const f32x4*)(ikg + 4 * i), bb = *(const f32x4*)(ikb + 4 * i); x[i] = (x[i] - mu) * rs * g + bb; }
        const float2* rp = ROPE + pos * 8;
        const f32x4 r0 = *(const f32x4*)(rp), r1 = *(const f32x4*)(rp + 2), r2 = *(const f32x4*)(rp + 4), r3 = *(const f32x4*)(rp + 6);
        const float cs[8] = {r0[0], r0[2], r1[0], r1[2], r2[0], r2[2], r3[0], r3[2]};
        const float sn[8] = {r0[1], r0[3], r1[1], r1[3], r2[1], r2[3], r3[1], r3[3]};
#pragma unroll
        for (int i = 0; i < 8; ++i) {
            const float x1 = x[i >> 2][i & 3], x2 = x[2 + (i >> 2)][i & 3];
            x[i >> 2][i & 3] = x1 * cs[i] - x2 * sn[i];
            x[2 + (i >> 2)][i & 3] = x2 * cs[i] + x1 * sn[i];
        }
#pragma unroll
        for (int i = 0; i < 8; ++i) {
            u32x4 o; o[0] = cvt_pk_bf16(x[2 * i][0], x[2 * i][1]); o[1] = cvt_pk_bf16(x[2 * i][2], x[2 * i][3]); o[2] = cvt_pk_bf16(x[2 * i + 1][0], x[2 * i + 1][1]); o[3] = cvt_pk_bf16(x[2 * i + 1][2], x[2 * i + 1][3]);
            *(u32x4*)(IK + (size_t)t * 64 + 8 * i) = o;
        }
    }
}

constexpr int GL_QE = 0, GL_KN = 8192, GL_SEG = 16384, GL_PART = 18432;
__device__ __forceinline__ void gla_cumsum(const Params& p, int layer, int b, int h, int c, int tid, LAS unsigned char* lds, float (&bc)[8], float& blast) {
    const int d = tid & 63, seg = tid >> 6;
    const float* wg2 = p.wg2 + (size_t)layer * 16 * 256 + h * 64 + d;
    float w[16];
#pragma unroll
    for (int rr = 0; rr < 16; ++rr) w[rr] = wg2[rr * 256];
    const float bgd = p.bg[layer * 256 + h * 64 + d];
    const float* GLR = (const float*)(p.ws + OFF_GLR);
    float pb = 0.f;
#pragma unroll
    for (int i = 0; i < 8; ++i) {
        const int pos = 64 * c - 48 + 8 * seg + i;
        float gl = 0.f;
        if (pos >= 0) {
            const f32x4* gp = (const f32x4*)(GLR + ((size_t)b * L + pos) * 16);
            const f32x4 g0 = gp[0], g1 = gp[1], g2 = gp[2], g3 = gp[3];
            float x = bgd;
#pragma unroll
            for (int rr = 0; rr < 4; ++rr) { x = fmaf(g0[rr], w[rr], x); }
#pragma unroll
            for (int rr = 0; rr < 4; ++rr) { x = fmaf(g1[rr], w[4 + rr], x); }
#pragma unroll
            for (int rr = 0; rr < 4; ++rr) { x = fmaf(g2[rr], w[8 + rr], x); }
#pragma unroll
            for (int rr = 0; rr < 4; ++rr) { x = fmaf(g3[rr], w[12 + rr], x); }
            gl = logsigmoid_fast(x) * (1.f / 16.f);
        }
        pb += gl; bc[i] = pb;
    }
    LAS float* segs = (LAS float*)(lds + GL_SEG);
    segs[seg * 64 + d] = pb;
    __syncthreads();
    float base = 0.f, tot = 0.f;
#pragma unroll
    for (int sg = 0; sg < 8; ++sg) { const float v = segs[sg * 64 + d]; tot += v; base += (sg < seg) ? v : 0.f; }
#pragma unroll
    for (int i = 0; i < 8; ++i) bc[i] += base;
    blast = tot;
}

__device__ __forceinline__ void phase_gla_a(const Params& p_in, int layer_in, char* smem) {
    const Params p = kparams(); const int layer = opaque_int(layer_in); (void)p_in;
    const int tid = opaque_tid(), wid = __builtin_amdgcn_readfirstlane(tid >> 6), lane = tid & 63, fr = lane & 15, fq = lane >> 4;
    LAS unsigned char* lds = (LAS unsigned char*)smem;
    const bf16_t* GK = (const bf16_t*)(p.ws + OFF_GK);
    const bf16_t* GVT = (const bf16_t*)(p.ws + OFF_GV);
    float* UT = (float*)(p.ws + OFF_UT);
    float* DL = (float*)(p.ws + OFF_DL);
    for (int task = opaque_bid(); task < 1024; task += gridDim.x) {
        const int bh = task >> 5, c = task & 31, b = bh >> 2, h = bh & 3;
        __syncthreads();
        float bc[8], blast;
        gla_cumsum(p, layer, b, h, c, tid, lds, bc, blast);
        {
            const int d = tid & 63, seg = tid >> 6;
            float ke[8];
#pragma unroll
            for (int i = 0; i < 8; ++i) {
                const int pos = 64 * c - 48 + 8 * seg + i;
                const float kv = (pos >= 0) ? bf2f(GK[((size_t)b * L + pos) * 256 + h * 64 + d]) : 0.f;
                ke[i] = kv * __expf(blast - bc[i]);
            }
            u32x4 o; o[0] = cvt_pk_bf16(ke[0], ke[1]); o[1] = cvt_pk_bf16(ke[2], ke[3]); o[2] = cvt_pk_bf16(ke[4], ke[5]); o[3] = cvt_pk_bf16(ke[6], ke[7]);
            *(LAS u32x4*)(lds + GL_QE + d * 128 + 16 * (seg ^ (d & 7))) = o;
            if (seg == 0) DL[(size_t)task * 64 + d] = __expf(blast);
        }
        __syncthreads();
        bf16x8 vf[2];
        {
            const bf16_t* vp = GVT + ((size_t)bh * 128 + 16 * wid + fr) * LPV + 64 * c + 8 * fq;
            vf[0] = *(const bf16x8*)vp; vf[1] = *(const bf16x8*)(vp + 32);
            const bf16x8 z8 = {0, 0, 0, 0, 0, 0, 0, 0};
            if (c == 0) { vf[0] = z8; if (fq < 2) vf[1] = z8; }
        }
#pragma unroll
        for (int dt = 0; dt < 4; ++dt) {
            f32x4 acc = {0.f, 0.f, 0.f, 0.f};
#pragma unroll
            for (int ks = 0; ks < 2; ++ks) {
                const int rowd = 16 * dt + fr;
                const bf16x8 kf = *(const LAS bf16x8*)(lds + GL_QE + rowd * 128 + 16 * ((4 * ks + fq) ^ (rowd & 7)));
                acc = __builtin_amdgcn_mfma_f32_16x16x32_bf16(vf[ks], kf, acc, 0, 0, 0);
            }
            float* up = UT + ((size_t)task * 128 + 16 * wid + 4 * fq) * 64 + 16 * dt + fr;
#pragma unroll
            for (int r = 0; r < 4; ++r) up[r * 64] = acc[r];
        }
    }
}

__device__ __forceinline__ void phase_gla_scan(const Params& p_in, int layer_in, char* smem) {
    const Params p = kparams(); const int layer = opaque_int(layer_in); (void)p_in;
    const int tid = opaque_tid();
    const float* UT = (const float*)(p.ws + OFF_UT);
    const float* DL = (const float*)(p.ws + OFF_DL);
    bf16_t* ST = (bf16_t*)(p.ws + OFF_ST);
    const int nthr = gridDim.x * NT;
    for (int el = opaque_bid() * NT + tid; el < 32 * 8192; el += nthr) {
        const int bh = el >> 13, ed = el & 8191, d = el & 63;
        float sacc = 0.f;
        ST[((size_t)bh * 33) * 8192 + ed] = 0;
#pragma unroll 1
        for (int c0 = 0; c0 < 32; c0 += 16) {
            float u[16], dl[16];
#pragma unroll
            for (int i = 0; i < 16; ++i) { u[i] = UT[((size_t)(bh * 32 + c0 + i)) * 8192 + ed]; dl[i] = DL[(size_t)(bh * 32 + c0 + i) * 64 + d]; }
#pragma unroll
            for (int i = 0; i < 16; ++i) { sacc = fmaf(dl[i], sacc, u[i]); ST[((size_t)bh * 33 + c0 + i + 1) * 8192 + ed] = f2bf(sacc); }
        }
    }
}

__device__ __forceinline__ void phase_gla_c(const Params& p_in, int layer_in, char* smem, bool do_store) {
    const Params p = kparams(); const int layer = opaque_int(layer_in); (void)p_in;
    const int tid = opaque_tid(), wid = __builtin_amdgcn_readfirstlane(tid >> 6), lane = tid & 63, fr = lane & 15, fq = lane >> 4;
    LAS unsigned char* lds = (LAS unsigned char*)smem;
    const bf16_t* GQ = (const bf16_t*)(p.ws + OFF_GQ);
    const bf16_t* GK = (const bf16_t*)(p.ws + OFF_GK);
    const bf16_t* GVT = (const bf16_t*)(p.ws + OFF_GV);
    const bf16_t* ST = (const bf16_t*)(p.ws + OFF_ST);
    bf16_t* MIX = (bf16_t*)(p.ws + OFF_MIX);
    const float* ng = p.norm_g + layer * 128;
    for (int task = opaque_bid(); task < 32 * 33; task += gridDim.x) {
        const int bh = task / 33, c = task - bh * 33, b = bh >> 2, h = bh & 3;
        __syncthreads();
        float bc[8], blast;
        gla_cumsum(p, layer, b, h, c, tid, lds, bc, blast);
        {
            const int d = tid & 63, seg = tid >> 6;
#pragma unroll
            for (int i = 0; i < 8; ++i) {
                const int t = 8 * seg + i, pos = 64 * c - 48 + t;
                float qv = 0.f, kv = 0.f;
                if (pos >= 0) { const size_t row = (size_t)b * L + pos; qv = bf2f(GQ[row * 256 + h * 64 + d]); kv = bf2f(GK[row * 256 + h * 64 + d]); }
                const int off = t * 128 + 16 * ((d >> 3) ^ (t & 7)) + 2 * (d & 7);
                *(LAS bf16_t*)(lds + GL_QE + off) = f2bf(qv * __expf(bc[i]));
                *(LAS bf16_t*)(lds + GL_KN + off) = f2bf(kv * __expf(-bc[i]));
            }
        }
        __syncthreads();
        const int tw = wid & 3, eh = wid >> 2;
        bf16x8 qf[2];
#pragma unroll
        for (int ks = 0; ks < 2; ++ks) { const int rowt = 16 * tw + fr; qf[ks] = *(const LAS bf16x8*)(lds + GL_QE + rowt * 128 + 16 * ((4 * ks + fq) ^ (rowt & 7))); }
        unsigned pk[4][2];
#pragma unroll
        for (int st = 0; st < 4; ++st) {
            f32x4 a = {0.f, 0.f, 0.f, 0.f};
#pragma unroll
            for (int ks = 0; ks < 2; ++ks) {
                const int rows = 16 * st + fr;
                const bf16x8 kf = *(const LAS bf16x8*)(lds + GL_KN + rows * 128 + 16 * ((4 * ks + fq) ^ (rows & 7)));
                a = __builtin_amdgcn_mfma_f32_16x16x32_bf16(kf, qf[ks], a, 0, 0, 0);
            }
#pragma unroll
            for (int r = 0; r < 4; ++r) a[r] = (16 * st + 4 * fq + r > 16 * tw + fr) ? 0.f : a[r];
            pk[st][0] = cvt_pk_bf16(a[0], a[1]); pk[st][1] = cvt_pk_bf16(a[2], a[3]);
        }
        bf16x8 pf[2];
#pragma unroll
        for (int ks = 0; ks < 2; ++ks) { u32x4 pw; pw[0] = pk[2 * ks][0]; pw[1] = pk[2 * ks][1]; pw[2] = pk[2 * ks + 1][0]; pw[3] = pk[2 * ks + 1][1]; pf[ks] = __builtin_bit_cast(bf16x8, pw); }
        f32x4 O[4];
        float ss = 0.f;
#pragma unroll
        for (int et = 0; et < 4; ++et) {
            const int e0 = 64 * eh + 16 * et;
            f32x4 acc = {0.f, 0.f, 0.f, 0.f};
            const bf16_t* sp = ST + (((size_t)bh * 33 + c) * 128 + e0 + fr) * 64 + 8 * fq;
            const bf16_t* vp = GVT + ((size_t)bh * 128 + e0 + fr) * LPV + 64 * c + 4 * fq;
#pragma unroll
            for (int ks = 0; ks < 2; ++ks) {
                const bf16x8 sf = *(const bf16x8*)(sp + 32 * ks);
                acc = __builtin_amdgcn_mfma_f32_16x16x32_bf16(sf, qf[ks], acc, 0, 0, 0);
                u32x2 va = *(const u32x2*)(vp + 32 * ks), vb = *(const u32x2*)(vp + 32 * ks + 16);
                if (c == 0) { va = (u32x2){0u, 0u}; if (ks == 0) vb = (u32x2){0u, 0u}; }
                u32x4 vw; vw[0] = va[0]; vw[1] = va[1]; vw[2] = vb[0]; vw[3] = vb[1];
                acc = __builtin_amdgcn_mfma_f32_16x16x32_bf16(__builtin_bit_cast(bf16x8, vw), pf[ks], acc, 0, 0, 0);
            }
            O[et] = acc;
            ss += acc[0] * acc[0] + acc[1] * acc[1] + acc[2] * acc[2] + acc[3] * acc[3];
        }
        ss += __shfl_xor(ss, 16); ss += __shfl_xor(ss, 32);
        LAS float* part = (LAS float*)(lds + GL_PART);
        if (fq == 0) part[eh * 64 + 16 * tw + fr] = ss;
        __syncthreads();
        const float tot = part[16 * tw + fr] + part[64 + 16 * tw + fr];
        const float rinv = rsqrtf(tot * (1.f / 128) + LN_EPS);
        const int pos = 64 * c - 48 + 16 * tw + fr;
        if (pos >= 0 && do_store) {
            bf16_t* mp = MIX + ((size_t)b * L + pos) * 1024 + h * 128 + 64 * eh + 4 * fq;
#pragma unroll
            for (int et = 0; et < 4; ++et) {
                const uint2 gz = *(const uint2*)(mp + 16 * et);
                const f32x4 nv = *(const f32x4*)(ng + 64 * eh + 16 * et + 4 * fq);
                const float g0 = __uint_as_float(gz.x << 16), g1 = __uint_as_float(gz.x & 0xFFFF0000u), g2 = __uint_as_float(gz.y << 16), g3 = __uint_as_float(gz.y & 0xFFFF0000u);
                uint2 o; o.x = pack2bf(O[et][0] * rinv * nv[0] * g0, O[et][1] * rinv * nv[1] * g1); o.y = pack2bf(O[et][2] * rinv * nv[2] * g2, O[et][3] * rinv * nv[3] * g3);
                *(uint2*)(mp + 16 * et) = o;
            }
        }
    }
}

__device__ __forceinline__ void phase_ln(const Params& p_in, int layer_in, char* smem) {
    const Params p = kparams(); const int layer = opaque_int(layer_in); (void)p_in;
    const int tid = opaque_tid(), wid = tid >> 6, lane = tid & 63;
    const float* Z = (const float*)(p.ws + OFF_GQ);
    float* H32 = (float*)(p.ws + OFF_H32);
    bf16_t* HB = (bf16_t*)(p.ws + OFF_HB);
    const float* g = p.ln_g + layer * D; const float* bb = p.ln_b + layer * D;
    const int nw = gridDim.x * 8;
    int t = opaque_bid() * 8 + wid;
    f32x4 v[4], vn[4];
    if (t < T) {
#pragma unroll
        for (int i = 0; i < 4; ++i) v[i] = *(const f32x4*)(Z + (size_t)t * D + 4 * lane + 256 * i);
    }
    for (; t < T; t += nw) {
        const int tn = t + nw;
        if (tn < T) {
#pragma unroll
            for (int i = 0; i < 4; ++i) vn[i] = *(const f32x4*)(Z + (size_t)tn * D + 4 * lane + 256 * i);
        }
        ln_row_wave(v, g, bb, lane);
        if (layer == DEPTH - 1) {
            const int b = t / L, pos = t - b * L;
            if (pos >= NMETA) {
#pragma unroll
                for (int i = 0; i < 4; ++i) *(f32x4*)(p.out + ((size_t)b * SEQ + (pos - NMETA)) * D + 4 * lane + 256 * i) = v[i];
            }
        } else {
#pragma unroll
            for (int i = 0; i < 4; ++i) {
                *(f32x4*)(H32 + (size_t)t * D + 4 * lane + 256 * i) = v[i];
                u32x2 o; o[0] = cvt_pk_bf16(v[i][0], v[i][1]); o[1] = cvt_pk_bf16(v[i][2], v[i][3]);
                *(u32x2*)(HB + (size_t)t * D + 4 * lane + 256 * i) = o;
            }
        }
#pragma unroll
        for (int i = 0; i < 4; ++i) v[i] = vn[i];
    }
}

#define XB_TMO      128
#define XB_XCNT(j)  (256  + 64 * (j))
#define XB_XSUB(j)  (1280 + 64 * (j))
#define XB_XGEN(j)  (2304 + 64 * (j))
#define XB_TOP      3328
#define XB_TOPGEN   3392
#define XCD_BAR_WORDS 3456
#define XB_SPIN_CAP (1u << 22)
__device__ __forceinline__ unsigned xb_ld(unsigned* p)              { return __hip_atomic_load(p, __ATOMIC_RELAXED, __HIP_MEMORY_SCOPE_AGENT); }
__device__ __forceinline__ unsigned xb_add(unsigned* p, unsigned v) { return __hip_atomic_fetch_add(p, v, __ATOMIC_RELAXED, __HIP_MEMORY_SCOPE_AGENT); }
__device__ __forceinline__ unsigned xb_xcc_id() { return (unsigned)__builtin_amdgcn_s_getreg((3 << 11) | 20) & 0xFu; }
#define XB_SPIN(cond, bar) do { unsigned _sp = 0; while (cond) { __builtin_amdgcn_s_sleep(1); \
    if ((++_sp & 255u) == 0u) { if (xb_ld(&(bar)[XB_TMO])) break; if (_sp > XB_SPIN_CAP) { atomicAdd(&(bar)[XB_TMO], 1u); break; } } } } while (0)
struct XcdBarrier { unsigned* bar; unsigned x; volatile LAS unsigned* st; };
__device__ __forceinline__ XcdBarrier xcd_barrier_post(unsigned* bar, volatile LAS unsigned* st) {
    XcdBarrier b; b.bar = bar; b.x = xb_xcc_id(); b.st = st;
    if (threadIdx.x == 0) (void)xb_add(&bar[XB_XCNT(b.x)], 1u);
    return b;
}
__device__ __forceinline__ void xcd_barrier_complete(unsigned* bar, unsigned x, unsigned& nloc, unsigned& nx) {
    const unsigned G = gridDim.x * gridDim.y * gridDim.z;
    unsigned sum, cnt, mine, sp = 0u;
    for (;;) {
        sum = 0u; cnt = 0u; mine = 0u;
#pragma unroll
        for (unsigned j = 0; j < 16; ++j) { const unsigned c = xb_ld(&bar[XB_XCNT(j)]); sum += c; cnt += (c > 0u) ? 1u : 0u; mine = (j == x) ? c : mine; }
        if (sum == G) break;
        __builtin_amdgcn_s_sleep(1);
        if ((++sp & 255u) == 0u) { if (xb_ld(&bar[XB_TMO])) break; if (sp > XB_SPIN_CAP) { atomicAdd(&bar[XB_TMO], 1u); break; } }
    }
    nloc = mine > 0u ? mine : 1u; nx = cnt > 0u ? cnt : 1u;
}
__device__ __forceinline__ void xcd_barrier(unsigned* bar_, volatile LAS unsigned* st_) {
    XcdBarrier b; b.bar = bar_; b.x = xb_xcc_id(); b.st = st_;
    asm volatile("s_waitcnt vmcnt(0)" ::: "memory");
    __syncthreads();
    if (opaque_tid() == 0) {
        unsigned* bar = b.bar;
        __builtin_amdgcn_s_waitcnt(0);
        unsigned nloc = b.st[0], nx = b.st[1];
        if (nloc == 0u) { xcd_barrier_complete(bar, b.x, nloc, nx); b.st[0] = nloc; b.st[1] = nx; }
        const unsigned old = xb_add(&bar[XB_XSUB(b.x)], 1u);
        const unsigned gen = old / nloc;
        if (old + 1u == (gen + 1u) * nloc) {
            __builtin_amdgcn_fence(__ATOMIC_RELEASE, "agent");
            asm volatile("s_waitcnt vmcnt(0)" ::: "memory");
            const unsigned og = xb_add(&bar[XB_TOP], 1u);
            const unsigned tg = og / nx;
            if (og + 1u == (tg + 1u) * nx) xb_add(&bar[XB_TOPGEN], 1u);
            else XB_SPIN(xb_ld(&bar[XB_TOPGEN]) == tg, bar);
            __builtin_amdgcn_fence(__ATOMIC_ACQUIRE, "agent");
            xb_add(&bar[XB_XGEN(b.x)], 1u);
            asm volatile("s_waitcnt vmcnt(0)" ::: "memory");
        } else {
            XB_SPIN(xb_ld(&bar[XB_XGEN(b.x)]) == gen, bar);
            __builtin_amdgcn_fence(__ATOMIC_ACQUIRE, "agent");
            asm volatile("s_waitcnt vmcnt(0)" ::: "memory");
        }
    }
    __syncthreads();
}

constexpr int SMEM_BYTES = 160 * 1024;
static_assert(DS_END <= SMEM_BYTES - 16, "dsa lds");

__global__ void __launch_bounds__(NT, 2) k_mega(Params p) {
    __shared__ __attribute__((aligned(16))) char smem[SMEM_BYTES];
    volatile LAS unsigned* xbw = (volatile LAS unsigned*)((LAS unsigned char*)smem + (SMEM_BYTES - 16));
    if (threadIdx.x == 0) { xbw[0] = 0u; xbw[1] = 0u; xbw[2] = 0u; xbw[3] = 0u; }
    __syncthreads();
    if (p.ws == nullptr) cg::this_grid().sync();
    (void)xcd_barrier_post((unsigned*)(p.ws + OFF_BAR), xbw);
    for (int rep = 0; rep < PROBE_REP_PREP; ++rep) {
    phase_prep(p, smem);
    xcd_barrier((unsigned*)(p.ws + OFF_BAR), xbw);
    }
#pragma unroll 1
    for (int layer = 0; layer < DEPTH; ++layer) {
        for (int rep = 0; rep < PROBE_REP_PROJ; ++rep) {
        phase_proj(p, layer, smem);
        xcd_barrier((unsigned*)(p.ws + OFF_BAR), xbw);
        }
        phase_rope(p, layer, smem);
        for (int rep = 0; rep < PROBE_REP_GLAA; ++rep) {
        phase_gla_a(p, layer, smem);
        xcd_barrier((unsigned*)(p.ws + OFF_BAR), xbw);
        phase_gla_scan(p, layer, smem);
        xcd_barrier((unsigned*)(p.ws + OFF_BAR), xbw);
        }
        for (int rep = 0; rep < PROBE_REP_GLAC; ++rep) phase_gla_c(p, layer, smem, rep == PROBE_REP_GLAC - 1);
        for (int rep = 0; rep < PROBE_REP_DSA; ++rep) phase_dsa(p, layer, smem, rep == PROBE_REP_DSA - 1);
        xcd_barrier((unsigned*)(p.ws + OFF_BAR), xbw);
        for (int rep = 0; rep < PROBE_REP_OUT; ++rep) {
        phase_outproj(p, layer, smem);
        xcd_barrier((unsigned*)(p.ws + OFF_BAR), xbw);
        }
        for (int rep = 0; rep < PROBE_REP_LN; ++rep) {
        phase_ln(p, layer, smem);
        xcd_barrier((unsigned*)(p.ws + OFF_BAR), xbw);
        }
    }
}

extern "C" void kernel_launch(void* const* d_in, const int* in_sizes, int n_in, void* d_out, int out_size, void* d_ws, size_t ws_size,
                              hipStream_t stream) {
    Params p{};
    p.x = (const float*)d_in[0]; p.meta = (const float*)d_in[1]; p.ln_in_g = (const float*)d_in[2]; p.ln_in_b = (const float*)d_in[3];
    p.w_in = (const float*)d_in[4]; p.wg2 = (const float*)d_in[5]; p.bg = (const float*)d_in[6]; p.norm_g = (const float*)d_in[7];
    p.ikg = (const float*)d_in[8]; p.ikb = (const float*)d_in[9]; p.w_out = (const float*)d_in[10]; p.ln_g = (const float*)d_in[11];
    p.ln_b = (const float*)d_in[12];
    p.out = (float*)d_out; p.ws = (char*)d_ws;
    static int grid_blocks = 0;
    if (!grid_blocks) {
        int dev = 0, cus = 0, per_cu = 0;
        hipGetDevice(&dev);
        hipDeviceGetAttribute(&cus, hipDeviceAttributeMultiprocessorCount, dev);
        hipOccupancyMaxActiveBlocksPerMultiprocessor(&per_cu, k_mega, NT, 0);
        if (per_cu > 1) per_cu = 1;
        grid_blocks = cus * per_cu;
    }
    (void)hipMemsetAsync((char*)d_ws + OFF_BAR, 0, XCD_BAR_WORDS * 4, stream);
    void* args[] = {&p};
    (void)hipLaunchCooperativeKernel((void*)k_mega, dim3(grid_blocks), dim3(NT), args, 0, stream);
}
```

```cpp
#include <hip/hip_runtime.h>
#include <hip/hip_cooperative_groups.h>
#include <stdint.h>
namespace cg = cooperative_groups;
#ifndef PROBE_REP_PREP
#define PROBE_REP_PREP 1
#define PROBE_REP_PROJ 1
#define PROBE_REP_GLAA 1
#define PROBE_REP_GLAC 1
#define PROBE_REP_DSA 1
#define PROBE_REP_OUT 1
#define PROBE_REP_LN 1
#define PROBE_DSA_A 1
#define PROBE_DSA_B 1
#define PROBE_DSA_C 1
#endif

constexpr int D = 1024, NB = 8, SEQ = 2048, NMETA = 16, L = 2064, T = NB * L;
constexpr int DEPTH = 2;
constexpr int INW = 3416, INWP = 3584;
constexpr int TP = 16640;
constexpr int NT = 512;
constexpr int TOPK = 256;
constexpr float LN_EPS = 1e-5f;
constexpr float ALPHA = 1.41421356237309515f;

typedef unsigned short bf16_t;
typedef short bf16x8 __attribute__((ext_vector_type(8)));
typedef float f32x4 __attribute__((ext_vector_type(4)));
#define LAS __attribute__((address_space(3)))

constexpr size_t SZ_H32 = (size_t)T * D * 4;
constexpr size_t SZ_HB = (size_t)TP * D * 2;
constexpr size_t SZ_WIN = (size_t)DEPTH * INWP * D * 2;
constexpr size_t SZ_WOUT = (size_t)DEPTH * D * D * 2;
constexpr int LPV = 2112;
constexpr size_t SZ_GQ = (size_t)T * 256 * 2, SZ_GK = SZ_GQ, SZ_GV = (size_t)NB * 4 * 128 * LPV * 2;
constexpr size_t SZ_UT = (size_t)1024 * 128 * 64 * 4, SZ_ST = (size_t)32 * 33 * 128 * 64 * 2, SZ_DL = (size_t)1024 * 64 * 4;
constexpr size_t SZ_AQ = (size_t)T * 512 * 2, SZ_IQ = (size_t)T * 512 * 2;
constexpr size_t SZ_MIX = (size_t)TP * 1024 * 2;
constexpr int LP = 2112;
constexpr size_t SZ_AK = (size_t)T * 128 * 2, SZ_AV = (size_t)NB * 2 * 64 * LP * 2, SZ_IK = (size_t)T * 64 * 2, SZ_IW = (size_t)T * 8 * 4;
constexpr size_t SZ_GLR = (size_t)T * 16 * 4;
constexpr size_t SZ_ROPE = (size_t)L * 8 * 2 * 4;

constexpr size_t OFF_H32 = 0;
constexpr size_t OFF_HB = OFF_H32 + SZ_H32;
constexpr size_t OFF_WIN = OFF_HB + SZ_HB;
constexpr size_t OFF_WOUT = OFF_WIN + SZ_WIN;
constexpr size_t OFF_GQ = OFF_WOUT + SZ_WOUT;
constexpr size_t OFF_GK = OFF_GQ + SZ_GQ;
constexpr size_t OFF_GV = OFF_GK + SZ_GK;
constexpr size_t OFF_AQ = OFF_GV + SZ_GV;
constexpr size_t OFF_IQ = OFF_AQ + SZ_AQ;
constexpr size_t OFF_MIX = OFF_IQ + SZ_IQ;
constexpr size_t OFF_AK = OFF_MIX + SZ_MIX;
constexpr size_t OFF_AV = OFF_AK + SZ_AK;
constexpr size_t OFF_IK = OFF_AV + SZ_AV;
constexpr size_t OFF_IW = OFF_IK + SZ_IK;
constexpr size_t OFF_GLR = OFF_IW + SZ_IW;
constexpr size_t OFF_ROPE = OFF_GLR + SZ_GLR;
constexpr size_t OFF_ST = OFF_ROPE + SZ_ROPE;
constexpr size_t OFF_DL = OFF_ST + SZ_ST;
constexpr size_t OFF_BAR = OFF_DL + SZ_DL;
constexpr size_t OFF_IKR = OFF_BAR + 16384;
constexpr size_t OFF_END = OFF_IKR + (size_t)T * 64 * 4;
constexpr size_t OFF_UT = OFF_HB;
static_assert(SZ_UT <= SZ_HB, "UT alias");
static_assert(SZ_GQ + SZ_GK + SZ_GV + SZ_AQ + SZ_IQ >= SZ_H32, "Z alias size");
static_assert(OFF_END <= (size_t)256 * 1024 * 1024, "workspace too large");

struct Params {
    const float* x; const float* meta; const float* ln_in_g; const float* ln_in_b;
    const float* w_in; const float* wg2; const float* bg; const float* norm_g;
    const float* ikg; const float* ikb; const float* w_out; const float* ln_g; const float* ln_b;
    float* out; char* ws;
};
typedef const Params __attribute__((address_space(4))) * KParamsPtr;
__device__ __forceinline__ Params kparams() {
    unsigned long long a = (unsigned long long)__builtin_amdgcn_kernarg_segment_ptr();
    asm volatile("" : "+s"(a));
    KParamsPtr q = (KParamsPtr)a;
    Params r;
    r.x = q->x; r.meta = q->meta; r.ln_in_g = q->ln_in_g; r.ln_in_b = q->ln_in_b; r.w_in = q->w_in; r.wg2 = q->wg2; r.bg = q->bg; r.norm_g = q->norm_g;
    r.ikg = q->ikg; r.ikb = q->ikb; r.w_out = q->w_out; r.ln_g = q->ln_g; r.ln_b = q->ln_b; r.out = q->out; r.ws = q->ws;
    return r;
}

__device__ __forceinline__ bf16_t f2bf(float f) {
    unsigned u = __float_as_uint(f);
    u += 0x7FFFu + ((u >> 16) & 1u);
    return (bf16_t)(u >> 16);
}
__device__ __forceinline__ unsigned pack2bf(float lo, float hi) { return (unsigned)f2bf(lo) | ((unsigned)f2bf(hi) << 16); }
__device__ __forceinline__ unsigned cvt_pk_bf16(float lo, float hi) { unsigned r; asm volatile("v_cvt_pk_bf16_f32 %0, %1, %2" : "=v"(r) : "v"(lo), "v"(hi)); return r; }
typedef unsigned u32x4 __attribute__((ext_vector_type(4)));
typedef unsigned u32x2 __attribute__((ext_vector_type(2)));
__device__ __forceinline__ float bf2f(bf16_t h) { return __uint_as_float(((unsigned)h) << 16); }
__device__ __forceinline__ int opaque_tid() { int t = threadIdx.x; asm volatile("" : "+v"(t)); return t; }
__device__ __forceinline__ int opaque_int(int v) { asm volatile("" : "+s"(v)); return v; }
__device__ __forceinline__ int opaque_bid() { int t = blockIdx.x; asm volatile("" : "+s"(t)); return t; }
__device__ __forceinline__ float wave_sum(float v) {
#pragma unroll
    for (int o = 32; o > 0; o >>= 1) v += __shfl_xor(v, o);
    return v;
}
__device__ __forceinline__ float wave_max(float v) {
#pragma unroll
    for (int o = 32; o > 0; o >>= 1) v = fmaxf(v, __shfl_xor(v, o));
    return v;
}
__device__ __forceinline__ float block_sum(float v, float* red) {
    v = wave_sum(v);
    const int tq = opaque_tid();
    __syncthreads();
    if ((tq & 63) == 0) red[tq >> 6] = v;
    __syncthreads();
    return ((red[0] + red[1]) + (red[2] + red[3])) + ((red[4] + red[5]) + (red[6] + red[7]));
}
__device__ __forceinline__ float silu_f(float x) { return x / (1.f + __expf(-x)); }
__device__ __forceinline__ float logsigmoid_f(float x) { return fminf(x, 0.f) - log1pf(expf(-fabsf(x))); }
__device__ __forceinline__ float logsigmoid_fast(float x) { return fminf(x, 0.f) - __logf(1.f + __expf(-fabsf(x))); }

__device__ __forceinline__ int proj_src_col(int n) {
    if (n < 1024) return n;
    if (n < 1536) return n - 1024 + 1040;
    if (n < 2048) return n - 1536 + 1552;
    if (n < 2560) return n - 2048 + 2904;
    if (n < 3072) return n - 2560 + 2320;
    if (n < 3200) return n - 3072 + 2064;
    if (n < 3328) return n - 3200 + 2192;
    const int c = n - 3328;
    if (c < 32) return 2832 + c;
    if (c < 48) return 1024 + (c - 32);
    if (c < 56) return 2896 + (c - 48);
    if (c >= 128 && c < 160) return 2832 + 32 + (c - 128);
    return -1;
}

__device__ __forceinline__ void sincos_acc(float a, float& s, float& c) {
    double ad = (double)a;
    double kd = rint(ad * 0.63661977236758134308);
    double r = fma(-kd, 1.57079632679489655800, ad);
    r = fma(-kd, 6.12323399573676603587e-17, r);
    double r2 = r * r;
    double sp = r * (1.0 + r2 * (-1.0 / 6 + r2 * (1.0 / 120 + r2 * (-1.0 / 5040 + r2 * (1.0 / 362880 + r2 * (-1.0 / 39916800))))));
    double cp = 1.0 + r2 * (-0.5 + r2 * (1.0 / 24 + r2 * (-1.0 / 720 + r2 * (1.0 / 40320 + r2 * (-1.0 / 3628800 + r2 * (1.0 / 479001600))))));
    int q = ((int)kd) & 3;
    double ss = (q & 1) ? cp : sp, cc = (q & 1) ? sp : cp;
    if (q == 1 || q == 2) cc = -cc;
    if (q == 2 || q == 3) ss = -ss;
    s = (float)ss; c = (float)cc;
}

__device__ __forceinline__ void ln_row_wave(f32x4 (&v)[4], const float* g, const float* bb, int lane) {
    float sm = 0.f;
#pragma unroll
    for (int i = 0; i < 4; ++i) sm += (v[i][0] + v[i][1]) + (v[i][2] + v[i][3]);
    const float mu = wave_sum(sm) * (1.f / D);
    float qq = 0.f;
#pragma unroll
    for (int i = 0; i < 4; ++i) { v[i] = v[i] - mu; qq += (v[i][0] * v[i][0] + v[i][1] * v[i][1]) + (v[i][2] * v[i][2] + v[i][3] * v[i][3]); }
    const float rs = rsqrtf(wave_sum(qq) * (1.f / D) + LN_EPS);
#pragma unroll
    for (int i = 0; i < 4; ++i) { const f32x4 gg = *(const f32x4*)(g + 4 * lane + 256 * i), b4 = *(const f32x4*)(bb + 4 * lane + 256 * i); v[i] = v[i] * rs * gg + b4; }
}
__device__ __forceinline__ int proj_dst_col(int src) {
    if (src < 1024) return src;
    if (src < 1040) return 3328 + 32 + (src - 1024);
    if (src < 1552) return 1024 + (src - 1040);
    if (src < 2064) return 1536 + (src - 1552);
    if (src < 2192) return 3072 + (src - 2064);
    if (src < 2320) return 3200 + (src - 2192);
    if (src < 2832) return 2560 + (src - 2320);
    if (src < 2864) return 3328 + (src - 2832);
    if (src < 2896) return 3328 + 128 + (src - 2864);
    if (src < 2904) return 3328 + 48 + (src - 2896);
    return 2048 + (src - 2904);
}
__device__ __forceinline__ void phase_prep(const Params& p_in, char* smem) {
    const Params p = kparams(); (void)p_in;
    const int tid = opaque_tid(), wid = tid >> 6, lane = tid & 63;
    bf16_t* WIN = (bf16_t*)(p.ws + OFF_WIN);
    bf16_t* WOUT = (bf16_t*)(p.ws + OFF_WOUT);
    float* H32 = (float*)(p.ws + OFF_H32);
    bf16_t* HB = (bf16_t*)(p.ws + OFF_HB);
    bf16_t* MIX = (bf16_t*)(p.ws + OFF_MIX);
    float2* ROPE = (float2*)(p.ws + OFF_ROPE);
    float (*tile)[65] = (float (*)[65])smem;
    constexpr int NCT_IN = (INW + 63) / 64, NT_IN = DEPTH * 16 * NCT_IN, NT_OUT = DEPTH * 16 * 16;
    for (int item = opaque_bid(); item < NT_IN + NT_OUT; item += gridDim.x) {
        const bool is_in = item < NT_IN;
        const int it = is_in ? item : item - NT_IN;
        const int nct = is_in ? NCT_IN : 16, ldw = is_in ? INW : D;
        const int l = it / (16 * nct), rem = it - l * 16 * nct, kt = rem / nct, ct = rem - kt * nct;
        const float* W = (is_in ? p.w_in : p.w_out) + (size_t)l * D * ldw;
        __syncthreads();
#pragma unroll
        for (int i = 0; i < 8; ++i) {
            const int e = tid + NT * i, kk = e >> 6, nn = e & 63, col = ct * 64 + nn;
            tile[kk][nn] = (col < ldw) ? W[(size_t)(kt * 64 + kk) * ldw + col] : 0.f;
        }
        __syncthreads();
        {
            const int nn = tid >> 3, k8 = (tid & 7) * 8, src = ct * 64 + nn;
            if (src < ldw) {
                const int dst = is_in ? proj_dst_col(src) : src;
                u32x4 o;
#pragma unroll
                for (int q = 0; q < 4; ++q) o[q] = cvt_pk_bf16(tile[k8 + 2 * q][nn], tile[k8 + 2 * q + 1][nn]);
                bf16_t* dstp = (is_in ? WIN + ((size_t)l * INWP + dst) * D : WOUT + ((size_t)l * D + dst) * D) + kt * 64 + k8;
                *(u32x4*)dstp = o;
            }
        }
    }
    {
        const int nw = gridDim.x * 8;
        for (int t = opaque_bid() * 8 + wid; t < TP; t += nw) {
            if (t < T) {
                const int b = t / L, pos = t - b * L;
                const float* src = (pos < NMETA) ? (p.meta + (size_t)pos * D) : (p.x + ((size_t)b * SEQ + (pos - NMETA)) * D);
                f32x4 v[4];
#pragma unroll
                for (int i = 0; i < 4; ++i) v[i] = *(const f32x4*)(src + 4 * lane + 256 * i);
                ln_row_wave(v, p.ln_in_g, p.ln_in_b, lane);
#pragma unroll
                for (int i = 0; i < 4; ++i) {
                    *(f32x4*)(H32 + (size_t)t * D + 4 * lane + 256 * i) = v[i];
                    u32x2 o; o[0] = cvt_pk_bf16(v[i][0], v[i][1]); o[1] = cvt_pk_bf16(v[i][2], v[i][3]);
                    *(u32x2*)(HB + (size_t)t * D + 4 * lane + 256 * i) = o;
                }
            } else {
#pragma unroll
                for (int i = 0; i < 4; ++i) {
                    *(u32x2*)(HB + (size_t)t * D + 4 * lane + 256 * i) = (u32x2){0u, 0u};
                    *(u32x2*)(MIX + (size_t)t * D + 4 * lane + 256 * i) = (u32x2){0u, 0u};
                }
            }
        }
    }
    for (int e = opaque_bid() * NT + tid; e < L * 8; e += gridDim.x * NT) {
        const int pos = e >> 3, i = e & 7;
        const float inv[8] = {1.0f, 0.19392274f, 0.03760603f, 0.0072926646f, 0.0014142136f, 0.0002742482f, 5.3182957e-05f, 1.0313385e-05f};
        float iv = inv[0];
#pragma unroll
        for (int j = 1; j < 8; ++j) iv = (i == j) ? inv[j] : iv;
        const float ang = (float)pos * iv;
        float sn, cs; sincos_acc(ang, sn, cs);
        ROPE[e] = make_float2(cs, sn);
    }
}

namespace pg8 {
constexpr int BM = 256, BK = 64, HALF = 128, HTB = HALF * BK * 2  , STAGE_BYTES = 8 * HTB, NXCD = 8, WGM = 8;
__device__ __forceinline__ int lds_byte(int r, int c) { const int st = (r >> 4) * 2 + (c >> 5), rr = r & 15, cc = c & 31, ob = rr * 64 + cc * 2; return st * 1024 + (ob ^ (((ob >> 9) & 1) << 5)); }
__device__ __forceinline__ void stage_rc(int b, int& R, int& C) { const int st = b / 1024, sb = b % 1024, swz = sb ^ (((sb >> 9) & 1) << 5); R = (st >> 1) * 16 + swz / 64; C = (st & 1) * 32 + (swz % 64) / 2; }
__device__ __forceinline__ int perm32(int rho) { const int n = rho >> 4, i = rho & 15; return 8 * (i >> 2) + 4 * n + (i & 3); }

struct Unit { int pm, pn; };
struct Gemm { const bf16_t* A; const bf16_t* Bt; int M, N, K; };

struct StaticOrder {
    int nM, nN, nwg, G, c;
    __device__ void init(int M, int N, int G_, int c_) { nM = M / BM; nN = N / BM; nwg = nM * nN; G = G_; c = c_; }
    __device__ bool next(int i, Unit& u) const {
        const long Lx = (long)i * G + c; if (Lx >= nwg) return false;
        int wgid = (int)Lx; { const int q = nwg / NXCD, r = nwg % NXCD, xcd = wgid % NXCD, off = wgid / NXCD; wgid = (xcd < r ? xcd * (q + 1) : r * (q + 1) + (xcd - r) * q) + off; }
        const int nig = WGM * nN, gid = wgid / nig, fm = gid * WGM, gsz = (nM - fm) < WGM ? (nM - fm) : WGM;
        u.pm = fm + ((wgid % nig) % gsz); u.pn = (wgid % nig) / gsz; return true;
    }
    __device__ __forceinline__ void a_ready(const Unit&) const {}
    __device__ __forceinline__ void done(const Unit&) const {}
};

template <class Epi, class Sched>
__device__ __forceinline__ void gemm_phase(LAS unsigned char* lds, const Gemm g, const Sched& S, const Epi& E) {
    const int tid = opaque_tid(), wid = __builtin_amdgcn_readfirstlane(tid >> 6), lane = tid & 63, wr = wid >> 2, wc = wid & 3, fr = lane & 15, fq = lane >> 4;
    const int K = g.K, nt = K / BK;
    unsigned voffA[2], voffB[2];
#pragma unroll
    for (int i = 0; i < 2; ++i) { int R, C; stage_rc(tid * 16 + i * 8192, R, C); const int Rb = Epi::PERM ? ((R & ~31) + perm32(R & 31)) : R;
        voffA[i] = (unsigned)(R * K + C) * 2u; voffB[i] = (unsigned)(Rb * K + C) * 2u; }
    const size_t kstep = (size_t)(BK * 2);
    const size_t hstep = (size_t)HALF * K * 2;
    const size_t tstep = 2 * hstep;
    const unsigned ldsw = (unsigned)wid * 1024u;
    const int aoff = lds_byte(wr * 64 + fr, fq * 8), boff = lds_byte(wc * 32 + fr, fq * 8);
#define PG8_SA(b, h) (((b) * 2 + (h)) * HTB)
#define PG8_SB(b, h) ((4 + (b) * 2 + (h)) * HTB)
#define PG8_STAGE(bufoff, gbase, voff) do { _Pragma("unroll") for (int _i = 0; _i < 2; ++_i) \
        __builtin_amdgcn_global_load_lds((const unsigned*)((const char*)(gbase) + (voff)[_i]), (LAS unsigned*)(lds + (bufoff) + ldsw + _i * 8192), 16, 0, 0); } while (0)
#define PG8_LDA(dst, b, h) do { _Pragma("unroll") for (int m = 0; m < 4; ++m) _Pragma("unroll") for (int k = 0; k < 2; ++k) dst[m][k] = *(const LAS bf16x8*)(lds + PG8_SA(b, h) + aoff + m * 2048 + k * 1024); } while (0)
#define PG8_LDB(dst, b, h) do { _Pragma("unroll") for (int n = 0; n < 2; ++n) _Pragma("unroll") for (int k = 0; k < 2; ++k) dst[n][k] = *(const LAS bf16x8*)(lds + PG8_SB(b, h) + boff + n * 2048 + k * 1024); } while (0)
#define PG8_MMA(ai, bj, At, Bt) do { __builtin_amdgcn_s_setprio(1); _Pragma("unroll") for (int m = 0; m < 4; ++m) _Pragma("unroll") for (int n = 0; n < 2; ++n) _Pragma("unroll") for (int k = 0; k < 2; ++k) \
        acc[ai][bj][m][n] = __builtin_amdgcn_mfma_f32_16x16x32_bf16(Bt[n][k], At[m][k], acc[ai][bj][m][n], 0, 0, 0); __builtin_amdgcn_s_setprio(0); } while (0)
#define PG8_WAIT_V(n) asm volatile("s_waitcnt vmcnt(" #n ")" ::: "memory")
#define PG8_WAIT_L(n) asm volatile("s_waitcnt lgkmcnt(" #n ")" ::: "memory")
#define PG8_BAR __builtin_amdgcn_s_barrier()
#define PG8_SCHED __builtin_amdgcn_sched_barrier(0)
    Unit cur, nxt; int ui = 0;
    if (!S.next(0, cur)) return;
    f32x4 acc[2][2][4][2];
#pragma unroll
    for (int a = 0; a < 2; ++a)
#pragma unroll
        for (int b = 0; b < 2; ++b)
#pragma unroll
            for (int m = 0; m < 4; ++m)
#pragma unroll
                for (int n = 0; n < 2; ++n) acc[a][b][m][n] = (f32x4){0.f, 0.f, 0.f, 0.f};
    bf16x8 At[4][2], B0[2][2], B1[2][2];
    const char* cA = (const char*)g.A + (size_t)cur.pm * tstep; const char* cB = (const char*)g.Bt + (size_t)cur.pn * tstep;
    S.a_ready(cur);
    PG8_STAGE(PG8_SB(0, 0), cB, voffB); PG8_STAGE(PG8_SA(0, 0), cA, voffA); PG8_STAGE(PG8_SB(0, 1), cB + hstep, voffB); PG8_STAGE(PG8_SA(0, 1), cA + hstep, voffA);
    if (wr == 1) PG8_BAR;
    PG8_WAIT_V(4); PG8_BAR;
    PG8_STAGE(PG8_SB(1, 0), cB + kstep, voffB); PG8_STAGE(PG8_SA(1, 0), cA + kstep, voffA); PG8_STAGE(PG8_SB(1, 1), cB + hstep + kstep, voffB);
    PG8_WAIT_V(6); PG8_BAR;
    for (;;) {
        const bool has_next = S.next(ui + 1, nxt);
        const char* nA = has_next ? (const char*)g.A + (size_t)nxt.pm * tstep : cA; const char* nB = has_next ? (const char*)g.Bt + (size_t)nxt.pn * tstep : cB;
        for (int t = 0; t < nt; t += 2) {
            const bool last = (t == nt - 2);
            const char* a1 = cA + (size_t)(t + 1) * kstep;
            const char* a2 = last ? nA : cA + (size_t)(t + 2) * kstep; const char* b2 = last ? nB : cB + (size_t)(t + 2) * kstep;
            const char* a3 = a2 + kstep; const char* b3 = b2 + kstep;
            if (last && has_next) S.a_ready(nxt);
            PG8_LDB(B0, 0, 0); PG8_SCHED; PG8_LDA(At, 0, 0); PG8_STAGE(PG8_SA(1, 1), a1 + hstep, voffA);
            PG8_WAIT_L(8); PG8_BAR; PG8_WAIT_L(0); PG8_MMA(0, 0, At, B0); PG8_BAR; PG8_SCHED;
            PG8_LDB(B1, 0, 1); PG8_STAGE(PG8_SB(0, 0), b2, voffB);
            PG8_BAR; PG8_WAIT_L(0); PG8_MMA(0, 1, At, B1); PG8_BAR;
            PG8_LDA(At, 0, 1); PG8_STAGE(PG8_SA(0, 0), a2, voffA);
            PG8_BAR; PG8_WAIT_L(0); PG8_MMA(1, 0, At, B0); PG8_BAR; PG8_SCHED;
            PG8_STAGE(PG8_SB(0, 1), b2 + hstep, voffB);
            PG8_WAIT_V(6); PG8_BAR; PG8_MMA(1, 1, At, B1); PG8_BAR;
            PG8_LDB(B0, 1, 0); PG8_SCHED; PG8_LDA(At, 1, 0); PG8_STAGE(PG8_SA(0, 1), a2 + hstep, voffA);
            PG8_WAIT_L(8); PG8_BAR; PG8_WAIT_L(0); PG8_MMA(0, 0, At, B0); PG8_BAR; PG8_SCHED;
            PG8_LDB(B1, 1, 1); PG8_STAGE(PG8_SB(1, 0), b3, voffB);
            PG8_BAR; PG8_WAIT_L(0); PG8_MMA(0, 1, At, B1); PG8_BAR;
            PG8_LDA(At, 1, 1); PG8_STAGE(PG8_SA(1, 0), a3, voffA);
            PG8_BAR; PG8_WAIT_L(0); PG8_MMA(1, 0, At, B0); PG8_BAR; PG8_SCHED;
            PG8_STAGE(PG8_SB(1, 1), b3 + hstep, voffB);
            PG8_WAIT_V(6); PG8_BAR; PG8_MMA(1, 1, At, B1); PG8_BAR;
        }
        E(acc, cur, wr, wc, fr, fq); S.done(cur);
        if (!has_next) break;
#pragma unroll
        for (int a = 0; a < 2; ++a)
#pragma unroll
            for (int b = 0; b < 2; ++b)
#pragma unroll
                for (int m = 0; m < 4; ++m)
#pragma unroll
                    for (int n = 0; n < 2; ++n) acc[a][b][m][n] = (f32x4){0.f, 0.f, 0.f, 0.f};
        cur = nxt; cA = nA; cB = nB; ++ui;
    }
    PG8_WAIT_V(0);
    if (wr == 0) PG8_BAR;
    PG8_BAR;
#undef PG8_SA
#undef PG8_SB
#undef PG8_STAGE
#undef PG8_LDA
#undef PG8_LDB
#undef PG8_MMA
#undef PG8_WAIT_V
#undef PG8_WAIT_L
#undef PG8_BAR
#undef PG8_SCHED
}
}

struct EpiProj {
    static constexpr bool PERM = true;
    char* ws;
    __device__ __forceinline__ void store8(bf16_t* dst, const f32x4& a, const f32x4& b, float sc) const {
        u32x4 o; o[0] = cvt_pk_bf16(a[0] * sc, a[1] * sc); o[1] = cvt_pk_bf16(a[2] * sc, a[3] * sc); o[2] = cvt_pk_bf16(b[0] * sc, b[1] * sc); o[3] = cvt_pk_bf16(b[2] * sc, b[3] * sc);
        *(u32x4*)dst = o;
    }
    __device__ __forceinline__ void operator()(const f32x4 (&acc)[2][2][4][2], const pg8::Unit& u, int wr, int wc, int fr, int fq) const {
        asm volatile("" : "+v"(fr), "+v"(fq));
        if (u.pn < 13) {
#pragma unroll
            for (int bj = 0; bj < 2; ++bj) {
                const int hb = 4 * u.pn + 2 * bj + (wc >> 1);
                const int cc8 = 32 * (wc & 1) + 8 * fq;
#pragma unroll
                for (int ai = 0; ai < 2; ++ai)
#pragma unroll
                    for (int m = 0; m < 4; ++m) {
                        const int t = 256 * u.pm + 128 * ai + 64 * wr + 16 * m + fr;
                        const f32x4 v0 = acc[ai][bj][m][0], v1 = acc[ai][bj][m][1];
                        if (t < T) {
                            const size_t tt = (size_t)t;
                            if (hb < 4) store8((bf16_t*)(ws + OFF_GQ) + tt * 256 + hb * 64 + cc8, v0, v1, 0.125f);
                            else if (hb < 8) store8((bf16_t*)(ws + OFF_GK) + tt * 256 + (hb - 4) * 64 + cc8, v0, v1, 1.f);
                            else if (hb < 16) {
                                const int bq = t / L, pos = t - bq * L;
                                bf16_t* dst = (bf16_t*)(ws + OFF_GV) + ((size_t)(bq * 4 + ((hb - 8) >> 1)) * 128 + ((hb - 8) & 1) * 64 + cc8) * LPV + 48 + pos;
#pragma unroll
                                for (int j = 0; j < 4; ++j) { dst[(size_t)j * LPV] = f2bf(v0[j]); dst[(size_t)(4 + j) * LPV] = f2bf(v1[j]); }
                            }
                            else if (hb < 24 || (hb >= 32 && hb < 40)) {
                                f32x4 s0, s1;
#pragma unroll
                                for (int j = 0; j < 4; ++j) { s0[j] = silu_f(v0[j]); s1[j] = silu_f(v1[j]); }
                                const int col = (hb < 24) ? (hb - 16) * 64 : 512 + (hb - 32) * 64;
                                store8((bf16_t*)(ws + OFF_MIX) + tt * 1024 + col + cc8, s0, s1, 1.f);
                            }
                            else if (hb < 32) store8((bf16_t*)(ws + OFF_AQ) + tt * 512 + (hb - 24) * 64 + cc8, v0, v1, 0.125f);
                            else if (hb < 48) store8((bf16_t*)(ws + OFF_IQ) + tt * 512 + (hb - 40) * 64 + cc8, v0, v1, 0.125f);
                            else if (hb < 50) store8((bf16_t*)(ws + OFF_AK) + tt * 128 + (hb - 48) * 64 + cc8, v0, v1, 1.f);
                            else {
                                const int bq = t / L, pos = t - bq * L;
                                bf16_t* dst = (bf16_t*)(ws + OFF_AV) + ((size_t)(bq * 2 + (hb - 50)) * 64 + cc8) * LP + pos;
#pragma unroll
                                for (int j = 0; j < 4; ++j) { dst[(size_t)j * LP] = f2bf(v0[j]); dst[(size_t)(4 + j) * LP] = f2bf(v1[j]); }
                            }
                        }
                        asm volatile("" ::: "memory");
                    }
            }
        } else {
#pragma unroll
            for (int ai = 0; ai < 2; ++ai)
#pragma unroll
                for (int m = 0; m < 4; ++m) {
                    const int t = 256 * u.pm + 128 * ai + 64 * wr + 16 * m + fr;
                    if (t < T) {
                        if (wc == 0) {
                            float* dst = (float*)(ws + OFF_IKR) + (size_t)t * 64 + 8 * fq;
                            *(f32x4*)dst = acc[ai][0][m][0]; *(f32x4*)(dst + 4) = acc[ai][0][m][1];
                            *(f32x4*)(dst + 32) = acc[ai][1][m][0]; *(f32x4*)(dst + 36) = acc[ai][1][m][1];
                        } else if (wc == 1) {
                            const f32x4 v0 = acc[ai][0][m][0], v1 = acc[ai][0][m][1];
                            if (fq < 2) {
                                float* dst = (float*)(ws + OFF_GLR) + (size_t)t * 16 + 8 * fq;
                                *(f32x4*)dst = v0; *(f32x4*)(dst + 4) = v1;
                            } else if (fq == 2) {
                                float* dst = (float*)(ws + OFF_IW) + (size_t)t * 8;
                                *(f32x4*)dst = v0 * 0.353553390593273762f; *(f32x4*)(dst + 4) = v1 * 0.353553390593273762f;
                            }
                        }
                    }
                    asm volatile("" ::: "memory");
                }
        }
    }
};

struct EpiOut {
    static constexpr bool PERM = false;
    const float* H32; float* Z;
    __device__ __forceinline__ void operator()(const f32x4 (&acc)[2][2][4][2], const pg8::Unit& u, int wr, int wc, int fr, int fq) const {
        asm volatile("" : "+v"(fr), "+v"(fq));
        const int col0 = u.pn * 256 + wc * 32 + 4 * fq;
#pragma unroll
        for (int ai = 0; ai < 2; ++ai) {
            f32x4 hv[4][2][2];
#pragma unroll
            for (int m = 0; m < 4; ++m) {
                int t = 256 * u.pm + 128 * ai + 64 * wr + 16 * m + fr; t = t < T ? t : T - 1;
                const size_t off = (size_t)t * D + col0;
#pragma unroll
                for (int bj = 0; bj < 2; ++bj)
#pragma unroll
                    for (int n = 0; n < 2; ++n) hv[m][bj][n] = *(const f32x4*)(H32 + off + bj * 128 + n * 16);
            }
#pragma unroll
            for (int m = 0; m < 4; ++m) {
                const int t = 256 * u.pm + 128 * ai + 64 * wr + 16 * m + fr;
                if (t < T) {
                    const size_t off = (size_t)t * D + col0;
#pragma unroll
                    for (int bj = 0; bj < 2; ++bj)
#pragma unroll
                        for (int n = 0; n < 2; ++n) *(f32x4*)(Z + off + bj * 128 + n * 16) = acc[ai][bj][m][n] + hv[m][bj][n] * ALPHA;
                }
            }
            asm volatile("" ::: "memory");
        }
    }
};

__device__ __forceinline__ void phase_proj(const Params& p_in, int layer_in, char* smem) {
    const Params p = kparams(); const int layer = opaque_int(layer_in); (void)p_in;
    pg8::Gemm g; g.A = (const bf16_t*)(p.ws + OFF_HB); g.Bt = (const bf16_t*)(p.ws + OFF_WIN) + (size_t)layer * INWP * D; g.M = TP; g.N = INWP; g.K = D;
    pg8::StaticOrder S; S.init(TP, INWP, gridDim.x, opaque_bid());
    EpiProj E; E.ws = p.ws;
    pg8::gemm_phase((LAS unsigned char*)smem, g, S, E);
}
__device__ __forceinline__ void phase_outproj(const Params& p_in, int layer_in, char* smem) {
    const Params p = kparams(); const int layer = opaque_int(layer_in); (void)p_in;
    pg8::Gemm g; g.A = (const bf16_t*)(p.ws + OFF_MIX); g.Bt = (const bf16_t*)(p.ws + OFF_WOUT) + (size_t)layer * D * D; g.M = TP; g.N = D; g.K = D;
    pg8::StaticOrder S; S.init(TP, D, gridDim.x, opaque_bid());
    EpiOut E; E.H32 = (const float*)(p.ws + OFF_H32); E.Z = (float*)(p.ws + OFF_GQ);
    pg8::gemm_phase((LAS unsigned char*)smem, g, S, E);
}

__device__ __forceinline__ void phase_gla_naive(const Params& p, int layer, char* smem) {
    float (*qs)[64] = (float (*)[64])smem;
    float (*ks)[64] = qs + 8;
    float (*es)[64] = ks + 8;
    float (*part)[8] = (float (*)[8])(es + 8);
    float (*os)[128] = (float (*)[128])(part + 2);
    const int tid = opaque_tid();
    const bf16_t* GQ = (const bf16_t*)(p.ws + OFF_GQ);
    const bf16_t* GK = (const bf16_t*)(p.ws + OFF_GK);
    const bf16_t* GV = (const bf16_t*)(p.ws + OFF_GV);
    const float* GLR = (const float*)(p.ws + OFF_GLR);
    bf16_t* MIX = (bf16_t*)(p.ws + OFF_MIX);
    const float* ng = p.norm_g + layer * 128;
    const float* wg2 = p.wg2 + (size_t)layer * 16 * 256; const float* bg = p.bg + layer * 256;
    for (int item = opaque_bid(); item < NB * 4; item += gridDim.x) {
        const int b = item >> 2, h = item & 3;
        float S[64];
#pragma unroll
        for (int d = 0; d < 64; ++d) S[d] = 0.f;
        const int e = tid & 127;
        const float nge = ng[e];
        const int ltt = tid >> 6, ld = tid & 63;
        float w[16];
#pragma unroll
        for (int rr = 0; rr < 16; ++rr) w[rr] = wg2[rr * 256 + h * 64 + ld];
        const float bgd = bg[h * 64 + ld];
        for (int t0 = 0; t0 < L; t0 += 8) {
            __syncthreads();
            {
                const size_t row = (size_t)b * L + t0 + ltt;
                qs[ltt][ld] = bf2f(GQ[row * 256 + h * 64 + ld]);
                ks[ltt][ld] = bf2f(GK[row * 256 + h * 64 + ld]);
                const float4* gp = (const float4*)&GLR[row * 16];
                const float4 g0 = gp[0], g1 = gp[1], g2 = gp[2], g3 = gp[3];
                float s = bgd;
                s = fmaf(g0.x, w[0], s); s = fmaf(g0.y, w[1], s); s = fmaf(g0.z, w[2], s); s = fmaf(g0.w, w[3], s);
                s = fmaf(g1.x, w[4], s); s = fmaf(g1.y, w[5], s); s = fmaf(g1.z, w[6], s); s = fmaf(g1.w, w[7], s);
                s = fmaf(g2.x, w[8], s); s = fmaf(g2.y, w[9], s); s = fmaf(g2.z, w[10], s); s = fmaf(g2.w, w[11], s);
                s = fmaf(g3.x, w[12], s); s = fmaf(g3.y, w[13], s); s = fmaf(g3.z, w[14], s); s = fmaf(g3.w, w[15], s);
                es[ltt][ld] = expf(logsigmoid_f(s) * (1.f / 16.f));
            }
            __syncthreads();
            if (tid < 128) {
#pragma unroll 1
                for (int tt = 0; tt < 8; ++tt) {
                    const size_t row = (size_t)b * L + t0 + tt;
                    const float v = bf2f(GV[row * 512 + h * 128 + e]);
                    float acc = 0.f;
#pragma unroll
                    for (int d = 0; d < 64; ++d) {
                        S[d] = fmaf(es[tt][d], S[d], ks[tt][d] * v);
                        acc = fmaf(qs[tt][d], S[d], acc);
                    }
                    os[tt][e] = acc;
                    const float ss = wave_sum(acc * acc);
                    if ((tid & 63) == 0) part[tid >> 6][tt] = ss;
                }
            }
            __syncthreads();
            if (tid < 128) {
#pragma unroll 1
                for (int tt = 0; tt < 8; ++tt) {
                    const size_t row = (size_t)b * L + t0 + tt;
                    const float tot = part[0][tt] + part[1][tt];
                    const float rinv = rsqrtf(tot * (1.f / 128) + LN_EPS);
                    const size_t idx = row * 1024 + h * 128 + e;
                    MIX[idx] = f2bf(os[tt][e] * rinv * nge * bf2f(MIX[idx]));
                }
            }
        }
    }
}

__device__ __forceinline__ unsigned okey(float x) {
    const unsigned u = __float_as_uint(x);
    return (u & 0x80000000u) ? ~u : (u | 0x80000000u);
}
__device__ __forceinline__ int wave_incl_scan(int v) {
    const int lane = opaque_tid() & 63;
#pragma unroll
    for (int o = 1; o < 64; o <<= 1) { const int n = __shfl_up(v, o); if (lane >= o) v += n; }
    return v;
}
__device__ __forceinline__ int block_excl_scan(int v, int* tmp) {
    const int incl = wave_incl_scan(v);
    const int tq = opaque_tid();
    __syncthreads();
    if ((tq & 63) == 63) tmp[tq >> 6] = incl;
    __syncthreads();
    const int w = tq >> 6;
    int base = 0;
    for (int i = 0; i < w; ++i) base += tmp[i];
    return base + incl - v;
}
__device__ __forceinline__ void unpack8(const uint4 u, float* kf) {
    kf[0] = __uint_as_float(u.x << 16); kf[1] = __uint_as_float(u.x & 0xFFFF0000u);
    kf[2] = __uint_as_float(u.y << 16); kf[3] = __uint_as_float(u.y & 0xFFFF0000u);
    kf[4] = __uint_as_float(u.z << 16); kf[5] = __uint_as_float(u.z & 0xFFFF0000u);
    kf[6] = __uint_as_float(u.w << 16); kf[7] = __uint_as_float(u.w & 0xFFFF0000u);
}

__device__ __forceinline__ void phase_dsa_naive(const Params& p, int layer, char* smem) {
    float* sc = (float*)smem;
    float (*iqs)[64] = (float (*)[64])(sc + 2080);
    float (*aqs)[64] = iqs + 8;
    float (*lg)[256] = (float (*)[256])(aqs + 8);
    unsigned* hist = (unsigned*)(lg + 8);
    int* sel = (int*)(hist + 256);
    int* misc = sel + 256;
    const int tid = opaque_tid();
    const bf16_t* IQ = (const bf16_t*)(p.ws + OFF_IQ);
    const bf16_t* IK = (const bf16_t*)(p.ws + OFF_IK);
    const float* IW = (const float*)(p.ws + OFF_IW);
    const bf16_t* AQ = (const bf16_t*)(p.ws + OFF_AQ);
    const bf16_t* AK = (const bf16_t*)(p.ws + OFF_AK);
    const bf16_t* AV = (const bf16_t*)(p.ws + OFF_AV);
    bf16_t* MIX = (bf16_t*)(p.ws + OFF_MIX);
    for (int item = opaque_bid(); item < T; item += gridDim.x) {
        const int b = item / L, t = item % L;
        const size_t row = (size_t)item;
        __syncthreads();
        iqs[tid >> 6][tid & 63] = bf2f(IQ[row * 512 + tid]); aqs[tid >> 6][tid & 63] = bf2f(AQ[row * 512 + tid]);
        __syncthreads();
        float w[8];
#pragma unroll
        for (int j = 0; j < 8; ++j) w[j] = IW[row * 8 + j];
        for (int s = tid; s <= t; s += NT) {
            const uint4* kp = (const uint4*)&IK[((size_t)b * L + s) * 64];
            float dd[8];
#pragma unroll
            for (int j = 0; j < 8; ++j) dd[j] = 0.f;
#pragma unroll 1
            for (int q = 0; q < 8; ++q) {
                float kf[8]; unpack8(kp[q], kf);
#pragma unroll
                for (int j = 0; j < 8; ++j) {
                    const float4 a0 = *(const float4*)&iqs[j][q * 8], a1 = *(const float4*)&iqs[j][q * 8 + 4];
                    dd[j] = fmaf(a0.x, kf[0], dd[j]); dd[j] = fmaf(a0.y, kf[1], dd[j]); dd[j] = fmaf(a0.z, kf[2], dd[j]); dd[j] = fmaf(a0.w, kf[3], dd[j]);
                    dd[j] = fmaf(a1.x, kf[4], dd[j]); dd[j] = fmaf(a1.y, kf[5], dd[j]); dd[j] = fmaf(a1.z, kf[6], dd[j]); dd[j] = fmaf(a1.w, kf[7], dd[j]);
                }
            }
            float score = 0.f;
#pragma unroll
            for (int j = 0; j < 8; ++j) score = fmaf(w[j], fmaxf(dd[j], 0.f), score);
            sc[s] = score;
        }
        __syncthreads();
        const int n = t + 1;
        int nsel;
        if (n <= TOPK) {
            if (tid < n) sel[tid] = tid;
            nsel = n;
        } else {
            unsigned prefix = 0; int remaining = TOPK;
            for (int pass = 0; pass < 4; ++pass) {
                const int shift = 24 - 8 * pass;
                if (tid < 256) hist[tid] = 0;
                __syncthreads();
                for (int s = tid; s < n; s += NT) {
                    const unsigned key = okey(sc[s]);
                    const bool match = (pass == 0) || ((key >> (shift + 8)) == prefix);
                    if (match) atomicAdd(&hist[(key >> shift) & 255u], 1u);
                }
                __syncthreads();
                if (tid == 0) {
                    int cum = 0, d = 255;
                    for (; d > 0; --d) { const int c = (int)hist[d]; if (cum + c >= remaining) break; cum += c; }
                    misc[0] = d; misc[1] = remaining - cum;
                }
                __syncthreads();
                prefix = (prefix << 8) | (unsigned)misc[0]; remaining = misc[1];
                __syncthreads();
            }
            const int s0 = tid * 5;
            int ceq = 0;
#pragma unroll
            for (int q = 0; q < 5; ++q) { const int s = s0 + q; if (s < n && okey(sc[s]) == prefix) ++ceq; }
            int eqrank = block_excl_scan(ceq, misc + 8);
            int csel = 0; unsigned selmask = 0;
#pragma unroll
            for (int q = 0; q < 5; ++q) {
                const int s = s0 + q;
                if (s < n) {
                    const unsigned key = okey(sc[s]);
                    bool take = key > prefix;
                    if (key == prefix) { take = eqrank < remaining; ++eqrank; }
                    if (take) { ++csel; selmask |= 1u << q; }
                }
            }
            int posn = block_excl_scan(csel, misc + 16);
#pragma unroll
            for (int q = 0; q < 5; ++q) if (selmask & (1u << q)) { if (posn < TOPK) sel[posn] = s0 + q; ++posn; }
            nsel = TOPK;
        }
        __syncthreads();
        {
            const int i = tid & 255, g = tid >> 8;
            if (i < nsel) {
                const int kidx = sel[i];
                const uint4* kp = (const uint4*)&AK[((size_t)b * L + kidx) * 128 + g * 64];
                float dd[4] = {0.f, 0.f, 0.f, 0.f};
#pragma unroll 1
                for (int q = 0; q < 8; ++q) {
                    float kf[8]; unpack8(kp[q], kf);
#pragma unroll
                    for (int r = 0; r < 4; ++r) {
                        const float4 a0 = *(const float4*)&aqs[g * 4 + r][q * 8], a1 = *(const float4*)&aqs[g * 4 + r][q * 8 + 4];
                        dd[r] = fmaf(a0.x, kf[0], dd[r]); dd[r] = fmaf(a0.y, kf[1], dd[r]); dd[r] = fmaf(a0.z, kf[2], dd[r]); dd[r] = fmaf(a0.w, kf[3], dd[r]);
                        dd[r] = fmaf(a1.x, kf[4], dd[r]); dd[r] = fmaf(a1.y, kf[5], dd[r]); dd[r] = fmaf(a1.z, kf[6], dd[r]); dd[r] = fmaf(a1.w, kf[7], dd[r]);
                    }
                }
#pragma unroll
                for (int r = 0; r < 4; ++r) lg[g * 4 + r][i] = dd[r];
            } else {
#pragma unroll
                for (int r = 0; r < 4; ++r) lg[g * 4 + r][i] = -INFINITY;
            }
        }
        __syncthreads();
        {
            const int h = tid >> 6, lane = tid & 63;
            float v0 = lg[h][lane], v1 = lg[h][lane + 64], v2 = lg[h][lane + 128], v3 = lg[h][lane + 192];
            const float m = wave_max(fmaxf(fmaxf(v0, v1), fmaxf(v2, v3)));
            v0 = expf(v0 - m); v1 = expf(v1 - m); v2 = expf(v2 - m); v3 = expf(v3 - m);
            const float inv = 1.f / wave_sum(v0 + v1 + v2 + v3);
            lg[h][lane] = v0 * inv; lg[h][lane + 64] = v1 * inv; lg[h][lane + 128] = v2 * inv; lg[h][lane + 192] = v3 * inv;
        }
        __syncthreads();
        {
            const int h = tid >> 6, d = tid & 63, g = h >> 2;
            float o = 0.f;
            for (int i = 0; i < nsel; ++i) o = fmaf(lg[h][i], bf2f(AV[((size_t)b * L + sel[i]) * 128 + g * 64 + d]), o);
            const size_t mi = row * 1024 + 512 + tid;
            MIX[mi] = f2bf(o * bf2f(MIX[mi]));
        }
    }
}


constexpr int DS_SC = 0, DS_BITS = 132096, DS_HIST = DS_BITS + 4224, DS_END = DS_HIST + 8 * 1040;
constexpr int DS_MB = 3 * 32768, DS_MBROW = 2112;
static_assert(DS_MB + 16 * DS_MBROW <= DS_BITS, "mask bytes overlap");

__device__ __forceinline__ void phase_dsa(const Params& p_in, int layer_in, char* smem, bool do_store) {
    const Params p = kparams(); const int layer = opaque_int(layer_in); (void)p_in;
    const int tid = opaque_tid(), wid = __builtin_amdgcn_readfirstlane(tid >> 6), lane = tid & 63, fr = lane & 15, fq = lane >> 4;
    LAS unsigned char* lds = (LAS unsigned char*)smem;
    const bf16_t* IQ = (const bf16_t*)(p.ws + OFF_IQ);
    const bf16_t* IK = (const bf16_t*)(p.ws + OFF_IK);
    const float* IW = (const float*)(p.ws + OFF_IW);
    const bf16_t* AQ = (const bf16_t*)(p.ws + OFF_AQ);
    const bf16_t* AK = (const bf16_t*)(p.ws + OFF_AK);
    const bf16_t* AVT = (const bf16_t*)(p.ws + OFF_AV);
    bf16_t* MIX = (bf16_t*)(p.ws + OFF_MIX);
    constexpr int NITEM = NB * 129;
    for (int idx = opaque_bid(); idx < NITEM; idx += gridDim.x) {
        const int b = idx & 7, mm = idx >> 3;
        int qr;
        { const int seg = mm >> 5, jj = mm & 31; qr = (seg == 0) ? jj : (seg == 1) ? 63 - jj : (seg == 2) ? 64 + jj : (seg == 3) ? 127 - jj : 128; }
        const int qt = 128 - qr, t0 = qt * 16;
        const size_t rowq = (size_t)b * L + t0 + fr;
        __syncthreads();
        for (int repA = 0; repA < PROBE_DSA_A; ++repA) {
            bf16x8 qf[8][2];
#pragma unroll
            for (int jh = 0; jh < 8; ++jh)
#pragma unroll
                for (int s2 = 0; s2 < 2; ++s2) qf[jh][s2] = *(const bf16x8*)(IQ + rowq * 512 + jh * 64 + s2 * 32 + fq * 8);
            float w[8];
            { const f32x4 w0 = *(const f32x4*)(IW + rowq * 8), w1 = *(const f32x4*)(IW + rowq * 8 + 4);
              w[0] = w0[0]; w[1] = w0[1]; w[2] = w0[2]; w[3] = w0[3]; w[4] = w1[0]; w[5] = w1[1]; w[6] = w1[2]; w[7] = w1[3]; }
            const int ntile = qt + 1;
            const bf16x8 z8 = {0, 0, 0, 0, 0, 0, 0, 0};
            bf16x8 ka0 = z8, ka1 = z8, kb0 = z8, kb1 = z8, kc0 = z8, kc1 = z8;
            int kt = wid;
            if (kt < ntile) { const bf16_t* kp = IK + ((size_t)b * L + 16 * kt + fr) * 64 + fq * 8; ka0 = *(const bf16x8*)kp; ka1 = *(const bf16x8*)(kp + 32); }
            if (kt + 8 < ntile) { const bf16_t* kp = IK + ((size_t)b * L + 16 * (kt + 8) + fr) * 64 + fq * 8; kb0 = *(const bf16x8*)kp; kb1 = *(const bf16x8*)(kp + 32); }
            for (; kt < ntile; kt += 8) {
                if (kt + 16 < ntile) { const bf16_t* kp = IK + ((size_t)b * L + 16 * (kt + 16) + fr) * 64 + fq * 8; kc0 = *(const bf16x8*)kp; kc1 = *(const bf16x8*)(kp + 32); }
                f32x4 sc = {0.f, 0.f, 0.f, 0.f};
#pragma unroll
                for (int jh = 0; jh < 8; ++jh) {
                    f32x4 d = {0.f, 0.f, 0.f, 0.f};
                    d = __builtin_amdgcn_mfma_f32_16x16x32_bf16(ka0, qf[jh][0], d, 0, 0, 0);
                    d = __builtin_amdgcn_mfma_f32_16x16x32_bf16(ka1, qf[jh][1], d, 0, 0, 0);
#pragma unroll
                    for (int r = 0; r < 4; ++r) sc[r] = fmaf(w[jh], fmaxf(d[r], 0.f), sc[r]);
                }
                u32x4 ko;
#pragma unroll
                for (int r = 0; r < 4; ++r) ko[r] = okey(sc[r]);
                *(LAS u32x4*)(lds + DS_SC + (fr * 2064 + 16 * kt + 4 * fq) * 4) = ko;
                ka0 = kb0; ka1 = kb1; kb0 = kc0; kb1 = kc1;
            }
        }
        __syncthreads();
        for (int repB = 0; repB < PROBE_DSA_B; ++repB) {
            LAS unsigned* hist = (LAS unsigned*)(lds + DS_HIST + wid * 1040);
#pragma unroll 1
            for (int qq = 0; qq < 2; ++qq) {
                const int q = wid * 2 + qq;
                const int n = t0 + q + 1;
                const LAS unsigned* row = (const LAS unsigned*)(lds + DS_SC) + q * 2064;
                LAS unsigned* bits = (LAS unsigned*)(lds + DS_BITS) + q * 66;
                if (n <= TOPK) {
#pragma unroll 1
                    for (int i = 0; i < 33; ++i) {
                        const unsigned long long sm = __ballot(lane + 64 * i < n);
                        if (lane == 0) { bits[2 * i] = (unsigned)sm; bits[2 * i + 1] = (unsigned)(sm >> 32); }
                    }
                } else {
                    unsigned kreg[33];
#pragma unroll
                    for (int i = 0; i < 33; ++i) { kreg[i] = 0u; if (64 * i < n) kreg[i] = (lane < n - 64 * i) ? row[lane + 64 * i] : 0u; }
                    unsigned prefix = 0; int remaining = TOPK;
#pragma unroll 1
                    for (int pass = 0; pass < 4; ++pass) {
                        const int shift = 24 - 8 * pass;
                        *(LAS u32x4*)(hist + lane * 4) = (u32x4){0u, 0u, 0u, 0u};
                        __builtin_amdgcn_wave_barrier(); asm volatile("" ::: "memory");
                        if (pass == 0) {
#pragma unroll
                            for (int i = 0; i < 33; ++i)
                                if (64 * i < n) __hip_atomic_fetch_add(hist + (kreg[i] >> 24), 1u, __ATOMIC_RELAXED, __HIP_MEMORY_SCOPE_WAVEFRONT);
                        } else {
                            const unsigned sh8 = (unsigned)(shift + 8);
#pragma unroll
                            for (int i = 0; i < 33; ++i)
                                if (64 * i < n) {
                                    const unsigned key = kreg[i];
                                    if ((key >> sh8) == prefix) __hip_atomic_fetch_add(hist + ((key >> shift) & 255u), 1u, __ATOMIC_RELAXED, __HIP_MEMORY_SCOPE_WAVEFRONT);
                                }
                        }
                        __builtin_amdgcn_wave_barrier(); asm volatile("s_waitcnt lgkmcnt(0)" ::: "memory");
                        const u32x4 hv = *(const LAS u32x4*)(hist + (63 - lane) * 4);
                        const int c0 = (int)hv[3], c1 = (int)hv[2], c2 = (int)hv[1], c3 = (int)hv[0];
                        const int tot = c0 + c1 + c2 + c3;
                        const int incl = wave_incl_scan(tot), excl = incl - tot;
                        const bool found = (excl < remaining) && (remaining <= incl);
                        int digit = 0, rem_new = 0;
                        if (found) {
                            int cum = excl;
                            if (cum + c0 >= remaining) { digit = 255 - 4 * lane; rem_new = remaining - cum; }
                            else { cum += c0;
                                if (cum + c1 >= remaining) { digit = 254 - 4 * lane; rem_new = remaining - cum; }
                                else { cum += c1;
                                    if (cum + c2 >= remaining) { digit = 253 - 4 * lane; rem_new = remaining - cum; }
                                    else { cum += c2; digit = 252 - 4 * lane; rem_new = remaining - cum; } } }
                        }
                        const unsigned long long fm = __ballot(found);
                        const int src = (int)__builtin_ctzll(fm);
                        digit = __shfl(digit, src); rem_new = __shfl(rem_new, src);
                        prefix = (prefix << 8) | (unsigned)digit; remaining = rem_new;
                    }
                    const unsigned tkey = prefix;
                    int eqcount = 0;
#pragma unroll
                    for (int i = 0; i < 33; ++i) {
                        if (64 * i < n) {
                            const unsigned key = kreg[i];
                            const bool valid = lane < n - 64 * i;
                            const bool gt = valid && (key > tkey), eq = valid && (key == tkey);
                            const unsigned long long em = __ballot(eq);
                            const int rank = eqcount + __popcll(em & ((1ull << lane) - 1ull));
                            const bool sel = gt || (eq && rank < remaining);
                            eqcount += __popcll(em);
                            const unsigned long long sm = __ballot(sel);
                            if (lane == 0) { bits[2 * i] = (unsigned)sm; bits[2 * i + 1] = (unsigned)(sm >> 32); }
                        } else if (lane == 0) { bits[2 * i] = 0u; bits[2 * i + 1] = 0u; }
                    }
                }
            }
        }
        __syncthreads();
        for (int repC = 0; repC < PROBE_DSA_C; ++repC) {
            if (repC > 0) __syncthreads();
            const int h = wid, g = h >> 2;
            const int nstep = (t0 + 16 + 63) >> 6;
            bf16x8 aqf[2];
            aqf[0] = *(const bf16x8*)(AQ + rowq * 512 + h * 64 + fq * 8);
            aqf[1] = *(const bf16x8*)(AQ + rowq * 512 + h * 64 + 32 + fq * 8);
            asm volatile("" : "+v"(aqf[0]), "+v"(aqf[1]));
            const int drow = 8 * wid + (lane >> 3);
            const int kch = (lane & 7) ^ (drow & 7), vch = (lane & 7) ^ ((drow >> 1) & 7);
            const bf16_t* vsrc0 = AVT + ((size_t)b * 128 + drow) * LP + vch * 8;
#define DSA_DMA(st_, buf_) do { \
                int krow_ = b * L + 64 * (st_) + drow; krow_ = krow_ < T ? krow_ : T - 1; \
                const bf16_t* ks_ = AK + (size_t)krow_ * 128 + kch * 8; \
                LAS unsigned char* lb_ = lds + (buf_) * 32768 + wid * 1024; \
                __builtin_amdgcn_global_load_lds((const unsigned*)ks_, (LAS unsigned*)lb_, 16, 0, 0); \
                __builtin_amdgcn_global_load_lds((const unsigned*)(ks_ + 64), (LAS unsigned*)(lb_ + 8192), 16, 0, 0); \
                __builtin_amdgcn_global_load_lds((const unsigned*)(vsrc0 + 64 * (st_)), (LAS unsigned*)(lb_ + 16384), 16, 0, 0); \
                __builtin_amdgcn_global_load_lds((const unsigned*)(vsrc0 + (size_t)64 * LP + 64 * (st_)), (LAS unsigned*)(lb_ + 24576), 16, 0, 0); } while (0)
            DSA_DMA(0, 0);
            DSA_DMA((nstep > 1 ? 1 : 0), 1);
            for (int wi = tid; wi < 16 * 66; wi += NT) {
                const int q = wi / 66, wd = wi - q * 66;
                const unsigned bw = *((const LAS unsigned*)(lds + DS_BITS) + wi);
                const int st = wd >> 1, hh = wd & 1;
#pragma unroll
                for (int f = 0; f < 4; ++f) {
                    const unsigned n0 = (bw >> (4 * f)) & 15u, n1 = (bw >> (16 + 4 * f)) & 15u;
                    u32x2 o; o.x = (n0 * 0x00204081u) & 0x01010101u; o.y = (n1 * 0x00204081u) & 0x01010101u;
                    *(LAS u32x2*)(lds + DS_MB + q * DS_MBROW + 64 * st + 16 * f + 8 * hh) = o;
                }
            }
            asm volatile("s_waitcnt vmcnt(4) lgkmcnt(0)" ::: "memory");
            __builtin_amdgcn_s_barrier();
            asm volatile("" ::: "memory");
            f32x4 O[4];
#pragma unroll
            for (int dt = 0; dt < 4; ++dt) O[dt] = (f32x4){0.f, 0.f, 0.f, 0.f};
            float m = -INFINITY, l = 0.f;
            const float C2 = 1.44269504088896341f;
            int buf = 0;
            for (int st = 0; st < nstep; ++st) {
                {
                    const int sn = (st + 2 < nstep) ? st + 2 : nstep - 1;
                    const int bn = (buf >= 1) ? buf - 1 : 2;
                    DSA_DMA(sn, bn);
                }
                const LAS unsigned char* sb = lds + buf * 32768;
                f32x4 S[4];
#pragma unroll
                for (int kt = 0; kt < 4; ++kt) {
                    S[kt] = (f32x4){0.f, 0.f, 0.f, 0.f};
#pragma unroll
                    for (int s2 = 0; s2 < 2; ++s2) {
                        const int rowk = 16 * kt + fr;
                        const bf16x8 kf = *(const LAS bf16x8*)(sb + g * 8192 + rowk * 128 + 16 * ((4 * s2 + fq) ^ (rowk & 7)));
                        S[kt] = __builtin_amdgcn_mfma_f32_16x16x32_bf16(kf, aqf[s2], S[kt], 0, 0, 0);
                    }
                }
                const u32x4 mb = *(const LAS u32x4*)(lds + DS_MB + fr * DS_MBROW + 64 * st + 16 * fq);
                float pmax = S[0][0];
#pragma unroll
                for (int kt = 0; kt < 4; ++kt)
#pragma unroll
                    for (int r = 0; r < 4; ++r) pmax = fmaxf(pmax, S[kt][r]);
                if (__any(pmax > m + 8.0f)) {
                    float pm = fmaxf(pmax, __shfl_xor(pmax, 16)); pm = fmaxf(pm, __shfl_xor(pm, 32));
                    const float mn = fmaxf(m, pm);
                    const float alpha = __builtin_amdgcn_exp2f((m - mn) * C2);
#pragma unroll
                    for (int dt = 0; dt < 4; ++dt) O[dt] *= alpha;
                    l *= alpha; m = mn;
                }
                const float mc = m * C2;
                unsigned pk[4][2];
#pragma unroll
                for (int kt = 0; kt < 4; ++kt) {
                    float pv[4];
#pragma unroll
                    for (int r = 0; r < 4; ++r) {
                        const float e = __builtin_amdgcn_exp2f(fmaf(S[kt][r], C2, -mc));
                        const float bf = (float)((mb[kt] >> (8 * r)) & 0xFFu);
                        pv[r] = e * bf; l += pv[r];
                    }
                    pk[kt][0] = cvt_pk_bf16(pv[0], pv[1]); pk[kt][1] = cvt_pk_bf16(pv[2], pv[3]);
                }
#pragma unroll
                for (int ks = 0; ks < 2; ++ks) {
                    u32x4 pw; pw[0] = pk[2 * ks][0]; pw[1] = pk[2 * ks][1]; pw[2] = pk[2 * ks + 1][0]; pw[3] = pk[2 * ks + 1][1];
                    const bf16x8 pf = __builtin_bit_cast(bf16x8, pw);
#pragma unroll
                    for (int dt = 0; dt < 4; ++dt) {
                        const int rowv = 16 * dt + fr, sw = (rowv >> 1) & 7;
                        const LAS unsigned char* vp = sb + 16384 + g * 8192 + rowv * 128 + 8 * (fq & 1);
                        const u32x2 va = *(const LAS u32x2*)(vp + 16 * ((4 * ks + (fq >> 1)) ^ sw));
                        const u32x2 vb = *(const LAS u32x2*)(vp + 16 * ((4 * ks + 2 + (fq >> 1)) ^ sw));
                        u32x4 vw; vw[0] = va[0]; vw[1] = va[1]; vw[2] = vb[0]; vw[3] = vb[1];
                        O[dt] = __builtin_amdgcn_mfma_f32_16x16x32_bf16(__builtin_bit_cast(bf16x8, vw), pf, O[dt], 0, 0, 0);
                    }
                }
                asm volatile("s_waitcnt vmcnt(4)" ::: "memory");
                __builtin_amdgcn_s_barrier();
                asm volatile("" ::: "memory");
                buf = (buf == 2) ? 0 : buf + 1;
            }
#undef DSA_DMA
            asm volatile("s_waitcnt vmcnt(0)" ::: "memory");
            l += __shfl_xor(l, 16); l += __shfl_xor(l, 32);
            const float inv = 1.f / fmaxf(l, 1e-30f);
            bf16_t* mp = MIX + rowq * 1024 + 512 + h * 64 + 4 * fq;
            if (do_store && repC == PROBE_DSA_C - 1)
#pragma unroll
            for (int dt = 0; dt < 4; ++dt) {
                const uint2 gz = *(const uint2*)(mp + 16 * dt);
                const float g0 = __uint_as_float(gz.x << 16), g1 = __uint_as_float(gz.x & 0xFFFF0000u), g2 = __uint_as_float(gz.y << 16), g3 = __uint_as_float(gz.y & 0xFFFF0000u);
                uint2 o; o.x = pack2bf(O[dt][0] * inv * g0, O[dt][1] * inv * g1); o.y = pack2bf(O[dt][2] * inv * g2, O[dt][3] * inv * g3);
                *(uint2*)(mp + 16 * dt) = o;
            }
        }
    }
}

__device__ __forceinline__ void rope16(const u32x4 a, const u32x4 b, const float2* rp, u32x4& oa, u32x4& ob) {
    const f32x4 r0 = *(const f32x4*)(rp), r1 = *(const f32x4*)(rp + 2), r2 = *(const f32x4*)(rp + 4), r3 = *(const f32x4*)(rp + 6);
    const float cs[8] = {r0[0], r0[2], r1[0], r1[2], r2[0], r2[2], r3[0], r3[2]};
    const float sn[8] = {r0[1], r0[3], r1[1], r1[3], r2[1], r2[3], r3[1], r3[3]};
    float o1[8], o2[8];
#pragma unroll
    for (int i = 0; i < 4; ++i) {
        const float x1l = __uint_as_float(a[i] << 16), x1h = __uint_as_float(a[i] & 0xFFFF0000u);
        const float x2l = __uint_as_float(b[i] << 16), x2h = __uint_as_float(b[i] & 0xFFFF0000u);
        o1[2 * i] = x1l * cs[2 * i] - x2l * sn[2 * i]; o1[2 * i + 1] = x1h * cs[2 * i + 1] - x2h * sn[2 * i + 1];
        o2[2 * i] = x2l * cs[2 * i] + x1l * sn[2 * i]; o2[2 * i + 1] = x2h * cs[2 * i + 1] + x1h * sn[2 * i + 1];
    }
#pragma unroll
    for (int i = 0; i < 4; ++i) { oa[i] = cvt_pk_bf16(o1[2 * i], o1[2 * i + 1]); ob[i] = cvt_pk_bf16(o2[2 * i], o2[2 * i + 1]); }
}
__device__ __forceinline__ void phase_rope(const Params& p_in, int layer_in, char* smem) {
    const Params p = kparams(); const int layer = opaque_int(layer_in); (void)p_in;
    const int tid = opaque_tid();
    const float2* ROPE = (const float2*)(p.ws + OFF_ROPE);
    const int nthr = gridDim.x * NT, gid = opaque_bid() * NT + tid;
    for (int th = gid; th < T * 18; th += nthr) {
        const int t = th / 18, hh = th - t * 18, pos = t % L;
        bf16_t* base = (hh < 8) ? (bf16_t*)(p.ws + OFF_AQ) + (size_t)t * 512 + hh * 64
                     : (hh < 16) ? (bf16_t*)(p.ws + OFF_IQ) + (size_t)t * 512 + (hh - 8) * 64
                                 : (bf16_t*)(p.ws + OFF_AK) + (size_t)t * 128 + (hh - 16) * 64;
        const u32x4 a = *(const u32x4*)base, b = *(const u32x4*)(base + 8);
        u32x4 oa, ob; rope16(a, b, ROPE + pos * 8, oa, ob);
        *(u32x4*)base = oa; *(u32x4*)(base + 8) = ob;
    }
    const float* IKR = (const float*)(p.ws + OFF_IKR);
    bf16_t* IK = (bf16_t*)(p.ws + OFF_IK);
    const float* ikg = p.ikg + layer * 64; const float* ikb = p.ikb + layer * 64;
    for (int t = gid; t < T; t += nthr) {
        const int pos = t % L;
        f32x4 x[16];
#pragma unroll
        for (int i = 0; i < 16; ++i) x[i] = *(const f32x4*)(IKR + (size_t)t * 64 + 4 * i);
        float sm = 0.f;
#pragma unroll
        for (int i = 0; i < 16; ++i) sm += (x[i][0] + x[i][1]) + (x[i][2] + x[i][3]);
        const float mu = sm * (1.f / 64);
        float qq = 0.f;
#pragma unroll
        for (int i = 0; i < 16; ++i) { const f32x4 d = x[i] - mu; qq += (d[0] * d[0] + d[1] * d[1]) + (d[2] * d[2] + d[3] * d[3]); }
        const float rs = rsqrtf(qq * (1.f / 64) + LN_EPS);
#pragma unroll
        for (int i = 0; i < 16; ++i) { const f32x4 g = *(const f32x4*)(ikg + 4 * i), bb = *(const f32x4*)(ikb + 4 * i); x[i] = (x[i] - mu) * rs * g + bb; }
        const float2* rp = ROPE + pos * 8;
        const f32x4 r0 = *(const f32x4*)(rp), r1 = *(const f32x4*)(rp + 2), r2 = *(const f32x4*)(rp + 4), r3 = *(const f32x4*)(rp + 6);
        const float cs[8] = {r0[0], r0[2], r1[0], r1[2], r2[0], r2[2], r3[0], r3[2]};
        const float sn[8] = {r0[1], r0[3], r1[1], r1[3], r2[1], r2[3], r3[1], r3[3]};
#pragma unroll
        for (int i = 0; i < 8; ++i) {
            const float x1 = x[i >> 2][i & 3], x2 = x[2 + (i >> 2)][i & 3];
            x[i >> 2][i & 3] = x1 * cs[i] - x2 * sn[i];
            x[2 + (i >> 2)][i & 3] = x2 * cs[i] + x1 * sn[i];
        }
#pragma unroll
        for (int i = 0; i < 8; ++i) {
            u32x4 o; o[0] = cvt_pk_bf16(x[2 * i][0], x[2 * i][1]); o[1] = cvt_pk_bf16(x[2 * i][2], x[2 * i][3]); o[2] = cvt_pk_bf16(x[2 * i + 1][0], x[2 * i + 1][1]); o[3] = cvt_pk_bf16(x[2 * i + 1][2], x[2 * i + 1][3]);
            *(u32x4*)(IK + (size_t)t * 64 + 8 * i) = o;
        }
    }
}

constexpr int GL_QE = 0, GL_KN = 8192, GL_SEG = 16384, GL_PART = 18432;
__device__ __forceinline__ void gla_cumsum(const Params& p, int layer, int b, int h, int c, int tid, LAS unsigned char* lds, float (&bc)[8], float& blast) {
    const int d = tid & 63, seg = tid >> 6;
    const float* wg2 = p.wg2 + (size_t)layer * 16 * 256 + h * 64 + d;
    float w[16];
#pragma unroll
    for (int rr = 0; rr < 16; ++rr) w[rr] = wg2[rr * 256];
    const float bgd = p.bg[layer * 256 + h * 64 + d];
    const float* GLR = (const float*)(p.ws + OFF_GLR);
    float pb = 0.f;
#pragma unroll
    for (int i = 0; i < 8; ++i) {
        const int pos = 64 * c - 48 + 8 * seg + i;
        float gl = 0.f;
        if (pos >= 0) {
            const f32x4* gp = (const f32x4*)(GLR + ((size_t)b * L + pos) * 16);
            const f32x4 g0 = gp[0], g1 = gp[1], g2 = gp[2], g3 = gp[3];
            float x = bgd;
#pragma unroll
            for (int rr = 0; rr < 4; ++rr) { x = fmaf(g0[rr], w[rr], x); }
#pragma unroll
            for (int rr = 0; rr < 4; ++rr) { x = fmaf(g1[rr], w[4 + rr], x); }
#pragma unroll
            for (int rr = 0; rr < 4; ++rr) { x = fmaf(g2[rr], w[8 + rr], x); }
#pragma unroll
            for (int rr = 0; rr < 4; ++rr) { x = fmaf(g3[rr], w[12 + rr], x); }
            gl = logsigmoid_fast(x) * (1.f / 16.f);
        }
        pb += gl; bc[i] = pb;
    }
    LAS float* segs = (LAS float*)(lds + GL_SEG);
    segs[seg * 64 + d] = pb;
    __syncthreads();
    float base = 0.f, tot = 0.f;
#pragma unroll
    for (int sg = 0; sg < 8; ++sg) { const float v = segs[sg * 64 + d]; tot += v; base += (sg < seg) ? v : 0.f; }
#pragma unroll
    for (int i = 0; i < 8; ++i) bc[i] += base;
    blast = tot;
}

__device__ __forceinline__ void phase_gla_a(const Params& p_in, int layer_in, char* smem) {
    const Params p = kparams(); const int layer = opaque_int(layer_in); (void)p_in;
    const int tid = opaque_tid(), wid = __builtin_amdgcn_readfirstlane(tid >> 6), lane = tid & 63, fr = lane & 15, fq = lane >> 4;
    LAS unsigned char* lds = (LAS unsigned char*)smem;
    const bf16_t* GK = (const bf16_t*)(p.ws + OFF_GK);
    const bf16_t* GVT = (const bf16_t*)(p.ws + OFF_GV);
    float* UT = (float*)(p.ws + OFF_UT);
    float* DL = (float*)(p.ws + OFF_DL);
    for (int task = opaque_bid(); task < 1024; task += gridDim.x) {
        const int bh = task >> 5, c = task & 31, b = bh >> 2, h = bh & 3;
        __syncthreads();
        float bc[8], blast;
        gla_cumsum(p, layer, b, h, c, tid, lds, bc, blast);
        {
            const int d = tid & 63, seg = tid >> 6;
            float ke[8];
#pragma unroll
            for (int i = 0; i < 8; ++i) {
                const int pos = 64 * c - 48 + 8 * seg + i;
                const float kv = (pos >= 0) ? bf2f(GK[((size_t)b * L + pos) * 256 + h * 64 + d]) : 0.f;
                ke[i] = kv * __expf(blast - bc[i]);
            }
            u32x4 o; o[0] = cvt_pk_bf16(ke[0], ke[1]); o[1] = cvt_pk_bf16(ke[2], ke[3]); o[2] = cvt_pk_bf16(ke[4], ke[5]); o[3] = cvt_pk_bf16(ke[6], ke[7]);
            *(LAS u32x4*)(lds + GL_QE + d * 128 + 16 * (seg ^ (d & 7))) = o;
            if (seg == 0) DL[(size_t)task * 64 + d] = __expf(blast);
        }
        __syncthreads();
        bf16x8 vf[2];
        {
            const bf16_t* vp = GVT + ((size_t)bh * 128 + 16 * wid + fr) * LPV + 64 * c + 8 * fq;
            vf[0] = *(const bf16x8*)vp; vf[1] = *(const bf16x8*)(vp + 32);
            const bf16x8 z8 = {0, 0, 0, 0, 0, 0, 0, 0};
            if (c == 0) { vf[0] = z8; if (fq < 2) vf[1] = z8; }
        }
#pragma unroll
        for (int dt = 0; dt < 4; ++dt) {
            f32x4 acc = {0.f, 0.f, 0.f, 0.f};
#pragma unroll
            for (int ks = 0; ks < 2; ++ks) {
                const int rowd = 16 * dt + fr;
                const bf16x8 kf = *(const LAS bf16x8*)(lds + GL_QE + rowd * 128 + 16 * ((4 * ks + fq) ^ (rowd & 7)));
                acc = __builtin_amdgcn_mfma_f32_16x16x32_bf16(vf[ks], kf, acc, 0, 0, 0);
            }
            float* up = UT + ((size_t)task * 128 + 16 * wid + 4 * fq) * 64 + 16 * dt + fr;
#pragma unroll
            for (int r = 0; r < 4; ++r) up[r * 64] = acc[r];
        }
    }
}

__device__ __forceinline__ void phase_gla_scan(const Params& p_in, int layer_in, char* smem) {
    const Params p = kparams(); const int layer = opaque_int(layer_in); (void)p_in;
    const int tid = opaque_tid();
    const float* UT = (const float*)(p.ws + OFF_UT);
    const float* DL = (const float*)(p.ws + OFF_DL);
    bf16_t* ST = (bf16_t*)(p.ws + OFF_ST);
    const int nthr = gridDim.x * NT;
    for (int el = opaque_bid() * NT + tid; el < 32 * 8192; el += nthr) {
        const int bh = el >> 13, ed = el & 8191, d = el & 63;
        float sacc = 0.f;
        ST[((size_t)bh * 33) * 8192 + ed] = 0;
#pragma unroll 1
        for (int c0 = 0; c0 < 32; c0 += 16) {
            float u[16], dl[16];
#pragma unroll
            for (int i = 0; i < 16; ++i) { u[i] = UT[((size_t)(bh * 32 + c0 + i)) * 8192 + ed]; dl[i] = DL[(size_t)(bh * 32 + c0 + i) * 64 + d]; }
#pragma unroll
            for (int i = 0; i < 16; ++i) { sacc = fmaf(dl[i], sacc, u[i]); ST[((size_t)bh * 33 + c0 + i + 1) * 8192 + ed] = f2bf(sacc); }
        }
    }
}

__device__ __forceinline__ void phase_gla_c(const Params& p_in, int layer_in, char* smem, bool do_store) {
    const Params p = kparams(); const int layer = opaque_int(layer_in); (void)p_in;
    const int tid = opaque_tid(), wid = __builtin_amdgcn_readfirstlane(tid >> 6), lane = tid & 63, fr = lane & 15, fq = lane >> 4;
    LAS unsigned char* lds = (LAS unsigned char*)smem;
    const bf16_t* GQ = (const bf16_t*)(p.ws + OFF_GQ);
    const bf16_t* GK = (const bf16_t*)(p.ws + OFF_GK);
    const bf16_t* GVT = (const bf16_t*)(p.ws + OFF_GV);
    const bf16_t* ST = (const bf16_t*)(p.ws + OFF_ST);
    bf16_t* MIX = (bf16_t*)(p.ws + OFF_MIX);
    const float* ng = p.norm_g + layer * 128;
    for (int task = opaque_bid(); task < 32 * 33; task += gridDim.x) {
        const int bh = task / 33, c = task - bh * 33, b = bh >> 2, h = bh & 3;
        __syncthreads();
        float bc[8], blast;
        gla_cumsum(p, layer, b, h, c, tid, lds, bc, blast);
        {
            const int d = tid & 63, seg = tid >> 6;
#pragma unroll
            for (int i = 0; i < 8; ++i) {
                const int t = 8 * seg + i, pos = 64 * c - 48 + t;
                float qv = 0.f, kv = 0.f;
                if (pos >= 0) { const size_t row = (size_t)b * L + pos; qv = bf2f(GQ[row * 256 + h * 64 + d]); kv = bf2f(GK[row * 256 + h * 64 + d]); }
                const int off = t * 128 + 16 * ((d >> 3) ^ (t & 7)) + 2 * (d & 7);
                *(LAS bf16_t*)(lds + GL_QE + off) = f2bf(qv * __expf(bc[i]));
                *(LAS bf16_t*)(lds + GL_KN + off) = f2bf(kv * __expf(-bc[i]));
            }
        }
        __syncthreads();
        const int tw = wid & 3, eh = wid >> 2;
        bf16x8 qf[2];
#pragma unroll
        for (int ks = 0; ks < 2; ++ks) { const int rowt = 16 * tw + fr; qf[ks] = *(const LAS bf16x8*)(lds + GL_QE + rowt * 128 + 16 * ((4 * ks + fq) ^ (rowt & 7))); }
        unsigned pk[4][2];
#pragma unroll
        for (int st = 0; st < 4; ++st) {
            f32x4 a = {0.f, 0.f, 0.f, 0.f};
#pragma unroll
            for (int ks = 0; ks < 2; ++ks) {
                const int rows = 16 * st + fr;
                const bf16x8 kf = *(const LAS bf16x8*)(lds + GL_KN + rows * 128 + 16 * ((4 * ks + fq) ^ (rows & 7)));
                a = __builtin_amdgcn_mfma_f32_16x16x32_bf16(kf, qf[ks], a, 0, 0, 0);
            }
#pragma unroll
            for (int r = 0; r < 4; ++r) a[r] = (16 * st + 4 * fq + r > 16 * tw + fr) ? 0.f : a[r];
            pk[st][0] = cvt_pk_bf16(a[0], a[1]); pk[st][1] = cvt_pk_bf16(a[2], a[3]);
        }
        bf16x8 pf[2];
#pragma unroll
        for (int ks = 0; ks < 2; ++ks) { u32x4 pw; pw[0] = pk[2 * ks][0]; pw[1] = pk[2 * ks][1]; pw[2] = pk[2 * ks + 1][0]; pw[3] = pk[2 * ks + 1][1]; pf[ks] = __builtin_bit_cast(bf16x8, pw); }
        f32x4 O[4];
        float ss = 0.f;
#pragma unroll
        for (int et = 0; et < 4; ++et) {
            const int e0 = 64 * eh + 16 * et;
            f32x4 acc = {0.f, 0.f, 0.f, 0.f};
            const bf16_t* sp = ST + (((size_t)bh * 33 + c) * 128 + e0 + fr) * 64 + 8 * fq;
            const bf16_t* vp = GVT + ((size_t)bh * 128 + e0 + fr) * LPV + 64 * c + 4 * fq;
#pragma unroll
            for (int ks = 0; ks < 2; ++ks) {
                const bf16x8 sf = *(const bf16x8*)(sp + 32 * ks);
                acc = __builtin_amdgcn_mfma_f32_16x16x32_bf16(sf, qf[ks], acc, 0, 0, 0);
                u32x2 va = *(const u32x2*)(vp + 32 * ks), vb = *(const u32x2*)(vp + 32 * ks + 16);
                if (c == 0) { va = (u32x2){0u, 0u}; if (ks == 0) vb = (u32x2){0u, 0u}; }
                u32x4 vw; vw[0] = va[0]; vw[1] = va[1]; vw[2] = vb[0]; vw[3] = vb[1];
                acc = __builtin_amdgcn_mfma_f32_16x16x32_bf16(__builtin_bit_cast(bf16x8, vw), pf[ks], acc, 0, 0, 0);
            }
            O[et] = acc;
            ss += acc[0] * acc[0] + acc[1] * acc[1] + acc[2] * acc[2] + acc[3] * acc[3];
        }
        ss += __shfl_xor(ss, 16); ss += __shfl_xor(ss, 32);
        LAS float* part = (LAS float*)(lds + GL_PART);
        if (fq == 0) part[eh * 64 + 16 * tw + fr] = ss;
        __syncthreads();
        const float tot = part[16 * tw + fr] + part[64 + 16 * tw + fr];
        const float rinv = rsqrtf(tot * (1.f / 128) + LN_EPS);
        const int pos = 64 * c - 48 + 16 * tw + fr;
        if (pos >= 0 && do_store) {
            bf16_t* mp = MIX + ((size_t)b * L + pos) * 1024 + h * 128 + 64 * eh + 4 * fq;
#pragma unroll
            for (int et = 0; et < 4; ++et) {
                const uint2 gz = *(const uint2*)(mp + 16 * et);
                const f32x4 nv = *(const f32x4*)(ng + 64 * eh + 16 * et + 4 * fq);
                const float g0 = __uint_as_float(gz.x << 16), g1 = __uint_as_float(gz.x & 0xFFFF0000u), g2 = __uint_as_float(gz.y << 16), g3 = __uint_as_float(gz.y & 0xFFFF0000u);
                uint2 o; o.x = pack2bf(O[et][0] * rinv * nv[0] * g0, O[et][1] * rinv * nv[1] * g1); o.y = pack2bf(O[et][2] * rinv * nv[2] * g2, O[et][3] * rinv * nv[3] * g3);
                *(uint2*)(mp + 16 * et) = o;
            }
        }
    }
}

__device__ __forceinline__ void phase_ln(const Params& p_in, int layer_in, char* smem) {
    const Params p = kparams(); const int layer = opaque_int(layer_in); (void)p_in;
    const int tid = opaque_tid(), wid = tid >> 6, lane = tid & 63;
    const float* Z = (const float*)(p.ws + OFF_GQ);
    float* H32 = (float*)(p.ws + OFF_H32);
    bf16_t* HB = (bf16_t*)(p.ws + OFF_HB);
    const float* g = p.ln_g + layer * D; const float* bb = p.ln_b + layer * D;
    const int nw = gridDim.x * 8;
    int t = opaque_bid() * 8 + wid;
    f32x4 v[4], vn[4];
    if (t < T) {
#pragma unroll
        for (int i = 0; i < 4; ++i) v[i] = *(const f32x4*)(Z + (size_t)t * D + 4 * lane + 256 * i);
    }
    for (; t < T; t += nw) {
        const int tn = t + nw;
        if (tn < T) {
#pragma unroll
            for (int i = 0; i < 4; ++i) vn[i] = *(const f32x4*)(Z + (size_t)tn * D + 4 * lane + 256 * i);
        }
        ln_row_wave(v, g, bb, lane);
        if (layer == DEPTH - 1) {
            const int b = t / L, pos = t - b * L;
            if (pos >= NMETA) {
#pragma unroll
                for (int i = 0; i < 4; ++i) *(f32x4*)(p.out + ((size_t)b * SEQ + (pos - NMETA)) * D + 4 * lane + 256 * i) = v[i];
            }
        } else {
#pragma unroll
            for (int i = 0; i < 4; ++i) {
                *(f32x4*)(H32 + (size_t)t * D + 4 * lane + 256 * i) = v[i];
                u32x2 o; o[0] = cvt_pk_bf16(v[i][0], v[i][1]); o[1] = cvt_pk_bf16(v[i][2], v[i][3]);
                *(u32x2*)(HB + (size_t)t * D + 4 * lane + 256 * i) = o;
            }
        }
#pragma unroll
        for (int i = 0; i < 4; ++i) v[i] = vn[i];
    }
}

#define XB_TMO      128
#define XB_XCNT(j)  (256  + 64 * (j))
#define XB_XSUB(j)  (1280 + 64 * (j))
#define XB_XGEN(j)  (2304 + 64 * (j))
#define XB_TOP      3328
#define XB_TOPGEN   3392
#define XCD_BAR_WORDS 3456
#define XB_SPIN_CAP (1u << 22)
__device__ __forceinline__ unsigned xb_ld(unsigned* p)              { return __hip_atomic_load(p, __ATOMIC_RELAXED, __HIP_MEMORY_SCOPE_AGENT); }
__device__ __forceinline__ unsigned xb_add(unsigned* p, unsigned v) { return __hip_atomic_fetch_add(p, v, __ATOMIC_RELAXED, __HIP_MEMORY_SCOPE_AGENT); }
__device__ __forceinline__ unsigned xb_xcc_id() { return (unsigned)__builtin_amdgcn_s_getreg((3 << 11) | 20) & 0xFu; }
#define XB_SPIN(cond, bar) do { unsigned _sp = 0; while (cond) { __builtin_amdgcn_s_sleep(1); \
    if ((++_sp & 255u) == 0u) { if (xb_ld(&(bar)[XB_TMO])) break; if (_sp > XB_SPIN_CAP) { atomicAdd(&(bar)[XB_TMO], 1u); break; } } } } while (0)
struct XcdBarrier { unsigned* bar; unsigned x; volatile LAS unsigned* st; };
__device__ __forceinline__ XcdBarrier xcd_barrier_post(unsigned* bar, volatile LAS unsigned* st) {
    XcdBarrier b; b.bar = bar; b.x = xb_xcc_id(); b.st = st;
    if (threadIdx.x == 0) (void)xb_add(&bar[XB_XCNT(b.x)], 1u);
    return b;
}
__device__ __forceinline__ void xcd_barrier_complete(unsigned* bar, unsigned x, unsigned& nloc, unsigned& nx) {
    const unsigned G = gridDim.x * gridDim.y * gridDim.z;
    unsigned sum, cnt, mine, sp = 0u;
    for (;;) {
        sum = 0u; cnt = 0u; mine = 0u;
#pragma unroll
        for (unsigned j = 0; j < 16; ++j) { const unsigned c = xb_ld(&bar[XB_XCNT(j)]); sum += c; cnt += (c > 0u) ? 1u : 0u; mine = (j == x) ? c : mine; }
        if (sum == G) break;
        __builtin_amdgcn_s_sleep(1);
        if ((++sp & 255u) == 0u) { if (xb_ld(&bar[XB_TMO])) break; if (sp > XB_SPIN_CAP) { atomicAdd(&bar[XB_TMO], 1u); break; } }
    }
    nloc = mine > 0u ? mine : 1u; nx = cnt > 0u ? cnt : 1u;
}
__device__ __forceinline__ void xcd_barrier(unsigned* bar_, volatile LAS unsigned* st_) {
    XcdBarrier b; b.bar = bar_; b.x = xb_xcc_id(); b.st = st_;
    asm volatile("s_waitcnt vmcnt(0)" ::: "memory");
    __syncthreads();
    if (opaque_tid() == 0) {
        unsigned* bar = b.bar;
        __builtin_amdgcn_s_waitcnt(0);
        unsigned nloc = b.st[0], nx = b.st[1];
        if (nloc == 0u) { xcd_barrier_complete(bar, b.x, nloc, nx); b.st[0] = nloc; b.st[1] = nx; }
        const unsigned old = xb_add(&bar[XB_XSUB(b.x)], 1u);
        const unsigned gen = old / nloc;
        if (old + 1u == (gen + 1u) * nloc) {
            __builtin_amdgcn_fence(__ATOMIC_RELEASE, "agent");
            asm volatile("s_waitcnt vmcnt(0)" ::: "memory");
            const unsigned og = xb_add(&bar[XB_TOP], 1u);
            const unsigned tg = og / nx;
            if (og + 1u == (tg + 1u) * nx) xb_add(&bar[XB_TOPGEN], 1u);
            else XB_SPIN(xb_ld(&bar[XB_TOPGEN]) == tg, bar);
            __builtin_amdgcn_fence(__ATOMIC_ACQUIRE, "agent");
            xb_add(&bar[XB_XGEN(b.x)], 1u);
            asm volatile("s_waitcnt vmcnt(0)" ::: "memory");
        } else {
            XB_SPIN(xb_ld(&bar[XB_XGEN(b.x)]) == gen, bar);
            __builtin_amdgcn_fence(__ATOMIC_ACQUIRE, "agent");
            asm volatile("s_waitcnt vmcnt(0)" ::: "memory");
        }
    }
    __syncthreads();
}

constexpr int SMEM_BYTES = 160 * 1024;
static_assert(DS_END <= SMEM_BYTES - 16, "dsa lds");

__global__ void __launch_bounds__(NT, 2) k_mega(Params p) {
    __shared__ __attribute__((aligned(16))) char smem[SMEM_BYTES];
    volatile LAS unsigned* xbw = (volatile LAS unsigned*)((LAS unsigned char*)smem + (SMEM_BYTES - 16));
    if (threadIdx.x == 0) { xbw[0] = 0u; xbw[1] = 0u; xbw[2] = 0u; xbw[3] = 0u; }
    __syncthreads();
    if (p.ws == nullptr) cg::this_grid().sync();
    (void)xcd_barrier_post((unsigned*)(p.ws + OFF_BAR), xbw);
    for (int rep = 0; rep < PROBE_REP_PREP; ++rep) {
    phase_prep(p, smem);
    xcd_barrier((unsigned*)(p.ws + OFF_BAR), xbw);
    }
#pragma unroll 1
    for (int layer = 0; layer < DEPTH; ++layer) {
        for (int rep = 0; rep < PROBE_REP_PROJ; ++rep) {
        phase_proj(p, layer, smem);
        xcd_barrier((unsigned*)(p.ws + OFF_BAR), xbw);
        }
        phase_rope(p, layer, smem);
        for (int rep = 0; rep < PROBE_REP_GLAA; ++rep) {
        phase_gla_a(p, layer, smem);
        xcd_barrier((unsigned*)(p.ws + OFF_BAR), xbw);
        phase_gla_scan(p, layer, smem);
        xcd_barrier((unsigned*)(p.ws + OFF_BAR), xbw);
        }
        for (int rep = 0; rep < PROBE_REP_GLAC; ++rep) phase_gla_c(p, layer, smem, rep == PROBE_REP_GLAC - 1);
        for (int rep = 0; rep < PROBE_REP_DSA; ++rep) phase_dsa(p, layer, smem, rep == PROBE_REP_DSA - 1);
        xcd_barrier((unsigned*)(p.ws + OFF_BAR), xbw);
        for (int rep = 0; rep < PROBE_REP_OUT; ++rep) {
        phase_outproj(p, layer, smem);
        xcd_barrier((unsigned*)(p.ws + OFF_BAR), xbw);
        }
        for (int rep = 0; rep < PROBE_REP_LN; ++rep) {
        phase_ln(p, layer, smem);
        xcd_barrier((unsigned*)(p.ws + OFF_BAR), xbw);
        }
    }
}

extern "C" void kernel_launch(void* const* d_in, const int* in_sizes, int n_in, void* d_out, int out_size, void* d_ws, size_t ws_size,
                              hipStream_t stream) {
    Params p{};
    p.x = (const float*)d_in[0]; p.meta = (const float*)d_in[1]; p.ln_in_g = (const float*)d_in[2]; p.ln_in_b = (const float*)d_in[3];
    p.w_in = (const float*)d_in[4]; p.wg2 = (const float*)d_in[5]; p.bg = (const float*)d_in[6]; p.norm_g = (const float*)d_in[7];
    p.ikg = (const float*)d_in[8]; p.ikb = (const float*)d_in[9]; p.w_out = (const float*)d_in[10]; p.ln_g = (const float*)d_in[11];
    p.ln_b = (const float*)d_in[12];
    p.out = (float*)d_out; p.ws = (char*)d_ws;
    static int grid_blocks = 0;
    if (!grid_blocks) {
        int dev = 0, cus = 0, per_cu = 0;
        hipGetDevice(&dev);
        hipDeviceGetAttribute(&cus, hipDeviceAttributeMultiprocessorCount, dev);
        hipOccupancyMaxActiveBlocksPerMultiprocessor(&per_cu, k_mega, NT, 0);
        if (per_cu > 1) per_cu = 1;
        grid_blocks = cus * per_cu;
    }
    (void)hipMemsetAsync((char*)d_ws + OFF_BAR, 0, XCD_BAR_WORDS * 4, stream);
    void* args[] = {&p};
    (void)hipLaunchCooperativeKernel((void*)k_mega, dim3(grid_blocks), dim3(NT), args, 0, stream);
}
```

```cpp
#include <hip/hip_runtime.h>
#include <hip/hip_cooperative_groups.h>
#include <stdint.h>
namespace cg = cooperative_groups;
#ifndef PROBE_REP_PREP
#define PROBE_REP_PREP 1
#define PROBE_REP_PROJ 1
#define PROBE_REP_GLAA 1
#define PROBE_REP_GLAC 1
#define PROBE_REP_DSA 1
#define PROBE_REP_OUT 1
#define PROBE_REP_LN 1
#define PROBE_DSA_A 1
#define PROBE_DSA_B 1
#define PROBE_DSA_C 1
#endif

constexpr int D = 1024, NB = 8, SEQ = 2048, NMETA = 16, L = 2064, T = NB * L;
constexpr int DEPTH = 2;
constexpr int INW = 3416, INWP = 3584;
constexpr int TP = 16640;
constexpr int NT = 512;
constexpr int TOPK = 256;
constexpr float LN_EPS = 1e-5f;
constexpr float ALPHA = 1.41421356237309515f;

typedef unsigned short bf16_t;
typedef short bf16x8 __attribute__((ext_vector_type(8)));
typedef float f32x4 __attribute__((ext_vector_type(4)));
#define LAS __attribute__((address_space(3)))

constexpr size_t SZ_H32 = (size_t)T * D * 4;
constexpr size_t SZ_HB = (size_t)TP * D * 2;
constexpr size_t SZ_WIN = (size_t)DEPTH * INWP * D * 2;
constexpr size_t SZ_WOUT = (size_t)DEPTH * D * D * 2;
constexpr int LPV = 2112;
constexpr size_t SZ_GQ = (size_t)T * 256 * 2, SZ_GK = SZ_GQ, SZ_GV = (size_t)NB * 4 * 128 * LPV * 2;
constexpr size_t SZ_UT = (size_t)1024 * 128 * 64 * 4, SZ_ST = (size_t)32 * 33 * 128 * 64 * 2, SZ_DL = (size_t)1024 * 64 * 4;
constexpr size_t SZ_AQ = (size_t)T * 512 * 2, SZ_IQ = (size_t)T * 512 * 2;
constexpr size_t SZ_MIX = (size_t)TP * 1024 * 2;
constexpr int LP = 2112;
constexpr size_t SZ_AK = (size_t)T * 128 * 2, SZ_AV = (size_t)NB * 2 * 64 * LP * 2, SZ_IK = (size_t)T * 64 * 2, SZ_IW = (size_t)T * 8 * 4;
constexpr size_t SZ_GLR = (size_t)T * 16 * 4;
constexpr size_t SZ_ROPE = (size_t)L * 8 * 2 * 4;

constexpr size_t OFF_H32 = 0;
constexpr size_t OFF_HB = OFF_H32 + SZ_H32;
constexpr size_t OFF_WIN = OFF_HB + SZ_HB;
constexpr size_t OFF_WOUT = OFF_WIN + SZ_WIN;
constexpr size_t OFF_GQ = OFF_WOUT + SZ_WOUT;
constexpr size_t OFF_GK = OFF_GQ + SZ_GQ;
constexpr size_t OFF_GV = OFF_GK + SZ_GK;
constexpr size_t OFF_AQ = OFF_GV + SZ_GV;
constexpr size_t OFF_IQ = OFF_AQ + SZ_AQ;
constexpr size_t OFF_MIX = OFF_IQ + SZ_IQ;
constexpr size_t OFF_AK = OFF_MIX + SZ_MIX;
constexpr size_t OFF_AV = OFF_AK + SZ_AK;
constexpr size_t OFF_IK = OFF_AV + SZ_AV;
constexpr size_t OFF_IW = OFF_IK + SZ_IK;
constexpr size_t OFF_GLR = OFF_IW + SZ_IW;
constexpr size_t OFF_ROPE = OFF_GLR + SZ_GLR;
constexpr size_t OFF_ST = OFF_ROPE + SZ_ROPE;
constexpr size_t OFF_DL = OFF_ST + SZ_ST;
constexpr size_t OFF_BAR = OFF_DL + SZ_DL;
constexpr size_t OFF_IKR = OFF_BAR + 16384;
constexpr size_t OFF_END = OFF_IKR + (size_t)T * 64 * 4;
constexpr size_t OFF_UT = OFF_HB;
static_assert(SZ_UT <= SZ_HB, "UT alias");
static_assert(SZ_GQ + SZ_GK + SZ_GV + SZ_AQ + SZ_IQ >= SZ_H32, "Z alias size");
static_assert(OFF_END <= (size_t)256 * 1024 * 1024, "workspace too large");

struct Params {
    const float* x; const float* meta; const float* ln_in_g; const float* ln_in_b;
    const float* w_in; const float* wg2; const float* bg; const float* norm_g;
    const float* ikg; const float* ikb; const float* w_out; const float* ln_g; const float* ln_b;
    float* out; char* ws;
};
typedef const Params __attribute__((address_space(4))) * KParamsPtr;
__device__ __forceinline__ Params kparams() {
    unsigned long long a = (unsigned long long)__builtin_amdgcn_kernarg_segment_ptr();
    asm volatile("" : "+s"(a));
    KParamsPtr q = (KParamsPtr)a;
    Params r;
    r.x = q->x; r.meta = q->meta; r.ln_in_g = q->ln_in_g; r.ln_in_b = q->ln_in_b; r.w_in = q->w_in; r.wg2 = q->wg2; r.bg = q->bg; r.norm_g = q->norm_g;
    r.ikg = q->ikg; r.ikb = q->ikb; r.w_out = q->w_out; r.ln_g = q->ln_g; r.ln_b = q->ln_b; r.out = q->out; r.ws = q->ws;
    return r;
}

__device__ __forceinline__ bf16_t f2bf(float f) {
    unsigned u = __float_as_uint(f);
    u += 0x7FFFu + ((u >> 16) & 1u);
    return (bf16_t)(u >> 16);
}
__device__ __forceinline__ unsigned pack2bf(float lo, float hi) { return (unsigned)f2bf(lo) | ((unsigned)f2bf(hi) << 16); }
__device__ __forceinline__ unsigned cvt_pk_bf16(float lo, float hi) { unsigned r; asm volatile("v_cvt_pk_bf16_f32 %0, %1, %2" : "=v"(r) : "v"(lo), "v"(hi)); return r; }
typedef unsigned u32x4 __attribute__((ext_vector_type(4)));
typedef unsigned u32x2 __attribute__((ext_vector_type(2)));
__device__ __forceinline__ float bf2f(bf16_t h) { return __uint_as_float(((unsigned)h) << 16); }
__device__ __forceinline__ int opaque_tid() { int t = threadIdx.x; asm volatile("" : "+v"(t)); return t; }
__device__ __forceinline__ int opaque_int(int v) { asm volatile("" : "+s"(v)); return v; }
__device__ __forceinline__ int opaque_bid() { int t = blockIdx.x; asm volatile("" : "+s"(t)); return t; }
__device__ __forceinline__ float wave_sum(float v) {
#pragma unroll
    for (int o = 32; o > 0; o >>= 1) v += __shfl_xor(v, o);
    return v;
}
__device__ __forceinline__ float wave_max(float v) {
#pragma unroll
    for (int o = 32; o > 0; o >>= 1) v = fmaxf(v, __shfl_xor(v, o));
    return v;
}
__device__ __forceinline__ float block_sum(float v, float* red) {
    v = wave_sum(v);
    const int tq = opaque_tid();
    __syncthreads();
    if ((tq & 63) == 0) red[tq >> 6] = v;
    __syncthreads();
    return ((red[0] + red[1]) + (red[2] + red[3])) + ((red[4] + red[5]) + (red[6] + red[7]));
}
__device__ __forceinline__ float silu_f(float x) { return x / (1.f + __expf(-x)); }
__device__ __forceinline__ float logsigmoid_f(float x) { return fminf(x, 0.f) - log1pf(expf(-fabsf(x))); }
__device__ __forceinline__ float logsigmoid_fast(float x) { return fminf(x, 0.f) - __logf(1.f + __expf(-fabsf(x))); }

__device__ __forceinline__ int proj_src_col(int n) {
    if (n < 1024) return n;
    if (n < 1536) return n - 1024 + 1040;
    if (n < 2048) return n - 1536 + 1552;
    if (n < 2560) return n - 2048 + 2904;
    if (n < 3072) return n - 2560 + 2320;
    if (n < 3200) return n - 3072 + 2064;
    if (n < 3328) return n - 3200 + 2192;
    const int c = n - 3328;
    if (c < 32) return 2832 + c;
    if (c < 48) return 1024 + (c - 32);
    if (c < 56) return 2896 + (c - 48);
    if (c >= 128 && c < 160) return 2832 + 32 + (c - 128);
    return -1;
}

__device__ __forceinline__ void sincos_acc(float a, float& s, float& c) {
    double ad = (double)a;
    double kd = rint(ad * 0.63661977236758134308);
    double r = fma(-kd, 1.57079632679489655800, ad);
    r = fma(-kd, 6.12323399573676603587e-17, r);
    double r2 = r * r;
    double sp = r * (1.0 + r2 * (-1.0 / 6 + r2 * (1.0 / 120 + r2 * (-1.0 / 5040 + r2 * (1.0 / 362880 + r2 * (-1.0 / 39916800))))));
    double cp = 1.0 + r2 * (-0.5 + r2 * (1.0 / 24 + r2 * (-1.0 / 720 + r2 * (1.0 / 40320 + r2 * (-1.0 / 3628800 + r2 * (1.0 / 479001600))))));
    int q = ((int)kd) & 3;
    double ss = (q & 1) ? cp : sp, cc = (q & 1) ? sp : cp;
    if (q == 1 || q == 2) cc = -cc;
    if (q == 2 || q == 3) ss = -ss;
    s = (float)ss; c = (float)cc;
}

__device__ __forceinline__ void ln_row_wave(f32x4 (&v)[4], const float* g, const float* bb, int lane) {
    float sm = 0.f;
#pragma unroll
    for (int i = 0; i < 4; ++i) sm += (v[i][0] + v[i][1]) + (v[i][2] + v[i][3]);
    const float mu = wave_sum(sm) * (1.f / D);
    float qq = 0.f;
#pragma unroll
    for (int i = 0; i < 4; ++i) { v[i] = v[i] - mu; qq += (v[i][0] * v[i][0] + v[i][1] * v[i][1]) + (v[i][2] * v[i][2] + v[i][3] * v[i][3]); }
    const float rs = rsqrtf(wave_sum(qq) * (1.f / D) + LN_EPS);
#pragma unroll
    for (int i = 0; i < 4; ++i) { const f32x4 gg = *(const f32x4*)(g + 4 * lane + 256 * i), b4 = *(const f32x4*)(bb + 4 * lane + 256 * i); v[i] = v[i] * rs * gg + b4; }
}
__device__ __forceinline__ int proj_dst_col(int src) {
    if (src < 1024) return src;
    if (src < 1040) return 3328 + 32 + (src - 1024);
    if (src < 1552) return 1024 + (src - 1040);
    if (src < 2064) return 1536 + (src - 1552);
    if (src < 2192) return 3072 + (src - 2064);
    if (src < 2320) return 3200 + (src - 2192);
    if (src < 2832) return 2560 + (src - 2320);
    if (src < 2864) return 3328 + (src - 2832);
    if (src < 2896) return 3328 + 128 + (src - 2864);
    if (src < 2904) return 3328 + 48 + (src - 2896);
    return 2048 + (src - 2904);
}
__device__ __forceinline__ void phase_prep(const Params& p_in, char* smem) {
    const Params p = kparams(); (void)p_in;
    const int tid = opaque_tid(), wid = tid >> 6, lane = tid & 63;
    bf16_t* WIN = (bf16_t*)(p.ws + OFF_WIN);
    bf16_t* WOUT = (bf16_t*)(p.ws + OFF_WOUT);
    float* H32 = (float*)(p.ws + OFF_H32);
    bf16_t* HB = (bf16_t*)(p.ws + OFF_HB);
    bf16_t* MIX = (bf16_t*)(p.ws + OFF_MIX);
    float2* ROPE = (float2*)(p.ws + OFF_ROPE);
    float (*tile)[65] = (float (*)[65])smem;
    constexpr int NCT_IN = (INW + 63) / 64, NT_IN = DEPTH * 16 * NCT_IN, NT_OUT = DEPTH * 16 * 16;
    for (int item = opaque_bid(); item < NT_IN + NT_OUT; item += gridDim.x) {
        const bool is_in = item < NT_IN;
        const int it = is_in ? item : item - NT_IN;
        const int nct = is_in ? NCT_IN : 16, ldw = is_in ? INW : D;
        const int l = it / (16 * nct), rem = it - l * 16 * nct, kt = rem / nct, ct = rem - kt * nct;
        const float* W = (is_in ? p.w_in : p.w_out) + (size_t)l * D * ldw;
        __syncthreads();
#pragma unroll
        for (int i = 0; i < 8; ++i) {
            const int e = tid + NT * i, kk = e >> 6, nn = e & 63, col = ct * 64 + nn;
            tile[kk][nn] = (col < ldw) ? W[(size_t)(kt * 64 + kk) * ldw + col] : 0.f;
        }
        __syncthreads();
        {
            const int nn = tid >> 3, k8 = (tid & 7) * 8, src = ct * 64 + nn;
            if (src < ldw) {
                const int dst = is_in ? proj_dst_col(src) : src;
                u32x4 o;
#pragma unroll
                for (int q = 0; q < 4; ++q) o[q] = cvt_pk_bf16(tile[k8 + 2 * q][nn], tile[k8 + 2 * q + 1][nn]);
                bf16_t* dstp = (is_in ? WIN + ((size_t)l * INWP + dst) * D : WOUT + ((size_t)l * D + dst) * D) + kt * 64 + k8;
                *(u32x4*)dstp = o;
            }
        }
    }
    {
        const int nw = gridDim.x * 8;
        for (int t = opaque_bid() * 8 + wid; t < TP; t += nw) {
            if (t < T) {
                const int b = t / L, pos = t - b * L;
                const float* src = (pos < NMETA) ? (p.meta + (size_t)pos * D) : (p.x + ((size_t)b * SEQ + (pos - NMETA)) * D);
                f32x4 v[4];
#pragma unroll
                for (int i = 0; i < 4; ++i) v[i] = *(const f32x4*)(src + 4 * lane + 256 * i);
                ln_row_wave(v, p.ln_in_g, p.ln_in_b, lane);
#pragma unroll
                for (int i = 0; i < 4; ++i) {
                    *(f32x4*)(H32 + (size_t)t * D + 4 * lane + 256 * i) = v[i];
                    u32x2 o; o[0] = cvt_pk_bf16(v[i][0], v[i][1]); o[1] = cvt_pk_bf16(v[i][2], v[i][3]);
                    *(u32x2*)(HB + (size_t)t * D + 4 * lane + 256 * i) = o;
                }
            } else {
#pragma unroll
                for (int i = 0; i < 4; ++i) {
                    *(u32x2*)(HB + (size_t)t * D + 4 * lane + 256 * i) = (u32x2){0u, 0u};
                    *(u32x2*)(MIX + (size_t)t * D + 4 * lane + 256 * i) = (u32x2){0u, 0u};
                }
            }
        }
    }
    for (int e = opaque_bid() * NT + tid; e < L * 8; e += gridDim.x * NT) {
        const int pos = e >> 3, i = e & 7;
        const float inv[8] = {1.0f, 0.19392274f, 0.03760603f, 0.0072926646f, 0.0014142136f, 0.0002742482f, 5.3182957e-05f, 1.0313385e-05f};
        float iv = inv[0];
#pragma unroll
        for (int j = 1; j < 8; ++j) iv = (i == j) ? inv[j] : iv;
        const float ang = (float)pos * iv;
        float sn, cs; sincos_acc(ang, sn, cs);
        ROPE[e] = make_float2(cs, sn);
    }
}

namespace pg8 {
constexpr int BM = 256, BK = 64, HALF = 128, HTB = HALF * BK * 2  , STAGE_BYTES = 8 * HTB, NXCD = 8, WGM = 8;
__device__ __forceinline__ int lds_byte(int r, int c) { const int st = (r >> 4) * 2 + (c >> 5), rr = r & 15, cc = c & 31, ob = rr * 64 + cc * 2; return st * 1024 + (ob ^ (((ob >> 9) & 1) << 5)); }
__device__ __forceinline__ void stage_rc(int b, int& R, int& C) { const int st = b / 1024, sb = b % 1024, swz = sb ^ (((sb >> 9) & 1) << 5); R = (st >> 1) * 16 + swz / 64; C = (st & 1) * 32 + (swz % 64) / 2; }
__device__ __forceinline__ int perm32(int rho) { const int n = rho >> 4, i = rho & 15; return 8 * (i >> 2) + 4 * n + (i & 3); }

struct Unit { int pm, pn; };
struct Gemm { const bf16_t* A; const bf16_t* Bt; int M, N, K; };

struct StaticOrder {
    int nM, nN, nwg, G, c;
    __device__ void init(int M, int N, int G_, int c_) { nM = M / BM; nN = N / BM; nwg = nM * nN; G = G_; c = c_; }
    __device__ bool next(int i, Unit& u) const {
        const long Lx = (long)i * G + c; if (Lx >= nwg) return false;
        int wgid = (int)Lx; { const int q = nwg / NXCD, r = nwg % NXCD, xcd = wgid % NXCD, off = wgid / NXCD; wgid = (xcd < r ? xcd * (q + 1) : r * (q + 1) + (xcd - r) * q) + off; }
        const int nig = WGM * nN, gid = wgid / nig, fm = gid * WGM, gsz = (nM - fm) < WGM ? (nM - fm) : WGM;
        u.pm = fm + ((wgid % nig) % gsz); u.pn = (wgid % nig) / gsz; return true;
    }
    __device__ __forceinline__ void a_ready(const Unit&) const {}
    __device__ __forceinline__ void done(const Unit&) const {}
};

template <class Epi, class Sched>
__device__ __forceinline__ void gemm_phase(LAS unsigned char* lds, const Gemm g, const Sched& S, const Epi& E) {
    const int tid = opaque_tid(), wid = __builtin_amdgcn_readfirstlane(tid >> 6), lane = tid & 63, wr = wid >> 2, wc = wid & 3, fr = lane & 15, fq = lane >> 4;
    const int K = g.K, nt = K / BK;
    unsigned voffA[2], voffB[2];
#pragma unroll
    for (int i = 0; i < 2; ++i) { int R, C; stage_rc(tid * 16 + i * 8192, R, C); const int Rb = Epi::PERM ? ((R & ~31) + perm32(R & 31)) : R;
        voffA[i] = (unsigned)(R * K + C) * 2u; voffB[i] = (unsigned)(Rb * K + C) * 2u; }
    const size_t kstep = (size_t)(BK * 2);
    const size_t hstep = (size_t)HALF * K * 2;
    const size_t tstep = 2 * hstep;
    const unsigned ldsw = (unsigned)wid * 1024u;
    const int aoff = lds_byte(wr * 64 + fr, fq * 8), boff = lds_byte(wc * 32 + fr, fq * 8);
#define PG8_SA(b, h) (((b) * 2 + (h)) * HTB)
#define PG8_SB(b, h) ((4 + (b) * 2 + (h)) * HTB)
#define PG8_STAGE(bufoff, gbase, voff) do { _Pragma("unroll") for (int _i = 0; _i < 2; ++_i) \
        __builtin_amdgcn_global_load_lds((const unsigned*)((const char*)(gbase) + (voff)[_i]), (LAS unsigned*)(lds + (bufoff) + ldsw + _i * 8192), 16, 0, 0); } while (0)
#define PG8_LDA(dst, b, h) do { _Pragma("unroll") for (int m = 0; m < 4; ++m) _Pragma("unroll") for (int k = 0; k < 2; ++k) dst[m][k] = *(const LAS bf16x8*)(lds + PG8_SA(b, h) + aoff + m * 2048 + k * 1024); } while (0)
#define PG8_LDB(dst, b, h) do { _Pragma("unroll") for (int n = 0; n < 2; ++n) _Pragma("unroll") for (int k = 0; k < 2; ++k) dst[n][k] = *(const LAS bf16x8*)(lds + PG8_SB(b, h) + boff + n * 2048 + k * 1024); } while (0)
#define PG8_MMA(ai, bj, At, Bt) do { __builtin_amdgcn_s_setprio(1); _Pragma("unroll") for (int m = 0; m < 4; ++m) _Pragma("unroll") for (int n = 0; n < 2; ++n) _Pragma("unroll") for (int k = 0; k < 2; ++k) \
        acc[ai][bj][m][n] = __builtin_amdgcn_mfma_f32_16x16x32_bf16(Bt[n][k], At[m][k], acc[ai][bj][m][n], 0, 0, 0); __builtin_amdgcn_s_setprio(0); } while (0)
#define PG8_WAIT_V(n) asm volatile("s_waitcnt vmcnt(" #n ")" ::: "memory")
#define PG8_WAIT_L(n) asm volatile("s_waitcnt lgkmcnt(" #n ")" ::: "memory")
#define PG8_BAR __builtin_amdgcn_s_barrier()
#define PG8_SCHED __builtin_amdgcn_sched_barrier(0)
    Unit cur, nxt; int ui = 0;
    if (!S.next(0, cur)) return;
    f32x4 acc[2][2][4][2];
#pragma unroll
    for (int a = 0; a < 2; ++a)
#pragma unroll
        for (int b = 0; b < 2; ++b)
#pragma unroll
            for (int m = 0; m < 4; ++m)
#pragma unroll
                for (int n = 0; n < 2; ++n) acc[a][b][m][n] = (f32x4){0.f, 0.f, 0.f, 0.f};
    bf16x8 At[4][2], B0[2][2], B1[2][2];
    const char* cA = (const char*)g.A + (size_t)cur.pm * tstep; const char* cB = (const char*)g.Bt + (size_t)cur.pn * tstep;
    S.a_ready(cur);
    PG8_STAGE(PG8_SB(0, 0), cB, voffB); PG8_STAGE(PG8_SA(0, 0), cA, voffA); PG8_STAGE(PG8_SB(0, 1), cB + hstep, voffB); PG8_STAGE(PG8_SA(0, 1), cA + hstep, voffA);
    if (wr == 1) PG8_BAR;
    PG8_WAIT_V(4); PG8_BAR;
    PG8_STAGE(PG8_SB(1, 0), cB + kstep, voffB); PG8_STAGE(PG8_SA(1, 0), cA + kstep, voffA); PG8_STAGE(PG8_SB(1, 1), cB + hstep + kstep, voffB);
    PG8_WAIT_V(6); PG8_BAR;
    for (;;) {
        const bool has_next = S.next(ui + 1, nxt);
        const char* nA = has_next ? (const char*)g.A + (size_t)nxt.pm * tstep : cA; const char* nB = has_next ? (const char*)g.Bt + (size_t)nxt.pn * tstep : cB;
        for (int t = 0; t < nt; t += 2) {
            const bool last = (t == nt - 2);
            const char* a1 = cA + (size_t)(t + 1) * kstep;
            const char* a2 = last ? nA : cA + (size_t)(t + 2) * kstep; const char* b2 = last ? nB : cB + (size_t)(t + 2) * kstep;
            const char* a3 = a2 + kstep; const char* b3 = b2 + kstep;
            if (last && has_next) S.a_ready(nxt);
            PG8_LDB(B0, 0, 0); PG8_SCHED; PG8_LDA(At, 0, 0); PG8_STAGE(PG8_SA(1, 1), a1 + hstep, voffA);
            PG8_WAIT_L(8); PG8_BAR; PG8_WAIT_L(0); PG8_MMA(0, 0, At, B0); PG8_BAR; PG8_SCHED;
            PG8_LDB(B1, 0, 1); PG8_STAGE(PG8_SB(0, 0), b2, voffB);
            PG8_BAR; PG8_WAIT_L(0); PG8_MMA(0, 1, At, B1); PG8_BAR;
            PG8_LDA(At, 0, 1); PG8_STAGE(PG8_SA(0, 0), a2, voffA);
            PG8_BAR; PG8_WAIT_L(0); PG8_MMA(1, 0, At, B0); PG8_BAR; PG8_SCHED;
            PG8_STAGE(PG8_SB(0, 1), b2 + hstep, voffB);
            PG8_WAIT_V(6); PG8_BAR; PG8_MMA(1, 1, At, B1); PG8_BAR;
            PG8_LDB(B0, 1, 0); PG8_SCHED; PG8_LDA(At, 1, 0); PG8_STAGE(PG8_SA(0, 1), a2 + hstep, voffA);
            PG8_WAIT_L(8); PG8_BAR; PG8_WAIT_L(0); PG8_MMA(0, 0, At, B0); PG8_BAR; PG8_SCHED;
            PG8_LDB(B1, 1, 1); PG8_STAGE(PG8_SB(1, 0), b3, voffB);
            PG8_BAR; PG8_WAIT_L(0); PG8_MMA(0, 1, At, B1); PG8_BAR;
            PG8_LDA(At, 1, 1); PG8_STAGE(PG8_SA(1, 0), a3, voffA);
            PG8_BAR; PG8_WAIT_L(0); PG8_MMA(1, 0, At, B0); PG8_BAR; PG8_SCHED;
            PG8_STAGE(PG8_SB(1, 1), b3 + hstep, voffB);
            PG8_WAIT_V(6); PG8_BAR; PG8_MMA(1, 1, At, B1); PG8_BAR;
        }
        E(acc, cur, wr, wc, fr, fq); S.done(cur);
        if (!has_next) break;
#pragma unroll
        for (int a = 0; a < 2; ++a)
#pragma unroll
            for (int b = 0; b < 2; ++b)
#pragma unroll
                for (int m = 0; m < 4; ++m)
#pragma unroll
                    for (int n = 0; n < 2; ++n) acc[a][b][m][n] = (f32x4){0.f, 0.f, 0.f, 0.f};
        cur = nxt; cA = nA; cB = nB; ++ui;
    }
    PG8_WAIT_V(0);
    if (wr == 0) PG8_BAR;
    PG8_BAR;
#undef PG8_SA
#undef PG8_SB
#undef PG8_STAGE
#undef PG8_LDA
#undef PG8_LDB
#undef PG8_MMA
#undef PG8_WAIT_V
#undef PG8_WAIT_L
#undef PG8_BAR
#undef PG8_SCHED
}
}

struct EpiProj {
    static constexpr bool PERM = true;
    char* ws;
    __device__ __forceinline__ void store8(bf16_t* dst, const f32x4& a, const f32x4& b, float sc) const {
        u32x4 o; o[0] = cvt_pk_bf16(a[0] * sc, a[1] * sc); o[1] = cvt_pk_bf16(a[2] * sc, a[3] * sc); o[2] = cvt_pk_bf16(b[0] * sc, b[1] * sc); o[3] = cvt_pk_bf16(b[2] * sc, b[3] * sc);
        *(u32x4*)dst = o;
    }
    __device__ __forceinline__ void operator()(const f32x4 (&acc)[2][2][4][2], const pg8::Unit& u, int wr, int wc, int fr, int fq) const {
        asm volatile("" : "+v"(fr), "+v"(fq));
        if (u.pn < 13) {
#pragma unroll
            for (int bj = 0; bj < 2; ++bj) {
                const int hb = 4 * u.pn + 2 * bj + (wc >> 1);
                const int cc8 = 32 * (wc & 1) + 8 * fq;
#pragma unroll
                for (int ai = 0; ai < 2; ++ai)
#pragma unroll
                    for (int m = 0; m < 4; ++m) {
                        const int t = 256 * u.pm + 128 * ai + 64 * wr + 16 * m + fr;
                        const f32x4 v0 = acc[ai][bj][m][0], v1 = acc[ai][bj][m][1];
                        if (t < T) {
                            const size_t tt = (size_t)t;
                            if (hb < 4) store8((bf16_t*)(ws + OFF_GQ) + tt * 256 + hb * 64 + cc8, v0, v1, 0.125f);
                            else if (hb < 8) store8((bf16_t*)(ws + OFF_GK) + tt * 256 + (hb - 4) * 64 + cc8, v0, v1, 1.f);
                            else if (hb < 16) {
                                const int bq = t / L, pos = t - bq * L;
                                bf16_t* dst = (bf16_t*)(ws + OFF_GV) + ((size_t)(bq * 4 + ((hb - 8) >> 1)) * 128 + ((hb - 8) & 1) * 64 + cc8) * LPV + 48 + pos;
#pragma unroll
                                for (int j = 0; j < 4; ++j) { dst[(size_t)j * LPV] = f2bf(v0[j]); dst[(size_t)(4 + j) * LPV] = f2bf(v1[j]); }
                            }
                            else if (hb < 24 || (hb >= 32 && hb < 40)) {
                                f32x4 s0, s1;
#pragma unroll
                                for (int j = 0; j < 4; ++j) { s0[j] = silu_f(v0[j]); s1[j] = silu_f(v1[j]); }
                                const int col = (hb < 24) ? (hb - 16) * 64 : 512 + (hb - 32) * 64;
                                store8((bf16_t*)(ws + OFF_MIX) + tt * 1024 + col + cc8, s0, s1, 1.f);
                            }
                            else if (hb < 32) store8((bf16_t*)(ws + OFF_AQ) + tt * 512 + (hb - 24) * 64 + cc8, v0, v1, 0.125f);
                            else if (hb < 48) store8((bf16_t*)(ws + OFF_IQ) + tt * 512 + (hb - 40) * 64 + cc8, v0, v1, 0.125f);
                            else if (hb < 50) store8((bf16_t*)(ws + OFF_AK) + tt * 128 + (hb - 48) * 64 + cc8, v0, v1, 1.f);
                            else {
                                const int bq = t / L, pos = t - bq * L;
                                bf16_t* dst = (bf16_t*)(ws + OFF_AV) + ((size_t)(bq * 2 + (hb - 50)) * 64 + cc8) * LP + pos;
#pragma unroll
                                for (int j = 0; j < 4; ++j) { dst[(size_t)j * LP] = f2bf(v0[j]); dst[(size_t)(4 + j) * LP] = f2bf(v1[j]); }
                            }
                        }
                        asm volatile("" ::: "memory");
                    }
            }
        } else {
#pragma unroll
            for (int ai = 0; ai < 2; ++ai)
#pragma unroll
                for (int m = 0; m < 4; ++m) {
                    const int t = 256 * u.pm + 128 * ai + 64 * wr + 16 * m + fr;
                    if (t < T) {
                        if (wc == 0) {
                            float* dst = (float*)(ws + OFF_IKR) + (size_t)t * 64 + 8 * fq;
                            *(f32x4*)dst = acc[ai][0][m][0]; *(f32x4*)(dst + 4) = acc[ai][0][m][1];
                            *(f32x4*)(dst + 32) = acc[ai][1][m][0]; *(f32x4*)(dst + 36) = acc[ai][1][m][1];
                        } else if (wc == 1) {
                            const f32x4 v0 = acc[ai][0][m][0], v1 = acc[ai][0][m][1];
                            if (fq < 2) {
                                float* dst = (float*)(ws + OFF_GLR) + (size_t)t * 16 + 8 * fq;
                                *(f32x4*)dst = v0; *(f32x4*)(dst + 4) = v1;
                            } else if (fq == 2) {
                                float* dst = (float*)(ws + OFF_IW) + (size_t)t * 8;
                                *(f32x4*)dst = v0 * 0.353553390593273762f; *(f32x4*)(dst + 4) = v1 * 0.353553390593273762f;
                            }
                        }
                    }
                    asm volatile("" ::: "memory");
                }
        }
    }
};

struct EpiOut {
    static constexpr bool PERM = false;
    const float* H32; float* Z;
    __device__ __forceinline__ void operator()(const f32x4 (&acc)[2][2][4][2], const pg8::Unit& u, int wr, int wc, int fr, int fq) const {
        asm volatile("" : "+v"(fr), "+v"(fq));
        const int col0 = u.pn * 256 + wc * 32 + 4 * fq;
#pragma unroll
        for (int ai = 0; ai < 2; ++ai) {
            f32x4 hv[4][2][2];
#pragma unroll
            for (int m = 0; m < 4; ++m) {
                int t = 256 * u.pm + 128 * ai + 64 * wr + 16 * m + fr; t = t < T ? t : T - 1;
                const size_t off = (size_t)t * D + col0;
#pragma unroll
                for (int bj = 0; bj < 2; ++bj)
#pragma unroll
                    for (int n = 0; n < 2; ++n) hv[m][bj][n] = *(const f32x4*)(H32 + off + bj * 128 + n * 16);
            }
#pragma unroll
            for (int m = 0; m < 4; ++m) {
                const int t = 256 * u.pm + 128 * ai + 64 * wr + 16 * m + fr;
                if (t < T) {
                    const size_t off = (size_t)t * D + col0;
#pragma unroll
                    for (int bj = 0; bj < 2; ++bj)
#pragma unroll
                        for (int n = 0; n < 2; ++n) *(f32x4*)(Z + off + bj * 128 + n * 16) = acc[ai][bj][m][n] + hv[m][bj][n] * ALPHA;
                }
            }
            asm volatile("" ::: "memory");
        }
    }
};

__device__ __forceinline__ void phase_proj(const Params& p_in, int layer_in, char* smem) {
    const Params p = kparams(); const int layer = opaque_int(layer_in); (void)p_in;
    pg8::Gemm g; g.A = (const bf16_t*)(p.ws + OFF_HB); g.Bt = (const bf16_t*)(p.ws + OFF_WIN) + (size_t)layer * INWP * D; g.M = TP; g.N = INWP; g.K = D;
    pg8::StaticOrder S; S.init(TP, INWP, gridDim.x, opaque_bid());
    EpiProj E; E.ws = p.ws;
    pg8::gemm_phase((LAS unsigned char*)smem, g, S, E);
}
__device__ __forceinline__ void phase_outproj(const Params& p_in, int layer_in, char* smem) {
    const Params p = kparams(); const int layer = opaque_int(layer_in); (void)p_in;
    pg8::Gemm g; g.A = (const bf16_t*)(p.ws + OFF_MIX); g.Bt = (const bf16_t*)(p.ws + OFF_WOUT) + (size_t)layer * D * D; g.M = TP; g.N = D; g.K = D;
    pg8::StaticOrder S; S.init(TP, D, gridDim.x, opaque_bid());
    EpiOut E; E.H32 = (const float*)(p.ws + OFF_H32); E.Z = (float*)(p.ws + OFF_GQ);
    pg8::gemm_phase((LAS unsigned char*)smem, g, S, E);
}

__device__ __forceinline__ void phase_gla_naive(const Params& p, int layer, char* smem) {
    float (*qs)[64] = (float (*)[64])smem;
    float (*ks)[64] = qs + 8;
    float (*es)[64] = ks + 8;
    float (*part)[8] = (float (*)[8])(es + 8);
    float (*os)[128] = (float (*)[128])(part + 2);
    const int tid = opaque_tid();
    const bf16_t* GQ = (const bf16_t*)(p.ws + OFF_GQ);
    const bf16_t* GK = (const bf16_t*)(p.ws + OFF_GK);
    const bf16_t* GV = (const bf16_t*)(p.ws + OFF_GV);
    const float* GLR = (const float*)(p.ws + OFF_GLR);
    bf16_t* MIX = (bf16_t*)(p.ws + OFF_MIX);
    const float* ng = p.norm_g + layer * 128;
    const float* wg2 = p.wg2 + (size_t)layer * 16 * 256; const float* bg = p.bg + layer * 256;
    for (int item = opaque_bid(); item < NB * 4; item += gridDim.x) {
        const int b = item >> 2, h = item & 3;
        float S[64];
#pragma unroll
        for (int d = 0; d < 64; ++d) S[d] = 0.f;
        const int e = tid & 127;
        const float nge = ng[e];
        const int ltt = tid >> 6, ld = tid & 63;
        float w[16];
#pragma unroll
        for (int rr = 0; rr < 16; ++rr) w[rr] = wg2[rr * 256 + h * 64 + ld];
        const float bgd = bg[h * 64 + ld];
        for (int t0 = 0; t0 < L; t0 += 8) {
            __syncthreads();
            {
                const size_t row = (size_t)b * L + t0 + ltt;
                qs[ltt][ld] = bf2f(GQ[row * 256 + h * 64 + ld]);
                ks[ltt][ld] = bf2f(GK[row * 256 + h * 64 + ld]);
                const float4* gp = (const float4*)&GLR[row * 16];
                const float4 g0 = gp[0], g1 = gp[1], g2 = gp[2], g3 = gp[3];
                float s = bgd;
                s = fmaf(g0.x, w[0], s); s = fmaf(g0.y, w[1], s); s = fmaf(g0.z, w[2], s); s = fmaf(g0.w, w[3], s);
                s = fmaf(g1.x, w[4], s); s = fmaf(g1.y, w[5], s); s = fmaf(g1.z, w[6], s); s = fmaf(g1.w, w[7], s);
                s = fmaf(g2.x, w[8], s); s = fmaf(g2.y, w[9], s); s = fmaf(g2.z, w[10], s); s = fmaf(g2.w, w[11], s);
                s = fmaf(g3.x, w[12], s); s = fmaf(g3.y, w[13], s); s = fmaf(g3.z, w[14], s); s = fmaf(g3.w, w[15], s);
                es[ltt][ld] = expf(logsigmoid_f(s) * (1.f / 16.f));
            }
            __syncthreads();
            if (tid < 128) {
#pragma unroll 1
                for (int tt = 0; tt < 8; ++tt) {
                    const size_t row = (size_t)b * L + t0 + tt;
                    const float v = bf2f(GV[row * 512 + h * 128 + e]);
                    float acc = 0.f;
#pragma unroll
                    for (int d = 0; d < 64; ++d) {
                        S[d] = fmaf(es[tt][d], S[d], ks[tt][d] * v);
                        acc = fmaf(qs[tt][d], S[d], acc);
                    }
                    os[tt][e] = acc;
                    const float ss = wave_sum(acc * acc);
                    if ((tid & 63) == 0) part[tid >> 6][tt] = ss;
                }
            }
            __syncthreads();
            if (tid < 128) {
#pragma unroll 1
                for (int tt = 0; tt < 8; ++tt) {
                    const size_t row = (size_t)b * L + t0 + tt;
                    const float tot = part[0][tt] + part[1][tt];
                    const float rinv = rsqrtf(tot * (1.f / 128) + LN_EPS);
                    const size_t idx = row * 1024 + h * 128 + e;
                    MIX[idx] = f2bf(os[tt][e] * rinv * nge * bf2f(MIX[idx]));
                }
            }
        }
    }
}

__device__ __forceinline__ unsigned okey(float x) {
    const unsigned u = __float_as_uint(x);
    return (u & 0x80000000u) ? ~u : (u | 0x80000000u);
}
__device__ __forceinline__ int wave_incl_scan(int v) {
    const int lane = opaque_tid() & 63;
#pragma unroll
    for (int o = 1; o < 64; o <<= 1) { const int n = __shfl_up(v, o); if (lane >= o) v += n; }
    return v;
}
__device__ __forceinline__ int block_excl_scan(int v, int* tmp) {
    const int incl = wave_incl_scan(v);
    const int tq = opaque_tid();
    __syncthreads();
    if ((tq & 63) == 63) tmp[tq >> 6] = incl;
    __syncthreads();
    const int w = tq >> 6;
    int base = 0;
    for (int i = 0; i < w; ++i) base += tmp[i];
    return base + incl - v;
}
__device__ __forceinline__ void unpack8(const uint4 u, float* kf) {
    kf[0] = __uint_as_float(u.x << 16); kf[1] = __uint_as_float(u.x & 0xFFFF0000u);
    kf[2] = __uint_as_float(u.y << 16); kf[3] = __uint_as_float(u.y & 0xFFFF0000u);
    kf[4] = __uint_as_float(u.z << 16); kf[5] = __uint_as_float(u.z & 0xFFFF0000u);
    kf[6] = __uint_as_float(u.w << 16); kf[7] = __uint_as_float(u.w & 0xFFFF0000u);
}

__device__ __forceinline__ void phase_dsa_naive(const Params& p, int layer, char* smem) {
    float* sc = (float*)smem;
    float (*iqs)[64] = (float (*)[64])(sc + 2080);
    float (*aqs)[64] = iqs + 8;
    float (*lg)[256] = (float (*)[256])(aqs + 8);
    unsigned* hist = (unsigned*)(lg + 8);
    int* sel = (int*)(hist + 256);
    int* misc = sel + 256;
    const int tid = opaque_tid();
    const bf16_t* IQ = (const bf16_t*)(p.ws + OFF_IQ);
    const bf16_t* IK = (const bf16_t*)(p.ws + OFF_IK);
    const float* IW = (const float*)(p.ws + OFF_IW);
    const bf16_t* AQ = (const bf16_t*)(p.ws + OFF_AQ);
    const bf16_t* AK = (const bf16_t*)(p.ws + OFF_AK);
    const bf16_t* AV = (const bf16_t*)(p.ws + OFF_AV);
    bf16_t* MIX = (bf16_t*)(p.ws + OFF_MIX);
    for (int item = opaque_bid(); item < T; item += gridDim.x) {
        const int b = item / L, t = item % L;
        const size_t row = (size_t)item;
        __syncthreads();
        iqs[tid >> 6][tid & 63] = bf2f(IQ[row * 512 + tid]); aqs[tid >> 6][tid & 63] = bf2f(AQ[row * 512 + tid]);
        __syncthreads();
        float w[8];
#pragma unroll
        for (int j = 0; j < 8; ++j) w[j] = IW[row * 8 + j];
        for (int s = tid; s <= t; s += NT) {
            const uint4* kp = (const uint4*)&IK[((size_t)b * L + s) * 64];
            float dd[8];
#pragma unroll
            for (int j = 0; j < 8; ++j) dd[j] = 0.f;
#pragma unroll 1
            for (int q = 0; q < 8; ++q) {
                float kf[8]; unpack8(kp[q], kf);
#pragma unroll
                for (int j = 0; j < 8; ++j) {
                    const float4 a0 = *(const float4*)&iqs[j][q * 8], a1 = *(const float4*)&iqs[j][q * 8 + 4];
                    dd[j] = fmaf(a0.x, kf[0], dd[j]); dd[j] = fmaf(a0.y, kf[1], dd[j]); dd[j] = fmaf(a0.z, kf[2], dd[j]); dd[j] = fmaf(a0.w, kf[3], dd[j]);
                    dd[j] = fmaf(a1.x, kf[4], dd[j]); dd[j] = fmaf(a1.y, kf[5], dd[j]); dd[j] = fmaf(a1.z, kf[6], dd[j]); dd[j] = fmaf(a1.w, kf[7], dd[j]);
                }
            }
            float score = 0.f;
#pragma unroll
            for (int j = 0; j < 8; ++j) score = fmaf(w[j], fmaxf(dd[j], 0.f), score);
            sc[s] = score;
        }
        __syncthreads();
        const int n = t + 1;
        int nsel;
        if (n <= TOPK) {
            if (tid < n) sel[tid] = tid;
            nsel = n;
        } else {
            unsigned prefix = 0; int remaining = TOPK;
            for (int pass = 0; pass < 4; ++pass) {
                const int shift = 24 - 8 * pass;
                if (tid < 256) hist[tid] = 0;
                __syncthreads();
                for (int s = tid; s < n; s += NT) {
                    const unsigned key = okey(sc[s]);
                    const bool match = (pass == 0) || ((key >> (shift + 8)) == prefix);
                    if (match) atomicAdd(&hist[(key >> shift) & 255u], 1u);
                }
                __syncthreads();
                if (tid == 0) {
                    int cum = 0, d = 255;
                    for (; d > 0; --d) { const int c = (int)hist[d]; if (cum + c >= remaining) break; cum += c; }
                    misc[0] = d; misc[1] = remaining - cum;
                }
                __syncthreads();
                prefix = (prefix << 8) | (unsigned)misc[0]; remaining = misc[1];
                __syncthreads();
            }
            const int s0 = tid * 5;
            int ceq = 0;
#pragma unroll
            for (int q = 0; q < 5; ++q) { const int s = s0 + q; if (s < n && okey(sc[s]) == prefix) ++ceq; }
            int eqrank = block_excl_scan(ceq, misc + 8);
            int csel = 0; unsigned selmask = 0;
#pragma unroll
            for (int q = 0; q < 5; ++q) {
                const int s = s0 + q;
                if (s < n) {
                    const unsigned key = okey(sc[s]);
                    bool take = key > prefix;
                    if (key == prefix) { take = eqrank < remaining; ++eqrank; }
                    if (take) { ++csel; selmask |= 1u << q; }
                }
            }
            int posn = block_excl_scan(csel, misc + 16);
#pragma unroll
            for (int q = 0; q < 5; ++q) if (selmask & (1u << q)) { if (posn < TOPK) sel[posn] = s0 + q; ++posn; }
            nsel = TOPK;
        }
        __syncthreads();
        {
            const int i = tid & 255, g = tid >> 8;
            if (i < nsel) {
                const int kidx = sel[i];
                const uint4* kp = (const uint4*)&AK[((size_t)b * L + kidx) * 128 + g * 64];
                float dd[4] = {0.f, 0.f, 0.f, 0.f};
#pragma unroll 1
                for (int q = 0; q < 8; ++q) {
                    float kf[8]; unpack8(kp[q], kf);
#pragma unroll
                    for (int r = 0; r < 4; ++r) {
                        const float4 a0 = *(const float4*)&aqs[g * 4 + r][q * 8], a1 = *(const float4*)&aqs[g * 4 + r][q * 8 + 4];
                        dd[r] = fmaf(a0.x, kf[0], dd[r]); dd[r] = fmaf(a0.y, kf[1], dd[r]); dd[r] = fmaf(a0.z, kf[2], dd[r]); dd[r] = fmaf(a0.w, kf[3], dd[r]);
                        dd[r] = fmaf(a1.x, kf[4], dd[r]); dd[r] = fmaf(a1.y, kf[5], dd[r]); dd[r] = fmaf(a1.z, kf[6], dd[r]); dd[r] = fmaf(a1.w, kf[7], dd[r]);
                    }
                }
#pragma unroll
                for (int r = 0; r < 4; ++r) lg[g * 4 + r][i] = dd[r];
            } else {
#pragma unroll
                for (int r = 0; r < 4; ++r) lg[g * 4 + r][i] = -INFINITY;
            }
        }
        __syncthreads();
        {
            const int h = tid >> 6, lane = tid & 63;
            float v0 = lg[h][lane], v1 = lg[h][lane + 64], v2 = lg[h][lane + 128], v3 = lg[h][lane + 192];
            const float m = wave_max(fmaxf(fmaxf(v0, v1), fmaxf(v2, v3)));
            v0 = expf(v0 - m); v1 = expf(v1 - m); v2 = expf(v2 - m); v3 = expf(v3 - m);
            const float inv = 1.f / wave_sum(v0 + v1 + v2 + v3);
            lg[h][lane] = v0 * inv; lg[h][lane + 64] = v1 * inv; lg[h][lane + 128] = v2 * inv; lg[h][lane + 192] = v3 * inv;
        }
        __syncthreads();
        {
            const int h = tid >> 6, d = tid & 63, g = h >> 2;
            float o = 0.f;
            for (int i = 0; i < nsel; ++i) o = fmaf(lg[h][i], bf2f(AV[((size_t)b * L + sel[i]) * 128 + g * 64 + d]), o);
            const size_t mi = row * 1024 + 512 + tid;
            MIX[mi] = f2bf(o * bf2f(MIX[mi]));
        }
    }
}


constexpr int DS_SC = 0, DS_BITS = 132096, DS_HIST = DS_BITS + 4224, DS_END = DS_HIST + 8 * 1040;
constexpr int DS_MB = 3 * 32768, DS_MBROW = 2112;
static_assert(DS_MB + 16 * DS_MBROW <= DS_BITS, "mask bytes overlap");


template <int NR>
__device__ __forceinline__ void dsa_select(const LAS unsigned* row, LAS unsigned* bits, LAS unsigned* hist, int n, int lane) {
    unsigned kreg[NR];
#pragma unroll
    for (int i = 0; i < NR; ++i) kreg[i] = (lane < n - 64 * i) ? row[lane + 64 * i] : 0u;
    unsigned prefix = 0; int remaining = TOPK;
#pragma unroll 1
    for (int pass = 0; pass < 4; ++pass) {
        const int shift = 24 - 8 * pass;
        *(LAS u32x4*)(hist + lane * 4) = (u32x4){0u, 0u, 0u, 0u};
        __builtin_amdgcn_wave_barrier(); asm volatile("" ::: "memory");
        const unsigned sh8 = (unsigned)(shift + 8) & 31u;
#pragma unroll
        for (int i = 0; i < NR; ++i) {
            const unsigned key = kreg[i];
            const bool match = (lane < n - 64 * i) && ((pass == 0) || ((key >> sh8) == prefix));
            if (match) __hip_atomic_fetch_add(hist + ((key >> shift) & 255u), 1u, __ATOMIC_RELAXED, __HIP_MEMORY_SCOPE_WAVEFRONT);
        }
        __builtin_amdgcn_wave_barrier(); asm volatile("s_waitcnt lgkmcnt(0)" ::: "memory");
        const u32x4 hv = *(const LAS u32x4*)(hist + (63 - lane) * 4);
        const int c0 = (int)hv[3], c1 = (int)hv[2], c2 = (int)hv[1], c3 = (int)hv[0];
        const int tot = c0 + c1 + c2 + c3;
        const int incl = wave_incl_scan(tot), excl = incl - tot;
        const bool found = (excl < remaining) && (remaining <= incl);
        int digit = 0, rem_new = 0;
        if (found) {
            int cum = excl;
            if (cum + c0 >= remaining) { digit = 255 - 4 * lane; rem_new = remaining - cum; }
            else { cum += c0;
                if (cum + c1 >= remaining) { digit = 254 - 4 * lane; rem_new = remaining - cum; }
                else { cum += c1;
                    if (cum + c2 >= remaining) { digit = 253 - 4 * lane; rem_new = remaining - cum; }
                    else { cum += c2; digit = 252 - 4 * lane; rem_new = remaining - cum; } } }
        }
        const unsigned long long fm = __ballot(found);
        const int src = (int)__builtin_ctzll(fm);
        digit = __builtin_amdgcn_readlane(digit, src); rem_new = __builtin_amdgcn_readlane(rem_new, src);
        prefix = (prefix << 8) | (unsigned)digit; remaining = rem_new;
    }
    const unsigned tkey = prefix;
    int eqcount = 0;
#pragma unroll
    for (int i = 0; i < 33; ++i) {
        if (i < NR) {
            const unsigned key = kreg[i < NR ? i : 0];
            const bool valid = lane < n - 64 * i;
            const bool gt = valid && (key > tkey), eq = valid && (key == tkey);
            const unsigned long long em = __ballot(eq);
            const int rank = eqcount + __popcll(em & ((1ull << lane) - 1ull));
            const bool sel = gt || (eq && rank < remaining);
            eqcount += __popcll(em);
            const unsigned long long sm = __ballot(sel);
            if (lane == 0) { bits[2 * i] = (unsigned)sm; bits[2 * i + 1] = (unsigned)(sm >> 32); }
        } else if (lane == 0) { bits[2 * i] = 0u; bits[2 * i + 1] = 0u; }
    }
}

__device__ __forceinline__ void phase_dsa(const Params& p_in, int layer_in, char* smem, bool do_store) {
    const Params p = kparams(); const int layer = opaque_int(layer_in); (void)p_in;
    const int tid = opaque_tid(), wid = __builtin_amdgcn_readfirstlane(tid >> 6), lane = tid & 63, fr = lane & 15, fq = lane >> 4;
    LAS unsigned char* lds = (LAS unsigned char*)smem;
    const bf16_t* IQ = (const bf16_t*)(p.ws + OFF_IQ);
    const bf16_t* IK = (const bf16_t*)(p.ws + OFF_IK);
    const float* IW = (const float*)(p.ws + OFF_IW);
    const bf16_t* AQ = (const bf16_t*)(p.ws + OFF_AQ);
    const bf16_t* AK = (const bf16_t*)(p.ws + OFF_AK);
    const bf16_t* AVT = (const bf16_t*)(p.ws + OFF_AV);
    bf16_t* MIX = (bf16_t*)(p.ws + OFF_MIX);
    constexpr int NITEM = NB * 129;
    for (int idx = opaque_bid(); idx < NITEM; idx += gridDim.x) {
        const int b = idx & 7, mm = idx >> 3;
        int qr;
        { const int seg = mm >> 5, jj = mm & 31; qr = (seg == 0) ? jj : (seg == 1) ? 63 - jj : (seg == 2) ? 64 + jj : (seg == 3) ? 127 - jj : 128; }
        const int qt = 128 - qr, t0 = qt * 16;
        const size_t rowq = (size_t)b * L + t0 + fr;
        __syncthreads();
        for (int repA = 0; repA < PROBE_DSA_A; ++repA) {
            bf16x8 qf[8][2];
#pragma unroll
            for (int jh = 0; jh < 8; ++jh)
#pragma unroll
                for (int s2 = 0; s2 < 2; ++s2) qf[jh][s2] = *(const bf16x8*)(IQ + rowq * 512 + jh * 64 + s2 * 32 + fq * 8);
            float w[8];
            { const f32x4 w0 = *(const f32x4*)(IW + rowq * 8), w1 = *(const f32x4*)(IW + rowq * 8 + 4);
              w[0] = w0[0]; w[1] = w0[1]; w[2] = w0[2]; w[3] = w0[3]; w[4] = w1[0]; w[5] = w1[1]; w[6] = w1[2]; w[7] = w1[3]; }
            const int ntile = qt + 1;
            const bf16x8 z8 = {0, 0, 0, 0, 0, 0, 0, 0};
            bf16x8 ka0 = z8, ka1 = z8, kb0 = z8, kb1 = z8, kc0 = z8, kc1 = z8;
            int kt = wid;
            if (kt < ntile) { const bf16_t* kp = IK + ((size_t)b * L + 16 * kt + fr) * 64 + fq * 8; ka0 = *(const bf16x8*)kp; ka1 = *(const bf16x8*)(kp + 32); }
            if (kt + 8 < ntile) { const bf16_t* kp = IK + ((size_t)b * L + 16 * (kt + 8) + fr) * 64 + fq * 8; kb0 = *(const bf16x8*)kp; kb1 = *(const bf16x8*)(kp + 32); }
            for (; kt < ntile; kt += 8) {
                if (kt + 16 < ntile) { const bf16_t* kp = IK + ((size_t)b * L + 16 * (kt + 16) + fr) * 64 + fq * 8; kc0 = *(const bf16x8*)kp; kc1 = *(const bf16x8*)(kp + 32); }
                f32x4 sc = {0.f, 0.f, 0.f, 0.f};
#pragma unroll
                for (int jh = 0; jh < 8; ++jh) {
                    f32x4 d = {0.f, 0.f, 0.f, 0.f};
                    d = __builtin_amdgcn_mfma_f32_16x16x32_bf16(ka0, qf[jh][0], d, 0, 0, 0);
                    d = __builtin_amdgcn_mfma_f32_16x16x32_bf16(ka1, qf[jh][1], d, 0, 0, 0);
#pragma unroll
                    for (int r = 0; r < 4; ++r) sc[r] = fmaf(w[jh], fmaxf(d[r], 0.f), sc[r]);
                }
                u32x4 ko;
#pragma unroll
                for (int r = 0; r < 4; ++r) ko[r] = okey(sc[r]);
                *(LAS u32x4*)(lds + DS_SC + (fr * 2064 + 16 * kt + 4 * fq) * 4) = ko;
                ka0 = kb0; ka1 = kb1; kb0 = kc0; kb1 = kc1;
            }
        }
        __syncthreads();
        for (int repB = 0; repB < PROBE_DSA_B; ++repB) {
            LAS unsigned* hist = (LAS unsigned*)(lds + DS_HIST + wid * 1040);
#pragma unroll 1
            for (int qq = 0; qq < 2; ++qq) {
                const int q = wid * 2 + qq;
                const int n = t0 + q + 1;
                const LAS unsigned* row = (const LAS unsigned*)(lds + DS_SC) + q * 2064;
                LAS unsigned* bits = (LAS unsigned*)(lds + DS_BITS) + q * 66;
                if (n <= TOPK) {
#pragma unroll 1
                    for (int i = 0; i < 33; ++i) {
                        const unsigned long long sm = __ballot(lane + 64 * i < n);
                        if (lane == 0) { bits[2 * i] = (unsigned)sm; bits[2 * i + 1] = (unsigned)(sm >> 32); }
                    }
                } else {
                    const int nr = (n + 63) >> 6;
                    if (nr <= 9) dsa_select<9>(row, bits, hist, n, lane);
                    else if (nr <= 17) dsa_select<17>(row, bits, hist, n, lane);
                    else if (nr <= 25) dsa_select<25>(row, bits, hist, n, lane);
                    else dsa_select<33>(row, bits, hist, n, lane);
                }
            }
        }
        __syncthreads();
        for (int repC = 0; repC < PROBE_DSA_C; ++repC) {
            if (repC > 0) __syncthreads();
            const int h = wid, g = h >> 2;
            const int nstep = (t0 + 16 + 63) >> 6;
            bf16x8 aqf[2];
            aqf[0] = *(const bf16x8*)(AQ + rowq * 512 + h * 64 + fq * 8);
            aqf[1] = *(const bf16x8*)(AQ + rowq * 512 + h * 64 + 32 + fq * 8);
            asm volatile("" : "+v"(aqf[0]), "+v"(aqf[1]));
            const int drow = 8 * wid + (lane >> 3);
            const int kch = (lane & 7) ^ (drow & 7), vch = (lane & 7) ^ ((drow >> 1) & 7);
            const bf16_t* vsrc0 = AVT + ((size_t)b * 128 + drow) * LP + vch * 8;
#define DSA_DMA(st_, buf_) do { \
                int krow_ = b * L + 64 * (st_) + drow; krow_ = krow_ < T ? krow_ : T - 1; \
                const bf16_t* ks_ = AK + (size_t)krow_ * 128 + kch * 8; \
                LAS unsigned char* lb_ = lds + (buf_) * 32768 + wid * 1024; \
                __builtin_amdgcn_global_load_lds((const unsigned*)ks_, (LAS unsigned*)lb_, 16, 0, 0); \
                __builtin_amdgcn_global_load_lds((const unsigned*)(ks_ + 64), (LAS unsigned*)(lb_ + 8192), 16, 0, 0); \
                __builtin_amdgcn_global_load_lds((const unsigned*)(vsrc0 + 64 * (st_)), (LAS unsigned*)(lb_ + 16384), 16, 0, 0); \
                __builtin_amdgcn_global_load_lds((const unsigned*)(vsrc0 + (size_t)64 * LP + 64 * (st_)), (LAS unsigned*)(lb_ + 24576), 16, 0, 0); } while (0)
            DSA_DMA(0, 0);
            DSA_DMA((nstep > 1 ? 1 : 0), 1);
            for (int wi = tid; wi < 16 * 66; wi += NT) {
                const int q = wi / 66, wd = wi - q * 66;
                const unsigned bw = *((const LAS unsigned*)(lds + DS_BITS) + wi);
                const int st = wd >> 1, hh = wd & 1;
#pragma unroll
                for (int f = 0; f < 4; ++f) {
                    const unsigned n0 = (bw >> (4 * f)) & 15u, n1 = (bw >> (16 + 4 * f)) & 15u;
                    u32x2 o; o.x = (n0 * 0x00204081u) & 0x01010101u; o.y = (n1 * 0x00204081u) & 0x01010101u;
                    *(LAS u32x2*)(lds + DS_MB + q * DS_MBROW + 64 * st + 16 * f + 8 * hh) = o;
                }
            }
            asm volatile("s_waitcnt vmcnt(4) lgkmcnt(0)" ::: "memory");
            __builtin_amdgcn_s_barrier();
            asm volatile("" ::: "memory");
            f32x4 O[4];
#pragma unroll
            for (int dt = 0; dt < 4; ++dt) O[dt] = (f32x4){0.f, 0.f, 0.f, 0.f};
            float m = -INFINITY, l = 0.f;
            const float C2 = 1.44269504088896341f;
            int buf = 0;
            for (int st = 0; st < nstep; ++st) {
                {
                    const int sn = (st + 2 < nstep) ? st + 2 : nstep - 1;
                    const int bn = (buf >= 1) ? buf - 1 : 2;
                    DSA_DMA(sn, bn);
                }
                const LAS unsigned char* sb = lds + buf * 32768;
                f32x4 S[4];
#pragma unroll
                for (int kt = 0; kt < 4; ++kt) {
                    S[kt] = (f32x4){0.f, 0.f, 0.f, 0.f};
#pragma unroll
                    for (int s2 = 0; s2 < 2; ++s2) {
                        const int rowk = 16 * kt + fr;
                        const bf16x8 kf = *(const LAS bf16x8*)(sb + g * 8192 + rowk * 128 + 16 * ((4 * s2 + fq) ^ (rowk & 7)));
                        S[kt] = __builtin_amdgcn_mfma_f32_16x16x32_bf16(kf, aqf[s2], S[kt], 0, 0, 0);
                    }
                }
                const u32x4 mb = *(const LAS u32x4*)(lds + DS_MB + fr * DS_MBROW + 64 * st + 16 * fq);
                float pmax = S[0][0];
#pragma unroll
                for (int kt = 0; kt < 4; ++kt)
#pragma unroll
                    for (int r = 0; r < 4; ++r) pmax = fmaxf(pmax, S[kt][r]);
                if (__any(pmax > m + 8.0f)) {
                    float pm = fmaxf(pmax, __shfl_xor(pmax, 16)); pm = fmaxf(pm, __shfl_xor(pm, 32));
                    const float mn = fmaxf(m, pm);
                    const float alpha = __builtin_amdgcn_exp2f((m - mn) * C2);
#pragma unroll
                    for (int dt = 0; dt < 4; ++dt) O[dt] *= alpha;
                    l *= alpha; m = mn;
                }
                const float mc = m * C2;
                unsigned pk[4][2];
#pragma unroll
                for (int kt = 0; kt < 4; ++kt) {
                    float pv[4];
#pragma unroll
                    for (int r = 0; r < 4; ++r) {
                        const float e = __builtin_amdgcn_exp2f(fmaf(S[kt][r], C2, -mc));
                        const float bf = (float)((mb[kt] >> (8 * r)) & 0xFFu);
                        pv[r] = e * bf; l += pv[r];
                    }
                    pk[kt][0] = cvt_pk_bf16(pv[0], pv[1]); pk[kt][1] = cvt_pk_bf16(pv[2], pv[3]);
                }
#pragma unroll
                for (int ks = 0; ks < 2; ++ks) {
                    u32x4 pw; pw[0] = pk[2 * ks][0]; pw[1] = pk[2 * ks][1]; pw[2] = pk[2 * ks + 1][0]; pw[3] = pk[2 * ks + 1][1];
                    const bf16x8 pf = __builtin_bit_cast(bf16x8, pw);
#pragma unroll
                    for (int dt = 0; dt < 4; ++dt) {
                        const int rowv = 16 * dt + fr, sw = (rowv >> 1) & 7;
                        const LAS unsigned char* vp = sb + 16384 + g * 8192 + rowv * 128 + 8 * (fq & 1);
                        const u32x2 va = *(const LAS u32x2*)(vp + 16 * ((4 * ks + (fq >> 1)) ^ sw));
                        const u32x2 vb = *(const LAS u32x2*)(vp + 16 * ((4 * ks + 2 + (fq >> 1)) ^ sw));
                        u32x4 vw; vw[0] = va[0]; vw[1] = va[1]; vw[2] = vb[0]; vw[3] = vb[1];
                        O[dt] = __builtin_amdgcn_mfma_f32_16x16x32_bf16(__builtin_bit_cast(bf16x8, vw), pf, O[dt], 0, 0, 0);
                    }
                }
                asm volatile("s_waitcnt vmcnt(4)" ::: "memory");
                __builtin_amdgcn_s_barrier();
                asm volatile("" ::: "memory");
                buf = (buf == 2) ? 0 : buf + 1;
            }
#undef DSA_DMA
            asm volatile("s_waitcnt vmcnt(0)" ::: "memory");
            l += __shfl_xor(l, 16); l += __shfl_xor(l, 32);
            const float inv = 1.f / fmaxf(l, 1e-30f);
            bf16_t* mp = MIX + rowq * 1024 + 512 + h * 64 + 4 * fq;
            if (do_store && repC == PROBE_DSA_C - 1)
#pragma unroll
            for (int dt = 0; dt < 4; ++dt) {
                const uint2 gz = *(const uint2*)(mp + 16 * dt);
                const float g0 = __uint_as_float(gz.x << 16), g1 = __uint_as_float(gz.x & 0xFFFF0000u), g2 = __uint_as_float(gz.y << 16), g3 = __uint_as_float(gz.y & 0xFFFF0000u);
                uint2 o; o.x = pack2bf(O[dt][0] * inv * g0, O[dt][1] * inv * g1); o.y = pack2bf(O[dt][2] * inv * g2, O[dt][3] * inv * g3);
                *(uint2*)(mp + 16 * dt) = o;
            }
        }
    }
}

__device__ __forceinline__ void rope16(const u32x4 a, const u32x4 b, const float2* rp, u32x4& oa, u32x4& ob) {
    const f32x4 r0 = *(const f32x4*)(rp), r1 = *(const f32x4*)(rp + 2), r2 = *(const f32x4*)(rp + 4), r3 = *(const f32x4*)(rp + 6);
    const float cs[8] = {r0[0], r0[2], r1[0], r1[2], r2[0], r2[2], r3[0], r3[2]};
    const float sn[8] = {r0[1], r0[3], r1[1], r1[3], r2[1], r2[3], r3[1], r3[3]};
    float o1[8], o2[8];
#pragma unroll
    for (int i = 0; i < 4; ++i) {
        const float x1l = __uint_as_float(a[i] << 16), x1h = __uint_as_float(a[i] & 0xFFFF0000u);
        const float x2l = __uint_as_float(b[i] << 16), x2h = __uint_as_float(b[i] & 0xFFFF0000u);
        o1[2 * i] = x1l * cs[2 * i] - x2l * sn[2 * i]; o1[2 * i + 1] = x1h * cs[2 * i + 1] - x2h * sn[2 * i + 1];
        o2[2 * i] = x2l * cs[2 * i] + x1l * sn[2 * i]; o2[2 * i + 1] = x2h * cs[2 * i + 1] + x1h * sn[2 * i + 1];
    }
#pragma unroll
    for (int i = 0; i < 4; ++i) { oa[i] = cvt_pk_bf16(o1[2 * i], o1[2 * i + 1]); ob[i] = cvt_pk_bf16(o2[2 * i], o2[2 * i + 1]); }
}
__device__ __forceinline__ void phase_rope(const Params& p_in, int layer_in, char* smem) {
    const Params p = kparams(); const int layer = opaque_int(layer_in); (void)p_in;
    const int tid = opaque_tid();
    const float2* ROPE = (const float2*)(p.ws + OFF_ROPE);
    const int nthr = gridDim.x * NT, gid = opaque_bid() * NT + tid;
    for (int th = gid; th < T * 18; th += nthr) {
        const int t = th / 18, hh = th - t * 18, pos = t % L;
        bf16_t* base = (hh < 8) ? (bf16_t*)(p.ws + OFF_AQ) + (size_t)t * 512 + hh * 64
                     : (hh < 16) ? (bf16_t*)(p.ws + OFF_IQ) + (size_t)t * 512 + (hh - 8) * 64
                                 : (bf16_t*)(p.ws + OFF_AK) + (size_t)t * 128 + (hh - 16) * 64;
        const u32x4 a = *(const u32x4*)base, b = *(const u32x4*)(base + 8);
        u32x4 oa, ob; rope16(a, b, ROPE + pos * 8, oa, ob);
        *(u32x4*)base = oa; *(u32x4*)(base + 8) = ob;
    }
    const float* IKR = (const float*)(p.ws + OFF_IKR);
    bf16_t* IK = (bf16_t*)(p.ws + OFF_IK);
    const float* ikg = p.ikg + layer * 64; const float* ikb = p.ikb + layer * 64;
    for (int t = gid; t < T; t += nthr) {
        const int pos = t % L;
        f32x4 x[16];
#pragma unroll
        for (int i = 0; i < 16; ++i) x[i] = *(const f32x4*)(IKR + (size_t)t * 64 + 4 * i);
        float sm = 0.f;
#pragma unroll
        for (int i = 0; i < 16; ++i) sm += (x[i][0] + x[i][1]) + (x[i][2] + x[i][3]);
        const float mu = sm * (1.f / 64);
        float qq = 0.f;
#pragma unroll
        for (int i = 0; i < 16; ++i) { const f32x4 d = x[i] - mu; qq += (d[0] * d[0] + d[1] * d[1]) + (d[2] * d[2] + d[3] * d[3]); }
        const float rs = rsqrtf(qq * (1.f / 64) + LN_EPS);
#pragma unroll
        for (int i = 0; i < 16; ++i) { const f32x4 g = *(const f32x4*)(ikg + 4 * i), bb = *(const f32x4*)(ikb + 4 * i); x[i] = (x[i] - mu) * rs * g + bb; }
        const float2* rp = ROPE + pos * 8;
        const f32x4 r0 = *(const f32x4*)(rp), r1 = *(const f32x4*)(rp + 2), r2 = *(const f32x4*)(rp + 4), r3 = *(const f32x4*)(rp + 6);
        const float cs[8] = {r0[0], r0[2], r1[0], r1[2], r2[0], r2[2], r3[0], r3[2]};
        const float sn[8] = {r0[1], r0[3], r1[1], r1[3], r2[1], r2[3], r3[1], r3[3]};
#pragma unroll
        for (int i = 0; i < 8; ++i) {
            const float x1 = x[i >> 2][i & 3], x2 = x[2 + (i >> 2)][i & 3];
            x[i >> 2][i & 3] = x1 * cs[i] - x2 * sn[i];
            x[2 + (i >> 2)][i & 3] = x2 * cs[i] + x1 * sn[i];
        }
#pragma unroll
        for (int i = 0; i < 8; ++i) {
            u32x4 o; o[0] = cvt_pk_bf16(x[2 * i][0], x[2 * i][1]); o[1] = cvt_pk_bf16(x[2 * i][2], x[2 * i][3]); o[2] = cvt_pk_bf16(x[2 * i + 1][0], x[2 * i + 1][1]); o[3] = cvt_pk_bf16(x[2 * i + 1][2], x[2 * i + 1][3]);
            *(u32x4*)(IK + (size_t)t * 64 + 8 * i) = o;
        }
    }
}

constexpr int GL_QE = 0, GL_KN = 8192, GL_SEG = 16384, GL_PART = 18432;
__device__ __forceinline__ void gla_cumsum(const Params& p, int layer, int b, int h, int c, int tid, LAS unsigned char* lds, float (&bc)[8], float& blast) {
    const int d = tid & 63, seg = tid >> 6;
    const float* wg2 = p.wg2 + (size_t)layer * 16 * 256 + h * 64 + d;
    float w[16];
#pragma unroll
    for (int rr = 0; rr < 16; ++rr) w[rr] = wg2[rr * 256];
    const float bgd = p.bg[layer * 256 + h * 64 + d];
    const float* GLR = (const float*)(p.ws + OFF_GLR);
    float pb = 0.f;
#pragma unroll
    for (int i = 0; i < 8; ++i) {
        const int pos = 64 * c - 48 + 8 * seg + i;
        float gl = 0.f;
        if (pos >= 0) {
            const f32x4* gp = (const f32x4*)(GLR + ((size_t)b * L + pos) * 16);
            const f32x4 g0 = gp[0], g1 = gp[1], g2 = gp[2], g3 = gp[3];
            float x = bgd;
#pragma unroll
            for (int rr = 0; rr < 4; ++rr) { x = fmaf(g0[rr], w[rr], x); }
#pragma unroll
            for (int rr = 0; rr < 4; ++rr) { x = fmaf(g1[rr], w[4 + rr], x); }
#pragma unroll
            for (int rr = 0; rr < 4; ++rr) { x = fmaf(g2[rr], w[8 + rr], x); }
#pragma unroll
            for (int rr = 0; rr < 4; ++rr) { x = fmaf(g3[rr], w[12 + rr], x); }
            gl = logsigmoid_fast(x) * (1.f / 16.f);
        }
        pb += gl; bc[i] = pb;
    }
    LAS float* segs = (LAS float*)(lds + GL_SEG);
    segs[seg * 64 + d] = pb;
    __syncthreads();
    float base = 0.f, tot = 0.f;
#pragma unroll
    for (int sg = 0; sg < 8; ++sg) { const float v = segs[sg * 64 + d]; tot += v; base += (sg < seg) ? v : 0.f; }
#pragma unroll
    for (int i = 0; i < 8; ++i) bc[i] += base;
    blast = tot;
}

__device__ __forceinline__ void phase_gla_a(const Params& p_in, int layer_in, char* smem) {
    const Params p = kparams(); const int layer = opaque_int(layer_in); (void)p_in;
    const int tid = opaque_tid(), wid = __builtin_amdgcn_readfirstlane(tid >> 6), lane = tid & 63, fr = lane & 15, fq = lane >> 4;
    LAS unsigned char* lds = (LAS unsigned char*)smem;
    const bf16_t* GK = (const bf16_t*)(p.ws + OFF_GK);
    const bf16_t* GVT = (const bf16_t*)(p.ws + OFF_GV);
    float* UT = (float*)(p.ws + OFF_UT);
    float* DL = (float*)(p.ws + OFF_DL);
    for (int task = opaque_bid(); task < 1024; task += gridDim.x) {
        const int bh = task >> 5, c = task & 31, b = bh >> 2, h = bh & 3;
        __syncthreads();
        float bc[8], blast;
        gla_cumsum(p, layer, b, h, c, tid, lds, bc, blast);
        {
            const int d = tid & 63, seg = tid >> 6;
            float ke[8];
#pragma unroll
            for (int i = 0; i < 8; ++i) {
                const int pos = 64 * c - 48 + 8 * seg + i;
                const float kv = (pos >= 0) ? bf2f(GK[((size_t)b * L + pos) * 256 + h * 64 + d]) : 0.f;
                ke[i] = kv * __expf(blast - bc[i]);
            }
            u32x4 o; o[0] = cvt_pk_bf16(ke[0], ke[1]); o[1] = cvt_pk_bf16(ke[2], ke[3]); o[2] = cvt_pk_bf16(ke[4], ke[5]); o[3] = cvt_pk_bf16(ke[6], ke[7]);
            *(LAS u32x4*)(lds + GL_QE + d * 128 + 16 * (seg ^ (d & 7))) = o;
            if (seg == 0) DL[(size_t)task * 64 + d] = __expf(blast);
        }
        __syncthreads();
        bf16x8 vf[2];
        {
            const bf16_t* vp = GVT + ((size_t)bh * 128 + 16 * wid + fr) * LPV + 64 * c + 8 * fq;
            vf[0] = *(const bf16x8*)vp; vf[1] = *(const bf16x8*)(vp + 32);
            const bf16x8 z8 = {0, 0, 0, 0, 0, 0, 0, 0};
            if (c == 0) { vf[0] = z8; if (fq < 2) vf[1] = z8; }
        }
#pragma unroll
        for (int dt = 0; dt < 4; ++dt) {
            f32x4 acc = {0.f, 0.f, 0.f, 0.f};
#pragma unroll
            for (int ks = 0; ks < 2; ++ks) {
                const int rowd = 16 * dt + fr;
                const bf16x8 kf = *(const LAS bf16x8*)(lds + GL_QE + rowd * 128 + 16 * ((4 * ks + fq) ^ (rowd & 7)));
                acc = __builtin_amdgcn_mfma_f32_16x16x32_bf16(vf[ks], kf, acc, 0, 0, 0);
            }
            float* up = UT + ((size_t)task * 128 + 16 * wid + 4 * fq) * 64 + 16 * dt + fr;
#pragma unroll
            for (int r = 0; r < 4; ++r) up[r * 64] = acc[r];
        }
    }
}

__device__ __forceinline__ void phase_gla_scan(const Params& p_in, int layer_in, char* smem) {
    const Params p = kparams(); const int layer = opaque_int(layer_in); (void)p_in;
    const int tid = opaque_tid();
    const float* UT = (const float*)(p.ws + OFF_UT);
    const float* DL = (const float*)(p.ws + OFF_DL);
    bf16_t* ST = (bf16_t*)(p.ws + OFF_ST);
    const int nthr = gridDim.x * NT;
    for (int el = opaque_bid() * NT + tid; el < 32 * 8192; el += nthr) {
        const int bh = el >> 13, ed = el & 8191, d = el & 63;
        float sacc = 0.f;
        ST[((size_t)bh * 33) * 8192 + ed] = 0;
#pragma unroll 1
        for (int c0 = 0; c0 < 32; c0 += 16) {
            float u[16], dl[16];
#pragma unroll
            for (int i = 0; i < 16; ++i) { u[i] = UT[((size_t)(bh * 32 + c0 + i)) * 8192 + ed]; dl[i] = DL[(size_t)(bh * 32 + c0 + i) * 64 + d]; }
#pragma unroll
            for (int i = 0; i < 16; ++i) { sacc = fmaf(dl[i], sacc, u[i]); ST[((size_t)bh * 33 + c0 + i + 1) * 8192 + ed] = f2bf(sacc); }
        }
    }
}

__device__ __forceinline__ void phase_gla_c(const Params& p_in, int layer_in, char* smem, bool do_store) {
    const Params p = kparams(); const int layer = opaque_int(layer_in); (void)p_in;
    const int tid = opaque_tid(), wid = __builtin_amdgcn_readfirstlane(tid >> 6), lane = tid & 63, fr = lane & 15, fq = lane >> 4;
    LAS unsigned char* lds = (LAS unsigned char*)smem;
    const bf16_t* GQ = (const bf16_t*)(p.ws + OFF_GQ);
    const bf16_t* GK = (const bf16_t*)(p.ws + OFF_GK);
    const bf16_t* GVT = (const bf16_t*)(p.ws + OFF_GV);
    const bf16_t* ST = (const bf16_t*)(p.ws + OFF_ST);
    bf16_t* MIX = (bf16_t*)(p.ws + OFF_MIX);
    const float* ng = p.norm_g + layer * 128;
    for (int task = opaque_bid(); task < 32 * 33; task += gridDim.x) {
        const int bh = task / 33, c = task - bh * 33, b = bh >> 2, h = bh & 3;
        __syncthreads();
        float bc[8], blast;
        gla_cumsum(p, layer, b, h, c, tid, lds, bc, blast);
        {
            const int d = tid & 63, seg = tid >> 6;
#pragma unroll
            for (int i = 0; i < 8; ++i) {
                const int t = 8 * seg + i, pos = 64 * c - 48 + t;
                float qv = 0.f, kv = 0.f;
                if (pos >= 0) { const size_t row = (size_t)b * L + pos; qv = bf2f(GQ[row * 256 + h * 64 + d]); kv = bf2f(GK[row * 256 + h * 64 + d]); }
                const int off = t * 128 + 16 * ((d >> 3) ^ (t & 7)) + 2 * (d & 7);
                *(LAS bf16_t*)(lds + GL_QE + off) = f2bf(qv * __expf(bc[i]));
                *(LAS bf16_t*)(lds + GL_KN + off) = f2bf(kv * __expf(-bc[i]));
            }
        }
        __syncthreads();
        const int tw = wid & 3, eh = wid >> 2;
        bf16x8 qf[2];
#pragma unroll
        for (int ks = 0; ks < 2; ++ks) { const int rowt = 16 * tw + fr; qf[ks] = *(const LAS bf16x8*)(lds + GL_QE + rowt * 128 + 16 * ((4 * ks + fq) ^ (rowt & 7))); }
        unsigned pk[4][2];
#pragma unroll
        for (int st = 0; st < 4; ++st) {
            f32x4 a = {0.f, 0.f, 0.f, 0.f};
#pragma unroll
            for (int ks = 0; ks < 2; ++ks) {
                const int rows = 16 * st + fr;
                const bf16x8 kf = *(const LAS bf16x8*)(lds + GL_KN + rows * 128 + 16 * ((4 * ks + fq) ^ (rows & 7)));
                a = __builtin_amdgcn_mfma_f32_16x16x32_bf16(kf, qf[ks], a, 0, 0, 0);
            }
#pragma unroll
            for (int r = 0; r < 4; ++r) a[r] = (16 * st + 4 * fq + r > 16 * tw + fr) ? 0.f : a[r];
            pk[st][0] = cvt_pk_bf16(a[0], a[1]); pk[st][1] = cvt_pk_bf16(a[2], a[3]);
        }
        bf16x8 pf[2];
#pragma unroll
        for (int ks = 0; ks < 2; ++ks) { u32x4 pw; pw[0] = pk[2 * ks][0]; pw[1] = pk[2 * ks][1]; pw[2] = pk[2 * ks + 1][0]; pw[3] = pk[2 * ks + 1][1]; pf[ks] = __builtin_bit_cast(bf16x8, pw); }
        f32x4 O[4];
        float ss = 0.f;
#pragma unroll
        for (int et = 0; et < 4; ++et) {
            const int e0 = 64 * eh + 16 * et;
            f32x4 acc = {0.f, 0.f, 0.f, 0.f};
            const bf16_t* sp = ST + (((size_t)bh * 33 + c) * 128 + e0 + fr) * 64 + 8 * fq;
            const bf16_t* vp = GVT + ((size_t)bh * 128 + e0 + fr) * LPV + 64 * c + 4 * fq;
#pragma unroll
            for (int ks = 0; ks < 2; ++ks) {
                const bf16x8 sf = *(const bf16x8*)(sp + 32 * ks);
                acc = __builtin_amdgcn_mfma_f32_16x16x32_bf16(sf, qf[ks], acc, 0, 0, 0);
                u32x2 va = *(const u32x2*)(vp + 32 * ks), vb = *(const u32x2*)(vp + 32 * ks + 16);
                if (c == 0) { va = (u32x2){0u, 0u}; if (ks == 0) vb = (u32x2){0u, 0u}; }
                u32x4 vw; vw[0] = va[0]; vw[1] = va[1]; vw[2] = vb[0]; vw[3] = vb[1];
                acc = __builtin_amdgcn_mfma_f32_16x16x32_bf16(__builtin_bit_cast(bf16x8, vw), pf[ks], acc, 0, 0, 0);
            }
            O[et] = acc;
            ss += acc[0] * acc[0] + acc[1] * acc[1] + acc[2] * acc[2] + acc[3] * acc[3];
        }
        ss += __shfl_xor(ss, 16); ss += __shfl_xor(ss, 32);
        LAS float* part = (LAS float*)(lds + GL_PART);
        if (fq == 0) part[eh * 64 + 16 * tw + fr] = ss;
        __syncthreads();
        const float tot = part[16 * tw + fr] + part[64 + 16 * tw + fr];
        const float rinv = rsqrtf(tot * (1.f / 128) + LN_EPS);
        const int pos = 64 * c - 48 + 16 * tw + fr;
        if (pos >= 0 && do_store) {
            bf16_t* mp = MIX + ((size_t)b * L + pos) * 1024 + h * 128 + 64 * eh + 4 * fq;
#pragma unroll
            for (int et = 0; et < 4; ++et) {
                const uint2 gz = *(const uint2*)(mp + 16 * et);
                const f32x4 nv = *(const f32x4*)(ng + 64 * eh + 16 * et + 4 * fq);
                const float g0 = __uint_as_float(gz.x << 16), g1 = __uint_as_float(gz.x & 0xFFFF0000u), g2 = __uint_as_float(gz.y << 16), g3 = __uint_as_float(gz.y & 0xFFFF0000u);
                uint2 o; o.x = pack2bf(O[et][0] * rinv * nv[0] * g0, O[et][1] * rinv * nv[1] * g1); o.y = pack2bf(O[et][2] * rinv * nv[2] * g2, O[et][3] * rinv * nv[3] * g3);
                *(uint2*)(mp + 16 * et) = o;
            }
        }
    }
}

__device__ __forceinline__ void phase_ln(const Params& p_in, int layer_in, char* smem) {
    const Params p = kparams(); const int layer = opaque_int(layer_in); (void)p_in;
    const int tid = opaque_tid(), wid = tid >> 6, lane = tid & 63;
    const float* Z = (const float*)(p.ws + OFF_GQ);
    float* H32 = (float*)(p.ws + OFF_H32);
    bf16_t* HB = (bf16_t*)(p.ws + OFF_HB);
    const float* g = p.ln_g + layer * D; const float* bb = p.ln_b + layer * D;
    const int nw = gridDim.x * 8;
    int t = opaque_bid() * 8 + wid;
    f32x4 v[4], vn[4];
    if (t < T) {
#pragma unroll
        for (int i = 0; i < 4; ++i) v[i] = *(const f32x4*)(Z + (size_t)t * D + 4 * lane + 256 * i);
    }
    for (; t < T; t += nw) {
        const int tn = t + nw;
        if (tn < T) {
#pragma unroll
            for (int i = 0; i < 4; ++i) vn[i] = *(const f32x4*)(Z + (size_t)tn * D + 4 * lane + 256 * i);
        }
        ln_row_wave(v, g, bb, lane);
        if (layer == DEPTH - 1) {
            const int b = t / L, pos = t - b * L;
            if (pos >= NMETA) {
#pragma unroll
                for (int i = 0; i < 4; ++i) *(f32x4*)(p.out + ((size_t)b * SEQ + (pos - NMETA)) * D + 4 * lane + 256 * i) = v[i];
            }
        } else {
#pragma unroll
            for (int i = 0; i < 4; ++i) {
                *(f32x4*)(H32 + (size_t)t * D + 4 * lane + 256 * i) = v[i];
                u32x2 o; o[0] = cvt_pk_bf16(v[i][0], v[i][1]); o[1] = cvt_pk_bf16(v[i][2], v[i][3]);
                *(u32x2*)(HB + (size_t)t * D + 4 * lane + 256 * i) = o;
            }
        }
#pragma unroll
        for (int i = 0; i < 4; ++i) v[i] = vn[i];
    }
}

#define XB_TMO      128
#define XB_XCNT(j)  (256  + 64 * (j))
#define XB_XSUB(j)  (1280 + 64 * (j))
#define XB_XGEN(j)  (2304 + 64 * (j))
#define XB_TOP      3328
#define XB_TOPGEN   3392
#define XCD_BAR_WORDS 3456
#define XB_SPIN_CAP (1u << 22)
__device__ __forceinline__ unsigned xb_ld(unsigned* p)              { return __hip_atomic_load(p, __ATOMIC_RELAXED, __HIP_MEMORY_SCOPE_AGENT); }
__device__ __forceinline__ unsigned xb_add(unsigned* p, unsigned v) { return __hip_atomic_fetch_add(p, v, __ATOMIC_RELAXED, __HIP_MEMORY_SCOPE_AGENT); }
__device__ __forceinline__ unsigned xb_xcc_id() { return (unsigned)__builtin_amdgcn_s_getreg((3 << 11) | 20) & 0xFu; }
#define XB_SPIN(cond, bar) do { unsigned _sp = 0; while (cond) { __builtin_amdgcn_s_sleep(1); \
    if ((++_sp & 255u) == 0u) { if (xb_ld(&(bar)[XB_TMO])) break; if (_sp > XB_SPIN_CAP) { atomicAdd(&(bar)[XB_TMO], 1u); break; } } } } while (0)
struct XcdBarrier { unsigned* bar; unsigned x; volatile LAS unsigned* st; };
__device__ __forceinline__ XcdBarrier xcd_barrier_post(unsigned* bar, volatile LAS unsigned* st) {
    XcdBarrier b; b.bar = bar; b.x = xb_xcc_id(); b.st = st;
    if (threadIdx.x == 0) (void)xb_add(&bar[XB_XCNT(b.x)], 1u);
    return b;
}
__device__ __forceinline__ void xcd_barrier_complete(unsigned* bar, unsigned x, unsigned& nloc, unsigned& nx) {
    const unsigned G = gridDim.x * gridDim.y * gridDim.z;
    unsigned sum, cnt, mine, sp = 0u;
    for (;;) {
        sum = 0u; cnt = 0u; mine = 0u;
#pragma unroll
        for (unsigned j = 0; j < 16; ++j) { const unsigned c = xb_ld(&bar[XB_XCNT(j)]); sum += c; cnt += (c > 0u) ? 1u : 0u; mine = (j == x) ? c : mine; }
        if (sum == G) break;
        __builtin_amdgcn_s_sleep(1);
        if ((++sp & 255u) == 0u) { if (xb_ld(&bar[XB_TMO])) break; if (sp > XB_SPIN_CAP) { atomicAdd(&bar[XB_TMO], 1u); break; } }
    }
    nloc = mine > 0u ? mine : 1u; nx = cnt > 0u ? cnt : 1u;
}
__device__ __forceinline__ void xcd_barrier(unsigned* bar_, volatile LAS unsigned* st_) {
    XcdBarrier b; b.bar = bar_; b.x = xb_xcc_id(); b.st = st_;
    asm volatile("s_waitcnt vmcnt(0)" ::: "memory");
    __syncthreads();
    if (opaque_tid() == 0) {
        unsigned* bar = b.bar;
        __builtin_amdgcn_s_waitcnt(0);
        unsigned nloc = b.st[0], nx = b.st[1];
        if (nloc == 0u) { xcd_barrier_complete(bar, b.x, nloc, nx); b.st[0] = nloc; b.st[1] = nx; }
        const unsigned old = xb_add(&bar[XB_XSUB(b.x)], 1u);
        const unsigned gen = old / nloc;
        if (old + 1u == (gen + 1u) * nloc) {
            __builtin_amdgcn_fence(__ATOMIC_RELEASE, "agent");
            asm volatile("s_waitcnt vmcnt(0)" ::: "memory");
            const unsigned og = xb_add(&bar[XB_TOP], 1u);
            const unsigned tg = og / nx;
            if (og + 1u == (tg + 1u) * nx) xb_add(&bar[XB_TOPGEN], 1u);
            else XB_SPIN(xb_ld(&bar[XB_TOPGEN]) == tg, bar);
            __builtin_amdgcn_fence(__ATOMIC_ACQUIRE, "agent");
            xb_add(&bar[XB_XGEN(b.x)], 1u);
            asm volatile("s_waitcnt vmcnt(0)" ::: "memory");
        } else {
            XB_SPIN(xb_ld(&bar[XB_XGEN(b.x)]) == gen, bar);
            __builtin_amdgcn_fence(__ATOMIC_ACQUIRE, "agent");
            asm volatile("s_waitcnt vmcnt(0)" ::: "memory");
        }
    }
    __syncthreads();
}

constexpr int SMEM_BYTES = 160 * 1024;
static_assert(DS_END <= SMEM_BYTES - 16, "dsa lds");

__global__ void __launch_bounds__(NT, 2) k_mega(Params p) {
    __shared__ __attribute__((aligned(16))) char smem[SMEM_BYTES];
    volatile LAS unsigned* xbw = (volatile LAS unsigned*)((LAS unsigned char*)smem + (SMEM_BYTES - 16));
    if (threadIdx.x == 0) { xbw[0] = 0u; xbw[1] = 0u; xbw[2] = 0u; xbw[3] = 0u; }
    __syncthreads();
    if (p.ws == nullptr) cg::this_grid().sync();
    (void)xcd_barrier_post((unsigned*)(p.ws + OFF_BAR), xbw);
    for (int rep = 0; rep < PROBE_REP_PREP; ++rep) {
    phase_prep(p, smem);
    xcd_barrier((unsigned*)(p.ws + OFF_BAR), xbw);
    }
#pragma unroll 1
    for (int layer = 0; layer < DEPTH; ++layer) {
        for (int rep = 0; rep < PROBE_REP_PROJ; ++rep) {
        phase_proj(p, layer, smem);
        xcd_barrier((unsigned*)(p.ws + OFF_BAR), xbw);
        }
        phase_rope(p, layer, smem);
        for (int rep = 0; rep < PROBE_REP_GLAA; ++rep) {
        phase_gla_a(p, layer, smem);
        xcd_barrier((unsigned*)(p.ws + OFF_BAR), xbw);
        phase_gla_scan(p, layer, smem);
        xcd_barrier((unsigned*)(p.ws + OFF_BAR), xbw);
        }
        for (int rep = 0; rep < PROBE_REP_GLAC; ++rep) phase_gla_c(p, layer, smem, rep == PROBE_REP_GLAC - 1);
        for (int rep = 0; rep < PROBE_REP_DSA; ++rep) phase_dsa(p, layer, smem, rep == PROBE_REP_DSA - 1);
        xcd_barrier((unsigned*)(p.ws + OFF_BAR), xbw);
        for (int rep = 0; rep < PROBE_REP_OUT; ++rep) {
        phase_outproj(p, layer, smem);
        xcd_barrier((unsigned*)(p.ws + OFF_BAR), xbw);
        }
        for (int rep = 0; rep < PROBE_REP_LN; ++rep) {
        phase_ln(p, layer, smem);
        xcd_barrier((unsigned*)(p.ws + OFF_BAR), xbw);
        }
    }
}

extern "C" void kernel_launch(void* const* d_in, const int* in_sizes, int n_in, void* d_out, int out_size, void* d_ws, size_t ws_size,
                              hipStream_t stream) {
    Params p{};
    p.x = (const float*)d_in[0]; p.meta = (const float*)d_in[1]; p.ln_in_g = (const float*)d_in[2]; p.ln_in_b = (const float*)d_in[3];
    p.w_in = (const float*)d_in[4]; p.wg2 = (const float*)d_in[5]; p.bg = (const float*)d_in[6]; p.norm_g = (const float*)d_in[7];
    p.ikg = (const float*)d_in[8]; p.ikb = (const float*)d_in[9]; p.w_out = (const float*)d_in[10]; p.ln_g = (const float*)d_in[11];
    p.ln_b = (const float*)d_in[12];
    p.out = (float*)d_out; p.ws = (char*)d_ws;
    static int grid_blocks = 0;
    if (!grid_blocks) {
        int dev = 0, cus = 0, per_cu = 0;
        hipGetDevice(&dev);
        hipDeviceGetAttribute(&cus, hipDeviceAttributeMultiprocessorCount, dev);
        hipOccupancyMaxActiveBlocksPerMultiprocessor(&per_cu, k_mega, NT, 0);
        if (per_cu > 1) per_cu = 1;
        grid_blocks = cus * per_cu;
    }
    (void)hipMemsetAsync((char*)d_ws + OFF_BAR, 0, XCD_BAR_WORDS * 4, stream);
    void* args[] = {&p};
    (void)hipLaunchCooperativeKernel((void*)k_mega, dim3(grid_blocks), dim3(NT), args, 0, stream);
}
```

```cpp
#include <hip/hip_runtime.h>
#include <hip/hip_cooperative_groups.h>
#include <stdint.h>
namespace cg = cooperative_groups;
#ifndef PROBE_REP_PREP
#define PROBE_REP_PREP 1
#define PROBE_REP_PROJ 1
#define PROBE_REP_GLAA 1
#define PROBE_REP_GLAC 1
#define PROBE_REP_DSA 1
#define PROBE_REP_OUT 1
#define PROBE_REP_LN 1
#define PROBE_DSA_A 1
#define PROBE_DSA_B 1
#define PROBE_DSA_C 1
#endif

constexpr int D = 1024, NB = 8, SEQ = 2048, NMETA = 16, L = 2064, T = NB * L;
constexpr int DEPTH = 2;
constexpr int INW = 3416, INWP = 3584;
constexpr int TP = 16640;
constexpr int NT = 512;
constexpr int TOPK = 256;
constexpr float LN_EPS = 1e-5f;
constexpr float ALPHA = 1.41421356237309515f;

typedef unsigned short bf16_t;
typedef short bf16x8 __attribute__((ext_vector_type(8)));
typedef float f32x4 __attribute__((ext_vector_type(4)));
#define LAS __attribute__((address_space(3)))

constexpr size_t SZ_H32 = (size_t)T * D * 4;
constexpr size_t SZ_HB = (size_t)TP * D * 2;
constexpr size_t SZ_WIN = (size_t)DEPTH * INWP * D * 2;
constexpr size_t SZ_WOUT = (size_t)DEPTH * D * D * 2;
constexpr int LPV = 2112;
constexpr size_t SZ_GQ = (size_t)T * 256 * 2, SZ_GK = SZ_GQ, SZ_GV = (size_t)NB * 4 * 128 * LPV * 2;
constexpr size_t SZ_UT = (size_t)1024 * 128 * 64 * 4, SZ_ST = (size_t)32 * 33 * 128 * 64 * 2, SZ_DL = (size_t)1024 * 64 * 4;
constexpr size_t SZ_AQ = (size_t)T * 512 * 2, SZ_IQ = (size_t)T * 512 * 2;
constexpr size_t SZ_MIX = (size_t)TP * 1024 * 2;
constexpr int LP = 2112;
constexpr size_t SZ_AK = (size_t)T * 128 * 2, SZ_AV = (size_t)NB * 2 * 64 * LP * 2, SZ_IK = (size_t)T * 64 * 2, SZ_IW = (size_t)T * 8 * 4;
constexpr size_t SZ_GLR = (size_t)T * 16 * 4;
constexpr size_t SZ_ROPE = (size_t)L * 8 * 2 * 4;

constexpr size_t OFF_H32 = 0;
constexpr size_t OFF_HB = OFF_H32 + SZ_H32;
constexpr size_t OFF_WIN = OFF_HB + SZ_HB;
constexpr size_t OFF_WOUT = OFF_WIN + SZ_WIN;
constexpr size_t OFF_GQ = OFF_WOUT + SZ_WOUT;
constexpr size_t OFF_GK = OFF_GQ + SZ_GQ;
constexpr size_t OFF_GV = OFF_GK + SZ_GK;
constexpr size_t OFF_AQ = OFF_GV + SZ_GV;
constexpr size_t OFF_IQ = OFF_AQ + SZ_AQ;
constexpr size_t OFF_MIX = OFF_IQ + SZ_IQ;
constexpr size_t OFF_AK = OFF_MIX + SZ_MIX;
constexpr size_t OFF_AV = OFF_AK + SZ_AK;
constexpr size_t OFF_IK = OFF_AV + SZ_AV;
constexpr size_t OFF_IW = OFF_IK + SZ_IK;
constexpr size_t OFF_GLR = OFF_IW + SZ_IW;
constexpr size_t OFF_ROPE = OFF_GLR + SZ_GLR;
constexpr size_t OFF_ST = OFF_ROPE + SZ_ROPE;
constexpr size_t OFF_DL = OFF_ST + SZ_ST;
constexpr size_t OFF_BAR = OFF_DL + SZ_DL;
constexpr size_t OFF_IKR = OFF_BAR + 16384;
constexpr size_t OFF_END = OFF_IKR + (size_t)T * 64 * 4;
constexpr size_t OFF_UT = OFF_HB;
static_assert(SZ_UT <= SZ_HB, "UT alias");
static_assert(SZ_GQ + SZ_GK + SZ_GV + SZ_AQ + SZ_IQ >= SZ_H32, "Z alias size");
static_assert(OFF_END <= (size_t)256 * 1024 * 1024, "workspace too large");

struct Params {
    const float* x; const float* meta; const float* ln_in_g; const float* ln_in_b;
    const float* w_in; const float* wg2; const float* bg; const float* norm_g;
    const float* ikg; const float* ikb; const float* w_out; const float* ln_g; const float* ln_b;
    float* out; char* ws;
};
typedef const Params __attribute__((address_space(4))) * KParamsPtr;
__device__ __forceinline__ Params kparams() {
    unsigned long long a = (unsigned long long)__builtin_amdgcn_kernarg_segment_ptr();
    asm volatile("" : "+s"(a));
    KParamsPtr q = (KParamsPtr)a;
    Params r;
    r.x = q->x; r.meta = q->meta; r.ln_in_g = q->ln_in_g; r.ln_in_b = q->ln_in_b; r.w_in = q->w_in; r.wg2 = q->wg2; r.bg = q->bg; r.norm_g = q->norm_g;
    r.ikg = q->ikg; r.ikb = q->ikb; r.w_out = q->w_out; r.ln_g = q->ln_g; r.ln_b = q->ln_b; r.out = q->out; r.ws = q->ws;
    return r;
}

__device__ __forceinline__ bf16_t f2bf(float f) {
    unsigned u = __float_as_uint(f);
    u += 0x7FFFu + ((u >> 16) & 1u);
    return (bf16_t)(u >> 16);
}
__device__ __forceinline__ unsigned pack2bf(float lo, float hi) { return (unsigned)f2bf(lo) | ((unsigned)f2bf(hi) << 16); }
__device__ __forceinline__ unsigned cvt_pk_bf16(float lo, float hi) { unsigned r; asm volatile("v_cvt_pk_bf16_f32 %0, %1, %2" : "=v"(r) : "v"(lo), "v"(hi)); return r; }
typedef unsigned u32x4 __attribute__((ext_vector_type(4)));
typedef unsigned u32x2 __attribute__((ext_vector_type(2)));
__device__ __forceinline__ float bf2f(bf16_t h) { return __uint_as_float(((unsigned)h) << 16); }
__device__ __forceinline__ int opaque_tid() { int t = threadIdx.x; asm volatile("" : "+v"(t)); return t; }
__device__ __forceinline__ int opaque_int(int v) { asm volatile("" : "+s"(v)); return v; }
__device__ __forceinline__ int opaque_bid() { int t = blockIdx.x; asm volatile("" : "+s"(t)); return t; }
__device__ __forceinline__ float wave_sum(float v) {
#pragma unroll
    for (int o = 32; o > 0; o >>= 1) v += __shfl_xor(v, o);
    return v;
}
__device__ __forceinline__ float wave_max(float v) {
#pragma unroll
    for (int o = 32; o > 0; o >>= 1) v = fmaxf(v, __shfl_xor(v, o));
    return v;
}
__device__ __forceinline__ float block_sum(float v, float* red) {
    v = wave_sum(v);
    const int tq = opaque_tid();
    __syncthreads();
    if ((tq & 63) == 0) red[tq >> 6] = v;
    __syncthreads();
    return ((red[0] + red[1]) + (red[2] + red[3])) + ((red[4] + red[5]) + (red[6] + red[7]));
}
__device__ __forceinline__ float silu_f(float x) { return x / (1.f + __expf(-x)); }
__device__ __forceinline__ float logsigmoid_f(float x) { return fminf(x, 0.f) - log1pf(expf(-fabsf(x))); }
__device__ __forceinline__ float logsigmoid_fast(float x) { return fminf(x, 0.f) - __logf(1.f + __expf(-fabsf(x))); }

__device__ __forceinline__ int proj_src_col(int n) {
    if (n < 1024) return n;
    if (n < 1536) return n - 1024 + 1040;
    if (n < 2048) return n - 1536 + 1552;
    if (n < 2560) return n - 2048 + 2904;
    if (n < 3072) return n - 2560 + 2320;
    if (n < 3200) return n - 3072 + 2064;
    if (n < 3328) return n - 3200 + 2192;
    const int c = n - 3328;
    if (c < 32) return 2832 + c;
    if (c < 48) return 1024 + (c - 32);
    if (c < 56) return 2896 + (c - 48);
    if (c >= 128 && c < 160) return 2832 + 32 + (c - 128);
    return -1;
}

__device__ __forceinline__ void sincos_acc(float a, float& s, float& c) {
    double ad = (double)a;
    double kd = rint(ad * 0.63661977236758134308);
    double r = fma(-kd, 1.57079632679489655800, ad);
    r = fma(-kd, 6.12323399573676603587e-17, r);
    double r2 = r * r;
    double sp = r * (1.0 + r2 * (-1.0 / 6 + r2 * (1.0 / 120 + r2 * (-1.0 / 5040 + r2 * (1.0 / 362880 + r2 * (-1.0 / 39916800))))));
    double cp = 1.0 + r2 * (-0.5 + r2 * (1.0 / 24 + r2 * (-1.0 / 720 + r2 * (1.0 / 40320 + r2 * (-1.0 / 3628800 + r2 * (1.0 / 479001600))))));
    int q = ((int)kd) & 3;
    double ss = (q & 1) ? cp : sp, cc = (q & 1) ? sp : cp;
    if (q == 1 || q == 2) cc = -cc;
    if (q == 2 || q == 3) ss = -ss;
    s = (float)ss; c = (float)cc;
}

__device__ __forceinline__ void ln_row_wave(f32x4 (&v)[4], const float* g, const float* bb, int lane) {
    float sm = 0.f;
#pragma unroll
    for (int i = 0; i < 4; ++i) sm += (v[i][0] + v[i][1]) + (v[i][2] + v[i][3]);
    const float mu = wave_sum(sm) * (1.f / D);
    float qq = 0.f;
#pragma unroll
    for (int i = 0; i < 4; ++i) { v[i] = v[i] - mu; qq += (v[i][0] * v[i][0] + v[i][1] * v[i][1]) + (v[i][2] * v[i][2] + v[i][3] * v[i][3]); }
    const float rs = rsqrtf(wave_sum(qq) * (1.f / D) + LN_EPS);
#pragma unroll
    for (int i = 0; i < 4; ++i) { const f32x4 gg = *(const f32x4*)(g + 4 * lane + 256 * i), b4 = *(const f32x4*)(bb + 4 * lane + 256 * i); v[i] = v[i] * rs * gg + b4; }
}
__device__ __forceinline__ int proj_dst_col(int src) {
    if (src < 1024) return src;
    if (src < 1040) return 3328 + 32 + (src - 1024);
    if (src < 1552) return 1024 + (src - 1040);
    if (src < 2064) return 1536 + (src - 1552);
    if (src < 2192) return 3072 + (src - 2064);
    if (src < 2320) return 3200 + (src - 2192);
    if (src < 2832) return 2560 + (src - 2320);
    if (src < 2864) return 3328 + (src - 2832);
    if (src < 2896) return 3328 + 128 + (src - 2864);
    if (src < 2904) return 3328 + 48 + (src - 2896);
    return 2048 + (src - 2904);
}
__device__ __forceinline__ void phase_prep(const Params& p_in, char* smem) {
    const Params p = kparams(); (void)p_in;
    const int tid = opaque_tid(), wid = tid >> 6, lane = tid & 63;
    bf16_t* WIN = (bf16_t*)(p.ws + OFF_WIN);
    bf16_t* WOUT = (bf16_t*)(p.ws + OFF_WOUT);
    float* H32 = (float*)(p.ws + OFF_H32);
    bf16_t* HB = (bf16_t*)(p.ws + OFF_HB);
    bf16_t* MIX = (bf16_t*)(p.ws + OFF_MIX);
    float2* ROPE = (float2*)(p.ws + OFF_ROPE);
    float (*tile)[65] = (float (*)[65])smem;
    constexpr int NCT_IN = (INW + 63) / 64, NT_IN = DEPTH * 16 * NCT_IN, NT_OUT = DEPTH * 16 * 16;
    for (int item = opaque_bid(); item < NT_IN + NT_OUT; item += gridDim.x) {
        const bool is_in = item < NT_IN;
        const int it = is_in ? item : item - NT_IN;
        const int nct = is_in ? NCT_IN : 16, ldw = is_in ? INW : D;
        const int l = it / (16 * nct), rem = it - l * 16 * nct, kt = rem / nct, ct = rem - kt * nct;
        const float* W = (is_in ? p.w_in : p.w_out) + (size_t)l * D * ldw;
        __syncthreads();
#pragma unroll
        for (int i = 0; i < 8; ++i) {
            const int e = tid + NT * i, kk = e >> 6, nn = e & 63, col = ct * 64 + nn;
            tile[kk][nn] = (col < ldw) ? W[(size_t)(kt * 64 + kk) * ldw + col] : 0.f;
        }
        __syncthreads();
        {
            const int nn = tid >> 3, k8 = (tid & 7) * 8, src = ct * 64 + nn;
            if (src < ldw) {
                const int dst = is_in ? proj_dst_col(src) : src;
                u32x4 o;
#pragma unroll
                for (int q = 0; q < 4; ++q) o[q] = cvt_pk_bf16(tile[k8 + 2 * q][nn], tile[k8 + 2 * q + 1][nn]);
                bf16_t* dstp = (is_in ? WIN + ((size_t)l * INWP + dst) * D : WOUT + ((size_t)l * D + dst) * D) + kt * 64 + k8;
                *(u32x4*)dstp = o;
            }
        }
    }
    {
        const int nw = gridDim.x * 8;
        for (int t = opaque_bid() * 8 + wid; t < TP; t += nw) {
            if (t < T) {
                const int b = t / L, pos = t - b * L;
                const float* src = (pos < NMETA) ? (p.meta + (size_t)pos * D) : (p.x + ((size_t)b * SEQ + (pos - NMETA)) * D);
                f32x4 v[4];
#pragma unroll
                for (int i = 0; i < 4; ++i) v[i] = *(const f32x4*)(src + 4 * lane + 256 * i);
                ln_row_wave(v, p.ln_in_g, p.ln_in_b, lane);
#pragma unroll
                for (int i = 0; i < 4; ++i) {
                    *(f32x4*)(H32 + (size_t)t * D + 4 * lane + 256 * i) = v[i];
                    u32x2 o; o[0] = cvt_pk_bf16(v[i][0], v[i][1]); o[1] = cvt_pk_bf16(v[i][2], v[i][3]);
                    *(u32x2*)(HB + (size_t)t * D + 4 * lane + 256 * i) = o;
                }
            } else {
#pragma unroll
                for (int i = 0; i < 4; ++i) {
                    *(u32x2*)(HB + (size_t)t * D + 4 * lane + 256 * i) = (u32x2){0u, 0u};
                    *(u32x2*)(MIX + (size_t)t * D + 4 * lane + 256 * i) = (u32x2){0u, 0u};
                }
            }
        }
    }
    for (int e = opaque_bid() * NT + tid; e < L * 8; e += gridDim.x * NT) {
        const int pos = e >> 3, i = e & 7;
        const float inv[8] = {1.0f, 0.19392274f, 0.03760603f, 0.0072926646f, 0.0014142136f, 0.0002742482f, 5.3182957e-05f, 1.0313385e-05f};
        float iv = inv[0];
#pragma unroll
        for (int j = 1; j < 8; ++j) iv = (i == j) ? inv[j] : iv;
        const float ang = (float)pos * iv;
        float sn, cs; sincos_acc(ang, sn, cs);
        ROPE[e] = make_float2(cs, sn);
    }
}

namespace pg8 {
constexpr int BM = 256, BK = 64, HALF = 128, HTB = HALF * BK * 2  , STAGE_BYTES = 8 * HTB, NXCD = 8, WGM = 8;
__device__ __forceinline__ int lds_byte(int r, int c) { const int st = (r >> 4) * 2 + (c >> 5), rr = r & 15, cc = c & 31, ob = rr * 64 + cc * 2; return st * 1024 + (ob ^ (((ob >> 9) & 1) << 5)); }
__device__ __forceinline__ void stage_rc(int b, int& R, int& C) { const int st = b / 1024, sb = b % 1024, swz = sb ^ (((sb >> 9) & 1) << 5); R = (st >> 1) * 16 + swz / 64; C = (st & 1) * 32 + (swz % 64) / 2; }
__device__ __forceinline__ int perm32(int rho) { const int n = rho >> 4, i = rho & 15; return 8 * (i >> 2) + 4 * n + (i & 3); }

struct Unit { int pm, pn; };
struct Gemm { const bf16_t* A; const bf16_t* Bt; int M, N, K; };

struct StaticOrder {
    int nM, nN, nwg, G, c;
    __device__ void init(int M, int N, int G_, int c_) { nM = M / BM; nN = N / BM; nwg = nM * nN; G = G_; c = c_; }
    __device__ bool next(int i, Unit& u) const {
        const long Lx = (long)i * G + c; if (Lx >= nwg) return false;
        int wgid = (int)Lx; { const int q = nwg / NXCD, r = nwg % NXCD, xcd = wgid % NXCD, off = wgid / NXCD; wgid = (xcd < r ? xcd * (q + 1) : r * (q + 1) + (xcd - r) * q) + off; }
        const int nig = WGM * nN, gid = wgid / nig, fm = gid * WGM, gsz = (nM - fm) < WGM ? (nM - fm) : WGM;
        u.pm = fm + ((wgid % nig) % gsz); u.pn = (wgid % nig) / gsz; return true;
    }
    __device__ __forceinline__ void a_ready(const Unit&) const {}
    __device__ __forceinline__ void done(const Unit&) const {}
};

template <class Epi, class Sched>
__device__ __forceinline__ void gemm_phase(LAS unsigned char* lds, const Gemm g, const Sched& S, const Epi& E) {
    const int tid = opaque_tid(), wid = __builtin_amdgcn_readfirstlane(tid >> 6), lane = tid & 63, wr = wid >> 2, wc = wid & 3, fr = lane & 15, fq = lane >> 4;
    const int K = g.K, nt = K / BK;
    unsigned voffA[2], voffB[2];
#pragma unroll
    for (int i = 0; i < 2; ++i) { int R, C; stage_rc(tid * 16 + i * 8192, R, C); const int Rb = Epi::PERM ? ((R & ~31) + perm32(R & 31)) : R;
        voffA[i] = (unsigned)(R * K + C) * 2u; voffB[i] = (unsigned)(Rb * K + C) * 2u; }
    const size_t kstep = (size_t)(BK * 2);
    const size_t hstep = (size_t)HALF * K * 2;
    const size_t tstep = 2 * hstep;
    const unsigned ldsw = (unsigned)wid * 1024u;
    const int aoff = lds_byte(wr * 64 + fr, fq * 8), boff = lds_byte(wc * 32 + fr, fq * 8);
#define PG8_SA(b, h) (((b) * 2 + (h)) * HTB)
#define PG8_SB(b, h) ((4 + (b) * 2 + (h)) * HTB)
#define PG8_STAGE(bufoff, gbase, voff) do { _Pragma("unroll") for (int _i = 0; _i < 2; ++_i) \
        __builtin_amdgcn_global_load_lds((const unsigned*)((const char*)(gbase) + (voff)[_i]), (LAS unsigned*)(lds + (bufoff) + ldsw + _i * 8192), 16, 0, 0); } while (0)
#define PG8_LDA(dst, b, h) do { _Pragma("unroll") for (int m = 0; m < 4; ++m) _Pragma("unroll") for (int k = 0; k < 2; ++k) dst[m][k] = *(const LAS bf16x8*)(lds + PG8_SA(b, h) + aoff + m * 2048 + k * 1024); } while (0)
#define PG8_LDB(dst, b, h) do { _Pragma("unroll") for (int n = 0; n < 2; ++n) _Pragma("unroll") for (int k = 0; k < 2; ++k) dst[n][k] = *(const LAS bf16x8*)(lds + PG8_SB(b, h) + boff + n * 2048 + k * 1024); } while (0)
#define PG8_MMA(ai, bj, At, Bt) do { __builtin_amdgcn_s_setprio(1); _Pragma("unroll") for (int m = 0; m < 4; ++m) _Pragma("unroll") for (int n = 0; n < 2; ++n) _Pragma("unroll") for (int k = 0; k < 2; ++k) \
        acc[ai][bj][m][n] = __builtin_amdgcn_mfma_f32_16x16x32_bf16(Bt[n][k], At[m][k], acc[ai][bj][m][n], 0, 0, 0); __builtin_amdgcn_s_setprio(0); } while (0)
#define PG8_WAIT_V(n) asm volatile("s_waitcnt vmcnt(" #n ")" ::: "memory")
#define PG8_WAIT_L(n) asm volatile("s_waitcnt lgkmcnt(" #n ")" ::: "memory")
#define PG8_BAR __builtin_amdgcn_s_barrier()
#define PG8_SCHED __builtin_amdgcn_sched_barrier(0)
    Unit cur, nxt; int ui = 0;
    if (!S.next(0, cur)) return;
    f32x4 acc[2][2][4][2];
#pragma unroll
    for (int a = 0; a < 2; ++a)
#pragma unroll
        for (int b = 0; b < 2; ++b)
#pragma unroll
            for (int m = 0; m < 4; ++m)
#pragma unroll
                for (int n = 0; n < 2; ++n) acc[a][b][m][n] = (f32x4){0.f, 0.f, 0.f, 0.f};
    bf16x8 At[4][2], B0[2][2], B1[2][2];
    const char* cA = (const char*)g.A + (size_t)cur.pm * tstep; const char* cB = (const char*)g.Bt + (size_t)cur.pn * tstep;
    S.a_ready(cur);
    PG8_STAGE(PG8_SB(0, 0), cB, voffB); PG8_STAGE(PG8_SA(0, 0), cA, voffA); PG8_STAGE(PG8_SB(0, 1), cB + hstep, voffB); PG8_STAGE(PG8_SA(0, 1), cA + hstep, voffA);
    if (wr == 1) PG8_BAR;
    PG8_WAIT_V(4); PG8_BAR;
    PG8_STAGE(PG8_SB(1, 0), cB + kstep, voffB); PG8_STAGE(PG8_SA(1, 0), cA + kstep, voffA); PG8_STAGE(PG8_SB(1, 1), cB + hstep + kstep, voffB);
    PG8_WAIT_V(6); PG8_BAR;
    for (;;) {
        const bool has_next = S.next(ui + 1, nxt);
        const char* nA = has_next ? (const char*)g.A + (size_t)nxt.pm * tstep : cA; const char* nB = has_next ? (const char*)g.Bt + (size_t)nxt.pn * tstep : cB;
        for (int t = 0; t < nt; t += 2) {
            const bool last = (t == nt - 2);
            const char* a1 = cA + (size_t)(t + 1) * kstep;
            const char* a2 = last ? nA : cA + (size_t)(t + 2) * kstep; const char* b2 = last ? nB : cB + (size_t)(t + 2) * kstep;
            const char* a3 = a2 + kstep; const char* b3 = b2 + kstep;
            if (last && has_next) S.a_ready(nxt);
            PG8_LDB(B0, 0, 0); PG8_SCHED; PG8_LDA(At, 0, 0); PG8_STAGE(PG8_SA(1, 1), a1 + hstep, voffA);
            PG8_WAIT_L(8); PG8_BAR; PG8_WAIT_L(0); PG8_MMA(0, 0, At, B0); PG8_BAR; PG8_SCHED;
            PG8_LDB(B1, 0, 1); PG8_STAGE(PG8_SB(0, 0), b2, voffB);
            PG8_BAR; PG8_WAIT_L(0); PG8_MMA(0, 1, At, B1); PG8_BAR;
            PG8_LDA(At, 0, 1); PG8_STAGE(PG8_SA(0, 0), a2, voffA);
            PG8_BAR; PG8_WAIT_L(0); PG8_MMA(1, 0, At, B0); PG8_BAR; PG8_SCHED;
            PG8_STAGE(PG8_SB(0, 1), b2 + hstep, voffB);
            PG8_WAIT_V(6); PG8_BAR; PG8_MMA(1, 1, At, B1); PG8_BAR;
            PG8_LDB(B0, 1, 0); PG8_SCHED; PG8_LDA(At, 1, 0); PG8_STAGE(PG8_SA(0, 1), a2 + hstep, voffA);
            PG8_WAIT_L(8); PG8_BAR; PG8_WAIT_L(0); PG8_MMA(0, 0, At, B0); PG8_BAR; PG8_SCHED;
            PG8_LDB(B1, 1, 1); PG8_STAGE(PG8_SB(1, 0), b3, voffB);
            PG8_BAR; PG8_WAIT_L(0); PG8_MMA(0, 1, At, B1); PG8_BAR;
            PG8_LDA(At, 1, 1); PG8_STAGE(PG8_SA(1, 0), a3, voffA);
            PG8_BAR; PG8_WAIT_L(0); PG8_MMA(1, 0, At, B0); PG8_BAR; PG8_SCHED;
            PG8_STAGE(PG8_SB(1, 1), b3 + hstep, voffB);
            PG8_WAIT_V(6); PG8_BAR; PG8_MMA(1, 1, At, B1); PG8_BAR;
        }
        E(acc, cur, wr, wc, fr, fq); S.done(cur);
        if (!has_next) break;
#pragma unroll
        for (int a = 0; a < 2; ++a)
#pragma unroll
            for (int b = 0; b < 2; ++b)
#pragma unroll
                for (int m = 0; m < 4; ++m)
#pragma unroll
                    for (int n = 0; n < 2; ++n) acc[a][b][m][n] = (f32x4){0.f, 0.f, 0.f, 0.f};
        cur = nxt; cA = nA; cB = nB; ++ui;
    }
    PG8_WAIT_V(0);
    if (wr == 0) PG8_BAR;
    PG8_BAR;
#undef PG8_SA
#undef PG8_SB
#undef PG8_STAGE
#undef PG8_LDA
#undef PG8_LDB
#undef PG8_MMA
#undef PG8_WAIT_V
#undef PG8_WAIT_L
#undef PG8_BAR
#undef PG8_SCHED
}
}

struct EpiProj {
    static constexpr bool PERM = true;
    char* ws;
    __device__ __forceinline__ void store8(bf16_t* dst, const f32x4& a, const f32x4& b, float sc) const {
        u32x4 o; o[0] = cvt_pk_bf16(a[0] * sc, a[1] * sc); o[1] = cvt_pk_bf16(a[2] * sc, a[3] * sc); o[2] = cvt_pk_bf16(b[0] * sc, b[1] * sc); o[3] = cvt_pk_bf16(b[2] * sc, b[3] * sc);
        *(u32x4*)dst = o;
    }
    __device__ __forceinline__ void operator()(const f32x4 (&acc)[2][2][4][2], const pg8::Unit& u, int wr, int wc, int fr, int fq) const {
        asm volatile("" : "+v"(fr), "+v"(fq));
        if (u.pn < 13) {
#pragma unroll
            for (int bj = 0; bj < 2; ++bj) {
                const int hb = 4 * u.pn + 2 * bj + (wc >> 1);
                const int cc8 = 32 * (wc & 1) + 8 * fq;
#pragma unroll
                for (int ai = 0; ai < 2; ++ai)
#pragma unroll
                    for (int m = 0; m < 4; ++m) {
                        const int t = 256 * u.pm + 128 * ai + 64 * wr + 16 * m + fr;
                        const f32x4 v0 = acc[ai][bj][m][0], v1 = acc[ai][bj][m][1];
                        if (t < T) {
                            const size_t tt = (size_t)t;
                            if (hb < 4) store8((bf16_t*)(ws + OFF_GQ) + tt * 256 + hb * 64 + cc8, v0, v1, 0.125f);
                            else if (hb < 8) store8((bf16_t*)(ws + OFF_GK) + tt * 256 + (hb - 4) * 64 + cc8, v0, v1, 1.f);
                            else if (hb < 16) {
                                const int bq = t / L, pos = t - bq * L;
                                bf16_t* dst = (bf16_t*)(ws + OFF_GV) + ((size_t)(bq * 4 + ((hb - 8) >> 1)) * 128 + ((hb - 8) & 1) * 64 + cc8) * LPV + 48 + pos;
#pragma unroll
                                for (int j = 0; j < 4; ++j) { dst[(size_t)j * LPV] = f2bf(v0[j]); dst[(size_t)(4 + j) * LPV] = f2bf(v1[j]); }
                            }
                            else if (hb < 24 || (hb >= 32 && hb < 40)) {
                                f32x4 s0, s1;
#pragma unroll
                                for (int j = 0; j < 4; ++j) { s0[j] = silu_f(v0[j]); s1[j] = silu_f(v1[j]); }
                                const int col = (hb < 24) ? (hb - 16) * 64 : 512 + (hb - 32) * 64;
                                store8((bf16_t*)(ws + OFF_MIX) + tt * 1024 + col + cc8, s0, s1, 1.f);
                            }
                            else if (hb < 32) store8((bf16_t*)(ws + OFF_AQ) + tt * 512 + (hb - 24) * 64 + cc8, v0, v1, 0.125f);
                            else if (hb < 48) store8((bf16_t*)(ws + OFF_IQ) + tt * 512 + (hb - 40) * 64 + cc8, v0, v1, 0.125f);
                            else if (hb < 50) store8((bf16_t*)(ws + OFF_AK) + tt * 128 + (hb - 48) * 64 + cc8, v0, v1, 1.f);
                            else {
                                const int bq = t / L, pos = t - bq * L;
                                bf16_t* dst = (bf16_t*)(ws + OFF_AV) + ((size_t)(bq * 2 + (hb - 50)) * 64 + cc8) * LP + pos;
#pragma unroll
                                for (int j = 0; j < 4; ++j) { dst[(size_t)j * LP] = f2bf(v0[j]); dst[(size_t)(4 + j) * LP] = f2bf(v1[j]); }
                            }
                        }
                        asm volatile("" ::: "memory");
                    }
            }
        } else {
#pragma unroll
            for (int ai = 0; ai < 2; ++ai)
#pragma unroll
                for (int m = 0; m < 4; ++m) {
                    const int t = 256 * u.pm + 128 * ai + 64 * wr + 16 * m + fr;
                    if (t < T) {
                        if (wc == 0) {
                            float* dst = (float*)(ws + OFF_IKR) + (size_t)t * 64 + 8 * fq;
                            *(f32x4*)dst = acc[ai][0][m][0]; *(f32x4*)(dst + 4) = acc[ai][0][m][1];
                            *(f32x4*)(dst + 32) = acc[ai][1][m][0]; *(f32x4*)(dst + 36) = acc[ai][1][m][1];
                        } else if (wc == 1) {
                            const f32x4 v0 = acc[ai][0][m][0], v1 = acc[ai][0][m][1];
                            if (fq < 2) {
                                float* dst = (float*)(ws + OFF_GLR) + (size_t)t * 16 + 8 * fq;
                                *(f32x4*)dst = v0; *(f32x4*)(dst + 4) = v1;
                            } else if (fq == 2) {
                                float* dst = (float*)(ws + OFF_IW) + (size_t)t * 8;
                                *(f32x4*)dst = v0 * 0.353553390593273762f; *(f32x4*)(dst + 4) = v1 * 0.353553390593273762f;
                            }
                        }
                    }
                    asm volatile("" ::: "memory");
                }
        }
    }
};

struct EpiOut {
    static constexpr bool PERM = false;
    const float* H32; float* Z;
    __device__ __forceinline__ void operator()(const f32x4 (&acc)[2][2][4][2], const pg8::Unit& u, int wr, int wc, int fr, int fq) const {
        asm volatile("" : "+v"(fr), "+v"(fq));
        const int col0 = u.pn * 256 + wc * 32 + 4 * fq;
#pragma unroll
        for (int ai = 0; ai < 2; ++ai) {
            f32x4 hv[4][2][2];
#pragma unroll
            for (int m = 0; m < 4; ++m) {
                int t = 256 * u.pm + 128 * ai + 64 * wr + 16 * m + fr; t = t < T ? t : T - 1;
                const size_t off = (size_t)t * D + col0;
#pragma unroll
                for (int bj = 0; bj < 2; ++bj)
#pragma unroll
                    for (int n = 0; n < 2; ++n) hv[m][bj][n] = *(const f32x4*)(H32 + off + bj * 128 + n * 16);
            }
#pragma unroll
            for (int m = 0; m < 4; ++m) {
                const int t = 256 * u.pm + 128 * ai + 64 * wr + 16 * m + fr;
                if (t < T) {
                    const size_t off = (size_t)t * D + col0;
#pragma unroll
                    for (int bj = 0; bj < 2; ++bj)
#pragma unroll
                        for (int n = 0; n < 2; ++n) *(f32x4*)(Z + off + bj * 128 + n * 16) = acc[ai][bj][m][n] + hv[m][bj][n] * ALPHA;
                }
            }
            asm volatile("" ::: "memory");
        }
    }
};

__device__ __forceinline__ void phase_proj(const Params& p_in, int layer_in, char* smem) {
    const Params p = kparams(); const int layer = opaque_int(layer_in); (void)p_in;
    pg8::Gemm g; g.A = (const bf16_t*)(p.ws + OFF_HB); g.Bt = (const bf16_t*)(p.ws + OFF_WIN) + (size_t)layer * INWP * D; g.M = TP; g.N = INWP; g.K = D;
    pg8::StaticOrder S; S.init(TP, INWP, gridDim.x, opaque_bid());
    EpiProj E; E.ws = p.ws;
    pg8::gemm_phase((LAS unsigned char*)smem, g, S, E);
}
__device__ __forceinline__ void phase_outproj(const Params& p_in, int layer_in, char* smem) {
    const Params p = kparams(); const int layer = opaque_int(layer_in); (void)p_in;
    const bf16_t* MIXp = (const bf16_t*)(p.ws + OFF_MIX);
    const bf16_t* WOUT = (const bf16_t*)(p.ws + OFF_WOUT) + (size_t)layer * D * D;
    const float* H32 = (const float*)(p.ws + OFF_H32);
    float* Z = (float*)(p.ws + OFF_GQ);
    {
        pg8::Gemm g; g.A = MIXp; g.Bt = WOUT; g.M = 16384; g.N = D; g.K = D;
        pg8::StaticOrder S; S.init(16384, D, gridDim.x, opaque_bid());
        EpiOut E; E.H32 = H32; E.Z = Z;
        pg8::gemm_phase((LAS unsigned char*)smem, g, S, E);
    }
    const int tid = opaque_tid(), wid = __builtin_amdgcn_readfirstlane(tid >> 6), lane = tid & 63, fr = lane & 15, fq = lane >> 4;
    for (int task = opaque_bid(); task < 64; task += gridDim.x) {
        const int rg = task >> 3, cs = task & 7;
        const bf16_t* ap = MIXp + (size_t)(16384 + 16 * rg + fr) * D + 8 * fq;
        const bf16_t* bp = WOUT + (size_t)(128 * cs + 16 * wid + fr) * D + 8 * fq;
        f32x4 acc = {0.f, 0.f, 0.f, 0.f};
        bf16x8 a0[8], b0[8], a1[8], b1[8];
#pragma unroll
        for (int k = 0; k < 8; ++k) { a0[k] = *(const bf16x8*)(ap + 32 * k); b0[k] = *(const bf16x8*)(bp + 32 * k); }
#pragma unroll
        for (int ch = 0; ch < 4; ++ch) {
            if (ch < 3) {
#pragma unroll
                for (int k = 0; k < 8; ++k) { a1[k] = *(const bf16x8*)(ap + 256 * (ch + 1) + 32 * k); b1[k] = *(const bf16x8*)(bp + 256 * (ch + 1) + 32 * k); }
            }
#pragma unroll
            for (int k = 0; k < 8; ++k) acc = __builtin_amdgcn_mfma_f32_16x16x32_bf16(a0[k], b0[k], acc, 0, 0, 0);
#pragma unroll
            for (int k = 0; k < 8; ++k) { a0[k] = a1[k]; b0[k] = b1[k]; }
        }
#pragma unroll
        for (int r = 0; r < 4; ++r) {
            const size_t off = (size_t)(16384 + 16 * rg + 4 * fq + r) * D + 128 * cs + 16 * wid + fr;
            Z[off] = acc[r] + ALPHA * H32[off];
        }
    }
}

__device__ __forceinline__ void phase_gla_naive(const Params& p, int layer, char* smem) {
    float (*qs)[64] = (float (*)[64])smem;
    float (*ks)[64] = qs + 8;
    float (*es)[64] = ks + 8;
    float (*part)[8] = (float (*)[8])(es + 8);
    float (*os)[128] = (float (*)[128])(part + 2);
    const int tid = opaque_tid();
    const bf16_t* GQ = (const bf16_t*)(p.ws + OFF_GQ);
    const bf16_t* GK = (const bf16_t*)(p.ws + OFF_GK);
    const bf16_t* GV = (const bf16_t*)(p.ws + OFF_GV);
    const float* GLR = (const float*)(p.ws + OFF_GLR);
    bf16_t* MIX = (bf16_t*)(p.ws + OFF_MIX);
    const float* ng = p.norm_g + layer * 128;
    const float* wg2 = p.wg2 + (size_t)layer * 16 * 256; const float* bg = p.bg + layer * 256;
    for (int item = opaque_bid(); item < NB * 4; item += gridDim.x) {
        const int b = item >> 2, h = item & 3;
        float S[64];
#pragma unroll
        for (int d = 0; d < 64; ++d) S[d] = 0.f;
        const int e = tid & 127;
        const float nge = ng[e];
        const int ltt = tid >> 6, ld = tid & 63;
        float w[16];
#pragma unroll
        for (int rr = 0; rr < 16; ++rr) w[rr] = wg2[rr * 256 + h * 64 + ld];
        const float bgd = bg[h * 64 + ld];
        for (int t0 = 0; t0 < L; t0 += 8) {
            __syncthreads();
            {
                const size_t row = (size_t)b * L + t0 + ltt;
                qs[ltt][ld] = bf2f(GQ[row * 256 + h * 64 + ld]);
                ks[ltt][ld] = bf2f(GK[row * 256 + h * 64 + ld]);
                const float4* gp = (const float4*)&GLR[row * 16];
                const float4 g0 = gp[0], g1 = gp[1], g2 = gp[2], g3 = gp[3];
                float s = bgd;
                s = fmaf(g0.x, w[0], s); s = fmaf(g0.y, w[1], s); s = fmaf(g0.z, w[2], s); s = fmaf(g0.w, w[3], s);
                s = fmaf(g1.x, w[4], s); s = fmaf(g1.y, w[5], s); s = fmaf(g1.z, w[6], s); s = fmaf(g1.w, w[7], s);
                s = fmaf(g2.x, w[8], s); s = fmaf(g2.y, w[9], s); s = fmaf(g2.z, w[10], s); s = fmaf(g2.w, w[11], s);
                s = fmaf(g3.x, w[12], s); s = fmaf(g3.y, w[13], s); s = fmaf(g3.z, w[14], s); s = fmaf(g3.w, w[15], s);
                es[ltt][ld] = expf(logsigmoid_f(s) * (1.f / 16.f));
            }
            __syncthreads();
            if (tid < 128) {
#pragma unroll 1
                for (int tt = 0; tt < 8; ++tt) {
                    const size_t row = (size_t)b * L + t0 + tt;
                    const float v = bf2f(GV[row * 512 + h * 128 + e]);
                    float acc = 0.f;
#pragma unroll
                    for (int d = 0; d < 64; ++d) {
                        S[d] = fmaf(es[tt][d], S[d], ks[tt][d] * v);
                        acc = fmaf(qs[tt][d], S[d], acc);
                    }
                    os[tt][e] = acc;
                    const float ss = wave_sum(acc * acc);
                    if ((tid & 63) == 0) part[tid >> 6][tt] = ss;
                }
            }
            __syncthreads();
            if (tid < 128) {
#pragma unroll 1
                for (int tt = 0; tt < 8; ++tt) {
                    const size_t row = (size_t)b * L + t0 + tt;
                    const float tot = part[0][tt] + part[1][tt];
                    const float rinv = rsqrtf(tot * (1.f / 128) + LN_EPS);
                    const size_t idx = row * 1024 + h * 128 + e;
                    MIX[idx] = f2bf(os[tt][e] * rinv * nge * bf2f(MIX[idx]));
                }
            }
        }
    }
}

__device__ __forceinline__ unsigned okey(float x) {
    const unsigned u = __float_as_uint(x);
    return (u & 0x80000000u) ? ~u : (u | 0x80000000u);
}
__device__ __forceinline__ int wave_incl_scan(int v) {
    const int lane = opaque_tid() & 63;
#pragma unroll
    for (int o = 1; o < 64; o <<= 1) { const int n = __shfl_up(v, o); if (lane >= o) v += n; }
    return v;
}
__device__ __forceinline__ int block_excl_scan(int v, int* tmp) {
    const int incl = wave_incl_scan(v);
    const int tq = opaque_tid();
    __syncthreads();
    if ((tq & 63) == 63) tmp[tq >> 6] = incl;
    __syncthreads();
    const int w = tq >> 6;
    int base = 0;
    for (int i = 0; i < w; ++i) base += tmp[i];
    return base + incl - v;
}
__device__ __forceinline__ void unpack8(const uint4 u, float* kf) {
    kf[0] = __uint_as_float(u.x << 16); kf[1] = __uint_as_float(u.x & 0xFFFF0000u);
    kf[2] = __uint_as_float(u.y << 16); kf[3] = __uint_as_float(u.y & 0xFFFF0000u);
    kf[4] = __uint_as_float(u.z << 16); kf[5] = __uint_as_float(u.z & 0xFFFF0000u);
    kf[6] = __uint_as_float(u.w << 16); kf[7] = __uint_as_float(u.w & 0xFFFF0000u);
}

__device__ __forceinline__ void phase_dsa_naive(const Params& p, int layer, char* smem) {
    float* sc = (float*)smem;
    float (*iqs)[64] = (float (*)[64])(sc + 2080);
    float (*aqs)[64] = iqs + 8;
    float (*lg)[256] = (float (*)[256])(aqs + 8);
    unsigned* hist = (unsigned*)(lg + 8);
    int* sel = (int*)(hist + 256);
    int* misc = sel + 256;
    const int tid = opaque_tid();
    const bf16_t* IQ = (const bf16_t*)(p.ws + OFF_IQ);
    const bf16_t* IK = (const bf16_t*)(p.ws + OFF_IK);
    const float* IW = (const float*)(p.ws + OFF_IW);
    const bf16_t* AQ = (const bf16_t*)(p.ws + OFF_AQ);
    const bf16_t* AK = (const bf16_t*)(p.ws + OFF_AK);
    const bf16_t* AV = (const bf16_t*)(p.ws + OFF_AV);
    bf16_t* MIX = (bf16_t*)(p.ws + OFF_MIX);
    for (int item = opaque_bid(); item < T; item += gridDim.x) {
        const int b = item / L, t = item % L;
        const size_t row = (size_t)item;
        __syncthreads();
        iqs[tid >> 6][tid & 63] = bf2f(IQ[row * 512 + tid]); aqs[tid >> 6][tid & 63] = bf2f(AQ[row * 512 + tid]);
        __syncthreads();
        float w[8];
#pragma unroll
        for (int j = 0; j < 8; ++j) w[j] = IW[row * 8 + j];
        for (int s = tid; s <= t; s += NT) {
            const uint4* kp = (const uint4*)&IK[((size_t)b * L + s) * 64];
            float dd[8];
#pragma unroll
            for (int j = 0; j < 8; ++j) dd[j] = 0.f;
#pragma unroll 1
            for (int q = 0; q < 8; ++q) {
                float kf[8]; unpack8(kp[q], kf);
#pragma unroll
                for (int j = 0; j < 8; ++j) {
                    const float4 a0 = *(const float4*)&iqs[j][q * 8], a1 = *(const float4*)&iqs[j][q * 8 + 4];
                    dd[j] = fmaf(a0.x, kf[0], dd[j]); dd[j] = fmaf(a0.y, kf[1], dd[j]); dd[j] = fmaf(a0.z, kf[2], dd[j]); dd[j] = fmaf(a0.w, kf[3], dd[j]);
                    dd[j] = fmaf(a1.x, kf[4], dd[j]); dd[j] = fmaf(a1.y, kf[5], dd[j]); dd[j] = fmaf(a1.z, kf[6], dd[j]); dd[j] = fmaf(a1.w, kf[7], dd[j]);
                }
            }
            float score = 0.f;
#pragma unroll
            for (int j = 0; j < 8; ++j) score = fmaf(w[j], fmaxf(dd[j], 0.f), score);
            sc[s] = score;
        }
        __syncthreads();
        const int n = t + 1;
        int nsel;
        if (n <= TOPK) {
            if (tid < n) sel[tid] = tid;
            nsel = n;
        } else {
            unsigned prefix = 0; int remaining = TOPK;
            for (int pass = 0; pass < 4; ++pass) {
                const int shift = 24 - 8 * pass;
                if (tid < 256) hist[tid] = 0;
                __syncthreads();
                for (int s = tid; s < n; s += NT) {
                    const unsigned key = okey(sc[s]);
                    const bool match = (pass == 0) || ((key >> (shift + 8)) == prefix);
                    if (match) atomicAdd(&hist[(key >> shift) & 255u], 1u);
                }
                __syncthreads();
                if (tid == 0) {
                    int cum = 0, d = 255;
                    for (; d > 0; --d) { const int c = (int)hist[d]; if (cum + c >= remaining) break; cum += c; }
                    misc[0] = d; misc[1] = remaining - cum;
                }
                __syncthreads();
                prefix = (prefix << 8) | (unsigned)misc[0]; remaining = misc[1];
                __syncthreads();
            }
            const int s0 = tid * 5;
            int ceq = 0;
#pragma unroll
            for (int q = 0; q < 5; ++q) { const int s = s0 + q; if (s < n && okey(sc[s]) == prefix) ++ceq; }
            int eqrank = block_excl_scan(ceq, misc + 8);
            int csel = 0; unsigned selmask = 0;
#pragma unroll
            for (int q = 0; q < 5; ++q) {
                const int s = s0 + q;
                if (s < n) {
                    const unsigned key = okey(sc[s]);
                    bool take = key > prefix;
                    if (key == prefix) { take = eqrank < remaining; ++eqrank; }
                    if (take) { ++csel; selmask |= 1u << q; }
                }
            }
            int posn = block_excl_scan(csel, misc + 16);
#pragma unroll
            for (int q = 0; q < 5; ++q) if (selmask & (1u << q)) { if (posn < TOPK) sel[posn] = s0 + q; ++posn; }
            nsel = TOPK;
        }
        __syncthreads();
        {
            const int i = tid & 255, g = tid >> 8;
            if (i < nsel) {
                const int kidx = sel[i];
                const uint4* kp = (const uint4*)&AK[((size_t)b * L + kidx) * 128 + g * 64];
                float dd[4] = {0.f, 0.f, 0.f, 0.f};
#pragma unroll 1
                for (int q = 0; q < 8; ++q) {
                    float kf[8]; unpack8(kp[q], kf);
#pragma unroll
                    for (int r = 0; r < 4; ++r) {
                        const float4 a0 = *(const float4*)&aqs[g * 4 + r][q * 8], a1 = *(const float4*)&aqs[g * 4 + r][q * 8 + 4];
                        dd[r] = fmaf(a0.x, kf[0], dd[r]); dd[r] = fmaf(a0.y, kf[1], dd[r]); dd[r] = fmaf(a0.z, kf[2], dd[r]); dd[r] = fmaf(a0.w, kf[3], dd[r]);
                        dd[r] = fmaf(a1.x, kf[4], dd[r]); dd[r] = fmaf(a1.y, kf[5], dd[r]); dd[r] = fmaf(a1.z, kf[6], dd[r]); dd[r] = fmaf(a1.w, kf[7], dd[r]);
                    }
                }
#pragma unroll
                for (int r = 0; r < 4; ++r) lg[g * 4 + r][i] = dd[r];
            } else {
#pragma unroll
                for (int r = 0; r < 4; ++r) lg[g * 4 + r][i] = -INFINITY;
            }
        }
        __syncthreads();
        {
            const int h = tid >> 6, lane = tid & 63;
            float v0 = lg[h][lane], v1 = lg[h][lane + 64], v2 = lg[h][lane + 128], v3 = lg[h][lane + 192];
            const float m = wave_max(fmaxf(fmaxf(v0, v1), fmaxf(v2, v3)));
            v0 = expf(v0 - m); v1 = expf(v1 - m); v2 = expf(v2 - m); v3 = expf(v3 - m);
            const float inv = 1.f / wave_sum(v0 + v1 + v2 + v3);
            lg[h][lane] = v0 * inv; lg[h][lane + 64] = v1 * inv; lg[h][lane + 128] = v2 * inv; lg[h][lane + 192] = v3 * inv;
        }
        __syncthreads();
        {
            const int h = tid >> 6, d = tid & 63, g = h >> 2;
            float o = 0.f;
            for (int i = 0; i < nsel; ++i) o = fmaf(lg[h][i], bf2f(AV[((size_t)b * L + sel[i]) * 128 + g * 64 + d]), o);
            const size_t mi = row * 1024 + 512 + tid;
            MIX[mi] = f2bf(o * bf2f(MIX[mi]));
        }
    }
}


constexpr int DS_SC = 0, DS_BITS = 132096, DS_HIST = DS_BITS + 4224, DS_END = DS_HIST + 8 * 1040;
constexpr int DS_MB = 3 * 32768, DS_MBROW = 2112;
static_assert(DS_MB + 16 * DS_MBROW <= DS_BITS, "mask bytes overlap");


template <int NR>
__device__ __forceinline__ void dsa_select(const LAS unsigned* row, LAS unsigned* bits, LAS unsigned* hist, int n, int lane) {
    unsigned kreg[NR];
#pragma unroll
    for (int i = 0; i < NR; ++i) kreg[i] = (lane < n - 64 * i) ? row[lane + 64 * i] : 0u;
    unsigned prefix = 0; int remaining = TOPK;
#pragma unroll 1
    for (int pass = 0; pass < 4; ++pass) {
        const int shift = 24 - 8 * pass;
        *(LAS u32x4*)(hist + lane * 4) = (u32x4){0u, 0u, 0u, 0u};
        __builtin_amdgcn_wave_barrier(); asm volatile("" ::: "memory");
        const unsigned sh8 = (unsigned)(shift + 8) & 31u;
#pragma unroll
        for (int i = 0; i < NR; ++i) {
            const unsigned key = kreg[i];
            const bool match = (lane < n - 64 * i) && ((pass == 0) || ((key >> sh8) == prefix));
            if (match) __hip_atomic_fetch_add(hist + ((key >> shift) & 255u), 1u, __ATOMIC_RELAXED, __HIP_MEMORY_SCOPE_WAVEFRONT);
        }
        __builtin_amdgcn_wave_barrier(); asm volatile("s_waitcnt lgkmcnt(0)" ::: "memory");
        const u32x4 hv = *(const LAS u32x4*)(hist + (63 - lane) * 4);
        const int c0 = (int)hv[3], c1 = (int)hv[2], c2 = (int)hv[1], c3 = (int)hv[0];
        const int tot = c0 + c1 + c2 + c3;
        const int incl = wave_incl_scan(tot), excl = incl - tot;
        const bool found = (excl < remaining) && (remaining <= incl);
        int digit = 0, rem_new = 0;
        if (found) {
            int cum = excl;
            if (cum + c0 >= remaining) { digit = 255 - 4 * lane; rem_new = remaining - cum; }
            else { cum += c0;
                if (cum + c1 >= remaining) { digit = 254 - 4 * lane; rem_new = remaining - cum; }
                else { cum += c1;
                    if (cum + c2 >= remaining) { digit = 253 - 4 * lane; rem_new = remaining - cum; }
                    else { cum += c2; digit = 252 - 4 * lane; rem_new = remaining - cum; } } }
        }
        const unsigned long long fm = __ballot(found);
        const int src = (int)__builtin_ctzll(fm);
        digit = __builtin_amdgcn_readlane(digit, src); rem_new = __builtin_amdgcn_readlane(rem_new, src);
        prefix = (prefix << 8) | (unsigned)digit; remaining = rem_new;
    }
    const unsigned tkey = prefix;
    int eqcount = 0;
#pragma unroll
    for (int i = 0; i < 33; ++i) {
        if (i < NR) {
            const unsigned key = kreg[i < NR ? i : 0];
            const bool valid = lane < n - 64 * i;
            const bool gt = valid && (key > tkey), eq = valid && (key == tkey);
            const unsigned long long em = __ballot(eq);
            const int rank = eqcount + __popcll(em & ((1ull << lane) - 1ull));
            const bool sel = gt || (eq && rank < remaining);
            eqcount += __popcll(em);
            const unsigned long long sm = __ballot(sel);
            if (lane == 0) { bits[2 * i] = (unsigned)sm; bits[2 * i + 1] = (unsigned)(sm >> 32); }
        } else if (lane == 0) { bits[2 * i] = 0u; bits[2 * i + 1] = 0u; }
    }
}

__device__ __forceinline__ void phase_dsa(const Params& p_in, int layer_in, char* smem, bool do_store) {
    const Params p = kparams(); const int layer = opaque_int(layer_in); (void)p_in;
    const int tid = opaque_tid(), wid = __builtin_amdgcn_readfirstlane(tid >> 6), lane = tid & 63, fr = lane & 15, fq = lane >> 4;
    LAS unsigned char* lds = (LAS unsigned char*)smem;
    const bf16_t* IQ = (const bf16_t*)(p.ws + OFF_IQ);
    const bf16_t* IK = (const bf16_t*)(p.ws + OFF_IK);
    const float* IW = (const float*)(p.ws + OFF_IW);
    const bf16_t* AQ = (const bf16_t*)(p.ws + OFF_AQ);
    const bf16_t* AK = (const bf16_t*)(p.ws + OFF_AK);
    const bf16_t* AVT = (const bf16_t*)(p.ws + OFF_AV);
    bf16_t* MIX = (bf16_t*)(p.ws + OFF_MIX);
    constexpr int NITEM = NB * 129;
    for (int idx = opaque_bid(); idx < NITEM; idx += gridDim.x) {
        const int b = idx & 7, mm = idx >> 3;
        int qr;
        { const int seg = mm >> 5, jj = mm & 31; qr = (seg == 0) ? jj : (seg == 1) ? 63 - jj : (seg == 2) ? 64 + jj : (seg == 3) ? 127 - jj : 128; }
        const int qt = 128 - qr, t0 = qt * 16;
        const size_t rowq = (size_t)b * L + t0 + fr;
        __syncthreads();
        for (int repA = 0; repA < PROBE_DSA_A; ++repA) {
            bf16x8 qf[8][2];
#pragma unroll
            for (int jh = 0; jh < 8; ++jh)
#pragma unroll
                for (int s2 = 0; s2 < 2; ++s2) qf[jh][s2] = *(const bf16x8*)(IQ + rowq * 512 + jh * 64 + s2 * 32 + fq * 8);
            float w[8];
            { const f32x4 w0 = *(const f32x4*)(IW + rowq * 8), w1 = *(const f32x4*)(IW + rowq * 8 + 4);
              w[0] = w0[0]; w[1] = w0[1]; w[2] = w0[2]; w[3] = w0[3]; w[4] = w1[0]; w[5] = w1[1]; w[6] = w1[2]; w[7] = w1[3]; }
            const int ntile = qt + 1;
            const bf16x8 z8 = {0, 0, 0, 0, 0, 0, 0, 0};
            bf16x8 ka0 = z8, ka1 = z8, kb0 = z8, kb1 = z8, kc0 = z8, kc1 = z8;
            int kt = wid;
            if (kt < ntile) { const bf16_t* kp = IK + ((size_t)b * L + 16 * kt + fr) * 64 + fq * 8; ka0 = *(const bf16x8*)kp; ka1 = *(const bf16x8*)(kp + 32); }
            if (kt + 8 < ntile) { const bf16_t* kp = IK + ((size_t)b * L + 16 * (kt + 8) + fr) * 64 + fq * 8; kb0 = *(const bf16x8*)kp; kb1 = *(const bf16x8*)(kp + 32); }
            for (; kt < ntile; kt += 8) {
                if (kt + 16 < ntile) { const bf16_t* kp = IK + ((size_t)b * L + 16 * (kt + 16) + fr) * 64 + fq * 8; kc0 = *(const bf16x8*)kp; kc1 = *(const bf16x8*)(kp + 32); }
                f32x4 sc = {0.f, 0.f, 0.f, 0.f};
#pragma unroll
                for (int jh = 0; jh < 8; ++jh) {
                    f32x4 d = {0.f, 0.f, 0.f, 0.f};
                    d = __builtin_amdgcn_mfma_f32_16x16x32_bf16(ka0, qf[jh][0], d, 0, 0, 0);
                    d = __builtin_amdgcn_mfma_f32_16x16x32_bf16(ka1, qf[jh][1], d, 0, 0, 0);
#pragma unroll
                    for (int r = 0; r < 4; ++r) sc[r] = fmaf(w[jh], fmaxf(d[r], 0.f), sc[r]);
                }
                u32x4 ko;
#pragma unroll
                for (int r = 0; r < 4; ++r) ko[r] = okey(sc[r]);
                *(LAS u32x4*)(lds + DS_SC + (fr * 2064 + 16 * kt + 4 * fq) * 4) = ko;
                ka0 = kb0; ka1 = kb1; kb0 = kc0; kb1 = kc1;
            }
        }
        __syncthreads();
        for (int repB = 0; repB < PROBE_DSA_B; ++repB) {
            LAS unsigned* hist = (LAS unsigned*)(lds + DS_HIST + wid * 1040);
#pragma unroll 1
            for (int qq = 0; qq < 2; ++qq) {
                const int q = wid * 2 + qq;
                const int n = t0 + q + 1;
                const LAS unsigned* row = (const LAS unsigned*)(lds + DS_SC) + q * 2064;
                LAS unsigned* bits = (LAS unsigned*)(lds + DS_BITS) + q * 66;
                if (n <= TOPK) {
#pragma unroll 1
                    for (int i = 0; i < 33; ++i) {
                        const unsigned long long sm = __ballot(lane + 64 * i < n);
                        if (lane == 0) { bits[2 * i] = (unsigned)sm; bits[2 * i + 1] = (unsigned)(sm >> 32); }
                    }
                } else {
                    const int nr = (n + 63) >> 6;
                    if (nr <= 9) dsa_select<9>(row, bits, hist, n, lane);
                    else if (nr <= 17) dsa_select<17>(row, bits, hist, n, lane);
                    else if (nr <= 25) dsa_select<25>(row, bits, hist, n, lane);
                    else dsa_select<33>(row, bits, hist, n, lane);
                }
            }
        }
        __syncthreads();
        for (int repC = 0; repC < PROBE_DSA_C; ++repC) {
            if (repC > 0) __syncthreads();
            const int h = wid, g = h >> 2;
            const int nstep = (t0 + 16 + 63) >> 6;
            bf16x8 aqf[2];
            aqf[0] = *(const bf16x8*)(AQ + rowq * 512 + h * 64 + fq * 8);
            aqf[1] = *(const bf16x8*)(AQ + rowq * 512 + h * 64 + 32 + fq * 8);
            asm volatile("" : "+v"(aqf[0]), "+v"(aqf[1]));
            const int drow = 8 * wid + (lane >> 3);
            const int kch = (lane & 7) ^ (drow & 7), vch = (lane & 7) ^ ((drow >> 1) & 7);
            const bf16_t* vsrc0 = AVT + ((size_t)b * 128 + drow) * LP + vch * 8;
#define DSA_DMA(st_, buf_) do { \
                int krow_ = b * L + 64 * (st_) + drow; krow_ = krow_ < T ? krow_ : T - 1; \
                const bf16_t* ks_ = AK + (size_t)krow_ * 128 + kch * 8; \
                LAS unsigned char* lb_ = lds + (buf_) * 32768 + wid * 1024; \
                __builtin_amdgcn_global_load_lds((const unsigned*)ks_, (LAS unsigned*)lb_, 16, 0, 0); \
                __builtin_amdgcn_global_load_lds((const unsigned*)(ks_ + 64), (LAS unsigned*)(lb_ + 8192), 16, 0, 0); \
                __builtin_amdgcn_global_load_lds((const unsigned*)(vsrc0 + 64 * (st_)), (LAS unsigned*)(lb_ + 16384), 16, 0, 0); \
                __builtin_amdgcn_global_load_lds((const unsigned*)(vsrc0 + (size_t)64 * LP + 64 * (st_)), (LAS unsigned*)(lb_ + 24576), 16, 0, 0); } while (0)
            DSA_DMA(0, 0);
            DSA_DMA((nstep > 1 ? 1 : 0), 1);
            for (int wi = tid; wi < 16 * 66; wi += NT) {
                const int q = wi / 66, wd = wi - q * 66;
                const unsigned bw = *((const LAS unsigned*)(lds + DS_BITS) + wi);
                const int st = wd >> 1, hh = wd & 1;
#pragma unroll
                for (int f = 0; f < 4; ++f) {
                    const unsigned n0 = (bw >> (4 * f)) & 15u, n1 = (bw >> (16 + 4 * f)) & 15u;
                    u32x2 o; o.x = (n0 * 0x00204081u) & 0x01010101u; o.y = (n1 * 0x00204081u) & 0x01010101u;
                    *(LAS u32x2*)(lds + DS_MB + q * DS_MBROW + 64 * st + 16 * f + 8 * hh) = o;
                }
            }
            asm volatile("s_waitcnt vmcnt(4) lgkmcnt(0)" ::: "memory");
            __builtin_amdgcn_s_barrier();
            asm volatile("" ::: "memory");
            f32x4 O[4];
#pragma unroll
            for (int dt = 0; dt < 4; ++dt) O[dt] = (f32x4){0.f, 0.f, 0.f, 0.f};
            float m = -INFINITY, l = 0.f;
            const float C2 = 1.44269504088896341f;
            int buf = 0;
            for (int st = 0; st < nstep; ++st) {
                {
                    const int sn = (st + 2 < nstep) ? st + 2 : nstep - 1;
                    const int bn = (buf >= 1) ? buf - 1 : 2;
                    DSA_DMA(sn, bn);
                }
                const LAS unsigned char* sb = lds + buf * 32768;
                f32x4 S[4];
#pragma unroll
                for (int kt = 0; kt < 4; ++kt) {
                    S[kt] = (f32x4){0.f, 0.f, 0.f, 0.f};
#pragma unroll
                    for (int s2 = 0; s2 < 2; ++s2) {
                        const int rowk = 16 * kt + fr;
                        const bf16x8 kf = *(const LAS bf16x8*)(sb + g * 8192 + rowk * 128 + 16 * ((4 * s2 + fq) ^ (rowk & 7)));
                        S[kt] = __builtin_amdgcn_mfma_f32_16x16x32_bf16(kf, aqf[s2], S[kt], 0, 0, 0);
                    }
                }
                const u32x4 mb = *(const LAS u32x4*)(lds + DS_MB + fr * DS_MBROW + 64 * st + 16 * fq);
                float pmax = S[0][0];
#pragma unroll
                for (int kt = 0; kt < 4; ++kt)
#pragma unroll
                    for (int r = 0; r < 4; ++r) pmax = fmaxf(pmax, S[kt][r]);
                if (__any(pmax > m + 8.0f)) {
                    float pm = fmaxf(pmax, __shfl_xor(pmax, 16)); pm = fmaxf(pm, __shfl_xor(pm, 32));
                    const float mn = fmaxf(m, pm);
                    const float alpha = __builtin_amdgcn_exp2f((m - mn) * C2);
#pragma unroll
                    for (int dt = 0; dt < 4; ++dt) O[dt] *= alpha;
                    l *= alpha; m = mn;
                }
                const float mc = m * C2;
                unsigned pk[4][2];
#pragma unroll
                for (int kt = 0; kt < 4; ++kt) {
                    float pv[4];
#pragma unroll
                    for (int r = 0; r < 4; ++r) {
                        const float e = __builtin_amdgcn_exp2f(fmaf(S[kt][r], C2, -mc));
                        const float bf = (float)((mb[kt] >> (8 * r)) & 0xFFu);
                        pv[r] = e * bf; l += pv[r];
                    }
                    pk[kt][0] = cvt_pk_bf16(pv[0], pv[1]); pk[kt][1] = cvt_pk_bf16(pv[2], pv[3]);
                }
#pragma unroll
                for (int ks = 0; ks < 2; ++ks) {
                    u32x4 pw; pw[0] = pk[2 * ks][0]; pw[1] = pk[2 * ks][1]; pw[2] = pk[2 * ks + 1][0]; pw[3] = pk[2 * ks + 1][1];
                    const bf16x8 pf = __builtin_bit_cast(bf16x8, pw);
#pragma unroll
                    for (int dt = 0; dt < 4; ++dt) {
                        const int rowv = 16 * dt + fr, sw = (rowv >> 1) & 7;
                        const LAS unsigned char* vp = sb + 16384 + g * 8192 + rowv * 128 + 8 * (fq & 1);
                        const u32x2 va = *(const LAS u32x2*)(vp + 16 * ((4 * ks + (fq >> 1)) ^ sw));
                        const u32x2 vb = *(const LAS u32x2*)(vp + 16 * ((4 * ks + 2 + (fq >> 1)) ^ sw));
                        u32x4 vw; vw[0] = va[0]; vw[1] = va[1]; vw[2] = vb[0]; vw[3] = vb[1];
                        O[dt] = __builtin_amdgcn_mfma_f32_16x16x32_bf16(__builtin_bit_cast(bf16x8, vw), pf, O[dt], 0, 0, 0);
                    }
                }
                asm volatile("s_waitcnt vmcnt(4)" ::: "memory");
                __builtin_amdgcn_s_barrier();
                asm volatile("" ::: "memory");
                buf = (buf == 2) ? 0 : buf + 1;
            }
#undef DSA_DMA
            asm volatile("s_waitcnt vmcnt(0)" ::: "memory");
            l += __shfl_xor(l, 16); l += __shfl_xor(l, 32);
            const float inv = 1.f / fmaxf(l, 1e-30f);
            bf16_t* mp = MIX + rowq * 1024 + 512 + h * 64 + 4 * fq;
            if (do_store && repC == PROBE_DSA_C - 1)
#pragma unroll
            for (int dt = 0; dt < 4; ++dt) {
                const uint2 gz = *(const uint2*)(mp + 16 * dt);
                const float g0 = __uint_as_float(gz.x << 16), g1 = __uint_as_float(gz.x & 0xFFFF0000u), g2 = __uint_as_float(gz.y << 16), g3 = __uint_as_float(gz.y & 0xFFFF0000u);
                uint2 o; o.x = pack2bf(O[dt][0] * inv * g0, O[dt][1] * inv * g1); o.y = pack2bf(O[dt][2] * inv * g2, O[dt][3] * inv * g3);
                *(uint2*)(mp + 16 * dt) = o;
            }
        }
    }
}

__device__ __forceinline__ void rope16(const u32x4 a, const u32x4 b, const float2* rp, u32x4& oa, u32x4& ob) {
    const f32x4 r0 = *(const f32x4*)(rp), r1 = *(const f32x4*)(rp + 2), r2 = *(const f32x4*)(rp + 4), r3 = *(const f32x4*)(rp + 6);
    const float cs[8] = {r0[0], r0[2], r1[0], r1[2], r2[0], r2[2], r3[0], r3[2]};
    const float sn[8] = {r0[1], r0[3], r1[1], r1[3], r2[1], r2[3], r3[1], r3[3]};
    float o1[8], o2[8];
#pragma unroll
    for (int i = 0; i < 4; ++i) {
        const float x1l = __uint_as_float(a[i] << 16), x1h = __uint_as_float(a[i] & 0xFFFF0000u);
        const float x2l = __uint_as_float(b[i] << 16), x2h = __uint_as_float(b[i] & 0xFFFF0000u);
        o1[2 * i] = x1l * cs[2 * i] - x2l * sn[2 * i]; o1[2 * i + 1] = x1h * cs[2 * i + 1] - x2h * sn[2 * i + 1];
        o2[2 * i] = x2l * cs[2 * i] + x1l * sn[2 * i]; o2[2 * i + 1] = x2h * cs[2 * i + 1] + x1h * sn[2 * i + 1];
    }
#pragma unroll
    for (int i = 0; i < 4; ++i) { oa[i] = cvt_pk_bf16(o1[2 * i], o1[2 * i + 1]); ob[i] = cvt_pk_bf16(o2[2 * i], o2[2 * i + 1]); }
}
__device__ __forceinline__ void phase_rope(const Params& p_in, int layer_in, char* smem) {
    const Params p = kparams(); const int layer = opaque_int(layer_in); (void)p_in;
    const int tid = opaque_tid();
    const float2* ROPE = (const float2*)(p.ws + OFF_ROPE);
    const int nthr = gridDim.x * NT, gid = opaque_bid() * NT + tid;
    for (int th = gid; th < T * 18; th += nthr) {
        const int t = th / 18, hh = th - t * 18, pos = t % L;
        bf16_t* base = (hh < 8) ? (bf16_t*)(p.ws + OFF_AQ) + (size_t)t * 512 + hh * 64
                     : (hh < 16) ? (bf16_t*)(p.ws + OFF_IQ) + (size_t)t * 512 + (hh - 8) * 64
                                 : (bf16_t*)(p.ws + OFF_AK) + (size_t)t * 128 + (hh - 16) * 64;
        const u32x4 a = *(const u32x4*)base, b = *(const u32x4*)(base + 8);
        u32x4 oa, ob; rope16(a, b, ROPE + pos * 8, oa, ob);
        *(u32x4*)base = oa; *(u32x4*)(base + 8) = ob;
    }
    const float* IKR = (const float*)(p.ws + OFF_IKR);
    bf16_t* IK = (bf16_t*)(p.ws + OFF_IK);
    const float* ikg = p.ikg + layer * 64; const float* ikb = p.ikb + layer * 64;
    for (int t = gid; t < T; t += nthr) {
        const int pos = t % L;
        f32x4 x[16];
#pragma unroll
        for (int i = 0; i < 16; ++i) x[i] = *(const f32x4*)(IKR + (size_t)t * 64 + 4 * i);
        float sm = 0.f;
#pragma unroll
        for (int i = 0; i < 16; ++i) sm += (x[i][0] + x[i][1]) + (x[i][2] + x[i][3]);
        const float mu = sm * (1.f / 64);
        float qq = 0.f;
#pragma unroll
        for (int i = 0; i < 16; ++i) { const f32x4 d = x[i] - mu; qq += (d[0] * d[0] + d[1] * d[1]) + (d[2] * d[2] + d[3] * d[3]); }
        const float rs = rsqrtf(qq * (1.f / 64) + LN_EPS);
#pragma unroll
        for (int i = 0; i < 16; ++i) { const f32x4 g = *(const f32x4*)(ikg + 4 * i), bb = *(const f32x4*)(ikb + 4 * i); x[i] = (x[i] - mu) * rs * g + bb; }
        const float2* rp = ROPE + pos * 8;
        const f32x4 r0 = *(const f32x4*)(rp), r1 = *(const f32x4*)(rp + 2), r2 = *(const f32x4*)(rp + 4), r3 = *(const f32x4*)(rp + 6);
        const float cs[8] = {r0[0], r0[2], r1[0], r1[2], r2[0], r2[2], r3[0], r3[2]};
        const float sn[8] = {r0[1], r0[3], r1[1], r1[3], r2[1], r2[3], r3[1], r3[3]};
#pragma unroll
        for (int i = 0; i < 8; ++i) {
            const float x1 = x[i >> 2][i & 3], x2 = x[2 + (i >> 2)][i & 3];
            x[i >> 2][i & 3] = x1 * cs[i] - x2 * sn[i];
            x[2 + (i >> 2)][i & 3] = x2 * cs[i] + x1 * sn[i];
        }
#pragma unroll
        for (int i = 0; i < 8; ++i) {
            u32x4 o; o[0] = cvt_pk_bf16(x[2 * i][0], x[2 * i][1]); o[1] = cvt_pk_bf16(x[2 * i][2], x[2 * i][3]); o[2] = cvt_pk_bf16(x[2 * i + 1][0], x[2 * i + 1][1]); o[3] = cvt_pk_bf16(x[2 * i + 1][2], x[2 * i + 1][3]);
            *(u32x4*)(IK + (size_t)t * 64 + 8 * i) = o;
        }
    }
}

constexpr int GL_QE = 0, GL_KN = 8192, GL_SEG = 16384, GL_PART = 18432;
__device__ __forceinline__ void gla_cumsum(const Params& p, int layer, int b, int h, int c, int tid, LAS unsigned char* lds, float (&bc)[8], float& blast) {
    const int d = tid & 63, seg = tid >> 6;
    const float* wg2 = p.wg2 + (size_t)layer * 16 * 256 + h * 64 + d;
    float w[16];
#pragma unroll
    for (int rr = 0; rr < 16; ++rr) w[rr] = wg2[rr * 256];
    const float bgd = p.bg[layer * 256 + h * 64 + d];
    const float* GLR = (const float*)(p.ws + OFF_GLR);
    float pb = 0.f;
#pragma unroll
    for (int i = 0; i < 8; ++i) {
        const int pos = 64 * c - 48 + 8 * seg + i;
        float gl = 0.f;
        if (pos >= 0) {
            const f32x4* gp = (const f32x4*)(GLR + ((size_t)b * L + pos) * 16);
            const f32x4 g0 = gp[0], g1 = gp[1], g2 = gp[2], g3 = gp[3];
            float x = bgd;
#pragma unroll
            for (int rr = 0; rr < 4; ++rr) { x = fmaf(g0[rr], w[rr], x); }
#pragma unroll
            for (int rr = 0; rr < 4; ++rr) { x = fmaf(g1[rr], w[4 + rr], x); }
#pragma unroll
            for (int rr = 0; rr < 4; ++rr) { x = fmaf(g2[rr], w[8 + rr], x); }
#pragma unroll
            for (int rr = 0; rr < 4; ++rr) { x = fmaf(g3[rr], w[12 + rr], x); }
            gl = logsigmoid_fast(x) * (1.f / 16.f);
        }
        pb += gl; bc[i] = pb;
    }
    LAS float* segs = (LAS float*)(lds + GL_SEG);
    segs[seg * 64 + d] = pb;
    __syncthreads();
    float base = 0.f, tot = 0.f;
#pragma unroll
    for (int sg = 0; sg < 8; ++sg) { const float v = segs[sg * 64 + d]; tot += v; base += (sg < seg) ? v : 0.f; }
#pragma unroll
    for (int i = 0; i < 8; ++i) bc[i] += base;
    blast = tot;
}

__device__ __forceinline__ void phase_gla_a(const Params& p_in, int layer_in, char* smem) {
    const Params p = kparams(); const int layer = opaque_int(layer_in); (void)p_in;
    const int tid = opaque_tid(), wid = __builtin_amdgcn_readfirstlane(tid >> 6), lane = tid & 63, fr = lane & 15, fq = lane >> 4;
    LAS unsigned char* lds = (LAS unsigned char*)smem;
    const bf16_t* GK = (const bf16_t*)(p.ws + OFF_GK);
    const bf16_t* GVT = (const bf16_t*)(p.ws + OFF_GV);
    float* UT = (float*)(p.ws + OFF_UT);
    float* DL = (float*)(p.ws + OFF_DL);
    for (int task = opaque_bid(); task < 1024; task += gridDim.x) {
        const int bh = task >> 5, c = task & 31, b = bh >> 2, h = bh & 3;
        __syncthreads();
        float bc[8], blast;
        gla_cumsum(p, layer, b, h, c, tid, lds, bc, blast);
        {
            const int d = tid & 63, seg = tid >> 6;
            float ke[8];
#pragma unroll
            for (int i = 0; i < 8; ++i) {
                const int pos = 64 * c - 48 + 8 * seg + i;
                const float kv = (pos >= 0) ? bf2f(GK[((size_t)b * L + pos) * 256 + h * 64 + d]) : 0.f;
                ke[i] = kv * __expf(blast - bc[i]);
            }
            u32x4 o; o[0] = cvt_pk_bf16(ke[0], ke[1]); o[1] = cvt_pk_bf16(ke[2], ke[3]); o[2] = cvt_pk_bf16(ke[4], ke[5]); o[3] = cvt_pk_bf16(ke[6], ke[7]);
            *(LAS u32x4*)(lds + GL_QE + d * 128 + 16 * (seg ^ (d & 7))) = o;
            if (seg == 0) DL[(size_t)task * 64 + d] = __expf(blast);
        }
        __syncthreads();
        bf16x8 vf[2];
        {
            const bf16_t* vp = GVT + ((size_t)bh * 128 + 16 * wid + fr) * LPV + 64 * c + 8 * fq;
            vf[0] = *(const bf16x8*)vp; vf[1] = *(const bf16x8*)(vp + 32);
            const bf16x8 z8 = {0, 0, 0, 0, 0, 0, 0, 0};
            if (c == 0) { vf[0] = z8; if (fq < 2) vf[1] = z8; }
        }
#pragma unroll
        for (int dt = 0; dt < 4; ++dt) {
            f32x4 acc = {0.f, 0.f, 0.f, 0.f};
#pragma unroll
            for (int ks = 0; ks < 2; ++ks) {
                const int rowd = 16 * dt + fr;
                const bf16x8 kf = *(const LAS bf16x8*)(lds + GL_QE + rowd * 128 + 16 * ((4 * ks + fq) ^ (rowd & 7)));
                acc = __builtin_amdgcn_mfma_f32_16x16x32_bf16(vf[ks], kf, acc, 0, 0, 0);
            }
            float* up = UT + ((size_t)task * 128 + 16 * wid + 4 * fq) * 64 + 16 * dt + fr;
#pragma unroll
            for (int r = 0; r < 4; ++r) up[r * 64] = acc[r];
        }
    }
}

__device__ __forceinline__ void phase_gla_scan(const Params& p_in, int layer_in, char* smem) {
    const Params p = kparams(); const int layer = opaque_int(layer_in); (void)p_in;
    const int tid = opaque_tid();
    const float* UT = (const float*)(p.ws + OFF_UT);
    const float* DL = (const float*)(p.ws + OFF_DL);
    bf16_t* ST = (bf16_t*)(p.ws + OFF_ST);
    const int nthr = gridDim.x * NT;
    for (int el = opaque_bid() * NT + tid; el < 32 * 8192; el += nthr) {
        const int bh = el >> 13, ed = el & 8191, d = el & 63;
        float sacc = 0.f;
        ST[((size_t)bh * 33) * 8192 + ed] = 0;
#pragma unroll 1
        for (int c0 = 0; c0 < 32; c0 += 16) {
            float u[16], dl[16];
#pragma unroll
            for (int i = 0; i < 16; ++i) { u[i] = UT[((size_t)(bh * 32 + c0 + i)) * 8192 + ed]; dl[i] = DL[(size_t)(bh * 32 + c0 + i) * 64 + d]; }
#pragma unroll
            for (int i = 0; i < 16; ++i) { sacc = fmaf(dl[i], sacc, u[i]); ST[((size_t)bh * 33 + c0 + i + 1) * 8192 + ed] = f2bf(sacc); }
        }
    }
}

__device__ __forceinline__ void phase_gla_c(const Params& p_in, int layer_in, char* smem, bool do_store) {
    const Params p = kparams(); const int layer = opaque_int(layer_in); (void)p_in;
    const int tid = opaque_tid(), wid = __builtin_amdgcn_readfirstlane(tid >> 6), lane = tid & 63, fr = lane & 15, fq = lane >> 4;
    LAS unsigned char* lds = (LAS unsigned char*)smem;
    const bf16_t* GQ = (const bf16_t*)(p.ws + OFF_GQ);
    const bf16_t* GK = (const bf16_t*)(p.ws + OFF_GK);
    const bf16_t* GVT = (const bf16_t*)(p.ws + OFF_GV);
    const bf16_t* ST = (const bf16_t*)(p.ws + OFF_ST);
    bf16_t* MIX = (bf16_t*)(p.ws + OFF_MIX);
    const float* ng = p.norm_g + layer * 128;
    for (int task = opaque_bid(); task < 32 * 33; task += gridDim.x) {
        const int bh = task / 33, c = task - bh * 33, b = bh >> 2, h = bh & 3;
        __syncthreads();
        float bc[8], blast;
        gla_cumsum(p, layer, b, h, c, tid, lds, bc, blast);
        {
            const int d = tid & 63, seg = tid >> 6;
#pragma unroll
            for (int i = 0; i < 8; ++i) {
                const int t = 8 * seg + i, pos = 64 * c - 48 + t;
                float qv = 0.f, kv = 0.f;
                if (pos >= 0) { const size_t row = (size_t)b * L + pos; qv = bf2f(GQ[row * 256 + h * 64 + d]); kv = bf2f(GK[row * 256 + h * 64 + d]); }
                const int off = t * 128 + 16 * ((d >> 3) ^ (t & 7)) + 2 * (d & 7);
                *(LAS bf16_t*)(lds + GL_QE + off) = f2bf(qv * __expf(bc[i]));
                *(LAS bf16_t*)(lds + GL_KN + off) = f2bf(kv * __expf(-bc[i]));
            }
        }
        __syncthreads();
        const int tw = wid & 3, eh = wid >> 2;
        bf16x8 qf[2];
#pragma unroll
        for (int ks = 0; ks < 2; ++ks) { const int rowt = 16 * tw + fr; qf[ks] = *(const LAS bf16x8*)(lds + GL_QE + rowt * 128 + 16 * ((4 * ks + fq) ^ (rowt & 7))); }
        unsigned pk[4][2];
#pragma unroll
        for (int st = 0; st < 4; ++st) {
            f32x4 a = {0.f, 0.f, 0.f, 0.f};
#pragma unroll
            for (int ks = 0; ks < 2; ++ks) {
                const int rows = 16 * st + fr;
                const bf16x8 kf = *(const LAS bf16x8*)(lds + GL_KN + rows * 128 + 16 * ((4 * ks + fq) ^ (rows & 7)));
                a = __builtin_amdgcn_mfma_f32_16x16x32_bf16(kf, qf[ks], a, 0, 0, 0);
            }
#pragma unroll
            for (int r = 0; r < 4; ++r) a[r] = (16 * st + 4 * fq + r > 16 * tw + fr) ? 0.f : a[r];
            pk[st][0] = cvt_pk_bf16(a[0], a[1]); pk[st][1] = cvt_pk_bf16(a[2], a[3]);
        }
        bf16x8 pf[2];
#pragma unroll
        for (int ks = 0; ks < 2; ++ks) { u32x4 pw; pw[0] = pk[2 * ks][0]; pw[1] = pk[2 * ks][1]; pw[2] = pk[2 * ks + 1][0]; pw[3] = pk[2 * ks + 1][1]; pf[ks] = __builtin_bit_cast(bf16x8, pw); }
        f32x4 O[4];
        float ss = 0.f;
#pragma unroll
        for (int et = 0; et < 4; ++et) {
            const int e0 = 64 * eh + 16 * et;
            f32x4 acc = {0.f, 0.f, 0.f, 0.f};
            const bf16_t* sp = ST + (((size_t)bh * 33 + c) * 128 + e0 + fr) * 64 + 8 * fq;
            const bf16_t* vp = GVT + ((size_t)bh * 128 + e0 + fr) * LPV + 64 * c + 4 * fq;
#pragma unroll
            for (int ks = 0; ks < 2; ++ks) {
                const bf16x8 sf = *(const bf16x8*)(sp + 32 * ks);
                acc = __builtin_amdgcn_mfma_f32_16x16x32_bf16(sf, qf[ks], acc, 0, 0, 0);
                u32x2 va = *(const u32x2*)(vp + 32 * ks), vb = *(const u32x2*)(vp + 32 * ks + 16);
                if (c == 0) { va = (u32x2){0u, 0u}; if (ks == 0) vb = (u32x2){0u, 0u}; }
                u32x4 vw; vw[0] = va[0]; vw[1] = va[1]; vw[2] = vb[0]; vw[3] = vb[1];
                acc = __builtin_amdgcn_mfma_f32_16x16x32_bf16(__builtin_bit_cast(bf16x8, vw), pf[ks], acc, 0, 0, 0);
            }
            O[et] = acc;
            ss += acc[0] * acc[0] + acc[1] * acc[1] + acc[2] * acc[2] + acc[3] * acc[3];
        }
        ss += __shfl_xor(ss, 16); ss += __shfl_xor(ss, 32);
        LAS float* part = (LAS float*)(lds + GL_PART);
        if (fq == 0) part[eh * 64 + 16 * tw + fr] = ss;
        __syncthreads();
        const float tot = part[16 * tw + fr] + part[64 + 16 * tw + fr];
        const float rinv = rsqrtf(tot * (1.f / 128) + LN_EPS);
        const int pos = 64 * c - 48 + 16 * tw + fr;
        if (pos >= 0 && do_store) {
            bf16_t* mp = MIX + ((size_t)b * L + pos) * 1024 + h * 128 + 64 * eh + 4 * fq;
#pragma unroll
            for (int et = 0; et < 4; ++et) {
                const uint2 gz = *(const uint2*)(mp + 16 * et);
                const f32x4 nv = *(const f32x4*)(ng + 64 * eh + 16 * et + 4 * fq);
                const float g0 = __uint_as_float(gz.x << 16), g1 = __uint_as_float(gz.x & 0xFFFF0000u), g2 = __uint_as_float(gz.y << 16), g3 = __uint_as_float(gz.y & 0xFFFF0000u);
                uint2 o; o.x = pack2bf(O[et][0] * rinv * nv[0] * g0, O[et][1] * rinv * nv[1] * g1); o.y = pack2bf(O[et][2] * rinv * nv[2] * g2, O[et][3] * rinv * nv[3] * g3);
                *(uint2*)(mp + 16 * et) = o;
            }
        }
    }
}

__device__ __forceinline__ void phase_ln(const Params& p_in, int layer_in, char* smem) {
    const Params p = kparams(); const int layer = opaque_int(layer_in); (void)p_in;
    const int tid = opaque_tid(), wid = tid >> 6, lane = tid & 63;
    const float* Z = (const float*)(p.ws + OFF_GQ);
    float* H32 = (float*)(p.ws + OFF_H32);
    bf16_t* HB = (bf16_t*)(p.ws + OFF_HB);
    const float* g = p.ln_g + layer * D; const float* bb = p.ln_b + layer * D;
    const int nw = gridDim.x * 8;
    int t = opaque_bid() * 8 + wid;
    f32x4 v[4], vn[4];
    if (t < T) {
#pragma unroll
        for (int i = 0; i < 4; ++i) v[i] = *(const f32x4*)(Z + (size_t)t * D + 4 * lane + 256 * i);
    }
    for (; t < T; t += nw) {
        const int tn = t + nw;
        if (tn < T) {
#pragma unroll
            for (int i = 0; i < 4; ++i) vn[i] = *(const f32x4*)(Z + (size_t)tn * D + 4 * lane + 256 * i);
        }
        ln_row_wave(v, g, bb, lane);
        if (layer == DEPTH - 1) {
            const int b = t / L, pos = t - b * L;
            if (pos >= NMETA) {
#pragma unroll
                for (int i = 0; i < 4; ++i) *(f32x4*)(p.out + ((size_t)b * SEQ + (pos - NMETA)) * D + 4 * lane + 256 * i) = v[i];
            }
        } else {
#pragma unroll
            for (int i = 0; i < 4; ++i) {
                *(f32x4*)(H32 + (size_t)t * D + 4 * lane + 256 * i) = v[i];
                u32x2 o; o[0] = cvt_pk_bf16(v[i][0], v[i][1]); o[1] = cvt_pk_bf16(v[i][2], v[i][3]);
                *(u32x2*)(HB + (size_t)t * D + 4 * lane + 256 * i) = o;
            }
        }
#pragma unroll
        for (int i = 0; i < 4; ++i) v[i] = vn[i];
    }
}

#define XB_TMO      128
#define XB_XCNT(j)  (256  + 64 * (j))
#define XB_XSUB(j)  (1280 + 64 * (j))
#define XB_XGEN(j)  (2304 + 64 * (j))
#define XB_TOP      3328
#define XB_TOPGEN   3392
#define XCD_BAR_WORDS 3456
#define XB_SPIN_CAP (1u << 22)
__device__ __forceinline__ unsigned xb_ld(unsigned* p)              { return __hip_atomic_load(p, __ATOMIC_RELAXED, __HIP_MEMORY_SCOPE_AGENT); }
__device__ __forceinline__ unsigned xb_add(unsigned* p, unsigned v) { return __hip_atomic_fetch_add(p, v, __ATOMIC_RELAXED, __HIP_MEMORY_SCOPE_AGENT); }
__device__ __forceinline__ unsigned xb_xcc_id() { return (unsigned)__builtin_amdgcn_s_getreg((3 << 11) | 20) & 0xFu; }
#define XB_SPIN(cond, bar) do { unsigned _sp = 0; while (cond) { __builtin_amdgcn_s_sleep(1); \
    if ((++_sp & 255u) == 0u) { if (xb_ld(&(bar)[XB_TMO])) break; if (_sp > XB_SPIN_CAP) { atomicAdd(&(bar)[XB_TMO], 1u); break; } } } } while (0)
struct XcdBarrier { unsigned* bar; unsigned x; volatile LAS unsigned* st; };
__device__ __forceinline__ XcdBarrier xcd_barrier_post(unsigned* bar, volatile LAS unsigned* st) {
    XcdBarrier b; b.bar = bar; b.x = xb_xcc_id(); b.st = st;
    if (threadIdx.x == 0) (void)xb_add(&bar[XB_XCNT(b.x)], 1u);
    return b;
}
__device__ __forceinline__ void xcd_barrier_complete(unsigned* bar, unsigned x, unsigned& nloc, unsigned& nx) {
    const unsigned G = gridDim.x * gridDim.y * gridDim.z;
    unsigned sum, cnt, mine, sp = 0u;
    for (;;) {
        sum = 0u; cnt = 0u; mine = 0u;
#pragma unroll
        for (unsigned j = 0; j < 16; ++j) { const unsigned c = xb_ld(&bar[XB_XCNT(j)]); sum += c; cnt += (c > 0u) ? 1u : 0u; mine = (j == x) ? c : mine; }
        if (sum == G) break;
        __builtin_amdgcn_s_sleep(1);
        if ((++sp & 255u) == 0u) { if (xb_ld(&bar[XB_TMO])) break; if (sp > XB_SPIN_CAP) { atomicAdd(&bar[XB_TMO], 1u); break; } }
    }
    nloc = mine > 0u ? mine : 1u; nx = cnt > 0u ? cnt : 1u;
}
__device__ __forceinline__ void xcd_barrier(unsigned* bar_, volatile LAS unsigned* st_) {
    XcdBarrier b; b.bar = bar_; b.x = xb_xcc_id(); b.st = st_;
    asm volatile("s_waitcnt vmcnt(0)" ::: "memory");
    __syncthreads();
    if (opaque_tid() == 0) {
        unsigned* bar = b.bar;
        __builtin_amdgcn_s_waitcnt(0);
        unsigned nloc = b.st[0], nx = b.st[1];
        if (nloc == 0u) { xcd_barrier_complete(bar, b.x, nloc, nx); b.st[0] = nloc; b.st[1] = nx; }
        const unsigned old = xb_add(&bar[XB_XSUB(b.x)], 1u);
        const unsigned gen = old / nloc;
        if (old + 1u == (gen + 1u) * nloc) {
            __builtin_amdgcn_fence(__ATOMIC_RELEASE, "agent");
            asm volatile("s_waitcnt vmcnt(0)" ::: "memory");
            const unsigned og = xb_add(&bar[XB_TOP], 1u);
            const unsigned tg = og / nx;
            if (og + 1u == (tg + 1u) * nx) xb_add(&bar[XB_TOPGEN], 1u);
            else XB_SPIN(xb_ld(&bar[XB_TOPGEN]) == tg, bar);
            __builtin_amdgcn_fence(__ATOMIC_ACQUIRE, "agent");
            xb_add(&bar[XB_XGEN(b.x)], 1u);
            asm volatile("s_waitcnt vmcnt(0)" ::: "memory");
        } else {
            XB_SPIN(xb_ld(&bar[XB_XGEN(b.x)]) == gen, bar);
            __builtin_amdgcn_fence(__ATOMIC_ACQUIRE, "agent");
            asm volatile("s_waitcnt vmcnt(0)" ::: "memory");
        }
    }
    __syncthreads();
}

constexpr int SMEM_BYTES = 160 * 1024;
static_assert(DS_END <= SMEM_BYTES - 16, "dsa lds");

__global__ void __launch_bounds__(NT, 2) k_mega(Params p) {
    __shared__ __attribute__((aligned(16))) char smem[SMEM_BYTES];
    volatile LAS unsigned* xbw = (volatile LAS unsigned*)((LAS unsigned char*)smem + (SMEM_BYTES - 16));
    if (threadIdx.x == 0) { xbw[0] = 0u; xbw[1] = 0u; xbw[2] = 0u; xbw[3] = 0u; }
    __syncthreads();
    if (p.ws == nullptr) cg::this_grid().sync();
    (void)xcd_barrier_post((unsigned*)(p.ws + OFF_BAR), xbw);
    for (int rep = 0; rep < PROBE_REP_PREP; ++rep) {
    phase_prep(p, smem);
    xcd_barrier((unsigned*)(p.ws + OFF_BAR), xbw);
    }
#pragma unroll 1
    for (int layer = 0; layer < DEPTH; ++layer) {
        for (int rep = 0; rep < PROBE_REP_PROJ; ++rep) {
        phase_proj(p, layer, smem);
        xcd_barrier((unsigned*)(p.ws + OFF_BAR), xbw);
        }
        phase_rope(p, layer, smem);
        for (int rep = 0; rep < PROBE_REP_GLAA; ++rep) {
        phase_gla_a(p, layer, smem);
        xcd_barrier((unsigned*)(p.ws + OFF_BAR), xbw);
        phase_gla_scan(p, layer, smem);
        xcd_barrier((unsigned*)(p.ws + OFF_BAR), xbw);
        }
        for (int rep = 0; rep < PROBE_REP_GLAC; ++rep) phase_gla_c(p, layer, smem, rep == PROBE_REP_GLAC - 1);
        for (int rep = 0; rep < PROBE_REP_DSA; ++rep) phase_dsa(p, layer, smem, rep == PROBE_REP_DSA - 1);
        xcd_barrier((unsigned*)(p.ws + OFF_BAR), xbw);
        for (int rep = 0; rep < PROBE_REP_OUT; ++rep) {
        phase_outproj(p, layer, smem);
        xcd_barrier((unsigned*)(p.ws + OFF_BAR), xbw);
        }
        for (int rep = 0; rep < PROBE_REP_LN; ++rep) {
        phase_ln(p, layer, smem);
        xcd_barrier((unsigned*)(p.ws + OFF_BAR), xbw);
        }
    }
}

extern "C" void kernel_launch(void* const* d_in, const int* in_sizes, int n_in, void* d_out, int out_size, void* d_ws, size_t ws_size,
                              hipStream_t stream) {
    Params p{};
    p.x = (const float*)d_in[0]; p.meta = (const float*)d_in[1]; p.ln_in_g = (const float*)d_in[2]; p.ln_in_b = (const float*)d_in[3];
    p.w_in = (const float*)d_in[4]; p.wg2 = (const float*)d_in[5]; p.bg = (const float*)d_in[6]; p.norm_g = (const float*)d_in[7];
    p.ikg = (const float*)d_in[8]; p.ikb = (const float*)d_in[9]; p.w_out = (const float*)d_in[10]; p.ln_g = (const float*)d_in[11];
    p.ln_b = (const float*)d_in[12];
    p.out = (float*)d_out; p.ws = (char*)d_ws;
    static int grid_blocks = 0;
    if (!grid_blocks) {
        int dev = 0, cus = 0, per_cu = 0;
        hipGetDevice(&dev);
        hipDeviceGetAttribute(&cus, hipDeviceAttributeMultiprocessorCount, dev);
        hipOccupancyMaxActiveBlocksPerMultiprocessor(&per_cu, k_mega, NT, 0);
        if (per_cu > 1) per_cu = 1;
        grid_blocks = cus * per_cu;
    }
    (void)hipMemsetAsync((char*)d_ws + OFF_BAR, 0, XCD_BAR_WORDS * 4, stream);
    void* args[] = {&p};
    (void)hipLaunchCooperativeKernel((void*)k_mega, dim3(grid_blocks), dim3(NT), args, 0, stream);
}
```

```cpp
#include <hip/hip_runtime.h>
#include <hip/hip_cooperative_groups.h>
#include <stdint.h>
namespace cg = cooperative_groups;
#ifndef PROBE_REP_PREP
#define PROBE_REP_PREP 1
#define PROBE_REP_PROJ 1
#define PROBE_REP_GLAA 1
#define PROBE_REP_GLAC 1
#define PROBE_REP_DSA 1
#define PROBE_REP_OUT 1
#define PROBE_REP_LN 1
#define PROBE_DSA_A 1
#define PROBE_DSA_B 1
#define PROBE_DSA_C 1
#endif

constexpr int D = 1024, NB = 8, SEQ = 2048, NMETA = 16, L = 2064, T = NB * L;
constexpr int DEPTH = 2;
constexpr int INW = 3416, INWP = 3584;
constexpr int TP = 16640;
constexpr int NT = 512;
constexpr int TOPK = 256;
constexpr float LN_EPS = 1e-5f;
constexpr float ALPHA = 1.41421356237309515f;

typedef unsigned short bf16_t;
typedef short bf16x8 __attribute__((ext_vector_type(8)));
typedef float f32x4 __attribute__((ext_vector_type(4)));
#define LAS __attribute__((address_space(3)))

constexpr size_t SZ_H32 = (size_t)T * D * 4;
constexpr size_t SZ_HB = (size_t)TP * D * 2;
constexpr size_t SZ_WIN = (size_t)DEPTH * INWP * D * 2;
constexpr size_t SZ_WOUT = (size_t)DEPTH * D * D * 2;
constexpr int LPV = 2112;
constexpr size_t SZ_GQ = (size_t)T * 256 * 2, SZ_GK = SZ_GQ, SZ_GV = (size_t)NB * 4 * 128 * LPV * 2;
constexpr size_t SZ_UT = (size_t)1024 * 128 * 64 * 4, SZ_ST = (size_t)32 * 33 * 128 * 64 * 2, SZ_DL = (size_t)1024 * 64 * 4;
constexpr size_t SZ_AQ = (size_t)T * 512 * 2, SZ_IQ = (size_t)T * 512 * 2;
constexpr size_t SZ_MIX = (size_t)TP * 1024 * 2;
constexpr int LP = 2112;
constexpr size_t SZ_AK = (size_t)T * 128 * 2, SZ_AV = (size_t)NB * 2 * 64 * LP * 2, SZ_IK = (size_t)T * 64 * 2, SZ_IW = (size_t)T * 8 * 4;
constexpr size_t SZ_GLR = (size_t)T * 16 * 4;
constexpr size_t SZ_ROPE = (size_t)L * 8 * 2 * 4;

constexpr size_t OFF_H32 = 0;
constexpr size_t OFF_HB = OFF_H32 + SZ_H32;
constexpr size_t OFF_WIN = OFF_HB + SZ_HB;
constexpr size_t OFF_WOUT = OFF_WIN + SZ_WIN;
constexpr size_t OFF_GQ = OFF_WOUT + SZ_WOUT;
constexpr size_t OFF_GK = OFF_GQ + SZ_GQ;
constexpr size_t OFF_GV = OFF_GK + SZ_GK;
constexpr size_t OFF_AQ = OFF_GV + SZ_GV;
constexpr size_t OFF_IQ = OFF_AQ + SZ_AQ;
constexpr size_t OFF_MIX = OFF_IQ + SZ_IQ;
constexpr size_t OFF_AK = OFF_MIX + SZ_MIX;
constexpr size_t OFF_AV = OFF_AK + SZ_AK;
constexpr size_t OFF_IK = OFF_AV + SZ_AV;
constexpr size_t OFF_IW = OFF_IK + SZ_IK;
constexpr size_t OFF_GLR = OFF_IW + SZ_IW;
constexpr size_t OFF_ROPE = OFF_GLR + SZ_GLR;
constexpr size_t OFF_ST = OFF_ROPE + SZ_ROPE;
constexpr size_t OFF_DL = OFF_ST + SZ_ST;
constexpr size_t OFF_BAR = OFF_DL + SZ_DL;
constexpr size_t OFF_IKR = OFF_BAR + 16384;
constexpr size_t OFF_END = OFF_IKR + (size_t)T * 64 * 4;
constexpr size_t OFF_UT = OFF_HB;
static_assert(SZ_UT <= SZ_HB, "UT alias");
static_assert(SZ_GQ + SZ_GK + SZ_GV + SZ_AQ + SZ_IQ >= SZ_H32, "Z alias size");
static_assert(OFF_END <= (size_t)256 * 1024 * 1024, "workspace too large");

struct Params {
    const float* x; const float* meta; const float* ln_in_g; const float* ln_in_b;
    const float* w_in; const float* wg2; const float* bg; const float* norm_g;
    const float* ikg; const float* ikb; const float* w_out; const float* ln_g; const float* ln_b;
    float* out; char* ws;
};
typedef const Params __attribute__((address_space(4))) * KParamsPtr;
__device__ __forceinline__ Params kparams() {
    unsigned long long a = (unsigned long long)__builtin_amdgcn_kernarg_segment_ptr();
    asm volatile("" : "+s"(a));
    KParamsPtr q = (KParamsPtr)a;
    Params r;
    r.x = q->x; r.meta = q->meta; r.ln_in_g = q->ln_in_g; r.ln_in_b = q->ln_in_b; r.w_in = q->w_in; r.wg2 = q->wg2; r.bg = q->bg; r.norm_g = q->norm_g;
    r.ikg = q->ikg; r.ikb = q->ikb; r.w_out = q->w_out; r.ln_g = q->ln_g; r.ln_b = q->ln_b; r.out = q->out; r.ws = q->ws;
    return r;
}

__device__ __forceinline__ bf16_t f2bf(float f) {
    unsigned u = __float_as_uint(f);
    u += 0x7FFFu + ((u >> 16) & 1u);
    return (bf16_t)(u >> 16);
}
__device__ __forceinline__ unsigned pack2bf(float lo, float hi) { return (unsigned)f2bf(lo) | ((unsigned)f2bf(hi) << 16); }
__device__ __forceinline__ unsigned cvt_pk_bf16(float lo, float hi) { unsigned r; asm volatile("v_cvt_pk_bf16_f32 %0, %1, %2" : "=v"(r) : "v"(lo), "v"(hi)); return r; }
typedef unsigned u32x4 __attribute__((ext_vector_type(4)));
typedef unsigned u32x2 __attribute__((ext_vector_type(2)));
__device__ __forceinline__ float bf2f(bf16_t h) { return __uint_as_float(((unsigned)h) << 16); }
__device__ __forceinline__ int opaque_tid() { int t = threadIdx.x; asm volatile("" : "+v"(t)); return t; }
__device__ __forceinline__ int opaque_int(int v) { asm volatile("" : "+s"(v)); return v; }
__device__ __forceinline__ int opaque_bid() { int t = blockIdx.x; asm volatile("" : "+s"(t)); return t; }
__device__ __forceinline__ float wave_sum(float v) {
#pragma unroll
    for (int o = 32; o > 0; o >>= 1) v += __shfl_xor(v, o);
    return v;
}
__device__ __forceinline__ float wave_max(float v) {
#pragma unroll
    for (int o = 32; o > 0; o >>= 1) v = fmaxf(v, __shfl_xor(v, o));
    return v;
}
__device__ __forceinline__ float block_sum(float v, float* red) {
    v = wave_sum(v);
    const int tq = opaque_tid();
    __syncthreads();
    if ((tq & 63) == 0) red[tq >> 6] = v;
    __syncthreads();
    return ((red[0] + red[1]) + (red[2] + red[3])) + ((red[4] + red[5]) + (red[6] + red[7]));
}
__device__ __forceinline__ float silu_f(float x) { return x / (1.f + __expf(-x)); }
__device__ __forceinline__ float logsigmoid_f(float x) { return fminf(x, 0.f) - log1pf(expf(-fabsf(x))); }
__device__ __forceinline__ float logsigmoid_fast(float x) { return fminf(x, 0.f) - __logf(1.f + __expf(-fabsf(x))); }

__device__ __forceinline__ int proj_src_col(int n) {
    if (n < 1024) return n;
    if (n < 1536) return n - 1024 + 1040;
    if (n < 2048) return n - 1536 + 1552;
    if (n < 2560) return n - 2048 + 2904;
    if (n < 3072) return n - 2560 + 2320;
    if (n < 3200) return n - 3072 + 2064;
    if (n < 3328) return n - 3200 + 2192;
    const int c = n - 3328;
    if (c < 32) return 2832 + c;
    if (c < 48) return 1024 + (c - 32);
    if (c < 56) return 2896 + (c - 48);
    if (c >= 128 && c < 160) return 2832 + 32 + (c - 128);
    return -1;
}

__device__ __forceinline__ void sincos_acc(float a, float& s, float& c) {
    double ad = (double)a;
    double kd = rint(ad * 0.63661977236758134308);
    double r = fma(-kd, 1.57079632679489655800, ad);
    r = fma(-kd, 6.12323399573676603587e-17, r);
    double r2 = r * r;
    double sp = r * (1.0 + r2 * (-1.0 / 6 + r2 * (1.0 / 120 + r2 * (-1.0 / 5040 + r2 * (1.0 / 362880 + r2 * (-1.0 / 39916800))))));
    double cp = 1.0 + r2 * (-0.5 + r2 * (1.0 / 24 + r2 * (-1.0 / 720 + r2 * (1.0 / 40320 + r2 * (-1.0 / 3628800 + r2 * (1.0 / 479001600))))));
    int q = ((int)kd) & 3;
    double ss = (q & 1) ? cp : sp, cc = (q & 1) ? sp : cp;
    if (q == 1 || q == 2) cc = -cc;
    if (q == 2 || q == 3) ss = -ss;
    s = (float)ss; c = (float)cc;
}

__device__ __forceinline__ void ln_row_wave(f32x4 (&v)[4], const float* g, const float* bb, int lane) {
    float sm = 0.f;
#pragma unroll
    for (int i = 0; i < 4; ++i) sm += (v[i][0] + v[i][1]) + (v[i][2] + v[i][3]);
    const float mu = wave_sum(sm) * (1.f / D);
    float qq = 0.f;
#pragma unroll
    for (int i = 0; i < 4; ++i) { v[i] = v[i] - mu; qq += (v[i][0] * v[i][0] + v[i][1] * v[i][1]) + (v[i][2] * v[i][2] + v[i][3] * v[i][3]); }
    const float rs = rsqrtf(wave_sum(qq) * (1.f / D) + LN_EPS);
#pragma unroll
    for (int i = 0; i < 4; ++i) { const f32x4 gg = *(const f32x4*)(g + 4 * lane + 256 * i), b4 = *(const f32x4*)(bb + 4 * lane + 256 * i); v[i] = v[i] * rs * gg + b4; }
}
__device__ __forceinline__ int proj_dst_col(int src) {
    if (src < 1024) return src;
    if (src < 1040) return 3328 + 32 + (src - 1024);
    if (src < 1552) return 1024 + (src - 1040);
    if (src < 2064) return 1536 + (src - 1552);
    if (src < 2192) return 3072 + (src - 2064);
    if (src < 2320) return 3200 + (src - 2192);
    if (src < 2832) return 2560 + (src - 2320);
    if (src < 2864) return 3328 + (src - 2832);
    if (src < 2896) return 3328 + 128 + (src - 2864);
    if (src < 2904) return 3328 + 48 + (src - 2896);
    return 2048 + (src - 2904);
}
__device__ __forceinline__ void phase_prep(const Params& p_in, char* smem) {
    const Params p = kparams(); (void)p_in;
    const int tid = opaque_tid(), wid = tid >> 6, lane = tid & 63;
    bf16_t* WIN = (bf16_t*)(p.ws + OFF_WIN);
    bf16_t* WOUT = (bf16_t*)(p.ws + OFF_WOUT);
    float* H32 = (float*)(p.ws + OFF_H32);
    bf16_t* HB = (bf16_t*)(p.ws + OFF_HB);
    bf16_t* MIX = (bf16_t*)(p.ws + OFF_MIX);
    float2* ROPE = (float2*)(p.ws + OFF_ROPE);
    float (*tile)[65] = (float (*)[65])smem;
    constexpr int NCT_IN = (INW + 63) / 64, NT_IN = DEPTH * 16 * NCT_IN, NT_OUT = DEPTH * 16 * 16;
    for (int item = opaque_bid(); item < NT_IN + NT_OUT; item += gridDim.x) {
        const bool is_in = item < NT_IN;
        const int it = is_in ? item : item - NT_IN;
        const int nct = is_in ? NCT_IN : 16, ldw = is_in ? INW : D;
        const int l = it / (16 * nct), rem = it - l * 16 * nct, kt = rem / nct, ct = rem - kt * nct;
        const float* W = (is_in ? p.w_in : p.w_out) + (size_t)l * D * ldw;
        __syncthreads();
#pragma unroll
        for (int i = 0; i < 8; ++i) {
            const int e = tid + NT * i, kk = e >> 6, nn = e & 63, col = ct * 64 + nn;
            tile[kk][nn] = (col < ldw) ? W[(size_t)(kt * 64 + kk) * ldw + col] : 0.f;
        }
        __syncthreads();
        {
            const int nn = tid >> 3, k8 = (tid & 7) * 8, src = ct * 64 + nn;
            if (src < ldw) {
                const int dst = is_in ? proj_dst_col(src) : src;
                u32x4 o;
#pragma unroll
                for (int q = 0; q < 4; ++q) o[q] = cvt_pk_bf16(tile[k8 + 2 * q][nn], tile[k8 + 2 * q + 1][nn]);
                bf16_t* dstp = (is_in ? WIN + ((size_t)l * INWP + dst) * D : WOUT + ((size_t)l * D + dst) * D) + kt * 64 + k8;
                *(u32x4*)dstp = o;
            }
        }
    }
    {
        const int nw = gridDim.x * 8;
        for (int t = opaque_bid() * 8 + wid; t < TP; t += nw) {
            if (t < T) {
                const int b = t / L, pos = t - b * L;
                const float* src = (pos < NMETA) ? (p.meta + (size_t)pos * D) : (p.x + ((size_t)b * SEQ + (pos - NMETA)) * D);
                f32x4 v[4];
#pragma unroll
                for (int i = 0; i < 4; ++i) v[i] = *(const f32x4*)(src + 4 * lane + 256 * i);
                ln_row_wave(v, p.ln_in_g, p.ln_in_b, lane);
#pragma unroll
                for (int i = 0; i < 4; ++i) {
                    *(f32x4*)(H32 + (size_t)t * D + 4 * lane + 256 * i) = v[i];
                    u32x2 o; o[0] = cvt_pk_bf16(v[i][0], v[i][1]); o[1] = cvt_pk_bf16(v[i][2], v[i][3]);
                    *(u32x2*)(HB + (size_t)t * D + 4 * lane + 256 * i) = o;
                }
            } else {
#pragma unroll
                for (int i = 0; i < 4; ++i) {
                    *(u32x2*)(HB + (size_t)t * D + 4 * lane + 256 * i) = (u32x2){0u, 0u};
                    *(u32x2*)(MIX + (size_t)t * D + 4 * lane + 256 * i) = (u32x2){0u, 0u};
                }
            }
        }
    }
    for (int e = opaque_bid() * NT + tid; e < L * 8; e += gridDim.x * NT) {
        const int pos = e >> 3, i = e & 7;
        const float inv[8] = {1.0f, 0.19392274f, 0.03760603f, 0.0072926646f, 0.0014142136f, 0.0002742482f, 5.3182957e-05f, 1.0313385e-05f};
        float iv = inv[0];
#pragma unroll
        for (int j = 1; j < 8; ++j) iv = (i == j) ? inv[j] : iv;
        const float ang = (float)pos * iv;
        float sn, cs; sincos_acc(ang, sn, cs);
        ROPE[e] = make_float2(cs, sn);
    }
}

namespace pg8 {
constexpr int BM = 256, BK = 64, HALF = 128, HTB = HALF * BK * 2  , STAGE_BYTES = 8 * HTB, NXCD = 8, WGM = 8;
__device__ __forceinline__ int lds_byte(int r, int c) { const int st = (r >> 4) * 2 + (c >> 5), rr = r & 15, cc = c & 31, ob = rr * 64 + cc * 2; return st * 1024 + (ob ^ (((ob >> 9) & 1) << 5)); }
__device__ __forceinline__ void stage_rc(int b, int& R, int& C) { const int st = b / 1024, sb = b % 1024, swz = sb ^ (((sb >> 9) & 1) << 5); R = (st >> 1) * 16 + swz / 64; C = (st & 1) * 32 + (swz % 64) / 2; }
__device__ __forceinline__ int perm32(int rho) { const int n = rho >> 4, i = rho & 15; return 8 * (i >> 2) + 4 * n + (i & 3); }

struct Unit { int pm, pn; };
struct Gemm { const bf16_t* A; const bf16_t* Bt; int M, N, K; };

struct StaticOrder {
    int nM, nN, nwg, G, c;
    __device__ void init(int M, int N, int G_, int c_) { nM = M / BM; nN = N / BM; nwg = nM * nN; G = G_; c = c_; }
    __device__ bool next(int i, Unit& u) const {
        const long Lx = (long)i * G + c; if (Lx >= nwg) return false;
        int wgid = (int)Lx; { const int q = nwg / NXCD, r = nwg % NXCD, xcd = wgid % NXCD, off = wgid / NXCD; wgid = (xcd < r ? xcd * (q + 1) : r * (q + 1) + (xcd - r) * q) + off; }
        const int nig = WGM * nN, gid = wgid / nig, fm = gid * WGM, gsz = (nM - fm) < WGM ? (nM - fm) : WGM;
        u.pm = fm + ((wgid % nig) % gsz); u.pn = (wgid % nig) / gsz; return true;
    }
    __device__ __forceinline__ void a_ready(const Unit&) const {}
    __device__ __forceinline__ void done(const Unit&) const {}
};

template <class Epi, class Sched>
__device__ __forceinline__ void gemm_phase(LAS unsigned char* lds, const Gemm g, const Sched& S, const Epi& E) {
    const int tid = opaque_tid(), wid = __builtin_amdgcn_readfirstlane(tid >> 6), lane = tid & 63, wr = wid >> 2, wc = wid & 3, fr = lane & 15, fq = lane >> 4;
    const int K = g.K, nt = K / BK;
    unsigned voffA[2], voffB[2];
#pragma unroll
    for (int i = 0; i < 2; ++i) { int R, C; stage_rc(tid * 16 + i * 8192, R, C); const int Rb = Epi::PERM ? ((R & ~31) + perm32(R & 31)) : R;
        voffA[i] = (unsigned)(R * K + C) * 2u; voffB[i] = (unsigned)(Rb * K + C) * 2u; }
    const size_t kstep = (size_t)(BK * 2);
    const size_t hstep = (size_t)HALF * K * 2;
    const size_t tstep = 2 * hstep;
    const unsigned ldsw = (unsigned)wid * 1024u;
    const int aoff = lds_byte(wr * 64 + fr, fq * 8), boff = lds_byte(wc * 32 + fr, fq * 8);
#define PG8_SA(b, h) (((b) * 2 + (h)) * HTB)
#define PG8_SB(b, h) ((4 + (b) * 2 + (h)) * HTB)
#define PG8_STAGE(bufoff, gbase, voff) do { _Pragma("unroll") for (int _i = 0; _i < 2; ++_i) \
        __builtin_amdgcn_global_load_lds((const unsigned*)((const char*)(gbase) + (voff)[_i]), (LAS unsigned*)(lds + (bufoff) + ldsw + _i * 8192), 16, 0, 0); } while (0)
#define PG8_LDA(dst, b, h) do { _Pragma("unroll") for (int m = 0; m < 4; ++m) _Pragma("unroll") for (int k = 0; k < 2; ++k) dst[m][k] = *(const LAS bf16x8*)(lds + PG8_SA(b, h) + aoff + m * 2048 + k * 1024); } while (0)
#define PG8_LDB(dst, b, h) do { _Pragma("unroll") for (int n = 0; n < 2; ++n) _Pragma("unroll") for (int k = 0; k < 2; ++k) dst[n][k] = *(const LAS bf16x8*)(lds + PG8_SB(b, h) + boff + n * 2048 + k * 1024); } while (0)
#define PG8_MMA(ai, bj, At, Bt) do { __builtin_amdgcn_s_setprio(1); _Pragma("unroll") for (int m = 0; m < 4; ++m) _Pragma("unroll") for (int n = 0; n < 2; ++n) _Pragma("unroll") for (int k = 0; k < 2; ++k) \
        acc[ai][bj][m][n] = __builtin_amdgcn_mfma_f32_16x16x32_bf16(Bt[n][k], At[m][k], acc[ai][bj][m][n], 0, 0, 0); __builtin_amdgcn_s_setprio(0); } while (0)
#define PG8_WAIT_V(n) asm volatile("s_waitcnt vmcnt(" #n ")" ::: "memory")
#define PG8_WAIT_L(n) asm volatile("s_waitcnt lgkmcnt(" #n ")" ::: "memory")
#define PG8_BAR __builtin_amdgcn_s_barrier()
#define PG8_SCHED __builtin_amdgcn_sched_barrier(0)
    Unit cur, nxt; int ui = 0;
    if (!S.next(0, cur)) return;
    f32x4 acc[2][2][4][2];
#pragma unroll
    for (int a = 0; a < 2; ++a)
#pragma unroll
        for (int b = 0; b < 2; ++b)
#pragma unroll
            for (int m = 0; m < 4; ++m)
#pragma unroll
                for (int n = 0; n < 2; ++n) acc[a][b][m][n] = (f32x4){0.f, 0.f, 0.f, 0.f};
    bf16x8 At[4][2], B0[2][2], B1[2][2];
    const char* cA = (const char*)g.A + (size_t)cur.pm * tstep; const char* cB = (const char*)g.Bt + (size_t)cur.pn * tstep;
    S.a_ready(cur);
    PG8_STAGE(PG8_SB(0, 0), cB, voffB); PG8_STAGE(PG8_SA(0, 0), cA, voffA); PG8_STAGE(PG8_SB(0, 1), cB + hstep, voffB); PG8_STAGE(PG8_SA(0, 1), cA + hstep, voffA);
    if (wr == 1) PG8_BAR;
    PG8_WAIT_V(4); PG8_BAR;
    PG8_STAGE(PG8_SB(1, 0), cB + kstep, voffB); PG8_STAGE(PG8_SA(1, 0), cA + kstep, voffA); PG8_STAGE(PG8_SB(1, 1), cB + hstep + kstep, voffB);
    PG8_WAIT_V(6); PG8_BAR;
    for (;;) {
        const bool has_next = S.next(ui + 1, nxt);
        const char* nA = has_next ? (const char*)g.A + (size_t)nxt.pm * tstep : cA; const char* nB = has_next ? (const char*)g.Bt + (size_t)nxt.pn * tstep : cB;
        for (int t = 0; t < nt; t += 2) {
            const bool last = (t == nt - 2);
            const char* a1 = cA + (size_t)(t + 1) * kstep;
            const char* a2 = last ? nA : cA + (size_t)(t + 2) * kstep; const char* b2 = last ? nB : cB + (size_t)(t + 2) * kstep;
            const char* a3 = a2 + kstep; const char* b3 = b2 + kstep;
            if (last && has_next) S.a_ready(nxt);
            PG8_LDB(B0, 0, 0); PG8_SCHED; PG8_LDA(At, 0, 0); PG8_STAGE(PG8_SA(1, 1), a1 + hstep, voffA);
            PG8_WAIT_L(8); PG8_BAR; PG8_WAIT_L(0); PG8_MMA(0, 0, At, B0); PG8_BAR; PG8_SCHED;
            PG8_LDB(B1, 0, 1); PG8_STAGE(PG8_SB(0, 0), b2, voffB);
            PG8_BAR; PG8_WAIT_L(0); PG8_MMA(0, 1, At, B1); PG8_BAR;
            PG8_LDA(At, 0, 1); PG8_STAGE(PG8_SA(0, 0), a2, voffA);
            PG8_BAR; PG8_WAIT_L(0); PG8_MMA(1, 0, At, B0); PG8_BAR; PG8_SCHED;
            PG8_STAGE(PG8_SB(0, 1), b2 + hstep, voffB);
            PG8_WAIT_V(6); PG8_BAR; PG8_MMA(1, 1, At, B1); PG8_BAR;
            PG8_LDB(B0, 1, 0); PG8_SCHED; PG8_LDA(At, 1, 0); PG8_STAGE(PG8_SA(0, 1), a2 + hstep, voffA);
            PG8_WAIT_L(8); PG8_BAR; PG8_WAIT_L(0); PG8_MMA(0, 0, At, B0); PG8_BAR; PG8_SCHED;
            PG8_LDB(B1, 1, 1); PG8_STAGE(PG8_SB(1, 0), b3, voffB);
            PG8_BAR; PG8_WAIT_L(0); PG8_MMA(0, 1, At, B1); PG8_BAR;
            PG8_LDA(At, 1, 1); PG8_STAGE(PG8_SA(1, 0), a3, voffA);
            PG8_BAR; PG8_WAIT_L(0); PG8_MMA(1, 0, At, B0); PG8_BAR; PG8_SCHED;
            PG8_STAGE(PG8_SB(1, 1), b3 + hstep, voffB);
            PG8_WAIT_V(6); PG8_BAR; PG8_MMA(1, 1, At, B1); PG8_BAR;
        }
        E(acc, cur, wr, wc, fr, fq); S.done(cur);
        if (!has_next) break;
#pragma unroll
        for (int a = 0; a < 2; ++a)
#pragma unroll
            for (int b = 0; b < 2; ++b)
#pragma unroll
                for (int m = 0; m < 4; ++m)
#pragma unroll
                    for (int n = 0; n < 2; ++n) acc[a][b][m][n] = (f32x4){0.f, 0.f, 0.f, 0.f};
        cur = nxt; cA = nA; cB = nB; ++ui;
    }
    PG8_WAIT_V(0);
    if (wr == 0) PG8_BAR;
    PG8_BAR;
#undef PG8_SA
#undef PG8_SB
#undef PG8_STAGE
#undef PG8_LDA
#undef PG8_LDB
#undef PG8_MMA
#undef PG8_WAIT_V
#undef PG8_WAIT_L
#undef PG8_BAR
#undef PG8_SCHED
}
}

struct EpiProj {
    static constexpr bool PERM = true;
    char* ws;
    __device__ __forceinline__ void store8(bf16_t* dst, const f32x4& a, const f32x4& b, float sc) const {
        u32x4 o; o[0] = cvt_pk_bf16(a[0] * sc, a[1] * sc); o[1] = cvt_pk_bf16(a[2] * sc, a[3] * sc); o[2] = cvt_pk_bf16(b[0] * sc, b[1] * sc); o[3] = cvt_pk_bf16(b[2] * sc, b[3] * sc);
        *(u32x4*)dst = o;
    }
    __device__ __forceinline__ void operator()(const f32x4 (&acc)[2][2][4][2], const pg8::Unit& u, int wr, int wc, int fr, int fq) const {
        asm volatile("" : "+v"(fr), "+v"(fq));
        if (u.pn < 13) {
#pragma unroll
            for (int bj = 0; bj < 2; ++bj) {
                const int hb = 4 * u.pn + 2 * bj + (wc >> 1);
                const int cc8 = 32 * (wc & 1) + 8 * fq;
#pragma unroll
                for (int ai = 0; ai < 2; ++ai)
#pragma unroll
                    for (int m = 0; m < 4; ++m) {
                        const int t = 256 * u.pm + 128 * ai + 64 * wr + 16 * m + fr;
                        const f32x4 v0 = acc[ai][bj][m][0], v1 = acc[ai][bj][m][1];
                        if (t < T) {
                            const size_t tt = (size_t)t;
                            if (hb < 4) store8((bf16_t*)(ws + OFF_GQ) + tt * 256 + hb * 64 + cc8, v0, v1, 0.125f);
                            else if (hb < 8) store8((bf16_t*)(ws + OFF_GK) + tt * 256 + (hb - 4) * 64 + cc8, v0, v1, 1.f);
                            else if (hb < 16) {
                                const int bq = t / L, pos = t - bq * L;
                                bf16_t* dst = (bf16_t*)(ws + OFF_GV) + ((size_t)(bq * 4 + ((hb - 8) >> 1)) * 128 + ((hb - 8) & 1) * 64 + cc8) * LPV + 48 + pos;
#pragma unroll
                                for (int j = 0; j < 4; ++j) { dst[(size_t)j * LPV] = f2bf(v0[j]); dst[(size_t)(4 + j) * LPV] = f2bf(v1[j]); }
                            }
                            else if (hb < 24 || (hb >= 32 && hb < 40)) {
                                f32x4 s0, s1;
#pragma unroll
                                for (int j = 0; j < 4; ++j) { s0[j] = silu_f(v0[j]); s1[j] = silu_f(v1[j]); }
                                const int col = (hb < 24) ? (hb - 16) * 64 : 512 + (hb - 32) * 64;
                                store8((bf16_t*)(ws + OFF_MIX) + tt * 1024 + col + cc8, s0, s1, 1.f);
                            }
                            else if (hb < 32) store8((bf16_t*)(ws + OFF_AQ) + tt * 512 + (hb - 24) * 64 + cc8, v0, v1, 0.125f);
                            else if (hb < 48) store8((bf16_t*)(ws + OFF_IQ) + tt * 512 + (hb - 40) * 64 + cc8, v0, v1, 0.125f);
                            else if (hb < 50) store8((bf16_t*)(ws + OFF_AK) + tt * 128 + (hb - 48) * 64 + cc8, v0, v1, 1.f);
                            else {
                                const int bq = t / L, pos = t - bq * L;
                                bf16_t* dst = (bf16_t*)(ws + OFF_AV) + ((size_t)(bq * 2 + (hb - 50)) * 64 + cc8) * LP + pos;
#pragma unroll
                                for (int j = 0; j < 4; ++j) { dst[(size_t)j * LP] = f2bf(v0[j]); dst[(size_t)(4 + j) * LP] = f2bf(v1[j]); }
                            }
                        }
                        asm volatile("" ::: "memory");
                    }
            }
        } else {
#pragma unroll
            for (int ai = 0; ai < 2; ++ai)
#pragma unroll
                for (int m = 0; m < 4; ++m) {
                    const int t = 256 * u.pm + 128 * ai + 64 * wr + 16 * m + fr;
                    if (t < T) {
                        if (wc == 0) {
                            float* dst = (float*)(ws + OFF_IKR) + (size_t)t * 64 + 8 * fq;
                            *(f32x4*)dst = acc[ai][0][m][0]; *(f32x4*)(dst + 4) = acc[ai][0][m][1];
                            *(f32x4*)(dst + 32) = acc[ai][1][m][0]; *(f32x4*)(dst + 36) = acc[ai][1][m][1];
                        } else if (wc == 1) {
                            const f32x4 v0 = acc[ai][0][m][0], v1 = acc[ai][0][m][1];
                            if (fq < 2) {
                                float* dst = (float*)(ws + OFF_GLR) + (size_t)t * 16 + 8 * fq;
                                *(f32x4*)dst = v0; *(f32x4*)(dst + 4) = v1;
                            } else if (fq == 2) {
                                float* dst = (float*)(ws + OFF_IW) + (size_t)t * 8;
                                *(f32x4*)dst = v0 * 0.353553390593273762f; *(f32x4*)(dst + 4) = v1 * 0.353553390593273762f;
                            }
                        }
                    }
                    asm volatile("" ::: "memory");
                }
        }
    }
};

struct EpiOut {
    static constexpr bool PERM = false;
    const float* H32; float* Z;
    __device__ __forceinline__ void operator()(const f32x4 (&acc)[2][2][4][2], const pg8::Unit& u, int wr, int wc, int fr, int fq) const {
        asm volatile("" : "+v"(fr), "+v"(fq));
        const int col0 = u.pn * 256 + wc * 32 + 4 * fq;
#pragma unroll
        for (int ai = 0; ai < 2; ++ai) {
            f32x4 hv[4][2][2];
#pragma unroll
            for (int m = 0; m < 4; ++m) {
                int t = 256 * u.pm + 128 * ai + 64 * wr + 16 * m + fr; t = t < T ? t : T - 1;
                const size_t off = (size_t)t * D + col0;
#pragma unroll
                for (int bj = 0; bj < 2; ++bj)
#pragma unroll
                    for (int n = 0; n < 2; ++n) hv[m][bj][n] = *(const f32x4*)(H32 + off + bj * 128 + n * 16);
            }
#pragma unroll
            for (int m = 0; m < 4; ++m) {
                const int t = 256 * u.pm + 128 * ai + 64 * wr + 16 * m + fr;
                if (t < T) {
                    const size_t off = (size_t)t * D + col0;
#pragma unroll
                    for (int bj = 0; bj < 2; ++bj)
#pragma unroll
                        for (int n = 0; n < 2; ++n) *(f32x4*)(Z + off + bj * 128 + n * 16) = acc[ai][bj][m][n] + hv[m][bj][n] * ALPHA;
                }
            }
            asm volatile("" ::: "memory");
        }
    }
};

__device__ __forceinline__ void phase_proj(const Params& p_in, int layer_in, char* smem) {
    const Params p = kparams(); const int layer = opaque_int(layer_in); (void)p_in;
    pg8::Gemm g; g.A = (const bf16_t*)(p.ws + OFF_HB); g.Bt = (const bf16_t*)(p.ws + OFF_WIN) + (size_t)layer * INWP * D; g.M = TP; g.N = INWP; g.K = D;
    pg8::StaticOrder S; S.init(TP, INWP, gridDim.x, opaque_bid());
    EpiProj E; E.ws = p.ws;
    pg8::gemm_phase((LAS unsigned char*)smem, g, S, E);
}
__device__ __forceinline__ void phase_outproj(const Params& p_in, int layer_in, char* smem) {
    const Params p = kparams(); const int layer = opaque_int(layer_in); (void)p_in;
    const bf16_t* MIXp = (const bf16_t*)(p.ws + OFF_MIX);
    const bf16_t* WOUT = (const bf16_t*)(p.ws + OFF_WOUT) + (size_t)layer * D * D;
    const float* H32 = (const float*)(p.ws + OFF_H32);
    float* Z = (float*)(p.ws + OFF_GQ);
    {
        pg8::Gemm g; g.A = MIXp; g.Bt = WOUT; g.M = 16384; g.N = D; g.K = D;
        pg8::StaticOrder S; S.init(16384, D, gridDim.x, opaque_bid());
        EpiOut E; E.H32 = H32; E.Z = Z;
        pg8::gemm_phase((LAS unsigned char*)smem, g, S, E);
    }
    const int tid = opaque_tid(), wid = __builtin_amdgcn_readfirstlane(tid >> 6), lane = tid & 63, fr = lane & 15, fq = lane >> 4;
    for (int task = opaque_bid(); task < 64; task += gridDim.x) {
        const int rg = task >> 3, cs = task & 7;
        const bf16_t* ap = MIXp + (size_t)(16384 + 16 * rg + fr) * D + 8 * fq;
        const bf16_t* bp = WOUT + (size_t)(128 * cs + 16 * wid + fr) * D + 8 * fq;
        f32x4 acc = {0.f, 0.f, 0.f, 0.f};
        bf16x8 a0[8], b0[8], a1[8], b1[8];
#pragma unroll
        for (int k = 0; k < 8; ++k) { a0[k] = *(const bf16x8*)(ap + 32 * k); b0[k] = *(const bf16x8*)(bp + 32 * k); }
#pragma unroll
        for (int ch = 0; ch < 4; ++ch) {
            if (ch < 3) {
#pragma unroll
                for (int k = 0; k < 8; ++k) { a1[k] = *(const bf16x8*)(ap + 256 * (ch + 1) + 32 * k); b1[k] = *(const bf16x8*)(bp + 256 * (ch + 1) + 32 * k); }
            }
#pragma unroll
            for (int k = 0; k < 8; ++k) acc = __builtin_amdgcn_mfma_f32_16x16x32_bf16(a0[k], b0[k], acc, 0, 0, 0);
#pragma unroll
            for (int k = 0; k < 8; ++k) { a0[k] = a1[k]; b0[k] = b1[k]; }
        }
#pragma unroll
        for (int r = 0; r < 4; ++r) {
            const size_t off = (size_t)(16384 + 16 * rg + 4 * fq + r) * D + 128 * cs + 16 * wid + fr;
            Z[off] = acc[r] + ALPHA * H32[off];
        }
    }
}

__device__ __forceinline__ void phase_gla_naive(const Params& p, int layer, char* smem) {
    float (*qs)[64] = (float (*)[64])smem;
    float (*ks)[64] = qs + 8;
    float (*es)[64] = ks + 8;
    float (*part)[8] = (float (*)[8])(es + 8);
    float (*os)[128] = (float (*)[128])(part + 2);
    const int tid = opaque_tid();
    const bf16_t* GQ = (const bf16_t*)(p.ws + OFF_GQ);
    const bf16_t* GK = (const bf16_t*)(p.ws + OFF_GK);
    const bf16_t* GV = (const bf16_t*)(p.ws + OFF_GV);
    const float* GLR = (const float*)(p.ws + OFF_GLR);
    bf16_t* MIX = (bf16_t*)(p.ws + OFF_MIX);
    const float* ng = p.norm_g + layer * 128;
    const float* wg2 = p.wg2 + (size_t)layer * 16 * 256; const float* bg = p.bg + layer * 256;
    for (int item = opaque_bid(); item < NB * 4; item += gridDim.x) {
        const int b = item >> 2, h = item & 3;
        float S[64];
#pragma unroll
        for (int d = 0; d < 64; ++d) S[d] = 0.f;
        const int e = tid & 127;
        const float nge = ng[e];
        const int ltt = tid >> 6, ld = tid & 63;
        float w[16];
#pragma unroll
        for (int rr = 0; rr < 16; ++rr) w[rr] = wg2[rr * 256 + h * 64 + ld];
        const float bgd = bg[h * 64 + ld];
        for (int t0 = 0; t0 < L; t0 += 8) {
            __syncthreads();
            {
                const size_t row = (size_t)b * L + t0 + ltt;
                qs[ltt][ld] = bf2f(GQ[row * 256 + h * 64 + ld]);
                ks[ltt][ld] = bf2f(GK[row * 256 + h * 64 + ld]);
                const float4* gp = (const float4*)&GLR[row * 16];
                const float4 g0 = gp[0], g1 = gp[1], g2 = gp[2], g3 = gp[3];
                float s = bgd;
                s = fmaf(g0.x, w[0], s); s = fmaf(g0.y, w[1], s); s = fmaf(g0.z, w[2], s); s = fmaf(g0.w, w[3], s);
                s = fmaf(g1.x, w[4], s); s = fmaf(g1.y, w[5], s); s = fmaf(g1.z, w[6], s); s = fmaf(g1.w, w[7], s);
                s = fmaf(g2.x, w[8], s); s = fmaf(g2.y, w[9], s); s = fmaf(g2.z, w[10], s); s = fmaf(g2.w, w[11], s);
                s = fmaf(g3.x, w[12], s); s = fmaf(g3.y, w[13], s); s = fmaf(g3.z, w[14], s); s = fmaf(g3.w, w[15], s);
                es[ltt][ld] = expf(logsigmoid_f(s) * (1.f / 16.f));
            }
            __syncthreads();
            if (tid < 128) {
#pragma unroll 1
                for (int tt = 0; tt < 8; ++tt) {
                    const size_t row = (size_t)b * L + t0 + tt;
                    const float v = bf2f(GV[row * 512 + h * 128 + e]);
                    float acc = 0.f;
#pragma unroll
                    for (int d = 0; d < 64; ++d) {
                        S[d] = fmaf(es[tt][d], S[d], ks[tt][d] * v);
                        acc = fmaf(qs[tt][d], S[d], acc);
                    }
                    os[tt][e] = acc;
                    const float ss = wave_sum(acc * acc);
                    if ((tid & 63) == 0) part[tid >> 6][tt] = ss;
                }
            }
            __syncthreads();
            if (tid < 128) {
#pragma unroll 1
                for (int tt = 0; tt < 8; ++tt) {
                    const size_t row = (size_t)b * L + t0 + tt;
                    const float tot = part[0][tt] + part[1][tt];
                    const float rinv = rsqrtf(tot * (1.f / 128) + LN_EPS);
                    const size_t idx = row * 1024 + h * 128 + e;
                    MIX[idx] = f2bf(os[tt][e] * rinv * nge * bf2f(MIX[idx]));
                }
            }
        }
    }
}

__device__ __forceinline__ unsigned okey(float x) {
    const unsigned u = __float_as_uint(x);
    return (u & 0x80000000u) ? ~u : (u | 0x80000000u);
}
__device__ __forceinline__ int wave_incl_scan(int v) {
    const int lane = opaque_tid() & 63;
#pragma unroll
    for (int o = 1; o < 64; o <<= 1) { const int n = __shfl_up(v, o); if (lane >= o) v += n; }
    return v;
}
__device__ __forceinline__ int block_excl_scan(int v, int* tmp) {
    const int incl = wave_incl_scan(v);
    const int tq = opaque_tid();
    __syncthreads();
    if ((tq & 63) == 63) tmp[tq >> 6] = incl;
    __syncthreads();
    const int w = tq >> 6;
    int base = 0;
    for (int i = 0; i < w; ++i) base += tmp[i];
    return base + incl - v;
}
__device__ __forceinline__ void unpack8(const uint4 u, float* kf) {
    kf[0] = __uint_as_float(u.x << 16); kf[1] = __uint_as_float(u.x & 0xFFFF0000u);
    kf[2] = __uint_as_float(u.y << 16); kf[3] = __uint_as_float(u.y & 0xFFFF0000u);
    kf[4] = __uint_as_float(u.z << 16); kf[5] = __uint_as_float(u.z & 0xFFFF0000u);
    kf[6] = __uint_as_float(u.w << 16); kf[7] = __uint_as_float(u.w & 0xFFFF0000u);
}

__device__ __forceinline__ void phase_dsa_naive(const Params& p, int layer, char* smem) {
    float* sc = (float*)smem;
    float (*iqs)[64] = (float (*)[64])(sc + 2080);
    float (*aqs)[64] = iqs + 8;
    float (*lg)[256] = (float (*)[256])(aqs + 8);
    unsigned* hist = (unsigned*)(lg + 8);
    int* sel = (int*)(hist + 256);
    int* misc = sel + 256;
    const int tid = opaque_tid();
    const bf16_t* IQ = (const bf16_t*)(p.ws + OFF_IQ);
    const bf16_t* IK = (const bf16_t*)(p.ws + OFF_IK);
    const float* IW = (const float*)(p.ws + OFF_IW);
    const bf16_t* AQ = (const bf16_t*)(p.ws + OFF_AQ);
    const bf16_t* AK = (const bf16_t*)(p.ws + OFF_AK);
    const bf16_t* AV = (const bf16_t*)(p.ws + OFF_AV);
    bf16_t* MIX = (bf16_t*)(p.ws + OFF_MIX);
    for (int item = opaque_bid(); item < T; item += gridDim.x) {
        const int b = item / L, t = item % L;
        const size_t row = (size_t)item;
        __syncthreads();
        iqs[tid >> 6][tid & 63] = bf2f(IQ[row * 512 + tid]); aqs[tid >> 6][tid & 63] = bf2f(AQ[row * 512 + tid]);
        __syncthreads();
        float w[8];
#pragma unroll
        for (int j = 0; j < 8; ++j) w[j] = IW[row * 8 + j];
        for (int s = tid; s <= t; s += NT) {
            const uint4* kp = (const uint4*)&IK[((size_t)b * L + s) * 64];
            float dd[8];
#pragma unroll
            for (int j = 0; j < 8; ++j) dd[j] = 0.f;
#pragma unroll 1
            for (int q = 0; q < 8; ++q) {
                float kf[8]; unpack8(kp[q], kf);
#pragma unroll
                for (int j = 0; j < 8; ++j) {
                    const float4 a0 = *(const float4*)&iqs[j][q * 8], a1 = *(const float4*)&iqs[j][q * 8 + 4];
                    dd[j] = fmaf(a0.x, kf[0], dd[j]); dd[j] = fmaf(a0.y, kf[1], dd[j]); dd[j] = fmaf(a0.z, kf[2], dd[j]); dd[j] = fmaf(a0.w, kf[3], dd[j]);
                    dd[j] = fmaf(a1.x, kf[4], dd[j]); dd[j] = fmaf(a1.y, kf[5], dd[j]); dd[j] = fmaf(a1.z, kf[6], dd[j]); dd[j] = fmaf(a1.w, kf[7], dd[j]);
                }
            }
            float score = 0.f;
#pragma unroll
            for (int j = 0; j < 8; ++j) score = fmaf(w[j], fmaxf(dd[j], 0.f), score);
            sc[s] = score;
        }
        __syncthreads();
        const int n = t + 1;
        int nsel;
        if (n <= TOPK) {
            if (tid < n) sel[tid] = tid;
            nsel = n;
        } else {
            unsigned prefix = 0; int remaining = TOPK;
            for (int pass = 0; pass < 4; ++pass) {
                const int shift = 24 - 8 * pass;
                if (tid < 256) hist[tid] = 0;
                __syncthreads();
                for (int s = tid; s < n; s += NT) {
                    const unsigned key = okey(sc[s]);
                    const bool match = (pass == 0) || ((key >> (shift + 8)) == prefix);
                    if (match) atomicAdd(&hist[(key >> shift) & 255u], 1u);
                }
                __syncthreads();
                if (tid == 0) {
                    int cum = 0, d = 255;
                    for (; d > 0; --d) { const int c = (int)hist[d]; if (cum + c >= remaining) break; cum += c; }
                    misc[0] = d; misc[1] = remaining - cum;
                }
                __syncthreads();
                prefix = (prefix << 8) | (unsigned)misc[0]; remaining = misc[1];
                __syncthreads();
            }
            const int s0 = tid * 5;
            int ceq = 0;
#pragma unroll
            for (int q = 0; q < 5; ++q) { const int s = s0 + q; if (s < n && okey(sc[s]) == prefix) ++ceq; }
            int eqrank = block_excl_scan(ceq, misc + 8);
            int csel = 0; unsigned selmask = 0;
#pragma unroll
            for (int q = 0; q < 5; ++q) {
                const int s = s0 + q;
                if (s < n) {
                    const unsigned key = okey(sc[s]);
                    bool take = key > prefix;
                    if (key == prefix) { take = eqrank < remaining; ++eqrank; }
                    if (take) { ++csel; selmask |= 1u << q; }
                }
            }
            int posn = block_excl_scan(csel, misc + 16);
#pragma unroll
            for (int q = 0; q < 5; ++q) if (selmask & (1u << q)) { if (posn < TOPK) sel[posn] = s0 + q; ++posn; }
            nsel = TOPK;
        }
        __syncthreads();
        {
            const int i = tid & 255, g = tid >> 8;
            if (i < nsel) {
                const int kidx = sel[i];
                const uint4* kp = (const uint4*)&AK[((size_t)b * L + kidx) * 128 + g * 64];
                float dd[4] = {0.f, 0.f, 0.f, 0.f};
#pragma unroll 1
                for (int q = 0; q < 8; ++q) {
                    float kf[8]; unpack8(kp[q], kf);
#pragma unroll
                    for (int r = 0; r < 4; ++r) {
                        const float4 a0 = *(const float4*)&aqs[g * 4 + r][q * 8], a1 = *(const float4*)&aqs[g * 4 + r][q * 8 + 4];
                        dd[r] = fmaf(a0.x, kf[0], dd[r]); dd[r] = fmaf(a0.y, kf[1], dd[r]); dd[r] = fmaf(a0.z, kf[2], dd[r]); dd[r] = fmaf(a0.w, kf[3], dd[r]);
                        dd[r] = fmaf(a1.x, kf[4], dd[r]); dd[r] = fmaf(a1.y, kf[5], dd[r]); dd[r] = fmaf(a1.z, kf[6], dd[r]); dd[r] = fmaf(a1.w, kf[7], dd[r]);
                    }
                }
#pragma unroll
                for (int r = 0; r < 4; ++r) lg[g * 4 + r][i] = dd[r];
            } else {
#pragma unroll
                for (int r = 0; r < 4; ++r) lg[g * 4 + r][i] = -INFINITY;
            }
        }
        __syncthreads();
        {
            const int h = tid >> 6, lane = tid & 63;
            float v0 = lg[h][lane], v1 = lg[h][lane + 64], v2 = lg[h][lane + 128], v3 = lg[h][lane + 192];
            const float m = wave_max(fmaxf(fmaxf(v0, v1), fmaxf(v2, v3)));
            v0 = expf(v0 - m); v1 = expf(v1 - m); v2 = expf(v2 - m); v3 = expf(v3 - m);
            const float inv = 1.f / wave_sum(v0 + v1 + v2 + v3);
            lg[h][lane] = v0 * inv; lg[h][lane + 64] = v1 * inv; lg[h][lane + 128] = v2 * inv; lg[h][lane + 192] = v3 * inv;
        }
        __syncthreads();
        {
            const int h = tid >> 6, d = tid & 63, g = h >> 2;
            float o = 0.f;
            for (int i = 0; i < nsel; ++i) o = fmaf(lg[h][i], bf2f(AV[((size_t)b * L + sel[i]) * 128 + g * 64 + d]), o);
            const size_t mi = row * 1024 + 512 + tid;
            MIX[mi] = f2bf(o * bf2f(MIX[mi]));
        }
    }
}


constexpr int DS_SC = 0, DS_BITS = 132096, DS_HIST = DS_BITS + 4224, DS_END = DS_HIST + 8 * 1040;
constexpr int DS_MB = 3 * 32768, DS_MBROW = 2112;
static_assert(DS_MB + 16 * DS_MBROW <= DS_BITS, "mask bytes overlap");


template <int NR>
__device__ __forceinline__ void dsa_select(const LAS unsigned* row, LAS unsigned* bits, LAS unsigned* hist, int n, int lane) {
    unsigned kreg[NR];
#pragma unroll
    for (int i = 0; i < NR; ++i) kreg[i] = (lane < n - 64 * i) ? row[lane + 64 * i] : 0u;
    unsigned prefix = 0; int remaining = TOPK;
#pragma unroll 1
    for (int pass = 0; pass < 4; ++pass) {
        const int shift = 24 - 8 * pass;
        *(LAS u32x4*)(hist + lane * 4) = (u32x4){0u, 0u, 0u, 0u};
        __builtin_amdgcn_wave_barrier(); asm volatile("" ::: "memory");
        const unsigned sh8 = (unsigned)(shift + 8) & 31u;
#pragma unroll
        for (int i = 0; i < NR; ++i) {
            const unsigned key = kreg[i];
            const bool match = (lane < n - 64 * i) && ((pass == 0) || ((key >> sh8) == prefix));
            if (match) __hip_atomic_fetch_add(hist + ((key >> shift) & 255u), 1u, __ATOMIC_RELAXED, __HIP_MEMORY_SCOPE_WAVEFRONT);
        }
        __builtin_amdgcn_wave_barrier(); asm volatile("s_waitcnt lgkmcnt(0)" ::: "memory");
        const u32x4 hv = *(const LAS u32x4*)(hist + (63 - lane) * 4);
        const int c0 = (int)hv[3], c1 = (int)hv[2], c2 = (int)hv[1], c3 = (int)hv[0];
        const int tot = c0 + c1 + c2 + c3;
        const int incl = wave_incl_scan(tot), excl = incl - tot;
        const bool found = (excl < remaining) && (remaining <= incl);
        int digit = 0, rem_new = 0;
        if (found) {
            int cum = excl;
            if (cum + c0 >= remaining) { digit = 255 - 4 * lane; rem_new = remaining - cum; }
            else { cum += c0;
                if (cum + c1 >= remaining) { digit = 254 - 4 * lane; rem_new = remaining - cum; }
                else { cum += c1;
                    if (cum + c2 >= remaining) { digit = 253 - 4 * lane; rem_new = remaining - cum; }
                    else { cum += c2; digit = 252 - 4 * lane; rem_new = remaining - cum; } } }
        }
        const unsigned long long fm = __ballot(found);
        const int src = (int)__builtin_ctzll(fm);
        digit = __builtin_amdgcn_readlane(digit, src); rem_new = __builtin_amdgcn_readlane(rem_new, src);
        prefix = (prefix << 8) | (unsigned)digit; remaining = rem_new;
    }
    const unsigned tkey = prefix;
    int eqcount = 0;
#pragma unroll
    for (int i = 0; i < 33; ++i) {
        if (i < NR) {
            const unsigned key = kreg[i < NR ? i : 0];
            const bool valid = lane < n - 64 * i;
            const bool gt = valid && (key > tkey), eq = valid && (key == tkey);
            const unsigned long long em = __ballot(eq);
            const int rank = eqcount + __popcll(em & ((1ull << lane) - 1ull));
            const bool sel = gt || (eq && rank < remaining);
            eqcount += __popcll(em);
            const unsigned long long sm = __ballot(sel);
            if (lane == 0) { bits[2 * i] = (unsigned)sm; bits[2 * i + 1] = (unsigned)(sm >> 32); }
        } else if (lane == 0) { bits[2 * i] = 0u; bits[2 * i + 1] = 0u; }
    }
}

__device__ __forceinline__ void phase_dsa(const Params& p_in, int layer_in, char* smem, bool do_store) {
    const Params p = kparams(); const int layer = opaque_int(layer_in); (void)p_in;
    const int tid = opaque_tid(), wid = __builtin_amdgcn_readfirstlane(tid >> 6), lane = tid & 63, fr = lane & 15, fq = lane >> 4;
    LAS unsigned char* lds = (LAS unsigned char*)smem;
    const bf16_t* IQ = (const bf16_t*)(p.ws + OFF_IQ);
    const bf16_t* IK = (const bf16_t*)(p.ws + OFF_IK);
    const float* IW = (const float*)(p.ws + OFF_IW);
    const bf16_t* AQ = (const bf16_t*)(p.ws + OFF_AQ);
    const bf16_t* AK = (const bf16_t*)(p.ws + OFF_AK);
    const bf16_t* AVT = (const bf16_t*)(p.ws + OFF_AV);
    bf16_t* MIX = (bf16_t*)(p.ws + OFF_MIX);
    constexpr int NITEM = NB * 129;
    for (int idx = opaque_bid(); idx < NITEM; idx += gridDim.x) {
        const int b = idx & 7, mm = idx >> 3;
        int qr;
        { const int seg = mm >> 5, jj = mm & 31; qr = (seg == 0) ? jj : (seg == 1) ? 63 - jj : (seg == 2) ? 64 + jj : (seg == 3) ? 127 - jj : 128; }
        const int qt = 128 - qr, t0 = qt * 16;
        const size_t rowq = (size_t)b * L + t0 + fr;
        __syncthreads();
        for (int repA = 0; repA < PROBE_DSA_A; ++repA) {
            bf16x8 qf[8][2];
#pragma unroll
            for (int jh = 0; jh < 8; ++jh)
#pragma unroll
                for (int s2 = 0; s2 < 2; ++s2) qf[jh][s2] = *(const bf16x8*)(IQ + rowq * 512 + jh * 64 + s2 * 32 + fq * 8);
            float w[8];
            { const f32x4 w0 = *(const f32x4*)(IW + rowq * 8), w1 = *(const f32x4*)(IW + rowq * 8 + 4);
              w[0] = w0[0]; w[1] = w0[1]; w[2] = w0[2]; w[3] = w0[3]; w[4] = w1[0]; w[5] = w1[1]; w[6] = w1[2]; w[7] = w1[3]; }
            const int ntile = qt + 1;
            const bf16x8 z8 = {0, 0, 0, 0, 0, 0, 0, 0};
            bf16x8 ka0 = z8, ka1 = z8, kb0 = z8, kb1 = z8, kc0 = z8, kc1 = z8;
            int kt = wid;
            if (kt < ntile) { const bf16_t* kp = IK + ((size_t)b * L + 16 * kt + fr) * 64 + fq * 8; ka0 = *(const bf16x8*)kp; ka1 = *(const bf16x8*)(kp + 32); }
            if (kt + 8 < ntile) { const bf16_t* kp = IK + ((size_t)b * L + 16 * (kt + 8) + fr) * 64 + fq * 8; kb0 = *(const bf16x8*)kp; kb1 = *(const bf16x8*)(kp + 32); }
            for (; kt < ntile; kt += 8) {
                if (kt + 16 < ntile) { const bf16_t* kp = IK + ((size_t)b * L + 16 * (kt + 16) + fr) * 64 + fq * 8; kc0 = *(const bf16x8*)kp; kc1 = *(const bf16x8*)(kp + 32); }
                f32x4 sc = {0.f, 0.f, 0.f, 0.f};
#pragma unroll
                for (int jh = 0; jh < 8; ++jh) {
                    f32x4 d = {0.f, 0.f, 0.f, 0.f};
                    d = __builtin_amdgcn_mfma_f32_16x16x32_bf16(ka0, qf[jh][0], d, 0, 0, 0);
                    d = __builtin_amdgcn_mfma_f32_16x16x32_bf16(ka1, qf[jh][1], d, 0, 0, 0);
#pragma unroll
                    for (int r = 0; r < 4; ++r) sc[r] = fmaf(w[jh], fmaxf(d[r], 0.f), sc[r]);
                }
                u32x4 ko;
#pragma unroll
                for (int r = 0; r < 4; ++r) ko[r] = okey(sc[r]);
                *(LAS u32x4*)(lds + DS_SC + (fr * 2064 + 16 * kt + 4 * fq) * 4) = ko;
                ka0 = kb0; ka1 = kb1; kb0 = kc0; kb1 = kc1;
            }
        }
        __syncthreads();
        for (int repB = 0; repB < PROBE_DSA_B; ++repB) {
            LAS unsigned* hist = (LAS unsigned*)(lds + DS_HIST + wid * 1040);
#pragma unroll 1
            for (int qq = 0; qq < 2; ++qq) {
                const int q = wid * 2 + qq;
                const int n = t0 + q + 1;
                const LAS unsigned* row = (const LAS unsigned*)(lds + DS_SC) + q * 2064;
                LAS unsigned* bits = (LAS unsigned*)(lds + DS_BITS) + q * 66;
                if (n <= TOPK) {
#pragma unroll 1
                    for (int i = 0; i < 33; ++i) {
                        const unsigned long long sm = __ballot(lane + 64 * i < n);
                        if (lane == 0) { bits[2 * i] = (unsigned)sm; bits[2 * i + 1] = (unsigned)(sm >> 32); }
                    }
                } else {
                    const int nr = (n + 63) >> 6;
                    if (nr <= 9) dsa_select<9>(row, bits, hist, n, lane);
                    else if (nr <= 17) dsa_select<17>(row, bits, hist, n, lane);
                    else if (nr <= 25) dsa_select<25>(row, bits, hist, n, lane);
                    else dsa_select<33>(row, bits, hist, n, lane);
                }
            }
        }
        __syncthreads();
        for (int repC = 0; repC < PROBE_DSA_C; ++repC) {
            if (repC > 0) __syncthreads();
            const int h = wid, g = h >> 2;
            const int nstep = (t0 + 16 + 63) >> 6;
            bf16x8 aqf[2];
            aqf[0] = *(const bf16x8*)(AQ + rowq * 512 + h * 64 + fq * 8);
            aqf[1] = *(const bf16x8*)(AQ + rowq * 512 + h * 64 + 32 + fq * 8);
            asm volatile("" : "+v"(aqf[0]), "+v"(aqf[1]));
            const int drow = 8 * wid + (lane >> 3);
            const int kch = (lane & 7) ^ (drow & 7), vch = (lane & 7) ^ ((drow >> 1) & 7);
            const bf16_t* vsrc0 = AVT + ((size_t)b * 128 + drow) * LP + vch * 8;
#define DSA_DMA(st_, buf_) do { \
                int krow_ = b * L + 64 * (st_) + drow; krow_ = krow_ < T ? krow_ : T - 1; \
                const bf16_t* ks_ = AK + (size_t)krow_ * 128 + kch * 8; \
                LAS unsigned char* lb_ = lds + (buf_) * 32768 + wid * 1024; \
                __builtin_amdgcn_global_load_lds((const unsigned*)ks_, (LAS unsigned*)lb_, 16, 0, 0); \
                __builtin_amdgcn_global_load_lds((const unsigned*)(ks_ + 64), (LAS unsigned*)(lb_ + 8192), 16, 0, 0); \
                __builtin_amdgcn_global_load_lds((const unsigned*)(vsrc0 + 64 * (st_)), (LAS unsigned*)(lb_ + 16384), 16, 0, 0); \
                __builtin_amdgcn_global_load_lds((const unsigned*)(vsrc0 + (size_t)64 * LP + 64 * (st_)), (LAS unsigned*)(lb_ + 24576), 16, 0, 0); } while (0)
            DSA_DMA(0, 0);
            DSA_DMA((nstep > 1 ? 1 : 0), 1);
            for (int wi = tid; wi < 16 * 66; wi += NT) {
                const int q = wi / 66, wd = wi - q * 66;
                const unsigned bw = *((const LAS unsigned*)(lds + DS_BITS) + wi);
                const int st = wd >> 1, hh = wd & 1;
#pragma unroll
                for (int f = 0; f < 4; ++f) {
                    const unsigned n0 = (bw >> (4 * f)) & 15u, n1 = (bw >> (16 + 4 * f)) & 15u;
                    u32x2 o; o.x = (n0 * 0x00204081u) & 0x01010101u; o.y = (n1 * 0x00204081u) & 0x01010101u;
                    *(LAS u32x2*)(lds + DS_MB + q * DS_MBROW + 64 * st + 16 * f + 8 * hh) = o;
                }
            }
            asm volatile("s_waitcnt vmcnt(4) lgkmcnt(0)" ::: "memory");
            __builtin_amdgcn_s_barrier();
            asm volatile("" ::: "memory");
            f32x4 O[4];
#pragma unroll
            for (int dt = 0; dt < 4; ++dt) O[dt] = (f32x4){0.f, 0.f, 0.f, 0.f};
            float m = -INFINITY, l = 0.f;
            const float C2 = 1.44269504088896341f;
            int buf = 0;
            for (int st = 0; st < nstep; ++st) {
                {
                    const int sn = (st + 2 < nstep) ? st + 2 : nstep - 1;
                    const int bn = (buf >= 1) ? buf - 1 : 2;
                    DSA_DMA(sn, bn);
                }
                const LAS unsigned char* sb = lds + buf * 32768;
                f32x4 S[4];
#pragma unroll
                for (int kt = 0; kt < 4; ++kt) {
                    S[kt] = (f32x4){0.f, 0.f, 0.f, 0.f};
#pragma unroll
                    for (int s2 = 0; s2 < 2; ++s2) {
                        const int rowk = 16 * kt + fr;
                        const bf16x8 kf = *(const LAS bf16x8*)(sb + g * 8192 + rowk * 128 + 16 * ((4 * s2 + fq) ^ (rowk & 7)));
                        S[kt] = __builtin_amdgcn_mfma_f32_16x16x32_bf16(kf, aqf[s2], S[kt], 0, 0, 0);
                    }
                }
                const u32x4 mb = *(const LAS u32x4*)(lds + DS_MB + fr * DS_MBROW + 64 * st + 16 * fq);
                float pmax = S[0][0];
#pragma unroll
                for (int kt = 0; kt < 4; ++kt)
#pragma unroll
                    for (int r = 0; r < 4; ++r) pmax = fmaxf(pmax, S[kt][r]);
                if (__any(pmax > m + 8.0f)) {
                    float pm = fmaxf(pmax, __shfl_xor(pmax, 16)); pm = fmaxf(pm, __shfl_xor(pm, 32));
                    const float mn = fmaxf(m, pm);
                    const float alpha = __builtin_amdgcn_exp2f((m - mn) * C2);
#pragma unroll
                    for (int dt = 0; dt < 4; ++dt) O[dt] *= alpha;
                    l *= alpha; m = mn;
                }
                const float mc = m * C2;
                unsigned pk[4][2];
#pragma unroll
                for (int kt = 0; kt < 4; ++kt) {
                    float pv[4];
#pragma unroll
                    for (int r = 0; r < 4; ++r) {
                        const float e = __builtin_amdgcn_exp2f(fmaf(S[kt][r], C2, -mc));
                        const float bf = (float)((mb[kt] >> (8 * r)) & 0xFFu);
                        pv[r] = e * bf; l += pv[r];
                    }
                    pk[kt][0] = cvt_pk_bf16(pv[0], pv[1]); pk[kt][1] = cvt_pk_bf16(pv[2], pv[3]);
                }
#pragma unroll
                for (int ks = 0; ks < 2; ++ks) {
                    u32x4 pw; pw[0] = pk[2 * ks][0]; pw[1] = pk[2 * ks][1]; pw[2] = pk[2 * ks + 1][0]; pw[3] = pk[2 * ks + 1][1];
                    const bf16x8 pf = __builtin_bit_cast(bf16x8, pw);
#pragma unroll
                    for (int dt = 0; dt < 4; ++dt) {
                        const int rowv = 16 * dt + fr, sw = (rowv >> 1) & 7;
                        const LAS unsigned char* vp = sb + 16384 + g * 8192 + rowv * 128 + 8 * (fq & 1);
                        const u32x2 va = *(const LAS u32x2*)(vp + 16 * ((4 * ks + (fq >> 1)) ^ sw));
                        const u32x2 vb = *(const LAS u32x2*)(vp + 16 * ((4 * ks + 2 + (fq >> 1)) ^ sw));
                        u32x4 vw; vw[0] = va[0]; vw[1] = va[1]; vw[2] = vb[0]; vw[3] = vb[1];
                        O[dt] = __builtin_amdgcn_mfma_f32_16x16x32_bf16(__builtin_bit_cast(bf16x8, vw), pf, O[dt], 0, 0, 0);
                    }
                }
                asm volatile("s_waitcnt vmcnt(4)" ::: "memory");
                __builtin_amdgcn_s_barrier();
                asm volatile("" ::: "memory");
                buf = (buf == 2) ? 0 : buf + 1;
            }
#undef DSA_DMA
            asm volatile("s_waitcnt vmcnt(0)" ::: "memory");
            l += __shfl_xor(l, 16); l += __shfl_xor(l, 32);
            const float inv = 1.f / fmaxf(l, 1e-30f);
            bf16_t* mp = MIX + rowq * 1024 + 512 + h * 64 + 4 * fq;
            if (do_store && repC == PROBE_DSA_C - 1)
#pragma unroll
            for (int dt = 0; dt < 4; ++dt) {
                const uint2 gz = *(const uint2*)(mp + 16 * dt);
                const float g0 = __uint_as_float(gz.x << 16), g1 = __uint_as_float(gz.x & 0xFFFF0000u), g2 = __uint_as_float(gz.y << 16), g3 = __uint_as_float(gz.y & 0xFFFF0000u);
                uint2 o; o.x = pack2bf(O[dt][0] * inv * g0, O[dt][1] * inv * g1); o.y = pack2bf(O[dt][2] * inv * g2, O[dt][3] * inv * g3);
                *(uint2*)(mp + 16 * dt) = o;
            }
        }
    }
}

__device__ __forceinline__ void rope16(const u32x4 a, const u32x4 b, const float2* rp, u32x4& oa, u32x4& ob) {
    const f32x4 r0 = *(const f32x4*)(rp), r1 = *(const f32x4*)(rp + 2), r2 = *(const f32x4*)(rp + 4), r3 = *(const f32x4*)(rp + 6);
    const float cs[8] = {r0[0], r0[2], r1[0], r1[2], r2[0], r2[2], r3[0], r3[2]};
    const float sn[8] = {r0[1], r0[3], r1[1], r1[3], r2[1], r2[3], r3[1], r3[3]};
    float o1[8], o2[8];
#pragma unroll
    for (int i = 0; i < 4; ++i) {
        const float x1l = __uint_as_float(a[i] << 16), x1h = __uint_as_float(a[i] & 0xFFFF0000u);
        const float x2l = __uint_as_float(b[i] << 16), x2h = __uint_as_float(b[i] & 0xFFFF0000u);
        o1[2 * i] = x1l * cs[2 * i] - x2l * sn[2 * i]; o1[2 * i + 1] = x1h * cs[2 * i + 1] - x2h * sn[2 * i + 1];
        o2[2 * i] = x2l * cs[2 * i] + x1l * sn[2 * i]; o2[2 * i + 1] = x2h * cs[2 * i + 1] + x1h * sn[2 * i + 1];
    }
#pragma unroll
    for (int i = 0; i < 4; ++i) { oa[i] = cvt_pk_bf16(o1[2 * i], o1[2 * i + 1]); ob[i] = cvt_pk_bf16(o2[2 * i], o2[2 * i + 1]); }
}
__device__ __forceinline__ void phase_rope(const Params& p_in, int layer_in, char* smem) {
    const Params p = kparams(); const int layer = opaque_int(layer_in); (void)p_in;
    const int tid = opaque_tid();
    const float2* ROPE = (const float2*)(p.ws + OFF_ROPE);
    const int nthr = gridDim.x * NT, gid = opaque_bid() * NT + tid;
    for (int th = gid; th < T * 18; th += nthr) {
        const int t = th / 18, hh = th - t * 18, pos = t % L;
        bf16_t* base = (hh < 8) ? (bf16_t*)(p.ws + OFF_AQ) + (size_t)t * 512 + hh * 64
                     : (hh < 16) ? (bf16_t*)(p.ws + OFF_IQ) + (size_t)t * 512 + (hh - 8) * 64
                                 : (bf16_t*)(p.ws + OFF_AK) + (size_t)t * 128 + (hh - 16) * 64;
        const u32x4 a = *(const u32x4*)base, b = *(const u32x4*)(base + 8);
        u32x4 oa, ob; rope16(a, b, ROPE + pos * 8, oa, ob);
        *(u32x4*)base = oa; *(u32x4*)(base + 8) = ob;
    }
    const float* IKR = (const float*)(p.ws + OFF_IKR);
    bf16_t* IK = (bf16_t*)(p.ws + OFF_IK);
    const float* ikg = p.ikg + layer * 64; const float* ikb = p.ikb + layer * 64;
    for (int t = gid; t < T; t += nthr) {
        const int pos = t % L;
        f32x4 x[16];
#pragma unroll
        for (int i = 0; i < 16; ++i) x[i] = *(const f32x4*)(IKR + (size_t)t * 64 + 4 * i);
        float sm = 0.f;
#pragma unroll
        for (int i = 0; i < 16; ++i) sm += (x[i][0] + x[i][1]) + (x[i][2] + x[i][3]);
        const float mu = sm * (1.f / 64);
        float qq = 0.f;
#pragma unroll
        for (int i = 0; i < 16; ++i) { const f32x4 d = x[i] - mu; qq += (d[0] * d[0] + d[1] * d[1]) + (d[2] * d[2] + d[3] * d[3]); }
        const float rs = rsqrtf(qq * (1.f / 64) + LN_EPS);
#pragma unroll
        for (int i = 0; i < 16; ++i) { const f32x4 g = *(const f32x4*)(ikg + 4 * i), bb = *(const f32x4*)(ikb + 4 * i); x[i] = (x[i] - mu) * rs * g + bb; }
        const float2* rp = ROPE + pos * 8;
        const f32x4 r0 = *(const f32x4*)(rp), r1 = *(const f32x4*)(rp + 2), r2 = *(const f32x4*)(rp + 4), r3 = *(const f32x4*)(rp + 6);
        const float cs[8] = {r0[0], r0[2], r1[0], r1[2], r2[0], r2[2], r3[0], r3[2]};
        const float sn[8] = {r0[1], r0[3], r1[1], r1[3], r2[1], r2[3], r3[1], r3[3]};
#pragma unroll
        for (int i = 0; i < 8; ++i) {
            const float x1 = x[i >> 2][i & 3], x2 = x[2 + (i >> 2)][i & 3];
            x[i >> 2][i & 3] = x1 * cs[i] - x2 * sn[i];
            x[2 + (i >> 2)][i & 3] = x2 * cs[i] + x1 * sn[i];
        }
#pragma unroll
        for (int i = 0; i < 8; ++i) {
            u32x4 o; o[0] = cvt_pk_bf16(x[2 * i][0], x[2 * i][1]); o[1] = cvt_pk_bf16(x[2 * i][2], x[2 * i][3]); o[2] = cvt_pk_bf16(x[2 * i + 1][0], x[2 * i + 1][1]); o[3] = cvt_pk_bf16(x[2 * i + 1][2], x[2 * i + 1][3]);
            *(u32x4*)(IK + (size_t)t * 64 + 8 * i) = o;
        }
    }
}

constexpr int GL_QE = 0, GL_KN = 8192, GL_SEG = 16384, GL_PART = 18432;
__device__ __forceinline__ void gla_cumsum(const Params& p, int layer, int b, int h, int c, int tid, LAS unsigned char* lds, float (&bc)[8], float& blast) {
    const int d = tid & 63, seg = tid >> 6;
    const float* wg2 = p.wg2 + (size_t)layer * 16 * 256 + h * 64 + d;
    float w[16];
#pragma unroll
    for (int rr = 0; rr < 16; ++rr) w[rr] = wg2[rr * 256];
    const float bgd = p.bg[layer * 256 + h * 64 + d];
    const float* GLR = (const float*)(p.ws + OFF_GLR);
    float pb = 0.f;
#pragma unroll
    for (int i = 0; i < 8; ++i) {
        const int pos = 64 * c - 48 + 8 * seg + i;
        float gl = 0.f;
        if (pos >= 0) {
            const f32x4* gp = (const f32x4*)(GLR + ((size_t)b * L + pos) * 16);
            const f32x4 g0 = gp[0], g1 = gp[1], g2 = gp[2], g3 = gp[3];
            float x = bgd;
#pragma unroll
            for (int rr = 0; rr < 4; ++rr) { x = fmaf(g0[rr], w[rr], x); }
#pragma unroll
            for (int rr = 0; rr < 4; ++rr) { x = fmaf(g1[rr], w[4 + rr], x); }
#pragma unroll
            for (int rr = 0; rr < 4; ++rr) { x = fmaf(g2[rr], w[8 + rr], x); }
#pragma unroll
            for (int rr = 0; rr < 4; ++rr) { x = fmaf(g3[rr], w[12 + rr], x); }
            gl = logsigmoid_fast(x) * (1.f / 16.f);
        }
        pb += gl; bc[i] = pb;
    }
    LAS float* segs = (LAS float*)(lds + GL_SEG);
    segs[seg * 64 + d] = pb;
    __syncthreads();
    float base = 0.f, tot = 0.f;
#pragma unroll
    for (int sg = 0; sg < 8; ++sg) { const float v = segs[sg * 64 + d]; tot += v; base += (sg < seg) ? v : 0.f; }
#pragma unroll
    for (int i = 0; i < 8; ++i) bc[i] += base;
    blast = tot;
}

constexpr size_t OUTS_QE = 0, OUTS_KN = (size_t)T * 256 * 2;
__device__ __forceinline__ void phase_gla_a(const Params& p_in, int layer_in, char* smem) {
    const Params p = kparams(); const int layer = opaque_int(layer_in); (void)p_in;
    const int tid = opaque_tid(), wid = __builtin_amdgcn_readfirstlane(tid >> 6), lane = tid & 63, fr = lane & 15, fq = lane >> 4;
    LAS unsigned char* lds = (LAS unsigned char*)smem;
    const bf16_t* GQ = (const bf16_t*)(p.ws + OFF_GQ);
    const bf16_t* GK = (const bf16_t*)(p.ws + OFF_GK);
    const bf16_t* GVT = (const bf16_t*)(p.ws + OFF_GV);
    bf16_t* QE = (bf16_t*)((char*)p.out + OUTS_QE);
    bf16_t* KN = (bf16_t*)((char*)p.out + OUTS_KN);
    float* UT = (float*)(p.ws + OFF_UT);
    float* DL = (float*)(p.ws + OFF_DL);
    for (int task = opaque_bid(); task < 32 * 33; task += gridDim.x) {
        const int bh = task / 33, c = task - bh * 33, b = bh >> 2, h = bh & 3;
        __syncthreads();
        float bc[8], blast;
        gla_cumsum(p, layer, b, h, c, tid, lds, bc, blast);
        {
            const int d = tid & 63, seg = tid >> 6;
            float ke[8];
#pragma unroll
            for (int i = 0; i < 8; ++i) {
                const int pos = 64 * c - 48 + 8 * seg + i;
                float kv = 0.f;
                if (pos >= 0) {
                    const size_t row = (size_t)b * L + pos;
                    const float qv = bf2f(GQ[row * 256 + h * 64 + d]); kv = bf2f(GK[row * 256 + h * 64 + d]);
                    QE[row * 256 + h * 64 + d] = f2bf(qv * __expf(bc[i]));
                    KN[row * 256 + h * 64 + d] = f2bf(kv * __expf(-bc[i]));
                }
                ke[i] = kv * __expf(blast - bc[i]);
            }
            if (c < 32) {
                u32x4 o; o[0] = cvt_pk_bf16(ke[0], ke[1]); o[1] = cvt_pk_bf16(ke[2], ke[3]); o[2] = cvt_pk_bf16(ke[4], ke[5]); o[3] = cvt_pk_bf16(ke[6], ke[7]);
                *(LAS u32x4*)(lds + GL_QE + d * 128 + 16 * (seg ^ (d & 7))) = o;
                if (seg == 0) DL[((size_t)bh * 32 + c) * 64 + d] = __expf(blast);
            }
        }
        __syncthreads();
        if (c < 32) {
            bf16x8 vf[2];
            {
                const bf16_t* vp = GVT + ((size_t)bh * 128 + 16 * wid + fr) * LPV + 64 * c + 8 * fq;
                vf[0] = *(const bf16x8*)vp; vf[1] = *(const bf16x8*)(vp + 32);
                const bf16x8 z8 = {0, 0, 0, 0, 0, 0, 0, 0};
                if (c == 0) { vf[0] = z8; if (fq < 2) vf[1] = z8; }
            }
#pragma unroll
            for (int dt = 0; dt < 4; ++dt) {
                f32x4 acc = {0.f, 0.f, 0.f, 0.f};
#pragma unroll
                for (int ks = 0; ks < 2; ++ks) {
                    const int rowd = 16 * dt + fr;
                    const bf16x8 kf = *(const LAS bf16x8*)(lds + GL_QE + rowd * 128 + 16 * ((4 * ks + fq) ^ (rowd & 7)));
                    acc = __builtin_amdgcn_mfma_f32_16x16x32_bf16(vf[ks], kf, acc, 0, 0, 0);
                }
                float* up = UT + (((size_t)bh * 32 + c) * 128 + 16 * wid + 4 * fq) * 64 + 16 * dt + fr;
#pragma unroll
                for (int r = 0; r < 4; ++r) up[r * 64] = acc[r];
            }
        }
    }
}

__device__ __forceinline__ void phase_gla_scan(const Params& p_in, int layer_in, char* smem) {
    const Params p = kparams(); const int layer = opaque_int(layer_in); (void)p_in;
    const int tid = opaque_tid();
    const float* UT = (const float*)(p.ws + OFF_UT);
    const float* DL = (const float*)(p.ws + OFF_DL);
    bf16_t* ST = (bf16_t*)(p.ws + OFF_ST);
    const int nthr = gridDim.x * NT;
    for (int el = opaque_bid() * NT + tid; el < 32 * 8192; el += nthr) {
        const int bh = el >> 13, ed = el & 8191, d = el & 63;
        float sacc = 0.f;
        ST[((size_t)bh * 33) * 8192 + ed] = 0;
#pragma unroll 1
        for (int c0 = 0; c0 < 32; c0 += 16) {
            float u[16], dl[16];
#pragma unroll
            for (int i = 0; i < 16; ++i) { u[i] = UT[((size_t)(bh * 32 + c0 + i)) * 8192 + ed]; dl[i] = DL[(size_t)(bh * 32 + c0 + i) * 64 + d]; }
#pragma unroll
            for (int i = 0; i < 16; ++i) { sacc = fmaf(dl[i], sacc, u[i]); ST[((size_t)bh * 33 + c0 + i + 1) * 8192 + ed] = f2bf(sacc); }
        }
    }
}

__device__ __forceinline__ void phase_gla_c(const Params& p_in, int layer_in, char* smem, bool do_store) {
    const Params p = kparams(); const int layer = opaque_int(layer_in); (void)p_in;
    const int tid = opaque_tid(), wid = __builtin_amdgcn_readfirstlane(tid >> 6), lane = tid & 63, fr = lane & 15, fq = lane >> 4;
    const bf16_t* QE = (const bf16_t*)((const char*)p.out + OUTS_QE);
    const bf16_t* KN = (const bf16_t*)((const char*)p.out + OUTS_KN);
    const bf16_t* GVT = (const bf16_t*)(p.ws + OFF_GV);
    const bf16_t* ST = (const bf16_t*)(p.ws + OFF_ST);
    bf16_t* MIX = (bf16_t*)(p.ws + OFF_MIX);
    const float* ng = p.norm_g + layer * 128;
    const bf16x8 z8 = {0, 0, 0, 0, 0, 0, 0, 0};
    const int nwt = 32 * 33 * 4, wstride = gridDim.x * 8;
    for (int wt = opaque_bid() * 8 + wid; wt < nwt; wt += wstride) {
        const int task = wt >> 2, tw = wt & 3;
        const int bh = task / 33, c = task - bh * 33, b = bh >> 2, h = bh & 3;
        const int pos_t = 64 * c - 48 + 16 * tw + fr;
        if (c == 0 && tw < 3) continue;
        bf16x8 qf[2];
        {
            const bf16_t* qp = QE + ((size_t)b * L + pos_t) * 256 + h * 64 + 8 * fq;
            qf[0] = *(const bf16x8*)qp; qf[1] = *(const bf16x8*)(qp + 32);
        }
        unsigned pk[4][2];
#pragma unroll
        for (int st = 0; st < 4; ++st) {
            f32x4 a = {0.f, 0.f, 0.f, 0.f};
            if (st <= tw) {
                const int pos_s = 64 * c - 48 + 16 * st + fr;
                bf16x8 k0 = z8, k1 = z8;
                if (pos_s >= 0) { const bf16_t* kp = KN + ((size_t)b * L + pos_s) * 256 + h * 64 + 8 * fq; k0 = *(const bf16x8*)kp; k1 = *(const bf16x8*)(kp + 32); }
                a = __builtin_amdgcn_mfma_f32_16x16x32_bf16(k0, qf[0], a, 0, 0, 0);
                a = __builtin_amdgcn_mfma_f32_16x16x32_bf16(k1, qf[1], a, 0, 0, 0);
#pragma unroll
                for (int r = 0; r < 4; ++r) a[r] = (16 * st + 4 * fq + r > 16 * tw + fr) ? 0.f : a[r];
            }
            pk[st][0] = cvt_pk_bf16(a[0], a[1]); pk[st][1] = cvt_pk_bf16(a[2], a[3]);
        }
        bf16x8 pf[2];
#pragma unroll
        for (int ks = 0; ks < 2; ++ks) { u32x4 pw; pw[0] = pk[2 * ks][0]; pw[1] = pk[2 * ks][1]; pw[2] = pk[2 * ks + 1][0]; pw[3] = pk[2 * ks + 1][1]; pf[ks] = __builtin_bit_cast(bf16x8, pw); }
        f32x4 O[8];
        float ss = 0.f;
#pragma unroll
        for (int et = 0; et < 8; ++et) {
            const int e0 = 16 * et;
            f32x4 acc = {0.f, 0.f, 0.f, 0.f};
            const bf16_t* sp = ST + (((size_t)bh * 33 + c) * 128 + e0 + fr) * 64 + 8 * fq;
            const bf16_t* vp = GVT + ((size_t)bh * 128 + e0 + fr) * LPV + 64 * c + 4 * fq;
            acc = __builtin_amdgcn_mfma_f32_16x16x32_bf16(*(const bf16x8*)sp, qf[0], acc, 0, 0, 0);
            acc = __builtin_amdgcn_mfma_f32_16x16x32_bf16(*(const bf16x8*)(sp + 32), qf[1], acc, 0, 0, 0);
            {
                u32x2 va = *(const u32x2*)vp, vb = *(const u32x2*)(vp + 16);
                if (c == 0) { va = (u32x2){0u, 0u}; vb = (u32x2){0u, 0u}; }
                u32x4 vw; vw[0] = va[0]; vw[1] = va[1]; vw[2] = vb[0]; vw[3] = vb[1];
                acc = __builtin_amdgcn_mfma_f32_16x16x32_bf16(__builtin_bit_cast(bf16x8, vw), pf[0], acc, 0, 0, 0);
            }
            if (tw >= 2) {
                u32x2 va = *(const u32x2*)(vp + 32), vb = *(const u32x2*)(vp + 48);
                if (c == 0) va = (u32x2){0u, 0u};
                u32x4 vw; vw[0] = va[0]; vw[1] = va[1]; vw[2] = vb[0]; vw[3] = vb[1];
                acc = __builtin_amdgcn_mfma_f32_16x16x32_bf16(__builtin_bit_cast(bf16x8, vw), pf[1], acc, 0, 0, 0);
            }
            O[et] = acc;
            ss += acc[0] * acc[0] + acc[1] * acc[1] + acc[2] * acc[2] + acc[3] * acc[3];
        }
        ss += __shfl_xor(ss, 16); ss += __shfl_xor(ss, 32);
        const float rinv = rsqrtf(ss * (1.f / 128) + LN_EPS);
        if (pos_t >= 0 && do_store) {
            bf16_t* mp = MIX + ((size_t)b * L + pos_t) * 1024 + h * 128 + 4 * fq;
#pragma unroll
            for (int et = 0; et < 8; ++et) {
                const uint2 gz = *(const uint2*)(mp + 16 * et);
                const f32x4 nv = *(const f32x4*)(ng + 16 * et + 4 * fq);
                const float g0 = __uint_as_float(gz.x << 16), g1 = __uint_as_float(gz.x & 0xFFFF0000u), g2 = __uint_as_float(gz.y << 16), g3 = __uint_as_float(gz.y & 0xFFFF0000u);
                uint2 o; o.x = cvt_pk_bf16(O[et][0] * rinv * nv[0] * g0, O[et][1] * rinv * nv[1] * g1); o.y = cvt_pk_bf16(O[et][2] * rinv * nv[2] * g2, O[et][3] * rinv * nv[3] * g3);
                *(uint2*)(mp + 16 * et) = o;
            }
        }
    }
}

__device__ __forceinline__ void phase_ln(const Params& p_in, int layer_in, char* smem) {
    const Params p = kparams(); const int layer = opaque_int(layer_in); (void)p_in;
    const int tid = opaque_tid(), wid = tid >> 6, lane = tid & 63;
    const float* Z = (const float*)(p.ws + OFF_GQ);
    float* H32 = (float*)(p.ws + OFF_H32);
    bf16_t* HB = (bf16_t*)(p.ws + OFF_HB);
    const float* g = p.ln_g + layer * D; const float* bb = p.ln_b + layer * D;
    const int nw = gridDim.x * 8;
    int t = opaque_bid() * 8 + wid;
    f32x4 v[4], vn[4];
    if (t < T) {
#pragma unroll
        for (int i = 0; i < 4; ++i) v[i] = *(const f32x4*)(Z + (size_t)t * D + 4 * lane + 256 * i);
    }
    for (; t < T; t += nw) {
        const int tn = t + nw;
        if (tn < T) {
#pragma unroll
            for (int i = 0; i < 4; ++i) vn[i] = *(const f32x4*)(Z + (size_t)tn * D + 4 * lane + 256 * i);
        }
        ln_row_wave(v, g, bb, lane);
        if (layer == DEPTH - 1) {
            const int b = t / L, pos = t - b * L;
            if (pos >= NMETA) {
#pragma unroll
                for (int i = 0; i < 4; ++i) *(f32x4*)(p.out + ((size_t)b * SEQ + (pos - NMETA)) * D + 4 * lane + 256 * i) = v[i];
            }
        } else {
#pragma unroll
            for (int i = 0; i < 4; ++i) {
                *(f32x4*)(H32 + (size_t)t * D + 4 * lane + 256 * i) = v[i];
                u32x2 o; o[0] = cvt_pk_bf16(v[i][0], v[i][1]); o[1] = cvt_pk_bf16(v[i][2], v[i][3]);
                *(u32x2*)(HB + (size_t)t * D + 4 * lane + 256 * i) = o;
            }
        }
#pragma unroll
        for (int i = 0; i < 4; ++i) v[i] = vn[i];
    }
}

#define XB_TMO      128
#define XB_XCNT(j)  (256  + 64 * (j))
#define XB_XSUB(j)  (1280 + 64 * (j))
#define XB_XGEN(j)  (2304 + 64 * (j))
#define XB_TOP      3328
#define XB_TOPGEN   3392
#define XCD_BAR_WORDS 3456
#define XB_SPIN_CAP (1u << 22)
__device__ __forceinline__ unsigned xb_ld(unsigned* p)              { return __hip_atomic_load(p, __ATOMIC_RELAXED, __HIP_MEMORY_SCOPE_AGENT); }
__device__ __forceinline__ unsigned xb_add(unsigned* p, unsigned v) { return __hip_atomic_fetch_add(p, v, __ATOMIC_RELAXED, __HIP_MEMORY_SCOPE_AGENT); }
__device__ __forceinline__ unsigned xb_xcc_id() { return (unsigned)__builtin_amdgcn_s_getreg((3 << 11) | 20) & 0xFu; }
#define XB_SPIN(cond, bar) do { unsigned _sp = 0; while (cond) { __builtin_amdgcn_s_sleep(1); \
    if ((++_sp & 255u) == 0u) { if (xb_ld(&(bar)[XB_TMO])) break; if (_sp > XB_SPIN_CAP) { atomicAdd(&(bar)[XB_TMO], 1u); break; } } } } while (0)
struct XcdBarrier { unsigned* bar; unsigned x; volatile LAS unsigned* st; };
__device__ __forceinline__ XcdBarrier xcd_barrier_post(unsigned* bar, volatile LAS unsigned* st) {
    XcdBarrier b; b.bar = bar; b.x = xb_xcc_id(); b.st = st;
    if (threadIdx.x == 0) (void)xb_add(&bar[XB_XCNT(b.x)], 1u);
    return b;
}
__device__ __forceinline__ void xcd_barrier_complete(unsigned* bar, unsigned x, unsigned& nloc, unsigned& nx) {
    const unsigned G = gridDim.x * gridDim.y * gridDim.z;
    unsigned sum, cnt, mine, sp = 0u;
    for (;;) {
        sum = 0u; cnt = 0u; mine = 0u;
#pragma unroll
        for (unsigned j = 0; j < 16; ++j) { const unsigned c = xb_ld(&bar[XB_XCNT(j)]); sum += c; cnt += (c > 0u) ? 1u : 0u; mine = (j == x) ? c : mine; }
        if (sum == G) break;
        __builtin_amdgcn_s_sleep(1);
        if ((++sp & 255u) == 0u) { if (xb_ld(&bar[XB_TMO])) break; if (sp > XB_SPIN_CAP) { atomicAdd(&bar[XB_TMO], 1u); break; } }
    }
    nloc = mine > 0u ? mine : 1u; nx = cnt > 0u ? cnt : 1u;
}
__device__ __forceinline__ void xcd_barrier(unsigned* bar_, volatile LAS unsigned* st_) {
    XcdBarrier b; b.bar = bar_; b.x = xb_xcc_id(); b.st = st_;
    asm volatile("s_waitcnt vmcnt(0)" ::: "memory");
    __syncthreads();
    if (opaque_tid() == 0) {
        unsigned* bar = b.bar;
        __builtin_amdgcn_s_waitcnt(0);
        unsigned nloc = b.st[0], nx = b.st[1];
        if (nloc == 0u) { xcd_barrier_complete(bar, b.x, nloc, nx); b.st[0] = nloc; b.st[1] = nx; }
        const unsigned old = xb_add(&bar[XB_XSUB(b.x)], 1u);
        const unsigned gen = old / nloc;
        if (old + 1u == (gen + 1u) * nloc) {
            __builtin_amdgcn_fence(__ATOMIC_RELEASE, "agent");
            asm volatile("s_waitcnt vmcnt(0)" ::: "memory");
            const unsigned og = xb_add(&bar[XB_TOP], 1u);
            const unsigned tg = og / nx;
            if (og + 1u == (tg + 1u) * nx) xb_add(&bar[XB_TOPGEN], 1u);
            else XB_SPIN(xb_ld(&bar[XB_TOPGEN]) == tg, bar);
            __builtin_amdgcn_fence(__ATOMIC_ACQUIRE, "agent");
            xb_add(&bar[XB_XGEN(b.x)], 1u);
            asm volatile("s_waitcnt vmcnt(0)" ::: "memory");
        } else {
            XB_SPIN(xb_ld(&bar[XB_XGEN(b.x)]) == gen, bar);
            __builtin_amdgcn_fence(__ATOMIC_ACQUIRE, "agent");
            asm volatile("s_waitcnt vmcnt(0)" ::: "memory");
        }
    }
    __syncthreads();
}

constexpr int SMEM_BYTES = 160 * 1024;
static_assert(DS_END <= SMEM_BYTES - 16, "dsa lds");

__global__ void __launch_bounds__(NT, 2) k_mega(Params p) {
    __shared__ __attribute__((aligned(16))) char smem[SMEM_BYTES];
    volatile LAS unsigned* xbw = (volatile LAS unsigned*)((LAS unsigned char*)smem + (SMEM_BYTES - 16));
    if (threadIdx.x == 0) { xbw[0] = 0u; xbw[1] = 0u; xbw[2] = 0u; xbw[3] = 0u; }
    __syncthreads();
    if (p.ws == nullptr) cg::this_grid().sync();
    (void)xcd_barrier_post((unsigned*)(p.ws + OFF_BAR), xbw);
    for (int rep = 0; rep < PROBE_REP_PREP; ++rep) {
    phase_prep(p, smem);
    xcd_barrier((unsigned*)(p.ws + OFF_BAR), xbw);
    }
#pragma unroll 1
    for (int layer = 0; layer < DEPTH; ++layer) {
        for (int rep = 0; rep < PROBE_REP_PROJ; ++rep) {
        phase_proj(p, layer, smem);
        xcd_barrier((unsigned*)(p.ws + OFF_BAR), xbw);
        }
        phase_rope(p, layer, smem);
        for (int rep = 0; rep < PROBE_REP_GLAA; ++rep) {
        phase_gla_a(p, layer, smem);
        xcd_barrier((unsigned*)(p.ws + OFF_BAR), xbw);
        phase_gla_scan(p, layer, smem);
        xcd_barrier((unsigned*)(p.ws + OFF_BAR), xbw);
        }
        for (int rep = 0; rep < PROBE_REP_GLAC; ++rep) phase_gla_c(p, layer, smem, rep == PROBE_REP_GLAC - 1);
        for (int rep = 0; rep < PROBE_REP_DSA; ++rep) phase_dsa(p, layer, smem, rep == PROBE_REP_DSA - 1);
        xcd_barrier((unsigned*)(p.ws + OFF_BAR), xbw);
        for (int rep = 0; rep < PROBE_REP_OUT; ++rep) {
        phase_outproj(p, layer, smem);
        xcd_barrier((unsigned*)(p.ws + OFF_BAR), xbw);
        }
        for (int rep = 0; rep < PROBE_REP_LN; ++rep) {
        phase_ln(p, layer, smem);
        xcd_barrier((unsigned*)(p.ws + OFF_BAR), xbw);
        }
    }
}

extern "C" void kernel_launch(void* const* d_in, const int* in_sizes, int n_in, void* d_out, int out_size, void* d_ws, size_t ws_size,
                              hipStream_t stream) {
    Params p{};
    p.x = (const float*)d_in[0]; p.meta = (const float*)d_in[1]; p.ln_in_g = (const float*)d_in[2]; p.ln_in_b = (const float*)d_in[3];
    p.w_in = (const float*)d_in[4]; p.wg2 = (const float*)d_in[5]; p.bg = (const float*)d_in[6]; p.norm_g = (const float*)d_in[7];
    p.ikg = (const float*)d_in[8]; p.ikb = (const float*)d_in[9]; p.w_out = (const float*)d_in[10]; p.ln_g = (const float*)d_in[11];
    p.ln_b = (const float*)d_in[12];
    p.out = (float*)d_out; p.ws = (char*)d_ws;
    static int grid_blocks = 0;
    if (!grid_blocks) {
        int dev = 0, cus = 0, per_cu = 0;
        hipGetDevice(&dev);
        hipDeviceGetAttribute(&cus, hipDeviceAttributeMultiprocessorCount, dev);
        hipOccupancyMaxActiveBlocksPerMultiprocessor(&per_cu, k_mega, NT, 0);
        if (per_cu > 1) per_cu = 1;
        grid_blocks = cus * per_cu;
    }
    (void)hipMemsetAsync((char*)d_ws + OFF_BAR, 0, XCD_BAR_WORDS * 4, stream);
    void* args[] = {&p};
    (void)hipLaunchCooperativeKernel((void*)k_mega, dim3(grid_blocks), dim3(NT), args, 0, stream);
}
```

```cpp
#include <hip/hip_runtime.h>
#include <hip/hip_cooperative_groups.h>
#include <stdint.h>
namespace cg = cooperative_groups;
#ifndef PROBE_REP_PREP
#define PROBE_REP_PREP 1
#define PROBE_REP_PROJ 1
#define PROBE_REP_GLAA 1
#define PROBE_REP_GLAC 1
#define PROBE_REP_DSA 1
#define PROBE_REP_OUT 1
#define PROBE_REP_LN 1
#define PROBE_DSA_A 1
#define PROBE_DSA_B 1
#define PROBE_DSA_C 1
#endif

constexpr int D = 1024, NB = 8, SEQ = 2048, NMETA = 16, L = 2064, T = NB * L;
constexpr int DEPTH = 2;
constexpr int INW = 3416, INWP = 3584;
constexpr int TP = 16640;
constexpr int NT = 512;
constexpr int TOPK = 256;
constexpr float LN_EPS = 1e-5f;
constexpr float ALPHA = 1.41421356237309515f;

typedef unsigned short bf16_t;
typedef short bf16x8 __attribute__((ext_vector_type(8)));
typedef float f32x4 __attribute__((ext_vector_type(4)));
#define LAS __attribute__((address_space(3)))

constexpr size_t SZ_H32 = (size_t)T * D * 4;
constexpr size_t SZ_HB = (size_t)TP * D * 2;
constexpr size_t SZ_WIN = (size_t)DEPTH * INWP * D * 2;
constexpr size_t SZ_WOUT = (size_t)DEPTH * D * D * 2;
constexpr int LPV = 2112;
constexpr size_t SZ_GQ = (size_t)T * 256 * 2, SZ_GK = SZ_GQ, SZ_GV = (size_t)NB * 4 * 128 * LPV * 2;
constexpr size_t SZ_UT = (size_t)1024 * 128 * 64 * 4, SZ_ST = (size_t)32 * 33 * 128 * 64 * 2, SZ_DL = (size_t)1024 * 64 * 4;
constexpr size_t SZ_AQ = (size_t)T * 512 * 2, SZ_IQ = (size_t)T * 512 * 2;
constexpr size_t SZ_MIX = (size_t)TP * 1024 * 2;
constexpr int LP = 2112;
constexpr size_t SZ_AK = (size_t)T * 128 * 2, SZ_AV = (size_t)NB * 2 * 64 * LP * 2, SZ_IK = (size_t)T * 64 * 2, SZ_IW = (size_t)T * 8 * 4;
constexpr size_t SZ_GLR = (size_t)T * 16 * 4;
constexpr size_t SZ_ROPE = (size_t)L * 8 * 2 * 4;

constexpr size_t OFF_H32 = 0;
constexpr size_t OFF_HB = OFF_H32 + SZ_H32;
constexpr size_t OFF_WIN = OFF_HB + SZ_HB;
constexpr size_t OFF_WOUT = OFF_WIN + SZ_WIN;
constexpr size_t OFF_GQ = OFF_WOUT + SZ_WOUT;
constexpr size_t OFF_GK = OFF_GQ + SZ_GQ;
constexpr size_t OFF_GV = OFF_GK + SZ_GK;
constexpr size_t OFF_AQ = OFF_GV + SZ_GV;
constexpr size_t OFF_IQ = OFF_AQ + SZ_AQ;
constexpr size_t OFF_MIX = OFF_IQ + SZ_IQ;
constexpr size_t OFF_AK = OFF_MIX + SZ_MIX;
constexpr size_t OFF_AV = OFF_AK + SZ_AK;
constexpr size_t OFF_IK = OFF_AV + SZ_AV;
constexpr size_t OFF_IW = OFF_IK + SZ_IK;
constexpr size_t OFF_GLR = OFF_IW + SZ_IW;
constexpr size_t OFF_ROPE = OFF_GLR + SZ_GLR;
constexpr size_t OFF_ST = OFF_ROPE + SZ_ROPE;
constexpr size_t OFF_DL = OFF_ST + SZ_ST;
constexpr size_t OFF_BAR = OFF_DL + SZ_DL;
constexpr size_t OFF_IKR = OFF_BAR + 16384;
constexpr size_t OFF_END = OFF_IKR + (size_t)T * 64 * 4;
constexpr size_t OFF_UT = OFF_HB;
static_assert(SZ_UT <= SZ_HB, "UT alias");
static_assert(SZ_GQ + SZ_GK + SZ_GV + SZ_AQ + SZ_IQ >= SZ_H32, "Z alias size");
static_assert(OFF_END <= (size_t)256 * 1024 * 1024, "workspace too large");

struct Params {
    const float* x; const float* meta; const float* ln_in_g; const float* ln_in_b;
    const float* w_in; const float* wg2; const float* bg; const float* norm_g;
    const float* ikg; const float* ikb; const float* w_out; const float* ln_g; const float* ln_b;
    float* out; char* ws;
};
typedef const Params __attribute__((address_space(4))) * KParamsPtr;
__device__ __forceinline__ Params kparams() {
    unsigned long long a = (unsigned long long)__builtin_amdgcn_kernarg_segment_ptr();
    asm volatile("" : "+s"(a));
    KParamsPtr q = (KParamsPtr)a;
    Params r;
    r.x = q->x; r.meta = q->meta; r.ln_in_g = q->ln_in_g; r.ln_in_b = q->ln_in_b; r.w_in = q->w_in; r.wg2 = q->wg2; r.bg = q->bg; r.norm_g = q->norm_g;
    r.ikg = q->ikg; r.ikb = q->ikb; r.w_out = q->w_out; r.ln_g = q->ln_g; r.ln_b = q->ln_b; r.out = q->out; r.ws = q->ws;
    return r;
}

__device__ __forceinline__ bf16_t f2bf(float f) {
    unsigned u = __float_as_uint(f);
    u += 0x7FFFu + ((u >> 16) & 1u);
    return (bf16_t)(u >> 16);
}
__device__ __forceinline__ unsigned pack2bf(float lo, float hi) { return (unsigned)f2bf(lo) | ((unsigned)f2bf(hi) << 16); }
__device__ __forceinline__ unsigned cvt_pk_bf16(float lo, float hi) { unsigned r; asm volatile("v_cvt_pk_bf16_f32 %0, %1, %2" : "=v"(r) : "v"(lo), "v"(hi)); return r; }
typedef unsigned u32x4 __attribute__((ext_vector_type(4)));
typedef unsigned u32x2 __attribute__((ext_vector_type(2)));
__device__ __forceinline__ float bf2f(bf16_t h) { return __uint_as_float(((unsigned)h) << 16); }
__device__ __forceinline__ int opaque_tid() { int t = threadIdx.x; asm volatile("" : "+v"(t)); return t; }
__device__ __forceinline__ int opaque_int(int v) { asm volatile("" : "+s"(v)); return v; }
__device__ __forceinline__ int opaque_bid() { int t = blockIdx.x; asm volatile("" : "+s"(t)); return t; }
__device__ __forceinline__ float wave_sum(float v) {
#pragma unroll
    for (int o = 32; o > 0; o >>= 1) v += __shfl_xor(v, o);
    return v;
}
__device__ __forceinline__ float wave_max(float v) {
#pragma unroll
    for (int o = 32; o > 0; o >>= 1) v = fmaxf(v, __shfl_xor(v, o));
    return v;
}
__device__ __forceinline__ float block_sum(float v, float* red) {
    v = wave_sum(v);
    const int tq = opaque_tid();
    __syncthreads();
    if ((tq & 63) == 0) red[tq >> 6] = v;
    __syncthreads();
    return ((red[0] + red[1]) + (red[2] + red[3])) + ((red[4] + red[5]) + (red[6] + red[7]));
}
__device__ __forceinline__ float silu_f(float x) { return x / (1.f + __expf(-x)); }
__device__ __forceinline__ float logsigmoid_f(float x) { return fminf(x, 0.f) - log1pf(expf(-fabsf(x))); }
__device__ __forceinline__ float logsigmoid_fast(float x) { return fminf(x, 0.f) - __logf(1.f + __expf(-fabsf(x))); }

__device__ __forceinline__ int proj_src_col(int n) {
    if (n < 1024) return n;
    if (n < 1536) return n - 1024 + 1040;
    if (n < 2048) return n - 1536 + 1552;
    if (n < 2560) return n - 2048 + 2904;
    if (n < 3072) return n - 2560 + 2320;
    if (n < 3200) return n - 3072 + 2064;
    if (n < 3328) return n - 3200 + 2192;
    const int c = n - 3328;
    if (c < 32) return 2832 + c;
    if (c < 48) return 1024 + (c - 32);
    if (c < 56) return 2896 + (c - 48);
    if (c >= 128 && c < 160) return 2832 + 32 + (c - 128);
    return -1;
}

__device__ __forceinline__ void sincos_acc(float a, float& s, float& c) {
    double ad = (double)a;
    double kd = rint(ad * 0.63661977236758134308);
    double r = fma(-kd, 1.57079632679489655800, ad);
    r = fma(-kd, 6.12323399573676603587e-17, r);
    double r2 = r * r;
    double sp = r * (1.0 + r2 * (-1.0 / 6 + r2 * (1.0 / 120 + r2 * (-1.0 / 5040 + r2 * (1.0 / 362880 + r2 * (-1.0 / 39916800))))));
    double cp = 1.0 + r2 * (-0.5 + r2 * (1.0 / 24 + r2 * (-1.0 / 720 + r2 * (1.0 / 40320 + r2 * (-1.0 / 3628800 + r2 * (1.0 / 479001600))))));
    int q = ((int)kd) & 3;
    double ss = (q & 1) ? cp : sp, cc = (q & 1) ? sp : cp;
    if (q == 1 || q == 2) cc = -cc;
    if (q == 2 || q == 3) ss = -ss;
    s = (float)ss; c = (float)cc;
}

__device__ __forceinline__ void ln_row_wave(f32x4 (&v)[4], const float* g, const float* bb, int lane) {
    float sm = 0.f;
#pragma unroll
    for (int i = 0; i < 4; ++i) sm += (v[i][0] + v[i][1]) + (v[i][2] + v[i][3]);
    const float mu = wave_sum(sm) * (1.f / D);
    float qq = 0.f;
#pragma unroll
    for (int i = 0; i < 4; ++i) { v[i] = v[i] - mu; qq += (v[i][0] * v[i][0] + v[i][1] * v[i][1]) + (v[i][2] * v[i][2] + v[i][3] * v[i][3]); }
    const float rs = rsqrtf(wave_sum(qq) * (1.f / D) + LN_EPS);
#pragma unroll
    for (int i = 0; i < 4; ++i) { const f32x4 gg = *(const f32x4*)(g + 4 * lane + 256 * i), b4 = *(const f32x4*)(bb + 4 * lane + 256 * i); v[i] = v[i] * rs * gg + b4; }
}
__device__ __forceinline__ int proj_dst_col(int src) {
    if (src < 1024) return src;
    if (src < 1040) return 3328 + 32 + (src - 1024);
    if (src < 1552) return 1024 + (src - 1040);
    if (src < 2064) return 1536 + (src - 1552);
    if (src < 2192) return 3072 + (src - 2064);
    if (src < 2320) return 3200 + (src - 2192);
    if (src < 2832) return 2560 + (src - 2320);
    if (src < 2864) return 3328 + (src - 2832);
    if (src < 2896) return 3328 + 128 + (src - 2864);
    if (src < 2904) return 3328 + 48 + (src - 2896);
    return 2048 + (src - 2904);
}
__device__ __forceinline__ void phase_prep(const Params& p_in, char* smem) {
    const Params p = kparams(); (void)p_in;
    const int tid = opaque_tid(), wid = tid >> 6, lane = tid & 63;
    bf16_t* WIN = (bf16_t*)(p.ws + OFF_WIN);
    bf16_t* WOUT = (bf16_t*)(p.ws + OFF_WOUT);
    float* H32 = (float*)(p.ws + OFF_H32);
    bf16_t* HB = (bf16_t*)(p.ws + OFF_HB);
    bf16_t* MIX = (bf16_t*)(p.ws + OFF_MIX);
    float2* ROPE = (float2*)(p.ws + OFF_ROPE);
    float (*tile)[65] = (float (*)[65])smem;
    constexpr int NCT_IN = (INW + 63) / 64, NT_IN = DEPTH * 16 * NCT_IN, NT_OUT = DEPTH * 16 * 16;
    for (int item = opaque_bid(); item < NT_IN + NT_OUT; item += gridDim.x) {
        const bool is_in = item < NT_IN;
        const int it = is_in ? item : item - NT_IN;
        const int nct = is_in ? NCT_IN : 16, ldw = is_in ? INW : D;
        const int l = it / (16 * nct), rem = it - l * 16 * nct, kt = rem / nct, ct = rem - kt * nct;
        const float* W = (is_in ? p.w_in : p.w_out) + (size_t)l * D * ldw;
        __syncthreads();
#pragma unroll
        for (int i = 0; i < 8; ++i) {
            const int e = tid + NT * i, kk = e >> 6, nn = e & 63, col = ct * 64 + nn;
            tile[kk][nn] = (col < ldw) ? W[(size_t)(kt * 64 + kk) * ldw + col] : 0.f;
        }
        __syncthreads();
        {
            const int nn = tid >> 3, k8 = (tid & 7) * 8, src = ct * 64 + nn;
            if (src < ldw) {
                const int dst = is_in ? proj_dst_col(src) : src;
                u32x4 o;
#pragma unroll
                for (int q = 0; q < 4; ++q) o[q] = cvt_pk_bf16(tile[k8 + 2 * q][nn], tile[k8 + 2 * q + 1][nn]);
                bf16_t* dstp = (is_in ? WIN + ((size_t)l * INWP + dst) * D : WOUT + ((size_t)l * D + dst) * D) + kt * 64 + k8;
                *(u32x4*)dstp = o;
            }
        }
    }
    {
        const int nw = gridDim.x * 8;
        for (int t = opaque_bid() * 8 + wid; t < TP; t += nw) {
            if (t < T) {
                const int b = t / L, pos = t - b * L;
                const float* src = (pos < NMETA) ? (p.meta + (size_t)pos * D) : (p.x + ((size_t)b * SEQ + (pos - NMETA)) * D);
                f32x4 v[4];
#pragma unroll
                for (int i = 0; i < 4; ++i) v[i] = *(const f32x4*)(src + 4 * lane + 256 * i);
                ln_row_wave(v, p.ln_in_g, p.ln_in_b, lane);
#pragma unroll
                for (int i = 0; i < 4; ++i) {
                    *(f32x4*)(H32 + (size_t)t * D + 4 * lane + 256 * i) = v[i];
                    u32x2 o; o[0] = cvt_pk_bf16(v[i][0], v[i][1]); o[1] = cvt_pk_bf16(v[i][2], v[i][3]);
                    *(u32x2*)(HB + (size_t)t * D + 4 * lane + 256 * i) = o;
                }
            } else {
#pragma unroll
                for (int i = 0; i < 4; ++i) {
                    *(u32x2*)(HB + (size_t)t * D + 4 * lane + 256 * i) = (u32x2){0u, 0u};
                    *(u32x2*)(MIX + (size_t)t * D + 4 * lane + 256 * i) = (u32x2){0u, 0u};
                }
            }
        }
    }
    for (int e = opaque_bid() * NT + tid; e < L * 8; e += gridDim.x * NT) {
        const int pos = e >> 3, i = e & 7;
        const float inv[8] = {1.0f, 0.19392274f, 0.03760603f, 0.0072926646f, 0.0014142136f, 0.0002742482f, 5.3182957e-05f, 1.0313385e-05f};
        float iv = inv[0];
#pragma unroll
        for (int j = 1; j < 8; ++j) iv = (i == j) ? inv[j] : iv;
        const float ang = (float)pos * iv;
        float sn, cs; sincos_acc(ang, sn, cs);
        ROPE[e] = make_float2(cs, sn);
    }
}

namespace pg8 {
constexpr int BM = 256, BK = 64, HALF = 128, HTB = HALF * BK * 2  , STAGE_BYTES = 8 * HTB, NXCD = 8, WGM = 8;
__device__ __forceinline__ int lds_byte(int r, int c) { const int st = (r >> 4) * 2 + (c >> 5), rr = r & 15, cc = c & 31, ob = rr * 64 + cc * 2; return st * 1024 + (ob ^ (((ob >> 9) & 1) << 5)); }
__device__ __forceinline__ void stage_rc(int b, int& R, int& C) { const int st = b / 1024, sb = b % 1024, swz = sb ^ (((sb >> 9) & 1) << 5); R = (st >> 1) * 16 + swz / 64; C = (st & 1) * 32 + (swz % 64) / 2; }
__device__ __forceinline__ int perm32(int rho) { const int n = rho >> 4, i = rho & 15; return 8 * (i >> 2) + 4 * n + (i & 3); }

struct Unit { int pm, pn; };
struct Gemm { const bf16_t* A; const bf16_t* Bt; int M, N, K; };

struct StaticOrder {
    int nM, nN, nwg, G, c;
    __device__ void init(int M, int N, int G_, int c_) { nM = M / BM; nN = N / BM; nwg = nM * nN; G = G_; c = c_; }
    __device__ bool next(int i, Unit& u) const {
        const long Lx = (long)i * G + c; if (Lx >= nwg) return false;
        int wgid = (int)Lx; { const int q = nwg / NXCD, r = nwg % NXCD, xcd = wgid % NXCD, off = wgid / NXCD; wgid = (xcd < r ? xcd * (q + 1) : r * (q + 1) + (xcd - r) * q) + off; }
        const int nig = WGM * nN, gid = wgid / nig, fm = gid * WGM, gsz = (nM - fm) < WGM ? (nM - fm) : WGM;
        u.pm = fm + ((wgid % nig) % gsz); u.pn = (wgid % nig) / gsz; return true;
    }
    __device__ __forceinline__ void a_ready(const Unit&) const {}
    __device__ __forceinline__ void done(const Unit&) const {}
};

template <class Epi, class Sched>
__device__ __forceinline__ void gemm_phase(LAS unsigned char* lds, const Gemm g, const Sched& S, const Epi& E) {
    const int tid = opaque_tid(), wid = __builtin_amdgcn_readfirstlane(tid >> 6), lane = tid & 63, wr = wid >> 2, wc = wid & 3, fr = lane & 15, fq = lane >> 4;
    const int K = g.K, nt = K / BK;
    unsigned voffA[2], voffB[2];
#pragma unroll
    for (int i = 0; i < 2; ++i) { int R, C; stage_rc(tid * 16 + i * 8192, R, C); const int Rb = Epi::PERM ? ((R & ~31) + perm32(R & 31)) : R;
        voffA[i] = (unsigned)(R * K + C) * 2u; voffB[i] = (unsigned)(Rb * K + C) * 2u; }
    const size_t kstep = (size_t)(BK * 2);
    const size_t hstep = (size_t)HALF * K * 2;
    const size_t tstep = 2 * hstep;
    const unsigned ldsw = (unsigned)wid * 1024u;
    const int aoff = lds_byte(wr * 64 + fr, fq * 8), boff = lds_byte(wc * 32 + fr, fq * 8);
#define PG8_SA(b, h) (((b) * 2 + (h)) * HTB)
#define PG8_SB(b, h) ((4 + (b) * 2 + (h)) * HTB)
#define PG8_STAGE(bufoff, gbase, voff) do { _Pragma("unroll") for (int _i = 0; _i < 2; ++_i) \
        __builtin_amdgcn_global_load_lds((const unsigned*)((const char*)(gbase) + (voff)[_i]), (LAS unsigned*)(lds + (bufoff) + ldsw + _i * 8192), 16, 0, 0); } while (0)
#define PG8_LDA(dst, b, h) do { _Pragma("unroll") for (int m = 0; m < 4; ++m) _Pragma("unroll") for (int k = 0; k < 2; ++k) dst[m][k] = *(const LAS bf16x8*)(lds + PG8_SA(b, h) + aoff + m * 2048 + k * 1024); } while (0)
#define PG8_LDB(dst, b, h) do { _Pragma("unroll") for (int n = 0; n < 2; ++n) _Pragma("unroll") for (int k = 0; k < 2; ++k) dst[n][k] = *(const LAS bf16x8*)(lds + PG8_SB(b, h) + boff + n * 2048 + k * 1024); } while (0)
#define PG8_MMA(ai, bj, At, Bt) do { __builtin_amdgcn_s_setprio(1); _Pragma("unroll") for (int m = 0; m < 4; ++m) _Pragma("unroll") for (int n = 0; n < 2; ++n) _Pragma("unroll") for (int k = 0; k < 2; ++k) \
        acc[ai][bj][m][n] = __builtin_amdgcn_mfma_f32_16x16x32_bf16(Bt[n][k], At[m][k], acc[ai][bj][m][n], 0, 0, 0); __builtin_amdgcn_s_setprio(0); } while (0)
#define PG8_WAIT_V(n) asm volatile("s_waitcnt vmcnt(" #n ")" ::: "memory")
#define PG8_WAIT_L(n) asm volatile("s_waitcnt lgkmcnt(" #n ")" ::: "memory")
#define PG8_BAR __builtin_amdgcn_s_barrier()
#define PG8_SCHED __builtin_amdgcn_sched_barrier(0)
    Unit cur, nxt; int ui = 0;
    if (!S.next(0, cur)) return;
    f32x4 acc[2][2][4][2];
#pragma unroll
    for (int a = 0; a < 2; ++a)
#pragma unroll
        for (int b = 0; b < 2; ++b)
#pragma unroll
            for (int m = 0; m < 4; ++m)
#pragma unroll
                for (int n = 0; n < 2; ++n) acc[a][b][m][n] = (f32x4){0.f, 0.f, 0.f, 0.f};
    bf16x8 At[4][2], B0[2][2], B1[2][2];
    const char* cA = (const char*)g.A + (size_t)cur.pm * tstep; const char* cB = (const char*)g.Bt + (size_t)cur.pn * tstep;
    S.a_ready(cur);
    PG8_STAGE(PG8_SB(0, 0), cB, voffB); PG8_STAGE(PG8_SA(0, 0), cA, voffA); PG8_STAGE(PG8_SB(0, 1), cB + hstep, voffB); PG8_STAGE(PG8_SA(0, 1), cA + hstep, voffA);
    if (wr == 1) PG8_BAR;
    PG8_WAIT_V(4); PG8_BAR;
    PG8_STAGE(PG8_SB(1, 0), cB + kstep, voffB); PG8_STAGE(PG8_SA(1, 0), cA + kstep, voffA); PG8_STAGE(PG8_SB(1, 1), cB + hstep + kstep, voffB);
    PG8_WAIT_V(6); PG8_BAR;
    for (;;) {
        const bool has_next = S.next(ui + 1, nxt);
        const char* nA = has_next ? (const char*)g.A + (size_t)nxt.pm * tstep : cA; const char* nB = has_next ? (const char*)g.Bt + (size_t)nxt.pn * tstep : cB;
        for (int t = 0; t < nt; t += 2) {
            const bool last = (t == nt - 2);
            const char* a1 = cA + (size_t)(t + 1) * kstep;
            const char* a2 = last ? nA : cA + (size_t)(t + 2) * kstep; const char* b2 = last ? nB : cB + (size_t)(t + 2) * kstep;
            const char* a3 = a2 + kstep; const char* b3 = b2 + kstep;
            if (last && has_next) S.a_ready(nxt);
            PG8_LDB(B0, 0, 0); PG8_SCHED; PG8_LDA(At, 0, 0); PG8_STAGE(PG8_SA(1, 1), a1 + hstep, voffA);
            PG8_WAIT_L(8); PG8_BAR; PG8_WAIT_L(0); PG8_MMA(0, 0, At, B0); PG8_BAR; PG8_SCHED;
            PG8_LDB(B1, 0, 1); PG8_STAGE(PG8_SB(0, 0), b2, voffB);
            PG8_BAR; PG8_WAIT_L(0); PG8_MMA(0, 1, At, B1); PG8_BAR;
            PG8_LDA(At, 0, 1); PG8_STAGE(PG8_SA(0, 0), a2, voffA);
            PG8_BAR; PG8_WAIT_L(0); PG8_MMA(1, 0, At, B0); PG8_BAR; PG8_SCHED;
            PG8_STAGE(PG8_SB(0, 1), b2 + hstep, voffB);
            PG8_WAIT_V(6); PG8_BAR; PG8_MMA(1, 1, At, B1); PG8_BAR;
            PG8_LDB(B0, 1, 0); PG8_SCHED; PG8_LDA(At, 1, 0); PG8_STAGE(PG8_SA(0, 1), a2 + hstep, voffA);
            PG8_WAIT_L(8); PG8_BAR; PG8_WAIT_L(0); PG8_MMA(0, 0, At, B0); PG8_BAR; PG8_SCHED;
            PG8_LDB(B1, 1, 1); PG8_STAGE(PG8_SB(1, 0), b3, voffB);
            PG8_BAR; PG8_WAIT_L(0); PG8_MMA(0, 1, At, B1); PG8_BAR;
            PG8_LDA(At, 1, 1); PG8_STAGE(PG8_SA(1, 0), a3, voffA);
            PG8_BAR; PG8_WAIT_L(0); PG8_MMA(1, 0, At, B0); PG8_BAR; PG8_SCHED;
            PG8_STAGE(PG8_SB(1, 1), b3 + hstep, voffB);
            PG8_WAIT_V(6); PG8_BAR; PG8_MMA(1, 1, At, B1); PG8_BAR;
        }
        E(acc, cur, wr, wc, fr, fq); S.done(cur);
        if (!has_next) break;
#pragma unroll
        for (int a = 0; a < 2; ++a)
#pragma unroll
            for (int b = 0; b < 2; ++b)
#pragma unroll
                for (int m = 0; m < 4; ++m)
#pragma unroll
                    for (int n = 0; n < 2; ++n) acc[a][b][m][n] = (f32x4){0.f, 0.f, 0.f, 0.f};
        cur = nxt; cA = nA; cB = nB; ++ui;
    }
    PG8_WAIT_V(0);
    if (wr == 0) PG8_BAR;
    PG8_BAR;
#undef PG8_SA
#undef PG8_SB
#undef PG8_STAGE
#undef PG8_LDA
#undef PG8_LDB
#undef PG8_MMA
#undef PG8_WAIT_V
#undef PG8_WAIT_L
#undef PG8_BAR
#undef PG8_SCHED
}
}

struct EpiProj {
    static constexpr bool PERM = true;
    char* ws;
    __device__ __forceinline__ void store8(bf16_t* dst, const f32x4& a, const f32x4& b, float sc) const {
        u32x4 o; o[0] = cvt_pk_bf16(a[0] * sc, a[1] * sc); o[1] = cvt_pk_bf16(a[2] * sc, a[3] * sc); o[2] = cvt_pk_bf16(b[0] * sc, b[1] * sc); o[3] = cvt_pk_bf16(b[2] * sc, b[3] * sc);
        *(u32x4*)dst = o;
    }
    __device__ __forceinline__ void operator()(const f32x4 (&acc)[2][2][4][2], const pg8::Unit& u, int wr, int wc, int fr, int fq) const {
        asm volatile("" : "+v"(fr), "+v"(fq));
        if (u.pn < 13) {
#pragma unroll
            for (int bj = 0; bj < 2; ++bj) {
                const int hb = 4 * u.pn + 2 * bj + (wc >> 1);
                const int cc8 = 32 * (wc & 1) + 8 * fq;
#pragma unroll
                for (int ai = 0; ai < 2; ++ai)
#pragma unroll
                    for (int m = 0; m < 4; ++m) {
                        const int t = 256 * u.pm + 128 * ai + 64 * wr + 16 * m + fr;
                        const f32x4 v0 = acc[ai][bj][m][0], v1 = acc[ai][bj][m][1];
                        if (t < T) {
                            const size_t tt = (size_t)t;
                            if (hb < 4) store8((bf16_t*)(ws + OFF_GQ) + tt * 256 + hb * 64 + cc8, v0, v1, 0.125f);
                            else if (hb < 8) store8((bf16_t*)(ws + OFF_GK) + tt * 256 + (hb - 4) * 64 + cc8, v0, v1, 1.f);
                            else if (hb < 16) {
                                const int bq = t / L, pos = t - bq * L;
                                bf16_t* dst = (bf16_t*)(ws + OFF_GV) + ((size_t)(bq * 4 + ((hb - 8) >> 1)) * 128 + ((hb - 8) & 1) * 64 + cc8) * LPV + 48 + pos;
#pragma unroll
                                for (int j = 0; j < 4; ++j) { dst[(size_t)j * LPV] = f2bf(v0[j]); dst[(size_t)(4 + j) * LPV] = f2bf(v1[j]); }
                            }
                            else if (hb < 24 || (hb >= 32 && hb < 40)) {
                                f32x4 s0, s1;
#pragma unroll
                                for (int j = 0; j < 4; ++j) { s0[j] = silu_f(v0[j]); s1[j] = silu_f(v1[j]); }
                                const int col = (hb < 24) ? (hb - 16) * 64 : 512 + (hb - 32) * 64;
                                store8((bf16_t*)(ws + OFF_MIX) + tt * 1024 + col + cc8, s0, s1, 1.f);
                            }
                            else if (hb < 32) store8((bf16_t*)(ws + OFF_AQ) + tt * 512 + (hb - 24) * 64 + cc8, v0, v1, 0.125f);
                            else if (hb < 48) store8((bf16_t*)(ws + OFF_IQ) + tt * 512 + (hb - 40) * 64 + cc8, v0, v1, 0.125f);
                            else if (hb < 50) store8((bf16_t*)(ws + OFF_AK) + tt * 128 + (hb - 48) * 64 + cc8, v0, v1, 1.f);
                            else {
                                const int bq = t / L, pos = t - bq * L;
                                bf16_t* dst = (bf16_t*)(ws + OFF_AV) + ((size_t)(bq * 2 + (hb - 50)) * 64 + cc8) * LP + pos;
#pragma unroll
                                for (int j = 0; j < 4; ++j) { dst[(size_t)j * LP] = f2bf(v0[j]); dst[(size_t)(4 + j) * LP] = f2bf(v1[j]); }
                            }
                        }
                        asm volatile("" ::: "memory");
                    }
            }
        } else {
#pragma unroll
            for (int ai = 0; ai < 2; ++ai)
#pragma unroll
                for (int m = 0; m < 4; ++m) {
                    const int t = 256 * u.pm + 128 * ai + 64 * wr + 16 * m + fr;
                    if (t < T) {
                        if (wc == 0) {
                            float* dst = (float*)(ws + OFF_IKR) + (size_t)t * 64 + 8 * fq;
                            *(f32x4*)dst = acc[ai][0][m][0]; *(f32x4*)(dst + 4) = acc[ai][0][m][1];
                            *(f32x4*)(dst + 32) = acc[ai][1][m][0]; *(f32x4*)(dst + 36) = acc[ai][1][m][1];
                        } else if (wc == 1) {
                            const f32x4 v0 = acc[ai][0][m][0], v1 = acc[ai][0][m][1];
                            if (fq < 2) {
                                float* dst = (float*)(ws + OFF_GLR) + (size_t)t * 16 + 8 * fq;
                                *(f32x4*)dst = v0; *(f32x4*)(dst + 4) = v1;
                            } else if (fq == 2) {
                                float* dst = (float*)(ws + OFF_IW) + (size_t)t * 8;
                                *(f32x4*)dst = v0 * 0.353553390593273762f; *(f32x4*)(dst + 4) = v1 * 0.353553390593273762f;
                            }
                        }
                    }
                    asm volatile("" ::: "memory");
                }
        }
    }
};

struct EpiOut {
    static constexpr bool PERM = false;
    const float* H32; float* Z;
    __device__ __forceinline__ void operator()(const f32x4 (&acc)[2][2][4][2], const pg8::Unit& u, int wr, int wc, int fr, int fq) const {
        asm volatile("" : "+v"(fr), "+v"(fq));
        const int col0 = u.pn * 256 + wc * 32 + 4 * fq;
#pragma unroll
        for (int ai = 0; ai < 2; ++ai) {
            f32x4 hv[4][2][2];
#pragma unroll
            for (int m = 0; m < 4; ++m) {
                int t = 256 * u.pm + 128 * ai + 64 * wr + 16 * m + fr; t = t < T ? t : T - 1;
                const size_t off = (size_t)t * D + col0;
#pragma unroll
                for (int bj = 0; bj < 2; ++bj)
#pragma unroll
                    for (int n = 0; n < 2; ++n) hv[m][bj][n] = *(const f32x4*)(H32 + off + bj * 128 + n * 16);
            }
#pragma unroll
            for (int m = 0; m < 4; ++m) {
                const int t = 256 * u.pm + 128 * ai + 64 * wr + 16 * m + fr;
                if (t < T) {
                    const size_t off = (size_t)t * D + col0;
#pragma unroll
                    for (int bj = 0; bj < 2; ++bj)
#pragma unroll
                        for (int n = 0; n < 2; ++n) *(f32x4*)(Z + off + bj * 128 + n * 16) = acc[ai][bj][m][n] + hv[m][bj][n] * ALPHA;
                }
            }
            asm volatile("" ::: "memory");
        }
    }
};

__device__ __forceinline__ void phase_proj(const Params& p_in, int layer_in, char* smem) {
    const Params p = kparams(); const int layer = opaque_int(layer_in); (void)p_in;
    pg8::Gemm g; g.A = (const bf16_t*)(p.ws + OFF_HB); g.Bt = (const bf16_t*)(p.ws + OFF_WIN) + (size_t)layer * INWP * D; g.M = TP; g.N = INWP; g.K = D;
    pg8::StaticOrder S; S.init(TP, INWP, gridDim.x, opaque_bid());
    EpiProj E; E.ws = p.ws;
    pg8::gemm_phase((LAS unsigned char*)smem, g, S, E);
}
__device__ __forceinline__ void phase_outproj(const Params& p_in, int layer_in, char* smem) {
    const Params p = kparams(); const int layer = opaque_int(layer_in); (void)p_in;
    const bf16_t* MIXp = (const bf16_t*)(p.ws + OFF_MIX);
    const bf16_t* WOUT = (const bf16_t*)(p.ws + OFF_WOUT) + (size_t)layer * D * D;
    const float* H32 = (const float*)(p.ws + OFF_H32);
    float* Z = (float*)(p.ws + OFF_GQ);
    {
        pg8::Gemm g; g.A = MIXp; g.Bt = WOUT; g.M = 16384; g.N = D; g.K = D;
        pg8::StaticOrder S; S.init(16384, D, gridDim.x, opaque_bid());
        EpiOut E; E.H32 = H32; E.Z = Z;
        pg8::gemm_phase((LAS unsigned char*)smem, g, S, E);
    }
    const int tid = opaque_tid(), wid = __builtin_amdgcn_readfirstlane(tid >> 6), lane = tid & 63, fr = lane & 15, fq = lane >> 4;
    for (int task = opaque_bid(); task < 64; task += gridDim.x) {
        const int rg = task >> 3, cs = task & 7;
        const bf16_t* ap = MIXp + (size_t)(16384 + 16 * rg + fr) * D + 8 * fq;
        const bf16_t* bp = WOUT + (size_t)(128 * cs + 16 * wid + fr) * D + 8 * fq;
        f32x4 acc = {0.f, 0.f, 0.f, 0.f};
        bf16x8 a0[8], b0[8], a1[8], b1[8];
#pragma unroll
        for (int k = 0; k < 8; ++k) { a0[k] = *(const bf16x8*)(ap + 32 * k); b0[k] = *(const bf16x8*)(bp + 32 * k); }
#pragma unroll
        for (int ch = 0; ch < 4; ++ch) {
            if (ch < 3) {
#pragma unroll
                for (int k = 0; k < 8; ++k) { a1[k] = *(const bf16x8*)(ap + 256 * (ch + 1) + 32 * k); b1[k] = *(const bf16x8*)(bp + 256 * (ch + 1) + 32 * k); }
            }
#pragma unroll
            for (int k = 0; k < 8; ++k) acc = __builtin_amdgcn_mfma_f32_16x16x32_bf16(a0[k], b0[k], acc, 0, 0, 0);
#pragma unroll
            for (int k = 0; k < 8; ++k) { a0[k] = a1[k]; b0[k] = b1[k]; }
        }
#pragma unroll
        for (int r = 0; r < 4; ++r) {
            const size_t off = (size_t)(16384 + 16 * rg + 4 * fq + r) * D + 128 * cs + 16 * wid + fr;
            Z[off] = acc[r] + ALPHA * H32[off];
        }
    }
}

__device__ __forceinline__ void phase_gla_naive(const Params& p, int layer, char* smem) {
    float (*qs)[64] = (float (*)[64])smem;
    float (*ks)[64] = qs + 8;
    float (*es)[64] = ks + 8;
    float (*part)[8] = (float (*)[8])(es + 8);
    float (*os)[128] = (float (*)[128])(part + 2);
    const int tid = opaque_tid();
    const bf16_t* GQ = (const bf16_t*)(p.ws + OFF_GQ);
    const bf16_t* GK = (const bf16_t*)(p.ws + OFF_GK);
    const bf16_t* GV = (const bf16_t*)(p.ws + OFF_GV);
    const float* GLR = (const float*)(p.ws + OFF_GLR);
    bf16_t* MIX = (bf16_t*)(p.ws + OFF_MIX);
    const float* ng = p.norm_g + layer * 128;
    const float* wg2 = p.wg2 + (size_t)layer * 16 * 256; const float* bg = p.bg + layer * 256;
    for (int item = opaque_bid(); item < NB * 4; item += gridDim.x) {
        const int b = item >> 2, h = item & 3;
        float S[64];
#pragma unroll
        for (int d = 0; d < 64; ++d) S[d] = 0.f;
        const int e = tid & 127;
        const float nge = ng[e];
        const int ltt = tid >> 6, ld = tid & 63;
        float w[16];
#pragma unroll
        for (int rr = 0; rr < 16; ++rr) w[rr] = wg2[rr * 256 + h * 64 + ld];
        const float bgd = bg[h * 64 + ld];
        for (int t0 = 0; t0 < L; t0 += 8) {
            __syncthreads();
            {
                const size_t row = (size_t)b * L + t0 + ltt;
                qs[ltt][ld] = bf2f(GQ[row * 256 + h * 64 + ld]);
                ks[ltt][ld] = bf2f(GK[row * 256 + h * 64 + ld]);
                const float4* gp = (const float4*)&GLR[row * 16];
                const float4 g0 = gp[0], g1 = gp[1], g2 = gp[2], g3 = gp[3];
                float s = bgd;
                s = fmaf(g0.x, w[0], s); s = fmaf(g0.y, w[1], s); s = fmaf(g0.z, w[2], s); s = fmaf(g0.w, w[3], s);
                s = fmaf(g1.x, w[4], s); s = fmaf(g1.y, w[5], s); s = fmaf(g1.z, w[6], s); s = fmaf(g1.w, w[7], s);
                s = fmaf(g2.x, w[8], s); s = fmaf(g2.y, w[9], s); s = fmaf(g2.z, w[10], s); s = fmaf(g2.w, w[11], s);
                s = fmaf(g3.x, w[12], s); s = fmaf(g3.y, w[13], s); s = fmaf(g3.z, w[14], s); s = fmaf(g3.w, w[15], s);
                es[ltt][ld] = expf(logsigmoid_f(s) * (1.f / 16.f));
            }
            __syncthreads();
            if (tid < 128) {
#pragma unroll 1
                for (int tt = 0; tt < 8; ++tt) {
                    const size_t row = (size_t)b * L + t0 + tt;
                    const float v = bf2f(GV[row * 512 + h * 128 + e]);
                    float acc = 0.f;
#pragma unroll
                    for (int d = 0; d < 64; ++d) {
                        S[d] = fmaf(es[tt][d], S[d], ks[tt][d] * v);
                        acc = fmaf(qs[tt][d], S[d], acc);
                    }
                    os[tt][e] = acc;
                    const float ss = wave_sum(acc * acc);
                    if ((tid & 63) == 0) part[tid >> 6][tt] = ss;
                }
            }
            __syncthreads();
            if (tid < 128) {
#pragma unroll 1
                for (int tt = 0; tt < 8; ++tt) {
                    const size_t row = (size_t)b * L + t0 + tt;
                    const float tot = part[0][tt] + part[1][tt];
                    const float rinv = rsqrtf(tot * (1.f / 128) + LN_EPS);
                    const size_t idx = row * 1024 + h * 128 + e;
                    MIX[idx] = f2bf(os[tt][e] * rinv * nge * bf2f(MIX[idx]));
                }
            }
        }
    }
}

__device__ __forceinline__ unsigned okey(float x) {
    const unsigned u = __float_as_uint(x);
    return (u & 0x80000000u) ? ~u : (u | 0x80000000u);
}
__device__ __forceinline__ int wave_incl_scan(int v) {
    const int lane = opaque_tid() & 63;
#pragma unroll
    for (int o = 1; o < 64; o <<= 1) { const int n = __shfl_up(v, o); if (lane >= o) v += n; }
    return v;
}
__device__ __forceinline__ int block_excl_scan(int v, int* tmp) {
    const int incl = wave_incl_scan(v);
    const int tq = opaque_tid();
    __syncthreads();
    if ((tq & 63) == 63) tmp[tq >> 6] = incl;
    __syncthreads();
    const int w = tq >> 6;
    int base = 0;
    for (int i = 0; i < w; ++i) base += tmp[i];
    return base + incl - v;
}
__device__ __forceinline__ void unpack8(const uint4 u, float* kf) {
    kf[0] = __uint_as_float(u.x << 16); kf[1] = __uint_as_float(u.x & 0xFFFF0000u);
    kf[2] = __uint_as_float(u.y << 16); kf[3] = __uint_as_float(u.y & 0xFFFF0000u);
    kf[4] = __uint_as_float(u.z << 16); kf[5] = __uint_as_float(u.z & 0xFFFF0000u);
    kf[6] = __uint_as_float(u.w << 16); kf[7] = __uint_as_float(u.w & 0xFFFF0000u);
}

__device__ __forceinline__ void phase_dsa_naive(const Params& p, int layer, char* smem) {
    float* sc = (float*)smem;
    float (*iqs)[64] = (float (*)[64])(sc + 2080);
    float (*aqs)[64] = iqs + 8;
    float (*lg)[256] = (float (*)[256])(aqs + 8);
    unsigned* hist = (unsigned*)(lg + 8);
    int* sel = (int*)(hist + 256);
    int* misc = sel + 256;
    const int tid = opaque_tid();
    const bf16_t* IQ = (const bf16_t*)(p.ws + OFF_IQ);
    const bf16_t* IK = (const bf16_t*)(p.ws + OFF_IK);
    const float* IW = (const float*)(p.ws + OFF_IW);
    const bf16_t* AQ = (const bf16_t*)(p.ws + OFF_AQ);
    const bf16_t* AK = (const bf16_t*)(p.ws + OFF_AK);
    const bf16_t* AV = (const bf16_t*)(p.ws + OFF_AV);
    bf16_t* MIX = (bf16_t*)(p.ws + OFF_MIX);
    for (int item = opaque_bid(); item < T; item += gridDim.x) {
        const int b = item / L, t = item % L;
        const size_t row = (size_t)item;
        __syncthreads();
        iqs[tid >> 6][tid & 63] = bf2f(IQ[row * 512 + tid]); aqs[tid >> 6][tid & 63] = bf2f(AQ[row * 512 + tid]);
        __syncthreads();
        float w[8];
#pragma unroll
        for (int j = 0; j < 8; ++j) w[j] = IW[row * 8 + j];
        for (int s = tid; s <= t; s += NT) {
            const uint4* kp = (const uint4*)&IK[((size_t)b * L + s) * 64];
            float dd[8];
#pragma unroll
            for (int j = 0; j < 8; ++j) dd[j] = 0.f;
#pragma unroll 1
            for (int q = 0; q < 8; ++q) {
                float kf[8]; unpack8(kp[q], kf);
#pragma unroll
                for (int j = 0; j < 8; ++j) {
                    const float4 a0 = *(const float4*)&iqs[j][q * 8], a1 = *(const float4*)&iqs[j][q * 8 + 4];
                    dd[j] = fmaf(a0.x, kf[0], dd[j]); dd[j] = fmaf(a0.y, kf[1], dd[j]); dd[j] = fmaf(a0.z, kf[2], dd[j]); dd[j] = fmaf(a0.w, kf[3], dd[j]);
                    dd[j] = fmaf(a1.x, kf[4], dd[j]); dd[j] = fmaf(a1.y, kf[5], dd[j]); dd[j] = fmaf(a1.z, kf[6], dd[j]); dd[j] = fmaf(a1.w, kf[7], dd[j]);
                }
            }
            float score = 0.f;
#pragma unroll
            for (int j = 0; j < 8; ++j) score = fmaf(w[j], fmaxf(dd[j], 0.f), score);
            sc[s] = score;
        }
        __syncthreads();
        const int n = t + 1;
        int nsel;
        if (n <= TOPK) {
            if (tid < n) sel[tid] = tid;
            nsel = n;
        } else {
            unsigned prefix = 0; int remaining = TOPK;
            for (int pass = 0; pass < 4; ++pass) {
                const int shift = 24 - 8 * pass;
                if (tid < 256) hist[tid] = 0;
                __syncthreads();
                for (int s = tid; s < n; s += NT) {
                    const unsigned key = okey(sc[s]);
                    const bool match = (pass == 0) || ((key >> (shift + 8)) == prefix);
                    if (match) atomicAdd(&hist[(key >> shift) & 255u], 1u);
                }
                __syncthreads();
                if (tid == 0) {
                    int cum = 0, d = 255;
                    for (; d > 0; --d) { const int c = (int)hist[d]; if (cum + c >= remaining) break; cum += c; }
                    misc[0] = d; misc[1] = remaining - cum;
                }
                __syncthreads();
                prefix = (prefix << 8) | (unsigned)misc[0]; remaining = misc[1];
                __syncthreads();
            }
            const int s0 = tid * 5;
            int ceq = 0;
#pragma unroll
            for (int q = 0; q < 5; ++q) { const int s = s0 + q; if (s < n && okey(sc[s]) == prefix) ++ceq; }
            int eqrank = block_excl_scan(ceq, misc + 8);
            int csel = 0; unsigned selmask = 0;
#pragma unroll
            for (int q = 0; q < 5; ++q) {
                const int s = s0 + q;
                if (s < n) {
                    const unsigned key = okey(sc[s]);
                    bool take = key > prefix;
                    if (key == prefix) { take = eqrank < remaining; ++eqrank; }
                    if (take) { ++csel; selmask |= 1u << q; }
                }
            }
            int posn = block_excl_scan(csel, misc + 16);
#pragma unroll
            for (int q = 0; q < 5; ++q) if (selmask & (1u << q)) { if (posn < TOPK) sel[posn] = s0 + q; ++posn; }
            nsel = TOPK;
        }
        __syncthreads();
        {
            const int i = tid & 255, g = tid >> 8;
            if (i < nsel) {
                const int kidx = sel[i];
                const uint4* kp = (const uint4*)&AK[((size_t)b * L + kidx) * 128 + g * 64];
                float dd[4] = {0.f, 0.f, 0.f, 0.f};
#pragma unroll 1
                for (int q = 0; q < 8; ++q) {
                    float kf[8]; unpack8(kp[q], kf);
#pragma unroll
                    for (int r = 0; r < 4; ++r) {
                        const float4 a0 = *(const float4*)&aqs[g * 4 + r][q * 8], a1 = *(const float4*)&aqs[g * 4 + r][q * 8 + 4];
                        dd[r] = fmaf(a0.x, kf[0], dd[r]); dd[r] = fmaf(a0.y, kf[1], dd[r]); dd[r] = fmaf(a0.z, kf[2], dd[r]); dd[r] = fmaf(a0.w, kf[3], dd[r]);
                        dd[r] = fmaf(a1.x, kf[4], dd[r]); dd[r] = fmaf(a1.y, kf[5], dd[r]); dd[r] = fmaf(a1.z, kf[6], dd[r]); dd[r] = fmaf(a1.w, kf[7], dd[r]);
                    }
                }
#pragma unroll
                for (int r = 0; r < 4; ++r) lg[g * 4 + r][i] = dd[r];
            } else {
#pragma unroll
                for (int r = 0; r < 4; ++r) lg[g * 4 + r][i] = -INFINITY;
            }
        }
        __syncthreads();
        {
            const int h = tid >> 6, lane = tid & 63;
            float v0 = lg[h][lane], v1 = lg[h][lane + 64], v2 = lg[h][lane + 128], v3 = lg[h][lane + 192];
            const float m = wave_max(fmaxf(fmaxf(v0, v1), fmaxf(v2, v3)));
            v0 = expf(v0 - m); v1 = expf(v1 - m); v2 = expf(v2 - m); v3 = expf(v3 - m);
            const float inv = 1.f / wave_sum(v0 + v1 + v2 + v3);
            lg[h][lane] = v0 * inv; lg[h][lane + 64] = v1 * inv; lg[h][lane + 128] = v2 * inv; lg[h][lane + 192] = v3 * inv;
        }
        __syncthreads();
        {
            const int h = tid >> 6, d = tid & 63, g = h >> 2;
            float o = 0.f;
            for (int i = 0; i < nsel; ++i) o = fmaf(lg[h][i], bf2f(AV[((size_t)b * L + sel[i]) * 128 + g * 64 + d]), o);
            const size_t mi = row * 1024 + 512 + tid;
            MIX[mi] = f2bf(o * bf2f(MIX[mi]));
        }
    }
}


constexpr int DS_SC = 0, DS_BITS = 132096, DS_HIST = DS_BITS + 4224, DS_END = DS_HIST + 8 * 1040;
constexpr int DS_MB = 3 * 32768, DS_MBROW = 2112;
static_assert(DS_MB + 16 * DS_MBROW <= DS_BITS, "mask bytes overlap");


template <int NR>
__device__ __forceinline__ void dsa_select(const LAS unsigned* row, LAS unsigned* bits, LAS unsigned* hist, int n, int lane) {
    unsigned kreg[NR];
#pragma unroll
    for (int i = 0; i < NR; ++i) kreg[i] = (lane < n - 64 * i) ? row[lane + 64 * i] : 0u;
    unsigned prefix = 0; int remaining = TOPK;
#pragma unroll 1
    for (int pass = 0; pass < 4; ++pass) {
        const int shift = 24 - 8 * pass;
        *(LAS u32x4*)(hist + lane * 4) = (u32x4){0u, 0u, 0u, 0u};
        __builtin_amdgcn_wave_barrier(); asm volatile("" ::: "memory");
        const unsigned sh8 = (unsigned)(shift + 8) & 31u;
#pragma unroll
        for (int i = 0; i < NR; ++i) {
            const unsigned key = kreg[i];
            const bool match = (lane < n - 64 * i) && ((pass == 0) || ((key >> sh8) == prefix));
            if (match) __hip_atomic_fetch_add(hist + ((key >> shift) & 255u), 1u, __ATOMIC_RELAXED, __HIP_MEMORY_SCOPE_WAVEFRONT);
        }
        __builtin_amdgcn_wave_barrier(); asm volatile("s_waitcnt lgkmcnt(0)" ::: "memory");
        const u32x4 hv = *(const LAS u32x4*)(hist + (63 - lane) * 4);
        const int c0 = (int)hv[3], c1 = (int)hv[2], c2 = (int)hv[1], c3 = (int)hv[0];
        const int tot = c0 + c1 + c2 + c3;
        const int incl = wave_incl_scan(tot), excl = incl - tot;
        const bool found = (excl < remaining) && (remaining <= incl);
        int digit = 0, rem_new = 0;
        if (found) {
            int cum = excl;
            if (cum + c0 >= remaining) { digit = 255 - 4 * lane; rem_new = remaining - cum; }
            else { cum += c0;
                if (cum + c1 >= remaining) { digit = 254 - 4 * lane; rem_new = remaining - cum; }
                else { cum += c1;
                    if (cum + c2 >= remaining) { digit = 253 - 4 * lane; rem_new = remaining - cum; }
                    else { cum += c2; digit = 252 - 4 * lane; rem_new = remaining - cum; } } }
        }
        const unsigned long long fm = __ballot(found);
        const int src = (int)__builtin_ctzll(fm);
        digit = __builtin_amdgcn_readlane(digit, src); rem_new = __builtin_amdgcn_readlane(rem_new, src);
        prefix = (prefix << 8) | (unsigned)digit; remaining = rem_new;
    }
    const unsigned tkey = prefix;
    int eqcount = 0;
#pragma unroll
    for (int i = 0; i < 33; ++i) {
        if (i < NR) {
            const unsigned key = kreg[i < NR ? i : 0];
            const bool valid = lane < n - 64 * i;
            const bool gt = valid && (key > tkey), eq = valid && (key == tkey);
            const unsigned long long em = __ballot(eq);
            const int rank = eqcount + __popcll(em & ((1ull << lane) - 1ull));
            const bool sel = gt || (eq && rank < remaining);
            eqcount += __popcll(em);
            const unsigned long long sm = __ballot(sel);
            if (lane == 0) { bits[2 * i] = (unsigned)sm; bits[2 * i + 1] = (unsigned)(sm >> 32); }
        } else if (lane == 0) { bits[2 * i] = 0u; bits[2 * i + 1] = 0u; }
    }
}

__device__ __forceinline__ void phase_dsa(const Params& p_in, int layer_in, char* smem, bool do_store) {
    const Params p = kparams(); const int layer = opaque_int(layer_in); (void)p_in;
    const int tid = opaque_tid(), wid = __builtin_amdgcn_readfirstlane(tid >> 6), lane = tid & 63, fr = lane & 15, fq = lane >> 4;
    LAS unsigned char* lds = (LAS unsigned char*)smem;
    const bf16_t* IQ = (const bf16_t*)(p.ws + OFF_IQ);
    const bf16_t* IK = (const bf16_t*)(p.ws + OFF_IK);
    const float* IW = (const float*)(p.ws + OFF_IW);
    const bf16_t* AQ = (const bf16_t*)(p.ws + OFF_AQ);
    const bf16_t* AK = (const bf16_t*)(p.ws + OFF_AK);
    const bf16_t* AVT = (const bf16_t*)(p.ws + OFF_AV);
    bf16_t* MIX = (bf16_t*)(p.ws + OFF_MIX);
    constexpr int NITEM = NB * 129;
    for (int idx = opaque_bid(); idx < NITEM; idx += gridDim.x) {
        const int b = idx & 7, mm = idx >> 3;
        int qr;
        { const int seg = mm >> 5, jj = mm & 31; qr = (seg == 0) ? jj : (seg == 1) ? 63 - jj : (seg == 2) ? 64 + jj : (seg == 3) ? 127 - jj : 128; }
        const int qt = 128 - qr, t0 = qt * 16;
        const size_t rowq = (size_t)b * L + t0 + fr;
        __syncthreads();
        for (int repA = 0; repA < PROBE_DSA_A; ++repA) {
            bf16x8 qf[8][2];
#pragma unroll
            for (int jh = 0; jh < 8; ++jh)
#pragma unroll
                for (int s2 = 0; s2 < 2; ++s2) qf[jh][s2] = *(const bf16x8*)(IQ + rowq * 512 + jh * 64 + s2 * 32 + fq * 8);
            float w[8];
            { const f32x4 w0 = *(const f32x4*)(IW + rowq * 8), w1 = *(const f32x4*)(IW + rowq * 8 + 4);
              w[0] = w0[0]; w[1] = w0[1]; w[2] = w0[2]; w[3] = w0[3]; w[4] = w1[0]; w[5] = w1[1]; w[6] = w1[2]; w[7] = w1[3]; }
            const int ntile = qt + 1;
            const bf16x8 z8 = {0, 0, 0, 0, 0, 0, 0, 0};
            bf16x8 ka0 = z8, ka1 = z8, kb0 = z8, kb1 = z8, kc0 = z8, kc1 = z8;
            int kt = wid;
            if (kt < ntile) { const bf16_t* kp = IK + ((size_t)b * L + 16 * kt + fr) * 64 + fq * 8; ka0 = *(const bf16x8*)kp; ka1 = *(const bf16x8*)(kp + 32); }
            if (kt + 8 < ntile) { const bf16_t* kp = IK + ((size_t)b * L + 16 * (kt + 8) + fr) * 64 + fq * 8; kb0 = *(const bf16x8*)kp; kb1 = *(const bf16x8*)(kp + 32); }
            for (; kt < ntile; kt += 8) {
                if (kt + 16 < ntile) { const bf16_t* kp = IK + ((size_t)b * L + 16 * (kt + 16) + fr) * 64 + fq * 8; kc0 = *(const bf16x8*)kp; kc1 = *(const bf16x8*)(kp + 32); }
                f32x4 sc = {0.f, 0.f, 0.f, 0.f};
#pragma unroll
                for (int jh = 0; jh < 8; ++jh) {
                    f32x4 d = {0.f, 0.f, 0.f, 0.f};
                    d = __builtin_amdgcn_mfma_f32_16x16x32_bf16(ka0, qf[jh][0], d, 0, 0, 0);
                    d = __builtin_amdgcn_mfma_f32_16x16x32_bf16(ka1, qf[jh][1], d, 0, 0, 0);
#pragma unroll
                    for (int r = 0; r < 4; ++r) sc[r] = fmaf(w[jh], fmaxf(d[r], 0.f), sc[r]);
                }
                u32x4 ko;
#pragma unroll
                for (int r = 0; r < 4; ++r) ko[r] = okey(sc[r]);
                *(LAS u32x4*)(lds + DS_SC + (fr * 2064 + 16 * kt + 4 * fq) * 4) = ko;
                ka0 = kb0; ka1 = kb1; kb0 = kc0; kb1 = kc1;
            }
        }
        __syncthreads();
        for (int repB = 0; repB < PROBE_DSA_B; ++repB) {
            LAS unsigned* hist = (LAS unsigned*)(lds + DS_HIST + wid * 1040);
#pragma unroll 1
            for (int qq = 0; qq < 2; ++qq) {
                const int q = wid * 2 + qq;
                const int n = t0 + q + 1;
                const LAS unsigned* row = (const LAS unsigned*)(lds + DS_SC) + q * 2064;
                LAS unsigned* bits = (LAS unsigned*)(lds + DS_BITS) + q * 66;
                if (n <= TOPK) {
#pragma unroll 1
                    for (int i = 0; i < 33; ++i) {
                        const unsigned long long sm = __ballot(lane + 64 * i < n);
                        if (lane == 0) { bits[2 * i] = (unsigned)sm; bits[2 * i + 1] = (unsigned)(sm >> 32); }
                    }
                } else {
                    const int nr = (n + 63) >> 6;
                    if (nr <= 9) dsa_select<9>(row, bits, hist, n, lane);
                    else if (nr <= 17) dsa_select<17>(row, bits, hist, n, lane);
                    else if (nr <= 25) dsa_select<25>(row, bits, hist, n, lane);
                    else dsa_select<33>(row, bits, hist, n, lane);
                }
            }
        }
        __syncthreads();
        for (int repC = 0; repC < PROBE_DSA_C; ++repC) {
            if (repC > 0) __syncthreads();
            const int h = wid, g = h >> 2;
            const int nstep = (t0 + 16 + 63) >> 6;
            bf16x8 aqf[2];
            aqf[0] = *(const bf16x8*)(AQ + rowq * 512 + h * 64 + fq * 8);
            aqf[1] = *(const bf16x8*)(AQ + rowq * 512 + h * 64 + 32 + fq * 8);
            asm volatile("" : "+v"(aqf[0]), "+v"(aqf[1]));
            const int drow = 8 * wid + (lane >> 3);
            const int kch = (lane & 7) ^ (drow & 7), vch = (lane & 7) ^ ((drow >> 1) & 7);
            const bf16_t* vsrc0 = AVT + ((size_t)b * 128 + drow) * LP + vch * 8;
#define DSA_DMA(st_, buf_) do { \
                int krow_ = b * L + 64 * (st_) + drow; krow_ = krow_ < T ? krow_ : T - 1; \
                const bf16_t* ks_ = AK + (size_t)krow_ * 128 + kch * 8; \
                LAS unsigned char* lb_ = lds + (buf_) * 32768 + wid * 1024; \
                __builtin_amdgcn_global_load_lds((const unsigned*)ks_, (LAS unsigned*)lb_, 16, 0, 0); \
                __builtin_amdgcn_global_load_lds((const unsigned*)(ks_ + 64), (LAS unsigned*)(lb_ + 8192), 16, 0, 0); \
                __builtin_amdgcn_global_load_lds((const unsigned*)(vsrc0 + 64 * (st_)), (LAS unsigned*)(lb_ + 16384), 16, 0, 0); \
                __builtin_amdgcn_global_load_lds((const unsigned*)(vsrc0 + (size_t)64 * LP + 64 * (st_)), (LAS unsigned*)(lb_ + 24576), 16, 0, 0); } while (0)
            DSA_DMA(0, 0);
            DSA_DMA((nstep > 1 ? 1 : 0), 1);
            for (int wi = tid; wi < 16 * 66; wi += NT) {
                const int q = wi / 66, wd = wi - q * 66;
                const unsigned bw = *((const LAS unsigned*)(lds + DS_BITS) + wi);
                const int st = wd >> 1, hh = wd & 1;
#pragma unroll
                for (int f = 0; f < 4; ++f) {
                    const unsigned n0 = (bw >> (4 * f)) & 15u, n1 = (bw >> (16 + 4 * f)) & 15u;
                    u32x2 o; o.x = (n0 * 0x00204081u) & 0x01010101u; o.y = (n1 * 0x00204081u) & 0x01010101u;
                    *(LAS u32x2*)(lds + DS_MB + q * DS_MBROW + 64 * st + 16 * f + 8 * hh) = o;
                }
            }
            asm volatile("s_waitcnt vmcnt(4) lgkmcnt(0)" ::: "memory");
            __builtin_amdgcn_s_barrier();
            asm volatile("" ::: "memory");
            f32x4 O[4];
#pragma unroll
            for (int dt = 0; dt < 4; ++dt) O[dt] = (f32x4){0.f, 0.f, 0.f, 0.f};
            float m = -INFINITY, l = 0.f;
            const float C2 = 1.44269504088896341f;
            int buf = 0;
            for (int st = 0; st < nstep; ++st) {
                {
                    const int sn = (st + 2 < nstep) ? st + 2 : nstep - 1;
                    const int bn = (buf >= 1) ? buf - 1 : 2;
                    DSA_DMA(sn, bn);
                }
                const LAS unsigned char* sb = lds + buf * 32768;
                f32x4 S[4];
#pragma unroll
                for (int kt = 0; kt < 4; ++kt) {
                    S[kt] = (f32x4){0.f, 0.f, 0.f, 0.f};
#pragma unroll
                    for (int s2 = 0; s2 < 2; ++s2) {
                        const int rowk = 16 * kt + fr;
                        const bf16x8 kf = *(const LAS bf16x8*)(sb + g * 8192 + rowk * 128 + 16 * ((4 * s2 + fq) ^ (rowk & 7)));
                        S[kt] = __builtin_amdgcn_mfma_f32_16x16x32_bf16(kf, aqf[s2], S[kt], 0, 0, 0);
                    }
                }
                const u32x4 mb = *(const LAS u32x4*)(lds + DS_MB + fr * DS_MBROW + 64 * st + 16 * fq);
                float pmax = S[0][0];
#pragma unroll
                for (int kt = 0; kt < 4; ++kt)
#pragma unroll
                    for (int r = 0; r < 4; ++r) pmax = fmaxf(pmax, S[kt][r]);
                if (__any(pmax > m + 8.0f)) {
                    float pm = fmaxf(pmax, __shfl_xor(pmax, 16)); pm = fmaxf(pm, __shfl_xor(pm, 32));
                    const float mn = fmaxf(m, pm);
                    const float alpha = __builtin_amdgcn_exp2f((m - mn) * C2);
#pragma unroll
                    for (int dt = 0; dt < 4; ++dt) O[dt] *= alpha;
                    l *= alpha; m = mn;
                }
                const float mc = m * C2;
                unsigned pk[4][2];
#pragma unroll
                for (int kt = 0; kt < 4; ++kt) {
                    float pv[4];
#pragma unroll
                    for (int r = 0; r < 4; ++r) {
                        const float e = __builtin_amdgcn_exp2f(fmaf(S[kt][r], C2, -mc));
                        const float bf = (float)((mb[kt] >> (8 * r)) & 0xFFu);
                        pv[r] = e * bf; l += pv[r];
                    }
                    pk[kt][0] = cvt_pk_bf16(pv[0], pv[1]); pk[kt][1] = cvt_pk_bf16(pv[2], pv[3]);
                }
#pragma unroll
                for (int ks = 0; ks < 2; ++ks) {
                    u32x4 pw; pw[0] = pk[2 * ks][0]; pw[1] = pk[2 * ks][1]; pw[2] = pk[2 * ks + 1][0]; pw[3] = pk[2 * ks + 1][1];
                    const bf16x8 pf = __builtin_bit_cast(bf16x8, pw);
#pragma unroll
                    for (int dt = 0; dt < 4; ++dt) {
                        const int rowv = 16 * dt + fr, sw = (rowv >> 1) & 7;
                        const LAS unsigned char* vp = sb + 16384 + g * 8192 + rowv * 128 + 8 * (fq & 1);
                        const u32x2 va = *(const LAS u32x2*)(vp + 16 * ((4 * ks + (fq >> 1)) ^ sw));
                        const u32x2 vb = *(const LAS u32x2*)(vp + 16 * ((4 * ks + 2 + (fq >> 1)) ^ sw));
                        u32x4 vw; vw[0] = va[0]; vw[1] = va[1]; vw[2] = vb[0]; vw[3] = vb[1];
                        O[dt] = __builtin_amdgcn_mfma_f32_16x16x32_bf16(__builtin_bit_cast(bf16x8, vw), pf, O[dt], 0, 0, 0);
                    }
                }
                asm volatile("s_waitcnt vmcnt(4)" ::: "memory");
                __builtin_amdgcn_s_barrier();
                asm volatile("" ::: "memory");
                buf = (buf == 2) ? 0 : buf + 1;
            }
#undef DSA_DMA
            asm volatile("s_waitcnt vmcnt(0)" ::: "memory");
            l += __shfl_xor(l, 16); l += __shfl_xor(l, 32);
            const float inv = 1.f / fmaxf(l, 1e-30f);
            bf16_t* mp = MIX + rowq * 1024 + 512 + h * 64 + 4 * fq;
            if (do_store && repC == PROBE_DSA_C - 1)
#pragma unroll
            for (int dt = 0; dt < 4; ++dt) {
                const uint2 gz = *(const uint2*)(mp + 16 * dt);
                const float g0 = __uint_as_float(gz.x << 16), g1 = __uint_as_float(gz.x & 0xFFFF0000u), g2 = __uint_as_float(gz.y << 16), g3 = __uint_as_float(gz.y & 0xFFFF0000u);
                uint2 o; o.x = pack2bf(O[dt][0] * inv * g0, O[dt][1] * inv * g1); o.y = pack2bf(O[dt][2] * inv * g2, O[dt][3] * inv * g3);
                *(uint2*)(mp + 16 * dt) = o;
            }
        }
    }
}

__device__ __forceinline__ void rope16(const u32x4 a, const u32x4 b, const float2* rp, u32x4& oa, u32x4& ob) {
    const f32x4 r0 = *(const f32x4*)(rp), r1 = *(const f32x4*)(rp + 2), r2 = *(const f32x4*)(rp + 4), r3 = *(const f32x4*)(rp + 6);
    const float cs[8] = {r0[0], r0[2], r1[0], r1[2], r2[0], r2[2], r3[0], r3[2]};
    const float sn[8] = {r0[1], r0[3], r1[1], r1[3], r2[1], r2[3], r3[1], r3[3]};
    float o1[8], o2[8];
#pragma unroll
    for (int i = 0; i < 4; ++i) {
        const float x1l = __uint_as_float(a[i] << 16), x1h = __uint_as_float(a[i] & 0xFFFF0000u);
        const float x2l = __uint_as_float(b[i] << 16), x2h = __uint_as_float(b[i] & 0xFFFF0000u);
        o1[2 * i] = x1l * cs[2 * i] - x2l * sn[2 * i]; o1[2 * i + 1] = x1h * cs[2 * i + 1] - x2h * sn[2 * i + 1];
        o2[2 * i] = x2l * cs[2 * i] + x1l * sn[2 * i]; o2[2 * i + 1] = x2h * cs[2 * i + 1] + x1h * sn[2 * i + 1];
    }
#pragma unroll
    for (int i = 0; i < 4; ++i) { oa[i] = cvt_pk_bf16(o1[2 * i], o1[2 * i + 1]); ob[i] = cvt_pk_bf16(o2[2 * i], o2[2 * i + 1]); }
}
__device__ __forceinline__ void phase_rope(const Params& p_in, int layer_in, char* smem) {
    const Params p = kparams(); const int layer = opaque_int(layer_in); (void)p_in;
    const int tid = opaque_tid();
    const float2* ROPE = (const float2*)(p.ws + OFF_ROPE);
    const int nthr = gridDim.x * NT, gid = opaque_bid() * NT + tid;
    for (int th = gid; th < T * 18; th += nthr) {
        const int t = th / 18, hh = th - t * 18, pos = t % L;
        bf16_t* base = (hh < 8) ? (bf16_t*)(p.ws + OFF_AQ) + (size_t)t * 512 + hh * 64
                     : (hh < 16) ? (bf16_t*)(p.ws + OFF_IQ) + (size_t)t * 512 + (hh - 8) * 64
                                 : (bf16_t*)(p.ws + OFF_AK) + (size_t)t * 128 + (hh - 16) * 64;
        const u32x4 a = *(const u32x4*)base, b = *(const u32x4*)(base + 8);
        u32x4 oa, ob; rope16(a, b, ROPE + pos * 8, oa, ob);
        *(u32x4*)base = oa; *(u32x4*)(base + 8) = ob;
    }
    const float* IKR = (const float*)(p.ws + OFF_IKR);
    bf16_t* IK = (bf16_t*)(p.ws + OFF_IK);
    const float* ikg = p.ikg + layer * 64; const float* ikb = p.ikb + layer * 64;
    for (int t = gid; t < T; t += nthr) {
        const int pos = t % L;
        f32x4 x[16];
#pragma unroll
        for (int i = 0; i < 16; ++i) x[i] = *(const f32x4*)(IKR + (size_t)t * 64 + 4 * i);
        float sm = 0.f;
#pragma unroll
        for (int i = 0; i < 16; ++i) sm += (x[i][0] + x[i][1]) + (x[i][2] + x[i][3]);
        const float mu = sm * (1.f / 64);
        float qq = 0.f;
#pragma unroll
        for (int i = 0; i < 16; ++i) { const f32x4 d = x[i] - mu; qq += (d[0] * d[0] + d[1] * d[1]) + (d[2] * d[2] + d[3] * d[3]); }
        const float rs = rsqrtf(qq * (1.f / 64) + LN_EPS);
#pragma unroll
        for (int i = 0; i < 16; ++i) { const f32x4 g = *(const f32x4*)(ikg + 4 * i), bb = *(const f32x4*)(ikb + 4 * i); x[i] = (x[i] - mu) * rs * g + bb; }
        const float2* rp = ROPE + pos * 8;
        const f32x4 r0 = *(const f32x4*)(rp), r1 = *(const f32x4*)(rp + 2), r2 = *(const f32x4*)(rp + 4), r3 = *(const f32x4*)(rp + 6);
        const float cs[8] = {r0[0], r0[2], r1[0], r1[2], r2[0], r2[2], r3[0], r3[2]};
        const float sn[8] = {r0[1], r0[3], r1[1], r1[3], r2[1], r2[3], r3[1], r3[3]};
#pragma unroll
        for (int i = 0; i < 8; ++i) {
            const float x1 = x[i >> 2][i & 3], x2 = x[2 + (i >> 2)][i & 3];
            x[i >> 2][i & 3] = x1 * cs[i] - x2 * sn[i];
            x[2 + (i >> 2)][i & 3] = x2 * cs[i] + x1 * sn[i];
        }
#pragma unroll
        for (int i = 0; i < 8; ++i) {
            u32x4 o; o[0] = cvt_pk_bf16(x[2 * i][0], x[2 * i][1]); o[1] = cvt_pk_bf16(x[2 * i][2], x[2 * i][3]); o[2] = cvt_pk_bf16(x[2 * i + 1][0], x[2 * i + 1][1]); o[3] = cvt_pk_bf16(x[2 * i + 1][2], x[2 * i + 1][3]);
            *(u32x4*)(IK + (size_t)t * 64 + 8 * i) = o;
        }
    }
}

constexpr int GL_QE = 0, GL_KN = 8192, GL_SEG = 16384, GL_PART = 18432;
__device__ __forceinline__ void gla_cumsum(const Params& p, int layer, int b, int h, int c, int tid, LAS unsigned char* lds, float (&bc)[8], float& blast) {
    const int d = tid & 63, seg = tid >> 6;
    const float* wg2 = p.wg2 + (size_t)layer * 16 * 256 + h * 64 + d;
    float w[16];
#pragma unroll
    for (int rr = 0; rr < 16; ++rr) w[rr] = wg2[rr * 256];
    const float bgd = p.bg[layer * 256 + h * 64 + d];
    const float* GLR = (const float*)(p.ws + OFF_GLR);
    float pb = 0.f;
#pragma unroll
    for (int i = 0; i < 8; ++i) {
        const int pos = 64 * c - 48 + 8 * seg + i;
        float gl = 0.f;
        if (pos >= 0) {
            const f32x4* gp = (const f32x4*)(GLR + ((size_t)b * L + pos) * 16);
            const f32x4 g0 = gp[0], g1 = gp[1], g2 = gp[2], g3 = gp[3];
            float x = bgd;
#pragma unroll
            for (int rr = 0; rr < 4; ++rr) { x = fmaf(g0[rr], w[rr], x); }
#pragma unroll
            for (int rr = 0; rr < 4; ++rr) { x = fmaf(g1[rr], w[4 + rr], x); }
#pragma unroll
            for (int rr = 0; rr < 4; ++rr) { x = fmaf(g2[rr], w[8 + rr], x); }
#pragma unroll
            for (int rr = 0; rr < 4; ++rr) { x = fmaf(g3[rr], w[12 + rr], x); }
            gl = logsigmoid_fast(x) * (1.f / 16.f);
        }
        pb += gl; bc[i] = pb;
    }
    LAS float* segs = (LAS float*)(lds + GL_SEG);
    segs[seg * 64 + d] = pb;
    __syncthreads();
    float base = 0.f, tot = 0.f;
#pragma unroll
    for (int sg = 0; sg < 8; ++sg) { const float v = segs[sg * 64 + d]; tot += v; base += (sg < seg) ? v : 0.f; }
#pragma unroll
    for (int i = 0; i < 8; ++i) bc[i] += base;
    blast = tot;
}

constexpr size_t OUTS_QE = 0, OUTS_KN = (size_t)T * 256 * 2;
__device__ __forceinline__ void phase_gla_a(const Params& p_in, int layer_in, char* smem) {
    const Params p = kparams(); const int layer = opaque_int(layer_in); (void)p_in;
    const int tid = opaque_tid(), wid = __builtin_amdgcn_readfirstlane(tid >> 6), lane = tid & 63, fr = lane & 15, fq = lane >> 4;
    LAS unsigned char* ldw = (LAS unsigned char*)smem + wid * 8192;
    const bf16_t* GQ = (const bf16_t*)(p.ws + OFF_GQ);
    const bf16_t* GK = (const bf16_t*)(p.ws + OFF_GK);
    const bf16_t* GVT = (const bf16_t*)(p.ws + OFF_GV);
    const float* GLR = (const float*)(p.ws + OFF_GLR);
    bf16_t* QE = (bf16_t*)((char*)p.out + OUTS_QE);
    bf16_t* KN = (bf16_t*)((char*)p.out + OUTS_KN);
    float* UT = (float*)(p.ws + OFF_UT);
    float* DL = (float*)(p.ws + OFF_DL);
    const int wstride = gridDim.x * 8;
    for (int task = wid * (int)gridDim.x + opaque_bid(); task < 32 * 33; task += wstride) {
        const int bh = task / 33, c = task - bh * 33, b = bh >> 2, h = bh & 3;
        const int d = lane;
        float w[16];
#pragma unroll
        for (int rr = 0; rr < 16; ++rr) w[rr] = p.wg2[(size_t)layer * 16 * 256 + rr * 256 + h * 64 + d];
        const float bgd = p.bg[layer * 256 + h * 64 + d];
        float bsum = 0.f;
        const int t_begin = (c == 0) ? 48 : 0;
        const size_t row0 = (size_t)b * L + 64 * c - 48;
        if (c == 0 && c < 32) {
#pragma unroll
            for (int q8 = 0; q8 < 6; ++q8) *(LAS u32x4*)(ldw + d * 128 + 16 * (q8 ^ (d & 7))) = (u32x4){0u, 0u, 0u, 0u};
        }
#pragma unroll 1
        for (int t8 = t_begin; t8 < 64; t8 += 8) {
            float kn[8];
#pragma unroll
            for (int i = 0; i < 8; ++i) {
                const size_t row = row0 + t8 + i;
                const f32x4* gp = (const f32x4*)(GLR + row * 16);
                const f32x4 g0 = gp[0], g1 = gp[1], g2 = gp[2], g3 = gp[3];
                const float qv = bf2f(GQ[row * 256 + h * 64 + d]), kv = bf2f(GK[row * 256 + h * 64 + d]);
                float x = bgd;
#pragma unroll
                for (int rr = 0; rr < 4; ++rr) x = fmaf(g0[rr], w[rr], x);
#pragma unroll
                for (int rr = 0; rr < 4; ++rr) x = fmaf(g1[rr], w[4 + rr], x);
#pragma unroll
                for (int rr = 0; rr < 4; ++rr) x = fmaf(g2[rr], w[8 + rr], x);
#pragma unroll
                for (int rr = 0; rr < 4; ++rr) x = fmaf(g3[rr], w[12 + rr], x);
                bsum += logsigmoid_fast(x) * (1.f / 16.f);
                const float eb = __expf(bsum);
                kn[i] = kv * __builtin_amdgcn_rcpf(eb);
                QE[row * 256 + h * 64 + d] = f2bf(qv * eb);
                KN[row * 256 + h * 64 + d] = f2bf(kn[i]);
            }
            if (c < 32) {
                u32x4 o; o[0] = cvt_pk_bf16(kn[0], kn[1]); o[1] = cvt_pk_bf16(kn[2], kn[3]); o[2] = cvt_pk_bf16(kn[4], kn[5]); o[3] = cvt_pk_bf16(kn[6], kn[7]);
                *(LAS u32x4*)(ldw + d * 128 + 16 * ((t8 >> 3) ^ (d & 7))) = o;
            }
        }
        if (c < 32) {
            const float dl = __expf(bsum);
            DL[((size_t)bh * 32 + c) * 64 + d] = dl;
            __builtin_amdgcn_wave_barrier(); asm volatile("s_waitcnt lgkmcnt(0)" ::: "memory");
            bf16x8 kf[4][2]; float dls[4];
#pragma unroll
            for (int dt = 0; dt < 4; ++dt) {
                const int rowd = 16 * dt + fr;
                dls[dt] = __shfl(dl, rowd);
#pragma unroll
                for (int ks = 0; ks < 2; ++ks) kf[dt][ks] = *(const LAS bf16x8*)(ldw + rowd * 128 + 16 * ((4 * ks + fq) ^ (rowd & 7)));
            }
            const bf16x8 z8 = {0, 0, 0, 0, 0, 0, 0, 0};
#pragma unroll
            for (int et = 0; et < 8; ++et) {
                const bf16_t* vp = GVT + ((size_t)bh * 128 + 16 * et + fr) * LPV + 64 * c + 8 * fq;
                bf16x8 v0 = *(const bf16x8*)vp, v1 = *(const bf16x8*)(vp + 32);
                v0 = (c == 0) ? z8 : v0; v1 = (c == 0 && fq < 2) ? z8 : v1;
#pragma unroll
                for (int dt = 0; dt < 4; ++dt) {
                    f32x4 acc = {0.f, 0.f, 0.f, 0.f};
                    acc = __builtin_amdgcn_mfma_f32_16x16x32_bf16(v0, kf[dt][0], acc, 0, 0, 0);
                    acc = __builtin_amdgcn_mfma_f32_16x16x32_bf16(v1, kf[dt][1], acc, 0, 0, 0);
                    float* up = UT + (((size_t)bh * 32 + c) * 128 + 16 * et + 4 * fq) * 64 + 16 * dt + fr;
#pragma unroll
                    for (int r = 0; r < 4; ++r) up[r * 64] = acc[r] * dls[dt];
                }
            }
            __builtin_amdgcn_wave_barrier(); asm volatile("s_waitcnt lgkmcnt(0)" ::: "memory");
        }
    }
}

__device__ __forceinline__ void phase_gla_scan(const Params& p_in, int layer_in, char* smem) {
    const Params p = kparams(); const int layer = opaque_int(layer_in); (void)p_in;
    const int tid = opaque_tid();
    const float* UT = (const float*)(p.ws + OFF_UT);
    const float* DL = (const float*)(p.ws + OFF_DL);
    bf16_t* ST = (bf16_t*)(p.ws + OFF_ST);
    const int nthr = gridDim.x * NT;
    for (int el = opaque_bid() * NT + tid; el < 32 * 8192; el += nthr) {
        const int bh = el >> 13, ed = el & 8191, d = el & 63;
        float sacc = 0.f;
        ST[((size_t)bh * 33) * 8192 + ed] = 0;
#pragma unroll 1
        for (int c0 = 0; c0 < 32; c0 += 16) {
            float u[16], dl[16];
#pragma unroll
            for (int i = 0; i < 16; ++i) { u[i] = UT[((size_t)(bh * 32 + c0 + i)) * 8192 + ed]; dl[i] = DL[(size_t)(bh * 32 + c0 + i) * 64 + d]; }
#pragma unroll
            for (int i = 0; i < 16; ++i) { sacc = fmaf(dl[i], sacc, u[i]); ST[((size_t)bh * 33 + c0 + i + 1) * 8192 + ed] = f2bf(sacc); }
        }
    }
}

__device__ __forceinline__ void phase_gla_c(const Params& p_in, int layer_in, char* smem, bool do_store) {
    const Params p = kparams(); const int layer = opaque_int(layer_in); (void)p_in;
    const int tid = opaque_tid(), wid = __builtin_amdgcn_readfirstlane(tid >> 6), lane = tid & 63, fr = lane & 15, fq = lane >> 4;
    const bf16_t* QE = (const bf16_t*)((const char*)p.out + OUTS_QE);
    const bf16_t* KN = (const bf16_t*)((const char*)p.out + OUTS_KN);
    const bf16_t* GVT = (const bf16_t*)(p.ws + OFF_GV);
    const bf16_t* ST = (const bf16_t*)(p.ws + OFF_ST);
    bf16_t* MIX = (bf16_t*)(p.ws + OFF_MIX);
    const float* ng = p.norm_g + layer * 128;
    const bf16x8 z8 = {0, 0, 0, 0, 0, 0, 0, 0};
    const int nwt = 32 * 33 * 4, wstride = gridDim.x * 8;
    for (int wt = wid * (int)gridDim.x + opaque_bid(); wt < nwt; wt += wstride) {
        const int task = wt >> 2, tw = wt & 3;
        const int bh = task / 33, c = task - bh * 33, b = bh >> 2, h = bh & 3;
        const int pos_t = 64 * c - 48 + 16 * tw + fr;
        if (c == 0 && tw < 3) continue;
        bf16x8 qf[2];
        {
            const bf16_t* qp = QE + ((size_t)b * L + pos_t) * 256 + h * 64 + 8 * fq;
            qf[0] = *(const bf16x8*)qp; qf[1] = *(const bf16x8*)(qp + 32);
        }
        unsigned pk[4][2];
#pragma unroll
        for (int st = 0; st < 4; ++st) {
            f32x4 a = {0.f, 0.f, 0.f, 0.f};
            const int pos_s = 64 * c - 48 + 16 * st + fr;
            const bf16_t* kp = KN + ((size_t)b * L + (pos_s > 0 ? pos_s : 0)) * 256 + h * 64 + 8 * fq;
            bf16x8 k0 = *(const bf16x8*)kp, k1 = *(const bf16x8*)(kp + 32);
            k0 = (pos_s >= 0) ? k0 : z8; k1 = (pos_s >= 0) ? k1 : z8;
            a = __builtin_amdgcn_mfma_f32_16x16x32_bf16(k0, qf[0], a, 0, 0, 0);
            a = __builtin_amdgcn_mfma_f32_16x16x32_bf16(k1, qf[1], a, 0, 0, 0);
#pragma unroll
            for (int r = 0; r < 4; ++r) a[r] = (16 * st + 4 * fq + r > 16 * tw + fr) ? 0.f : a[r];
            pk[st][0] = cvt_pk_bf16(a[0], a[1]); pk[st][1] = cvt_pk_bf16(a[2], a[3]);
        }
        bf16x8 pf[2];
#pragma unroll
        for (int ks = 0; ks < 2; ++ks) { u32x4 pw; pw[0] = pk[2 * ks][0]; pw[1] = pk[2 * ks][1]; pw[2] = pk[2 * ks + 1][0]; pw[3] = pk[2 * ks + 1][1]; pf[ks] = __builtin_bit_cast(bf16x8, pw); }
        f32x4 O[8];
        float ss = 0.f;
        const u32x2 z2 = {0u, 0u};
#pragma unroll
        for (int et = 0; et < 8; ++et) {
            const int e0 = 16 * et;
            f32x4 acc = {0.f, 0.f, 0.f, 0.f};
            const bf16_t* sp = ST + (((size_t)bh * 33 + c) * 128 + e0 + fr) * 64 + 8 * fq;
            const bf16_t* vp = GVT + ((size_t)bh * 128 + e0 + fr) * LPV + 64 * c + 4 * fq;
            acc = __builtin_amdgcn_mfma_f32_16x16x32_bf16(*(const bf16x8*)sp, qf[0], acc, 0, 0, 0);
            acc = __builtin_amdgcn_mfma_f32_16x16x32_bf16(*(const bf16x8*)(sp + 32), qf[1], acc, 0, 0, 0);
            u32x2 va = *(const u32x2*)vp, vb = *(const u32x2*)(vp + 16), vc = *(const u32x2*)(vp + 32), vd = *(const u32x2*)(vp + 48);
            va = (c == 0) ? z2 : va; vb = (c == 0) ? z2 : vb; vc = (c == 0) ? z2 : vc;
            u32x4 vw; vw[0] = va[0]; vw[1] = va[1]; vw[2] = vb[0]; vw[3] = vb[1];
            acc = __builtin_amdgcn_mfma_f32_16x16x32_bf16(__builtin_bit_cast(bf16x8, vw), pf[0], acc, 0, 0, 0);
            u32x4 vx; vx[0] = vc[0]; vx[1] = vc[1]; vx[2] = vd[0]; vx[3] = vd[1];
            acc = __builtin_amdgcn_mfma_f32_16x16x32_bf16(__builtin_bit_cast(bf16x8, vx), pf[1], acc, 0, 0, 0);
            O[et] = acc;
            ss += acc[0] * acc[0] + acc[1] * acc[1] + acc[2] * acc[2] + acc[3] * acc[3];
        }
        ss += __shfl_xor(ss, 16); ss += __shfl_xor(ss, 32);
        const float rinv = rsqrtf(ss * (1.f / 128) + LN_EPS);
        if (pos_t >= 0 && do_store) {
            bf16_t* mp = MIX + ((size_t)b * L + pos_t) * 1024 + h * 128 + 4 * fq;
#pragma unroll
            for (int et = 0; et < 8; ++et) {
                const uint2 gz = *(const uint2*)(mp + 16 * et);
                const f32x4 nv = *(const f32x4*)(ng + 16 * et + 4 * fq);
                const float g0 = __uint_as_float(gz.x << 16), g1 = __uint_as_float(gz.x & 0xFFFF0000u), g2 = __uint_as_float(gz.y << 16), g3 = __uint_as_float(gz.y & 0xFFFF0000u);
                uint2 o; o.x = cvt_pk_bf16(O[et][0] * rinv * nv[0] * g0, O[et][1] * rinv * nv[1] * g1); o.y = cvt_pk_bf16(O[et][2] * rinv * nv[2] * g2, O[et][3] * rinv * nv[3] * g3);
                *(uint2*)(mp + 16 * et) = o;
            }
        }
    }
}

__device__ __forceinline__ void phase_ln(const Params& p_in, int layer_in, char* smem) {
    const Params p = kparams(); const int layer = opaque_int(layer_in); (void)p_in;
    const int tid = opaque_tid(), wid = tid >> 6, lane = tid & 63;
    const float* Z = (const float*)(p.ws + OFF_GQ);
    float* H32 = (float*)(p.ws + OFF_H32);
    bf16_t* HB = (bf16_t*)(p.ws + OFF_HB);
    const float* g = p.ln_g + layer * D; const float* bb = p.ln_b + layer * D;
    const int nw = gridDim.x * 8;
    int t = opaque_bid() * 8 + wid;
    f32x4 v[4], vn[4];
    if (t < T) {
#pragma unroll
        for (int i = 0; i < 4; ++i) v[i] = *(const f32x4*)(Z + (size_t)t * D + 4 * lane + 256 * i);
    }
    for (; t < T; t += nw) {
        const int tn = t + nw;
        if (tn < T) {
#pragma unroll
            for (int i = 0; i < 4; ++i) vn[i] = *(const f32x4*)(Z + (size_t)tn * D + 4 * lane + 256 * i);
        }
        ln_row_wave(v, g, bb, lane);
        if (layer == DEPTH - 1) {
            const int b = t / L, pos = t - b * L;
            if (pos >= NMETA) {
#pragma unroll
                for (int i = 0; i < 4; ++i) *(f32x4*)(p.out + ((size_t)b * SEQ + (pos - NMETA)) * D + 4 * lane + 256 * i) = v[i];
            }
        } else {
#pragma unroll
            for (int i = 0; i < 4; ++i) {
                *(f32x4*)(H32 + (size_t)t * D + 4 * lane + 256 * i) = v[i];
                u32x2 o; o[0] = cvt_pk_bf16(v[i][0], v[i][1]); o[1] = cvt_pk_bf16(v[i][2], v[i][3]);
                *(u32x2*)(HB + (size_t)t * D + 4 * lane + 256 * i) = o;
            }
        }
#pragma unroll
        for (int i = 0; i < 4; ++i) v[i] = vn[i];
    }
}

#define XB_TMO      128
#define XB_XCNT(j)  (256  + 64 * (j))
#define XB_XSUB(j)  (1280 + 64 * (j))
#define XB_XGEN(j)  (2304 + 64 * (j))
#define XB_TOP      3328
#define XB_TOPGEN   3392
#define XCD_BAR_WORDS 3456
#define XB_SPIN_CAP (1u << 22)
__device__ __forceinline__ unsigned xb_ld(unsigned* p)              { return __hip_atomic_load(p, __ATOMIC_RELAXED, __HIP_MEMORY_SCOPE_AGENT); }
__device__ __forceinline__ unsigned xb_add(unsigned* p, unsigned v) { return __hip_atomic_fetch_add(p, v, __ATOMIC_RELAXED, __HIP_MEMORY_SCOPE_AGENT); }
__device__ __forceinline__ unsigned xb_xcc_id() { return (unsigned)__builtin_amdgcn_s_getreg((3 << 11) | 20) & 0xFu; }
#define XB_SPIN(cond, bar) do { unsigned _sp = 0; while (cond) { __builtin_amdgcn_s_sleep(1); \
    if ((++_sp & 255u) == 0u) { if (xb_ld(&(bar)[XB_TMO])) break; if (_sp > XB_SPIN_CAP) { atomicAdd(&(bar)[XB_TMO], 1u); break; } } } } while (0)
struct XcdBarrier { unsigned* bar; unsigned x; volatile LAS unsigned* st; };
__device__ __forceinline__ XcdBarrier xcd_barrier_post(unsigned* bar, volatile LAS unsigned* st) {
    XcdBarrier b; b.bar = bar; b.x = xb_xcc_id(); b.st = st;
    if (threadIdx.x == 0) (void)xb_add(&bar[XB_XCNT(b.x)], 1u);
    return b;
}
__device__ __forceinline__ void xcd_barrier_complete(unsigned* bar, unsigned x, unsigned& nloc, unsigned& nx) {
    const unsigned G = gridDim.x * gridDim.y * gridDim.z;
    unsigned sum, cnt, mine, sp = 0u;
    for (;;) {
        sum = 0u; cnt = 0u; mine = 0u;
#pragma unroll
        for (unsigned j = 0; j < 16; ++j) { const unsigned c = xb_ld(&bar[XB_XCNT(j)]); sum += c; cnt += (c > 0u) ? 1u : 0u; mine = (j == x) ? c : mine; }
        if (sum == G) break;
        __builtin_amdgcn_s_sleep(1);
        if ((++sp & 255u) == 0u) { if (xb_ld(&bar[XB_TMO])) break; if (sp > XB_SPIN_CAP) { atomicAdd(&bar[XB_TMO], 1u); break; } }
    }
    nloc = mine > 0u ? mine : 1u; nx = cnt > 0u ? cnt : 1u;
}
__device__ __forceinline__ void xcd_barrier(unsigned* bar_, volatile LAS unsigned* st_) {
    XcdBarrier b; b.bar = bar_; b.x = xb_xcc_id(); b.st = st_;
    asm volatile("s_waitcnt vmcnt(0)" ::: "memory");
    __syncthreads();
    if (opaque_tid() == 0) {
        unsigned* bar = b.bar;
        __builtin_amdgcn_s_waitcnt(0);
        unsigned nloc = b.st[0], nx = b.st[1];
        if (nloc == 0u) { xcd_barrier_complete(bar, b.x, nloc, nx); b.st[0] = nloc; b.st[1] = nx; }
        const unsigned old = xb_add(&bar[XB_XSUB(b.x)], 1u);
        const unsigned gen = old / nloc;
        if (old + 1u == (gen + 1u) * nloc) {
            __builtin_amdgcn_fence(__ATOMIC_RELEASE, "agent");
            asm volatile("s_waitcnt vmcnt(0)" ::: "memory");
            const unsigned og = xb_add(&bar[XB_TOP], 1u);
            const unsigned tg = og / nx;
            if (og + 1u == (tg + 1u) * nx) xb_add(&bar[XB_TOPGEN], 1u);
            else XB_SPIN(xb_ld(&bar[XB_TOPGEN]) == tg, bar);
            __builtin_amdgcn_fence(__ATOMIC_ACQUIRE, "agent");
            xb_add(&bar[XB_XGEN(b.x)], 1u);
            asm volatile("s_waitcnt vmcnt(0)" ::: "memory");
        } else {
            XB_SPIN(xb_ld(&bar[XB_XGEN(b.x)]) == gen, bar);
            __builtin_amdgcn_fence(__ATOMIC_ACQUIRE, "agent");
            asm volatile("s_waitcnt vmcnt(0)" ::: "memory");
        }
    }
    __syncthreads();
}

constexpr int SMEM_BYTES = 160 * 1024;
static_assert(DS_END <= SMEM_BYTES - 16, "dsa lds");

__global__ void __launch_bounds__(NT, 2) k_mega(Params p) {
    __shared__ __attribute__((aligned(16))) char smem[SMEM_BYTES];
    volatile LAS unsigned* xbw = (volatile LAS unsigned*)((LAS unsigned char*)smem + (SMEM_BYTES - 16));
    if (threadIdx.x == 0) { xbw[0] = 0u; xbw[1] = 0u; xbw[2] = 0u; xbw[3] = 0u; }
    __syncthreads();
    if (p.ws == nullptr) cg::this_grid().sync();
    (void)xcd_barrier_post((unsigned*)(p.ws + OFF_BAR), xbw);
    for (int rep = 0; rep < PROBE_REP_PREP; ++rep) {
    phase_prep(p, smem);
    xcd_barrier((unsigned*)(p.ws + OFF_BAR), xbw);
    }
#pragma unroll 1
    for (int layer = 0; layer < DEPTH; ++layer) {
        for (int rep = 0; rep < PROBE_REP_PROJ; ++rep) {
        phase_proj(p, layer, smem);
        xcd_barrier((unsigned*)(p.ws + OFF_BAR), xbw);
        }
        phase_rope(p, layer, smem);
        for (int rep = 0; rep < PROBE_REP_GLAA; ++rep) {
        phase_gla_a(p, layer, smem);
        xcd_barrier((unsigned*)(p.ws + OFF_BAR), xbw);
        phase_gla_scan(p, layer, smem);
        xcd_barrier((unsigned*)(p.ws + OFF_BAR), xbw);
        }
        for (int rep = 0; rep < PROBE_REP_GLAC; ++rep) phase_gla_c(p, layer, smem, rep == PROBE_REP_GLAC - 1);
        for (int rep = 0; rep < PROBE_REP_DSA; ++rep) phase_dsa(p, layer, smem, rep == PROBE_REP_DSA - 1);
        xcd_barrier((unsigned*)(p.ws + OFF_BAR), xbw);
        for (int rep = 0; rep < PROBE_REP_OUT; ++rep) {
        phase_outproj(p, layer, smem);
        xcd_barrier((unsigned*)(p.ws + OFF_BAR), xbw);
        }
        for (int rep = 0; rep < PROBE_REP_LN; ++rep) {
        phase_ln(p, layer, smem);
        xcd_barrier((unsigned*)(p.ws + OFF_BAR), xbw);
        }
    }
}

extern "C" void kernel_launch(void* const* d_in, const int* in_sizes, int n_in, void* d_out, int out_size, void* d_ws, size_t ws_size,
                              hipStream_t stream) {
    Params p{};
    p.x = (const float*)d_in[0]; p.meta = (const float*)d_in[1]; p.ln_in_g = (const float*)d_in[2]; p.ln_in_b = (const float*)d_in[3];
    p.w_in = (const float*)d_in[4]; p.wg2 = (const float*)d_in[5]; p.bg = (const float*)d_in[6]; p.norm_g = (const float*)d_in[7];
    p.ikg = (const float*)d_in[8]; p.ikb = (const float*)d_in[9]; p.w_out = (const float*)d_in[10]; p.ln_g = (const float*)d_in[11];
    p.ln_b = (const float*)d_in[12];
    p.out = (float*)d_out; p.ws = (char*)d_ws;
    static int grid_blocks = 0;
    if (!grid_blocks) {
        int dev = 0, cus = 0, per_cu = 0;
        hipGetDevice(&dev);
        hipDeviceGetAttribute(&cus, hipDeviceAttributeMultiprocessorCount, dev);
        hipOccupancyMaxActiveBlocksPerMultiprocessor(&per_cu, k_mega, NT, 0);
        if (per_cu > 1) per_cu = 1;
        grid_blocks = cus * per_cu;
    }
    (void)hipMemsetAsync((char*)d_ws + OFF_BAR, 0, XCD_BAR_WORDS * 4, stream);
    void* args[] = {&p};
    (void)hipLaunchCooperativeKernel((void*)k_mega, dim3(grid_blocks), dim3(NT), args, 0, stream);
}
```

```cpp
#include <hip/hip_runtime.h>
#include <hip/hip_cooperative_groups.h>
#include <stdint.h>
namespace cg = cooperative_groups;
#ifndef PROBE_REP_PREP
#define PROBE_REP_PREP 1
#define PROBE_REP_PROJ 1
#define PROBE_REP_GLAA 1
#define PROBE_REP_GLAC 1
#define PROBE_REP_DSA 1
#define PROBE_REP_OUT 1
#define PROBE_REP_LN 1
#define PROBE_DSA_A 1
#define PROBE_DSA_B 1
#define PROBE_DSA_C 1
#endif

constexpr int D = 1024, NB = 8, SEQ = 2048, NMETA = 16, L = 2064, T = NB * L;
constexpr int DEPTH = 2;
constexpr int INW = 3416, INWP = 3584;
constexpr int TP = 16640;
constexpr int NT = 512;
constexpr int TOPK = 256;
constexpr float LN_EPS = 1e-5f;
constexpr float ALPHA = 1.41421356237309515f;

typedef unsigned short bf16_t;
typedef short bf16x8 __attribute__((ext_vector_type(8)));
typedef float f32x4 __attribute__((ext_vector_type(4)));
#define LAS __attribute__((address_space(3)))

constexpr size_t SZ_H32 = (size_t)T * D * 4;
constexpr size_t SZ_HB = (size_t)TP * D * 2;
constexpr size_t SZ_WIN = (size_t)DEPTH * INWP * D * 2;
constexpr size_t SZ_WOUT = (size_t)DEPTH * D * D * 2;
constexpr int LPV = 2112;
constexpr size_t SZ_GQ = (size_t)T * 256 * 2, SZ_GK = SZ_GQ, SZ_GV = (size_t)NB * 4 * 128 * LPV * 2;
constexpr size_t SZ_UT = (size_t)1024 * 128 * 64 * 4, SZ_ST = (size_t)32 * 33 * 128 * 64 * 2, SZ_DL = (size_t)1024 * 64 * 4;
constexpr size_t SZ_AQ = (size_t)T * 512 * 2, SZ_IQ = (size_t)T * 512 * 2;
constexpr size_t SZ_MIX = (size_t)TP * 1024 * 2;
constexpr int LP = 2112;
constexpr size_t SZ_AK = (size_t)T * 128 * 2, SZ_AV = (size_t)NB * 2 * 64 * LP * 2, SZ_IK = (size_t)T * 64 * 2, SZ_IW = (size_t)T * 8 * 4;
constexpr size_t SZ_GLR = (size_t)T * 16 * 4;
constexpr size_t SZ_ROPE = (size_t)L * 8 * 2 * 4;

constexpr size_t OFF_H32 = 0;
constexpr size_t OFF_HB = OFF_H32 + SZ_H32;
constexpr size_t OFF_WIN = OFF_HB + SZ_HB;
constexpr size_t OFF_WOUT = OFF_WIN + SZ_WIN;
constexpr size_t OFF_GQ = OFF_WOUT + SZ_WOUT;
constexpr size_t OFF_GK = OFF_GQ + SZ_GQ;
constexpr size_t OFF_GV = OFF_GK + SZ_GK;
constexpr size_t OFF_AQ = OFF_GV + SZ_GV;
constexpr size_t OFF_IQ = OFF_AQ + SZ_AQ;
constexpr size_t OFF_MIX = OFF_IQ + SZ_IQ;
constexpr size_t OFF_AK = OFF_MIX + SZ_MIX;
constexpr size_t OFF_AV = OFF_AK + SZ_AK;
constexpr size_t OFF_IK = OFF_AV + SZ_AV;
constexpr size_t OFF_IW = OFF_IK + SZ_IK;
constexpr size_t OFF_GLR = OFF_IW + SZ_IW;
constexpr size_t OFF_ROPE = OFF_GLR + SZ_GLR;
constexpr size_t OFF_ST = OFF_ROPE + SZ_ROPE;
constexpr size_t OFF_DL = OFF_ST + SZ_ST;
constexpr size_t OFF_BAR = OFF_DL + SZ_DL;
constexpr size_t OFF_IKR = OFF_BAR + 16384;
constexpr size_t OFF_END = OFF_IKR + (size_t)T * 64 * 4;
constexpr size_t OFF_UT = OFF_HB;
static_assert(SZ_UT <= SZ_HB, "UT alias");
static_assert(SZ_GQ + SZ_GK + SZ_GV + SZ_AQ + SZ_IQ >= SZ_H32, "Z alias size");
static_assert(OFF_END <= (size_t)256 * 1024 * 1024, "workspace too large");

struct Params {
    const float* x; const float* meta; const float* ln_in_g; const float* ln_in_b;
    const float* w_in; const float* wg2; const float* bg; const float* norm_g;
    const float* ikg; const float* ikb; const float* w_out; const float* ln_g; const float* ln_b;
    float* out; char* ws;
};
typedef const Params __attribute__((address_space(4))) * KParamsPtr;
__device__ __forceinline__ Params kparams() {
    unsigned long long a = (unsigned long long)__builtin_amdgcn_kernarg_segment_ptr();
    asm volatile("" : "+s"(a));
    KParamsPtr q = (KParamsPtr)a;
    Params r;
    r.x = q->x; r.meta = q->meta; r.ln_in_g = q->ln_in_g; r.ln_in_b = q->ln_in_b; r.w_in = q->w_in; r.wg2 = q->wg2; r.bg = q->bg; r.norm_g = q->norm_g;
    r.ikg = q->ikg; r.ikb = q->ikb; r.w_out = q->w_out; r.ln_g = q->ln_g; r.ln_b = q->ln_b; r.out = q->out; r.ws = q->ws;
    return r;
}

__device__ __forceinline__ bf16_t f2bf(float f) {
    unsigned u = __float_as_uint(f);
    u += 0x7FFFu + ((u >> 16) & 1u);
    return (bf16_t)(u >> 16);
}
__device__ __forceinline__ unsigned pack2bf(float lo, float hi) { return (unsigned)f2bf(lo) | ((unsigned)f2bf(hi) << 16); }
__device__ __forceinline__ unsigned cvt_pk_bf16(float lo, float hi) { unsigned r; asm volatile("v_cvt_pk_bf16_f32 %0, %1, %2" : "=v"(r) : "v"(lo), "v"(hi)); return r; }
typedef unsigned u32x4 __attribute__((ext_vector_type(4)));
typedef unsigned u32x2 __attribute__((ext_vector_type(2)));
__device__ __forceinline__ float bf2f(bf16_t h) { return __uint_as_float(((unsigned)h) << 16); }
__device__ __forceinline__ int opaque_tid() { int t = threadIdx.x; asm volatile("" : "+v"(t)); return t; }
__device__ __forceinline__ int opaque_int(int v) { asm volatile("" : "+s"(v)); return v; }
__device__ __forceinline__ int opaque_bid() { int t = blockIdx.x; asm volatile("" : "+s"(t)); return t; }
__device__ __forceinline__ float wave_sum(float v) {
#pragma unroll
    for (int o = 32; o > 0; o >>= 1) v += __shfl_xor(v, o);
    return v;
}
__device__ __forceinline__ float wave_max(float v) {
#pragma unroll
    for (int o = 32; o > 0; o >>= 1) v = fmaxf(v, __shfl_xor(v, o));
    return v;
}
__device__ __forceinline__ float block_sum(float v, float* red) {
    v = wave_sum(v);
    const int tq = opaque_tid();
    __syncthreads();
    if ((tq & 63) == 0) red[tq >> 6] = v;
    __syncthreads();
    return ((red[0] + red[1]) + (red[2] + red[3])) + ((red[4] + red[5]) + (red[6] + red[7]));
}
__device__ __forceinline__ float silu_f(float x) { return x / (1.f + __expf(-x)); }
__device__ __forceinline__ float logsigmoid_f(float x) { return fminf(x, 0.f) - log1pf(expf(-fabsf(x))); }
__device__ __forceinline__ float logsigmoid_fast(float x) { return fminf(x, 0.f) - __logf(1.f + __expf(-fabsf(x))); }

__device__ __forceinline__ int proj_src_col(int n) {
    if (n < 1024) return n;
    if (n < 1536) return n - 1024 + 1040;
    if (n < 2048) return n - 1536 + 1552;
    if (n < 2560) return n - 2048 + 2904;
    if (n < 3072) return n - 2560 + 2320;
    if (n < 3200) return n - 3072 + 2064;
    if (n < 3328) return n - 3200 + 2192;
    const int c = n - 3328;
    if (c < 32) return 2832 + c;
    if (c < 48) return 1024 + (c - 32);
    if (c < 56) return 2896 + (c - 48);
    if (c >= 128 && c < 160) return 2832 + 32 + (c - 128);
    return -1;
}

__device__ __forceinline__ void sincos_acc(float a, float& s, float& c) {
    double ad = (double)a;
    double kd = rint(ad * 0.63661977236758134308);
    double r = fma(-kd, 1.57079632679489655800, ad);
    r = fma(-kd, 6.12323399573676603587e-17, r);
    double r2 = r * r;
    double sp = r * (1.0 + r2 * (-1.0 / 6 + r2 * (1.0 / 120 + r2 * (-1.0 / 5040 + r2 * (1.0 / 362880 + r2 * (-1.0 / 39916800))))));
    double cp = 1.0 + r2 * (-0.5 + r2 * (1.0 / 24 + r2 * (-1.0 / 720 + r2 * (1.0 / 40320 + r2 * (-1.0 / 3628800 + r2 * (1.0 / 479001600))))));
    int q = ((int)kd) & 3;
    double ss = (q & 1) ? cp : sp, cc = (q & 1) ? sp : cp;
    if (q == 1 || q == 2) cc = -cc;
    if (q == 2 || q == 3) ss = -ss;
    s = (float)ss; c = (float)cc;
}

__device__ __forceinline__ void ln_row_wave(f32x4 (&v)[4], const float* g, const float* bb, int lane) {
    float sm = 0.f;
#pragma unroll
    for (int i = 0; i < 4; ++i) sm += (v[i][0] + v[i][1]) + (v[i][2] + v[i][3]);
    const float mu = wave_sum(sm) * (1.f / D);
    float qq = 0.f;
#pragma unroll
    for (int i = 0; i < 4; ++i) { v[i] = v[i] - mu; qq += (v[i][0] * v[i][0] + v[i][1] * v[i][1]) + (v[i][2] * v[i][2] + v[i][3] * v[i][3]); }
    const float rs = rsqrtf(wave_sum(qq) * (1.f / D) + LN_EPS);
#pragma unroll
    for (int i = 0; i < 4; ++i) { const f32x4 gg = *(const f32x4*)(g + 4 * lane + 256 * i), b4 = *(const f32x4*)(bb + 4 * lane + 256 * i); v[i] = v[i] * rs * gg + b4; }
}
__device__ __forceinline__ int proj_dst_col(int src) {
    if (src < 1024) return src;
    if (src < 1040) return 3328 + 32 + (src - 1024);
    if (src < 1552) return 1024 + (src - 1040);
    if (src < 2064) return 1536 + (src - 1552);
    if (src < 2192) return 3072 + (src - 2064);
    if (src < 2320) return 3200 + (src - 2192);
    if (src < 2832) return 2560 + (src - 2320);
    if (src < 2864) return 3328 + (src - 2832);
    if (src < 2896) return 3328 + 128 + (src - 2864);
    if (src < 2904) return 3328 + 48 + (src - 2896);
    return 2048 + (src - 2904);
}
__device__ __forceinline__ void phase_prep(const Params& p_in, char* smem) {
    const Params p = kparams(); (void)p_in;
    const int tid = opaque_tid(), wid = tid >> 6, lane = tid & 63;
    bf16_t* WIN = (bf16_t*)(p.ws + OFF_WIN);
    bf16_t* WOUT = (bf16_t*)(p.ws + OFF_WOUT);
    float* H32 = (float*)(p.ws + OFF_H32);
    bf16_t* HB = (bf16_t*)(p.ws + OFF_HB);
    bf16_t* MIX = (bf16_t*)(p.ws + OFF_MIX);
    float2* ROPE = (float2*)(p.ws + OFF_ROPE);
    float (*tile)[65] = (float (*)[65])smem;
    constexpr int NCT_IN = (INW + 63) / 64, NT_IN = DEPTH * 16 * NCT_IN, NT_OUT = DEPTH * 16 * 16;
    for (int item = opaque_bid(); item < NT_IN + NT_OUT; item += gridDim.x) {
        const bool is_in = item < NT_IN;
        const int it = is_in ? item : item - NT_IN;
        const int nct = is_in ? NCT_IN : 16, ldw = is_in ? INW : D;
        const int l = it / (16 * nct), rem = it - l * 16 * nct, kt = rem / nct, ct = rem - kt * nct;
        const float* W = (is_in ? p.w_in : p.w_out) + (size_t)l * D * ldw;
        __syncthreads();
#pragma unroll
        for (int i = 0; i < 8; ++i) {
            const int e = tid + NT * i, kk = e >> 6, nn = e & 63, col = ct * 64 + nn;
            tile[kk][nn] = (col < ldw) ? W[(size_t)(kt * 64 + kk) * ldw + col] : 0.f;
        }
        __syncthreads();
        {
            const int nn = tid >> 3, k8 = (tid & 7) * 8, src = ct * 64 + nn;
            if (src < ldw) {
                const int dst = is_in ? proj_dst_col(src) : src;
                u32x4 o;
#pragma unroll
                for (int q = 0; q < 4; ++q) o[q] = cvt_pk_bf16(tile[k8 + 2 * q][nn], tile[k8 + 2 * q + 1][nn]);
                bf16_t* dstp = (is_in ? WIN + ((size_t)l * INWP + dst) * D : WOUT + ((size_t)l * D + dst) * D) + kt * 64 + k8;
                *(u32x4*)dstp = o;
            }
        }
    }
    {
        const int nw = gridDim.x * 8;
        for (int t = opaque_bid() * 8 + wid; t < TP; t += nw) {
            if (t < T) {
                const int b = t / L, pos = t - b * L;
                const float* src = (pos < NMETA) ? (p.meta + (size_t)pos * D) : (p.x + ((size_t)b * SEQ + (pos - NMETA)) * D);
                f32x4 v[4];
#pragma unroll
                for (int i = 0; i < 4; ++i) v[i] = *(const f32x4*)(src + 4 * lane + 256 * i);
                ln_row_wave(v, p.ln_in_g, p.ln_in_b, lane);
#pragma unroll
                for (int i = 0; i < 4; ++i) {
                    *(f32x4*)(H32 + (size_t)t * D + 4 * lane + 256 * i) = v[i];
                    u32x2 o; o[0] = cvt_pk_bf16(v[i][0], v[i][1]); o[1] = cvt_pk_bf16(v[i][2], v[i][3]);
                    *(u32x2*)(HB + (size_t)t * D + 4 * lane + 256 * i) = o;
                }
            } else {
#pragma unroll
                for (int i = 0; i < 4; ++i) {
                    *(u32x2*)(HB + (size_t)t * D + 4 * lane + 256 * i) = (u32x2){0u, 0u};
                    *(u32x2*)(MIX + (size_t)t * D + 4 * lane + 256 * i) = (u32x2){0u, 0u};
                }
            }
        }
    }
    for (int e = opaque_bid() * NT + tid; e < L * 8; e += gridDim.x * NT) {
        const int pos = e >> 3, i = e & 7;
        const float inv[8] = {1.0f, 0.19392274f, 0.03760603f, 0.0072926646f, 0.0014142136f, 0.0002742482f, 5.3182957e-05f, 1.0313385e-05f};
        float iv = inv[0];
#pragma unroll
        for (int j = 1; j < 8; ++j) iv = (i == j) ? inv[j] : iv;
        const float ang = (float)pos * iv;
        float sn, cs; sincos_acc(ang, sn, cs);
        ROPE[e] = make_float2(cs, sn);
    }
}

namespace pg8 {
constexpr int BM = 256, BK = 64, HALF = 128, HTB = HALF * BK * 2  , STAGE_BYTES = 8 * HTB, NXCD = 8, WGM = 8;
__device__ __forceinline__ int lds_byte(int r, int c) { const int st = (r >> 4) * 2 + (c >> 5), rr = r & 15, cc = c & 31, ob = rr * 64 + cc * 2; return st * 1024 + (ob ^ (((ob >> 9) & 1) << 5)); }
__device__ __forceinline__ void stage_rc(int b, int& R, int& C) { const int st = b / 1024, sb = b % 1024, swz = sb ^ (((sb >> 9) & 1) << 5); R = (st >> 1) * 16 + swz / 64; C = (st & 1) * 32 + (swz % 64) / 2; }
__device__ __forceinline__ int perm32(int rho) { const int n = rho >> 4, i = rho & 15; return 8 * (i >> 2) + 4 * n + (i & 3); }

struct Unit { int pm, pn; };
struct Gemm { const bf16_t* A; const bf16_t* Bt; int M, N, K; };

struct StaticOrder {
    int nM, nN, nwg, G, c;
    __device__ void init(int M, int N, int G_, int c_) { nM = M / BM; nN = N / BM; nwg = nM * nN; G = G_; c = c_; }
    __device__ bool next(int i, Unit& u) const {
        const long Lx = (long)i * G + c; if (Lx >= nwg) return false;
        int wgid = (int)Lx; { const int q = nwg / NXCD, r = nwg % NXCD, xcd = wgid % NXCD, off = wgid / NXCD; wgid = (xcd < r ? xcd * (q + 1) : r * (q + 1) + (xcd - r) * q) + off; }
        const int nig = WGM * nN, gid = wgid / nig, fm = gid * WGM, gsz = (nM - fm) < WGM ? (nM - fm) : WGM;
        u.pm = fm + ((wgid % nig) % gsz); u.pn = (wgid % nig) / gsz; return true;
    }
    __device__ __forceinline__ void a_ready(const Unit&) const {}
    __device__ __forceinline__ void done(const Unit&) const {}
};

template <class Epi, class Sched>
__device__ __forceinline__ void gemm_phase(LAS unsigned char* lds, const Gemm g, const Sched& S, const Epi& E) {
    const int tid = opaque_tid(), wid = __builtin_amdgcn_readfirstlane(tid >> 6), lane = tid & 63, wr = wid >> 2, wc = wid & 3, fr = lane & 15, fq = lane >> 4;
    const int K = g.K, nt = K / BK;
    unsigned voffA[2], voffB[2];
#pragma unroll
    for (int i = 0; i < 2; ++i) { int R, C; stage_rc(tid * 16 + i * 8192, R, C); const int Rb = Epi::PERM ? ((R & ~31) + perm32(R & 31)) : R;
        voffA[i] = (unsigned)(R * K + C) * 2u; voffB[i] = (unsigned)(Rb * K + C) * 2u; }
    const size_t kstep = (size_t)(BK * 2);
    const size_t hstep = (size_t)HALF * K * 2;
    const size_t tstep = 2 * hstep;
    const unsigned ldsw = (unsigned)wid * 1024u;
    const int aoff = lds_byte(wr * 64 + fr, fq * 8), boff = lds_byte(wc * 32 + fr, fq * 8);
#define PG8_SA(b, h) (((b) * 2 + (h)) * HTB)
#define PG8_SB(b, h) ((4 + (b) * 2 + (h)) * HTB)
#define PG8_STAGE(bufoff, gbase, voff) do { _Pragma("unroll") for (int _i = 0; _i < 2; ++_i) \
        __builtin_amdgcn_global_load_lds((const unsigned*)((const char*)(gbase) + (voff)[_i]), (LAS unsigned*)(lds + (bufoff) + ldsw + _i * 8192), 16, 0, 0); } while (0)
#define PG8_LDA(dst, b, h) do { _Pragma("unroll") for (int m = 0; m < 4; ++m) _Pragma("unroll") for (int k = 0; k < 2; ++k) dst[m][k] = *(const LAS bf16x8*)(lds + PG8_SA(b, h) + aoff + m * 2048 + k * 1024); } while (0)
#define PG8_LDB(dst, b, h) do { _Pragma("unroll") for (int n = 0; n < 2; ++n) _Pragma("unroll") for (int k = 0; k < 2; ++k) dst[n][k] = *(const LAS bf16x8*)(lds + PG8_SB(b, h) + boff + n * 2048 + k * 1024); } while (0)
#define PG8_MMA(ai, bj, At, Bt) do { __builtin_amdgcn_s_setprio(1); _Pragma("unroll") for (int m = 0; m < 4; ++m) _Pragma("unroll") for (int n = 0; n < 2; ++n) _Pragma("unroll") for (int k = 0; k < 2; ++k) \
        acc[ai][bj][m][n] = __builtin_amdgcn_mfma_f32_16x16x32_bf16(Bt[n][k], At[m][k], acc[ai][bj][m][n], 0, 0, 0); __builtin_amdgcn_s_setprio(0); } while (0)
#define PG8_WAIT_V(n) asm volatile("s_waitcnt vmcnt(" #n ")" ::: "memory")
#define PG8_WAIT_L(n) asm volatile("s_waitcnt lgkmcnt(" #n ")" ::: "memory")
#define PG8_BAR __builtin_amdgcn_s_barrier()
#define PG8_SCHED __builtin_amdgcn_sched_barrier(0)
    Unit cur, nxt; int ui = 0;
    if (!S.next(0, cur)) return;
    f32x4 acc[2][2][4][2];
#pragma unroll
    for (int a = 0; a < 2; ++a)
#pragma unroll
        for (int b = 0; b < 2; ++b)
#pragma unroll
            for (int m = 0; m < 4; ++m)
#pragma unroll
                for (int n = 0; n < 2; ++n) acc[a][b][m][n] = (f32x4){0.f, 0.f, 0.f, 0.f};
    bf16x8 At[4][2], B0[2][2], B1[2][2];
    const char* cA = (const char*)g.A + (size_t)cur.pm * tstep; const char* cB = (const char*)g.Bt + (size_t)cur.pn * tstep;
    S.a_ready(cur);
    PG8_STAGE(PG8_SB(0, 0), cB, voffB); PG8_STAGE(PG8_SA(0, 0), cA, voffA); PG8_STAGE(PG8_SB(0, 1), cB + hstep, voffB); PG8_STAGE(PG8_SA(0, 1), cA + hstep, voffA);
    if (wr == 1) PG8_BAR;
    PG8_WAIT_V(4); PG8_BAR;
    PG8_STAGE(PG8_SB(1, 0), cB + kstep, voffB); PG8_STAGE(PG8_SA(1, 0), cA + kstep, voffA); PG8_STAGE(PG8_SB(1, 1), cB + hstep + kstep, voffB);
    PG8_WAIT_V(6); PG8_BAR;
    for (;;) {
        const bool has_next = S.next(ui + 1, nxt);
        const char* nA = has_next ? (const char*)g.A + (size_t)nxt.pm * tstep : cA; const char* nB = has_next ? (const char*)g.Bt + (size_t)nxt.pn * tstep : cB;
        for (int t = 0; t < nt; t += 2) {
            const bool last = (t == nt - 2);
            const char* a1 = cA + (size_t)(t + 1) * kstep;
            const char* a2 = last ? nA : cA + (size_t)(t + 2) * kstep; const char* b2 = last ? nB : cB + (size_t)(t + 2) * kstep;
            const char* a3 = a2 + kstep; const char* b3 = b2 + kstep;
            if (last && has_next) S.a_ready(nxt);
            PG8_LDB(B0, 0, 0); PG8_SCHED; PG8_LDA(At, 0, 0); PG8_STAGE(PG8_SA(1, 1), a1 + hstep, voffA);
            PG8_WAIT_L(8); PG8_BAR; PG8_WAIT_L(0); PG8_MMA(0, 0, At, B0); PG8_BAR; PG8_SCHED;
            PG8_LDB(B1, 0, 1); PG8_STAGE(PG8_SB(0, 0), b2, voffB);
            PG8_BAR; PG8_WAIT_L(0); PG8_MMA(0, 1, At, B1); PG8_BAR;
            PG8_LDA(At, 0, 1); PG8_STAGE(PG8_SA(0, 0), a2, voffA);
            PG8_BAR; PG8_WAIT_L(0); PG8_MMA(1, 0, At, B0); PG8_BAR; PG8_SCHED;
            PG8_STAGE(PG8_SB(0, 1), b2 + hstep, voffB);
            PG8_WAIT_V(6); PG8_BAR; PG8_MMA(1, 1, At, B1); PG8_BAR;
            PG8_LDB(B0, 1, 0); PG8_SCHED; PG8_LDA(At, 1, 0); PG8_STAGE(PG8_SA(0, 1), a2 + hstep, voffA);
            PG8_WAIT_L(8); PG8_BAR; PG8_WAIT_L(0); PG8_MMA(0, 0, At, B0); PG8_BAR; PG8_SCHED;
            PG8_LDB(B1, 1, 1); PG8_STAGE(PG8_SB(1, 0), b3, voffB);
            PG8_BAR; PG8_WAIT_L(0); PG8_MMA(0, 1, At, B1); PG8_BAR;
            PG8_LDA(At, 1, 1); PG8_STAGE(PG8_SA(1, 0), a3, voffA);
            PG8_BAR; PG8_WAIT_L(0); PG8_MMA(1, 0, At, B0); PG8_BAR; PG8_SCHED;
            PG8_STAGE(PG8_SB(1, 1), b3 + hstep, voffB);
            PG8_WAIT_V(6); PG8_BAR; PG8_MMA(1, 1, At, B1); PG8_BAR;
        }
        E(acc, cur, wr, wc, fr, fq); S.done(cur);
        if (!has_next) break;
#pragma unroll
        for (int a = 0; a < 2; ++a)
#pragma unroll
            for (int b = 0; b < 2; ++b)
#pragma unroll
                for (int m = 0; m < 4; ++m)
#pragma unroll
                    for (int n = 0; n < 2; ++n) acc[a][b][m][n] = (f32x4){0.f, 0.f, 0.f, 0.f};
        cur = nxt; cA = nA; cB = nB; ++ui;
    }
    PG8_WAIT_V(0);
    if (wr == 0) PG8_BAR;
    PG8_BAR;
#undef PG8_SA
#undef PG8_SB
#undef PG8_STAGE
#undef PG8_LDA
#undef PG8_LDB
#undef PG8_MMA
#undef PG8_WAIT_V
#undef PG8_WAIT_L
#undef PG8_BAR
#undef PG8_SCHED
}
}

struct EpiProj {
    static constexpr bool PERM = true;
    char* ws;
    __device__ __forceinline__ void store8(bf16_t* dst, const f32x4& a, const f32x4& b, float sc) const {
        u32x4 o; o[0] = cvt_pk_bf16(a[0] * sc, a[1] * sc); o[1] = cvt_pk_bf16(a[2] * sc, a[3] * sc); o[2] = cvt_pk_bf16(b[0] * sc, b[1] * sc); o[3] = cvt_pk_bf16(b[2] * sc, b[3] * sc);
        *(u32x4*)dst = o;
    }
    __device__ __forceinline__ void operator()(const f32x4 (&acc)[2][2][4][2], const pg8::Unit& u, int wr, int wc, int fr, int fq) const {
        asm volatile("" : "+v"(fr), "+v"(fq));
        if (u.pn < 13) {
#pragma unroll
            for (int bj = 0; bj < 2; ++bj) {
                const int hb = 4 * u.pn + 2 * bj + (wc >> 1);
                const int cc8 = 32 * (wc & 1) + 8 * fq;
#pragma unroll
                for (int ai = 0; ai < 2; ++ai)
#pragma unroll
                    for (int m = 0; m < 4; ++m) {
                        const int t = 256 * u.pm + 128 * ai + 64 * wr + 16 * m + fr;
                        const f32x4 v0 = acc[ai][bj][m][0], v1 = acc[ai][bj][m][1];
                        if (t < T) {
                            const size_t tt = (size_t)t;
                            if (hb < 4) store8((bf16_t*)(ws + OFF_GQ) + tt * 256 + hb * 64 + cc8, v0, v1, 0.125f);
                            else if (hb < 8) store8((bf16_t*)(ws + OFF_GK) + tt * 256 + (hb - 4) * 64 + cc8, v0, v1, 1.f);
                            else if (hb < 16) {
                                const int bq = t / L, pos = t - bq * L;
                                bf16_t* dst = (bf16_t*)(ws + OFF_GV) + ((size_t)(bq * 4 + ((hb - 8) >> 1)) * 128 + ((hb - 8) & 1) * 64 + cc8) * LPV + 48 + pos;
#pragma unroll
                                for (int j = 0; j < 4; ++j) { dst[(size_t)j * LPV] = f2bf(v0[j]); dst[(size_t)(4 + j) * LPV] = f2bf(v1[j]); }
                            }
                            else if (hb < 24 || (hb >= 32 && hb < 40)) {
                                f32x4 s0, s1;
#pragma unroll
                                for (int j = 0; j < 4; ++j) { s0[j] = silu_f(v0[j]); s1[j] = silu_f(v1[j]); }
                                const int col = (hb < 24) ? (hb - 16) * 64 : 512 + (hb - 32) * 64;
                                store8((bf16_t*)(ws + OFF_MIX) + tt * 1024 + col + cc8, s0, s1, 1.f);
                            }
                            else if (hb < 32) store8((bf16_t*)(ws + OFF_AQ) + tt * 512 + (hb - 24) * 64 + cc8, v0, v1, 0.125f);
                            else if (hb < 48) store8((bf16_t*)(ws + OFF_IQ) + tt * 512 + (hb - 40) * 64 + cc8, v0, v1, 0.125f);
                            else if (hb < 50) store8((bf16_t*)(ws + OFF_AK) + tt * 128 + (hb - 48) * 64 + cc8, v0, v1, 1.f);
                            else {
                                const int bq = t / L, pos = t - bq * L;
                                bf16_t* dst = (bf16_t*)(ws + OFF_AV) + ((size_t)(bq * 2 + (hb - 50)) * 64 + cc8) * LP + pos;
#pragma unroll
                                for (int j = 0; j < 4; ++j) { dst[(size_t)j * LP] = f2bf(v0[j]); dst[(size_t)(4 + j) * LP] = f2bf(v1[j]); }
                            }
                        }
                        asm volatile("" ::: "memory");
                    }
            }
        } else {
#pragma unroll
            for (int ai = 0; ai < 2; ++ai)
#pragma unroll
                for (int m = 0; m < 4; ++m) {
                    const int t = 256 * u.pm + 128 * ai + 64 * wr + 16 * m + fr;
                    if (t < T) {
                        if (wc == 0) {
                            float* dst = (float*)(ws + OFF_IKR) + (size_t)t * 64 + 8 * fq;
                            *(f32x4*)dst = acc[ai][0][m][0]; *(f32x4*)(dst + 4) = acc[ai][0][m][1];
                            *(f32x4*)(dst + 32) = acc[ai][1][m][0]; *(f32x4*)(dst + 36) = acc[ai][1][m][1];
                        } else if (wc == 1) {
                            const f32x4 v0 = acc[ai][0][m][0], v1 = acc[ai][0][m][1];
                            if (fq < 2) {
                                float* dst = (float*)(ws + OFF_GLR) + (size_t)t * 16 + 8 * fq;
                                *(f32x4*)dst = v0; *(f32x4*)(dst + 4) = v1;
                            } else if (fq == 2) {
                                float* dst = (float*)(ws + OFF_IW) + (size_t)t * 8;
                                *(f32x4*)dst = v0 * 0.353553390593273762f; *(f32x4*)(dst + 4) = v1 * 0.353553390593273762f;
                            }
                        }
                    }
                    asm volatile("" ::: "memory");
                }
        }
    }
};

struct EpiOut {
    static constexpr bool PERM = false;
    const float* H32; float* Z;
    __device__ __forceinline__ void operator()(const f32x4 (&acc)[2][2][4][2], const pg8::Unit& u, int wr, int wc, int fr, int fq) const {
        asm volatile("" : "+v"(fr), "+v"(fq));
        const int col0 = u.pn * 256 + wc * 32 + 4 * fq;
#pragma unroll
        for (int ai = 0; ai < 2; ++ai) {
            f32x4 hv[4][2][2];
#pragma unroll
            for (int m = 0; m < 4; ++m) {
                int t = 256 * u.pm + 128 * ai + 64 * wr + 16 * m + fr; t = t < T ? t : T - 1;
                const size_t off = (size_t)t * D + col0;
#pragma unroll
                for (int bj = 0; bj < 2; ++bj)
#pragma unroll
                    for (int n = 0; n < 2; ++n) hv[m][bj][n] = *(const f32x4*)(H32 + off + bj * 128 + n * 16);
            }
#pragma unroll
            for (int m = 0; m < 4; ++m) {
                const int t = 256 * u.pm + 128 * ai + 64 * wr + 16 * m + fr;
                if (t < T) {
                    const size_t off = (size_t)t * D + col0;
#pragma unroll
                    for (int bj = 0; bj < 2; ++bj)
#pragma unroll
                        for (int n = 0; n < 2; ++n) *(f32x4*)(Z + off + bj * 128 + n * 16) = acc[ai][bj][m][n] + hv[m][bj][n] * ALPHA;
                }
            }
            asm volatile("" ::: "memory");
        }
    }
};

__device__ __forceinline__ void phase_proj(const Params& p_in, int layer_in, char* smem) {
    const Params p = kparams(); const int layer = opaque_int(layer_in); (void)p_in;
    pg8::Gemm g; g.A = (const bf16_t*)(p.ws + OFF_HB); g.Bt = (const bf16_t*)(p.ws + OFF_WIN) + (size_t)layer * INWP * D; g.M = TP; g.N = INWP; g.K = D;
    pg8::StaticOrder S; S.init(TP, INWP, gridDim.x, opaque_bid());
    EpiProj E; E.ws = p.ws;
    pg8::gemm_phase((LAS unsigned char*)smem, g, S, E);
}
__device__ __forceinline__ void phase_outproj(const Params& p_in, int layer_in, char* smem) {
    const Params p = kparams(); const int layer = opaque_int(layer_in); (void)p_in;
    const bf16_t* MIXp = (const bf16_t*)(p.ws + OFF_MIX);
    const bf16_t* WOUT = (const bf16_t*)(p.ws + OFF_WOUT) + (size_t)layer * D * D;
    const float* H32 = (const float*)(p.ws + OFF_H32);
    float* Z = (float*)(p.ws + OFF_GQ);
    {
        pg8::Gemm g; g.A = MIXp; g.Bt = WOUT; g.M = 16384; g.N = D; g.K = D;
        pg8::StaticOrder S; S.init(16384, D, gridDim.x, opaque_bid());
        EpiOut E; E.H32 = H32; E.Z = Z;
        pg8::gemm_phase((LAS unsigned char*)smem, g, S, E);
    }
    const int tid = opaque_tid(), wid = __builtin_amdgcn_readfirstlane(tid >> 6), lane = tid & 63, fr = lane & 15, fq = lane >> 4;
    for (int task = opaque_bid(); task < 64; task += gridDim.x) {
        const int rg = task >> 3, cs = task & 7;
        const bf16_t* ap = MIXp + (size_t)(16384 + 16 * rg + fr) * D + 8 * fq;
        const bf16_t* bp = WOUT + (size_t)(128 * cs + 16 * wid + fr) * D + 8 * fq;
        f32x4 acc = {0.f, 0.f, 0.f, 0.f};
        bf16x8 a0[8], b0[8], a1[8], b1[8];
#pragma unroll
        for (int k = 0; k < 8; ++k) { a0[k] = *(const bf16x8*)(ap + 32 * k); b0[k] = *(const bf16x8*)(bp + 32 * k); }
#pragma unroll
        for (int ch = 0; ch < 4; ++ch) {
            if (ch < 3) {
#pragma unroll
                for (int k = 0; k < 8; ++k) { a1[k] = *(const bf16x8*)(ap + 256 * (ch + 1) + 32 * k); b1[k] = *(const bf16x8*)(bp + 256 * (ch + 1) + 32 * k); }
            }
#pragma unroll
            for (int k = 0; k < 8; ++k) acc = __builtin_amdgcn_mfma_f32_16x16x32_bf16(a0[k], b0[k], acc, 0, 0, 0);
#pragma unroll
            for (int k = 0; k < 8; ++k) { a0[k] = a1[k]; b0[k] = b1[k]; }
        }
#pragma unroll
        for (int r = 0; r < 4; ++r) {
            const size_t off = (size_t)(16384 + 16 * rg + 4 * fq + r) * D + 128 * cs + 16 * wid + fr;
            Z[off] = acc[r] + ALPHA * H32[off];
        }
    }
}

__device__ __forceinline__ void phase_gla_naive(const Params& p, int layer, char* smem) {
    float (*qs)[64] = (float (*)[64])smem;
    float (*ks)[64] = qs + 8;
    float (*es)[64] = ks + 8;
    float (*part)[8] = (float (*)[8])(es + 8);
    float (*os)[128] = (float (*)[128])(part + 2);
    const int tid = opaque_tid();
    const bf16_t* GQ = (const bf16_t*)(p.ws + OFF_GQ);
    const bf16_t* GK = (const bf16_t*)(p.ws + OFF_GK);
    const bf16_t* GV = (const bf16_t*)(p.ws + OFF_GV);
    const float* GLR = (const float*)(p.ws + OFF_GLR);
    bf16_t* MIX = (bf16_t*)(p.ws + OFF_MIX);
    const float* ng = p.norm_g + layer * 128;
    const float* wg2 = p.wg2 + (size_t)layer * 16 * 256; const float* bg = p.bg + layer * 256;
    for (int item = opaque_bid(); item < NB * 4; item += gridDim.x) {
        const int b = item >> 2, h = item & 3;
        float S[64];
#pragma unroll
        for (int d = 0; d < 64; ++d) S[d] = 0.f;
        const int e = tid & 127;
        const float nge = ng[e];
        const int ltt = tid >> 6, ld = tid & 63;
        float w[16];
#pragma unroll
        for (int rr = 0; rr < 16; ++rr) w[rr] = wg2[rr * 256 + h * 64 + ld];
        const float bgd = bg[h * 64 + ld];
        for (int t0 = 0; t0 < L; t0 += 8) {
            __syncthreads();
            {
                const size_t row = (size_t)b * L + t0 + ltt;
                qs[ltt][ld] = bf2f(GQ[row * 256 + h * 64 + ld]);
                ks[ltt][ld] = bf2f(GK[row * 256 + h * 64 + ld]);
                const float4* gp = (const float4*)&GLR[row * 16];
                const float4 g0 = gp[0], g1 = gp[1], g2 = gp[2], g3 = gp[3];
                float s = bgd;
                s = fmaf(g0.x, w[0], s); s = fmaf(g0.y, w[1], s); s = fmaf(g0.z, w[2], s); s = fmaf(g0.w, w[3], s);
                s = fmaf(g1.x, w[4], s); s = fmaf(g1.y, w[5], s); s = fmaf(g1.z, w[6], s); s = fmaf(g1.w, w[7], s);
                s = fmaf(g2.x, w[8], s); s = fmaf(g2.y, w[9], s); s = fmaf(g2.z, w[10], s); s = fmaf(g2.w, w[11], s);
                s = fmaf(g3.x, w[12], s); s = fmaf(g3.y, w[13], s); s = fmaf(g3.z, w[14], s); s = fmaf(g3.w, w[15], s);
                es[ltt][ld] = expf(logsigmoid_f(s) * (1.f / 16.f));
            }
            __syncthreads();
            if (tid < 128) {
#pragma unroll 1
                for (int tt = 0; tt < 8; ++tt) {
                    const size_t row = (size_t)b * L + t0 + tt;
                    const float v = bf2f(GV[row * 512 + h * 128 + e]);
                    float acc = 0.f;
#pragma unroll
                    for (int d = 0; d < 64; ++d) {
                        S[d] = fmaf(es[tt][d], S[d], ks[tt][d] * v);
                        acc = fmaf(qs[tt][d], S[d], acc);
                    }
                    os[tt][e] = acc;
                    const float ss = wave_sum(acc * acc);
                    if ((tid & 63) == 0) part[tid >> 6][tt] = ss;
                }
            }
            __syncthreads();
            if (tid < 128) {
#pragma unroll 1
                for (int tt = 0; tt < 8; ++tt) {
                    const size_t row = (size_t)b * L + t0 + tt;
                    const float tot = part[0][tt] + part[1][tt];
                    const float rinv = rsqrtf(tot * (1.f / 128) + LN_EPS);
                    const size_t idx = row * 1024 + h * 128 + e;
                    MIX[idx] = f2bf(os[tt][e] * rinv * nge * bf2f(MIX[idx]));
                }
            }
        }
    }
}

__device__ __forceinline__ unsigned okey(float x) {
    const unsigned u = __float_as_uint(x);
    return (u & 0x80000000u) ? ~u : (u | 0x80000000u);
}
__device__ __forceinline__ int wave_incl_scan(int v) {
    const int lane = opaque_tid() & 63;
#pragma unroll
    for (int o = 1; o < 64; o <<= 1) { const int n = __shfl_up(v, o); if (lane >= o) v += n; }
    return v;
}
__device__ __forceinline__ int block_excl_scan(int v, int* tmp) {
    const int incl = wave_incl_scan(v);
    const int tq = opaque_tid();
    __syncthreads();
    if ((tq & 63) == 63) tmp[tq >> 6] = incl;
    __syncthreads();
    const int w = tq >> 6;
    int base = 0;
    for (int i = 0; i < w; ++i) base += tmp[i];
    return base + incl - v;
}
__device__ __forceinline__ void unpack8(const uint4 u, float* kf) {
    kf[0] = __uint_as_float(u.x << 16); kf[1] = __uint_as_float(u.x & 0xFFFF0000u);
    kf[2] = __uint_as_float(u.y << 16); kf[3] = __uint_as_float(u.y & 0xFFFF0000u);
    kf[4] = __uint_as_float(u.z << 16); kf[5] = __uint_as_float(u.z & 0xFFFF0000u);
    kf[6] = __uint_as_float(u.w << 16); kf[7] = __uint_as_float(u.w & 0xFFFF0000u);
}

__device__ __forceinline__ void phase_dsa_naive(const Params& p, int layer, char* smem) {
    float* sc = (float*)smem;
    float (*iqs)[64] = (float (*)[64])(sc + 2080);
    float (*aqs)[64] = iqs + 8;
    float (*lg)[256] = (float (*)[256])(aqs + 8);
    unsigned* hist = (unsigned*)(lg + 8);
    int* sel = (int*)(hist + 256);
    int* misc = sel + 256;
    const int tid = opaque_tid();
    const bf16_t* IQ = (const bf16_t*)(p.ws + OFF_IQ);
    const bf16_t* IK = (const bf16_t*)(p.ws + OFF_IK);
    const float* IW = (const float*)(p.ws + OFF_IW);
    const bf16_t* AQ = (const bf16_t*)(p.ws + OFF_AQ);
    const bf16_t* AK = (const bf16_t*)(p.ws + OFF_AK);
    const bf16_t* AV = (const bf16_t*)(p.ws + OFF_AV);
    bf16_t* MIX = (bf16_t*)(p.ws + OFF_MIX);
    for (int item = opaque_bid(); item < T; item += gridDim.x) {
        const int b = item / L, t = item % L;
        const size_t row = (size_t)item;
        __syncthreads();
        iqs[tid >> 6][tid & 63] = bf2f(IQ[row * 512 + tid]); aqs[tid >> 6][tid & 63] = bf2f(AQ[row * 512 + tid]);
        __syncthreads();
        float w[8];
#pragma unroll
        for (int j = 0; j < 8; ++j) w[j] = IW[row * 8 + j];
        for (int s = tid; s <= t; s += NT) {
            const uint4* kp = (const uint4*)&IK[((size_t)b * L + s) * 64];
            float dd[8];
#pragma unroll
            for (int j = 0; j < 8; ++j) dd[j] = 0.f;
#pragma unroll 1
            for (int q = 0; q < 8; ++q) {
                float kf[8]; unpack8(kp[q], kf);
#pragma unroll
                for (int j = 0; j < 8; ++j) {
                    const float4 a0 = *(const float4*)&iqs[j][q * 8], a1 = *(const float4*)&iqs[j][q * 8 + 4];
                    dd[j] = fmaf(a0.x, kf[0], dd[j]); dd[j] = fmaf(a0.y, kf[1], dd[j]); dd[j] = fmaf(a0.z, kf[2], dd[j]); dd[j] = fmaf(a0.w, kf[3], dd[j]);
                    dd[j] = fmaf(a1.x, kf[4], dd[j]); dd[j] = fmaf(a1.y, kf[5], dd[j]); dd[j] = fmaf(a1.z, kf[6], dd[j]); dd[j] = fmaf(a1.w, kf[7], dd[j]);
                }
            }
            float score = 0.f;
#pragma unroll
            for (int j = 0; j < 8; ++j) score = fmaf(w[j], fmaxf(dd[j], 0.f), score);
            sc[s] = score;
        }
        __syncthreads();
        const int n = t + 1;
        int nsel;
        if (n <= TOPK) {
            if (tid < n) sel[tid] = tid;
            nsel = n;
        } else {
            unsigned prefix = 0; int remaining = TOPK;
            for (int pass = 0; pass < 4; ++pass) {
                const int shift = 24 - 8 * pass;
                if (tid < 256) hist[tid] = 0;
                __syncthreads();
                for (int s = tid; s < n; s += NT) {
                    const unsigned key = okey(sc[s]);
                    const bool match = (pass == 0) || ((key >> (shift + 8)) == prefix);
                    if (match) atomicAdd(&hist[(key >> shift) & 255u], 1u);
                }
                __syncthreads();
                if (tid == 0) {
                    int cum = 0, d = 255;
                    for (; d > 0; --d) { const int c = (int)hist[d]; if (cum + c >= remaining) break; cum += c; }
                    misc[0] = d; misc[1] = remaining - cum;
                }
                __syncthreads();
                prefix = (prefix << 8) | (unsigned)misc[0]; remaining = misc[1];
                __syncthreads();
            }
            const int s0 = tid * 5;
            int ceq = 0;
#pragma unroll
            for (int q = 0; q < 5; ++q) { const int s = s0 + q; if (s < n && okey(sc[s]) == prefix) ++ceq; }
            int eqrank = block_excl_scan(ceq, misc + 8);
            int csel = 0; unsigned selmask = 0;
#pragma unroll
            for (int q = 0; q < 5; ++q) {
                const int s = s0 + q;
                if (s < n) {
                    const unsigned key = okey(sc[s]);
                    bool take = key > prefix;
                    if (key == prefix) { take = eqrank < remaining; ++eqrank; }
                    if (take) { ++csel; selmask |= 1u << q; }
                }
            }
            int posn = block_excl_scan(csel, misc + 16);
#pragma unroll
            for (int q = 0; q < 5; ++q) if (selmask & (1u << q)) { if (posn < TOPK) sel[posn] = s0 + q; ++posn; }
            nsel = TOPK;
        }
        __syncthreads();
        {
            const int i = tid & 255, g = tid >> 8;
            if (i < nsel) {
                const int kidx = sel[i];
                const uint4* kp = (const uint4*)&AK[((size_t)b * L + kidx) * 128 + g * 64];
                float dd[4] = {0.f, 0.f, 0.f, 0.f};
#pragma unroll 1
                for (int q = 0; q < 8; ++q) {
                    float kf[8]; unpack8(kp[q], kf);
#pragma unroll
                    for (int r = 0; r < 4; ++r) {
                        const float4 a0 = *(const float4*)&aqs[g * 4 + r][q * 8], a1 = *(const float4*)&aqs[g * 4 + r][q * 8 + 4];
                        dd[r] = fmaf(a0.x, kf[0], dd[r]); dd[r] = fmaf(a0.y, kf[1], dd[r]); dd[r] = fmaf(a0.z, kf[2], dd[r]); dd[r] = fmaf(a0.w, kf[3], dd[r]);
                        dd[r] = fmaf(a1.x, kf[4], dd[r]); dd[r] = fmaf(a1.y, kf[5], dd[r]); dd[r] = fmaf(a1.z, kf[6], dd[r]); dd[r] = fmaf(a1.w, kf[7], dd[r]);
                    }
                }
#pragma unroll
                for (int r = 0; r < 4; ++r) lg[g * 4 + r][i] = dd[r];
            } else {
#pragma unroll
                for (int r = 0; r < 4; ++r) lg[g * 4 + r][i] = -INFINITY;
            }
        }
        __syncthreads();
        {
            const int h = tid >> 6, lane = tid & 63;
            float v0 = lg[h][lane], v1 = lg[h][lane + 64], v2 = lg[h][lane + 128], v3 = lg[h][lane + 192];
            const float m = wave_max(fmaxf(fmaxf(v0, v1), fmaxf(v2, v3)));
            v0 = expf(v0 - m); v1 = expf(v1 - m); v2 = expf(v2 - m); v3 = expf(v3 - m);
            const float inv = 1.f / wave_sum(v0 + v1 + v2 + v3);
            lg[h][lane] = v0 * inv; lg[h][lane + 64] = v1 * inv; lg[h][lane + 128] = v2 * inv; lg[h][lane + 192] = v3 * inv;
        }
        __syncthreads();
        {
            const int h = tid >> 6, d = tid & 63, g = h >> 2;
            float o = 0.f;
            for (int i = 0; i < nsel; ++i) o = fmaf(lg[h][i], bf2f(AV[((size_t)b * L + sel[i]) * 128 + g * 64 + d]), o);
            const size_t mi = row * 1024 + 512 + tid;
            MIX[mi] = f2bf(o * bf2f(MIX[mi]));
        }
    }
}


constexpr int DS_SC = 0, DS_BITS = 132096, DS_HIST = DS_BITS + 4224, DS_END = DS_HIST + 8 * 1040;
constexpr int DS_MB = 3 * 32768, DS_MBROW = 2112;
static_assert(DS_MB + 16 * DS_MBROW <= DS_BITS, "mask bytes overlap");


template <int NR>
__device__ __forceinline__ void dsa_select(const LAS unsigned* row, LAS unsigned* bits, LAS unsigned* hist, int n, int lane) {
    unsigned kreg[NR];
#pragma unroll
    for (int i = 0; i < NR; ++i) kreg[i] = (lane < n - 64 * i) ? row[lane + 64 * i] : 0u;
    unsigned prefix = 0; int remaining = TOPK;
#pragma unroll 1
    for (int pass = 0; pass < 4; ++pass) {
        const int shift = 24 - 8 * pass;
        *(LAS u32x4*)(hist + lane * 4) = (u32x4){0u, 0u, 0u, 0u};
        __builtin_amdgcn_wave_barrier(); asm volatile("" ::: "memory");
        const unsigned sh8 = (unsigned)(shift + 8) & 31u;
#pragma unroll
        for (int i = 0; i < NR; ++i) {
            const unsigned key = kreg[i];
            const bool match = (lane < n - 64 * i) && ((pass == 0) || ((key >> sh8) == prefix));
            if (match) __hip_atomic_fetch_add(hist + ((key >> shift) & 255u), 1u, __ATOMIC_RELAXED, __HIP_MEMORY_SCOPE_WAVEFRONT);
        }
        __builtin_amdgcn_wave_barrier(); asm volatile("s_waitcnt lgkmcnt(0)" ::: "memory");
        const u32x4 hv = *(const LAS u32x4*)(hist + (63 - lane) * 4);
        const int c0 = (int)hv[3], c1 = (int)hv[2], c2 = (int)hv[1], c3 = (int)hv[0];
        const int tot = c0 + c1 + c2 + c3;
        const int incl = wave_incl_scan(tot), excl = incl - tot;
        const bool found = (excl < remaining) && (remaining <= incl);
        int digit = 0, rem_new = 0;
        if (found) {
            int cum = excl;
            if (cum + c0 >= remaining) { digit = 255 - 4 * lane; rem_new = remaining - cum; }
            else { cum += c0;
                if (cum + c1 >= remaining) { digit = 254 - 4 * lane; rem_new = remaining - cum; }
                else { cum += c1;
                    if (cum + c2 >= remaining) { digit = 253 - 4 * lane; rem_new = remaining - cum; }
                    else { cum += c2; digit = 252 - 4 * lane; rem_new = remaining - cum; } } }
        }
        const unsigned long long fm = __ballot(found);
        const int src = (int)__builtin_ctzll(fm);
        digit = __builtin_amdgcn_readlane(digit, src); rem_new = __builtin_amdgcn_readlane(rem_new, src);
        prefix = (prefix << 8) | (unsigned)digit; remaining = rem_new;
    }
    const unsigned tkey = prefix;
    int eqcount = 0;
#pragma unroll
    for (int i = 0; i < 33; ++i) {
        if (i < NR) {
            const unsigned key = kreg[i < NR ? i : 0];
            const bool valid = lane < n - 64 * i;
            const bool gt = valid && (key > tkey), eq = valid && (key == tkey);
            const unsigned long long em = __ballot(eq);
            const int rank = eqcount + __popcll(em & ((1ull << lane) - 1ull));
            const bool sel = gt || (eq && rank < remaining);
            eqcount += __popcll(em);
            const unsigned long long sm = __ballot(sel);
            if (lane == 0) { bits[2 * i] = (unsigned)sm; bits[2 * i + 1] = (unsigned)(sm >> 32); }
        } else if (lane == 0) { bits[2 * i] = 0u; bits[2 * i + 1] = 0u; }
    }
}

__device__ __forceinline__ void phase_dsa(const Params& p_in, int layer_in, char* smem, bool do_store) {
    const Params p = kparams(); const int layer = opaque_int(layer_in); (void)p_in;
    const int tid = opaque_tid(), wid = __builtin_amdgcn_readfirstlane(tid >> 6), lane = tid & 63, fr = lane & 15, fq = lane >> 4;
    LAS unsigned char* lds = (LAS unsigned char*)smem;
    const bf16_t* IQ = (const bf16_t*)(p.ws + OFF_IQ);
    const bf16_t* IK = (const bf16_t*)(p.ws + OFF_IK);
    const float* IW = (const float*)(p.ws + OFF_IW);
    const bf16_t* AQ = (const bf16_t*)(p.ws + OFF_AQ);
    const bf16_t* AK = (const bf16_t*)(p.ws + OFF_AK);
    const bf16_t* AVT = (const bf16_t*)(p.ws + OFF_AV);
    bf16_t* MIX = (bf16_t*)(p.ws + OFF_MIX);
    constexpr int NITEM = NB * 129;
    for (int idx = opaque_bid(); idx < NITEM; idx += gridDim.x) {
        const int b = idx & 7, mm = idx >> 3;
        int qr;
        { const int seg = mm >> 5, jj = mm & 31; qr = (seg == 0) ? jj : (seg == 1) ? 63 - jj : (seg == 2) ? 64 + jj : (seg == 3) ? 127 - jj : 128; }
        const int qt = 128 - qr, t0 = qt * 16;
        const size_t rowq = (size_t)b * L + t0 + fr;
        __syncthreads();
        for (int repA = 0; repA < PROBE_DSA_A; ++repA) {
            bf16x8 qf[8][2];
#pragma unroll
            for (int jh = 0; jh < 8; ++jh)
#pragma unroll
                for (int s2 = 0; s2 < 2; ++s2) qf[jh][s2] = *(const bf16x8*)(IQ + rowq * 512 + jh * 64 + s2 * 32 + fq * 8);
            float w[8];
            { const f32x4 w0 = *(const f32x4*)(IW + rowq * 8), w1 = *(const f32x4*)(IW + rowq * 8 + 4);
              w[0] = w0[0]; w[1] = w0[1]; w[2] = w0[2]; w[3] = w0[3]; w[4] = w1[0]; w[5] = w1[1]; w[6] = w1[2]; w[7] = w1[3]; }
            const int ntile = qt + 1;
            const bf16x8 z8 = {0, 0, 0, 0, 0, 0, 0, 0};
            bf16x8 ka0 = z8, ka1 = z8, kb0 = z8, kb1 = z8, kc0 = z8, kc1 = z8;
            int kt = wid;
            if (kt < ntile) { const bf16_t* kp = IK + ((size_t)b * L + 16 * kt + fr) * 64 + fq * 8; ka0 = *(const bf16x8*)kp; ka1 = *(const bf16x8*)(kp + 32); }
            if (kt + 8 < ntile) { const bf16_t* kp = IK + ((size_t)b * L + 16 * (kt + 8) + fr) * 64 + fq * 8; kb0 = *(const bf16x8*)kp; kb1 = *(const bf16x8*)(kp + 32); }
            for (; kt < ntile; kt += 8) {
                if (kt + 16 < ntile) { const bf16_t* kp = IK + ((size_t)b * L + 16 * (kt + 16) + fr) * 64 + fq * 8; kc0 = *(const bf16x8*)kp; kc1 = *(const bf16x8*)(kp + 32); }
                f32x4 sc = {0.f, 0.f, 0.f, 0.f};
#pragma unroll
                for (int jh = 0; jh < 8; ++jh) {
                    f32x4 d = {0.f, 0.f, 0.f, 0.f};
                    d = __builtin_amdgcn_mfma_f32_16x16x32_bf16(ka0, qf[jh][0], d, 0, 0, 0);
                    d = __builtin_amdgcn_mfma_f32_16x16x32_bf16(ka1, qf[jh][1], d, 0, 0, 0);
#pragma unroll
                    for (int r = 0; r < 4; ++r) sc[r] = fmaf(w[jh], fmaxf(d[r], 0.f), sc[r]);
                }
                u32x4 ko;
#pragma unroll
                for (int r = 0; r < 4; ++r) ko[r] = okey(sc[r]);
                *(LAS u32x4*)(lds + DS_SC + (fr * 2064 + 16 * kt + 4 * fq) * 4) = ko;
                ka0 = kb0; ka1 = kb1; kb0 = kc0; kb1 = kc1;
            }
        }
        __syncthreads();
        for (int repB = 0; repB < PROBE_DSA_B; ++repB) {
            LAS unsigned* hist = (LAS unsigned*)(lds + DS_HIST + wid * 1040);
#pragma unroll 1
            for (int qq = 0; qq < 2; ++qq) {
                const int q = wid * 2 + qq;
                const int n = t0 + q + 1;
                const LAS unsigned* row = (const LAS unsigned*)(lds + DS_SC) + q * 2064;
                LAS unsigned* bits = (LAS unsigned*)(lds + DS_BITS) + q * 66;
                if (n <= TOPK) {
#pragma unroll 1
                    for (int i = 0; i < 33; ++i) {
                        const unsigned long long sm = __ballot(lane + 64 * i < n);
                        if (lane == 0) { bits[2 * i] = (unsigned)sm; bits[2 * i + 1] = (unsigned)(sm >> 32); }
                    }
                } else {
                    const int nr = (n + 63) >> 6;
                    if (nr <= 9) dsa_select<9>(row, bits, hist, n, lane);
                    else if (nr <= 17) dsa_select<17>(row, bits, hist, n, lane);
                    else if (nr <= 25) dsa_select<25>(row, bits, hist, n, lane);
                    else dsa_select<33>(row, bits, hist, n, lane);
                }
            }
        }
        __syncthreads();
        for (int repC = 0; repC < PROBE_DSA_C; ++repC) {
            if (repC > 0) __syncthreads();
            const int h = wid, g = h >> 2;
            const int nstep = (t0 + 16 + 63) >> 6;
            bf16x8 aqf[2];
            aqf[0] = *(const bf16x8*)(AQ + rowq * 512 + h * 64 + fq * 8);
            aqf[1] = *(const bf16x8*)(AQ + rowq * 512 + h * 64 + 32 + fq * 8);
            asm volatile("" : "+v"(aqf[0]), "+v"(aqf[1]));
            const int drow = 8 * wid + (lane >> 3);
            const int kch = (lane & 7) ^ (drow & 7), vch = (lane & 7) ^ ((drow >> 1) & 7);
            const bf16_t* vsrc0 = AVT + ((size_t)b * 128 + drow) * LP + vch * 8;
#define DSA_DMA(st_, buf_) do { \
                int krow_ = b * L + 64 * (st_) + drow; krow_ = krow_ < T ? krow_ : T - 1; \
                const bf16_t* ks_ = AK + (size_t)krow_ * 128 + kch * 8; \
                LAS unsigned char* lb_ = lds + (buf_) * 32768 + wid * 1024; \
                __builtin_amdgcn_global_load_lds((const unsigned*)ks_, (LAS unsigned*)lb_, 16, 0, 0); \
                __builtin_amdgcn_global_load_lds((const unsigned*)(ks_ + 64), (LAS unsigned*)(lb_ + 8192), 16, 0, 0); \
                __builtin_amdgcn_global_load_lds((const unsigned*)(vsrc0 + 64 * (st_)), (LAS unsigned*)(lb_ + 16384), 16, 0, 0); \
                __builtin_amdgcn_global_load_lds((const unsigned*)(vsrc0 + (size_t)64 * LP + 64 * (st_)), (LAS unsigned*)(lb_ + 24576), 16, 0, 0); } while (0)
            DSA_DMA(0, 0);
            DSA_DMA((nstep > 1 ? 1 : 0), 1);
            for (int wi = tid; wi < 16 * 66; wi += NT) {
                const int q = wi / 66, wd = wi - q * 66;
                const unsigned bw = *((const LAS unsigned*)(lds + DS_BITS) + wi);
                const int st = wd >> 1, hh = wd & 1;
#pragma unroll
                for (int f = 0; f < 4; ++f) {
                    const unsigned n0 = (bw >> (4 * f)) & 15u, n1 = (bw >> (16 + 4 * f)) & 15u;
                    u32x2 o; o.x = (n0 * 0x00204081u) & 0x01010101u; o.y = (n1 * 0x00204081u) & 0x01010101u;
                    *(LAS u32x2*)(lds + DS_MB + q * DS_MBROW + 64 * st + 16 * f + 8 * hh) = o;
                }
            }
            asm volatile("s_waitcnt vmcnt(4) lgkmcnt(0)" ::: "memory");
            __builtin_amdgcn_s_barrier();
            asm volatile("" ::: "memory");
            f32x4 O[4];
#pragma unroll
            for (int dt = 0; dt < 4; ++dt) O[dt] = (f32x4){0.f, 0.f, 0.f, 0.f};
            float m = -INFINITY, l = 0.f;
            const float C2 = 1.44269504088896341f;
            int buf = 0;
            for (int st = 0; st < nstep; ++st) {
                {
                    const int sn = (st + 2 < nstep) ? st + 2 : nstep - 1;
                    const int bn = (buf >= 1) ? buf - 1 : 2;
                    DSA_DMA(sn, bn);
                }
                const LAS unsigned char* sb = lds + buf * 32768;
                f32x4 S[4];
#pragma unroll
                for (int kt = 0; kt < 4; ++kt) {
                    S[kt] = (f32x4){0.f, 0.f, 0.f, 0.f};
#pragma unroll
                    for (int s2 = 0; s2 < 2; ++s2) {
                        const int rowk = 16 * kt + fr;
                        const bf16x8 kf = *(const LAS bf16x8*)(sb + g * 8192 + rowk * 128 + 16 * ((4 * s2 + fq) ^ (rowk & 7)));
                        S[kt] = __builtin_amdgcn_mfma_f32_16x16x32_bf16(kf, aqf[s2], S[kt], 0, 0, 0);
                    }
                }
                const u32x4 mb = *(const LAS u32x4*)(lds + DS_MB + fr * DS_MBROW + 64 * st + 16 * fq);
                float pmax = S[0][0];
#pragma unroll
                for (int kt = 0; kt < 4; ++kt)
#pragma unroll
                    for (int r = 0; r < 4; ++r) pmax = fmaxf(pmax, S[kt][r]);
                if (__any(pmax > m + 8.0f)) {
                    float pm = fmaxf(pmax, __shfl_xor(pmax, 16)); pm = fmaxf(pm, __shfl_xor(pm, 32));
                    const float mn = fmaxf(m, pm);
                    const float alpha = __builtin_amdgcn_exp2f((m - mn) * C2);
#pragma unroll
                    for (int dt = 0; dt < 4; ++dt) O[dt] *= alpha;
                    l *= alpha; m = mn;
                }
                const float mc = m * C2;
                unsigned pk[4][2];
#pragma unroll
                for (int kt = 0; kt < 4; ++kt) {
                    float pv[4];
#pragma unroll
                    for (int r = 0; r < 4; ++r) {
                        const float e = __builtin_amdgcn_exp2f(fmaf(S[kt][r], C2, -mc));
                        const float bf = (float)((mb[kt] >> (8 * r)) & 0xFFu);
                        pv[r] = e * bf; l += pv[r];
                    }
                    pk[kt][0] = cvt_pk_bf16(pv[0], pv[1]); pk[kt][1] = cvt_pk_bf16(pv[2], pv[3]);
                }
#pragma unroll
                for (int ks = 0; ks < 2; ++ks) {
                    u32x4 pw; pw[0] = pk[2 * ks][0]; pw[1] = pk[2 * ks][1]; pw[2] = pk[2 * ks + 1][0]; pw[3] = pk[2 * ks + 1][1];
                    const bf16x8 pf = __builtin_bit_cast(bf16x8, pw);
#pragma unroll
                    for (int dt = 0; dt < 4; ++dt) {
                        const int rowv = 16 * dt + fr, sw = (rowv >> 1) & 7;
                        const LAS unsigned char* vp = sb + 16384 + g * 8192 + rowv * 128 + 8 * (fq & 1);
                        const u32x2 va = *(const LAS u32x2*)(vp + 16 * ((4 * ks + (fq >> 1)) ^ sw));
                        const u32x2 vb = *(const LAS u32x2*)(vp + 16 * ((4 * ks + 2 + (fq >> 1)) ^ sw));
                        u32x4 vw; vw[0] = va[0]; vw[1] = va[1]; vw[2] = vb[0]; vw[3] = vb[1];
                        O[dt] = __builtin_amdgcn_mfma_f32_16x16x32_bf16(__builtin_bit_cast(bf16x8, vw), pf, O[dt], 0, 0, 0);
                    }
                }
                asm volatile("s_waitcnt vmcnt(4)" ::: "memory");
                __builtin_amdgcn_s_barrier();
                asm volatile("" ::: "memory");
                buf = (buf == 2) ? 0 : buf + 1;
            }
#undef DSA_DMA
            asm volatile("s_waitcnt vmcnt(0)" ::: "memory");
            l += __shfl_xor(l, 16); l += __shfl_xor(l, 32);
            const float inv = 1.f / fmaxf(l, 1e-30f);
            bf16_t* mp = MIX + rowq * 1024 + 512 + h * 64 + 4 * fq;
            if (do_store && repC == PROBE_DSA_C - 1)
#pragma unroll
            for (int dt = 0; dt < 4; ++dt) {
                const uint2 gz = *(const uint2*)(mp + 16 * dt);
                const float g0 = __uint_as_float(gz.x << 16), g1 = __uint_as_float(gz.x & 0xFFFF0000u), g2 = __uint_as_float(gz.y << 16), g3 = __uint_as_float(gz.y & 0xFFFF0000u);
                uint2 o; o.x = pack2bf(O[dt][0] * inv * g0, O[dt][1] * inv * g1); o.y = pack2bf(O[dt][2] * inv * g2, O[dt][3] * inv * g3);
                *(uint2*)(mp + 16 * dt) = o;
            }
        }
    }
}

__device__ __forceinline__ void rope16(const u32x4 a, const u32x4 b, const float2* rp, u32x4& oa, u32x4& ob) {
    const f32x4 r0 = *(const f32x4*)(rp), r1 = *(const f32x4*)(rp + 2), r2 = *(const f32x4*)(rp + 4), r3 = *(const f32x4*)(rp + 6);
    const float cs[8] = {r0[0], r0[2], r1[0], r1[2], r2[0], r2[2], r3[0], r3[2]};
    const float sn[8] = {r0[1], r0[3], r1[1], r1[3], r2[1], r2[3], r3[1], r3[3]};
    float o1[8], o2[8];
#pragma unroll
    for (int i = 0; i < 4; ++i) {
        const float x1l = __uint_as_float(a[i] << 16), x1h = __uint_as_float(a[i] & 0xFFFF0000u);
        const float x2l = __uint_as_float(b[i] << 16), x2h = __uint_as_float(b[i] & 0xFFFF0000u);
        o1[2 * i] = x1l * cs[2 * i] - x2l * sn[2 * i]; o1[2 * i + 1] = x1h * cs[2 * i + 1] - x2h * sn[2 * i + 1];
        o2[2 * i] = x2l * cs[2 * i] + x1l * sn[2 * i]; o2[2 * i + 1] = x2h * cs[2 * i + 1] + x1h * sn[2 * i + 1];
    }
#pragma unroll
    for (int i = 0; i < 4; ++i) { oa[i] = cvt_pk_bf16(o1[2 * i], o1[2 * i + 1]); ob[i] = cvt_pk_bf16(o2[2 * i], o2[2 * i + 1]); }
}
__device__ __forceinline__ void phase_rope(const Params& p_in, int layer_in, char* smem) {
    const Params p = kparams(); const int layer = opaque_int(layer_in); (void)p_in;
    const int tid = opaque_tid();
    const float2* ROPE = (const float2*)(p.ws + OFF_ROPE);
    const int nthr = gridDim.x * NT, gid = opaque_bid() * NT + tid;
    for (int th = gid; th < T * 18; th += nthr) {
        const int t = th / 18, hh = th - t * 18, pos = t % L;
        bf16_t* base = (hh < 8) ? (bf16_t*)(p.ws + OFF_AQ) + (size_t)t * 512 + hh * 64
                     : (hh < 16) ? (bf16_t*)(p.ws + OFF_IQ) + (size_t)t * 512 + (hh - 8) * 64
                                 : (bf16_t*)(p.ws + OFF_AK) + (size_t)t * 128 + (hh - 16) * 64;
        const u32x4 a = *(const u32x4*)base, b = *(const u32x4*)(base + 8);
        u32x4 oa, ob; rope16(a, b, ROPE + pos * 8, oa, ob);
        *(u32x4*)base = oa; *(u32x4*)(base + 8) = ob;
    }
    const float* IKR = (const float*)(p.ws + OFF_IKR);
    bf16_t* IK = (bf16_t*)(p.ws + OFF_IK);
    const float* ikg = p.ikg + layer * 64; const float* ikb = p.ikb + layer * 64;
    for (int t = gid; t < T; t += nthr) {
        const int pos = t % L;
        f32x4 x[16];
#pragma unroll
        for (int i = 0; i < 16; ++i) x[i] = *(const f32x4*)(IKR + (size_t)t * 64 + 4 * i);
        float sm = 0.f;
#pragma unroll
        for (int i = 0; i < 16; ++i) sm += (x[i][0] + x[i][1]) + (x[i][2] + x[i][3]);
        const float mu = sm * (1.f / 64);
        float qq = 0.f;
#pragma unroll
        for (int i = 0; i < 16; ++i) { const f32x4 d = x[i] - mu; qq += (d[0] * d[0] + d[1] * d[1]) + (d[2] * d[2] + d[3] * d[3]); }
        const float rs = rsqrtf(qq * (1.f / 64) + LN_EPS);
#pragma unroll
        for (int i = 0; i < 16; ++i) { const f32x4 g = *(const f32x4*)(ikg + 4 * i), bb = *(const f32x4*)(ikb + 4 * i); x[i] = (x[i] - mu) * rs * g + bb; }
        const float2* rp = ROPE + pos * 8;
        const f32x4 r0 = *(const f32x4*)(rp), r1 = *(const f32x4*)(rp + 2), r2 = *(const f32x4*)(rp + 4), r3 = *(const f32x4*)(rp + 6);
        const float cs[8] = {r0[0], r0[2], r1[0], r1[2], r2[0], r2[2], r3[0], r3[2]};
        const float sn[8] = {r0[1], r0[3], r1[1], r1[3], r2[1], r2[3], r3[1], r3[3]};
#pragma unroll
        for (int i = 0; i < 8; ++i) {
            const float x1 = x[i >> 2][i & 3], x2 = x[2 + (i >> 2)][i & 3];
            x[i >> 2][i & 3] = x1 * cs[i] - x2 * sn[i];
            x[2 + (i >> 2)][i & 3] = x2 * cs[i] + x1 * sn[i];
        }
#pragma unroll
        for (int i = 0; i < 8; ++i) {
            u32x4 o; o[0] = cvt_pk_bf16(x[2 * i][0], x[2 * i][1]); o[1] = cvt_pk_bf16(x[2 * i][2], x[2 * i][3]); o[2] = cvt_pk_bf16(x[2 * i + 1][0], x[2 * i + 1][1]); o[3] = cvt_pk_bf16(x[2 * i + 1][2], x[2 * i + 1][3]);
            *(u32x4*)(IK + (size_t)t * 64 + 8 * i) = o;
        }
    }
}

constexpr int GL_QE = 0, GL_KN = 8192, GL_SEG = 16384, GL_PART = 18432;
__device__ __forceinline__ void gla_cumsum(const Params& p, int layer, int b, int h, int c, int tid, LAS unsigned char* lds, float (&bc)[8], float& blast) {
    const int d = tid & 63, seg = tid >> 6;
    const float* wg2 = p.wg2 + (size_t)layer * 16 * 256 + h * 64 + d;
    float w[16];
#pragma unroll
    for (int rr = 0; rr < 16; ++rr) w[rr] = wg2[rr * 256];
    const float bgd = p.bg[layer * 256 + h * 64 + d];
    const float* GLR = (const float*)(p.ws + OFF_GLR);
    float pb = 0.f;
#pragma unroll
    for (int i = 0; i < 8; ++i) {
        const int pos = 64 * c - 48 + 8 * seg + i;
        float gl = 0.f;
        if (pos >= 0) {
            const f32x4* gp = (const f32x4*)(GLR + ((size_t)b * L + pos) * 16);
            const f32x4 g0 = gp[0], g1 = gp[1], g2 = gp[2], g3 = gp[3];
            float x = bgd;
#pragma unroll
            for (int rr = 0; rr < 4; ++rr) { x = fmaf(g0[rr], w[rr], x); }
#pragma unroll
            for (int rr = 0; rr < 4; ++rr) { x = fmaf(g1[rr], w[4 + rr], x); }
#pragma unroll
            for (int rr = 0; rr < 4; ++rr) { x = fmaf(g2[rr], w[8 + rr], x); }
#pragma unroll
            for (int rr = 0; rr < 4; ++rr) { x = fmaf(g3[rr], w[12 + rr], x); }
            gl = logsigmoid_fast(x) * (1.f / 16.f);
        }
        pb += gl; bc[i] = pb;
    }
    LAS float* segs = (LAS float*)(lds + GL_SEG);
    segs[seg * 64 + d] = pb;
    __syncthreads();
    float base = 0.f, tot = 0.f;
#pragma unroll
    for (int sg = 0; sg < 8; ++sg) { const float v = segs[sg * 64 + d]; tot += v; base += (sg < seg) ? v : 0.f; }
#pragma unroll
    for (int i = 0; i < 8; ++i) bc[i] += base;
    blast = tot;
}

constexpr size_t OUTS_QE = 0, OUTS_KN = (size_t)T * 256 * 2;
__device__ __forceinline__ void phase_gla_a(const Params& p_in, int layer_in, char* smem) {
    const Params p = kparams(); const int layer = opaque_int(layer_in); (void)p_in;
    const int tid = opaque_tid(), wid = __builtin_amdgcn_readfirstlane(tid >> 6), lane = tid & 63, fr = lane & 15, fq = lane >> 4;
    LAS unsigned char* ldw = (LAS unsigned char*)smem + wid * 8192;
    const bf16_t* GQ = (const bf16_t*)(p.ws + OFF_GQ);
    const bf16_t* GK = (const bf16_t*)(p.ws + OFF_GK);
    const bf16_t* GVT = (const bf16_t*)(p.ws + OFF_GV);
    const float* GLR = (const float*)(p.ws + OFF_GLR);
    bf16_t* QE = (bf16_t*)((char*)p.out + OUTS_QE);
    bf16_t* KN = (bf16_t*)((char*)p.out + OUTS_KN);
    float* UT = (float*)(p.ws + OFF_UT);
    float* DL = (float*)(p.ws + OFF_DL);
    const int wstride = gridDim.x * 8;
    for (int task = wid * (int)gridDim.x + opaque_bid(); task < 32 * 33; task += wstride) {
        const int bh = task / 33, c = task - bh * 33, b = bh >> 2, h = bh & 3;
        const int d = lane;
        float w[16];
#pragma unroll
        for (int rr = 0; rr < 16; ++rr) w[rr] = p.wg2[(size_t)layer * 16 * 256 + rr * 256 + h * 64 + d];
        const float bgd = p.bg[layer * 256 + h * 64 + d];
        float bsum = 0.f;
        const int rowi0 = b * L + 64 * c - 48;
        f32x4 g4[4];
#pragma unroll
        for (int m = 0; m < 4; ++m) { int rr_ = rowi0 + ((lane + 64 * m) >> 2); rr_ = rr_ > 0 ? rr_ : 0; g4[m] = *(const f32x4*)(GLR + (size_t)rr_ * 16 + 4 * (lane & 3)); }
        LAS unsigned char* ldg = (LAS unsigned char*)smem + 65536 + wid * 4096;
#pragma unroll
        for (int m = 0; m < 4; ++m) *(LAS f32x4*)(ldg + (lane + 64 * m) * 16) = g4[m];
        unsigned qk[64];
#pragma unroll
        for (int t = 0; t < 64; ++t) { int rr_ = rowi0 + t; rr_ = rr_ > 0 ? rr_ : 0; const size_t o_ = (size_t)rr_ * 256 + h * 64 + d; qk[t] = (unsigned)GQ[o_] | ((unsigned)GK[o_] << 16); }
        float kn[8];
        __builtin_amdgcn_wave_barrier(); asm volatile("s_waitcnt lgkmcnt(0)" ::: "memory");
#pragma unroll
        for (int t = 0; t < 64; ++t) {
            const bool valid = (c > 0) || (t >= 48);
            float x = bgd;
            {
                const LAS f32x4* gp = (const LAS f32x4*)(ldg + t * 64);
                const f32x4 g0 = gp[0], g1 = gp[1], g2 = gp[2], g3 = gp[3];
#pragma unroll
                for (int rr = 0; rr < 4; ++rr) x = fmaf(g0[rr], w[rr], x);
#pragma unroll
                for (int rr = 0; rr < 4; ++rr) x = fmaf(g1[rr], w[4 + rr], x);
#pragma unroll
                for (int rr = 0; rr < 4; ++rr) x = fmaf(g2[rr], w[8 + rr], x);
#pragma unroll
                for (int rr = 0; rr < 4; ++rr) x = fmaf(g3[rr], w[12 + rr], x);
            }
            bsum += valid ? logsigmoid_fast(x) * (1.f / 16.f) : 0.f;
            const float eb = __expf(bsum);
            const float qv = __uint_as_float(qk[t] << 16), kv = __uint_as_float(qk[t] & 0xFFFF0000u);
            const float knv = valid ? kv * __builtin_amdgcn_rcpf(eb) : 0.f;
            kn[t & 7] = knv;
            if (valid) {
                const size_t o_ = (size_t)(rowi0 + t) * 256 + h * 64 + d;
                QE[o_] = f2bf(qv * eb);
                KN[o_] = f2bf(knv);
            }
            if ((t & 7) == 7 && c < 32) {
                u32x4 o; o[0] = cvt_pk_bf16(kn[0], kn[1]); o[1] = cvt_pk_bf16(kn[2], kn[3]); o[2] = cvt_pk_bf16(kn[4], kn[5]); o[3] = cvt_pk_bf16(kn[6], kn[7]);
                *(LAS u32x4*)(ldw + d * 128 + 16 * ((t >> 3) ^ (d & 7))) = o;
            }
        }
        if (c < 32) {
            const float dl = __expf(bsum);
            DL[((size_t)bh * 32 + c) * 64 + d] = dl;
            __builtin_amdgcn_wave_barrier(); asm volatile("s_waitcnt lgkmcnt(0)" ::: "memory");
            bf16x8 kf[4][2]; float dls[4];
#pragma unroll
            for (int dt = 0; dt < 4; ++dt) {
                const int rowd = 16 * dt + fr;
                dls[dt] = __shfl(dl, rowd);
#pragma unroll
                for (int ks = 0; ks < 2; ++ks) kf[dt][ks] = *(const LAS bf16x8*)(ldw + rowd * 128 + 16 * ((4 * ks + fq) ^ (rowd & 7)));
            }
            const bf16x8 z8 = {0, 0, 0, 0, 0, 0, 0, 0};
#pragma unroll
            for (int et = 0; et < 8; ++et) {
                const bf16_t* vp = GVT + ((size_t)bh * 128 + 16 * et + fr) * LPV + 64 * c + 8 * fq;
                bf16x8 v0 = *(const bf16x8*)vp, v1 = *(const bf16x8*)(vp + 32);
                v0 = (c == 0) ? z8 : v0; v1 = (c == 0 && fq < 2) ? z8 : v1;
#pragma unroll
                for (int dt = 0; dt < 4; ++dt) {
                    f32x4 acc = {0.f, 0.f, 0.f, 0.f};
                    acc = __builtin_amdgcn_mfma_f32_16x16x32_bf16(v0, kf[dt][0], acc, 0, 0, 0);
                    acc = __builtin_amdgcn_mfma_f32_16x16x32_bf16(v1, kf[dt][1], acc, 0, 0, 0);
                    float* up = UT + (((size_t)bh * 32 + c) * 128 + 16 * et + 4 * fq) * 64 + 16 * dt + fr;
#pragma unroll
                    for (int r = 0; r < 4; ++r) up[r * 64] = acc[r] * dls[dt];
                }
            }
            __builtin_amdgcn_wave_barrier(); asm volatile("s_waitcnt lgkmcnt(0)" ::: "memory");
        }
    }
}

__device__ __forceinline__ void phase_gla_scan(const Params& p_in, int layer_in, char* smem) {
    const Params p = kparams(); const int layer = opaque_int(layer_in); (void)p_in;
    const int tid = opaque_tid();
    const float* UT = (const float*)(p.ws + OFF_UT);
    const float* DL = (const float*)(p.ws + OFF_DL);
    bf16_t* ST = (bf16_t*)(p.ws + OFF_ST);
    const int nthr = gridDim.x * NT;
    for (int el = opaque_bid() * NT + tid; el < 32 * 8192; el += nthr) {
        const int bh = el >> 13, ed = el & 8191, d = el & 63;
        float sacc = 0.f;
        ST[((size_t)bh * 33) * 8192 + ed] = 0;
#pragma unroll 1
        for (int c0 = 0; c0 < 32; c0 += 16) {
            float u[16], dl[16];
#pragma unroll
            for (int i = 0; i < 16; ++i) { u[i] = UT[((size_t)(bh * 32 + c0 + i)) * 8192 + ed]; dl[i] = DL[(size_t)(bh * 32 + c0 + i) * 64 + d]; }
#pragma unroll
            for (int i = 0; i < 16; ++i) { sacc = fmaf(dl[i], sacc, u[i]); ST[((size_t)bh * 33 + c0 + i + 1) * 8192 + ed] = f2bf(sacc); }
        }
    }
}

__device__ __forceinline__ void phase_gla_c(const Params& p_in, int layer_in, char* smem, bool do_store) {
    const Params p = kparams(); const int layer = opaque_int(layer_in); (void)p_in;
    const int tid = opaque_tid(), wid = __builtin_amdgcn_readfirstlane(tid >> 6), lane = tid & 63, fr = lane & 15, fq = lane >> 4;
    const bf16_t* QE = (const bf16_t*)((const char*)p.out + OUTS_QE);
    const bf16_t* KN = (const bf16_t*)((const char*)p.out + OUTS_KN);
    const bf16_t* GVT = (const bf16_t*)(p.ws + OFF_GV);
    const bf16_t* ST = (const bf16_t*)(p.ws + OFF_ST);
    bf16_t* MIX = (bf16_t*)(p.ws + OFF_MIX);
    const float* ng = p.norm_g + layer * 128;
    const bf16x8 z8 = {0, 0, 0, 0, 0, 0, 0, 0};
    const int nwt = 32 * 33 * 4, wstride = gridDim.x * 8;
    for (int wt = wid * (int)gridDim.x + opaque_bid(); wt < nwt; wt += wstride) {
        const int task = wt >> 2, tw = wt & 3;
        const int bh = task / 33, c = task - bh * 33, b = bh >> 2, h = bh & 3;
        const int pos_t = 64 * c - 48 + 16 * tw + fr;
        if (c == 0 && tw < 3) continue;
        bf16x8 qf[2];
        {
            const bf16_t* qp = QE + ((size_t)b * L + pos_t) * 256 + h * 64 + 8 * fq;
            qf[0] = *(const bf16x8*)qp; qf[1] = *(const bf16x8*)(qp + 32);
        }
        unsigned pk[4][2];
#pragma unroll
        for (int st = 0; st < 4; ++st) {
            f32x4 a = {0.f, 0.f, 0.f, 0.f};
            const int pos_s = 64 * c - 48 + 16 * st + fr;
            const bf16_t* kp = KN + ((size_t)b * L + (pos_s > 0 ? pos_s : 0)) * 256 + h * 64 + 8 * fq;
            bf16x8 k0 = *(const bf16x8*)kp, k1 = *(const bf16x8*)(kp + 32);
            k0 = (pos_s >= 0) ? k0 : z8; k1 = (pos_s >= 0) ? k1 : z8;
            a = __builtin_amdgcn_mfma_f32_16x16x32_bf16(k0, qf[0], a, 0, 0, 0);
            a = __builtin_amdgcn_mfma_f32_16x16x32_bf16(k1, qf[1], a, 0, 0, 0);
#pragma unroll
            for (int r = 0; r < 4; ++r) a[r] = (16 * st + 4 * fq + r > 16 * tw + fr) ? 0.f : a[r];
            pk[st][0] = cvt_pk_bf16(a[0], a[1]); pk[st][1] = cvt_pk_bf16(a[2], a[3]);
        }
        bf16x8 pf[2];
#pragma unroll
        for (int ks = 0; ks < 2; ++ks) { u32x4 pw; pw[0] = pk[2 * ks][0]; pw[1] = pk[2 * ks][1]; pw[2] = pk[2 * ks + 1][0]; pw[3] = pk[2 * ks + 1][1]; pf[ks] = __builtin_bit_cast(bf16x8, pw); }
        f32x4 O[8];
        float ss = 0.f;
        const u32x2 z2 = {0u, 0u};
#pragma unroll
        for (int et = 0; et < 8; ++et) {
            const int e0 = 16 * et;
            f32x4 acc = {0.f, 0.f, 0.f, 0.f};
            const bf16_t* sp = ST + (((size_t)bh * 33 + c) * 128 + e0 + fr) * 64 + 8 * fq;
            const bf16_t* vp = GVT + ((size_t)bh * 128 + e0 + fr) * LPV + 64 * c + 4 * fq;
            acc = __builtin_amdgcn_mfma_f32_16x16x32_bf16(*(const bf16x8*)sp, qf[0], acc, 0, 0, 0);
            acc = __builtin_amdgcn_mfma_f32_16x16x32_bf16(*(const bf16x8*)(sp + 32), qf[1], acc, 0, 0, 0);
            u32x2 va = *(const u32x2*)vp, vb = *(const u32x2*)(vp + 16), vc = *(const u32x2*)(vp + 32), vd = *(const u32x2*)(vp + 48);
            va = (c == 0) ? z2 : va; vb = (c == 0) ? z2 : vb; vc = (c == 0) ? z2 : vc;
            u32x4 vw; vw[0] = va[0]; vw[1] = va[1]; vw[2] = vb[0]; vw[3] = vb[1];
            acc = __builtin_amdgcn_mfma_f32_16x16x32_bf16(__builtin_bit_cast(bf16x8, vw), pf[0], acc, 0, 0, 0);
            u32x4 vx; vx[0] = vc[0]; vx[1] = vc[1]; vx[2] = vd[0]; vx[3] = vd[1];
            acc = __builtin_amdgcn_mfma_f32_16x16x32_bf16(__builtin_bit_cast(bf16x8, vx), pf[1], acc, 0, 0, 0);
            O[et] = acc;
            ss += acc[0] * acc[0] + acc[1] * acc[1] + acc[2] * acc[2] + acc[3] * acc[3];
        }
        ss += __shfl_xor(ss, 16); ss += __shfl_xor(ss, 32);
        const float rinv = rsqrtf(ss * (1.f / 128) + LN_EPS);
        if (pos_t >= 0 && do_store) {
            bf16_t* mp = MIX + ((size_t)b * L + pos_t) * 1024 + h * 128 + 4 * fq;
#pragma unroll
            for (int et = 0; et < 8; ++et) {
                const uint2 gz = *(const uint2*)(mp + 16 * et);
                const f32x4 nv = *(const f32x4*)(ng + 16 * et + 4 * fq);
                const float g0 = __uint_as_float(gz.x << 16), g1 = __uint_as_float(gz.x & 0xFFFF0000u), g2 = __uint_as_float(gz.y << 16), g3 = __uint_as_float(gz.y & 0xFFFF0000u);
                uint2 o; o.x = cvt_pk_bf16(O[et][0] * rinv * nv[0] * g0, O[et][1] * rinv * nv[1] * g1); o.y = cvt_pk_bf16(O[et][2] * rinv * nv[2] * g2, O[et][3] * rinv * nv[3] * g3);
                *(uint2*)(mp + 16 * et) = o;
            }
        }
    }
}

__device__ __forceinline__ void phase_ln(const Params& p_in, int layer_in, char* smem) {
    const Params p = kparams(); const int layer = opaque_int(layer_in); (void)p_in;
    const int tid = opaque_tid(), wid = tid >> 6, lane = tid & 63;
    const float* Z = (const float*)(p.ws + OFF_GQ);
    float* H32 = (float*)(p.ws + OFF_H32);
    bf16_t* HB = (bf16_t*)(p.ws + OFF_HB);
    const float* g = p.ln_g + layer * D; const float* bb = p.ln_b + layer * D;
    const int nw = gridDim.x * 8;
    int t = opaque_bid() * 8 + wid;
    f32x4 v[4], vn[4];
    if (t < T) {
#pragma unroll
        for (int i = 0; i < 4; ++i) v[i] = *(const f32x4*)(Z + (size_t)t * D + 4 * lane + 256 * i);
    }
    for (; t < T; t += nw) {
        const int tn = t + nw;
        if (tn < T) {
#pragma unroll
            for (int i = 0; i < 4; ++i) vn[i] = *(const f32x4*)(Z + (size_t)tn * D + 4 * lane + 256 * i);
        }
        ln_row_wave(v, g, bb, lane);
        if (layer == DEPTH - 1) {
            const int b = t / L, pos = t - b * L;
            if (pos >= NMETA) {
#pragma unroll
                for (int i = 0; i < 4; ++i) *(f32x4*)(p.out + ((size_t)b * SEQ + (pos - NMETA)) * D + 4 * lane + 256 * i) = v[i];
            }
        } else {
#pragma unroll
            for (int i = 0; i < 4; ++i) {
                *(f32x4*)(H32 + (size_t)t * D + 4 * lane + 256 * i) = v[i];
                u32x2 o; o[0] = cvt_pk_bf16(v[i][0], v[i][1]); o[1] = cvt_pk_bf16(v[i][2], v[i][3]);
                *(u32x2*)(HB + (size_t)t * D + 4 * lane + 256 * i) = o;
            }
        }
#pragma unroll
        for (int i = 0; i < 4; ++i) v[i] = vn[i];
    }
}

#define XB_TMO      128
#define XB_XCNT(j)  (256  + 64 * (j))
#define XB_XSUB(j)  (1280 + 64 * (j))
#define XB_XGEN(j)  (2304 + 64 * (j))
#define XB_TOP      3328
#define XB_TOPGEN   3392
#define XCD_BAR_WORDS 3456
#define XB_SPIN_CAP (1u << 22)
__device__ __forceinline__ unsigned xb_ld(unsigned* p)              { return __hip_atomic_load(p, __ATOMIC_RELAXED, __HIP_MEMORY_SCOPE_AGENT); }
__device__ __forceinline__ unsigned xb_add(unsigned* p, unsigned v) { return __hip_atomic_fetch_add(p, v, __ATOMIC_RELAXED, __HIP_MEMORY_SCOPE_AGENT); }
__device__ __forceinline__ unsigned xb_xcc_id() { return (unsigned)__builtin_amdgcn_s_getreg((3 << 11) | 20) & 0xFu; }
#define XB_SPIN(cond, bar) do { unsigned _sp = 0; while (cond) { __builtin_amdgcn_s_sleep(1); \
    if ((++_sp & 255u) == 0u) { if (xb_ld(&(bar)[XB_TMO])) break; if (_sp > XB_SPIN_CAP) { atomicAdd(&(bar)[XB_TMO], 1u); break; } } } } while (0)
struct XcdBarrier { unsigned* bar; unsigned x; volatile LAS unsigned* st; };
__device__ __forceinline__ XcdBarrier xcd_barrier_post(unsigned* bar, volatile LAS unsigned* st) {
    XcdBarrier b; b.bar = bar; b.x = xb_xcc_id(); b.st = st;
    if (threadIdx.x == 0) (void)xb_add(&bar[XB_XCNT(b.x)], 1u);
    return b;
}
__device__ __forceinline__ void xcd_barrier_complete(unsigned* bar, unsigned x, unsigned& nloc, unsigned& nx) {
    const unsigned G = gridDim.x * gridDim.y * gridDim.z;
    unsigned sum, cnt, mine, sp = 0u;
    for (;;) {
        sum = 0u; cnt = 0u; mine = 0u;
#pragma unroll
        for (unsigned j = 0; j < 16; ++j) { const unsigned c = xb_ld(&bar[XB_XCNT(j)]); sum += c; cnt += (c > 0u) ? 1u : 0u; mine = (j == x) ? c : mine; }
        if (sum == G) break;
        __builtin_amdgcn_s_sleep(1);
        if ((++sp & 255u) == 0u) { if (xb_ld(&bar[XB_TMO])) break; if (sp > XB_SPIN_CAP) { atomicAdd(&bar[XB_TMO], 1u); break; } }
    }
    nloc = mine > 0u ? mine : 1u; nx = cnt > 0u ? cnt : 1u;
}
__device__ __forceinline__ void xcd_barrier(unsigned* bar_, volatile LAS unsigned* st_) {
    XcdBarrier b; b.bar = bar_; b.x = xb_xcc_id(); b.st = st_;
    asm volatile("s_waitcnt vmcnt(0)" ::: "memory");
    __syncthreads();
    if (opaque_tid() == 0) {
        unsigned* bar = b.bar;
        __builtin_amdgcn_s_waitcnt(0);
        unsigned nloc = b.st[0], nx = b.st[1];
        if (nloc == 0u) { xcd_barrier_complete(bar, b.x, nloc, nx); b.st[0] = nloc; b.st[1] = nx; }
        const unsigned old = xb_add(&bar[XB_XSUB(b.x)], 1u);
        const unsigned gen = old / nloc;
        if (old + 1u == (gen + 1u) * nloc) {
            __builtin_amdgcn_fence(__ATOMIC_RELEASE, "agent");
            asm volatile("s_waitcnt vmcnt(0)" ::: "memory");
            const unsigned og = xb_add(&bar[XB_TOP], 1u);
            const unsigned tg = og / nx;
            if (og + 1u == (tg + 1u) * nx) xb_add(&bar[XB_TOPGEN], 1u);
            else XB_SPIN(xb_ld(&bar[XB_TOPGEN]) == tg, bar);
            __builtin_amdgcn_fence(__ATOMIC_ACQUIRE, "agent");
            xb_add(&bar[XB_XGEN(b.x)], 1u);
            asm volatile("s_waitcnt vmcnt(0)" ::: "memory");
        } else {
            XB_SPIN(xb_ld(&bar[XB_XGEN(b.x)]) == gen, bar);
            __builtin_amdgcn_fence(__ATOMIC_ACQUIRE, "agent");
            asm volatile("s_waitcnt vmcnt(0)" ::: "memory");
        }
    }
    __syncthreads();
}

constexpr int SMEM_BYTES = 160 * 1024;
static_assert(DS_END <= SMEM_BYTES - 16, "dsa lds");

__global__ void __launch_bounds__(NT, 2) k_mega(Params p) {
    __shared__ __attribute__((aligned(16))) char smem[SMEM_BYTES];
    volatile LAS unsigned* xbw = (volatile LAS unsigned*)((LAS unsigned char*)smem + (SMEM_BYTES - 16));
    if (threadIdx.x == 0) { xbw[0] = 0u; xbw[1] = 0u; xbw[2] = 0u; xbw[3] = 0u; }
    __syncthreads();
    if (p.ws == nullptr) cg::this_grid().sync();
    (void)xcd_barrier_post((unsigned*)(p.ws + OFF_BAR), xbw);
    for (int rep = 0; rep < PROBE_REP_PREP; ++rep) {
    phase_prep(p, smem);
    xcd_barrier((unsigned*)(p.ws + OFF_BAR), xbw);
    }
#pragma unroll 1
    for (int layer = 0; layer < DEPTH; ++layer) {
        for (int rep = 0; rep < PROBE_REP_PROJ; ++rep) {
        phase_proj(p, layer, smem);
        xcd_barrier((unsigned*)(p.ws + OFF_BAR), xbw);
        }
        phase_rope(p, layer, smem);
        for (int rep = 0; rep < PROBE_REP_GLAA; ++rep) {
        phase_gla_a(p, layer, smem);
        xcd_barrier((unsigned*)(p.ws + OFF_BAR), xbw);
        phase_gla_scan(p, layer, smem);
        xcd_barrier((unsigned*)(p.ws + OFF_BAR), xbw);
        }
        for (int rep = 0; rep < PROBE_REP_GLAC; ++rep) phase_gla_c(p, layer, smem, rep == PROBE_REP_GLAC - 1);
        for (int rep = 0; rep < PROBE_REP_DSA; ++rep) phase_dsa(p, layer, smem, rep == PROBE_REP_DSA - 1);
        xcd_barrier((unsigned*)(p.ws + OFF_BAR), xbw);
        for (int rep = 0; rep < PROBE_REP_OUT; ++rep) {
        phase_outproj(p, layer, smem);
        xcd_barrier((unsigned*)(p.ws + OFF_BAR), xbw);
        }
        for (int rep = 0; rep < PROBE_REP_LN; ++rep) {
        phase_ln(p, layer, smem);
        xcd_barrier((unsigned*)(p.ws + OFF_BAR), xbw);
        }
    }
}

extern "C" void kernel_launch(void* const* d_in, const int* in_sizes, int n_in, void* d_out, int out_size, void* d_ws, size_t ws_size,
                              hipStream_t stream) {
    Params p{};
    p.x = (const float*)d_in[0]; p.meta = (const float*)d_in[1]; p.ln_in_g = (const float*)d_in[2]; p.ln_in_b = (const float*)d_in[3];
    p.w_in = (const float*)d_in[4]; p.wg2 = (const float*)d_in[5]; p.bg = (const float*)d_in[6]; p.norm_g = (const float*)d_in[7];
    p.ikg = (const float*)d_in[8]; p.ikb = (const float*)d_in[9]; p.w_out = (const float*)d_in[10]; p.ln_g = (const float*)d_in[11];
    p.ln_b = (const float*)d_in[12];
    p.out = (float*)d_out; p.ws = (char*)d_ws;
    static int grid_blocks = 0;
    if (!grid_blocks) {
        int dev = 0, cus = 0, per_cu = 0;
        hipGetDevice(&dev);
        hipDeviceGetAttribute(&cus, hipDeviceAttributeMultiprocessorCount, dev);
        hipOccupancyMaxActiveBlocksPerMultiprocessor(&per_cu, k_mega, NT, 0);
        if (per_cu > 1) per_cu = 1;
        grid_blocks = cus * per_cu;
    }
    (void)hipMemsetAsync((char*)d_ws + OFF_BAR, 0, XCD_BAR_WORDS * 4, stream);
    void* args[] = {&p};
    (void)hipLaunchCooperativeKernel((void*)k_mega, dim3(grid_blocks), dim3(NT), args, 0, stream);
}
```

```cpp
#include <hip/hip_runtime.h>
#include <hip/hip_cooperative_groups.h>
#include <stdint.h>
namespace cg = cooperative_groups;
#ifndef PROBE_REP_PREP
#define PROBE_REP_PREP 1
#define PROBE_REP_PROJ 1
#define PROBE_REP_GLAA 1
#define PROBE_REP_GLAC 1
#define PROBE_REP_DSA 1
#define PROBE_REP_OUT 1
#define PROBE_REP_LN 1
#define PROBE_DSA_A 1
#define PROBE_DSA_B 1
#define PROBE_DSA_C 1
#endif

constexpr int D = 1024, NB = 8, SEQ = 2048, NMETA = 16, L = 2064, T = NB * L;
constexpr int DEPTH = 2;
constexpr int INW = 3416, INWP = 3584;
constexpr int TP = 16640;
constexpr int NT = 512;
constexpr int TOPK = 256;
constexpr float LN_EPS = 1e-5f;
constexpr float ALPHA = 1.41421356237309515f;

typedef unsigned short bf16_t;
typedef short bf16x8 __attribute__((ext_vector_type(8)));
typedef float f32x4 __attribute__((ext_vector_type(4)));
#define LAS __attribute__((address_space(3)))

constexpr size_t SZ_H32 = (size_t)T * D * 4;
constexpr size_t SZ_HB = (size_t)TP * D * 2;
constexpr size_t SZ_WIN = (size_t)DEPTH * INWP * D * 2;
constexpr size_t SZ_WOUT = (size_t)DEPTH * D * D * 2;
constexpr int LPV = 2112;
constexpr size_t SZ_GQ = (size_t)T * 256 * 2, SZ_GK = SZ_GQ, SZ_GV = (size_t)NB * 4 * 128 * LPV * 2;
constexpr size_t SZ_UT = (size_t)1024 * 128 * 64 * 4, SZ_ST = (size_t)32 * 33 * 128 * 64 * 2, SZ_DL = (size_t)1024 * 64 * 4;
constexpr size_t SZ_AQ = (size_t)T * 512 * 2, SZ_IQ = (size_t)T * 512 * 2;
constexpr size_t SZ_MIX = (size_t)TP * 1024 * 2;
constexpr int LP = 2112;
constexpr size_t SZ_AK = (size_t)T * 128 * 2, SZ_AV = (size_t)NB * 2 * 64 * LP * 2, SZ_IK = (size_t)T * 64 * 2, SZ_IW = (size_t)T * 8 * 4;
constexpr size_t SZ_GLR = (size_t)T * 16 * 4;
constexpr size_t SZ_ROPE = (size_t)L * 8 * 2 * 4;

constexpr size_t OFF_H32 = 0;
constexpr size_t OFF_HB = OFF_H32 + SZ_H32;
constexpr size_t OFF_WIN = OFF_HB + SZ_HB;
constexpr size_t OFF_WOUT = OFF_WIN + SZ_WIN;
constexpr size_t OFF_GQ = OFF_WOUT + SZ_WOUT;
constexpr size_t OFF_GK = OFF_GQ + SZ_GQ;
constexpr size_t OFF_GV = OFF_GK + SZ_GK;
constexpr size_t OFF_AQ = OFF_GV + SZ_GV;
constexpr size_t OFF_IQ = OFF_AQ + SZ_AQ;
constexpr size_t OFF_MIX = OFF_IQ + SZ_IQ;
constexpr size_t OFF_AK = OFF_MIX + SZ_MIX;
constexpr size_t OFF_AV = OFF_AK + SZ_AK;
constexpr size_t OFF_IK = OFF_AV + SZ_AV;
constexpr size_t OFF_IW = OFF_IK + SZ_IK;
constexpr size_t OFF_GLR = OFF_IW + SZ_IW;
constexpr size_t OFF_ROPE = OFF_GLR + SZ_GLR;
constexpr size_t OFF_ST = OFF_ROPE + SZ_ROPE;
constexpr size_t OFF_DL = OFF_ST + SZ_ST;
constexpr size_t OFF_BAR = OFF_DL + SZ_DL;
constexpr size_t OFF_IKR = OFF_BAR + 16384;
constexpr size_t OFF_END = OFF_IKR + (size_t)T * 64 * 4;
constexpr size_t OFF_UT = OFF_HB;
static_assert(SZ_UT <= SZ_HB, "UT alias");
static_assert(SZ_GQ + SZ_GK + SZ_GV + SZ_AQ + SZ_IQ >= SZ_H32, "Z alias size");
static_assert(OFF_END <= (size_t)256 * 1024 * 1024, "workspace too large");

struct Params {
    const float* x; const float* meta; const float* ln_in_g; const float* ln_in_b;
    const float* w_in; const float* wg2; const float* bg; const float* norm_g;
    const float* ikg; const float* ikb; const float* w_out; const float* ln_g; const float* ln_b;
    float* out; char* ws;
};
typedef const Params __attribute__((address_space(4))) * KParamsPtr;
__device__ __forceinline__ Params kparams() {
    unsigned long long a = (unsigned long long)__builtin_amdgcn_kernarg_segment_ptr();
    asm volatile("" : "+s"(a));
    KParamsPtr q = (KParamsPtr)a;
    Params r;
    r.x = q->x; r.meta = q->meta; r.ln_in_g = q->ln_in_g; r.ln_in_b = q->ln_in_b; r.w_in = q->w_in; r.wg2 = q->wg2; r.bg = q->bg; r.norm_g = q->norm_g;
    r.ikg = q->ikg; r.ikb = q->ikb; r.w_out = q->w_out; r.ln_g = q->ln_g; r.ln_b = q->ln_b; r.out = q->out; r.ws = q->ws;
    return r;
}

__device__ __forceinline__ bf16_t f2bf(float f) {
    unsigned u = __float_as_uint(f);
    u += 0x7FFFu + ((u >> 16) & 1u);
    return (bf16_t)(u >> 16);
}
__device__ __forceinline__ unsigned pack2bf(float lo, float hi) { return (unsigned)f2bf(lo) | ((unsigned)f2bf(hi) << 16); }
__device__ __forceinline__ unsigned cvt_pk_bf16(float lo, float hi) { unsigned r; asm volatile("v_cvt_pk_bf16_f32 %0, %1, %2" : "=v"(r) : "v"(lo), "v"(hi)); return r; }
typedef unsigned u32x4 __attribute__((ext_vector_type(4)));
typedef unsigned u32x2 __attribute__((ext_vector_type(2)));
__device__ __forceinline__ float bf2f(bf16_t h) { return __uint_as_float(((unsigned)h) << 16); }
__device__ __forceinline__ int opaque_tid() { int t = threadIdx.x; asm volatile("" : "+v"(t)); return t; }
__device__ __forceinline__ int opaque_int(int v) { asm volatile("" : "+s"(v)); return v; }
__device__ __forceinline__ int opaque_bid() { int t = blockIdx.x; asm volatile("" : "+s"(t)); return t; }
__device__ __forceinline__ float wave_sum(float v) {
#pragma unroll
    for (int o = 32; o > 0; o >>= 1) v += __shfl_xor(v, o);
    return v;
}
__device__ __forceinline__ float wave_max(float v) {
#pragma unroll
    for (int o = 32; o > 0; o >>= 1) v = fmaxf(v, __shfl_xor(v, o));
    return v;
}
__device__ __forceinline__ float block_sum(float v, float* red) {
    v = wave_sum(v);
    const int tq = opaque_tid();
    __syncthreads();
    if ((tq & 63) == 0) red[tq >> 6] = v;
    __syncthreads();
    return ((red[0] + red[1]) + (red[2] + red[3])) + ((red[4] + red[5]) + (red[6] + red[7]));
}
__device__ __forceinline__ float silu_f(float x) { return x / (1.f + __expf(-x)); }
__device__ __forceinline__ float logsigmoid_f(float x) { return fminf(x, 0.f) - log1pf(expf(-fabsf(x))); }
__device__ __forceinline__ float logsigmoid_fast(float x) { return fminf(x, 0.f) - __logf(1.f + __expf(-fabsf(x))); }

__device__ __forceinline__ int proj_src_col(int n) {
    if (n < 1024) return n;
    if (n < 1536) return n - 1024 + 1040;
    if (n < 2048) return n - 1536 + 1552;
    if (n < 2560) return n - 2048 + 2904;
    if (n < 3072) return n - 2560 + 2320;
    if (n < 3200) return n - 3072 + 2064;
    if (n < 3328) return n - 3200 + 2192;
    const int c = n - 3328;
    if (c < 32) return 2832 + c;
    if (c < 48) return 1024 + (c - 32);
    if (c < 56) return 2896 + (c - 48);
    if (c >= 128 && c < 160) return 2832 + 32 + (c - 128);
    return -1;
}

__device__ __forceinline__ void sincos_acc(float a, float& s, float& c) {
    double ad = (double)a;
    double kd = rint(ad * 0.63661977236758134308);
    double r = fma(-kd, 1.57079632679489655800, ad);
    r = fma(-kd, 6.12323399573676603587e-17, r);
    double r2 = r * r;
    double sp = r * (1.0 + r2 * (-1.0 / 6 + r2 * (1.0 / 120 + r2 * (-1.0 / 5040 + r2 * (1.0 / 362880 + r2 * (-1.0 / 39916800))))));
    double cp = 1.0 + r2 * (-0.5 + r2 * (1.0 / 24 + r2 * (-1.0 / 720 + r2 * (1.0 / 40320 + r2 * (-1.0 / 3628800 + r2 * (1.0 / 479001600))))));
    int q = ((int)kd) & 3;
    double ss = (q & 1) ? cp : sp, cc = (q & 1) ? sp : cp;
    if (q == 1 || q == 2) cc = -cc;
    if (q == 2 || q == 3) ss = -ss;
    s = (float)ss; c = (float)cc;
}

__device__ __forceinline__ void ln_row_wave(f32x4 (&v)[4], const float* g, const float* bb, int lane) {
    float sm = 0.f;
#pragma unroll
    for (int i = 0; i < 4; ++i) sm += (v[i][0] + v[i][1]) + (v[i][2] + v[i][3]);
    const float mu = wave_sum(sm) * (1.f / D);
    float qq = 0.f;
#pragma unroll
    for (int i = 0; i < 4; ++i) { v[i] = v[i] - mu; qq += (v[i][0] * v[i][0] + v[i][1] * v[i][1]) + (v[i][2] * v[i][2] + v[i][3] * v[i][3]); }
    const float rs = rsqrtf(wave_sum(qq) * (1.f / D) + LN_EPS);
#pragma unroll
    for (int i = 0; i < 4; ++i) { const f32x4 gg = *(const f32x4*)(g + 4 * lane + 256 * i), b4 = *(const f32x4*)(bb + 4 * lane + 256 * i); v[i] = v[i] * rs * gg + b4; }
}
__device__ __forceinline__ int proj_dst_col(int src) {
    if (src < 1024) return src;
    if (src < 1040) return 3328 + 32 + (src - 1024);
    if (src < 1552) return 1024 + (src - 1040);
    if (src < 2064) return 1536 + (src - 1552);
    if (src < 2192) return 3072 + (src - 2064);
    if (src < 2320) return 3200 + (src - 2192);
    if (src < 2832) return 2560 + (src - 2320);
    if (src < 2864) return 3328 + (src - 2832);
    if (src < 2896) return 3328 + 128 + (src - 2864);
    if (src < 2904) return 3328 + 48 + (src - 2896);
    return 2048 + (src - 2904);
}
__device__ __forceinline__ void phase_prep(const Params& p_in, char* smem) {
    const Params p = kparams(); (void)p_in;
    const int tid = opaque_tid(), wid = tid >> 6, lane = tid & 63;
    bf16_t* WIN = (bf16_t*)(p.ws + OFF_WIN);
    bf16_t* WOUT = (bf16_t*)(p.ws + OFF_WOUT);
    float* H32 = (float*)(p.ws + OFF_H32);
    bf16_t* HB = (bf16_t*)(p.ws + OFF_HB);
    bf16_t* MIX = (bf16_t*)(p.ws + OFF_MIX);
    float2* ROPE = (float2*)(p.ws + OFF_ROPE);
    float (*tile)[65] = (float (*)[65])smem;
    constexpr int NCT_IN = (INW + 63) / 64, NT_IN = DEPTH * 16 * NCT_IN, NT_OUT = DEPTH * 16 * 16;
    for (int item = opaque_bid(); item < NT_IN + NT_OUT; item += gridDim.x) {
        const bool is_in = item < NT_IN;
        const int it = is_in ? item : item - NT_IN;
        const int nct = is_in ? NCT_IN : 16, ldw = is_in ? INW : D;
        const int l = it / (16 * nct), rem = it - l * 16 * nct, kt = rem / nct, ct = rem - kt * nct;
        const float* W = (is_in ? p.w_in : p.w_out) + (size_t)l * D * ldw;
        __syncthreads();
#pragma unroll
        for (int i = 0; i < 8; ++i) {
            const int e = tid + NT * i, kk = e >> 6, nn = e & 63, col = ct * 64 + nn;
            tile[kk][nn] = (col < ldw) ? W[(size_t)(kt * 64 + kk) * ldw + col] : 0.f;
        }
        __syncthreads();
        {
            const int nn = tid >> 3, k8 = (tid & 7) * 8, src = ct * 64 + nn;
            if (src < ldw) {
                const int dst = is_in ? proj_dst_col(src) : src;
                u32x4 o;
#pragma unroll
                for (int q = 0; q < 4; ++q) o[q] = cvt_pk_bf16(tile[k8 + 2 * q][nn], tile[k8 + 2 * q + 1][nn]);
                bf16_t* dstp = (is_in ? WIN + ((size_t)l * INWP + dst) * D : WOUT + ((size_t)l * D + dst) * D) + kt * 64 + k8;
                *(u32x4*)dstp = o;
            }
        }
    }
    {
        const int nw = gridDim.x * 8;
        for (int t = opaque_bid() * 8 + wid; t < TP; t += nw) {
            if (t < T) {
                const int b = t / L, pos = t - b * L;
                const float* src = (pos < NMETA) ? (p.meta + (size_t)pos * D) : (p.x + ((size_t)b * SEQ + (pos - NMETA)) * D);
                f32x4 v[4];
#pragma unroll
                for (int i = 0; i < 4; ++i) v[i] = *(const f32x4*)(src + 4 * lane + 256 * i);
                ln_row_wave(v, p.ln_in_g, p.ln_in_b, lane);
#pragma unroll
                for (int i = 0; i < 4; ++i) {
                    *(f32x4*)(H32 + (size_t)t * D + 4 * lane + 256 * i) = v[i];
                    u32x2 o; o[0] = cvt_pk_bf16(v[i][0], v[i][1]); o[1] = cvt_pk_bf16(v[i][2], v[i][3]);
                    *(u32x2*)(HB + (size_t)t * D + 4 * lane + 256 * i) = o;
                }
            } else {
#pragma unroll
                for (int i = 0; i < 4; ++i) {
                    *(u32x2*)(HB + (size_t)t * D + 4 * lane + 256 * i) = (u32x2){0u, 0u};
                    *(u32x2*)(MIX + (size_t)t * D + 4 * lane + 256 * i) = (u32x2){0u, 0u};
                }
            }
        }
    }
    for (int e = opaque_bid() * NT + tid; e < L * 8; e += gridDim.x * NT) {
        const int pos = e >> 3, i = e & 7;
        const float inv[8] = {1.0f, 0.19392274f, 0.03760603f, 0.0072926646f, 0.0014142136f, 0.0002742482f, 5.3182957e-05f, 1.0313385e-05f};
        float iv = inv[0];
#pragma unroll
        for (int j = 1; j < 8; ++j) iv = (i == j) ? inv[j] : iv;
        const float ang = (float)pos * iv;
        float sn, cs; sincos_acc(ang, sn, cs);
        ROPE[e] = make_float2(cs, sn);
    }
}

namespace pg8 {
constexpr int BM = 256, BK = 64, HALF = 128, HTB = HALF * BK * 2  , STAGE_BYTES = 8 * HTB, NXCD = 8, WGM = 8;
__device__ __forceinline__ int lds_byte(int r, int c) { const int st = (r >> 4) * 2 + (c >> 5), rr = r & 15, cc = c & 31, ob = rr * 64 + cc * 2; return st * 1024 + (ob ^ (((ob >> 9) & 1) << 5)); }
__device__ __forceinline__ void stage_rc(int b, int& R, int& C) { const int st = b / 1024, sb = b % 1024, swz = sb ^ (((sb >> 9) & 1) << 5); R = (st >> 1) * 16 + swz / 64; C = (st & 1) * 32 + (swz % 64) / 2; }
__device__ __forceinline__ int perm32(int rho) { const int n = rho >> 4, i = rho & 15; return 8 * (i >> 2) + 4 * n + (i & 3); }

struct Unit { int pm, pn; };
struct Gemm { const bf16_t* A; const bf16_t* Bt; int M, N, K; };

struct StaticOrder {
    int nM, nN, nwg, G, c;
    __device__ void init(int M, int N, int G_, int c_) { nM = M / BM; nN = N / BM; nwg = nM * nN; G = G_; c = c_; }
    __device__ bool next(int i, Unit& u) const {
        const long Lx = (long)i * G + c; if (Lx >= nwg) return false;
        int wgid = (int)Lx; { const int q = nwg / NXCD, r = nwg % NXCD, xcd = wgid % NXCD, off = wgid / NXCD; wgid = (xcd < r ? xcd * (q + 1) : r * (q + 1) + (xcd - r) * q) + off; }
        const int nig = WGM * nN, gid = wgid / nig, fm = gid * WGM, gsz = (nM - fm) < WGM ? (nM - fm) : WGM;
        u.pm = fm + ((wgid % nig) % gsz); u.pn = (wgid % nig) / gsz; return true;
    }
    __device__ __forceinline__ void a_ready(const Unit&) const {}
    __device__ __forceinline__ void done(const Unit&) const {}
};

template <class Epi, class Sched>
__device__ __forceinline__ void gemm_phase(LAS unsigned char* lds, const Gemm g, const Sched& S, const Epi& E) {
    const int tid = opaque_tid(), wid = __builtin_amdgcn_readfirstlane(tid >> 6), lane = tid & 63, wr = wid >> 2, wc = wid & 3, fr = lane & 15, fq = lane >> 4;
    const int K = g.K, nt = K / BK;
    unsigned voffA[2], voffB[2];
#pragma unroll
    for (int i = 0; i < 2; ++i) { int R, C; stage_rc(tid * 16 + i * 8192, R, C); const int Rb = Epi::PERM ? ((R & ~31) + perm32(R & 31)) : R;
        voffA[i] = (unsigned)(R * K + C) * 2u; voffB[i] = (unsigned)(Rb * K + C) * 2u; }
    const size_t kstep = (size_t)(BK * 2);
    const size_t hstep = (size_t)HALF * K * 2;
    const size_t tstep = 2 * hstep;
    const unsigned ldsw = (unsigned)wid * 1024u;
    const int aoff = lds_byte(wr * 64 + fr, fq * 8), boff = lds_byte(wc * 32 + fr, fq * 8);
#define PG8_SA(b, h) (((b) * 2 + (h)) * HTB)
#define PG8_SB(b, h) ((4 + (b) * 2 + (h)) * HTB)
#define PG8_STAGE(bufoff, gbase, voff) do { _Pragma("unroll") for (int _i = 0; _i < 2; ++_i) \
        __builtin_amdgcn_global_load_lds((const unsigned*)((const char*)(gbase) + (voff)[_i]), (LAS unsigned*)(lds + (bufoff) + ldsw + _i * 8192), 16, 0, 0); } while (0)
#define PG8_LDA(dst, b, h) do { _Pragma("unroll") for (int m = 0; m < 4; ++m) _Pragma("unroll") for (int k = 0; k < 2; ++k) dst[m][k] = *(const LAS bf16x8*)(lds + PG8_SA(b, h) + aoff + m * 2048 + k * 1024); } while (0)
#define PG8_LDB(dst, b, h) do { _Pragma("unroll") for (int n = 0; n < 2; ++n) _Pragma("unroll") for (int k = 0; k < 2; ++k) dst[n][k] = *(const LAS bf16x8*)(lds + PG8_SB(b, h) + boff + n * 2048 + k * 1024); } while (0)
#define PG8_MMA(ai, bj, At, Bt) do { __builtin_amdgcn_s_setprio(1); _Pragma("unroll") for (int m = 0; m < 4; ++m) _Pragma("unroll") for (int n = 0; n < 2; ++n) _Pragma("unroll") for (int k = 0; k < 2; ++k) \
        acc[ai][bj][m][n] = __builtin_amdgcn_mfma_f32_16x16x32_bf16(Bt[n][k], At[m][k], acc[ai][bj][m][n], 0, 0, 0); __builtin_amdgcn_s_setprio(0); } while (0)
#define PG8_WAIT_V(n) asm volatile("s_waitcnt vmcnt(" #n ")" ::: "memory")
#define PG8_WAIT_L(n) asm volatile("s_waitcnt lgkmcnt(" #n ")" ::: "memory")
#define PG8_BAR __builtin_amdgcn_s_barrier()
#define PG8_SCHED __builtin_amdgcn_sched_barrier(0)
    Unit cur, nxt; int ui = 0;
    if (!S.next(0, cur)) return;
    f32x4 acc[2][2][4][2];
#pragma unroll
    for (int a = 0; a < 2; ++a)
#pragma unroll
        for (int b = 0; b < 2; ++b)
#pragma unroll
            for (int m = 0; m < 4; ++m)
#pragma unroll
                for (int n = 0; n < 2; ++n) acc[a][b][m][n] = (f32x4){0.f, 0.f, 0.f, 0.f};
    bf16x8 At[4][2], B0[2][2], B1[2][2];
    const char* cA = (const char*)g.A + (size_t)cur.pm * tstep; const char* cB = (const char*)g.Bt + (size_t)cur.pn * tstep;
    S.a_ready(cur);
    PG8_STAGE(PG8_SB(0, 0), cB, voffB); PG8_STAGE(PG8_SA(0, 0), cA, voffA); PG8_STAGE(PG8_SB(0, 1), cB + hstep, voffB); PG8_STAGE(PG8_SA(0, 1), cA + hstep, voffA);
    if (wr == 1) PG8_BAR;
    PG8_WAIT_V(4); PG8_BAR;
    PG8_STAGE(PG8_SB(1, 0), cB + kstep, voffB); PG8_STAGE(PG8_SA(1, 0), cA + kstep, voffA); PG8_STAGE(PG8_SB(1, 1), cB + hstep + kstep, voffB);
    PG8_WAIT_V(6); PG8_BAR;
    for (;;) {
        const bool has_next = S.next(ui + 1, nxt);
        const char* nA = has_next ? (const char*)g.A + (size_t)nxt.pm * tstep : cA; const char* nB = has_next ? (const char*)g.Bt + (size_t)nxt.pn * tstep : cB;
        for (int t = 0; t < nt; t += 2) {
            const bool last = (t == nt - 2);
            const char* a1 = cA + (size_t)(t + 1) * kstep;
            const char* a2 = last ? nA : cA + (size_t)(t + 2) * kstep; const char* b2 = last ? nB : cB + (size_t)(t + 2) * kstep;
            const char* a3 = a2 + kstep; const char* b3 = b2 + kstep;
            if (last && has_next) S.a_ready(nxt);
            PG8_LDB(B0, 0, 0); PG8_SCHED; PG8_LDA(At, 0, 0); PG8_STAGE(PG8_SA(1, 1), a1 + hstep, voffA);
            PG8_WAIT_L(8); PG8_BAR; PG8_WAIT_L(0); PG8_MMA(0, 0, At, B0); PG8_BAR; PG8_SCHED;
            PG8_LDB(B1, 0, 1); PG8_STAGE(PG8_SB(0, 0), b2, voffB);
            PG8_BAR; PG8_WAIT_L(0); PG8_MMA(0, 1, At, B1); PG8_BAR;
            PG8_LDA(At, 0, 1); PG8_STAGE(PG8_SA(0, 0), a2, voffA);
            PG8_BAR; PG8_WAIT_L(0); PG8_MMA(1, 0, At, B0); PG8_BAR; PG8_SCHED;
            PG8_STAGE(PG8_SB(0, 1), b2 + hstep, voffB);
            PG8_WAIT_V(6); PG8_BAR; PG8_MMA(1, 1, At, B1); PG8_BAR;
            PG8_LDB(B0, 1, 0); PG8_SCHED; PG8_LDA(At, 1, 0); PG8_STAGE(PG8_SA(0, 1), a2 + hstep, voffA);
            PG8_WAIT_L(8); PG8_BAR; PG8_WAIT_L(0); PG8_MMA(0, 0, At, B0); PG8_BAR; PG8_SCHED;
            PG8_LDB(B1, 1, 1); PG8_STAGE(PG8_SB(1, 0), b3, voffB);
            PG8_BAR; PG8_WAIT_L(0); PG8_MMA(0, 1, At, B1); PG8_BAR;
            PG8_LDA(At, 1, 1); PG8_STAGE(PG8_SA(1, 0), a3, voffA);
            PG8_BAR; PG8_WAIT_L(0); PG8_MMA(1, 0, At, B0); PG8_BAR; PG8_SCHED;
            PG8_STAGE(PG8_SB(1, 1), b3 + hstep, voffB);
            PG8_WAIT_V(6); PG8_BAR; PG8_MMA(1, 1, At, B1); PG8_BAR;
        }
        E(acc, cur, wr, wc, fr, fq); S.done(cur);
        if (!has_next) break;
#pragma unroll
        for (int a = 0; a < 2; ++a)
#pragma unroll
            for (int b = 0; b < 2; ++b)
#pragma unroll
                for (int m = 0; m < 4; ++m)
#pragma unroll
                    for (int n = 0; n < 2; ++n) acc[a][b][m][n] = (f32x4){0.f, 0.f, 0.f, 0.f};
        cur = nxt; cA = nA; cB = nB; ++ui;
    }
    PG8_WAIT_V(0);
    if (wr == 0) PG8_BAR;
    PG8_BAR;
#undef PG8_SA
#undef PG8_SB
#undef PG8_STAGE
#undef PG8_LDA
#undef PG8_LDB
#undef PG8_MMA
#undef PG8_WAIT_V
#undef PG8_WAIT_L
#undef PG8_BAR
#undef PG8_SCHED
}
}

struct EpiProj {
    static constexpr bool PERM = true;
    char* ws;
    __device__ __forceinline__ void store8(bf16_t* dst, const f32x4& a, const f32x4& b, float sc) const {
        u32x4 o; o[0] = cvt_pk_bf16(a[0] * sc, a[1] * sc); o[1] = cvt_pk_bf16(a[2] * sc, a[3] * sc); o[2] = cvt_pk_bf16(b[0] * sc, b[1] * sc); o[3] = cvt_pk_bf16(b[2] * sc, b[3] * sc);
        *(u32x4*)dst = o;
    }
    __device__ __forceinline__ void operator()(const f32x4 (&acc)[2][2][4][2], const pg8::Unit& u, int wr, int wc, int fr, int fq) const {
        asm volatile("" : "+v"(fr), "+v"(fq));
        if (u.pn < 13) {
#pragma unroll
            for (int bj = 0; bj < 2; ++bj) {
                const int hb = 4 * u.pn + 2 * bj + (wc >> 1);
                const int cc8 = 32 * (wc & 1) + 8 * fq;
#pragma unroll
                for (int ai = 0; ai < 2; ++ai)
#pragma unroll
                    for (int m = 0; m < 4; ++m) {
                        const int t = 256 * u.pm + 128 * ai + 64 * wr + 16 * m + fr;
                        const f32x4 v0 = acc[ai][bj][m][0], v1 = acc[ai][bj][m][1];
                        if (t < T) {
                            const size_t tt = (size_t)t;
                            if (hb < 4) store8((bf16_t*)(ws + OFF_GQ) + tt * 256 + hb * 64 + cc8, v0, v1, 0.125f);
                            else if (hb < 8) store8((bf16_t*)(ws + OFF_GK) + tt * 256 + (hb - 4) * 64 + cc8, v0, v1, 1.f);
                            else if (hb < 16) {
                                const int bq = t / L, pos = t - bq * L;
                                bf16_t* dst = (bf16_t*)(ws + OFF_GV) + ((size_t)(bq * 4 + ((hb - 8) >> 1)) * 128 + ((hb - 8) & 1) * 64 + cc8) * LPV + 48 + pos;
#pragma unroll
                                for (int j = 0; j < 4; ++j) { dst[(size_t)j * LPV] = f2bf(v0[j]); dst[(size_t)(4 + j) * LPV] = f2bf(v1[j]); }
                            }
                            else if (hb < 24 || (hb >= 32 && hb < 40)) {
                                f32x4 s0, s1;
#pragma unroll
                                for (int j = 0; j < 4; ++j) { s0[j] = silu_f(v0[j]); s1[j] = silu_f(v1[j]); }
                                const int col = (hb < 24) ? (hb - 16) * 64 : 512 + (hb - 32) * 64;
                                store8((bf16_t*)(ws + OFF_MIX) + tt * 1024 + col + cc8, s0, s1, 1.f);
                            }
                            else if (hb < 32) store8((bf16_t*)(ws + OFF_AQ) + tt * 512 + (hb - 24) * 64 + cc8, v0, v1, 0.125f * 1.44269504088896341f);
                            else if (hb < 48) store8((bf16_t*)(ws + OFF_IQ) + tt * 512 + (hb - 40) * 64 + cc8, v0, v1, 0.125f);
                            else if (hb < 50) store8((bf16_t*)(ws + OFF_AK) + tt * 128 + (hb - 48) * 64 + cc8, v0, v1, 1.f);
                            else {
                                const int bq = t / L, pos = t - bq * L;
                                bf16_t* dst = (bf16_t*)(ws + OFF_AV) + ((size_t)(bq * 2 + (hb - 50)) * 64 + cc8) * LP + pos;
#pragma unroll
                                for (int j = 0; j < 4; ++j) { dst[(size_t)j * LP] = f2bf(v0[j]); dst[(size_t)(4 + j) * LP] = f2bf(v1[j]); }
                            }
                        }
                        asm volatile("" ::: "memory");
                    }
            }
        } else {
#pragma unroll
            for (int ai = 0; ai < 2; ++ai)
#pragma unroll
                for (int m = 0; m < 4; ++m) {
                    const int t = 256 * u.pm + 128 * ai + 64 * wr + 16 * m + fr;
                    if (t < T) {
                        if (wc == 0) {
                            float* dst = (float*)(ws + OFF_IKR) + (size_t)t * 64 + 8 * fq;
                            *(f32x4*)dst = acc[ai][0][m][0]; *(f32x4*)(dst + 4) = acc[ai][0][m][1];
                            *(f32x4*)(dst + 32) = acc[ai][1][m][0]; *(f32x4*)(dst + 36) = acc[ai][1][m][1];
                        } else if (wc == 1) {
                            const f32x4 v0 = acc[ai][0][m][0], v1 = acc[ai][0][m][1];
                            if (fq < 2) {
                                float* dst = (float*)(ws + OFF_GLR) + (size_t)t * 16 + 8 * fq;
                                *(f32x4*)dst = v0; *(f32x4*)(dst + 4) = v1;
                            } else if (fq == 2) {
                                float* dst = (float*)(ws + OFF_IW) + (size_t)t * 8;
                                *(f32x4*)dst = v0 * 0.353553390593273762f; *(f32x4*)(dst + 4) = v1 * 0.353553390593273762f;
                            }
                        }
                    }
                    asm volatile("" ::: "memory");
                }
        }
    }
};

struct EpiOut {
    static constexpr bool PERM = false;
    const float* H32; float* Z;
    __device__ __forceinline__ void operator()(const f32x4 (&acc)[2][2][4][2], const pg8::Unit& u, int wr, int wc, int fr, int fq) const {
        asm volatile("" : "+v"(fr), "+v"(fq));
        const int col0 = u.pn * 256 + wc * 32 + 4 * fq;
#pragma unroll
        for (int ai = 0; ai < 2; ++ai) {
            f32x4 hv[4][2][2];
#pragma unroll
            for (int m = 0; m < 4; ++m) {
                int t = 256 * u.pm + 128 * ai + 64 * wr + 16 * m + fr; t = t < T ? t : T - 1;
                const size_t off = (size_t)t * D + col0;
#pragma unroll
                for (int bj = 0; bj < 2; ++bj)
#pragma unroll
                    for (int n = 0; n < 2; ++n) hv[m][bj][n] = *(const f32x4*)(H32 + off + bj * 128 + n * 16);
            }
#pragma unroll
            for (int m = 0; m < 4; ++m) {
                const int t = 256 * u.pm + 128 * ai + 64 * wr + 16 * m + fr;
                if (t < T) {
                    const size_t off = (size_t)t * D + col0;
#pragma unroll
                    for (int bj = 0; bj < 2; ++bj)
#pragma unroll
                        for (int n = 0; n < 2; ++n) *(f32x4*)(Z + off + bj * 128 + n * 16) = acc[ai][bj][m][n] + hv[m][bj][n] * ALPHA;
                }
            }
            asm volatile("" ::: "memory");
        }
    }
};

__device__ __forceinline__ void phase_proj(const Params& p_in, int layer_in, char* smem) {
    const Params p = kparams(); const int layer = opaque_int(layer_in); (void)p_in;
    pg8::Gemm g; g.A = (const bf16_t*)(p.ws + OFF_HB); g.Bt = (const bf16_t*)(p.ws + OFF_WIN) + (size_t)layer * INWP * D; g.M = TP; g.N = INWP; g.K = D;
    pg8::StaticOrder S; S.init(TP, INWP, gridDim.x, opaque_bid());
    EpiProj E; E.ws = p.ws;
    pg8::gemm_phase((LAS unsigned char*)smem, g, S, E);
}
__device__ __forceinline__ void phase_outproj(const Params& p_in, int layer_in, char* smem) {
    const Params p = kparams(); const int layer = opaque_int(layer_in); (void)p_in;
    const bf16_t* MIXp = (const bf16_t*)(p.ws + OFF_MIX);
    const bf16_t* WOUT = (const bf16_t*)(p.ws + OFF_WOUT) + (size_t)layer * D * D;
    const float* H32 = (const float*)(p.ws + OFF_H32);
    float* Z = (float*)(p.ws + OFF_GQ);
    {
        pg8::Gemm g; g.A = MIXp; g.Bt = WOUT; g.M = 16384; g.N = D; g.K = D;
        pg8::StaticOrder S; S.init(16384, D, gridDim.x, opaque_bid());
        EpiOut E; E.H32 = H32; E.Z = Z;
        pg8::gemm_phase((LAS unsigned char*)smem, g, S, E);
    }
    const int tid = opaque_tid(), wid = __builtin_amdgcn_readfirstlane(tid >> 6), lane = tid & 63, fr = lane & 15, fq = lane >> 4;
    for (int task = opaque_bid(); task < 64; task += gridDim.x) {
        const int rg = task >> 3, cs = task & 7;
        const bf16_t* ap = MIXp + (size_t)(16384 + 16 * rg + fr) * D + 8 * fq;
        const bf16_t* bp = WOUT + (size_t)(128 * cs + 16 * wid + fr) * D + 8 * fq;
        f32x4 acc = {0.f, 0.f, 0.f, 0.f};
        bf16x8 a0[8], b0[8], a1[8], b1[8];
#pragma unroll
        for (int k = 0; k < 8; ++k) { a0[k] = *(const bf16x8*)(ap + 32 * k); b0[k] = *(const bf16x8*)(bp + 32 * k); }
#pragma unroll
        for (int ch = 0; ch < 4; ++ch) {
            if (ch < 3) {
#pragma unroll
                for (int k = 0; k < 8; ++k) { a1[k] = *(const bf16x8*)(ap + 256 * (ch + 1) + 32 * k); b1[k] = *(const bf16x8*)(bp + 256 * (ch + 1) + 32 * k); }
            }
#pragma unroll
            for (int k = 0; k < 8; ++k) acc = __builtin_amdgcn_mfma_f32_16x16x32_bf16(a0[k], b0[k], acc, 0, 0, 0);
#pragma unroll
            for (int k = 0; k < 8; ++k) { a0[k] = a1[k]; b0[k] = b1[k]; }
        }
#pragma unroll
        for (int r = 0; r < 4; ++r) {
            const size_t off = (size_t)(16384 + 16 * rg + 4 * fq + r) * D + 128 * cs + 16 * wid + fr;
            Z[off] = acc[r] + ALPHA * H32[off];
        }
    }
}

__device__ __forceinline__ void phase_gla_naive(const Params& p, int layer, char* smem) {
    float (*qs)[64] = (float (*)[64])smem;
    float (*ks)[64] = qs + 8;
    float (*es)[64] = ks + 8;
    float (*part)[8] = (float (*)[8])(es + 8);
    float (*os)[128] = (float (*)[128])(part + 2);
    const int tid = opaque_tid();
    const bf16_t* GQ = (const bf16_t*)(p.ws + OFF_GQ);
    const bf16_t* GK = (const bf16_t*)(p.ws + OFF_GK);
    const bf16_t* GV = (const bf16_t*)(p.ws + OFF_GV);
    const float* GLR = (const float*)(p.ws + OFF_GLR);
    bf16_t* MIX = (bf16_t*)(p.ws + OFF_MIX);
    const float* ng = p.norm_g + layer * 128;
    const float* wg2 = p.wg2 + (size_t)layer * 16 * 256; const float* bg = p.bg + layer * 256;
    for (int item = opaque_bid(); item < NB * 4; item += gridDim.x) {
        const int b = item >> 2, h = item & 3;
        float S[64];
#pragma unroll
        for (int d = 0; d < 64; ++d) S[d] = 0.f;
        const int e = tid & 127;
        const float nge = ng[e];
        const int ltt = tid >> 6, ld = tid & 63;
        float w[16];
#pragma unroll
        for (int rr = 0; rr < 16; ++rr) w[rr] = wg2[rr * 256 + h * 64 + ld];
        const float bgd = bg[h * 64 + ld];
        for (int t0 = 0; t0 < L; t0 += 8) {
            __syncthreads();
            {
                const size_t row = (size_t)b * L + t0 + ltt;
                qs[ltt][ld] = bf2f(GQ[row * 256 + h * 64 + ld]);
                ks[ltt][ld] = bf2f(GK[row * 256 + h * 64 + ld]);
                const float4* gp = (const float4*)&GLR[row * 16];
                const float4 g0 = gp[0], g1 = gp[1], g2 = gp[2], g3 = gp[3];
                float s = bgd;
                s = fmaf(g0.x, w[0], s); s = fmaf(g0.y, w[1], s); s = fmaf(g0.z, w[2], s); s = fmaf(g0.w, w[3], s);
                s = fmaf(g1.x, w[4], s); s = fmaf(g1.y, w[5], s); s = fmaf(g1.z, w[6], s); s = fmaf(g1.w, w[7], s);
                s = fmaf(g2.x, w[8], s); s = fmaf(g2.y, w[9], s); s = fmaf(g2.z, w[10], s); s = fmaf(g2.w, w[11], s);
                s = fmaf(g3.x, w[12], s); s = fmaf(g3.y, w[13], s); s = fmaf(g3.z, w[14], s); s = fmaf(g3.w, w[15], s);
                es[ltt][ld] = expf(logsigmoid_f(s) * (1.f / 16.f));
            }
            __syncthreads();
            if (tid < 128) {
#pragma unroll 1
                for (int tt = 0; tt < 8; ++tt) {
                    const size_t row = (size_t)b * L + t0 + tt;
                    const float v = bf2f(GV[row * 512 + h * 128 + e]);
                    float acc = 0.f;
#pragma unroll
                    for (int d = 0; d < 64; ++d) {
                        S[d] = fmaf(es[tt][d], S[d], ks[tt][d] * v);
                        acc = fmaf(qs[tt][d], S[d], acc);
                    }
                    os[tt][e] = acc;
                    const float ss = wave_sum(acc * acc);
                    if ((tid & 63) == 0) part[tid >> 6][tt] = ss;
                }
            }
            __syncthreads();
            if (tid < 128) {
#pragma unroll 1
                for (int tt = 0; tt < 8; ++tt) {
                    const size_t row = (size_t)b * L + t0 + tt;
                    const float tot = part[0][tt] + part[1][tt];
                    const float rinv = rsqrtf(tot * (1.f / 128) + LN_EPS);
                    const size_t idx = row * 1024 + h * 128 + e;
                    MIX[idx] = f2bf(os[tt][e] * rinv * nge * bf2f(MIX[idx]));
                }
            }
        }
    }
}

__device__ __forceinline__ unsigned okey(float x) {
    const unsigned u = __float_as_uint(x);
    return (u & 0x80000000u) ? ~u : (u | 0x80000000u);
}
__device__ __forceinline__ int wave_incl_scan(int v) {
    const int lane = opaque_tid() & 63;
#pragma unroll
    for (int o = 1; o < 64; o <<= 1) { const int n = __shfl_up(v, o); if (lane >= o) v += n; }
    return v;
}
__device__ __forceinline__ int block_excl_scan(int v, int* tmp) {
    const int incl = wave_incl_scan(v);
    const int tq = opaque_tid();
    __syncthreads();
    if ((tq & 63) == 63) tmp[tq >> 6] = incl;
    __syncthreads();
    const int w = tq >> 6;
    int base = 0;
    for (int i = 0; i < w; ++i) base += tmp[i];
    return base + incl - v;
}
__device__ __forceinline__ void unpack8(const uint4 u, float* kf) {
    kf[0] = __uint_as_float(u.x << 16); kf[1] = __uint_as_float(u.x & 0xFFFF0000u);
    kf[2] = __uint_as_float(u.y << 16); kf[3] = __uint_as_float(u.y & 0xFFFF0000u);
    kf[4] = __uint_as_float(u.z << 16); kf[5] = __uint_as_float(u.z & 0xFFFF0000u);
    kf[6] = __uint_as_float(u.w << 16); kf[7] = __uint_as_float(u.w & 0xFFFF0000u);
}

__device__ __forceinline__ void phase_dsa_naive(const Params& p, int layer, char* smem) {
    float* sc = (float*)smem;
    float (*iqs)[64] = (float (*)[64])(sc + 2080);
    float (*aqs)[64] = iqs + 8;
    float (*lg)[256] = (float (*)[256])(aqs + 8);
    unsigned* hist = (unsigned*)(lg + 8);
    int* sel = (int*)(hist + 256);
    int* misc = sel + 256;
    const int tid = opaque_tid();
    const bf16_t* IQ = (const bf16_t*)(p.ws + OFF_IQ);
    const bf16_t* IK = (const bf16_t*)(p.ws + OFF_IK);
    const float* IW = (const float*)(p.ws + OFF_IW);
    const bf16_t* AQ = (const bf16_t*)(p.ws + OFF_AQ);
    const bf16_t* AK = (const bf16_t*)(p.ws + OFF_AK);
    const bf16_t* AV = (const bf16_t*)(p.ws + OFF_AV);
    bf16_t* MIX = (bf16_t*)(p.ws + OFF_MIX);
    for (int item = opaque_bid(); item < T; item += gridDim.x) {
        const int b = item / L, t = item % L;
        const size_t row = (size_t)item;
        __syncthreads();
        iqs[tid >> 6][tid & 63] = bf2f(IQ[row * 512 + tid]); aqs[tid >> 6][tid & 63] = bf2f(AQ[row * 512 + tid]);
        __syncthreads();
        float w[8];
#pragma unroll
        for (int j = 0; j < 8; ++j) w[j] = IW[row * 8 + j];
        for (int s = tid; s <= t; s += NT) {
            const uint4* kp = (const uint4*)&IK[((size_t)b * L + s) * 64];
            float dd[8];
#pragma unroll
            for (int j = 0; j < 8; ++j) dd[j] = 0.f;
#pragma unroll 1
            for (int q = 0; q < 8; ++q) {
                float kf[8]; unpack8(kp[q], kf);
#pragma unroll
                for (int j = 0; j < 8; ++j) {
                    const float4 a0 = *(const float4*)&iqs[j][q * 8], a1 = *(const float4*)&iqs[j][q * 8 + 4];
                    dd[j] = fmaf(a0.x, kf[0], dd[j]); dd[j] = fmaf(a0.y, kf[1], dd[j]); dd[j] = fmaf(a0.z, kf[2], dd[j]); dd[j] = fmaf(a0.w, kf[3], dd[j]);
                    dd[j] = fmaf(a1.x, kf[4], dd[j]); dd[j] = fmaf(a1.y, kf[5], dd[j]); dd[j] = fmaf(a1.z, kf[6], dd[j]); dd[j] = fmaf(a1.w, kf[7], dd[j]);
                }
            }
            float score = 0.f;
#pragma unroll
            for (int j = 0; j < 8; ++j) score = fmaf(w[j], fmaxf(dd[j], 0.f), score);
            sc[s] = score;
        }
        __syncthreads();
        const int n = t + 1;
        int nsel;
        if (n <= TOPK) {
            if (tid < n) sel[tid] = tid;
            nsel = n;
        } else {
            unsigned prefix = 0; int remaining = TOPK;
            for (int pass = 0; pass < 4; ++pass) {
                const int shift = 24 - 8 * pass;
                if (tid < 256) hist[tid] = 0;
                __syncthreads();
                for (int s = tid; s < n; s += NT) {
                    const unsigned key = okey(sc[s]);
                    const bool match = (pass == 0) || ((key >> (shift + 8)) == prefix);
                    if (match) atomicAdd(&hist[(key >> shift) & 255u], 1u);
                }
                __syncthreads();
                if (tid == 0) {
                    int cum = 0, d = 255;
                    for (; d > 0; --d) { const int c = (int)hist[d]; if (cum + c >= remaining) break; cum += c; }
                    misc[0] = d; misc[1] = remaining - cum;
                }
                __syncthreads();
                prefix = (prefix << 8) | (unsigned)misc[0]; remaining = misc[1];
                __syncthreads();
            }
            const int s0 = tid * 5;
            int ceq = 0;
#pragma unroll
            for (int q = 0; q < 5; ++q) { const int s = s0 + q; if (s < n && okey(sc[s]) == prefix) ++ceq; }
            int eqrank = block_excl_scan(ceq, misc + 8);
            int csel = 0; unsigned selmask = 0;
#pragma unroll
            for (int q = 0; q < 5; ++q) {
                const int s = s0 + q;
                if (s < n) {
                    const unsigned key = okey(sc[s]);
                    bool take = key > prefix;
                    if (key == prefix) { take = eqrank < remaining; ++eqrank; }
                    if (take) { ++csel; selmask |= 1u << q; }
                }
            }
            int posn = block_excl_scan(csel, misc + 16);
#pragma unroll
            for (int q = 0; q < 5; ++q) if (selmask & (1u << q)) { if (posn < TOPK) sel[posn] = s0 + q; ++posn; }
            nsel = TOPK;
        }
        __syncthreads();
        {
            const int i = tid & 255, g = tid >> 8;
            if (i < nsel) {
                const int kidx = sel[i];
                const uint4* kp = (const uint4*)&AK[((size_t)b * L + kidx) * 128 + g * 64];
                float dd[4] = {0.f, 0.f, 0.f, 0.f};
#pragma unroll 1
                for (int q = 0; q < 8; ++q) {
                    float kf[8]; unpack8(kp[q], kf);
#pragma unroll
                    for (int r = 0; r < 4; ++r) {
                        const float4 a0 = *(const float4*)&aqs[g * 4 + r][q * 8], a1 = *(const float4*)&aqs[g * 4 + r][q * 8 + 4];
                        dd[r] = fmaf(a0.x, kf[0], dd[r]); dd[r] = fmaf(a0.y, kf[1], dd[r]); dd[r] = fmaf(a0.z, kf[2], dd[r]); dd[r] = fmaf(a0.w, kf[3], dd[r]);
                        dd[r] = fmaf(a1.x, kf[4], dd[r]); dd[r] = fmaf(a1.y, kf[5], dd[r]); dd[r] = fmaf(a1.z, kf[6], dd[r]); dd[r] = fmaf(a1.w, kf[7], dd[r]);
                    }
                }
#pragma unroll
                for (int r = 0; r < 4; ++r) lg[g * 4 + r][i] = dd[r];
            } else {
#pragma unroll
                for (int r = 0; r < 4; ++r) lg[g * 4 + r][i] = -INFINITY;
            }
        }
        __syncthreads();
        {
            const int h = tid >> 6, lane = tid & 63;
            float v0 = lg[h][lane], v1 = lg[h][lane + 64], v2 = lg[h][lane + 128], v3 = lg[h][lane + 192];
            const float m = wave_max(fmaxf(fmaxf(v0, v1), fmaxf(v2, v3)));
            v0 = expf(v0 - m); v1 = expf(v1 - m); v2 = expf(v2 - m); v3 = expf(v3 - m);
            const float inv = 1.f / wave_sum(v0 + v1 + v2 + v3);
            lg[h][lane] = v0 * inv; lg[h][lane + 64] = v1 * inv; lg[h][lane + 128] = v2 * inv; lg[h][lane + 192] = v3 * inv;
        }
        __syncthreads();
        {
            const int h = tid >> 6, d = tid & 63, g = h >> 2;
            float o = 0.f;
            for (int i = 0; i < nsel; ++i) o = fmaf(lg[h][i], bf2f(AV[((size_t)b * L + sel[i]) * 128 + g * 64 + d]), o);
            const size_t mi = row * 1024 + 512 + tid;
            MIX[mi] = f2bf(o * bf2f(MIX[mi]));
        }
    }
}


constexpr int DS_SC = 0, DS_BITS = 134144, DS_HIST = DS_BITS + 4224, DS_END = DS_HIST + 8 * 1040;
constexpr int DS_TAB = 65536, DS_CONST = DS_TAB + 2112 * 32;
static_assert(DS_CONST + 32 <= DS_BITS, "bias table overlaps bitmask");


template <int NR>
__device__ __forceinline__ void dsa_select(const LAS unsigned* row, LAS unsigned* bits, LAS unsigned* hist, int n, int lane) {
    unsigned kreg[NR];
#pragma unroll
    for (int i = 0; i < NR; ++i) kreg[i] = (lane < n - 64 * i) ? row[lane + 64 * i] : 0u;
    unsigned prefix = 0; int remaining = TOPK;
#pragma unroll 1
    for (int pass = 0; pass < 4; ++pass) {
        const int shift = 24 - 8 * pass;
        *(LAS u32x4*)(hist + lane * 4) = (u32x4){0u, 0u, 0u, 0u};
        __builtin_amdgcn_wave_barrier(); asm volatile("" ::: "memory");
        const unsigned sh8 = (unsigned)(shift + 8) & 31u;
#pragma unroll
        for (int i = 0; i < NR; ++i) {
            const unsigned key = kreg[i];
            const bool match = (lane < n - 64 * i) && ((pass == 0) || ((key >> sh8) == prefix));
            if (match) __hip_atomic_fetch_add(hist + ((key >> shift) & 255u), 1u, __ATOMIC_RELAXED, __HIP_MEMORY_SCOPE_WAVEFRONT);
        }
        __builtin_amdgcn_wave_barrier(); asm volatile("s_waitcnt lgkmcnt(0)" ::: "memory");
        const u32x4 hv = *(const LAS u32x4*)(hist + (63 - lane) * 4);
        const int c0 = (int)hv[3], c1 = (int)hv[2], c2 = (int)hv[1], c3 = (int)hv[0];
        const int tot = c0 + c1 + c2 + c3;
        const int incl = wave_incl_scan(tot), excl = incl - tot;
        const bool found = (excl < remaining) && (remaining <= incl);
        int digit = 0, rem_new = 0;
        if (found) {
            int cum = excl;
            if (cum + c0 >= remaining) { digit = 255 - 4 * lane; rem_new = remaining - cum; }
            else { cum += c0;
                if (cum + c1 >= remaining) { digit = 254 - 4 * lane; rem_new = remaining - cum; }
                else { cum += c1;
                    if (cum + c2 >= remaining) { digit = 253 - 4 * lane; rem_new = remaining - cum; }
                    else { cum += c2; digit = 252 - 4 * lane; rem_new = remaining - cum; } } }
        }
        const unsigned long long fm = __ballot(found);
        const int src = (int)__builtin_ctzll(fm);
        digit = __builtin_amdgcn_readlane(digit, src); rem_new = __builtin_amdgcn_readlane(rem_new, src);
        prefix = (prefix << 8) | (unsigned)digit; remaining = rem_new;
    }
    const unsigned tkey = prefix;
    int eqcount = 0;
#pragma unroll
    for (int i = 0; i < 33; ++i) {
        if (i < NR) {
            const unsigned key = kreg[i < NR ? i : 0];
            const bool valid = lane < n - 64 * i;
            const bool gt = valid && (key > tkey), eq = valid && (key == tkey);
            const unsigned long long em = __ballot(eq);
            const int rank = eqcount + __popcll(em & ((1ull << lane) - 1ull));
            const bool sel = gt || (eq && rank < remaining);
            eqcount += __popcll(em);
            const unsigned long long sm = __ballot(sel);
            if (lane == 0) { bits[2 * i] = (unsigned)sm; bits[2 * i + 1] = (unsigned)(sm >> 32); }
        } else if (lane == 0) { bits[2 * i] = 0u; bits[2 * i + 1] = 0u; }
    }
}

__device__ __forceinline__ void phase_dsa(const Params& p_in, int layer_in, char* smem, bool do_store) {
    const Params p = kparams(); const int layer = opaque_int(layer_in); (void)p_in;
    const int tid = opaque_tid(), wid = __builtin_amdgcn_readfirstlane(tid >> 6), lane = tid & 63, fr = lane & 15, fq = lane >> 4;
    LAS unsigned char* lds = (LAS unsigned char*)smem;
    const bf16_t* IQ = (const bf16_t*)(p.ws + OFF_IQ);
    const bf16_t* IK = (const bf16_t*)(p.ws + OFF_IK);
    const float* IW = (const float*)(p.ws + OFF_IW);
    const bf16_t* AQ = (const bf16_t*)(p.ws + OFF_AQ);
    const bf16_t* AK = (const bf16_t*)(p.ws + OFF_AK);
    const bf16_t* AVT = (const bf16_t*)(p.ws + OFF_AV);
    bf16_t* MIX = (bf16_t*)(p.ws + OFF_MIX);
    constexpr int NITEM = NB * 129;
    for (int idx = opaque_bid(); idx < NITEM; idx += gridDim.x) {
        const int b = idx & 7, mm = idx >> 3;
        int qr;
        { const int seg = mm >> 5, jj = mm & 31; qr = (seg == 0) ? jj : (seg == 1) ? 63 - jj : (seg == 2) ? 64 + jj : (seg == 3) ? 127 - jj : 128; }
        const int qt = 128 - qr, t0 = qt * 16;
        const size_t rowq = (size_t)b * L + t0 + fr;
        __syncthreads();
        for (int repA = 0; repA < PROBE_DSA_A; ++repA) {
            bf16x8 qf[8][2];
#pragma unroll
            for (int jh = 0; jh < 8; ++jh)
#pragma unroll
                for (int s2 = 0; s2 < 2; ++s2) qf[jh][s2] = *(const bf16x8*)(IQ + rowq * 512 + jh * 64 + s2 * 32 + fq * 8);
            float w[8];
            { const f32x4 w0 = *(const f32x4*)(IW + rowq * 8), w1 = *(const f32x4*)(IW + rowq * 8 + 4);
              w[0] = w0[0]; w[1] = w0[1]; w[2] = w0[2]; w[3] = w0[3]; w[4] = w1[0]; w[5] = w1[1]; w[6] = w1[2]; w[7] = w1[3]; }
            const int ntile = qt + 1;
            const bf16x8 z8 = {0, 0, 0, 0, 0, 0, 0, 0};
            bf16x8 ka0 = z8, ka1 = z8, kb0 = z8, kb1 = z8, kc0 = z8, kc1 = z8;
            int kt = wid;
            if (kt < ntile) { const bf16_t* kp = IK + ((size_t)b * L + 16 * kt + fr) * 64 + fq * 8; ka0 = *(const bf16x8*)kp; ka1 = *(const bf16x8*)(kp + 32); }
            if (kt + 8 < ntile) { const bf16_t* kp = IK + ((size_t)b * L + 16 * (kt + 8) + fr) * 64 + fq * 8; kb0 = *(const bf16x8*)kp; kb1 = *(const bf16x8*)(kp + 32); }
            for (; kt < ntile; kt += 8) {
                if (kt + 16 < ntile) { const bf16_t* kp = IK + ((size_t)b * L + 16 * (kt + 16) + fr) * 64 + fq * 8; kc0 = *(const bf16x8*)kp; kc1 = *(const bf16x8*)(kp + 32); }
                f32x4 sc = {0.f, 0.f, 0.f, 0.f};
#pragma unroll
                for (int jh = 0; jh < 8; ++jh) {
                    f32x4 d = {0.f, 0.f, 0.f, 0.f};
                    d = __builtin_amdgcn_mfma_f32_16x16x32_bf16(ka0, qf[jh][0], d, 0, 0, 0);
                    d = __builtin_amdgcn_mfma_f32_16x16x32_bf16(ka1, qf[jh][1], d, 0, 0, 0);
#pragma unroll
                    for (int r = 0; r < 4; ++r) sc[r] = fmaf(w[jh], fmaxf(d[r], 0.f), sc[r]);
                }
                u32x4 ko;
#pragma unroll
                for (int r = 0; r < 4; ++r) ko[r] = okey(sc[r]);
                *(LAS u32x4*)(lds + DS_SC + (fr * 2064 + 16 * kt + 4 * fq) * 4) = ko;
                ka0 = kb0; ka1 = kb1; kb0 = kc0; kb1 = kc1;
            }
        }
        __syncthreads();
        for (int repB = 0; repB < PROBE_DSA_B; ++repB) {
            LAS unsigned* hist = (LAS unsigned*)(lds + DS_HIST + wid * 1040);
#pragma unroll 1
            for (int qq = 0; qq < 2; ++qq) {
                const int q = wid * 2 + qq;
                const int n = t0 + q + 1;
                const LAS unsigned* row = (const LAS unsigned*)(lds + DS_SC) + q * 2064;
                LAS unsigned* bits = (LAS unsigned*)(lds + DS_BITS) + q * 66;
                if (n <= TOPK) {
#pragma unroll 1
                    for (int i = 0; i < 33; ++i) {
                        const unsigned long long sm = __ballot(lane + 64 * i < n);
                        if (lane == 0) { bits[2 * i] = (unsigned)sm; bits[2 * i + 1] = (unsigned)(sm >> 32); }
                    }
                } else {
                    const int nr = (n + 63) >> 6;
                    if (nr <= 9) dsa_select<9>(row, bits, hist, n, lane);
                    else if (nr <= 17) dsa_select<17>(row, bits, hist, n, lane);
                    else if (nr <= 25) dsa_select<25>(row, bits, hist, n, lane);
                    else dsa_select<33>(row, bits, hist, n, lane);
                }
            }
        }
        __syncthreads();
        for (int repC = 0; repC < PROBE_DSA_C; ++repC) {
            if (repC > 0) __syncthreads();
            const int h = wid, g = h >> 2;
            const int nstep = (t0 + 16 + 63) >> 6;
            bf16x8 aqf[2];
            aqf[0] = *(const bf16x8*)(AQ + rowq * 512 + h * 64 + fq * 8);
            aqf[1] = *(const bf16x8*)(AQ + rowq * 512 + h * 64 + 32 + fq * 8);
            asm volatile("" : "+v"(aqf[0]), "+v"(aqf[1]));
            const int drow = 8 * wid + (lane >> 3);
            const int kch = (lane & 7) ^ (2 * ((drow >> 3) & 3) + ((drow >> 1) & 1)), vch = (lane & 7) ^ ((drow >> 1) & 7);
            const bf16_t* vsrc0 = AVT + ((size_t)b * 128 + drow) * LP + vch * 8;
#define DSA_DMA(st_, buf_) do { \
                int krow_ = b * L + 64 * (st_) + drow; krow_ = krow_ < T ? krow_ : T - 1; \
                const bf16_t* ks_ = AK + (size_t)krow_ * 128 + kch * 8; \
                LAS unsigned char* lb_ = lds + (buf_) * 32768 + wid * 1024; \
                __builtin_amdgcn_global_load_lds((const unsigned*)ks_, (LAS unsigned*)lb_, 16, 0, 0); \
                __builtin_amdgcn_global_load_lds((const unsigned*)(ks_ + 64), (LAS unsigned*)(lb_ + 8192), 16, 0, 0); \
                __builtin_amdgcn_global_load_lds((const unsigned*)(vsrc0 + 64 * (st_)), (LAS unsigned*)(lb_ + 16384), 16, 0, 0); \
                __builtin_amdgcn_global_load_lds((const unsigned*)(vsrc0 + (size_t)64 * LP + 64 * (st_)), (LAS unsigned*)(lb_ + 24576), 16, 0, 0); } while (0)
            DSA_DMA(0, 0);
            for (int key = tid; key < 2112; key += NT) {
                const int w32 = key & 31;
                const int R = (key >> 5) * 32 + ((w32 >> 2) & 1) * 16 + 4 * (w32 >> 3) + (w32 & 3);
                u32x4 lo, hi;
#pragma unroll
                for (int qp = 0; qp < 8; ++qp) {
                    const unsigned b0 = (*((const LAS unsigned*)(lds + DS_BITS) + (2 * qp) * 66 + (key >> 5)) >> w32) & 1u;
                    const unsigned b1 = (*((const LAS unsigned*)(lds + DS_BITS) + (2 * qp + 1) * 66 + (key >> 5)) >> w32) & 1u;
                    const unsigned v = (b0 ? 0u : 0xC6EAu) | (b1 ? 0u : 0xC6EA0000u);
                    if (qp < 4) lo[qp] = v; else hi[qp - 4] = v;
                }
                *(LAS u32x4*)(lds + DS_TAB + R * 32) = lo; *(LAS u32x4*)(lds + DS_TAB + R * 32 + 16) = hi;
            }
            if (tid < 8) *((LAS unsigned*)(lds + DS_CONST) + tid) = (tid == 0) ? 0x00003F80u : 0u;
            const int swzk = 2 * (fr >> 2) + ((fr >> 1) & 1);
            const int krow0 = 8 * (fr >> 2) + (fr & 3);
            const int tab_base = (fq < 2) ? DS_TAB + fr * 32 + 16 * fq : DS_CONST + 16 * (fq - 2);
            const int tab_mul = (fq < 2) ? 512 : 0;
            u32x4 bqw = {0u, 0u, 0u, 0u};
            if (fq < 2 && (fr >> 3) == fq) { const int j = fr & 7; bqw[j >> 1] = (j & 1) ? 0x3F800000u : 0x00003F80u; }
            u32x4 onw = {0u, 0u, 0u, 0u};
            if (fr == 0) onw = (u32x4){0x3F803F80u, 0x3F803F80u, 0x3F803F80u, 0x3F803F80u};
            const bf16x8 onesA = __builtin_bit_cast(bf16x8, onw);
            asm volatile("s_waitcnt vmcnt(0) lgkmcnt(0)" ::: "memory");
            __builtin_amdgcn_s_barrier();
            asm volatile("" ::: "memory");
            f32x4 O[4], O5 = {0.f, 0.f, 0.f, 0.f};
#pragma unroll
            for (int dt = 0; dt < 4; ++dt) O[dt] = (f32x4){0.f, 0.f, 0.f, 0.f};
            float mt = 0.f;
            for (int st = 0; st < nstep; ++st) {
                const int buf = st & 1;
                {
                    const int sn = (st + 1 < nstep) ? st + 1 : nstep - 1;
                    DSA_DMA(sn, buf ^ 1);
                }
                const LAS unsigned char* sb = lds + buf * 32768;
                const bf16x8 bq = __builtin_bit_cast(bf16x8, bqw);
                f32x4 S[4];
#pragma unroll
                for (int kt = 0; kt < 4; ++kt) {
                    const int rowk = krow0 + 32 * (kt >> 1) + 4 * (kt & 1);
                    const bf16x8 bias = *(const LAS bf16x8*)(lds + tab_base + (4 * st + kt) * tab_mul);
                    S[kt] = __builtin_amdgcn_mfma_f32_16x16x32_bf16(bias, bq, (f32x4){0.f, 0.f, 0.f, 0.f}, 0, 0, 0);
#pragma unroll
                    for (int s2 = 0; s2 < 2; ++s2) {
                        const bf16x8 kf = *(const LAS bf16x8*)(sb + g * 8192 + rowk * 128 + 16 * ((4 * s2 + fq) ^ swzk));
                        S[kt] = __builtin_amdgcn_mfma_f32_16x16x32_bf16(kf, aqf[s2], S[kt], 0, 0, 0);
                    }
                }
                float pmax = fmaxf(fmaxf(S[0][0], S[0][1]), S[0][2]);
                pmax = fmaxf(fmaxf(pmax, S[0][3]), S[1][0]); pmax = fmaxf(fmaxf(pmax, S[1][1]), S[1][2]); pmax = fmaxf(fmaxf(pmax, S[1][3]), S[2][0]);
                pmax = fmaxf(fmaxf(pmax, S[2][1]), S[2][2]); pmax = fmaxf(fmaxf(pmax, S[2][3]), S[3][0]); pmax = fmaxf(fmaxf(pmax, S[3][1]), S[3][2]);
                pmax = fmaxf(pmax, S[3][3]);
                if (st == 0 || __any(pmax > 11.5f)) {
                    float pm = fmaxf(pmax, __shfl_xor(pmax, 16)); pm = fmaxf(pm, __shfl_xor(pm, 32));
                    const float up = (st == 0) ? fmaxf(pm, -64.f) : fmaxf(pm, 0.f);
                    const float mn = __uint_as_float((unsigned)f2bf(mt + up) << 16);
                    const float dlt = mt - mn;
                    const float alpha = __builtin_amdgcn_exp2f(dlt);
#pragma unroll
                    for (int dt = 0; dt < 4; ++dt) O[dt] *= alpha;
                    O5 *= alpha;
#pragma unroll
                    for (int kt = 0; kt < 4; ++kt) S[kt] += dlt;
                    mt = mn;
                    if (fq == 2) bqw[0] = (unsigned)f2bf(-mt);
                }
                unsigned pk[4][2];
#pragma unroll
                for (int kt = 0; kt < 4; ++kt) {
                    const float e0 = __builtin_amdgcn_exp2f(S[kt][0]), e1 = __builtin_amdgcn_exp2f(S[kt][1]), e2 = __builtin_amdgcn_exp2f(S[kt][2]), e3 = __builtin_amdgcn_exp2f(S[kt][3]);
                    pk[kt][0] = cvt_pk_bf16(e0, e1); pk[kt][1] = cvt_pk_bf16(e2, e3);
                }
#pragma unroll
                for (int ks = 0; ks < 2; ++ks) {
                    u32x4 pw; pw[0] = pk[2 * ks][0]; pw[1] = pk[2 * ks][1]; pw[2] = pk[2 * ks + 1][0]; pw[3] = pk[2 * ks + 1][1];
                    const bf16x8 pf = __builtin_bit_cast(bf16x8, pw);
                    O5 = __builtin_amdgcn_mfma_f32_16x16x32_bf16(onesA, pf, O5, 0, 0, 0);
#pragma unroll
                    for (int dt = 0; dt < 4; ++dt) {
                        const int rowv = 16 * dt + fr;
                        const bf16x8 vf = *(const LAS bf16x8*)(sb + 16384 + g * 8192 + rowv * 128 + 16 * ((4 * ks + fq) ^ ((rowv >> 1) & 7)));
                        O[dt] = __builtin_amdgcn_mfma_f32_16x16x32_bf16(vf, pf, O[dt], 0, 0, 0);
                    }
                }
                asm volatile("s_waitcnt vmcnt(0)" ::: "memory");
                __builtin_amdgcn_s_barrier();
                asm volatile("" ::: "memory");
            }
#undef DSA_DMA
            const float l = __shfl(O5[0], fr);
            const float inv = 1.f / fmaxf(l, 1e-30f);
            bf16_t* mp = MIX + rowq * 1024 + 512 + h * 64 + 4 * fq;
            if (do_store && repC == PROBE_DSA_C - 1)
#pragma unroll
            for (int dt = 0; dt < 4; ++dt) {
                const uint2 gz = *(const uint2*)(mp + 16 * dt);
                const float g0 = __uint_as_float(gz.x << 16), g1 = __uint_as_float(gz.x & 0xFFFF0000u), g2 = __uint_as_float(gz.y << 16), g3 = __uint_as_float(gz.y & 0xFFFF0000u);
                uint2 o; o.x = cvt_pk_bf16(O[dt][0] * inv * g0, O[dt][1] * inv * g1); o.y = cvt_pk_bf16(O[dt][2] * inv * g2, O[dt][3] * inv * g3);
                *(uint2*)(mp + 16 * dt) = o;
            }
        }
    }
}

__device__ __forceinline__ void rope16(const u32x4 a, const u32x4 b, const float2* rp, u32x4& oa, u32x4& ob) {
    const f32x4 r0 = *(const f32x4*)(rp), r1 = *(const f32x4*)(rp + 2), r2 = *(const f32x4*)(rp + 4), r3 = *(const f32x4*)(rp + 6);
    const float cs[8] = {r0[0], r0[2], r1[0], r1[2], r2[0], r2[2], r3[0], r3[2]};
    const float sn[8] = {r0[1], r0[3], r1[1], r1[3], r2[1], r2[3], r3[1], r3[3]};
    float o1[8], o2[8];
#pragma unroll
    for (int i = 0; i < 4; ++i) {
        const float x1l = __uint_as_float(a[i] << 16), x1h = __uint_as_float(a[i] & 0xFFFF0000u);
        const float x2l = __uint_as_float(b[i] << 16), x2h = __uint_as_float(b[i] & 0xFFFF0000u);
        o1[2 * i] = x1l * cs[2 * i] - x2l * sn[2 * i]; o1[2 * i + 1] = x1h * cs[2 * i + 1] - x2h * sn[2 * i + 1];
        o2[2 * i] = x2l * cs[2 * i] + x1l * sn[2 * i]; o2[2 * i + 1] = x2h * cs[2 * i + 1] + x1h * sn[2 * i + 1];
    }
#pragma unroll
    for (int i = 0; i < 4; ++i) { oa[i] = cvt_pk_bf16(o1[2 * i], o1[2 * i + 1]); ob[i] = cvt_pk_bf16(o2[2 * i], o2[2 * i + 1]); }
}
__device__ __forceinline__ void phase_rope(const Params& p_in, int layer_in, char* smem) {
    const Params p = kparams(); const int layer = opaque_int(layer_in); (void)p_in;
    const int tid = opaque_tid();
    const float2* ROPE = (const float2*)(p.ws + OFF_ROPE);
    const int nthr = gridDim.x * NT, gid = opaque_bid() * NT + tid;
    for (int th = gid; th < T * 18; th += nthr) {
        const int t = th / 18, hh = th - t * 18, pos = t % L;
        bf16_t* base = (hh < 8) ? (bf16_t*)(p.ws + OFF_AQ) + (size_t)t * 512 + hh * 64
                     : (hh < 16) ? (bf16_t*)(p.ws + OFF_IQ) + (size_t)t * 512 + (hh - 8) * 64
                                 : (bf16_t*)(p.ws + OFF_AK) + (size_t)t * 128 + (hh - 16) * 64;
        const u32x4 a = *(const u32x4*)base, b = *(const u32x4*)(base + 8);
        u32x4 oa, ob; rope16(a, b, ROPE + pos * 8, oa, ob);
        *(u32x4*)base = oa; *(u32x4*)(base + 8) = ob;
    }
    const float* IKR = (const float*)(p.ws + OFF_IKR);
    bf16_t* IK = (bf16_t*)(p.ws + OFF_IK);
    const float* ikg = p.ikg + layer * 64; const float* ikb = p.ikb + layer * 64;
    for (int t = gid; t < T; t += nthr) {
        const int pos = t % L;
        f32x4 x[16];
#pragma unroll
        for (int i = 0; i < 16; ++i) x[i] = *(const f32x4*)(IKR + (size_t)t * 64 + 4 * i);
        float sm = 0.f;
#pragma unroll
        for (int i = 0; i < 16; ++i) sm += (x[i][0] + x[i][1]) + (x[i][2] + x[i][3]);
        const float mu = sm * (1.f / 64);
        float qq = 0.f;
#pragma unroll
        for (int i = 0; i < 16; ++i) { const f32x4 d = x[i] - mu; qq += (d[0] * d[0] + d[1] * d[1]) + (d[2] * d[2] + d[3] * d[3]); }
        const float rs = rsqrtf(qq * (1.f / 64) + LN_EPS);
#pragma unroll
        for (int i = 0; i < 16; ++i) { const f32x4 g = *(const f32x4*)(ikg + 4 * i), bb = *(const f32x4*)(ikb + 4 * i); x[i] = (x[i] - mu) * rs * g + bb; }
        const float2* rp = ROPE + pos * 8;
        const f32x4 r0 = *(const f32x4*)(rp), r1 = *(const f32x4*)(rp + 2), r2 = *(const f32x4*)(rp + 4), r3 = *(const f32x4*)(rp + 6);
        const float cs[8] = {r0[0], r0[2], r1[0], r1[2], r2[0], r2[2], r3[0], r3[2]};
        const float sn[8] = {r0[1], r0[3], r1[1], r1[3], r2[1], r2[3], r3[1], r3[3]};
#pragma unroll
        for (int i = 0; i < 8; ++i) {
            const float x1 = x[i >> 2][i & 3], x2 = x[2 + (i >> 2)][i & 3];
            x[i >> 2][i & 3] = x1 * cs[i] - x2 * sn[i];
            x[2 + (i >> 2)][i & 3] = x2 * cs[i] + x1 * sn[i];
        }
#pragma unroll
        for (int i = 0; i < 8; ++i) {
            u32x4 o; o[0] = cvt_pk_bf16(x[2 * i][0], x[2 * i][1]); o[1] = cvt_pk_bf16(x[2 * i][2], x[2 * i][3]); o[2] = cvt_pk_bf16(x[2 * i + 1][0], x[2 * i + 1][1]); o[3] = cvt_pk_bf16(x[2 * i + 1][2], x[2 * i + 1][3]);
            *(u32x4*)(IK + (size_t)t * 64 + 8 * i) = o;
        }
    }
}

constexpr int GL_QE = 0, GL_KN = 8192, GL_SEG = 16384, GL_PART = 18432;
__device__ __forceinline__ void gla_cumsum(const Params& p, int layer, int b, int h, int c, int tid, LAS unsigned char* lds, float (&bc)[8], float& blast) {
    const int d = tid & 63, seg = tid >> 6;
    const float* wg2 = p.wg2 + (size_t)layer * 16 * 256 + h * 64 + d;
    float w[16];
#pragma unroll
    for (int rr = 0; rr < 16; ++rr) w[rr] = wg2[rr * 256];
    const float bgd = p.bg[layer * 256 + h * 64 + d];
    const float* GLR = (const float*)(p.ws + OFF_GLR);
    float pb = 0.f;
#pragma unroll
    for (int i = 0; i < 8; ++i) {
        const int pos = 64 * c - 48 + 8 * seg + i;
        float gl = 0.f;
        if (pos >= 0) {
            const f32x4* gp = (const f32x4*)(GLR + ((size_t)b * L + pos) * 16);
            const f32x4 g0 = gp[0], g1 = gp[1], g2 = gp[2], g3 = gp[3];
            float x = bgd;
#pragma unroll
            for (int rr = 0; rr < 4; ++rr) { x = fmaf(g0[rr], w[rr], x); }
#pragma unroll
            for (int rr = 0; rr < 4; ++rr) { x = fmaf(g1[rr], w[4 + rr], x); }
#pragma unroll
            for (int rr = 0; rr < 4; ++rr) { x = fmaf(g2[rr], w[8 + rr], x); }
#pragma unroll
            for (int rr = 0; rr < 4; ++rr) { x = fmaf(g3[rr], w[12 + rr], x); }
            gl = logsigmoid_fast(x) * (1.f / 16.f);
        }
        pb += gl; bc[i] = pb;
    }
    LAS float* segs = (LAS float*)(lds + GL_SEG);
    segs[seg * 64 + d] = pb;
    __syncthreads();
    float base = 0.f, tot = 0.f;
#pragma unroll
    for (int sg = 0; sg < 8; ++sg) { const float v = segs[sg * 64 + d]; tot += v; base += (sg < seg) ? v : 0.f; }
#pragma unroll
    for (int i = 0; i < 8; ++i) bc[i] += base;
    blast = tot;
}

constexpr size_t OUTS_QE = 0, OUTS_KN = (size_t)T * 256 * 2;
__device__ __forceinline__ void phase_gla_a(const Params& p_in, int layer_in, char* smem) {
    const Params p = kparams(); const int layer = opaque_int(layer_in); (void)p_in;
    const int tid = opaque_tid(), wid = __builtin_amdgcn_readfirstlane(tid >> 6), lane = tid & 63, fr = lane & 15, fq = lane >> 4;
    LAS unsigned char* ldw = (LAS unsigned char*)smem + wid * 8192;
    const bf16_t* GQ = (const bf16_t*)(p.ws + OFF_GQ);
    const bf16_t* GK = (const bf16_t*)(p.ws + OFF_GK);
    const bf16_t* GVT = (const bf16_t*)(p.ws + OFF_GV);
    const float* GLR = (const float*)(p.ws + OFF_GLR);
    bf16_t* QE = (bf16_t*)((char*)p.out + OUTS_QE);
    bf16_t* KN = (bf16_t*)((char*)p.out + OUTS_KN);
    float* UT = (float*)(p.ws + OFF_UT);
    float* DL = (float*)(p.ws + OFF_DL);
    const int wstride = gridDim.x * 8;
    for (int task = wid * (int)gridDim.x + opaque_bid(); task < 32 * 33; task += wstride) {
        const int bh = task / 33, c = task - bh * 33, b = bh >> 2, h = bh & 3;
        const int d = lane;
        float w[16];
#pragma unroll
        for (int rr = 0; rr < 16; ++rr) w[rr] = p.wg2[(size_t)layer * 16 * 256 + rr * 256 + h * 64 + d];
        const float bgd = p.bg[layer * 256 + h * 64 + d];
        float bsum = 0.f;
        const int rowi0 = b * L + 64 * c - 48;
        f32x4 g4[4];
#pragma unroll
        for (int m = 0; m < 4; ++m) { int rr_ = rowi0 + ((lane + 64 * m) >> 2); rr_ = rr_ > 0 ? rr_ : 0; g4[m] = *(const f32x4*)(GLR + (size_t)rr_ * 16 + 4 * (lane & 3)); }
        LAS unsigned char* ldg = (LAS unsigned char*)smem + 65536 + wid * 4096;
#pragma unroll
        for (int m = 0; m < 4; ++m) *(LAS f32x4*)(ldg + (lane + 64 * m) * 16) = g4[m];
        unsigned qk[64];
#pragma unroll
        for (int t = 0; t < 64; ++t) { int rr_ = rowi0 + t; rr_ = rr_ > 0 ? rr_ : 0; const size_t o_ = (size_t)rr_ * 256 + h * 64 + d; qk[t] = (unsigned)GQ[o_] | ((unsigned)GK[o_] << 16); }
        float kn[8];
        __builtin_amdgcn_wave_barrier(); asm volatile("s_waitcnt lgkmcnt(0)" ::: "memory");
#pragma unroll
        for (int t = 0; t < 64; ++t) {
            const bool valid = (c > 0) || (t >= 48);
            float x = bgd;
            {
                const LAS f32x4* gp = (const LAS f32x4*)(ldg + t * 64);
                const f32x4 g0 = gp[0], g1 = gp[1], g2 = gp[2], g3 = gp[3];
#pragma unroll
                for (int rr = 0; rr < 4; ++rr) x = fmaf(g0[rr], w[rr], x);
#pragma unroll
                for (int rr = 0; rr < 4; ++rr) x = fmaf(g1[rr], w[4 + rr], x);
#pragma unroll
                for (int rr = 0; rr < 4; ++rr) x = fmaf(g2[rr], w[8 + rr], x);
#pragma unroll
                for (int rr = 0; rr < 4; ++rr) x = fmaf(g3[rr], w[12 + rr], x);
            }
            bsum += valid ? logsigmoid_fast(x) * (1.f / 16.f) : 0.f;
            const float eb = __expf(bsum);
            const float qv = __uint_as_float(qk[t] << 16), kv = __uint_as_float(qk[t] & 0xFFFF0000u);
            const float knv = valid ? kv * __builtin_amdgcn_rcpf(eb) : 0.f;
            kn[t & 7] = knv;
            if (valid) {
                const size_t o_ = (size_t)(rowi0 + t) * 256 + h * 64 + d;
                QE[o_] = f2bf(qv * eb);
                KN[o_] = f2bf(knv);
            }
            if ((t & 7) == 7 && c < 32) {
                u32x4 o; o[0] = cvt_pk_bf16(kn[0], kn[1]); o[1] = cvt_pk_bf16(kn[2], kn[3]); o[2] = cvt_pk_bf16(kn[4], kn[5]); o[3] = cvt_pk_bf16(kn[6], kn[7]);
                *(LAS u32x4*)(ldw + d * 128 + 16 * ((t >> 3) ^ (d & 7))) = o;
            }
        }
        if (c < 32) {
            const float dl = __expf(bsum);
            DL[((size_t)bh * 32 + c) * 64 + d] = dl;
            __builtin_amdgcn_wave_barrier(); asm volatile("s_waitcnt lgkmcnt(0)" ::: "memory");
            bf16x8 kf[4][2]; float dls[4];
#pragma unroll
            for (int dt = 0; dt < 4; ++dt) {
                const int rowd = 16 * dt + fr;
                dls[dt] = __shfl(dl, rowd);
#pragma unroll
                for (int ks = 0; ks < 2; ++ks) kf[dt][ks] = *(const LAS bf16x8*)(ldw + rowd * 128 + 16 * ((4 * ks + fq) ^ (rowd & 7)));
            }
            const bf16x8 z8 = {0, 0, 0, 0, 0, 0, 0, 0};
#pragma unroll
            for (int et = 0; et < 8; ++et) {
                const bf16_t* vp = GVT + ((size_t)bh * 128 + 16 * et + fr) * LPV + 64 * c + 8 * fq;
                bf16x8 v0 = *(const bf16x8*)vp, v1 = *(const bf16x8*)(vp + 32);
                v0 = (c == 0) ? z8 : v0; v1 = (c == 0 && fq < 2) ? z8 : v1;
#pragma unroll
                for (int dt = 0; dt < 4; ++dt) {
                    f32x4 acc = {0.f, 0.f, 0.f, 0.f};
                    acc = __builtin_amdgcn_mfma_f32_16x16x32_bf16(v0, kf[dt][0], acc, 0, 0, 0);
                    acc = __builtin_amdgcn_mfma_f32_16x16x32_bf16(v1, kf[dt][1], acc, 0, 0, 0);
                    float* up = UT + (((size_t)bh * 32 + c) * 128 + 16 * et + 4 * fq) * 64 + 16 * dt + fr;
#pragma unroll
                    for (int r = 0; r < 4; ++r) up[r * 64] = acc[r] * dls[dt];
                }
            }
            __builtin_amdgcn_wave_barrier(); asm volatile("s_waitcnt lgkmcnt(0)" ::: "memory");
        }
    }
}

__device__ __forceinline__ void phase_gla_scan(const Params& p_in, int layer_in, char* smem) {
    const Params p = kparams(); const int layer = opaque_int(layer_in); (void)p_in;
    const int tid = opaque_tid();
    const float* UT = (const float*)(p.ws + OFF_UT);
    const float* DL = (const float*)(p.ws + OFF_DL);
    bf16_t* ST = (bf16_t*)(p.ws + OFF_ST);
    const int nthr = gridDim.x * NT;
    for (int el = opaque_bid() * NT + tid; el < 32 * 8192; el += nthr) {
        const int bh = el >> 13, ed = el & 8191, d = el & 63;
        float sacc = 0.f;
        ST[((size_t)bh * 33) * 8192 + ed] = 0;
#pragma unroll 1
        for (int c0 = 0; c0 < 32; c0 += 16) {
            float u[16], dl[16];
#pragma unroll
            for (int i = 0; i < 16; ++i) { u[i] = UT[((size_t)(bh * 32 + c0 + i)) * 8192 + ed]; dl[i] = DL[(size_t)(bh * 32 + c0 + i) * 64 + d]; }
#pragma unroll
            for (int i = 0; i < 16; ++i) { sacc = fmaf(dl[i], sacc, u[i]); ST[((size_t)bh * 33 + c0 + i + 1) * 8192 + ed] = f2bf(sacc); }
        }
    }
}

__device__ __forceinline__ void phase_gla_c(const Params& p_in, int layer_in, char* smem, bool do_store) {
    const Params p = kparams(); const int layer = opaque_int(layer_in); (void)p_in;
    const int tid = opaque_tid(), wid = __builtin_amdgcn_readfirstlane(tid >> 6), lane = tid & 63, fr = lane & 15, fq = lane >> 4;
    const bf16_t* QE = (const bf16_t*)((const char*)p.out + OUTS_QE);
    const bf16_t* KN = (const bf16_t*)((const char*)p.out + OUTS_KN);
    const bf16_t* GVT = (const bf16_t*)(p.ws + OFF_GV);
    const bf16_t* ST = (const bf16_t*)(p.ws + OFF_ST);
    bf16_t* MIX = (bf16_t*)(p.ws + OFF_MIX);
    const float* ng = p.norm_g + layer * 128;
    const bf16x8 z8 = {0, 0, 0, 0, 0, 0, 0, 0};
    const int nwt = 32 * 33 * 4, wstride = gridDim.x * 8;
    for (int wt = wid * (int)gridDim.x + opaque_bid(); wt < nwt; wt += wstride) {
        const int task = wt >> 2, tw = wt & 3;
        const int bh = task / 33, c = task - bh * 33, b = bh >> 2, h = bh & 3;
        const int pos_t = 64 * c - 48 + 16 * tw + fr;
        if (c == 0 && tw < 3) continue;
        bf16x8 qf[2];
        {
            const bf16_t* qp = QE + ((size_t)b * L + pos_t) * 256 + h * 64 + 8 * fq;
            qf[0] = *(const bf16x8*)qp; qf[1] = *(const bf16x8*)(qp + 32);
        }
        unsigned pk[4][2];
#pragma unroll
        for (int st = 0; st < 4; ++st) {
            f32x4 a = {0.f, 0.f, 0.f, 0.f};
            const int pos_s = 64 * c - 48 + 16 * st + fr;
            const bf16_t* kp = KN + ((size_t)b * L + (pos_s > 0 ? pos_s : 0)) * 256 + h * 64 + 8 * fq;
            bf16x8 k0 = *(const bf16x8*)kp, k1 = *(const bf16x8*)(kp + 32);
            k0 = (pos_s >= 0) ? k0 : z8; k1 = (pos_s >= 0) ? k1 : z8;
            a = __builtin_amdgcn_mfma_f32_16x16x32_bf16(k0, qf[0], a, 0, 0, 0);
            a = __builtin_amdgcn_mfma_f32_16x16x32_bf16(k1, qf[1], a, 0, 0, 0);
#pragma unroll
            for (int r = 0; r < 4; ++r) a[r] = (16 * st + 4 * fq + r > 16 * tw + fr) ? 0.f : a[r];
            pk[st][0] = cvt_pk_bf16(a[0], a[1]); pk[st][1] = cvt_pk_bf16(a[2], a[3]);
        }
        bf16x8 pf[2];
#pragma unroll
        for (int ks = 0; ks < 2; ++ks) { u32x4 pw; pw[0] = pk[2 * ks][0]; pw[1] = pk[2 * ks][1]; pw[2] = pk[2 * ks + 1][0]; pw[3] = pk[2 * ks + 1][1]; pf[ks] = __builtin_bit_cast(bf16x8, pw); }
        f32x4 O[8];
        float ss = 0.f;
        const u32x2 z2 = {0u, 0u};
#pragma unroll
        for (int et = 0; et < 8; ++et) {
            const int e0 = 16 * et;
            f32x4 acc = {0.f, 0.f, 0.f, 0.f};
            const bf16_t* sp = ST + (((size_t)bh * 33 + c) * 128 + e0 + fr) * 64 + 8 * fq;
            const bf16_t* vp = GVT + ((size_t)bh * 128 + e0 + fr) * LPV + 64 * c + 4 * fq;
            acc = __builtin_amdgcn_mfma_f32_16x16x32_bf16(*(const bf16x8*)sp, qf[0], acc, 0, 0, 0);
            acc = __builtin_amdgcn_mfma_f32_16x16x32_bf16(*(const bf16x8*)(sp + 32), qf[1], acc, 0, 0, 0);
            u32x2 va = *(const u32x2*)vp, vb = *(const u32x2*)(vp + 16), vc = *(const u32x2*)(vp + 32), vd = *(const u32x2*)(vp + 48);
            va = (c == 0) ? z2 : va; vb = (c == 0) ? z2 : vb; vc = (c == 0) ? z2 : vc;
            u32x4 vw; vw[0] = va[0]; vw[1] = va[1]; vw[2] = vb[0]; vw[3] = vb[1];
            acc = __builtin_amdgcn_mfma_f32_16x16x32_bf16(__builtin_bit_cast(bf16x8, vw), pf[0], acc, 0, 0, 0);
            u32x4 vx; vx[0] = vc[0]; vx[1] = vc[1]; vx[2] = vd[0]; vx[3] = vd[1];
            acc = __builtin_amdgcn_mfma_f32_16x16x32_bf16(__builtin_bit_cast(bf16x8, vx), pf[1], acc, 0, 0, 0);
            O[et] = acc;
            ss += acc[0] * acc[0] + acc[1] * acc[1] + acc[2] * acc[2] + acc[3] * acc[3];
        }
        ss += __shfl_xor(ss, 16); ss += __shfl_xor(ss, 32);
        const float rinv = rsqrtf(ss * (1.f / 128) + LN_EPS);
        if (pos_t >= 0 && do_store) {
            bf16_t* mp = MIX + ((size_t)b * L + pos_t) * 1024 + h * 128 + 4 * fq;
#pragma unroll
            for (int et = 0; et < 8; ++et) {
                const uint2 gz = *(const uint2*)(mp + 16 * et);
                const f32x4 nv = *(const f32x4*)(ng + 16 * et + 4 * fq);
                const float g0 = __uint_as_float(gz.x << 16), g1 = __uint_as_float(gz.x & 0xFFFF0000u), g2 = __uint_as_float(gz.y << 16), g3 = __uint_as_float(gz.y & 0xFFFF0000u);
                uint2 o; o.x = cvt_pk_bf16(O[et][0] * rinv * nv[0] * g0, O[et][1] * rinv * nv[1] * g1); o.y = cvt_pk_bf16(O[et][2] * rinv * nv[2] * g2, O[et][3] * rinv * nv[3] * g3);
                *(uint2*)(mp + 16 * et) = o;
            }
        }
    }
}

__device__ __forceinline__ void phase_ln(const Params& p_in, int layer_in, char* smem) {
    const Params p = kparams(); const int layer = opaque_int(layer_in); (void)p_in;
    const int tid = opaque_tid(), wid = tid >> 6, lane = tid & 63;
    const float* Z = (const float*)(p.ws + OFF_GQ);
    float* H32 = (float*)(p.ws + OFF_H32);
    bf16_t* HB = (bf16_t*)(p.ws + OFF_HB);
    const float* g = p.ln_g + layer * D; const float* bb = p.ln_b + layer * D;
    const int nw = gridDim.x * 8;
    int t = opaque_bid() * 8 + wid;
    f32x4 v[4], vn[4];
    if (t < T) {
#pragma unroll
        for (int i = 0; i < 4; ++i) v[i] = *(const f32x4*)(Z + (size_t)t * D + 4 * lane + 256 * i);
    }
    for (; t < T; t += nw) {
        const int tn = t + nw;
        if (tn < T) {
#pragma unroll
            for (int i = 0; i < 4; ++i) vn[i] = *(const f32x4*)(Z + (size_t)tn * D + 4 * lane + 256 * i);
        }
        ln_row_wave(v, g, bb, lane);
        if (layer == DEPTH - 1) {
            const int b = t / L, pos = t - b * L;
            if (pos >= NMETA) {
#pragma unroll
                for (int i = 0; i < 4; ++i) *(f32x4*)(p.out + ((size_t)b * SEQ + (pos - NMETA)) * D + 4 * lane + 256 * i) = v[i];
            }
        } else {
#pragma unroll
            for (int i = 0; i < 4; ++i) {
                *(f32x4*)(H32 + (size_t)t * D + 4 * lane + 256 * i) = v[i];
                u32x2 o; o[0] = cvt_pk_bf16(v[i][0], v[i][1]); o[1] = cvt_pk_bf16(v[i][2], v[i][3]);
                *(u32x2*)(HB + (size_t)t * D + 4 * lane + 256 * i) = o;
            }
        }
#pragma unroll
        for (int i = 0; i < 4; ++i) v[i] = vn[i];
    }
}

#define XB_TMO      128
#define XB_XCNT(j)  (256  + 64 * (j))
#define XB_XSUB(j)  (1280 + 64 * (j))
#define XB_XGEN(j)  (2304 + 64 * (j))
#define XB_TOP      3328
#define XB_TOPGEN   3392
#define XCD_BAR_WORDS 3456
#define XB_SPIN_CAP (1u << 22)
__device__ __forceinline__ unsigned xb_ld(unsigned* p)              { return __hip_atomic_load(p, __ATOMIC_RELAXED, __HIP_MEMORY_SCOPE_AGENT); }
__device__ __forceinline__ unsigned xb_add(unsigned* p, unsigned v) { return __hip_atomic_fetch_add(p, v, __ATOMIC_RELAXED, __HIP_MEMORY_SCOPE_AGENT); }
__device__ __forceinline__ unsigned xb_xcc_id() { return (unsigned)__builtin_amdgcn_s_getreg((3 << 11) | 20) & 0xFu; }
#define XB_SPIN(cond, bar) do { unsigned _sp = 0; while (cond) { __builtin_amdgcn_s_sleep(1); \
    if ((++_sp & 255u) == 0u) { if (xb_ld(&(bar)[XB_TMO])) break; if (_sp > XB_SPIN_CAP) { atomicAdd(&(bar)[XB_TMO], 1u); break; } } } } while (0)
struct XcdBarrier { unsigned* bar; unsigned x; volatile LAS unsigned* st; };
__device__ __forceinline__ XcdBarrier xcd_barrier_post(unsigned* bar, volatile LAS unsigned* st) {
    XcdBarrier b; b.bar = bar; b.x = xb_xcc_id(); b.st = st;
    if (threadIdx.x == 0) (void)xb_add(&bar[XB_XCNT(b.x)], 1u);
    return b;
}
__device__ __forceinline__ void xcd_barrier_complete(unsigned* bar, unsigned x, unsigned& nloc, unsigned& nx) {
    const unsigned G = gridDim.x * gridDim.y * gridDim.z;
    unsigned sum, cnt, mine, sp = 0u;
    for (;;) {
        sum = 0u; cnt = 0u; mine = 0u;
#pragma unroll
        for (unsigned j = 0; j < 16; ++j) { const unsigned c = xb_ld(&bar[XB_XCNT(j)]); sum += c; cnt += (c > 0u) ? 1u : 0u; mine = (j == x) ? c : mine; }
        if (sum == G) break;
        __builtin_amdgcn_s_sleep(1);
        if ((++sp & 255u) == 0u) { if (xb_ld(&bar[XB_TMO])) break; if (sp > XB_SPIN_CAP) { atomicAdd(&bar[XB_TMO], 1u); break; } }
    }
    nloc = mine > 0u ? mine : 1u; nx = cnt > 0u ? cnt : 1u;
}
__device__ __forceinline__ void xcd_barrier(unsigned* bar_, volatile LAS unsigned* st_) {
    XcdBarrier b; b.bar = bar_; b.x = xb_xcc_id(); b.st = st_;
    asm volatile("s_waitcnt vmcnt(0)" ::: "memory");
    __syncthreads();
    if (opaque_tid() == 0) {
        unsigned* bar = b.bar;
        __builtin_amdgcn_s_waitcnt(0);
        unsigned nloc = b.st[0], nx = b.st[1];
        if (nloc == 0u) { xcd_barrier_complete(bar, b.x, nloc, nx); b.st[0] = nloc; b.st[1] = nx; }
        const unsigned old = xb_add(&bar[XB_XSUB(b.x)], 1u);
        const unsigned gen = old / nloc;
        if (old + 1u == (gen + 1u) * nloc) {
            __builtin_amdgcn_fence(__ATOMIC_RELEASE, "agent");
            asm volatile("s_waitcnt vmcnt(0)" ::: "memory");
            const unsigned og = xb_add(&bar[XB_TOP], 1u);
            const unsigned tg = og / nx;
            if (og + 1u == (tg + 1u) * nx) xb_add(&bar[XB_TOPGEN], 1u);
            else XB_SPIN(xb_ld(&bar[XB_TOPGEN]) == tg, bar);
            __builtin_amdgcn_fence(__ATOMIC_ACQUIRE, "agent");
            xb_add(&bar[XB_XGEN(b.x)], 1u);
            asm volatile("s_waitcnt vmcnt(0)" ::: "memory");
        } else {
            XB_SPIN(xb_ld(&bar[XB_XGEN(b.x)]) == gen, bar);
            __builtin_amdgcn_fence(__ATOMIC_ACQUIRE, "agent");
            asm volatile("s_waitcnt vmcnt(0)" ::: "memory");
        }
    }
    __syncthreads();
}

constexpr int SMEM_BYTES = 160 * 1024;
static_assert(DS_END <= SMEM_BYTES - 16, "dsa lds");

__global__ void __launch_bounds__(NT, 2) k_mega(Params p) {
    __shared__ __attribute__((aligned(16))) char smem[SMEM_BYTES];
    volatile LAS unsigned* xbw = (volatile LAS unsigned*)((LAS unsigned char*)smem + (SMEM_BYTES - 16));
    if (threadIdx.x == 0) { xbw[0] = 0u; xbw[1] = 0u; xbw[2] = 0u; xbw[3] = 0u; }
    __syncthreads();
    if (p.ws == nullptr) cg::this_grid().sync();
    (void)xcd_barrier_post((unsigned*)(p.ws + OFF_BAR), xbw);
    for (int rep = 0; rep < PROBE_REP_PREP; ++rep) {
    phase_prep(p, smem);
    xcd_barrier((unsigned*)(p.ws + OFF_BAR), xbw);
    }
#pragma unroll 1
    for (int layer = 0; layer < DEPTH; ++layer) {
        for (int rep = 0; rep < PROBE_REP_PROJ; ++rep) {
        phase_proj(p, layer, smem);
        xcd_barrier((unsigned*)(p.ws + OFF_BAR), xbw);
        }
        phase_rope(p, layer, smem);
        for (int rep = 0; rep < PROBE_REP_GLAA; ++rep) {
        phase_gla_a(p, layer, smem);
        xcd_barrier((unsigned*)(p.ws + OFF_BAR), xbw);
        phase_gla_scan(p, layer, smem);
        xcd_barrier((unsigned*)(p.ws + OFF_BAR), xbw);
        }
        for (int rep = 0; rep < PROBE_REP_GLAC; ++rep) phase_gla_c(p, layer, smem, rep == PROBE_REP_GLAC - 1);
        for (int rep = 0; rep < PROBE_REP_DSA; ++rep) phase_dsa(p, layer, smem, rep == PROBE_REP_DSA - 1);
        xcd_barrier((unsigned*)(p.ws + OFF_BAR), xbw);
        for (int rep = 0; rep < PROBE_REP_OUT; ++rep) {
        phase_outproj(p, layer, smem);
        xcd_barrier((unsigned*)(p.ws + OFF_BAR), xbw);
        }
        for (int rep = 0; rep < PROBE_REP_LN; ++rep) {
        phase_ln(p, layer, smem);
        xcd_barrier((unsigned*)(p.ws + OFF_BAR), xbw);
        }
    }
}

extern "C" void kernel_launch(void* const* d_in, const int* in_sizes, int n_in, void* d_out, int out_size, void* d_ws, size_t ws_size,
                              hipStream_t stream) {
    Params p{};
    p.x = (const float*)d_in[0]; p.meta = (const float*)d_in[1]; p.ln_in_g = (const float*)d_in[2]; p.ln_in_b = (const float*)d_in[3];
    p.w_in = (const float*)d_in[4]; p.wg2 = (const float*)d_in[5]; p.bg = (const float*)d_in[6]; p.norm_g = (const float*)d_in[7];
    p.ikg = (const float*)d_in[8]; p.ikb = (const float*)d_in[9]; p.w_out = (const float*)d_in[10]; p.ln_g = (const float*)d_in[11];
    p.ln_b = (const float*)d_in[12];
    p.out = (float*)d_out; p.ws = (char*)d_ws;
    static int grid_blocks = 0;
    if (!grid_blocks) {
        int dev = 0, cus = 0, per_cu = 0;
        hipGetDevice(&dev);
        hipDeviceGetAttribute(&cus, hipDeviceAttributeMultiprocessorCount, dev);
        hipOccupancyMaxActiveBlocksPerMultiprocessor(&per_cu, k_mega, NT, 0);
        if (per_cu > 1) per_cu = 1;
        grid_blocks = cus * per_cu;
    }
    (void)hipMemsetAsync((char*)d_ws + OFF_BAR, 0, XCD_BAR_WORDS * 4, stream);
    void* args[] = {&p};
    (void)hipLaunchCooperativeKernel((void*)k_mega, dim3(grid_blocks), dim3(NT), args, 0, stream);
}
```

```cpp
#include <hip/hip_runtime.h>
#include <hip/hip_cooperative_groups.h>
#include <stdint.h>
namespace cg = cooperative_groups;
#ifndef PROBE_REP_PREP
#define PROBE_REP_PREP 1
#define PROBE_REP_PROJ 1
#define PROBE_REP_GLAA 1
#define PROBE_REP_GLAC 1
#define PROBE_REP_DSA 1
#define PROBE_REP_OUT 1
#define PROBE_REP_LN 1
#define PROBE_DSA_A 1
#define PROBE_DSA_B 1
#define PROBE_DSA_C 1
#endif

constexpr int D = 1024, NB = 8, SEQ = 2048, NMETA = 16, L = 2064, T = NB * L;
constexpr int DEPTH = 2;
constexpr int INW = 3416, INWP = 3584;
constexpr int TP = 16640;
constexpr int NT = 512;
constexpr int TOPK = 256;
constexpr float LN_EPS = 1e-5f;
constexpr float ALPHA = 1.41421356237309515f;

typedef unsigned short bf16_t;
typedef short bf16x8 __attribute__((ext_vector_type(8)));
typedef float f32x4 __attribute__((ext_vector_type(4)));
#define LAS __attribute__((address_space(3)))

constexpr size_t SZ_H32 = (size_t)T * D * 4;
constexpr size_t SZ_HB = (size_t)TP * D * 2;
constexpr size_t SZ_WIN = (size_t)DEPTH * INWP * D * 2;
constexpr size_t SZ_WOUT = (size_t)DEPTH * D * D * 2;
constexpr int LPV = 2112;
constexpr size_t SZ_GQ = (size_t)T * 256 * 2, SZ_GK = SZ_GQ, SZ_GV = (size_t)NB * 4 * 128 * LPV * 2;
constexpr size_t SZ_UT = (size_t)1024 * 128 * 64 * 4, SZ_ST = (size_t)32 * 33 * 128 * 64 * 2, SZ_DL = (size_t)1024 * 64 * 4;
constexpr size_t SZ_AQ = (size_t)T * 512 * 2, SZ_IQ = (size_t)T * 512 * 2;
constexpr size_t SZ_MIX = (size_t)TP * 1024 * 2;
constexpr int LP = 2112;
constexpr size_t SZ_AK = (size_t)T * 128 * 2, SZ_AV = (size_t)NB * 2 * 64 * LP * 2, SZ_IK = (size_t)T * 64 * 2, SZ_IW = (size_t)T * 8 * 4;
constexpr size_t SZ_GLR = (size_t)T * 16 * 4;
constexpr size_t SZ_ROPE = (size_t)L * 8 * 2 * 4;

constexpr size_t OFF_H32 = 0;
constexpr size_t OFF_HB = OFF_H32 + SZ_H32;
constexpr size_t OFF_WIN = OFF_HB + SZ_HB;
constexpr size_t OFF_WOUT = OFF_WIN + SZ_WIN;
constexpr size_t OFF_GQ = OFF_WOUT + SZ_WOUT;
constexpr size_t OFF_GK = OFF_GQ + SZ_GQ;
constexpr size_t OFF_GV = OFF_GK + SZ_GK;
constexpr size_t OFF_AQ = OFF_GV + SZ_GV;
constexpr size_t OFF_IQ = OFF_AQ + SZ_AQ;
constexpr size_t OFF_MIX = OFF_IQ + SZ_IQ;
constexpr size_t OFF_AK = OFF_MIX + SZ_MIX;
constexpr size_t OFF_AV = OFF_AK + SZ_AK;
constexpr size_t OFF_IK = OFF_AV + SZ_AV;
constexpr size_t OFF_IW = OFF_IK + SZ_IK;
constexpr size_t OFF_GLR = OFF_IW + SZ_IW;
constexpr size_t OFF_ROPE = OFF_GLR + SZ_GLR;
constexpr size_t OFF_ST = OFF_ROPE + SZ_ROPE;
constexpr size_t OFF_DL = OFF_ST + SZ_ST;
constexpr size_t OFF_BAR = OFF_DL + SZ_DL;
constexpr size_t OFF_IKR = OFF_BAR + 16384;
constexpr size_t OFF_END = OFF_IKR + (size_t)T * 64 * 4;
constexpr size_t OFF_UT = OFF_HB;
static_assert(SZ_UT <= SZ_HB, "UT alias");
static_assert(SZ_GQ + SZ_GK + SZ_GV + SZ_AQ + SZ_IQ >= SZ_H32, "Z alias size");
static_assert(OFF_END <= (size_t)256 * 1024 * 1024, "workspace too large");

struct Params {
    const float* x; const float* meta; const float* ln_in_g; const float* ln_in_b;
    const float* w_in; const float* wg2; const float* bg; const float* norm_g;
    const float* ikg; const float* ikb; const float* w_out; const float* ln_g; const float* ln_b;
    float* out; char* ws;
};
typedef const Params __attribute__((address_space(4))) * KParamsPtr;
__device__ __forceinline__ Params kparams() {
    unsigned long long a = (unsigned long long)__builtin_amdgcn_kernarg_segment_ptr();
    asm volatile("" : "+s"(a));
    KParamsPtr q = (KParamsPtr)a;
    Params r;
    r.x = q->x; r.meta = q->meta; r.ln_in_g = q->ln_in_g; r.ln_in_b = q->ln_in_b; r.w_in = q->w_in; r.wg2 = q->wg2; r.bg = q->bg; r.norm_g = q->norm_g;
    r.ikg = q->ikg; r.ikb = q->ikb; r.w_out = q->w_out; r.ln_g = q->ln_g; r.ln_b = q->ln_b; r.out = q->out; r.ws = q->ws;
    return r;
}

__device__ __forceinline__ bf16_t f2bf(float f) {
    unsigned u = __float_as_uint(f);
    u += 0x7FFFu + ((u >> 16) & 1u);
    return (bf16_t)(u >> 16);
}
__device__ __forceinline__ unsigned pack2bf(float lo, float hi) { return (unsigned)f2bf(lo) | ((unsigned)f2bf(hi) << 16); }
__device__ __forceinline__ unsigned cvt_pk_bf16(float lo, float hi) { unsigned r; asm volatile("v_cvt_pk_bf16_f32 %0, %1, %2" : "=v"(r) : "v"(lo), "v"(hi)); return r; }
typedef unsigned u32x4 __attribute__((ext_vector_type(4)));
typedef unsigned u32x2 __attribute__((ext_vector_type(2)));
__device__ __forceinline__ float bf2f(bf16_t h) { return __uint_as_float(((unsigned)h) << 16); }
constexpr int WVTAB_OFF = 160 * 1024 - 16 - 64;
__device__ __forceinline__ int opaque_tid() {
    const unsigned slot = (unsigned)__builtin_amdgcn_s_getreg(((6 - 1) << 11) | 4) & 63u;
    const unsigned wv = *((const volatile LAS unsigned char*)(size_t)WVTAB_OFF + slot);
    int t = (int)(wv << 6) | (int)__builtin_amdgcn_mbcnt_hi(~0u, __builtin_amdgcn_mbcnt_lo(~0u, 0u));
    asm volatile("" : "+v"(t)); return t;
}
__device__ __forceinline__ int opaque_int(int v) { asm volatile("" : "+s"(v)); return v; }
__device__ __forceinline__ int opaque_bid() { int t = blockIdx.x; asm volatile("" : "+s"(t)); return t; }
__device__ __forceinline__ float wave_sum(float v) {
#pragma unroll
    for (int o = 32; o > 0; o >>= 1) v += __shfl_xor(v, o);
    return v;
}
__device__ __forceinline__ float wave_max(float v) {
#pragma unroll
    for (int o = 32; o > 0; o >>= 1) v = fmaxf(v, __shfl_xor(v, o));
    return v;
}
__device__ __forceinline__ float block_sum(float v, float* red) {
    v = wave_sum(v);
    const int tq = opaque_tid();
    __syncthreads();
    if ((tq & 63) == 0) red[tq >> 6] = v;
    __syncthreads();
    return ((red[0] + red[1]) + (red[2] + red[3])) + ((red[4] + red[5]) + (red[6] + red[7]));
}
__device__ __forceinline__ float silu_f(float x) { return x / (1.f + __expf(-x)); }
__device__ __forceinline__ float logsigmoid_f(float x) { return fminf(x, 0.f) - log1pf(expf(-fabsf(x))); }
__device__ __forceinline__ float logsigmoid_fast(float x) { return fminf(x, 0.f) - __logf(1.f + __expf(-fabsf(x))); }

__device__ __forceinline__ int proj_src_col(int n) {
    if (n < 1024) return n;
    if (n < 1536) return n - 1024 + 1040;
    if (n < 2048) return n - 1536 + 1552;
    if (n < 2560) return n - 2048 + 2904;
    if (n < 3072) return n - 2560 + 2320;
    if (n < 3200) return n - 3072 + 2064;
    if (n < 3328) return n - 3200 + 2192;
    const int c = n - 3328;
    if (c < 32) return 2832 + c;
    if (c < 48) return 1024 + (c - 32);
    if (c < 56) return 2896 + (c - 48);
    if (c >= 128 && c < 160) return 2832 + 32 + (c - 128);
    return -1;
}

__device__ __forceinline__ void sincos_acc(float a, float& s, float& c) {
    double ad = (double)a;
    double kd = rint(ad * 0.63661977236758134308);
    double r = fma(-kd, 1.57079632679489655800, ad);
    r = fma(-kd, 6.12323399573676603587e-17, r);
    double r2 = r * r;
    double sp = r * (1.0 + r2 * (-1.0 / 6 + r2 * (1.0 / 120 + r2 * (-1.0 / 5040 + r2 * (1.0 / 362880 + r2 * (-1.0 / 39916800))))));
    double cp = 1.0 + r2 * (-0.5 + r2 * (1.0 / 24 + r2 * (-1.0 / 720 + r2 * (1.0 / 40320 + r2 * (-1.0 / 3628800 + r2 * (1.0 / 479001600))))));
    int q = ((int)kd) & 3;
    double ss = (q & 1) ? cp : sp, cc = (q & 1) ? sp : cp;
    if (q == 1 || q == 2) cc = -cc;
    if (q == 2 || q == 3) ss = -ss;
    s = (float)ss; c = (float)cc;
}

__device__ __forceinline__ void ln_row_wave(f32x4 (&v)[4], const float* g, const float* bb, int lane) {
    float sm = 0.f;
#pragma unroll
    for (int i = 0; i < 4; ++i) sm += (v[i][0] + v[i][1]) + (v[i][2] + v[i][3]);
    const float mu = wave_sum(sm) * (1.f / D);
    float qq = 0.f;
#pragma unroll
    for (int i = 0; i < 4; ++i) { v[i] = v[i] - mu; qq += (v[i][0] * v[i][0] + v[i][1] * v[i][1]) + (v[i][2] * v[i][2] + v[i][3] * v[i][3]); }
    const float rs = rsqrtf(wave_sum(qq) * (1.f / D) + LN_EPS);
#pragma unroll
    for (int i = 0; i < 4; ++i) { const f32x4 gg = *(const f32x4*)(g + 4 * lane + 256 * i), b4 = *(const f32x4*)(bb + 4 * lane + 256 * i); v[i] = v[i] * rs * gg + b4; }
}
__device__ __forceinline__ int proj_dst_col(int src) {
    if (src < 1024) return src;
    if (src < 1040) return 3328 + 32 + (src - 1024);
    if (src < 1552) return 1024 + (src - 1040);
    if (src < 2064) return 1536 + (src - 1552);
    if (src < 2192) return 3072 + (src - 2064);
    if (src < 2320) return 3200 + (src - 2192);
    if (src < 2832) return 2560 + (src - 2320);
    if (src < 2864) return 3328 + (src - 2832);
    if (src < 2896) return 3328 + 128 + (src - 2864);
    if (src < 2904) return 3328 + 48 + (src - 2896);
    return 2048 + (src - 2904);
}
__device__ __forceinline__ void phase_prep(const Params& p_in, char* smem) {
    const Params p = kparams(); (void)p_in;
    const int tid = opaque_tid(), wid = tid >> 6, lane = tid & 63;
    bf16_t* WIN = (bf16_t*)(p.ws + OFF_WIN);
    bf16_t* WOUT = (bf16_t*)(p.ws + OFF_WOUT);
    float* H32 = (float*)(p.ws + OFF_H32);
    bf16_t* HB = (bf16_t*)(p.ws + OFF_HB);
    bf16_t* MIX = (bf16_t*)(p.ws + OFF_MIX);
    float2* ROPE = (float2*)(p.ws + OFF_ROPE);
    float (*tile)[65] = (float (*)[65])smem;
    constexpr int NCT_IN = (INW + 63) / 64, NT_IN = DEPTH * 16 * NCT_IN, NT_OUT = DEPTH * 16 * 16;
    for (int item = opaque_bid(); item < NT_IN + NT_OUT; item += gridDim.x) {
        const bool is_in = item < NT_IN;
        const int it = is_in ? item : item - NT_IN;
        const int nct = is_in ? NCT_IN : 16, ldw = is_in ? INW : D;
        const int l = it / (16 * nct), rem = it - l * 16 * nct, kt = rem / nct, ct = rem - kt * nct;
        const float* W = (is_in ? p.w_in : p.w_out) + (size_t)l * D * ldw;
        __syncthreads();
#pragma unroll
        for (int i = 0; i < 8; ++i) {
            const int e = tid + NT * i, kk = e >> 6, nn = e & 63, col = ct * 64 + nn;
            tile[kk][nn] = (col < ldw) ? W[(size_t)(kt * 64 + kk) * ldw + col] : 0.f;
        }
        __syncthreads();
        {
            const int nn = tid >> 3, k8 = (tid & 7) * 8, src = ct * 64 + nn;
            if (src < ldw) {
                const int dst = is_in ? proj_dst_col(src) : src;
                u32x4 o;
#pragma unroll
                for (int q = 0; q < 4; ++q) o[q] = cvt_pk_bf16(tile[k8 + 2 * q][nn], tile[k8 + 2 * q + 1][nn]);
                bf16_t* dstp = (is_in ? WIN + ((size_t)l * INWP + dst) * D : WOUT + ((size_t)l * D + dst) * D) + kt * 64 + k8;
                *(u32x4*)dstp = o;
            }
        }
    }
    {
        const int nw = gridDim.x * 8;
        for (int t = opaque_bid() * 8 + wid; t < TP; t += nw) {
            if (t < T) {
                const int b = t / L, pos = t - b * L;
                const float* src = (pos < NMETA) ? (p.meta + (size_t)pos * D) : (p.x + ((size_t)b * SEQ + (pos - NMETA)) * D);
                f32x4 v[4];
#pragma unroll
                for (int i = 0; i < 4; ++i) v[i] = *(const f32x4*)(src + 4 * lane + 256 * i);
                ln_row_wave(v, p.ln_in_g, p.ln_in_b, lane);
#pragma unroll
                for (int i = 0; i < 4; ++i) {
                    *(f32x4*)(H32 + (size_t)t * D + 4 * lane + 256 * i) = v[i];
                    u32x2 o; o[0] = cvt_pk_bf16(v[i][0], v[i][1]); o[1] = cvt_pk_bf16(v[i][2], v[i][3]);
                    *(u32x2*)(HB + (size_t)t * D + 4 * lane + 256 * i) = o;
                }
            } else {
#pragma unroll
                for (int i = 0; i < 4; ++i) {
                    *(u32x2*)(HB + (size_t)t * D + 4 * lane + 256 * i) = (u32x2){0u, 0u};
                    *(u32x2*)(MIX + (size_t)t * D + 4 * lane + 256 * i) = (u32x2){0u, 0u};
                }
            }
        }
    }
    for (int e = opaque_bid() * NT + tid; e < L * 8; e += gridDim.x * NT) {
        const int pos = e >> 3, i = e & 7;
        const float inv[8] = {1.0f, 0.19392274f, 0.03760603f, 0.0072926646f, 0.0014142136f, 0.0002742482f, 5.3182957e-05f, 1.0313385e-05f};
        float iv = inv[0];
#pragma unroll
        for (int j = 1; j < 8; ++j) iv = (i == j) ? inv[j] : iv;
        const float ang = (float)pos * iv;
        float sn, cs; sincos_acc(ang, sn, cs);
        ROPE[e] = make_float2(cs, sn);
    }
}

namespace pg8 {
constexpr int BM = 256, BK = 64, HALF = 128, HTB = HALF * BK * 2  , STAGE_BYTES = 8 * HTB, NXCD = 8, WGM = 8;
__device__ __forceinline__ int lds_byte(int r, int c) { const int st = (r >> 4) * 2 + (c >> 5), rr = r & 15, cc = c & 31, ob = rr * 64 + cc * 2; return st * 1024 + (ob ^ (((ob >> 9) & 1) << 5)); }
__device__ __forceinline__ void stage_rc(int b, int& R, int& C) { const int st = b / 1024, sb = b % 1024, swz = sb ^ (((sb >> 9) & 1) << 5); R = (st >> 1) * 16 + swz / 64; C = (st & 1) * 32 + (swz % 64) / 2; }
__device__ __forceinline__ int perm32(int rho) { const int n = rho >> 4, i = rho & 15; return 8 * (i >> 2) + 4 * n + (i & 3); }

struct Unit { int pm, pn; };
struct Gemm { const bf16_t* A; const bf16_t* Bt; int M, N, K; };

struct StaticOrder {
    int nM, nN, nwg, G, c;
    __device__ void init(int M, int N, int G_, int c_) { nM = M / BM; nN = N / BM; nwg = nM * nN; G = G_; c = c_; }
    __device__ bool next(int i, Unit& u) const {
        const long Lx = (long)i * G + c; if (Lx >= nwg) return false;
        int wgid = (int)Lx; { const int q = nwg / NXCD, r = nwg % NXCD, xcd = wgid % NXCD, off = wgid / NXCD; wgid = (xcd < r ? xcd * (q + 1) : r * (q + 1) + (xcd - r) * q) + off; }
        const int nig = WGM * nN, gid = wgid / nig, fm = gid * WGM, gsz = (nM - fm) < WGM ? (nM - fm) : WGM;
        u.pm = fm + ((wgid % nig) % gsz); u.pn = (wgid % nig) / gsz; return true;
    }
    __device__ __forceinline__ void a_ready(const Unit&) const {}
    __device__ __forceinline__ void done(const Unit&) const {}
};

template <class Epi, class Sched>
__device__ __forceinline__ void gemm_phase(LAS unsigned char* lds, const Gemm g, const Sched& S, const Epi& E) {
    const int tid = opaque_tid(), wid = __builtin_amdgcn_readfirstlane(tid >> 6), lane = tid & 63, wr = wid >> 2, wc = wid & 3, fr = lane & 15, fq = lane >> 4;
    const int K = g.K, nt = K / BK;
    unsigned voffA[2], voffB[2];
#pragma unroll
    for (int i = 0; i < 2; ++i) { int R, C; stage_rc(tid * 16 + i * 8192, R, C); const int Rb = Epi::PERM ? ((R & ~31) + perm32(R & 31)) : R;
        voffA[i] = (unsigned)(R * K + C) * 2u; voffB[i] = (unsigned)(Rb * K + C) * 2u; }
    const size_t kstep = (size_t)(BK * 2);
    const size_t hstep = (size_t)HALF * K * 2;
    const size_t tstep = 2 * hstep;
    const unsigned ldsw = (unsigned)wid * 1024u;
    const int aoff = lds_byte(wr * 64 + fr, fq * 8), boff = lds_byte(wc * 32 + fr, fq * 8);
#define PG8_SA(b, h) (((b) * 2 + (h)) * HTB)
#define PG8_SB(b, h) ((4 + (b) * 2 + (h)) * HTB)
#define PG8_STAGE(bufoff, gbase, voff) do { _Pragma("unroll") for (int _i = 0; _i < 2; ++_i) \
        __builtin_amdgcn_global_load_lds((const unsigned*)((const char*)(gbase) + (voff)[_i]), (LAS unsigned*)(lds + (bufoff) + ldsw + _i * 8192), 16, 0, 0); } while (0)
    const LAS unsigned char* la_base = lds + aoff; asm volatile("" : "+v"(la_base));
    const LAS unsigned char* lb_base = lds + 4 * HTB + boff; asm volatile("" : "+v"(lb_base));
#define PG8_LDA(dst, b, h) do { _Pragma("unroll") for (int m = 0; m < 4; ++m) _Pragma("unroll") for (int k = 0; k < 2; ++k) dst[m][k] = *(const LAS bf16x8*)(la_base + PG8_SA(b, h) + m * 2048 + k * 1024); } while (0)
#define PG8_LDB(dst, b, h) do { _Pragma("unroll") for (int n = 0; n < 2; ++n) _Pragma("unroll") for (int k = 0; k < 2; ++k) dst[n][k] = *(const LAS bf16x8*)(lb_base + (PG8_SB(b, h) - 4 * HTB) + n * 2048 + k * 1024); } while (0)
#define PG8_MMA(ai, bj, At, Bt) do { __builtin_amdgcn_s_setprio(1); _Pragma("unroll") for (int m = 0; m < 4; ++m) _Pragma("unroll") for (int n = 0; n < 2; ++n) _Pragma("unroll") for (int k = 0; k < 2; ++k) \
        acc[ai][bj][m][n] = __builtin_amdgcn_mfma_f32_16x16x32_bf16(Bt[n][k], At[m][k], acc[ai][bj][m][n], 0, 0, 0); __builtin_amdgcn_s_setprio(0); } while (0)
#define PG8_WAIT_V(n) asm volatile("s_waitcnt vmcnt(" #n ")" ::: "memory")
#define PG8_WAIT_L(n) asm volatile("s_waitcnt lgkmcnt(" #n ")" ::: "memory")
#define PG8_BAR __builtin_amdgcn_s_barrier()
#define PG8_SCHED __builtin_amdgcn_sched_barrier(0)
    Unit cur, nxt; int ui = 0;
    if (!S.next(0, cur)) return;
    f32x4 acc[2][2][4][2];
#pragma unroll
    for (int a = 0; a < 2; ++a)
#pragma unroll
        for (int b = 0; b < 2; ++b)
#pragma unroll
            for (int m = 0; m < 4; ++m)
#pragma unroll
                for (int n = 0; n < 2; ++n) acc[a][b][m][n] = (f32x4){0.f, 0.f, 0.f, 0.f};
    bf16x8 At[4][2], B0[2][2], B1[2][2];
    const char* cA = (const char*)g.A + (size_t)cur.pm * tstep; const char* cB = (const char*)g.Bt + (size_t)cur.pn * tstep;
    S.a_ready(cur);
    PG8_STAGE(PG8_SB(0, 0), cB, voffB); PG8_STAGE(PG8_SA(0, 0), cA, voffA); PG8_STAGE(PG8_SB(0, 1), cB + hstep, voffB); PG8_STAGE(PG8_SA(0, 1), cA + hstep, voffA);
    if (wr == 1) PG8_BAR;
    PG8_WAIT_V(4); PG8_BAR;
    PG8_STAGE(PG8_SB(1, 0), cB + kstep, voffB); PG8_STAGE(PG8_SA(1, 0), cA + kstep, voffA); PG8_STAGE(PG8_SB(1, 1), cB + hstep + kstep, voffB);
    PG8_WAIT_V(6); PG8_BAR;
    for (;;) {
        const bool has_next = S.next(ui + 1, nxt);
        const char* nA = has_next ? (const char*)g.A + (size_t)nxt.pm * tstep : cA; const char* nB = has_next ? (const char*)g.Bt + (size_t)nxt.pn * tstep : cB;
        for (int t = 0; t < nt; t += 2) {
            const bool last = (t == nt - 2);
            const char* a1 = cA + (size_t)(t + 1) * kstep;
            const char* a2 = last ? nA : cA + (size_t)(t + 2) * kstep; const char* b2 = last ? nB : cB + (size_t)(t + 2) * kstep;
            const char* a3 = a2 + kstep; const char* b3 = b2 + kstep;
            if (last && has_next) S.a_ready(nxt);
            PG8_LDB(B0, 0, 0); PG8_SCHED; PG8_LDA(At, 0, 0); PG8_STAGE(PG8_SA(1, 1), a1 + hstep, voffA);
            PG8_WAIT_L(8); PG8_BAR; PG8_WAIT_L(0); PG8_MMA(0, 0, At, B0); PG8_BAR; PG8_SCHED;
            PG8_LDB(B1, 0, 1); PG8_STAGE(PG8_SB(0, 0), b2, voffB);
            PG8_BAR; PG8_WAIT_L(0); PG8_MMA(0, 1, At, B1); PG8_BAR;
            PG8_LDA(At, 0, 1); PG8_STAGE(PG8_SA(0, 0), a2, voffA);
            PG8_BAR; PG8_WAIT_L(0); PG8_MMA(1, 0, At, B0); PG8_BAR; PG8_SCHED;
            PG8_STAGE(PG8_SB(0, 1), b2 + hstep, voffB);
            PG8_WAIT_V(6); PG8_BAR; PG8_MMA(1, 1, At, B1); PG8_BAR;
            PG8_LDB(B0, 1, 0); PG8_SCHED; PG8_LDA(At, 1, 0); PG8_STAGE(PG8_SA(0, 1), a2 + hstep, voffA);
            PG8_WAIT_L(8); PG8_BAR; PG8_WAIT_L(0); PG8_MMA(0, 0, At, B0); PG8_BAR; PG8_SCHED;
            PG8_LDB(B1, 1, 1); PG8_STAGE(PG8_SB(1, 0), b3, voffB);
            PG8_BAR; PG8_WAIT_L(0); PG8_MMA(0, 1, At, B1); PG8_BAR;
            PG8_LDA(At, 1, 1); PG8_STAGE(PG8_SA(1, 0), a3, voffA);
            PG8_BAR; PG8_WAIT_L(0); PG8_MMA(1, 0, At, B0); PG8_BAR; PG8_SCHED;
            PG8_STAGE(PG8_SB(1, 1), b3 + hstep, voffB);
            PG8_WAIT_V(6); PG8_BAR; PG8_MMA(1, 1, At, B1); PG8_BAR;
        }
        E(acc, cur, wr, wc, fr, fq); S.done(cur);
        if (!has_next) break;
#pragma unroll
        for (int a = 0; a < 2; ++a)
#pragma unroll
            for (int b = 0; b < 2; ++b)
#pragma unroll
                for (int m = 0; m < 4; ++m)
#pragma unroll
                    for (int n = 0; n < 2; ++n) acc[a][b][m][n] = (f32x4){0.f, 0.f, 0.f, 0.f};
        cur = nxt; cA = nA; cB = nB; ++ui;
    }
    PG8_WAIT_V(0);
    if (wr == 0) PG8_BAR;
    PG8_BAR;
#undef PG8_SA
#undef PG8_SB
#undef PG8_STAGE
#undef PG8_LDA
#undef PG8_LDB
#undef PG8_MMA
#undef PG8_WAIT_V
#undef PG8_WAIT_L
#undef PG8_BAR
#undef PG8_SCHED
}
}

struct EpiProj {
    static constexpr bool PERM = true;
    char* ws;
    __device__ __forceinline__ void store8(bf16_t* dst, const f32x4& a, const f32x4& b, float sc) const {
        u32x4 o; o[0] = cvt_pk_bf16(a[0] * sc, a[1] * sc); o[1] = cvt_pk_bf16(a[2] * sc, a[3] * sc); o[2] = cvt_pk_bf16(b[0] * sc, b[1] * sc); o[3] = cvt_pk_bf16(b[2] * sc, b[3] * sc);
        *(u32x4*)dst = o;
    }
    __device__ __forceinline__ void operator()(const f32x4 (&acc)[2][2][4][2], const pg8::Unit& u, int wr, int wc, int fr, int fq) const {
        { int ln_ = (int)__builtin_amdgcn_mbcnt_hi(~0u, __builtin_amdgcn_mbcnt_lo(~0u, 0u)); asm volatile("" : "+v"(ln_)); fr = ln_ & 15; fq = ln_ >> 4; }
        if (u.pn < 13) {
#pragma unroll
            for (int bj = 0; bj < 2; ++bj) {
                const int hb = 4 * u.pn + 2 * bj + (wc >> 1);
                const int cc8 = 32 * (wc & 1) + 8 * fq;
#pragma unroll
                for (int ai = 0; ai < 2; ++ai)
#pragma unroll
                    for (int m = 0; m < 4; ++m) {
                        const int t = 256 * u.pm + 128 * ai + 64 * wr + 16 * m + fr;
                        const f32x4 v0 = acc[ai][bj][m][0], v1 = acc[ai][bj][m][1];
                        if (t < T) {
                            const size_t tt = (size_t)t;
                            if (hb < 4) store8((bf16_t*)(ws + OFF_GQ) + tt * 256 + hb * 64 + cc8, v0, v1, 0.125f);
                            else if (hb < 8) store8((bf16_t*)(ws + OFF_GK) + tt * 256 + (hb - 4) * 64 + cc8, v0, v1, 1.f);
                            else if (hb < 16) {
                                const int bq = t / L, pos = t - bq * L;
                                bf16_t* dst = (bf16_t*)(ws + OFF_GV) + ((size_t)(bq * 4 + ((hb - 8) >> 1)) * 128 + ((hb - 8) & 1) * 64 + cc8) * LPV + 48 + pos;
#pragma unroll
                                for (int j = 0; j < 4; ++j) { dst[(size_t)j * LPV] = f2bf(v0[j]); dst[(size_t)(4 + j) * LPV] = f2bf(v1[j]); }
                            }
                            else if (hb < 24 || (hb >= 32 && hb < 40)) {
                                f32x4 s0, s1;
#pragma unroll
                                for (int j = 0; j < 4; ++j) { s0[j] = silu_f(v0[j]); s1[j] = silu_f(v1[j]); }
                                const int col = (hb < 24) ? (hb - 16) * 64 : 512 + (hb - 32) * 64;
                                store8((bf16_t*)(ws + OFF_MIX) + tt * 1024 + col + cc8, s0, s1, 1.f);
                            }
                            else if (hb < 32) store8((bf16_t*)(ws + OFF_AQ) + tt * 512 + (hb - 24) * 64 + cc8, v0, v1, 0.125f * 1.44269504088896341f);
                            else if (hb < 48) store8((bf16_t*)(ws + OFF_IQ) + tt * 512 + (hb - 40) * 64 + cc8, v0, v1, 0.125f);
                            else if (hb < 50) store8((bf16_t*)(ws + OFF_AK) + tt * 128 + (hb - 48) * 64 + cc8, v0, v1, 1.f);
                            else {
                                const int bq = t / L, pos = t - bq * L;
                                bf16_t* dst = (bf16_t*)(ws + OFF_AV) + ((size_t)(bq * 2 + (hb - 50)) * 64 + cc8) * LP + pos;
#pragma unroll
                                for (int j = 0; j < 4; ++j) { dst[(size_t)j * LP] = f2bf(v0[j]); dst[(size_t)(4 + j) * LP] = f2bf(v1[j]); }
                            }
                        }
                        asm volatile("" ::: "memory");
                    }
            }
        } else {
#pragma unroll
            for (int ai = 0; ai < 2; ++ai)
#pragma unroll
                for (int m = 0; m < 4; ++m) {
                    const int t = 256 * u.pm + 128 * ai + 64 * wr + 16 * m + fr;
                    if (t < T) {
                        if (wc == 0) {
                            float* dst = (float*)(ws + OFF_IKR) + (size_t)t * 64 + 8 * fq;
                            *(f32x4*)dst = acc[ai][0][m][0]; *(f32x4*)(dst + 4) = acc[ai][0][m][1];
                            *(f32x4*)(dst + 32) = acc[ai][1][m][0]; *(f32x4*)(dst + 36) = acc[ai][1][m][1];
                        } else if (wc == 1) {
                            const f32x4 v0 = acc[ai][0][m][0], v1 = acc[ai][0][m][1];
                            if (fq < 2) {
                                float* dst = (float*)(ws + OFF_GLR) + (size_t)t * 16 + 8 * fq;
                                *(f32x4*)dst = v0; *(f32x4*)(dst + 4) = v1;
                            } else if (fq == 2) {
                                float* dst = (float*)(ws + OFF_IW) + (size_t)t * 8;
                                *(f32x4*)dst = v0 * 0.353553390593273762f; *(f32x4*)(dst + 4) = v1 * 0.353553390593273762f;
                            }
                        }
                    }
                    asm volatile("" ::: "memory");
                }
        }
    }
};

struct EpiOut {
    static constexpr bool PERM = false;
    const float* H32; float* Z;
    __device__ __forceinline__ void operator()(const f32x4 (&acc)[2][2][4][2], const pg8::Unit& u, int wr, int wc, int fr, int fq) const {
        { int ln_ = (int)__builtin_amdgcn_mbcnt_hi(~0u, __builtin_amdgcn_mbcnt_lo(~0u, 0u)); asm volatile("" : "+v"(ln_)); fr = ln_ & 15; fq = ln_ >> 4; }
        const int col0 = u.pn * 256 + wc * 32 + 4 * fq;
#pragma unroll
        for (int ai = 0; ai < 2; ++ai) {
            f32x4 hv[4][2][2];
#pragma unroll
            for (int m = 0; m < 4; ++m) {
                int t = 256 * u.pm + 128 * ai + 64 * wr + 16 * m + fr; t = t < T ? t : T - 1;
                const size_t off = (size_t)t * D + col0;
#pragma unroll
                for (int bj = 0; bj < 2; ++bj)
#pragma unroll
                    for (int n = 0; n < 2; ++n) hv[m][bj][n] = *(const f32x4*)(H32 + off + bj * 128 + n * 16);
            }
#pragma unroll
            for (int m = 0; m < 4; ++m) {
                const int t = 256 * u.pm + 128 * ai + 64 * wr + 16 * m + fr;
                if (t < T) {
                    const size_t off = (size_t)t * D + col0;
#pragma unroll
                    for (int bj = 0; bj < 2; ++bj)
#pragma unroll
                        for (int n = 0; n < 2; ++n) *(f32x4*)(Z + off + bj * 128 + n * 16) = acc[ai][bj][m][n] + hv[m][bj][n] * ALPHA;
                }
            }
            asm volatile("" ::: "memory");
        }
    }
};

__device__ __forceinline__ void phase_proj(const Params& p_in, int layer_in, char* smem) {
    const Params p = kparams(); const int layer = opaque_int(layer_in); (void)p_in;
    pg8::Gemm g; g.A = (const bf16_t*)(p.ws + OFF_HB); g.Bt = (const bf16_t*)(p.ws + OFF_WIN) + (size_t)layer * INWP * D; g.M = TP; g.N = INWP; g.K = D;
    pg8::StaticOrder S; S.init(TP, INWP, gridDim.x, opaque_bid());
    EpiProj E; E.ws = p.ws;
    pg8::gemm_phase((LAS unsigned char*)smem, g, S, E);
}
__device__ __forceinline__ void phase_outproj(const Params& p_in, int layer_in, char* smem) {
    const Params p = kparams(); const int layer = opaque_int(layer_in); (void)p_in;
    const bf16_t* MIXp = (const bf16_t*)(p.ws + OFF_MIX);
    const bf16_t* WOUT = (const bf16_t*)(p.ws + OFF_WOUT) + (size_t)layer * D * D;
    const float* H32 = (const float*)(p.ws + OFF_H32);
    float* Z = (float*)(p.ws + OFF_GQ);
    {
        pg8::Gemm g; g.A = MIXp; g.Bt = WOUT; g.M = 16384; g.N = D; g.K = D;
        pg8::StaticOrder S; S.init(16384, D, gridDim.x, opaque_bid());
        EpiOut E; E.H32 = H32; E.Z = Z;
        pg8::gemm_phase((LAS unsigned char*)smem, g, S, E);
    }
    const int tid = opaque_tid(), wid = __builtin_amdgcn_readfirstlane(tid >> 6), lane = tid & 63, fr = lane & 15, fq = lane >> 4;
    for (int task = opaque_bid(); task < 64; task += gridDim.x) {
        const int rg = task >> 3, cs = task & 7;
        const bf16_t* ap = MIXp + (size_t)(16384 + 16 * rg + fr) * D + 8 * fq;
        const bf16_t* bp = WOUT + (size_t)(128 * cs + 16 * wid + fr) * D + 8 * fq;
        f32x4 acc = {0.f, 0.f, 0.f, 0.f};
        bf16x8 a0[8], b0[8], a1[8], b1[8];
#pragma unroll
        for (int k = 0; k < 8; ++k) { a0[k] = *(const bf16x8*)(ap + 32 * k); b0[k] = *(const bf16x8*)(bp + 32 * k); }
#pragma unroll
        for (int ch = 0; ch < 4; ++ch) {
            if (ch < 3) {
#pragma unroll
                for (int k = 0; k < 8; ++k) { a1[k] = *(const bf16x8*)(ap + 256 * (ch + 1) + 32 * k); b1[k] = *(const bf16x8*)(bp + 256 * (ch + 1) + 32 * k); }
            }
#pragma unroll
            for (int k = 0; k < 8; ++k) acc = __builtin_amdgcn_mfma_f32_16x16x32_bf16(a0[k], b0[k], acc, 0, 0, 0);
#pragma unroll
            for (int k = 0; k < 8; ++k) { a0[k] = a1[k]; b0[k] = b1[k]; }
        }
#pragma unroll
        for (int r = 0; r < 4; ++r) {
            const size_t off = (size_t)(16384 + 16 * rg + 4 * fq + r) * D + 128 * cs + 16 * wid + fr;
            Z[off] = acc[r] + ALPHA * H32[off];
        }
    }
}

__device__ __forceinline__ void phase_gla_naive(const Params& p, int layer, char* smem) {
    float (*qs)[64] = (float (*)[64])smem;
    float (*ks)[64] = qs + 8;
    float (*es)[64] = ks + 8;
    float (*part)[8] = (float (*)[8])(es + 8);
    float (*os)[128] = (float (*)[128])(part + 2);
    const int tid = opaque_tid();
    const bf16_t* GQ = (const bf16_t*)(p.ws + OFF_GQ);
    const bf16_t* GK = (const bf16_t*)(p.ws + OFF_GK);
    const bf16_t* GV = (const bf16_t*)(p.ws + OFF_GV);
    const float* GLR = (const float*)(p.ws + OFF_GLR);
    bf16_t* MIX = (bf16_t*)(p.ws + OFF_MIX);
    const float* ng = p.norm_g + layer * 128;
    const float* wg2 = p.wg2 + (size_t)layer * 16 * 256; const float* bg = p.bg + layer * 256;
    for (int item = opaque_bid(); item < NB * 4; item += gridDim.x) {
        const int b = item >> 2, h = item & 3;
        float S[64];
#pragma unroll
        for (int d = 0; d < 64; ++d) S[d] = 0.f;
        const int e = tid & 127;
        const float nge = ng[e];
        const int ltt = tid >> 6, ld = tid & 63;
        float w[16];
#pragma unroll
        for (int rr = 0; rr < 16; ++rr) w[rr] = wg2[rr * 256 + h * 64 + ld];
        const float bgd = bg[h * 64 + ld];
        for (int t0 = 0; t0 < L; t0 += 8) {
            __syncthreads();
            {
                const size_t row = (size_t)b * L + t0 + ltt;
                qs[ltt][ld] = bf2f(GQ[row * 256 + h * 64 + ld]);
                ks[ltt][ld] = bf2f(GK[row * 256 + h * 64 + ld]);
                const float4* gp = (const float4*)&GLR[row * 16];
                const float4 g0 = gp[0], g1 = gp[1], g2 = gp[2], g3 = gp[3];
                float s = bgd;
                s = fmaf(g0.x, w[0], s); s = fmaf(g0.y, w[1], s); s = fmaf(g0.z, w[2], s); s = fmaf(g0.w, w[3], s);
                s = fmaf(g1.x, w[4], s); s = fmaf(g1.y, w[5], s); s = fmaf(g1.z, w[6], s); s = fmaf(g1.w, w[7], s);
                s = fmaf(g2.x, w[8], s); s = fmaf(g2.y, w[9], s); s = fmaf(g2.z, w[10], s); s = fmaf(g2.w, w[11], s);
                s = fmaf(g3.x, w[12], s); s = fmaf(g3.y, w[13], s); s = fmaf(g3.z, w[14], s); s = fmaf(g3.w, w[15], s);
                es[ltt][ld] = expf(logsigmoid_f(s) * (1.f / 16.f));
            }
            __syncthreads();
            if (tid < 128) {
#pragma unroll 1
                for (int tt = 0; tt < 8; ++tt) {
                    const size_t row = (size_t)b * L + t0 + tt;
                    const float v = bf2f(GV[row * 512 + h * 128 + e]);
                    float acc = 0.f;
#pragma unroll
                    for (int d = 0; d < 64; ++d) {
                        S[d] = fmaf(es[tt][d], S[d], ks[tt][d] * v);
                        acc = fmaf(qs[tt][d], S[d], acc);
                    }
                    os[tt][e] = acc;
                    const float ss = wave_sum(acc * acc);
                    if ((tid & 63) == 0) part[tid >> 6][tt] = ss;
                }
            }
            __syncthreads();
            if (tid < 128) {
#pragma unroll 1
                for (int tt = 0; tt < 8; ++tt) {
                    const size_t row = (size_t)b * L + t0 + tt;
                    const float tot = part[0][tt] + part[1][tt];
                    const float rinv = rsqrtf(tot * (1.f / 128) + LN_EPS);
                    const size_t idx = row * 1024 + h * 128 + e;
                    MIX[idx] = f2bf(os[tt][e] * rinv * nge * bf2f(MIX[idx]));
                }
            }
        }
    }
}

__device__ __forceinline__ unsigned okey(float x) {
    const unsigned u = __float_as_uint(x);
    return (u & 0x80000000u) ? ~u : (u | 0x80000000u);
}
__device__ __forceinline__ int wave_incl_scan(int v) {
    const int lane = opaque_tid() & 63;
#pragma unroll
    for (int o = 1; o < 64; o <<= 1) { const int n = __shfl_up(v, o); if (lane >= o) v += n; }
    return v;
}
__device__ __forceinline__ int block_excl_scan(int v, int* tmp) {
    const int incl = wave_incl_scan(v);
    const int tq = opaque_tid();
    __syncthreads();
    if ((tq & 63) == 63) tmp[tq >> 6] = incl;
    __syncthreads();
    const int w = tq >> 6;
    int base = 0;
    for (int i = 0; i < w; ++i) base += tmp[i];
    return base + incl - v;
}
__device__ __forceinline__ void unpack8(const uint4 u, float* kf) {
    kf[0] = __uint_as_float(u.x << 16); kf[1] = __uint_as_float(u.x & 0xFFFF0000u);
    kf[2] = __uint_as_float(u.y << 16); kf[3] = __uint_as_float(u.y & 0xFFFF0000u);
    kf[4] = __uint_as_float(u.z << 16); kf[5] = __uint_as_float(u.z & 0xFFFF0000u);
    kf[6] = __uint_as_float(u.w << 16); kf[7] = __uint_as_float(u.w & 0xFFFF0000u);
}

__device__ __forceinline__ void phase_dsa_naive(const Params& p, int layer, char* smem) {
    float* sc = (float*)smem;
    float (*iqs)[64] = (float (*)[64])(sc + 2080);
    float (*aqs)[64] = iqs + 8;
    float (*lg)[256] = (float (*)[256])(aqs + 8);
    unsigned* hist = (unsigned*)(lg + 8);
    int* sel = (int*)(hist + 256);
    int* misc = sel + 256;
    const int tid = opaque_tid();
    const bf16_t* IQ = (const bf16_t*)(p.ws + OFF_IQ);
    const bf16_t* IK = (const bf16_t*)(p.ws + OFF_IK);
    const float* IW = (const float*)(p.ws + OFF_IW);
    const bf16_t* AQ = (const bf16_t*)(p.ws + OFF_AQ);
    const bf16_t* AK = (const bf16_t*)(p.ws + OFF_AK);
    const bf16_t* AV = (const bf16_t*)(p.ws + OFF_AV);
    bf16_t* MIX = (bf16_t*)(p.ws + OFF_MIX);
    for (int item = opaque_bid(); item < T; item += gridDim.x) {
        const int b = item / L, t = item % L;
        const size_t row = (size_t)item;
        __syncthreads();
        iqs[tid >> 6][tid & 63] = bf2f(IQ[row * 512 + tid]); aqs[tid >> 6][tid & 63] = bf2f(AQ[row * 512 + tid]);
        __syncthreads();
        float w[8];
#pragma unroll
        for (int j = 0; j < 8; ++j) w[j] = IW[row * 8 + j];
        for (int s = tid; s <= t; s += NT) {
            const uint4* kp = (const uint4*)&IK[((size_t)b * L + s) * 64];
            float dd[8];
#pragma unroll
            for (int j = 0; j < 8; ++j) dd[j] = 0.f;
#pragma unroll 1
            for (int q = 0; q < 8; ++q) {
                float kf[8]; unpack8(kp[q], kf);
#pragma unroll
                for (int j = 0; j < 8; ++j) {
                    const float4 a0 = *(const float4*)&iqs[j][q * 8], a1 = *(const float4*)&iqs[j][q * 8 + 4];
                    dd[j] = fmaf(a0.x, kf[0], dd[j]); dd[j] = fmaf(a0.y, kf[1], dd[j]); dd[j] = fmaf(a0.z, kf[2], dd[j]); dd[j] = fmaf(a0.w, kf[3], dd[j]);
                    dd[j] = fmaf(a1.x, kf[4], dd[j]); dd[j] = fmaf(a1.y, kf[5], dd[j]); dd[j] = fmaf(a1.z, kf[6], dd[j]); dd[j] = fmaf(a1.w, kf[7], dd[j]);
                }
            }
            float score = 0.f;
#pragma unroll
            for (int j = 0; j < 8; ++j) score = fmaf(w[j], fmaxf(dd[j], 0.f), score);
            sc[s] = score;
        }
        __syncthreads();
        const int n = t + 1;
        int nsel;
        if (n <= TOPK) {
            if (tid < n) sel[tid] = tid;
            nsel = n;
        } else {
            unsigned prefix = 0; int remaining = TOPK;
            for (int pass = 0; pass < 4; ++pass) {
                const int shift = 24 - 8 * pass;
                if (tid < 256) hist[tid] = 0;
                __syncthreads();
                for (int s = tid; s < n; s += NT) {
                    const unsigned key = okey(sc[s]);
                    const bool match = (pass == 0) || ((key >> (shift + 8)) == prefix);
                    if (match) atomicAdd(&hist[(key >> shift) & 255u], 1u);
                }
                __syncthreads();
                if (tid == 0) {
                    int cum = 0, d = 255;
                    for (; d > 0; --d) { const int c = (int)hist[d]; if (cum + c >= remaining) break; cum += c; }
                    misc[0] = d; misc[1] = remaining - cum;
                }
                __syncthreads();
                prefix = (prefix << 8) | (unsigned)misc[0]; remaining = misc[1];
                __syncthreads();
            }
            const int s0 = tid * 5;
            int ceq = 0;
#pragma unroll
            for (int q = 0; q < 5; ++q) { const int s = s0 + q; if (s < n && okey(sc[s]) == prefix) ++ceq; }
            int eqrank = block_excl_scan(ceq, misc + 8);
            int csel = 0; unsigned selmask = 0;
#pragma unroll
            for (int q = 0; q < 5; ++q) {
                const int s = s0 + q;
                if (s < n) {
                    const unsigned key = okey(sc[s]);
                    bool take = key > prefix;
                    if (key == prefix) { take = eqrank < remaining; ++eqrank; }
                    if (take) { ++csel; selmask |= 1u << q; }
                }
            }
            int posn = block_excl_scan(csel, misc + 16);
#pragma unroll
            for (int q = 0; q < 5; ++q) if (selmask & (1u << q)) { if (posn < TOPK) sel[posn] = s0 + q; ++posn; }
            nsel = TOPK;
        }
        __syncthreads();
        {
            const int i = tid & 255, g = tid >> 8;
            if (i < nsel) {
                const int kidx = sel[i];
                const uint4* kp = (const uint4*)&AK[((size_t)b * L + kidx) * 128 + g * 64];
                float dd[4] = {0.f, 0.f, 0.f, 0.f};
#pragma unroll 1
                for (int q = 0; q < 8; ++q) {
                    float kf[8]; unpack8(kp[q], kf);
#pragma unroll
                    for (int r = 0; r < 4; ++r) {
                        const float4 a0 = *(const float4*)&aqs[g * 4 + r][q * 8], a1 = *(const float4*)&aqs[g * 4 + r][q * 8 + 4];
                        dd[r] = fmaf(a0.x, kf[0], dd[r]); dd[r] = fmaf(a0.y, kf[1], dd[r]); dd[r] = fmaf(a0.z, kf[2], dd[r]); dd[r] = fmaf(a0.w, kf[3], dd[r]);
                        dd[r] = fmaf(a1.x, kf[4], dd[r]); dd[r] = fmaf(a1.y, kf[5], dd[r]); dd[r] = fmaf(a1.z, kf[6], dd[r]); dd[r] = fmaf(a1.w, kf[7], dd[r]);
                    }
                }
#pragma unroll
                for (int r = 0; r < 4; ++r) lg[g * 4 + r][i] = dd[r];
            } else {
#pragma unroll
                for (int r = 0; r < 4; ++r) lg[g * 4 + r][i] = -INFINITY;
            }
        }
        __syncthreads();
        {
            const int h = tid >> 6, lane = tid & 63;
            float v0 = lg[h][lane], v1 = lg[h][lane + 64], v2 = lg[h][lane + 128], v3 = lg[h][lane + 192];
            const float m = wave_max(fmaxf(fmaxf(v0, v1), fmaxf(v2, v3)));
            v0 = expf(v0 - m); v1 = expf(v1 - m); v2 = expf(v2 - m); v3 = expf(v3 - m);
            const float inv = 1.f / wave_sum(v0 + v1 + v2 + v3);
            lg[h][lane] = v0 * inv; lg[h][lane + 64] = v1 * inv; lg[h][lane + 128] = v2 * inv; lg[h][lane + 192] = v3 * inv;
        }
        __syncthreads();
        {
            const int h = tid >> 6, d = tid & 63, g = h >> 2;
            float o = 0.f;
            for (int i = 0; i < nsel; ++i) o = fmaf(lg[h][i], bf2f(AV[((size_t)b * L + sel[i]) * 128 + g * 64 + d]), o);
            const size_t mi = row * 1024 + 512 + tid;
            MIX[mi] = f2bf(o * bf2f(MIX[mi]));
        }
    }
}


constexpr int DS_SC = 0, DS_BITS = 134144, DS_HIST = DS_BITS + 4224, DS_CAND = DS_HIST + 8 * 1040, DS_END = DS_CAND + 8 * 512;
constexpr int DS_TAB = 65536, DS_CONST = DS_TAB + 2112 * 32;
static_assert(DS_CONST + 32 <= DS_BITS, "bias table overlaps bitmask");


template <int NR>
__device__ __forceinline__ void dsa_select(const LAS unsigned* row, LAS unsigned* bits, LAS unsigned* hist, int n, int lane) {
    unsigned kreg[NR];
#pragma unroll
    for (int i = 0; i < NR; ++i) kreg[i] = (lane < n - 64 * i) ? okey(__uint_as_float(row[lane + 64 * i])) : 0u;
    unsigned prefix = 0; int remaining = TOPK;
#pragma unroll 1
    for (int pass = 0; pass < 4; ++pass) {
        const int shift = 24 - 8 * pass;
        *(LAS u32x4*)(hist + lane * 4) = (u32x4){0u, 0u, 0u, 0u};
        __builtin_amdgcn_wave_barrier(); asm volatile("" ::: "memory");
        const unsigned sh8 = (unsigned)(shift + 8) & 31u;
#pragma unroll
        for (int i = 0; i < NR; ++i) {
            const unsigned key = kreg[i];
            const bool match = (lane < n - 64 * i) && ((pass == 0) || ((key >> sh8) == prefix));
            if (match) __hip_atomic_fetch_add(hist + ((key >> shift) & 255u), 1u, __ATOMIC_RELAXED, __HIP_MEMORY_SCOPE_WAVEFRONT);
        }
        __builtin_amdgcn_wave_barrier(); asm volatile("s_waitcnt lgkmcnt(0)" ::: "memory");
        const u32x4 hv = *(const LAS u32x4*)(hist + (63 - lane) * 4);
        const int c0 = (int)hv[3], c1 = (int)hv[2], c2 = (int)hv[1], c3 = (int)hv[0];
        const int tot = c0 + c1 + c2 + c3;
        const int incl = wave_incl_scan(tot), excl = incl - tot;
        const bool found = (excl < remaining) && (remaining <= incl);
        int digit = 0, rem_new = 0;
        if (found) {
            int cum = excl;
            if (cum + c0 >= remaining) { digit = 255 - 4 * lane; rem_new = remaining - cum; }
            else { cum += c0;
                if (cum + c1 >= remaining) { digit = 254 - 4 * lane; rem_new = remaining - cum; }
                else { cum += c1;
                    if (cum + c2 >= remaining) { digit = 253 - 4 * lane; rem_new = remaining - cum; }
                    else { cum += c2; digit = 252 - 4 * lane; rem_new = remaining - cum; } } }
        }
        const unsigned long long fm = __ballot(found);
        const int src = (int)__builtin_ctzll(fm);
        digit = __builtin_amdgcn_readlane(digit, src); rem_new = __builtin_amdgcn_readlane(rem_new, src);
        prefix = (prefix << 8) | (unsigned)digit; remaining = rem_new;
    }
    const unsigned tkey = prefix;
    int eqcount = 0;
#pragma unroll
    for (int i = 0; i < 33; ++i) {
        if (i < NR) {
            const unsigned key = kreg[i < NR ? i : 0];
            const bool valid = lane < n - 64 * i;
            const bool gt = valid && (key > tkey), eq = valid && (key == tkey);
            const unsigned long long em = __ballot(eq);
            const int rank = eqcount + __popcll(em & ((1ull << lane) - 1ull));
            const bool sel = gt || (eq && rank < remaining);
            eqcount += __popcll(em);
            const unsigned long long sm = __ballot(sel);
            if (lane == 0) { bits[2 * i] = (unsigned)sm; bits[2 * i + 1] = (unsigned)(sm >> 32); }
        } else if (lane == 0) { bits[2 * i] = 0u; bits[2 * i + 1] = 0u; }
    }
}


template <int NR>
__device__ __forceinline__ bool dsa_select_v(const LAS unsigned* row, LAS unsigned* bits, LAS unsigned* hist, LAS unsigned* cand, int n, int lane) {
    float x[NR];
    const float qnan = __uint_as_float(0x7FC00000u);
#pragma unroll
    for (int i = 0; i < NR; ++i) x[i] = (lane < n - 64 * i) ? __uint_as_float(row[lane + 64 * i]) : qnan;
    float mn = x[0], mx = x[0];
#pragma unroll
    for (int i = 1; i < NR; ++i) { mn = fminf(mn, x[i]); mx = fmaxf(mx, x[i]); }
#pragma unroll
    for (int o = 32; o > 0; o >>= 1) { mn = fminf(mn, __shfl_xor(mn, o)); mx = fmaxf(mx, __shfl_xor(mx, o)); }
    bool ok = mx > mn;
    const float scale = 255.f / (mx - mn) * 0.99999f;
    int dstar = 0, rem = 0, cb = 0;
    if (ok) {
        *(LAS u32x4*)(hist + lane * 4) = (u32x4){0u, 0u, 0u, 0u};
        __builtin_amdgcn_wave_barrier(); asm volatile("" ::: "memory");
#pragma unroll
        for (int i = 0; i < NR; ++i) {
            const float xv = x[i];
            if (xv == xv) __hip_atomic_fetch_add(hist + (unsigned)(int)((xv - mn) * scale), 1u, __ATOMIC_RELAXED, __HIP_MEMORY_SCOPE_WAVEFRONT);
        }
        __builtin_amdgcn_wave_barrier(); asm volatile("s_waitcnt lgkmcnt(0)" ::: "memory");
        const u32x4 hv = *(const LAS u32x4*)(hist + (63 - lane) * 4);
        const int c0 = (int)hv[3], c1 = (int)hv[2], c2 = (int)hv[1], c3 = (int)hv[0];
        const int tot = c0 + c1 + c2 + c3;
        const int incl = wave_incl_scan(tot), excl = incl - tot;
        const bool found = (excl < TOPK) && (TOPK <= incl);
        int digit = 0, rem_new = 0, cnt = 0;
        if (found) {
            int cum = excl;
            if (cum + c0 >= TOPK) { digit = 255 - 4 * lane; rem_new = TOPK - cum; cnt = c0; }
            else { cum += c0;
                if (cum + c1 >= TOPK) { digit = 254 - 4 * lane; rem_new = TOPK - cum; cnt = c1; }
                else { cum += c1;
                    if (cum + c2 >= TOPK) { digit = 253 - 4 * lane; rem_new = TOPK - cum; cnt = c2; }
                    else { cum += c2; digit = 252 - 4 * lane; rem_new = TOPK - cum; cnt = c3; } } }
        }
        const unsigned long long fm = __ballot(found);
        const int src = (int)__builtin_ctzll(fm | (1ull << 63));
        dstar = __builtin_amdgcn_readlane(digit, src); rem = __builtin_amdgcn_readlane(rem_new, src); cb = __builtin_amdgcn_readlane(cnt, src);
        ok = (fm != 0ull) && (cb <= 64);
    }
    if (!ok) return false;
    int base = 0;
#pragma unroll
    for (int i = 0; i < NR; ++i) {
        const float xv = x[i];
        const bool inb = (xv == xv) && ((int)((xv - mn) * scale) == dstar);
        const unsigned long long bm = __ballot(inb);
        if (bm != 0ull) {
            if (inb) { const int pos = base + __popcll(bm & ((1ull << lane) - 1ull)); cand[2 * pos] = __float_as_uint(xv); cand[2 * pos + 1] = (unsigned)(lane + 64 * i); }
            base += __popcll(bm);
        }
    }
    __builtin_amdgcn_wave_barrier(); asm volatile("s_waitcnt lgkmcnt(0)" ::: "memory");
    float xc = qnan; int ic = 0x7fffffff;
    if (lane < cb) { xc = __uint_as_float(cand[2 * lane]); ic = (int)cand[2 * lane + 1]; }
    int rank = 0;
    for (int j = 0; j < cb; ++j) {
        const float xj = __builtin_bit_cast(float, __builtin_amdgcn_readlane(__builtin_bit_cast(int, xc), j));
        const int ij = __builtin_amdgcn_readlane(ic, j);
        rank += ((xj > xc) || (xj == xc && ij < ic)) ? 1 : 0;
    }
    const unsigned long long tm = __ballot((lane < cb) && (rank == rem - 1));
    const int tl = (int)__builtin_ctzll(tm | (1ull << 63));
    const float tx = __builtin_bit_cast(float, __builtin_amdgcn_readlane(__builtin_bit_cast(int, xc), tl));
    const int ti = __builtin_amdgcn_readlane(ic, tl);
#pragma unroll
    for (int i = 0; i < 33; ++i) {
        if (i < NR) {
            const float xv = x[i < NR ? i : 0];
            const bool sel = (xv > tx) || (xv == tx && (lane + 64 * i) <= ti);
            const unsigned long long sm = __ballot(sel);
            if (lane == 0) { bits[2 * i] = (unsigned)sm; bits[2 * i + 1] = (unsigned)(sm >> 32); }
        } else if (lane == 0) { bits[2 * i] = 0u; bits[2 * i + 1] = 0u; }
    }
    return true;
}

__device__ __forceinline__ void phase_dsa(const Params& p_in, int layer_in, char* smem, bool do_store) {
    const Params p = kparams(); const int layer = opaque_int(layer_in); (void)p_in;
    const int tid = opaque_tid(), wid = __builtin_amdgcn_readfirstlane(tid >> 6), lane_ = tid & 63, fr_ = lane_ & 15, fq_ = lane_ >> 4;
    LAS unsigned char* lds = (LAS unsigned char*)smem;
    const bf16_t* IQ = (const bf16_t*)(p.ws + OFF_IQ);
    const bf16_t* IK = (const bf16_t*)(p.ws + OFF_IK);
    const float* IW = (const float*)(p.ws + OFF_IW);
    const bf16_t* AQ = (const bf16_t*)(p.ws + OFF_AQ);
    const bf16_t* AK = (const bf16_t*)(p.ws + OFF_AK);
    const bf16_t* AVT = (const bf16_t*)(p.ws + OFF_AV);
    bf16_t* MIX = (bf16_t*)(p.ws + OFF_MIX);
    constexpr int NITEM = NB * 129;
    for (int idx = opaque_bid(); idx < NITEM; idx += gridDim.x) {
        const int b = idx & 7, mm = idx >> 3;
        int qr;
        { const int seg = mm >> 5, jj = mm & 31; qr = (seg == 0) ? jj : (seg == 1) ? 63 - jj : (seg == 2) ? 64 + jj : (seg == 3) ? 127 - jj : 128; }
        const int qt = 128 - qr, t0 = qt * 16;
        __syncthreads();
        for (int repA = 0; repA < PROBE_DSA_A; ++repA) {
            int fr = fr_, fq = fq_; asm volatile("" : "+v"(fr), "+v"(fq));
            const size_t rowq = (size_t)b * L + t0 + fr;
            bf16x8 qf[8][2];
#pragma unroll
            for (int jh = 0; jh < 8; ++jh)
#pragma unroll
                for (int s2 = 0; s2 < 2; ++s2) qf[jh][s2] = *(const bf16x8*)(IQ + rowq * 512 + jh * 64 + s2 * 32 + fq * 8);
            float w[8];
            { const f32x4 w0 = *(const f32x4*)(IW + rowq * 8), w1 = *(const f32x4*)(IW + rowq * 8 + 4);
              w[0] = w0[0]; w[1] = w0[1]; w[2] = w0[2]; w[3] = w0[3]; w[4] = w1[0]; w[5] = w1[1]; w[6] = w1[2]; w[7] = w1[3]; }
            const int ntile = qt + 1;
            const bf16x8 z8 = {0, 0, 0, 0, 0, 0, 0, 0};
            bf16x8 ka0 = z8, ka1 = z8, kb0 = z8, kb1 = z8, kc0 = z8, kc1 = z8;
            int kt = wid;
            if (kt < ntile) { const bf16_t* kp = IK + ((size_t)b * L + 16 * kt + fr) * 64 + fq * 8; ka0 = *(const bf16x8*)kp; ka1 = *(const bf16x8*)(kp + 32); }
            if (kt + 8 < ntile) { const bf16_t* kp = IK + ((size_t)b * L + 16 * (kt + 8) + fr) * 64 + fq * 8; kb0 = *(const bf16x8*)kp; kb1 = *(const bf16x8*)(kp + 32); }
            for (; kt < ntile; kt += 8) {
                if (kt + 16 < ntile) { const bf16_t* kp = IK + ((size_t)b * L + 16 * (kt + 16) + fr) * 64 + fq * 8; kc0 = *(const bf16x8*)kp; kc1 = *(const bf16x8*)(kp + 32); }
                f32x4 sc = {0.f, 0.f, 0.f, 0.f};
#pragma unroll
                for (int jh = 0; jh < 8; ++jh) {
                    f32x4 d = {0.f, 0.f, 0.f, 0.f};
                    d = __builtin_amdgcn_mfma_f32_16x16x32_bf16(ka0, qf[jh][0], d, 0, 0, 0);
                    d = __builtin_amdgcn_mfma_f32_16x16x32_bf16(ka1, qf[jh][1], d, 0, 0, 0);
#pragma unroll
                    for (int r = 0; r < 4; ++r) sc[r] = fmaf(w[jh], fmaxf(d[r], 0.f), sc[r]);
                }
                *(LAS f32x4*)(lds + DS_SC + (fr * 2064 + 16 * kt + 4 * fq) * 4) = sc;
                ka0 = kb0; ka1 = kb1; kb0 = kc0; kb1 = kc1;
            }
        }
        __syncthreads();
        for (int repB = 0; repB < PROBE_DSA_B; ++repB) {
            int lane = lane_; asm volatile("" : "+v"(lane));
            LAS unsigned* hist = (LAS unsigned*)(lds + DS_HIST + wid * 1040);
#pragma unroll 1
            for (int qq = 0; qq < 2; ++qq) {
                const int q = wid * 2 + qq;
                const int n = t0 + q + 1;
                const LAS unsigned* row = (const LAS unsigned*)(lds + DS_SC) + q * 2064;
                LAS unsigned* bits = (LAS unsigned*)(lds + DS_BITS) + q * 66;
                if (n <= TOPK) {
#pragma unroll 1
                    for (int i = 0; i < 33; ++i) {
                        const unsigned long long sm = __ballot(lane + 64 * i < n);
                        if (lane == 0) { bits[2 * i] = (unsigned)sm; bits[2 * i + 1] = (unsigned)(sm >> 32); }
                    }
                } else {
                    const int nr = (n + 63) >> 6;
                    LAS unsigned* cand = (LAS unsigned*)(lds + DS_CAND + wid * 512);
                    bool done;
                    if (nr <= 9) done = dsa_select_v<9>(row, bits, hist, cand, n, lane);
                    else if (nr <= 17) done = dsa_select_v<17>(row, bits, hist, cand, n, lane);
                    else if (nr <= 25) done = dsa_select_v<25>(row, bits, hist, cand, n, lane);
                    else done = dsa_select_v<33>(row, bits, hist, cand, n, lane);
                    if (!done) dsa_select<33>(row, bits, hist, n, lane);
                }
            }
        }
        __syncthreads();
        for (int repC = 0; repC < PROBE_DSA_C; ++repC) {
            if (repC > 0) __syncthreads();
            int fr = fr_, fq = fq_, lane = lane_; asm volatile("" : "+v"(fr), "+v"(fq), "+v"(lane));
            const size_t rowq = (size_t)b * L + t0 + fr;
            const int h = wid, g = h >> 2;
            const int nstep = (t0 + 16 + 63) >> 6;
            bf16x8 aqf[2];
            aqf[0] = *(const bf16x8*)(AQ + rowq * 512 + h * 64 + fq * 8);
            aqf[1] = *(const bf16x8*)(AQ + rowq * 512 + h * 64 + 32 + fq * 8);
            asm volatile("" : "+v"(aqf[0]), "+v"(aqf[1]));
            const int drow = 8 * wid + (lane >> 3);
            const int kch = (lane & 7) ^ (2 * ((drow >> 3) & 3) + ((drow >> 1) & 1)), vch = (lane & 7) ^ ((drow >> 1) & 7);
            const bf16_t* vsrc0 = AVT + ((size_t)b * 128 + drow) * LP + vch * 8;
#define DSA_DMA(st_, buf_) do { \
                int krow_ = b * L + 64 * (st_) + drow; krow_ = krow_ < T ? krow_ : T - 1; \
                const bf16_t* ks_ = AK + (size_t)krow_ * 128 + kch * 8; \
                LAS unsigned char* lb_ = lds + (buf_) * 32768 + wid * 1024; \
                __builtin_amdgcn_global_load_lds((const unsigned*)ks_, (LAS unsigned*)lb_, 16, 0, 0); \
                __builtin_amdgcn_global_load_lds((const unsigned*)(ks_ + 64), (LAS unsigned*)(lb_ + 8192), 16, 0, 0); \
                __builtin_amdgcn_global_load_lds((const unsigned*)(vsrc0 + 64 * (st_)), (LAS unsigned*)(lb_ + 16384), 16, 0, 0); \
                __builtin_amdgcn_global_load_lds((const unsigned*)(vsrc0 + (size_t)64 * LP + 64 * (st_)), (LAS unsigned*)(lb_ + 24576), 16, 0, 0); } while (0)
            DSA_DMA(0, 0);
            unsigned nb_lo = 0xC6EAu, nb_hi = 0xC6EA0000u; asm volatile("" : "+v"(nb_lo), "+v"(nb_hi));
            for (int key = tid; key < 2112; key += NT) {
                const int w32 = key & 31;
                const int R = (key >> 5) * 32 + ((w32 >> 2) & 1) * 16 + 4 * (w32 >> 3) + (w32 & 3);
                u32x4 lo, hi;
#pragma unroll
                for (int qp = 0; qp < 8; ++qp) {
                    const unsigned b0 = (*((const LAS unsigned*)(lds + DS_BITS) + (2 * qp) * 66 + (key >> 5)) >> w32) & 1u;
                    const unsigned b1 = (*((const LAS unsigned*)(lds + DS_BITS) + (2 * qp + 1) * 66 + (key >> 5)) >> w32) & 1u;
                    const unsigned v = (b0 ? 0u : nb_lo) | (b1 ? 0u : nb_hi);
                    if (qp < 4) lo[qp] = v; else hi[qp - 4] = v;
                }
                *(LAS u32x4*)(lds + DS_TAB + R * 32) = lo; *(LAS u32x4*)(lds + DS_TAB + R * 32 + 16) = hi;
            }
            if (tid < 8) *((LAS unsigned*)(lds + DS_CONST) + tid) = (tid == 0) ? 0x00003F80u : 0u;
            const int swzk = 2 * (fr >> 2) + ((fr >> 1) & 1);
            const int krow0 = 8 * (fr >> 2) + (fr & 3);
            const int tab_base = (fq < 2) ? DS_TAB + fr * 32 + 16 * fq : DS_CONST + 16 * (fq - 2);
            const int tab_mul = (fq < 2) ? 512 : 0;
            u32x4 bqw = {0u, 0u, 0u, 0u};
            if (fq < 2 && (fr >> 3) == fq) { const int j = fr & 7; bqw[j >> 1] = (j & 1) ? 0x3F800000u : 0x00003F80u; }
            u32x4 onw = {0u, 0u, 0u, 0u};
            if (fr == 0) onw = (u32x4){0x3F803F80u, 0x3F803F80u, 0x3F803F80u, 0x3F803F80u};
            const bf16x8 onesA = __builtin_bit_cast(bf16x8, onw);
            asm volatile("s_waitcnt vmcnt(0) lgkmcnt(0)" ::: "memory");
            __builtin_amdgcn_s_barrier();
            asm volatile("" ::: "memory");
            f32x4 O[4], O5 = {0.f, 0.f, 0.f, 0.f};
#pragma unroll
            for (int dt = 0; dt < 4; ++dt) O[dt] = (f32x4){0.f, 0.f, 0.f, 0.f};
            float mt = 0.f;
            for (int st = 0; st < nstep; ++st) {
                const int buf = st & 1;
                {
                    const int sn = (st + 1 < nstep) ? st + 1 : nstep - 1;
                    DSA_DMA(sn, buf ^ 1);
                }
                const LAS unsigned char* sb = lds + buf * 32768;
                const bf16x8 bq = __builtin_bit_cast(bf16x8, bqw);
                f32x4 S[4];
#pragma unroll
                for (int kt = 0; kt < 4; ++kt) {
                    const int rowk = krow0 + 32 * (kt >> 1) + 4 * (kt & 1);
                    const bf16x8 bias = *(const LAS bf16x8*)(lds + tab_base + (4 * st + kt) * tab_mul);
                    S[kt] = __builtin_amdgcn_mfma_f32_16x16x32_bf16(bias, bq, (f32x4){0.f, 0.f, 0.f, 0.f}, 0, 0, 0);
#pragma unroll
                    for (int s2 = 0; s2 < 2; ++s2) {
                        const bf16x8 kf = *(const LAS bf16x8*)(sb + g * 8192 + rowk * 128 + 16 * ((4 * s2 + fq) ^ swzk));
                        S[kt] = __builtin_amdgcn_mfma_f32_16x16x32_bf16(kf, aqf[s2], S[kt], 0, 0, 0);
                    }
                }
                float pmax = fmaxf(fmaxf(S[0][0], S[0][1]), S[0][2]);
                pmax = fmaxf(fmaxf(pmax, S[0][3]), S[1][0]); pmax = fmaxf(fmaxf(pmax, S[1][1]), S[1][2]); pmax = fmaxf(fmaxf(pmax, S[1][3]), S[2][0]);
                pmax = fmaxf(fmaxf(pmax, S[2][1]), S[2][2]); pmax = fmaxf(fmaxf(pmax, S[2][3]), S[3][0]); pmax = fmaxf(fmaxf(pmax, S[3][1]), S[3][2]);
                pmax = fmaxf(pmax, S[3][3]);
                if (st == 0 || __any(pmax > 11.5f)) {
                    float pm = fmaxf(pmax, __shfl_xor(pmax, 16)); pm = fmaxf(pm, __shfl_xor(pm, 32));
                    const float up = (st == 0) ? fmaxf(pm, -64.f) : fmaxf(pm, 0.f);
                    const float mn = __uint_as_float((unsigned)f2bf(mt + up) << 16);
                    const float dlt = mt - mn;
                    const float alpha = __builtin_amdgcn_exp2f(dlt);
#pragma unroll
                    for (int dt = 0; dt < 4; ++dt) O[dt] *= alpha;
                    O5 *= alpha;
#pragma unroll
                    for (int kt = 0; kt < 4; ++kt) S[kt] += dlt;
                    mt = mn;
                    if (fq == 2) bqw[0] = (unsigned)f2bf(-mt);
                }
                unsigned pk[4][2];
#pragma unroll
                for (int kt = 0; kt < 4; ++kt) {
                    const float e0 = __builtin_amdgcn_exp2f(S[kt][0]), e1 = __builtin_amdgcn_exp2f(S[kt][1]), e2 = __builtin_amdgcn_exp2f(S[kt][2]), e3 = __builtin_amdgcn_exp2f(S[kt][3]);
                    pk[kt][0] = cvt_pk_bf16(e0, e1); pk[kt][1] = cvt_pk_bf16(e2, e3);
                }
#pragma unroll
                for (int ks = 0; ks < 2; ++ks) {
                    u32x4 pw; pw[0] = pk[2 * ks][0]; pw[1] = pk[2 * ks][1]; pw[2] = pk[2 * ks + 1][0]; pw[3] = pk[2 * ks + 1][1];
                    const bf16x8 pf = __builtin_bit_cast(bf16x8, pw);
                    O5 = __builtin_amdgcn_mfma_f32_16x16x32_bf16(onesA, pf, O5, 0, 0, 0);
#pragma unroll
                    for (int dt = 0; dt < 4; ++dt) {
                        const int rowv = 16 * dt + fr;
                        const bf16x8 vf = *(const LAS bf16x8*)(sb + 16384 + g * 8192 + rowv * 128 + 16 * ((4 * ks + fq) ^ ((rowv >> 1) & 7)));
                        O[dt] = __builtin_amdgcn_mfma_f32_16x16x32_bf16(vf, pf, O[dt], 0, 0, 0);
                    }
                }
                asm volatile("s_waitcnt vmcnt(0)" ::: "memory");
                __builtin_amdgcn_s_barrier();
                asm volatile("" ::: "memory");
            }
#undef DSA_DMA
            const float l = __shfl(O5[0], fr);
            const float inv = 1.f / fmaxf(l, 1e-30f);
            bf16_t* mp = MIX + rowq * 1024 + 512 + h * 64 + 4 * fq;
            if (do_store && repC == PROBE_DSA_C - 1)
#pragma unroll
            for (int dt = 0; dt < 4; ++dt) {
                const uint2 gz = *(const uint2*)(mp + 16 * dt);
                const float g0 = __uint_as_float(gz.x << 16), g1 = __uint_as_float(gz.x & 0xFFFF0000u), g2 = __uint_as_float(gz.y << 16), g3 = __uint_as_float(gz.y & 0xFFFF0000u);
                uint2 o; o.x = cvt_pk_bf16(O[dt][0] * inv * g0, O[dt][1] * inv * g1); o.y = cvt_pk_bf16(O[dt][2] * inv * g2, O[dt][3] * inv * g3);
                *(uint2*)(mp + 16 * dt) = o;
            }
        }
    }
}

__device__ __forceinline__ void rope16(const u32x4 a, const u32x4 b, const float2* rp, u32x4& oa, u32x4& ob) {
    const f32x4 r0 = *(const f32x4*)(rp), r1 = *(const f32x4*)(rp + 2), r2 = *(const f32x4*)(rp + 4), r3 = *(const f32x4*)(rp + 6);
    const float cs[8] = {r0[0], r0[2], r1[0], r1[2], r2[0], r2[2], r3[0], r3[2]};
    const float sn[8] = {r0[1], r0[3], r1[1], r1[3], r2[1], r2[3], r3[1], r3[3]};
    float o1[8], o2[8];
#pragma unroll
    for (int i = 0; i < 4; ++i) {
        const float x1l = __uint_as_float(a[i] << 16), x1h = __uint_as_float(a[i] & 0xFFFF0000u);
        const float x2l = __uint_as_float(b[i] << 16), x2h = __uint_as_float(b[i] & 0xFFFF0000u);
        o1[2 * i] = x1l * cs[2 * i] - x2l * sn[2 * i]; o1[2 * i + 1] = x1h * cs[2 * i + 1] - x2h * sn[2 * i + 1];
        o2[2 * i] = x2l * cs[2 * i] + x1l * sn[2 * i]; o2[2 * i + 1] = x2h * cs[2 * i + 1] + x1h * sn[2 * i + 1];
    }
#pragma unroll
    for (int i = 0; i < 4; ++i) { oa[i] = cvt_pk_bf16(o1[2 * i], o1[2 * i + 1]); ob[i] = cvt_pk_bf16(o2[2 * i], o2[2 * i + 1]); }
}
__device__ __forceinline__ void phase_rope(const Params& p_in, int layer_in, char* smem) {
    const Params p = kparams(); const int layer = opaque_int(layer_in); (void)p_in;
    const int tid = opaque_tid();
    const float2* ROPE = (const float2*)(p.ws + OFF_ROPE);
    const int nthr = gridDim.x * NT, gid = opaque_bid() * NT + tid;
    for (int th = gid; th < T * 18; th += nthr) {
        const int t = th / 18, hh = th - t * 18, pos = t % L;
        bf16_t* base = (hh < 8) ? (bf16_t*)(p.ws + OFF_AQ) + (size_t)t * 512 + hh * 64
                     : (hh < 16) ? (bf16_t*)(p.ws + OFF_IQ) + (size_t)t * 512 + (hh - 8) * 64
                                 : (bf16_t*)(p.ws + OFF_AK) + (size_t)t * 128 + (hh - 16) * 64;
        const u32x4 a = *(const u32x4*)base, b = *(const u32x4*)(base + 8);
        u32x4 oa, ob; rope16(a, b, ROPE + pos * 8, oa, ob);
        *(u32x4*)base = oa; *(u32x4*)(base + 8) = ob;
    }
    const float* IKR = (const float*)(p.ws + OFF_IKR);
    bf16_t* IK = (bf16_t*)(p.ws + OFF_IK);
    const float* ikg = p.ikg + layer * 64; const float* ikb = p.ikb + layer * 64;
    for (int t = gid; t < T; t += nthr) {
        const int pos = t % L;
        f32x4 x[16];
#pragma unroll
        for (int i = 0; i < 16; ++i) x[i] = *(const f32x4*)(IKR + (size_t)t * 64 + 4 * i);
        float sm = 0.f;
#pragma unroll
        for (int i = 0; i < 16; ++i) sm += (x[i][0] + x[i][1]) + (x[i][2] + x[i][3]);
        const float mu = sm * (1.f / 64);
        float qq = 0.f;
#pragma unroll
        for (int i = 0; i < 16; ++i) { const f32x4 d = x[i] - mu; qq += (d[0] * d[0] + d[1] * d[1]) + (d[2] * d[2] + d[3] * d[3]); }
        const float rs = rsqrtf(qq * (1.f / 64) + LN_EPS);
#pragma unroll
        for (int i = 0; i < 16; ++i) { const f32x4 g = *(const f32x4*)(ikg + 4 * i), bb = *(const f32x4*)(ikb + 4 * i); x[i] = (x[i] - mu) * rs * g + bb; }
        const float2* rp = ROPE + pos * 8;
        const f32x4 r0 = *(const f32x4*)(rp), r1 = *(const f32x4*)(rp + 2), r2 = *(const f32x4*)(rp + 4), r3 = *(const f32x4*)(rp + 6);
        const float cs[8] = {r0[0], r0[2], r1[0], r1[2], r2[0], r2[2], r3[0], r3[2]};
        const float sn[8] = {r0[1], r0[3], r1[1], r1[3], r2[1], r2[3], r3[1], r3[3]};
#pragma unroll
        for (int i = 0; i < 8; ++i) {
            const float x1 = x[i >> 2][i & 3], x2 = x[2 + (i >> 2)][i & 3];
            x[i >> 2][i & 3] = x1 * cs[i] - x2 * sn[i];
            x[2 + (i >> 2)][i & 3] = x2 * cs[i] + x1 * sn[i];
        }
#pragma unroll
        for (int i = 0; i < 8; ++i) {
            u32x4 o; o[0] = cvt_pk_bf16(x[2 * i][0], x[2 * i][1]); o[1] = cvt_pk_bf16(x[2 * i][2], x[2 * i][3]); o[2] = cvt_pk_bf16(x[2 * i + 1][0], x[2 * i + 1][1]); o[3] = cvt_pk_bf16(x[2 * i + 1][2], x[2 * i + 1][3]);
            *(u32x4*)(IK + (size_t)t * 64 + 8 * i) = o;
        }
    }
}

constexpr int GL_QE = 0, GL_KN = 8192, GL_SEG = 16384, GL_PART = 18432;
__device__ __forceinline__ void gla_cumsum(const Params& p, int layer, int b, int h, int c, int tid, LAS unsigned char* lds, float (&bc)[8], float& blast) {
    const int d = tid & 63, seg = tid >> 6;
    const float* wg2 = p.wg2 + (size_t)layer * 16 * 256 + h * 64 + d;
    float w[16];
#pragma unroll
    for (int rr = 0; rr < 16; ++rr) w[rr] = wg2[rr * 256];
    const float bgd = p.bg[layer * 256 + h * 64 + d];
    const float* GLR = (const float*)(p.ws + OFF_GLR);
    float pb = 0.f;
#pragma unroll
    for (int i = 0; i < 8; ++i) {
        const int pos = 64 * c - 48 + 8 * seg + i;
        float gl = 0.f;
        if (pos >= 0) {
            const f32x4* gp = (const f32x4*)(GLR + ((size_t)b * L + pos) * 16);
            const f32x4 g0 = gp[0], g1 = gp[1], g2 = gp[2], g3 = gp[3];
            float x = bgd;
#pragma unroll
            for (int rr = 0; rr < 4; ++rr) { x = fmaf(g0[rr], w[rr], x); }
#pragma unroll
            for (int rr = 0; rr < 4; ++rr) { x = fmaf(g1[rr], w[4 + rr], x); }
#pragma unroll
            for (int rr = 0; rr < 4; ++rr) { x = fmaf(g2[rr], w[8 + rr], x); }
#pragma unroll
            for (int rr = 0; rr < 4; ++rr) { x = fmaf(g3[rr], w[12 + rr], x); }
            gl = logsigmoid_fast(x) * (1.f / 16.f);
        }
        pb += gl; bc[i] = pb;
    }
    LAS float* segs = (LAS float*)(lds + GL_SEG);
    segs[seg * 64 + d] = pb;
    __syncthreads();
    float base = 0.f, tot = 0.f;
#pragma unroll
    for (int sg = 0; sg < 8; ++sg) { const float v = segs[sg * 64 + d]; tot += v; base += (sg < seg) ? v : 0.f; }
#pragma unroll
    for (int i = 0; i < 8; ++i) bc[i] += base;
    blast = tot;
}

constexpr size_t OUTS_QE = 0, OUTS_KN = (size_t)T * 256 * 2;
__device__ __forceinline__ void phase_gla_a(const Params& p_in, int layer_in, char* smem) {
    const Params p = kparams(); const int layer = opaque_int(layer_in); (void)p_in;
    const int tid = opaque_tid(), wid = __builtin_amdgcn_readfirstlane(tid >> 6), lane = tid & 63, fr = lane & 15, fq = lane >> 4;
    LAS unsigned char* ldw = (LAS unsigned char*)smem + wid * 8192;
    const bf16_t* GQ = (const bf16_t*)(p.ws + OFF_GQ);
    const bf16_t* GK = (const bf16_t*)(p.ws + OFF_GK);
    const bf16_t* GVT = (const bf16_t*)(p.ws + OFF_GV);
    const float* GLR = (const float*)(p.ws + OFF_GLR);
    bf16_t* QE = (bf16_t*)((char*)p.out + OUTS_QE);
    bf16_t* KN = (bf16_t*)((char*)p.out + OUTS_KN);
    float* UT = (float*)(p.ws + OFF_UT);
    float* DL = (float*)(p.ws + OFF_DL);
    const int wstride = gridDim.x * 8;
    for (int task = wid * (int)gridDim.x + opaque_bid(); task < 32 * 33; task += wstride) {
        const int bh = task / 33, c = task - bh * 33, b = bh >> 2, h = bh & 3;
        const int d = lane;
        float w[16];
#pragma unroll
        for (int rr = 0; rr < 16; ++rr) w[rr] = p.wg2[(size_t)layer * 16 * 256 + rr * 256 + h * 64 + d];
        const float bgd = p.bg[layer * 256 + h * 64 + d];
        float bsum = 0.f;
        const int rowi0 = b * L + 64 * c - 48;
        f32x4 g4[4];
#pragma unroll
        for (int m = 0; m < 4; ++m) { int rr_ = rowi0 + ((lane + 64 * m) >> 2); rr_ = rr_ > 0 ? rr_ : 0; g4[m] = *(const f32x4*)(GLR + (size_t)rr_ * 16 + 4 * (lane & 3)); }
        LAS unsigned char* ldg = (LAS unsigned char*)smem + 65536 + wid * 4096;
#pragma unroll
        for (int m = 0; m < 4; ++m) *(LAS f32x4*)(ldg + (lane + 64 * m) * 16) = g4[m];
        unsigned qk[64];
#pragma unroll
        for (int t = 0; t < 64; ++t) { int rr_ = rowi0 + t; rr_ = rr_ > 0 ? rr_ : 0; const size_t o_ = (size_t)rr_ * 256 + h * 64 + d; qk[t] = (unsigned)GQ[o_] | ((unsigned)GK[o_] << 16); }
        float kn[8];
        __builtin_amdgcn_wave_barrier(); asm volatile("s_waitcnt lgkmcnt(0)" ::: "memory");
#pragma unroll
        for (int t = 0; t < 64; ++t) {
            const bool valid = (c > 0) || (t >= 48);
            float x = bgd;
            {
                const LAS f32x4* gp = (const LAS f32x4*)(ldg + t * 64);
                const f32x4 g0 = gp[0], g1 = gp[1], g2 = gp[2], g3 = gp[3];
#pragma unroll
                for (int rr = 0; rr < 4; ++rr) x = fmaf(g0[rr], w[rr], x);
#pragma unroll
                for (int rr = 0; rr < 4; ++rr) x = fmaf(g1[rr], w[4 + rr], x);
#pragma unroll
                for (int rr = 0; rr < 4; ++rr) x = fmaf(g2[rr], w[8 + rr], x);
#pragma unroll
                for (int rr = 0; rr < 4; ++rr) x = fmaf(g3[rr], w[12 + rr], x);
            }
            bsum += valid ? logsigmoid_fast(x) * (1.f / 16.f) : 0.f;
            const float eb = __expf(bsum);
            const float qv = __uint_as_float(qk[t] << 16), kv = __uint_as_float(qk[t] & 0xFFFF0000u);
            const float knv = valid ? kv * __builtin_amdgcn_rcpf(eb) : 0.f;
            kn[t & 7] = knv;
            if (valid) {
                const size_t o_ = (size_t)(rowi0 + t) * 256 + h * 64 + d;
                QE[o_] = f2bf(qv * eb);
                KN[o_] = f2bf(knv);
            }
            if ((t & 7) == 7 && c < 32) {
                u32x4 o; o[0] = cvt_pk_bf16(kn[0], kn[1]); o[1] = cvt_pk_bf16(kn[2], kn[3]); o[2] = cvt_pk_bf16(kn[4], kn[5]); o[3] = cvt_pk_bf16(kn[6], kn[7]);
                *(LAS u32x4*)(ldw + d * 128 + 16 * ((t >> 3) ^ (d & 7))) = o;
            }
        }
        if (c < 32) {
            const float dl = __expf(bsum);
            DL[((size_t)bh * 32 + c) * 64 + d] = dl;
            __builtin_amdgcn_wave_barrier(); asm volatile("s_waitcnt lgkmcnt(0)" ::: "memory");
            bf16x8 kf[4][2]; float dls[4];
#pragma unroll
            for (int dt = 0; dt < 4; ++dt) {
                const int rowd = 16 * dt + fr;
                dls[dt] = __shfl(dl, rowd);
#pragma unroll
                for (int ks = 0; ks < 2; ++ks) kf[dt][ks] = *(const LAS bf16x8*)(ldw + rowd * 128 + 16 * ((4 * ks + fq) ^ (rowd & 7)));
            }
            const bf16x8 z8 = {0, 0, 0, 0, 0, 0, 0, 0};
#pragma unroll
            for (int et = 0; et < 8; ++et) {
                const bf16_t* vp = GVT + ((size_t)bh * 128 + 16 * et + fr) * LPV + 64 * c + 8 * fq;
                bf16x8 v0 = *(const bf16x8*)vp, v1 = *(const bf16x8*)(vp + 32);
                v0 = (c == 0) ? z8 : v0; v1 = (c == 0 && fq < 2) ? z8 : v1;
#pragma unroll
                for (int dt = 0; dt < 4; ++dt) {
                    f32x4 acc = {0.f, 0.f, 0.f, 0.f};
                    acc = __builtin_amdgcn_mfma_f32_16x16x32_bf16(v0, kf[dt][0], acc, 0, 0, 0);
                    acc = __builtin_amdgcn_mfma_f32_16x16x32_bf16(v1, kf[dt][1], acc, 0, 0, 0);
                    float* up = UT + (((size_t)bh * 32 + c) * 128 + 16 * et + 4 * fq) * 64 + 16 * dt + fr;
#pragma unroll
                    for (int r = 0; r < 4; ++r) up[r * 64] = acc[r] * dls[dt];
                }
            }
            __builtin_amdgcn_wave_barrier(); asm volatile("s_waitcnt lgkmcnt(0)" ::: "memory");
        }
    }
}

__device__ __forceinline__ void phase_gla_scan(const Params& p_in, int layer_in, char* smem) {
    const Params p = kparams(); const int layer = opaque_int(layer_in); (void)p_in;
    const int tid = opaque_tid();
    const float* UT = (const float*)(p.ws + OFF_UT);
    const float* DL = (const float*)(p.ws + OFF_DL);
    bf16_t* ST = (bf16_t*)(p.ws + OFF_ST);
    const int nthr = gridDim.x * NT;
    for (int el = opaque_bid() * NT + tid; el < 32 * 8192; el += nthr) {
        const int bh = el >> 13, ed = el & 8191, d = el & 63;
        float sacc = 0.f;
        ST[((size_t)bh * 33) * 8192 + ed] = 0;
#pragma unroll 1
        for (int c0 = 0; c0 < 32; c0 += 16) {
            float u[16], dl[16];
#pragma unroll
            for (int i = 0; i < 16; ++i) { u[i] = UT[((size_t)(bh * 32 + c0 + i)) * 8192 + ed]; dl[i] = DL[(size_t)(bh * 32 + c0 + i) * 64 + d]; }
#pragma unroll
            for (int i = 0; i < 16; ++i) { sacc = fmaf(dl[i], sacc, u[i]); ST[((size_t)bh * 33 + c0 + i + 1) * 8192 + ed] = f2bf(sacc); }
        }
    }
}

__device__ __forceinline__ void phase_gla_c(const Params& p_in, int layer_in, char* smem, bool do_store) {
    const Params p = kparams(); const int layer = opaque_int(layer_in); (void)p_in;
    const int tid = opaque_tid(), wid = __builtin_amdgcn_readfirstlane(tid >> 6), lane = tid & 63, fr = lane & 15, fq = lane >> 4;
    const bf16_t* QE = (const bf16_t*)((const char*)p.out + OUTS_QE);
    const bf16_t* KN = (const bf16_t*)((const char*)p.out + OUTS_KN);
    const bf16_t* GVT = (const bf16_t*)(p.ws + OFF_GV);
    const bf16_t* ST = (const bf16_t*)(p.ws + OFF_ST);
    bf16_t* MIX = (bf16_t*)(p.ws + OFF_MIX);
    const float* ng = p.norm_g + layer * 128;
    const bf16x8 z8 = {0, 0, 0, 0, 0, 0, 0, 0};
    const int nwt = 32 * 33 * 4, wstride = gridDim.x * 8;
    for (int wt = wid * (int)gridDim.x + opaque_bid(); wt < nwt; wt += wstride) {
        const int task = wt >> 2, tw = wt & 3;
        const int bh = task / 33, c = task - bh * 33, b = bh >> 2, h = bh & 3;
        const int pos_t = 64 * c - 48 + 16 * tw + fr;
        if (c == 0 && tw < 3) continue;
        bf16x8 qf[2];
        {
            const bf16_t* qp = QE + ((size_t)b * L + pos_t) * 256 + h * 64 + 8 * fq;
            qf[0] = *(const bf16x8*)qp; qf[1] = *(const bf16x8*)(qp + 32);
        }
        unsigned pk[4][2];
#pragma unroll
        for (int st = 0; st < 4; ++st) {
            f32x4 a = {0.f, 0.f, 0.f, 0.f};
            const int pos_s = 64 * c - 48 + 16 * st + fr;
            const bf16_t* kp = KN + ((size_t)b * L + (pos_s > 0 ? pos_s : 0)) * 256 + h * 64 + 8 * fq;
            bf16x8 k0 = *(const bf16x8*)kp, k1 = *(const bf16x8*)(kp + 32);
            k0 = (pos_s >= 0) ? k0 : z8; k1 = (pos_s >= 0) ? k1 : z8;
            a = __builtin_amdgcn_mfma_f32_16x16x32_bf16(k0, qf[0], a, 0, 0, 0);
            a = __builtin_amdgcn_mfma_f32_16x16x32_bf16(k1, qf[1], a, 0, 0, 0);
#pragma unroll
            for (int r = 0; r < 4; ++r) a[r] = (16 * st + 4 * fq + r > 16 * tw + fr) ? 0.f : a[r];
            pk[st][0] = cvt_pk_bf16(a[0], a[1]); pk[st][1] = cvt_pk_bf16(a[2], a[3]);
        }
        bf16x8 pf[2];
#pragma unroll
        for (int ks = 0; ks < 2; ++ks) { u32x4 pw; pw[0] = pk[2 * ks][0]; pw[1] = pk[2 * ks][1]; pw[2] = pk[2 * ks + 1][0]; pw[3] = pk[2 * ks + 1][1]; pf[ks] = __builtin_bit_cast(bf16x8, pw); }
        f32x4 O[8];
        float ss = 0.f;
        const u32x2 z2 = {0u, 0u};
#pragma unroll
        for (int et = 0; et < 8; ++et) {
            const int e0 = 16 * et;
            f32x4 acc = {0.f, 0.f, 0.f, 0.f};
            const bf16_t* sp = ST + (((size_t)bh * 33 + c) * 128 + e0 + fr) * 64 + 8 * fq;
            const bf16_t* vp = GVT + ((size_t)bh * 128 + e0 + fr) * LPV + 64 * c + 4 * fq;
            acc = __builtin_amdgcn_mfma_f32_16x16x32_bf16(*(const bf16x8*)sp, qf[0], acc, 0, 0, 0);
            acc = __builtin_amdgcn_mfma_f32_16x16x32_bf16(*(const bf16x8*)(sp + 32), qf[1], acc, 0, 0, 0);
            u32x2 va = *(const u32x2*)vp, vb = *(const u32x2*)(vp + 16), vc = *(const u32x2*)(vp + 32), vd = *(const u32x2*)(vp + 48);
            va = (c == 0) ? z2 : va; vb = (c == 0) ? z2 : vb; vc = (c == 0) ? z2 : vc;
            u32x4 vw; vw[0] = va[0]; vw[1] = va[1]; vw[2] = vb[0]; vw[3] = vb[1];
            acc = __builtin_amdgcn_mfma_f32_16x16x32_bf16(__builtin_bit_cast(bf16x8, vw), pf[0], acc, 0, 0, 0);
            u32x4 vx; vx[0] = vc[0]; vx[1] = vc[1]; vx[2] = vd[0]; vx[3] = vd[1];
            acc = __builtin_amdgcn_mfma_f32_16x16x32_bf16(__builtin_bit_cast(bf16x8, vx), pf[1], acc, 0, 0, 0);
            O[et] = acc;
            ss += acc[0] * acc[0] + acc[1] * acc[1] + acc[2] * acc[2] + acc[3] * acc[3];
        }
        ss += __shfl_xor(ss, 16); ss += __shfl_xor(ss, 32);
        const float rinv = rsqrtf(ss * (1.f / 128) + LN_EPS);
        if (pos_t >= 0 && do_store) {
            bf16_t* mp = MIX + ((size_t)b * L + pos_t) * 1024 + h * 128 + 4 * fq;
#pragma unroll
            for (int et = 0; et < 8; ++et) {
                const uint2 gz = *(const uint2*)(mp + 16 * et);
                const f32x4 nv = *(const f32x4*)(ng + 16 * et + 4 * fq);
                const float g0 = __uint_as_float(gz.x << 16), g1 = __uint_as_float(gz.x & 0xFFFF0000u), g2 = __uint_as_float(gz.y << 16), g3 = __uint_as_float(gz.y & 0xFFFF0000u);
                uint2 o; o.x = cvt_pk_bf16(O[et][0] * rinv * nv[0] * g0, O[et][1] * rinv * nv[1] * g1); o.y = cvt_pk_bf16(O[et][2] * rinv * nv[2] * g2, O[et][3] * rinv * nv[3] * g3);
                *(uint2*)(mp + 16 * et) = o;
            }
        }
    }
}

__device__ __forceinline__ void phase_ln(const Params& p_in, int layer_in, char* smem) {
    const Params p = kparams(); const int layer = opaque_int(layer_in); (void)p_in;
    const int tid = opaque_tid(), wid = tid >> 6, lane = tid & 63;
    const float* Z = (const float*)(p.ws + OFF_GQ);
    float* H32 = (float*)(p.ws + OFF_H32);
    bf16_t* HB = (bf16_t*)(p.ws + OFF_HB);
    const float* g = p.ln_g + layer * D; const float* bb = p.ln_b + layer * D;
    const int nw = gridDim.x * 8;
    int t = opaque_bid() * 8 + wid;
    f32x4 v[4], vn[4];
    if (t < T) {
#pragma unroll
        for (int i = 0; i < 4; ++i) v[i] = *(const f32x4*)(Z + (size_t)t * D + 4 * lane + 256 * i);
    }
    for (; t < T; t += nw) {
        const int tn = t + nw;
        if (tn < T) {
#pragma unroll
            for (int i = 0; i < 4; ++i) vn[i] = *(const f32x4*)(Z + (size_t)tn * D + 4 * lane + 256 * i);
        }
        ln_row_wave(v, g, bb, lane);
        if (layer == DEPTH - 1) {
            const int b = t / L, pos = t - b * L;
            if (pos >= NMETA) {
#pragma unroll
                for (int i = 0; i < 4; ++i) *(f32x4*)(p.out + ((size_t)b * SEQ + (pos - NMETA)) * D + 4 * lane + 256 * i) = v[i];
            }
        } else {
#pragma unroll
            for (int i = 0; i < 4; ++i) {
                *(f32x4*)(H32 + (size_t)t * D + 4 * lane + 256 * i) = v[i];
                u32x2 o; o[0] = cvt_pk_bf16(v[i][0], v[i][1]); o[1] = cvt_pk_bf16(v[i][2], v[i][3]);
                *(u32x2*)(HB + (size_t)t * D + 4 * lane + 256 * i) = o;
            }
        }
#pragma unroll
        for (int i = 0; i < 4; ++i) v[i] = vn[i];
    }
}

#define XB_TMO      128
#define XB_XCNT(j)  (256  + 64 * (j))
#define XB_XSUB(j)  (1280 + 64 * (j))
#define XB_XGEN(j)  (2304 + 64 * (j))
#define XB_TOP      3328
#define XB_TOPGEN   3392
#define XCD_BAR_WORDS 3456
#define XB_SPIN_CAP (1u << 22)
__device__ __forceinline__ unsigned xb_ld(unsigned* p)              { return __hip_atomic_load(p, __ATOMIC_RELAXED, __HIP_MEMORY_SCOPE_AGENT); }
__device__ __forceinline__ unsigned xb_add(unsigned* p, unsigned v) { return __hip_atomic_fetch_add(p, v, __ATOMIC_RELAXED, __HIP_MEMORY_SCOPE_AGENT); }
__device__ __forceinline__ unsigned xb_xcc_id() { return (unsigned)__builtin_amdgcn_s_getreg((3 << 11) | 20) & 0xFu; }
#define XB_SPIN(cond, bar) do { unsigned _sp = 0; while (cond) { __builtin_amdgcn_s_sleep(1); \
    if ((++_sp & 255u) == 0u) { if (xb_ld(&(bar)[XB_TMO])) break; if (_sp > XB_SPIN_CAP) { atomicAdd(&(bar)[XB_TMO], 1u); break; } } } } while (0)
struct XcdBarrier { unsigned* bar; unsigned x; volatile LAS unsigned* st; };
__device__ __forceinline__ XcdBarrier xcd_barrier_post(unsigned* bar, volatile LAS unsigned* st) {
    XcdBarrier b; b.bar = bar; b.x = xb_xcc_id(); b.st = st;
    if (threadIdx.x == 0) (void)xb_add(&bar[XB_XCNT(b.x)], 1u);
    return b;
}
__device__ __forceinline__ void xcd_barrier_complete(unsigned* bar, unsigned x, unsigned& nloc, unsigned& nx) {
    const unsigned G = gridDim.x * gridDim.y * gridDim.z;
    unsigned sum, cnt, mine, sp = 0u;
    for (;;) {
        sum = 0u; cnt = 0u; mine = 0u;
#pragma unroll
        for (unsigned j = 0; j < 16; ++j) { const unsigned c = xb_ld(&bar[XB_XCNT(j)]); sum += c; cnt += (c > 0u) ? 1u : 0u; mine = (j == x) ? c : mine; }
        if (sum == G) break;
        __builtin_amdgcn_s_sleep(1);
        if ((++sp & 255u) == 0u) { if (xb_ld(&bar[XB_TMO])) break; if (sp > XB_SPIN_CAP) { atomicAdd(&bar[XB_TMO], 1u); break; } }
    }
    nloc = mine > 0u ? mine : 1u; nx = cnt > 0u ? cnt : 1u;
}
__device__ __forceinline__ void xcd_barrier(unsigned* bar_, volatile LAS unsigned* st_) {
    XcdBarrier b; b.bar = bar_; b.x = xb_xcc_id(); b.st = st_;
    asm volatile("s_waitcnt vmcnt(0)" ::: "memory");
    __syncthreads();
    if (opaque_tid() == 0) {
        unsigned* bar = b.bar;
        __builtin_amdgcn_s_waitcnt(0);
        unsigned nloc = b.st[0], nx = b.st[1];
        if (nloc == 0u) { xcd_barrier_complete(bar, b.x, nloc, nx); b.st[0] = nloc; b.st[1] = nx; }
        const unsigned old = xb_add(&bar[XB_XSUB(b.x)], 1u);
        const unsigned gen = old / nloc;
        if (old + 1u == (gen + 1u) * nloc) {
            __builtin_amdgcn_fence(__ATOMIC_RELEASE, "agent");
            asm volatile("s_waitcnt vmcnt(0)" ::: "memory");
            const unsigned og = xb_add(&bar[XB_TOP], 1u);
            const unsigned tg = og / nx;
            if (og + 1u == (tg + 1u) * nx) xb_add(&bar[XB_TOPGEN], 1u);
            else XB_SPIN(xb_ld(&bar[XB_TOPGEN]) == tg, bar);
            __builtin_amdgcn_fence(__ATOMIC_ACQUIRE, "agent");
            xb_add(&bar[XB_XGEN(b.x)], 1u);
            asm volatile("s_waitcnt vmcnt(0)" ::: "memory");
        } else {
            XB_SPIN(xb_ld(&bar[XB_XGEN(b.x)]) == gen, bar);
            __builtin_amdgcn_fence(__ATOMIC_ACQUIRE, "agent");
            asm volatile("s_waitcnt vmcnt(0)" ::: "memory");
        }
    }
    __syncthreads();
}

constexpr int SMEM_BYTES = 160 * 1024;
static_assert(DS_END <= SMEM_BYTES - 16 - 64, "dsa lds");
static_assert(WVTAB_OFF == SMEM_BYTES - 16 - 64, "wave table");

__global__ void __launch_bounds__(NT, 2) k_mega(Params p) {
    __shared__ __attribute__((aligned(16))) char smem[SMEM_BYTES];
    volatile LAS unsigned* xbw = (volatile LAS unsigned*)((LAS unsigned char*)smem + (SMEM_BYTES - 16));
    if (threadIdx.x == 0) { xbw[0] = 0u; xbw[1] = 0u; xbw[2] = 0u; xbw[3] = 0u; }
    {
        const unsigned slot = (unsigned)__builtin_amdgcn_s_getreg(((6 - 1) << 11) | 4) & 63u;
        if ((threadIdx.x & 63) == 0) *((volatile LAS unsigned char*)smem + WVTAB_OFF + slot) = (unsigned char)(threadIdx.x >> 6);
    }
    __syncthreads();
    if (p.ws == nullptr) cg::this_grid().sync();
    (void)xcd_barrier_post((unsigned*)(p.ws + OFF_BAR), xbw);
    for (int rep = 0; rep < PROBE_REP_PREP; ++rep) {
    phase_prep(p, smem);
    xcd_barrier((unsigned*)(p.ws + OFF_BAR), xbw);
    }
#pragma unroll 1
    for (int layer = 0; layer < DEPTH; ++layer) {
        for (int rep = 0; rep < PROBE_REP_PROJ; ++rep) {
        phase_proj(p, layer, smem);
        xcd_barrier((unsigned*)(p.ws + OFF_BAR), xbw);
        }
        phase_rope(p, layer, smem);
        for (int rep = 0; rep < PROBE_REP_GLAA; ++rep) {
        phase_gla_a(p, layer, smem);
        xcd_barrier((unsigned*)(p.ws + OFF_BAR), xbw);
        phase_gla_scan(p, layer, smem);
        xcd_barrier((unsigned*)(p.ws + OFF_BAR), xbw);
        }
        for (int rep = 0; rep < PROBE_REP_GLAC; ++rep) phase_gla_c(p, layer, smem, rep == PROBE_REP_GLAC - 1);
        for (int rep = 0; rep < PROBE_REP_DSA; ++rep) phase_dsa(p, layer, smem, rep == PROBE_REP_DSA - 1);
        xcd_barrier((unsigned*)(p.ws + OFF_BAR), xbw);
        for (int rep = 0; rep < PROBE_REP_OUT; ++rep) {
        phase_outproj(p, layer, smem);
        xcd_barrier((unsigned*)(p.ws + OFF_BAR), xbw);
        }
        for (int rep = 0; rep < PROBE_REP_LN; ++rep) {
        phase_ln(p, layer, smem);
        xcd_barrier((unsigned*)(p.ws + OFF_BAR), xbw);
        }
    }
}

extern "C" void kernel_launch(void* const* d_in, const int* in_sizes, int n_in, void* d_out, int out_size, void* d_ws, size_t ws_size,
                              hipStream_t stream) {
    Params p{};
    p.x = (const float*)d_in[0]; p.meta = (const float*)d_in[1]; p.ln_in_g = (const float*)d_in[2]; p.ln_in_b = (const float*)d_in[3];
    p.w_in = (const float*)d_in[4]; p.wg2 = (const float*)d_in[5]; p.bg = (const float*)d_in[6]; p.norm_g = (const float*)d_in[7];
    p.ikg = (const float*)d_in[8]; p.ikb = (const float*)d_in[9]; p.w_out = (const float*)d_in[10]; p.ln_g = (const float*)d_in[11];
    p.ln_b = (const float*)d_in[12];
    p.out = (float*)d_out; p.ws = (char*)d_ws;
    static int grid_blocks = 0;
    if (!grid_blocks) {
        int dev = 0, cus = 0, per_cu = 0;
        hipGetDevice(&dev);
        hipDeviceGetAttribute(&cus, hipDeviceAttributeMultiprocessorCount, dev);
        hipOccupancyMaxActiveBlocksPerMultiprocessor(&per_cu, k_mega, NT, 0);
        if (per_cu > 1) per_cu = 1;
        grid_blocks = cus * per_cu;
    }
    (void)hipMemsetAsync((char*)d_ws + OFF_BAR, 0, XCD_BAR_WORDS * 4, stream);
    void* args[] = {&p};
    (void)hipLaunchCooperativeKernel((void*)k_mega, dim3(grid_blocks), dim3(NT), args, 0, stream);
}
```

```cpp
#include <hip/hip_runtime.h>
#include <hip/hip_cooperative_groups.h>
#include <stdint.h>
namespace cg = cooperative_groups;
#ifndef PROBE_REP_PREP
#define PROBE_REP_PREP 1
#define PROBE_REP_PROJ 1
#define PROBE_REP_GLAA 1
#define PROBE_REP_GLAC 1
#define PROBE_REP_DSA 1
#define PROBE_REP_OUT 1
#define PROBE_REP_LN 1
#define PROBE_DSA_A 1
#define PROBE_DSA_B 1
#define PROBE_DSA_C 1
#endif

constexpr int D = 1024, NB = 8, SEQ = 2048, NMETA = 16, L = 2064, T = NB * L;
constexpr int DEPTH = 2;
constexpr int INW = 3416, INWP = 3584;
constexpr int TP = 16640;
constexpr int NT = 512;
constexpr int TOPK = 256;
constexpr float LN_EPS = 1e-5f;
constexpr float ALPHA = 1.41421356237309515f;

typedef unsigned short bf16_t;
typedef short bf16x8 __attribute__((ext_vector_type(8)));
typedef float f32x4 __attribute__((ext_vector_type(4)));
#define LAS __attribute__((address_space(3)))

constexpr size_t SZ_H32 = (size_t)T * D * 4;
constexpr size_t SZ_HB = (size_t)TP * D * 2;
constexpr size_t SZ_WIN = (size_t)DEPTH * INWP * D * 2;
constexpr size_t SZ_WOUT = (size_t)DEPTH * D * D * 2;
constexpr int LPV = 2112;
constexpr size_t SZ_GQ = (size_t)T * 256 * 2, SZ_GK = SZ_GQ, SZ_GV = (size_t)NB * 4 * 128 * LPV * 2;
constexpr size_t SZ_UT = (size_t)1024 * 128 * 64 * 4, SZ_ST = (size_t)32 * 33 * 128 * 64 * 2, SZ_DL = (size_t)1024 * 64 * 4;
constexpr size_t SZ_AQ = (size_t)T * 512 * 2, SZ_IQ = (size_t)T * 512 * 2;
constexpr size_t SZ_MIX = (size_t)TP * 1024 * 2;
constexpr int LP = 2112;
constexpr size_t SZ_AK = (size_t)T * 128 * 2, SZ_AV = (size_t)NB * 2 * 64 * LP * 2, SZ_IK = (size_t)T * 64 * 2, SZ_IW = (size_t)T * 8 * 4;
constexpr size_t SZ_GLR = (size_t)T * 16 * 4;
constexpr size_t SZ_ROPE = (size_t)L * 8 * 2 * 4;

constexpr size_t OFF_H32 = 0;
constexpr size_t OFF_HB = OFF_H32 + SZ_H32;
constexpr size_t OFF_WIN = OFF_HB + SZ_HB;
constexpr size_t OFF_WOUT = OFF_WIN + SZ_WIN;
constexpr size_t OFF_GQ = OFF_WOUT + SZ_WOUT;
constexpr size_t OFF_GK = OFF_GQ + SZ_GQ;
constexpr size_t OFF_GV = OFF_GK + SZ_GK;
constexpr size_t OFF_AQ = OFF_GV + SZ_GV;
constexpr size_t OFF_IQ = OFF_AQ + SZ_AQ;
constexpr size_t OFF_MIX = OFF_IQ + SZ_IQ;
constexpr size_t OFF_AK = OFF_MIX + SZ_MIX;
constexpr size_t OFF_AV = OFF_AK + SZ_AK;
constexpr size_t OFF_IK = OFF_AV + SZ_AV;
constexpr size_t OFF_IW = OFF_IK + SZ_IK;
constexpr size_t OFF_GLR = OFF_IW + SZ_IW;
constexpr size_t OFF_ROPE = OFF_GLR + SZ_GLR;
constexpr size_t OFF_ST = OFF_ROPE + SZ_ROPE;
constexpr size_t OFF_DL = OFF_ST + SZ_ST;
constexpr size_t OFF_BAR = OFF_DL + SZ_DL;
constexpr size_t OFF_IKR = OFF_BAR + 16384;
constexpr size_t OFF_END = OFF_IKR + (size_t)T * 64 * 4;
constexpr size_t OFF_UT = OFF_HB;
static_assert(SZ_UT <= SZ_HB, "UT alias");
static_assert(SZ_GQ + SZ_GK + SZ_GV + SZ_AQ + SZ_IQ >= SZ_H32, "Z alias size");
static_assert(OFF_END <= (size_t)256 * 1024 * 1024, "workspace too large");

struct Params {
    const float* x; const float* meta; const float* ln_in_g; const float* ln_in_b;
    const float* w_in; const float* wg2; const float* bg; const float* norm_g;
    const float* ikg; const float* ikb; const float* w_out; const float* ln_g; const float* ln_b;
    float* out; char* ws;
};
typedef const Params __attribute__((address_space(4))) * KParamsPtr;
__device__ __forceinline__ Params kparams() {
    unsigned long long a = (unsigned long long)__builtin_amdgcn_kernarg_segment_ptr();
    asm volatile("" : "+s"(a));
    KParamsPtr q = (KParamsPtr)a;
    Params r;
    r.x = q->x; r.meta = q->meta; r.ln_in_g = q->ln_in_g; r.ln_in_b = q->ln_in_b; r.w_in = q->w_in; r.wg2 = q->wg2; r.bg = q->bg; r.norm_g = q->norm_g;
    r.ikg = q->ikg; r.ikb = q->ikb; r.w_out = q->w_out; r.ln_g = q->ln_g; r.ln_b = q->ln_b; r.out = q->out; r.ws = q->ws;
    return r;
}

__device__ __forceinline__ bf16_t f2bf(float f) {
    unsigned u = __float_as_uint(f);
    u += 0x7FFFu + ((u >> 16) & 1u);
    return (bf16_t)(u >> 16);
}
__device__ __forceinline__ unsigned pack2bf(float lo, float hi) { return (unsigned)f2bf(lo) | ((unsigned)f2bf(hi) << 16); }
__device__ __forceinline__ unsigned cvt_pk_bf16(float lo, float hi) { unsigned r; asm volatile("v_cvt_pk_bf16_f32 %0, %1, %2" : "=v"(r) : "v"(lo), "v"(hi)); return r; }
typedef unsigned u32x4 __attribute__((ext_vector_type(4)));
typedef unsigned u32x2 __attribute__((ext_vector_type(2)));
__device__ __forceinline__ float bf2f(bf16_t h) { return __uint_as_float(((unsigned)h) << 16); }
constexpr int WVTAB_OFF = 160 * 1024 - 16 - 64;
__device__ __forceinline__ int opaque_tid() {
    const unsigned slot = (unsigned)__builtin_amdgcn_s_getreg(((6 - 1) << 11) | 4) & 63u;
    const unsigned wv = *((const volatile LAS unsigned char*)(size_t)WVTAB_OFF + slot);
    int t = (int)(wv << 6) | (int)__builtin_amdgcn_mbcnt_hi(~0u, __builtin_amdgcn_mbcnt_lo(~0u, 0u));
    asm volatile("" : "+v"(t)); return t;
}
__device__ __forceinline__ int opaque_int(int v) { asm volatile("" : "+s"(v)); return v; }
__device__ __forceinline__ int opaque_bid() { int t = blockIdx.x; asm volatile("" : "+s"(t)); return t; }
__device__ __forceinline__ float wave_sum(float v) {
#pragma unroll
    for (int o = 32; o > 0; o >>= 1) v += __shfl_xor(v, o);
    return v;
}
__device__ __forceinline__ float wave_max(float v) {
#pragma unroll
    for (int o = 32; o > 0; o >>= 1) v = fmaxf(v, __shfl_xor(v, o));
    return v;
}
__device__ __forceinline__ float block_sum(float v, float* red) {
    v = wave_sum(v);
    const int tq = opaque_tid();
    __syncthreads();
    if ((tq & 63) == 0) red[tq >> 6] = v;
    __syncthreads();
    return ((red[0] + red[1]) + (red[2] + red[3])) + ((red[4] + red[5]) + (red[6] + red[7]));
}
__device__ __forceinline__ float silu_f(float x) { return x / (1.f + __expf(-x)); }
__device__ __forceinline__ float logsigmoid_f(float x) { return fminf(x, 0.f) - log1pf(expf(-fabsf(x))); }
__device__ __forceinline__ float logsigmoid_fast(float x) { return fminf(x, 0.f) - __logf(1.f + __expf(-fabsf(x))); }

__device__ __forceinline__ int proj_src_col(int n) {
    if (n < 1024) return n;
    if (n < 1536) return n - 1024 + 1040;
    if (n < 2048) return n - 1536 + 1552;
    if (n < 2560) return n - 2048 + 2904;
    if (n < 3072) return n - 2560 + 2320;
    if (n < 3200) return n - 3072 + 2064;
    if (n < 3328) return n - 3200 + 2192;
    const int c = n - 3328;
    if (c < 32) return 2832 + c;
    if (c < 48) return 1024 + (c - 32);
    if (c < 56) return 2896 + (c - 48);
    if (c >= 128 && c < 160) return 2832 + 32 + (c - 128);
    return -1;
}

__device__ __forceinline__ void sincos_acc(float a, float& s, float& c) {
    double ad = (double)a;
    double kd = rint(ad * 0.63661977236758134308);
    double r = fma(-kd, 1.57079632679489655800, ad);
    r = fma(-kd, 6.12323399573676603587e-17, r);
    double r2 = r * r;
    double sp = r * (1.0 + r2 * (-1.0 / 6 + r2 * (1.0 / 120 + r2 * (-1.0 / 5040 + r2 * (1.0 / 362880 + r2 * (-1.0 / 39916800))))));
    double cp = 1.0 + r2 * (-0.5 + r2 * (1.0 / 24 + r2 * (-1.0 / 720 + r2 * (1.0 / 40320 + r2 * (-1.0 / 3628800 + r2 * (1.0 / 479001600))))));
    int q = ((int)kd) & 3;
    double ss = (q & 1) ? cp : sp, cc = (q & 1) ? sp : cp;
    if (q == 1 || q == 2) cc = -cc;
    if (q == 2 || q == 3) ss = -ss;
    s = (float)ss; c = (float)cc;
}

__device__ __forceinline__ void ln_row_wave(f32x4 (&v)[4], const float* g, const float* bb, int lane) {
    float sm = 0.f;
#pragma unroll
    for (int i = 0; i < 4; ++i) sm += (v[i][0] + v[i][1]) + (v[i][2] + v[i][3]);
    const float mu = wave_sum(sm) * (1.f / D);
    float qq = 0.f;
#pragma unroll
    for (int i = 0; i < 4; ++i) { v[i] = v[i] - mu; qq += (v[i][0] * v[i][0] + v[i][1] * v[i][1]) + (v[i][2] * v[i][2] + v[i][3] * v[i][3]); }
    const float rs = rsqrtf(wave_sum(qq) * (1.f / D) + LN_EPS);
#pragma unroll
    for (int i = 0; i < 4; ++i) { const f32x4 gg = *(const f32x4*)(g + 4 * lane + 256 * i), b4 = *(const f32x4*)(bb + 4 * lane + 256 * i); v[i] = v[i] * rs * gg + b4; }
}
__device__ __forceinline__ int proj_dst_col(int src) {
    if (src < 1024) return src;
    if (src < 1040) return 3328 + 32 + (src - 1024);
    if (src < 1552) return 1024 + (src - 1040);
    if (src < 2064) return 1536 + (src - 1552);
    if (src < 2192) return 3072 + (src - 2064);
    if (src < 2320) return 3200 + (src - 2192);
    if (src < 2832) return 2560 + (src - 2320);
    if (src < 2864) return 3328 + (src - 2832);
    if (src < 2896) return 3328 + 128 + (src - 2864);
    if (src < 2904) return 3328 + 48 + (src - 2896);
    return 2048 + (src - 2904);
}
__device__ __forceinline__ void phase_prep(const Params& p_in, char* smem) {
    const Params p = kparams(); (void)p_in;
    const int tid = opaque_tid(), wid = tid >> 6, lane = tid & 63;
    bf16_t* WIN = (bf16_t*)(p.ws + OFF_WIN);
    bf16_t* WOUT = (bf16_t*)(p.ws + OFF_WOUT);
    float* H32 = (float*)(p.ws + OFF_H32);
    bf16_t* HB = (bf16_t*)(p.ws + OFF_HB);
    bf16_t* MIX = (bf16_t*)(p.ws + OFF_MIX);
    float2* ROPE = (float2*)(p.ws + OFF_ROPE);
    float (*tile)[65] = (float (*)[65])smem;
    constexpr int NCT_IN = (INW + 63) / 64, NT_IN = DEPTH * 16 * NCT_IN, NT_OUT = DEPTH * 16 * 16;
    for (int item = opaque_bid(); item < NT_IN + NT_OUT; item += gridDim.x) {
        const bool is_in = item < NT_IN;
        const int it = is_in ? item : item - NT_IN;
        const int nct = is_in ? NCT_IN : 16, ldw = is_in ? INW : D;
        const int l = it / (16 * nct), rem = it - l * 16 * nct, kt = rem / nct, ct = rem - kt * nct;
        const float* W = (is_in ? p.w_in : p.w_out) + (size_t)l * D * ldw;
        __syncthreads();
#pragma unroll
        for (int i = 0; i < 8; ++i) {
            const int e = tid + NT * i, kk = e >> 6, nn = e & 63, col = ct * 64 + nn;
            tile[kk][nn] = (col < ldw) ? W[(size_t)(kt * 64 + kk) * ldw + col] : 0.f;
        }
        __syncthreads();
        {
            const int nn = tid >> 3, k8 = (tid & 7) * 8, src = ct * 64 + nn;
            if (src < ldw) {
                const int dst = is_in ? proj_dst_col(src) : src;
                u32x4 o;
#pragma unroll
                for (int q = 0; q < 4; ++q) o[q] = cvt_pk_bf16(tile[k8 + 2 * q][nn], tile[k8 + 2 * q + 1][nn]);
                bf16_t* dstp = (is_in ? WIN + ((size_t)l * INWP + dst) * D : WOUT + ((size_t)l * D + dst) * D) + kt * 64 + k8;
                *(u32x4*)dstp = o;
            }
        }
    }
    {
        const int nw = gridDim.x * 8;
        for (int t = opaque_bid() * 8 + wid; t < TP; t += nw) {
            if (t < T) {
                const int b = t / L, pos = t - b * L;
                const float* src = (pos < NMETA) ? (p.meta + (size_t)pos * D) : (p.x + ((size_t)b * SEQ + (pos - NMETA)) * D);
                f32x4 v[4];
#pragma unroll
                for (int i = 0; i < 4; ++i) v[i] = *(const f32x4*)(src + 4 * lane + 256 * i);
                ln_row_wave(v, p.ln_in_g, p.ln_in_b, lane);
#pragma unroll
                for (int i = 0; i < 4; ++i) {
                    *(f32x4*)(H32 + (size_t)t * D + 4 * lane + 256 * i) = v[i];
                    u32x2 o; o[0] = cvt_pk_bf16(v[i][0], v[i][1]); o[1] = cvt_pk_bf16(v[i][2], v[i][3]);
                    *(u32x2*)(HB + (size_t)t * D + 4 * lane + 256 * i) = o;
                }
            } else {
#pragma unroll
                for (int i = 0; i < 4; ++i) {
                    *(u32x2*)(HB + (size_t)t * D + 4 * lane + 256 * i) = (u32x2){0u, 0u};
                    *(u32x2*)(MIX + (size_t)t * D + 4 * lane + 256 * i) = (u32x2){0u, 0u};
                }
            }
        }
    }
    for (int e = opaque_bid() * NT + tid; e < L * 8; e += gridDim.x * NT) {
        const int pos = e >> 3, i = e & 7;
        const float inv[8] = {1.0f, 0.19392274f, 0.03760603f, 0.0072926646f, 0.0014142136f, 0.0002742482f, 5.3182957e-05f, 1.0313385e-05f};
        float iv = inv[0];
#pragma unroll
        for (int j = 1; j < 8; ++j) iv = (i == j) ? inv[j] : iv;
        const float ang = (float)pos * iv;
        float sn, cs; sincos_acc(ang, sn, cs);
        ROPE[e] = make_float2(cs, sn);
    }
}

namespace pg8 {
constexpr int BM = 256, BK = 64, HALF = 128, HTB = HALF * BK * 2  , STAGE_BYTES = 8 * HTB, NXCD = 8, WGM = 8;
__device__ __forceinline__ int lds_byte(int r, int c) { const int st = (r >> 4) * 2 + (c >> 5), rr = r & 15, cc = c & 31, ob = rr * 64 + cc * 2; return st * 1024 + (ob ^ (((ob >> 9) & 1) << 5)); }
__device__ __forceinline__ void stage_rc(int b, int& R, int& C) { const int st = b / 1024, sb = b % 1024, swz = sb ^ (((sb >> 9) & 1) << 5); R = (st >> 1) * 16 + swz / 64; C = (st & 1) * 32 + (swz % 64) / 2; }
__device__ __forceinline__ int perm32(int rho) { const int n = rho >> 4, i = rho & 15; return 8 * (i >> 2) + 4 * n + (i & 3); }

struct Unit { int pm, pn; };
struct Gemm { const bf16_t* A; const bf16_t* Bt; int M, N, K; };

struct StaticOrder {
    int nM, nN, nwg, G, c;
    __device__ void init(int M, int N, int G_, int c_) { nM = M / BM; nN = N / BM; nwg = nM * nN; G = G_; c = c_; }
    __device__ bool next(int i, Unit& u) const {
        const long Lx = (long)i * G + c; if (Lx >= nwg) return false;
        int wgid = (int)Lx; { const int q = nwg / NXCD, r = nwg % NXCD, xcd = wgid % NXCD, off = wgid / NXCD; wgid = (xcd < r ? xcd * (q + 1) : r * (q + 1) + (xcd - r) * q) + off; }
        const int nig = WGM * nN, gid = wgid / nig, fm = gid * WGM, gsz = (nM - fm) < WGM ? (nM - fm) : WGM;
        u.pm = fm + ((wgid % nig) % gsz); u.pn = (wgid % nig) / gsz; return true;
    }
    __device__ __forceinline__ void a_ready(const Unit&) const {}
    __device__ __forceinline__ void done(const Unit&) const {}
};

template <class Epi, class Sched>
__device__ __forceinline__ void gemm_phase(LAS unsigned char* lds, const Gemm g, const Sched& S, const Epi& E) {
    const int tid = opaque_tid(), wid = __builtin_amdgcn_readfirstlane(tid >> 6), lane = tid & 63, wr = wid >> 2, wc = wid & 3, fr = lane & 15, fq = lane >> 4;
    const int K = g.K, nt = K / BK;
    unsigned voffA[2], voffB[2];
#pragma unroll
    for (int i = 0; i < 2; ++i) { int R, C; stage_rc(tid * 16 + i * 8192, R, C); const int Rb = Epi::PERM ? ((R & ~31) + perm32(R & 31)) : R;
        voffA[i] = (unsigned)(R * K + C) * 2u; voffB[i] = (unsigned)(Rb * K + C) * 2u; }
    const size_t kstep = (size_t)(BK * 2);
    const size_t hstep = (size_t)HALF * K * 2;
    const size_t tstep = 2 * hstep;
    const unsigned ldsw = (unsigned)wid * 1024u;
    const int aoff = lds_byte(wr * 64 + fr, fq * 8), boff = lds_byte(wc * 32 + fr, fq * 8);
#define PG8_SA(b, h) (((b) * 2 + (h)) * HTB)
#define PG8_SB(b, h) ((4 + (b) * 2 + (h)) * HTB)
#define PG8_STAGE(bufoff, gbase, voff) do { _Pragma("unroll") for (int _i = 0; _i < 2; ++_i) \
        __builtin_amdgcn_global_load_lds((const unsigned*)((const char*)(gbase) + (voff)[_i]), (LAS unsigned*)(lds + (bufoff) + ldsw + _i * 8192), 16, 0, 0); } while (0)
    const LAS unsigned char* la_base = lds + aoff; asm volatile("" : "+v"(la_base));
    const LAS unsigned char* lb_base = lds + 4 * HTB + boff; asm volatile("" : "+v"(lb_base));
#define PG8_LDA(dst, b, h) do { _Pragma("unroll") for (int m = 0; m < 4; ++m) _Pragma("unroll") for (int k = 0; k < 2; ++k) dst[m][k] = *(const LAS bf16x8*)(la_base + PG8_SA(b, h) + m * 2048 + k * 1024); } while (0)
#define PG8_LDB(dst, b, h) do { _Pragma("unroll") for (int n = 0; n < 2; ++n) _Pragma("unroll") for (int k = 0; k < 2; ++k) dst[n][k] = *(const LAS bf16x8*)(lb_base + (PG8_SB(b, h) - 4 * HTB) + n * 2048 + k * 1024); } while (0)
#define PG8_MMA(ai, bj, At, Bt) do { __builtin_amdgcn_s_setprio(1); _Pragma("unroll") for (int m = 0; m < 4; ++m) _Pragma("unroll") for (int n = 0; n < 2; ++n) _Pragma("unroll") for (int k = 0; k < 2; ++k) \
        acc[ai][bj][m][n] = __builtin_amdgcn_mfma_f32_16x16x32_bf16(Bt[n][k], At[m][k], acc[ai][bj][m][n], 0, 0, 0); __builtin_amdgcn_s_setprio(0); } while (0)
#define PG8_WAIT_V(n) asm volatile("s_waitcnt vmcnt(" #n ")" ::: "memory")
#define PG8_WAIT_L(n) asm volatile("s_waitcnt lgkmcnt(" #n ")" ::: "memory")
#define PG8_BAR __builtin_amdgcn_s_barrier()
#define PG8_SCHED __builtin_amdgcn_sched_barrier(0)
    Unit cur, nxt; int ui = 0;
    if (!S.next(0, cur)) return;
    f32x4 acc[2][2][4][2];
#pragma unroll
    for (int a = 0; a < 2; ++a)
#pragma unroll
        for (int b = 0; b < 2; ++b)
#pragma unroll
            for (int m = 0; m < 4; ++m)
#pragma unroll
                for (int n = 0; n < 2; ++n) acc[a][b][m][n] = (f32x4){0.f, 0.f, 0.f, 0.f};
    bf16x8 At[4][2], B0[2][2], B1[2][2];
    const char* cA = (const char*)g.A + (size_t)cur.pm * tstep; const char* cB = (const char*)g.Bt + (size_t)cur.pn * tstep;
    S.a_ready(cur);
    PG8_STAGE(PG8_SB(0, 0), cB, voffB); PG8_STAGE(PG8_SA(0, 0), cA, voffA); PG8_STAGE(PG8_SB(0, 1), cB + hstep, voffB); PG8_STAGE(PG8_SA(0, 1), cA + hstep, voffA);
    if (wr == 1) PG8_BAR;
    PG8_WAIT_V(4); PG8_BAR;
    PG8_STAGE(PG8_SB(1, 0), cB + kstep, voffB); PG8_STAGE(PG8_SA(1, 0), cA + kstep, voffA); PG8_STAGE(PG8_SB(1, 1), cB + hstep + kstep, voffB);
    PG8_WAIT_V(6); PG8_BAR;
    for (;;) {
        const bool has_next = S.next(ui + 1, nxt);
        const char* nA = has_next ? (const char*)g.A + (size_t)nxt.pm * tstep : cA; const char* nB = has_next ? (const char*)g.Bt + (size_t)nxt.pn * tstep : cB;
        for (int t = 0; t < nt; t += 2) {
            const bool last = (t == nt - 2);
            const char* a1 = cA + (size_t)(t + 1) * kstep;
            const char* a2 = last ? nA : cA + (size_t)(t + 2) * kstep; const char* b2 = last ? nB : cB + (size_t)(t + 2) * kstep;
            const char* a3 = a2 + kstep; const char* b3 = b2 + kstep;
            if (last && has_next) S.a_ready(nxt);
            PG8_LDB(B0, 0, 0); PG8_SCHED; PG8_LDA(At, 0, 0); PG8_STAGE(PG8_SA(1, 1), a1 + hstep, voffA);
            PG8_WAIT_L(8); PG8_BAR; PG8_WAIT_L(0); PG8_MMA(0, 0, At, B0); PG8_BAR; PG8_SCHED;
            PG8_LDB(B1, 0, 1); PG8_STAGE(PG8_SB(0, 0), b2, voffB);
            PG8_BAR; PG8_WAIT_L(0); PG8_MMA(0, 1, At, B1); PG8_BAR;
            PG8_LDA(At, 0, 1); PG8_STAGE(PG8_SA(0, 0), a2, voffA);
            PG8_BAR; PG8_WAIT_L(0); PG8_MMA(1, 0, At, B0); PG8_BAR; PG8_SCHED;
            PG8_STAGE(PG8_SB(0, 1), b2 + hstep, voffB);
            PG8_WAIT_V(6); PG8_BAR; PG8_MMA(1, 1, At, B1); PG8_BAR;
            PG8_LDB(B0, 1, 0); PG8_SCHED; PG8_LDA(At, 1, 0); PG8_STAGE(PG8_SA(0, 1), a2 + hstep, voffA);
            PG8_WAIT_L(8); PG8_BAR; PG8_WAIT_L(0); PG8_MMA(0, 0, At, B0); PG8_BAR; PG8_SCHED;
            PG8_LDB(B1, 1, 1); PG8_STAGE(PG8_SB(1, 0), b3, voffB);
            PG8_BAR; PG8_WAIT_L(0); PG8_MMA(0, 1, At, B1); PG8_BAR;
            PG8_LDA(At, 1, 1); PG8_STAGE(PG8_SA(1, 0), a3, voffA);
            PG8_BAR; PG8_WAIT_L(0); PG8_MMA(1, 0, At, B0); PG8_BAR; PG8_SCHED;
            PG8_STAGE(PG8_SB(1, 1), b3 + hstep, voffB);
            PG8_WAIT_V(6); PG8_BAR; PG8_MMA(1, 1, At, B1); PG8_BAR;
        }
        E(acc, cur, wr, wc, fr, fq); S.done(cur);
        if (!has_next) break;
#pragma unroll
        for (int a = 0; a < 2; ++a)
#pragma unroll
            for (int b = 0; b < 2; ++b)
#pragma unroll
                for (int m = 0; m < 4; ++m)
#pragma unroll
                    for (int n = 0; n < 2; ++n) acc[a][b][m][n] = (f32x4){0.f, 0.f, 0.f, 0.f};
        cur = nxt; cA = nA; cB = nB; ++ui;
    }
    PG8_WAIT_V(0);
    if (wr == 0) PG8_BAR;
    PG8_BAR;
#undef PG8_SA
#undef PG8_SB
#undef PG8_STAGE
#undef PG8_LDA
#undef PG8_LDB
#undef PG8_MMA
#undef PG8_WAIT_V
#undef PG8_WAIT_L
#undef PG8_BAR
#undef PG8_SCHED
}
}

struct EpiProj {
    static constexpr bool PERM = true;
    char* ws;
    __device__ __forceinline__ void store8(bf16_t* dst, const f32x4& a, const f32x4& b, float sc) const {
        u32x4 o; o[0] = cvt_pk_bf16(a[0] * sc, a[1] * sc); o[1] = cvt_pk_bf16(a[2] * sc, a[3] * sc); o[2] = cvt_pk_bf16(b[0] * sc, b[1] * sc); o[3] = cvt_pk_bf16(b[2] * sc, b[3] * sc);
        *(u32x4*)dst = o;
    }
    __device__ __forceinline__ void operator()(const f32x4 (&acc)[2][2][4][2], const pg8::Unit& u, int wr, int wc, int fr, int fq) const {
        { int ln_ = (int)__builtin_amdgcn_mbcnt_hi(~0u, __builtin_amdgcn_mbcnt_lo(~0u, 0u)); asm volatile("" : "+v"(ln_)); fr = ln_ & 15; fq = ln_ >> 4; }
        if (u.pn < 13) {
#pragma unroll
            for (int bj = 0; bj < 2; ++bj) {
                const int hb = 4 * u.pn + 2 * bj + (wc >> 1);
                const int cc8 = 32 * (wc & 1) + 8 * fq;
#pragma unroll
                for (int ai = 0; ai < 2; ++ai)
#pragma unroll
                    for (int m = 0; m < 4; ++m) {
                        const int t = 256 * u.pm + 128 * ai + 64 * wr + 16 * m + fr;
                        const f32x4 v0 = acc[ai][bj][m][0], v1 = acc[ai][bj][m][1];
                        if (t < T) {
                            const size_t tt = (size_t)t;
                            if (hb < 4) store8((bf16_t*)(ws + OFF_GQ) + tt * 256 + hb * 64 + cc8, v0, v1, 0.125f);
                            else if (hb < 8) store8((bf16_t*)(ws + OFF_GK) + tt * 256 + (hb - 4) * 64 + cc8, v0, v1, 1.f);
                            else if (hb < 16) {
                                const int bq = t / L, pos = t - bq * L;
                                bf16_t* dst = (bf16_t*)(ws + OFF_GV) + ((size_t)(bq * 4 + ((hb - 8) >> 1)) * 128 + ((hb - 8) & 1) * 64 + cc8) * LPV + 48 + pos;
#pragma unroll
                                for (int j = 0; j < 4; ++j) { dst[(size_t)j * LPV] = f2bf(v0[j]); dst[(size_t)(4 + j) * LPV] = f2bf(v1[j]); }
                            }
                            else if (hb < 24 || (hb >= 32 && hb < 40)) {
                                f32x4 s0, s1;
#pragma unroll
                                for (int j = 0; j < 4; ++j) { s0[j] = silu_f(v0[j]); s1[j] = silu_f(v1[j]); }
                                const int col = (hb < 24) ? (hb - 16) * 64 : 512 + (hb - 32) * 64;
                                store8((bf16_t*)(ws + OFF_MIX) + tt * 1024 + col + cc8, s0, s1, 1.f);
                            }
                            else if (hb < 32) store8((bf16_t*)(ws + OFF_AQ) + tt * 512 + (hb - 24) * 64 + cc8, v0, v1, 0.125f * 1.44269504088896341f);
                            else if (hb < 48) store8((bf16_t*)(ws + OFF_IQ) + tt * 512 + (hb - 40) * 64 + cc8, v0, v1, 0.125f);
                            else if (hb < 50) store8((bf16_t*)(ws + OFF_AK) + tt * 128 + (hb - 48) * 64 + cc8, v0, v1, 1.f);
                            else {
                                const int bq = t / L, pos = t - bq * L;
                                bf16_t* dst = (bf16_t*)(ws + OFF_AV) + ((size_t)(bq * 2 + (hb - 50)) * 64 + cc8) * LP + pos;
#pragma unroll
                                for (int j = 0; j < 4; ++j) { dst[(size_t)j * LP] = f2bf(v0[j]); dst[(size_t)(4 + j) * LP] = f2bf(v1[j]); }
                            }
                        }
                        asm volatile("" ::: "memory");
                    }
            }
        } else {
#pragma unroll
            for (int ai = 0; ai < 2; ++ai)
#pragma unroll
                for (int m = 0; m < 4; ++m) {
                    const int t = 256 * u.pm + 128 * ai + 64 * wr + 16 * m + fr;
                    if (t < T) {
                        if (wc == 0) {
                            float* dst = (float*)(ws + OFF_IKR) + (size_t)t * 64 + 8 * fq;
                            *(f32x4*)dst = acc[ai][0][m][0]; *(f32x4*)(dst + 4) = acc[ai][0][m][1];
                            *(f32x4*)(dst + 32) = acc[ai][1][m][0]; *(f32x4*)(dst + 36) = acc[ai][1][m][1];
                        } else if (wc == 1) {
                            const f32x4 v0 = acc[ai][0][m][0], v1 = acc[ai][0][m][1];
                            if (fq < 2) {
                                float* dst = (float*)(ws + OFF_GLR) + (size_t)t * 16 + 8 * fq;
                                *(f32x4*)dst = v0; *(f32x4*)(dst + 4) = v1;
                            } else if (fq == 2) {
                                float* dst = (float*)(ws + OFF_IW) + (size_t)t * 8;
                                *(f32x4*)dst = v0 * 0.353553390593273762f; *(f32x4*)(dst + 4) = v1 * 0.353553390593273762f;
                            }
                        }
                    }
                    asm volatile("" ::: "memory");
                }
        }
    }
};

struct EpiOut {
    static constexpr bool PERM = false;
    const float* H32; float* Z;
    __device__ __forceinline__ void operator()(const f32x4 (&acc)[2][2][4][2], const pg8::Unit& u, int wr, int wc, int fr, int fq) const {
        { int ln_ = (int)__builtin_amdgcn_mbcnt_hi(~0u, __builtin_amdgcn_mbcnt_lo(~0u, 0u)); asm volatile("" : "+v"(ln_)); fr = ln_ & 15; fq = ln_ >> 4; }
        const int col0 = u.pn * 256 + wc * 32 + 4 * fq;
#pragma unroll
        for (int ai = 0; ai < 2; ++ai) {
            f32x4 hv[4][2][2];
#pragma unroll
            for (int m = 0; m < 4; ++m) {
                int t = 256 * u.pm + 128 * ai + 64 * wr + 16 * m + fr; t = t < T ? t : T - 1;
                const size_t off = (size_t)t * D + col0;
#pragma unroll
                for (int bj = 0; bj < 2; ++bj)
#pragma unroll
                    for (int n = 0; n < 2; ++n) hv[m][bj][n] = *(const f32x4*)(H32 + off + bj * 128 + n * 16);
            }
#pragma unroll
            for (int m = 0; m < 4; ++m) {
                const int t = 256 * u.pm + 128 * ai + 64 * wr + 16 * m + fr;
                if (t < T) {
                    const size_t off = (size_t)t * D + col0;
#pragma unroll
                    for (int bj = 0; bj < 2; ++bj)
#pragma unroll
                        for (int n = 0; n < 2; ++n) *(f32x4*)(Z + off + bj * 128 + n * 16) = acc[ai][bj][m][n] + hv[m][bj][n] * ALPHA;
                }
            }
            asm volatile("" ::: "memory");
        }
    }
};

__device__ __forceinline__ void phase_proj(const Params& p_in, int layer_in, char* smem) {
    const Params p = kparams(); const int layer = opaque_int(layer_in); (void)p_in;
    pg8::Gemm g; g.A = (const bf16_t*)(p.ws + OFF_HB); g.Bt = (const bf16_t*)(p.ws + OFF_WIN) + (size_t)layer * INWP * D; g.M = TP; g.N = INWP; g.K = D;
    pg8::StaticOrder S; S.init(TP, INWP, gridDim.x, opaque_bid());
    EpiProj E; E.ws = p.ws;
    pg8::gemm_phase((LAS unsigned char*)smem, g, S, E);
}
__device__ __forceinline__ void phase_outproj(const Params& p_in, int layer_in, char* smem) {
    const Params p = kparams(); const int layer = opaque_int(layer_in); (void)p_in;
    const bf16_t* MIXp = (const bf16_t*)(p.ws + OFF_MIX);
    const bf16_t* WOUT = (const bf16_t*)(p.ws + OFF_WOUT) + (size_t)layer * D * D;
    const float* H32 = (const float*)(p.ws + OFF_H32);
    float* Z = (float*)(p.ws + OFF_GQ);
    {
        pg8::Gemm g; g.A = MIXp; g.Bt = WOUT; g.M = 16384; g.N = D; g.K = D;
        pg8::StaticOrder S; S.init(16384, D, gridDim.x, opaque_bid());
        EpiOut E; E.H32 = H32; E.Z = Z;
        pg8::gemm_phase((LAS unsigned char*)smem, g, S, E);
    }
    const int tid = opaque_tid(), wid = __builtin_amdgcn_readfirstlane(tid >> 6), lane = tid & 63, fr = lane & 15, fq = lane >> 4;
    for (int task = opaque_bid(); task < 64; task += gridDim.x) {
        const int rg = task >> 3, cs = task & 7;
        const bf16_t* ap = MIXp + (size_t)(16384 + 16 * rg + fr) * D + 8 * fq;
        const bf16_t* bp = WOUT + (size_t)(128 * cs + 16 * wid + fr) * D + 8 * fq;
        f32x4 acc = {0.f, 0.f, 0.f, 0.f};
        bf16x8 a0[8], b0[8], a1[8], b1[8];
#pragma unroll
        for (int k = 0; k < 8; ++k) { a0[k] = *(const bf16x8*)(ap + 32 * k); b0[k] = *(const bf16x8*)(bp + 32 * k); }
#pragma unroll
        for (int ch = 0; ch < 4; ++ch) {
            if (ch < 3) {
#pragma unroll
                for (int k = 0; k < 8; ++k) { a1[k] = *(const bf16x8*)(ap + 256 * (ch + 1) + 32 * k); b1[k] = *(const bf16x8*)(bp + 256 * (ch + 1) + 32 * k); }
            }
#pragma unroll
            for (int k = 0; k < 8; ++k) acc = __builtin_amdgcn_mfma_f32_16x16x32_bf16(a0[k], b0[k], acc, 0, 0, 0);
#pragma unroll
            for (int k = 0; k < 8; ++k) { a0[k] = a1[k]; b0[k] = b1[k]; }
        }
#pragma unroll
        for (int r = 0; r < 4; ++r) {
            const size_t off = (size_t)(16384 + 16 * rg + 4 * fq + r) * D + 128 * cs + 16 * wid + fr;
            Z[off] = acc[r] + ALPHA * H32[off];
        }
    }
}

__device__ __forceinline__ void phase_gla_naive(const Params& p, int layer, char* smem) {
    float (*qs)[64] = (float (*)[64])smem;
    float (*ks)[64] = qs + 8;
    float (*es)[64] = ks + 8;
    float (*part)[8] = (float (*)[8])(es + 8);
    float (*os)[128] = (float (*)[128])(part + 2);
    const int tid = opaque_tid();
    const bf16_t* GQ = (const bf16_t*)(p.ws + OFF_GQ);
    const bf16_t* GK = (const bf16_t*)(p.ws + OFF_GK);
    const bf16_t* GV = (const bf16_t*)(p.ws + OFF_GV);
    const float* GLR = (const float*)(p.ws + OFF_GLR);
    bf16_t* MIX = (bf16_t*)(p.ws + OFF_MIX);
    const float* ng = p.norm_g + layer * 128;
    const float* wg2 = p.wg2 + (size_t)layer * 16 * 256; const float* bg = p.bg + layer * 256;
    for (int item = opaque_bid(); item < NB * 4; item += gridDim.x) {
        const int b = item >> 2, h = item & 3;
        float S[64];
#pragma unroll
        for (int d = 0; d < 64; ++d) S[d] = 0.f;
        const int e = tid & 127;
        const float nge = ng[e];
        const int ltt = tid >> 6, ld = tid & 63;
        float w[16];
#pragma unroll
        for (int rr = 0; rr < 16; ++rr) w[rr] = wg2[rr * 256 + h * 64 + ld];
        const float bgd = bg[h * 64 + ld];
        for (int t0 = 0; t0 < L; t0 += 8) {
            __syncthreads();
            {
                const size_t row = (size_t)b * L + t0 + ltt;
                qs[ltt][ld] = bf2f(GQ[row * 256 + h * 64 + ld]);
                ks[ltt][ld] = bf2f(GK[row * 256 + h * 64 + ld]);
                const float4* gp = (const float4*)&GLR[row * 16];
                const float4 g0 = gp[0], g1 = gp[1], g2 = gp[2], g3 = gp[3];
                float s = bgd;
                s = fmaf(g0.x, w[0], s); s = fmaf(g0.y, w[1], s); s = fmaf(g0.z, w[2], s); s = fmaf(g0.w, w[3], s);
                s = fmaf(g1.x, w[4], s); s = fmaf(g1.y, w[5], s); s = fmaf(g1.z, w[6], s); s = fmaf(g1.w, w[7], s);
                s = fmaf(g2.x, w[8], s); s = fmaf(g2.y, w[9], s); s = fmaf(g2.z, w[10], s); s = fmaf(g2.w, w[11], s);
                s = fmaf(g3.x, w[12], s); s = fmaf(g3.y, w[13], s); s = fmaf(g3.z, w[14], s); s = fmaf(g3.w, w[15], s);
                es[ltt][ld] = expf(logsigmoid_f(s) * (1.f / 16.f));
            }
            __syncthreads();
            if (tid < 128) {
#pragma unroll 1
                for (int tt = 0; tt < 8; ++tt) {
                    const size_t row = (size_t)b * L + t0 + tt;
                    const float v = bf2f(GV[row * 512 + h * 128 + e]);
                    float acc = 0.f;
#pragma unroll
                    for (int d = 0; d < 64; ++d) {
                        S[d] = fmaf(es[tt][d], S[d], ks[tt][d] * v);
                        acc = fmaf(qs[tt][d], S[d], acc);
                    }
                    os[tt][e] = acc;
                    const float ss = wave_sum(acc * acc);
                    if ((tid & 63) == 0) part[tid >> 6][tt] = ss;
                }
            }
            __syncthreads();
            if (tid < 128) {
#pragma unroll 1
                for (int tt = 0; tt < 8; ++tt) {
                    const size_t row = (size_t)b * L + t0 + tt;
                    const float tot = part[0][tt] + part[1][tt];
                    const float rinv = rsqrtf(tot * (1.f / 128) + LN_EPS);
                    const size_t idx = row * 1024 + h * 128 + e;
                    MIX[idx] = f2bf(os[tt][e] * rinv * nge * bf2f(MIX[idx]));
                }
            }
        }
    }
}

__device__ __forceinline__ unsigned okey(float x) {
    const unsigned u = __float_as_uint(x);
    return (u & 0x80000000u) ? ~u : (u | 0x80000000u);
}
__device__ __forceinline__ int wave_incl_scan(int v) {
    const int lane = opaque_tid() & 63;
#pragma unroll
    for (int o = 1; o < 64; o <<= 1) { const int n = __shfl_up(v, o); if (lane >= o) v += n; }
    return v;
}
__device__ __forceinline__ int block_excl_scan(int v, int* tmp) {
    const int incl = wave_incl_scan(v);
    const int tq = opaque_tid();
    __syncthreads();
    if ((tq & 63) == 63) tmp[tq >> 6] = incl;
    __syncthreads();
    const int w = tq >> 6;
    int base = 0;
    for (int i = 0; i < w; ++i) base += tmp[i];
    return base + incl - v;
}
__device__ __forceinline__ void unpack8(const uint4 u, float* kf) {
    kf[0] = __uint_as_float(u.x << 16); kf[1] = __uint_as_float(u.x & 0xFFFF0000u);
    kf[2] = __uint_as_float(u.y << 16); kf[3] = __uint_as_float(u.y & 0xFFFF0000u);
    kf[4] = __uint_as_float(u.z << 16); kf[5] = __uint_as_float(u.z & 0xFFFF0000u);
    kf[6] = __uint_as_float(u.w << 16); kf[7] = __uint_as_float(u.w & 0xFFFF0000u);
}

__device__ __forceinline__ void phase_dsa_naive(const Params& p, int layer, char* smem) {
    float* sc = (float*)smem;
    float (*iqs)[64] = (float (*)[64])(sc + 2080);
    float (*aqs)[64] = iqs + 8;
    float (*lg)[256] = (float (*)[256])(aqs + 8);
    unsigned* hist = (unsigned*)(lg + 8);
    int* sel = (int*)(hist + 256);
    int* misc = sel + 256;
    const int tid = opaque_tid();
    const bf16_t* IQ = (const bf16_t*)(p.ws + OFF_IQ);
    const bf16_t* IK = (const bf16_t*)(p.ws + OFF_IK);
    const float* IW = (const float*)(p.ws + OFF_IW);
    const bf16_t* AQ = (const bf16_t*)(p.ws + OFF_AQ);
    const bf16_t* AK = (const bf16_t*)(p.ws + OFF_AK);
    const bf16_t* AV = (const bf16_t*)(p.ws + OFF_AV);
    bf16_t* MIX = (bf16_t*)(p.ws + OFF_MIX);
    for (int item = opaque_bid(); item < T; item += gridDim.x) {
        const int b = item / L, t = item % L;
        const size_t row = (size_t)item;
        __syncthreads();
        iqs[tid >> 6][tid & 63] = bf2f(IQ[row * 512 + tid]); aqs[tid >> 6][tid & 63] = bf2f(AQ[row * 512 + tid]);
        __syncthreads();
        float w[8];
#pragma unroll
        for (int j = 0; j < 8; ++j) w[j] = IW[row * 8 + j];
        for (int s = tid; s <= t; s += NT) {
            const uint4* kp = (const uint4*)&IK[((size_t)b * L + s) * 64];
            float dd[8];
#pragma unroll
            for (int j = 0; j < 8; ++j) dd[j] = 0.f;
#pragma unroll 1
            for (int q = 0; q < 8; ++q) {
                float kf[8]; unpack8(kp[q], kf);
#pragma unroll
                for (int j = 0; j < 8; ++j) {
                    const float4 a0 = *(const float4*)&iqs[j][q * 8], a1 = *(const float4*)&iqs[j][q * 8 + 4];
                    dd[j] = fmaf(a0.x, kf[0], dd[j]); dd[j] = fmaf(a0.y, kf[1], dd[j]); dd[j] = fmaf(a0.z, kf[2], dd[j]); dd[j] = fmaf(a0.w, kf[3], dd[j]);
                    dd[j] = fmaf(a1.x, kf[4], dd[j]); dd[j] = fmaf(a1.y, kf[5], dd[j]); dd[j] = fmaf(a1.z, kf[6], dd[j]); dd[j] = fmaf(a1.w, kf[7], dd[j]);
                }
            }
            float score = 0.f;
#pragma unroll
            for (int j = 0; j < 8; ++j) score = fmaf(w[j], fmaxf(dd[j], 0.f), score);
            sc[s] = score;
        }
        __syncthreads();
        const int n = t + 1;
        int nsel;
        if (n <= TOPK) {
            if (tid < n) sel[tid] = tid;
            nsel = n;
        } else {
            unsigned prefix = 0; int remaining = TOPK;
            for (int pass = 0; pass < 4; ++pass) {
                const int shift = 24 - 8 * pass;
                if (tid < 256) hist[tid] = 0;
                __syncthreads();
                for (int s = tid; s < n; s += NT) {
                    const unsigned key = okey(sc[s]);
                    const bool match = (pass == 0) || ((key >> (shift + 8)) == prefix);
                    if (match) atomicAdd(&hist[(key >> shift) & 255u], 1u);
                }
                __syncthreads();
                if (tid == 0) {
                    int cum = 0, d = 255;
                    for (; d > 0; --d) { const int c = (int)hist[d]; if (cum + c >= remaining) break; cum += c; }
                    misc[0] = d; misc[1] = remaining - cum;
                }
                __syncthreads();
                prefix = (prefix << 8) | (unsigned)misc[0]; remaining = misc[1];
                __syncthreads();
            }
            const int s0 = tid * 5;
            int ceq = 0;
#pragma unroll
            for (int q = 0; q < 5; ++q) { const int s = s0 + q; if (s < n && okey(sc[s]) == prefix) ++ceq; }
            int eqrank = block_excl_scan(ceq, misc + 8);
            int csel = 0; unsigned selmask = 0;
#pragma unroll
            for (int q = 0; q < 5; ++q) {
                const int s = s0 + q;
                if (s < n) {
                    const unsigned key = okey(sc[s]);
                    bool take = key > prefix;
                    if (key == prefix) { take = eqrank < remaining; ++eqrank; }
                    if (take) { ++csel; selmask |= 1u << q; }
                }
            }
            int posn = block_excl_scan(csel, misc + 16);
#pragma unroll
            for (int q = 0; q < 5; ++q) if (selmask & (1u << q)) { if (posn < TOPK) sel[posn] = s0 + q; ++posn; }
            nsel = TOPK;
        }
        __syncthreads();
        {
            const int i = tid & 255, g = tid >> 8;
            if (i < nsel) {
                const int kidx = sel[i];
                const uint4* kp = (const uint4*)&AK[((size_t)b * L + kidx) * 128 + g * 64];
                float dd[4] = {0.f, 0.f, 0.f, 0.f};
#pragma unroll 1
                for (int q = 0; q < 8; ++q) {
                    float kf[8]; unpack8(kp[q], kf);
#pragma unroll
                    for (int r = 0; r < 4; ++r) {
                        const float4 a0 = *(const float4*)&aqs[g * 4 + r][q * 8], a1 = *(const float4*)&aqs[g * 4 + r][q * 8 + 4];
                        dd[r] = fmaf(a0.x, kf[0], dd[r]); dd[r] = fmaf(a0.y, kf[1], dd[r]); dd[r] = fmaf(a0.z, kf[2], dd[r]); dd[r] = fmaf(a0.w, kf[3], dd[r]);
                        dd[r] = fmaf(a1.x, kf[4], dd[r]); dd[r] = fmaf(a1.y, kf[5], dd[r]); dd[r] = fmaf(a1.z, kf[6], dd[r]); dd[r] = fmaf(a1.w, kf[7], dd[r]);
                    }
                }
#pragma unroll
                for (int r = 0; r < 4; ++r) lg[g * 4 + r][i] = dd[r];
            } else {
#pragma unroll
                for (int r = 0; r < 4; ++r) lg[g * 4 + r][i] = -INFINITY;
            }
        }
        __syncthreads();
        {
            const int h = tid >> 6, lane = tid & 63;
            float v0 = lg[h][lane], v1 = lg[h][lane + 64], v2 = lg[h][lane + 128], v3 = lg[h][lane + 192];
            const float m = wave_max(fmaxf(fmaxf(v0, v1), fmaxf(v2, v3)));
            v0 = expf(v0 - m); v1 = expf(v1 - m); v2 = expf(v2 - m); v3 = expf(v3 - m);
            const float inv = 1.f / wave_sum(v0 + v1 + v2 + v3);
            lg[h][lane] = v0 * inv; lg[h][lane + 64] = v1 * inv; lg[h][lane + 128] = v2 * inv; lg[h][lane + 192] = v3 * inv;
        }
        __syncthreads();
        {
            const int h = tid >> 6, d = tid & 63, g = h >> 2;
            float o = 0.f;
            for (int i = 0; i < nsel; ++i) o = fmaf(lg[h][i], bf2f(AV[((size_t)b * L + sel[i]) * 128 + g * 64 + d]), o);
            const size_t mi = row * 1024 + 512 + tid;
            MIX[mi] = f2bf(o * bf2f(MIX[mi]));
        }
    }
}


constexpr int DS_SC = 0, DS_BITS = 134144, DS_HIST = DS_BITS + 4224, DS_CAND = DS_HIST + 8 * 1040, DS_END = DS_CAND + 8 * 512;
constexpr int DS_TAB = 65536, DS_CONST = DS_TAB + 2112 * 32;
static_assert(DS_CONST + 32 <= DS_BITS, "bias table overlaps bitmask");


template <int NR>
__device__ __forceinline__ void dsa_select(const LAS unsigned* row, LAS unsigned* bits, LAS unsigned* hist, int n, int lane) {
    unsigned kreg[NR];
#pragma unroll
    for (int i = 0; i < NR; ++i) kreg[i] = (lane < n - 64 * i) ? okey(__uint_as_float(row[lane + 64 * i])) : 0u;
    unsigned prefix = 0; int remaining = TOPK;
#pragma unroll 1
    for (int pass = 0; pass < 4; ++pass) {
        const int shift = 24 - 8 * pass;
        *(LAS u32x4*)(hist + lane * 4) = (u32x4){0u, 0u, 0u, 0u};
        __builtin_amdgcn_wave_barrier(); asm volatile("" ::: "memory");
        const unsigned sh8 = (unsigned)(shift + 8) & 31u;
#pragma unroll
        for (int i = 0; i < NR; ++i) {
            const unsigned key = kreg[i];
            const bool match = (lane < n - 64 * i) && ((pass == 0) || ((key >> sh8) == prefix));
            if (match) __hip_atomic_fetch_add(hist + ((key >> shift) & 255u), 1u, __ATOMIC_RELAXED, __HIP_MEMORY_SCOPE_WAVEFRONT);
        }
        __builtin_amdgcn_wave_barrier(); asm volatile("s_waitcnt lgkmcnt(0)" ::: "memory");
        const u32x4 hv = *(const LAS u32x4*)(hist + (63 - lane) * 4);
        const int c0 = (int)hv[3], c1 = (int)hv[2], c2 = (int)hv[1], c3 = (int)hv[0];
        const int tot = c0 + c1 + c2 + c3;
        const int incl = wave_incl_scan(tot), excl = incl - tot;
        const bool found = (excl < remaining) && (remaining <= incl);
        int digit = 0, rem_new = 0;
        if (found) {
            int cum = excl;
            if (cum + c0 >= remaining) { digit = 255 - 4 * lane; rem_new = remaining - cum; }
            else { cum += c0;
                if (cum + c1 >= remaining) { digit = 254 - 4 * lane; rem_new = remaining - cum; }
                else { cum += c1;
                    if (cum + c2 >= remaining) { digit = 253 - 4 * lane; rem_new = remaining - cum; }
                    else { cum += c2; digit = 252 - 4 * lane; rem_new = remaining - cum; } } }
        }
        const unsigned long long fm = __ballot(found);
        const int src = (int)__builtin_ctzll(fm);
        digit = __builtin_amdgcn_readlane(digit, src); rem_new = __builtin_amdgcn_readlane(rem_new, src);
        prefix = (prefix << 8) | (unsigned)digit; remaining = rem_new;
    }
    const unsigned tkey = prefix;
    int eqcount = 0;
#pragma unroll
    for (int i = 0; i < 33; ++i) {
        if (i < NR) {
            const unsigned key = kreg[i < NR ? i : 0];
            const bool valid = lane < n - 64 * i;
            const bool gt = valid && (key > tkey), eq = valid && (key == tkey);
            const unsigned long long em = __ballot(eq);
            const int rank = eqcount + __popcll(em & ((1ull << lane) - 1ull));
            const bool sel = gt || (eq && rank < remaining);
            eqcount += __popcll(em);
            const unsigned long long sm = __ballot(sel);
            if (lane == 0) { bits[2 * i] = (unsigned)sm; bits[2 * i + 1] = (unsigned)(sm >> 32); }
        } else if (lane == 0) { bits[2 * i] = 0u; bits[2 * i + 1] = 0u; }
    }
}


template <int NR>
__device__ __forceinline__ bool dsa_select_v(const LAS unsigned* row, LAS unsigned* bits, LAS unsigned* hist, LAS unsigned* cand, int n, int lane) {
    float x[NR];
    const float qnan = __uint_as_float(0x7FC00000u);
#pragma unroll
    for (int i = 0; i < NR; ++i) x[i] = (lane < n - 64 * i) ? __uint_as_float(row[lane + 64 * i]) : qnan;
    float mn = x[0], mx = x[0];
#pragma unroll
    for (int i = 1; i < NR; ++i) { mn = fminf(mn, x[i]); mx = fmaxf(mx, x[i]); }
#pragma unroll
    for (int o = 32; o > 0; o >>= 1) { mn = fminf(mn, __shfl_xor(mn, o)); mx = fmaxf(mx, __shfl_xor(mx, o)); }
    bool ok = mx > mn;
    const float scale = 255.f / (mx - mn) * 0.99999f;
    int dstar = 0, rem = 0, cb = 0;
    if (ok) {
        *(LAS u32x4*)(hist + lane * 4) = (u32x4){0u, 0u, 0u, 0u};
        __builtin_amdgcn_wave_barrier(); asm volatile("" ::: "memory");
#pragma unroll
        for (int i = 0; i < NR; ++i) {
            const float xv = x[i];
            if (xv == xv) __hip_atomic_fetch_add(hist + (unsigned)(int)((xv - mn) * scale), 1u, __ATOMIC_RELAXED, __HIP_MEMORY_SCOPE_WAVEFRONT);
        }
        __builtin_amdgcn_wave_barrier(); asm volatile("s_waitcnt lgkmcnt(0)" ::: "memory");
        const u32x4 hv = *(const LAS u32x4*)(hist + (63 - lane) * 4);
        const int c0 = (int)hv[3], c1 = (int)hv[2], c2 = (int)hv[1], c3 = (int)hv[0];
        const int tot = c0 + c1 + c2 + c3;
        const int incl = wave_incl_scan(tot), excl = incl - tot;
        const bool found = (excl < TOPK) && (TOPK <= incl);
        int digit = 0, rem_new = 0, cnt = 0;
        if (found) {
            int cum = excl;
            if (cum + c0 >= TOPK) { digit = 255 - 4 * lane; rem_new = TOPK - cum; cnt = c0; }
            else { cum += c0;
                if (cum + c1 >= TOPK) { digit = 254 - 4 * lane; rem_new = TOPK - cum; cnt = c1; }
                else { cum += c1;
                    if (cum + c2 >= TOPK) { digit = 253 - 4 * lane; rem_new = TOPK - cum; cnt = c2; }
                    else { cum += c2; digit = 252 - 4 * lane; rem_new = TOPK - cum; cnt = c3; } } }
        }
        const unsigned long long fm = __ballot(found);
        const int src = (int)__builtin_ctzll(fm | (1ull << 63));
        dstar = __builtin_amdgcn_readlane(digit, src); rem = __builtin_amdgcn_readlane(rem_new, src); cb = __builtin_amdgcn_readlane(cnt, src);
        ok = (fm != 0ull) && (cb <= 64);
    }
    if (!ok) return false;
    int base = 0;
#pragma unroll
    for (int i = 0; i < NR; ++i) {
        const float xv = x[i];
        const bool inb = (xv == xv) && ((int)((xv - mn) * scale) == dstar);
        const unsigned long long bm = __ballot(inb);
        if (bm != 0ull) {
            if (inb) { const int pos = base + __popcll(bm & ((1ull << lane) - 1ull)); cand[2 * pos] = __float_as_uint(xv); cand[2 * pos + 1] = (unsigned)(lane + 64 * i); }
            base += __popcll(bm);
        }
    }
    __builtin_amdgcn_wave_barrier(); asm volatile("s_waitcnt lgkmcnt(0)" ::: "memory");
    float xc = qnan; int ic = 0x7fffffff;
    if (lane < cb) { xc = __uint_as_float(cand[2 * lane]); ic = (int)cand[2 * lane + 1]; }
    int rank = 0;
    for (int j = 0; j < cb; ++j) {
        const float xj = __builtin_bit_cast(float, __builtin_amdgcn_readlane(__builtin_bit_cast(int, xc), j));
        const int ij = __builtin_amdgcn_readlane(ic, j);
        rank += ((xj > xc) || (xj == xc && ij < ic)) ? 1 : 0;
    }
    const unsigned long long tm = __ballot((lane < cb) && (rank == rem - 1));
    const int tl = (int)__builtin_ctzll(tm | (1ull << 63));
    const float tx = __builtin_bit_cast(float, __builtin_amdgcn_readlane(__builtin_bit_cast(int, xc), tl));
    const int ti = __builtin_amdgcn_readlane(ic, tl);
#pragma unroll
    for (int i = 0; i < 33; ++i) {
        if (i < NR) {
            const float xv = x[i < NR ? i : 0];
            const bool sel = (xv > tx) || (xv == tx && (lane + 64 * i) <= ti);
            const unsigned long long sm = __ballot(sel);
            if (lane == 0) { bits[2 * i] = (unsigned)sm; bits[2 * i + 1] = (unsigned)(sm >> 32); }
        } else if (lane == 0) { bits[2 * i] = 0u; bits[2 * i + 1] = 0u; }
    }
    return true;
}

__device__ __forceinline__ void phase_dsa(const Params& p_in, int layer_in, char* smem, bool do_store) {
    const Params p = kparams(); const int layer = opaque_int(layer_in); (void)p_in;
    const int tid = opaque_tid(), wid = __builtin_amdgcn_readfirstlane(tid >> 6), lane_ = tid & 63, fr_ = lane_ & 15, fq_ = lane_ >> 4;
    LAS unsigned char* lds = (LAS unsigned char*)smem;
    const bf16_t* IQ = (const bf16_t*)(p.ws + OFF_IQ);
    const bf16_t* IK = (const bf16_t*)(p.ws + OFF_IK);
    const float* IW = (const float*)(p.ws + OFF_IW);
    const bf16_t* AQ = (const bf16_t*)(p.ws + OFF_AQ);
    const bf16_t* AK = (const bf16_t*)(p.ws + OFF_AK);
    const bf16_t* AVT = (const bf16_t*)(p.ws + OFF_AV);
    bf16_t* MIX = (bf16_t*)(p.ws + OFF_MIX);
    constexpr int NITEM = NB * 129;
    for (int idx = opaque_bid(); idx < NITEM; idx += gridDim.x) {
        const int b = idx & 7, mm = idx >> 3;
        int qr;
        { const int seg = mm >> 5, jj = mm & 31; qr = (seg == 0) ? jj : (seg == 1) ? 63 - jj : (seg == 2) ? 64 + jj : (seg == 3) ? 127 - jj : 128; }
        const int qt = 128 - qr, t0 = qt * 16;
        __syncthreads();
        for (int repA = 0; repA < PROBE_DSA_A; ++repA) {
            int fr = fr_, fq = fq_; asm volatile("" : "+v"(fr), "+v"(fq));
            const size_t rowq = (size_t)b * L + t0 + fr;
            bf16x8 qf[8][2];
#pragma unroll
            for (int jh = 0; jh < 8; ++jh)
#pragma unroll
                for (int s2 = 0; s2 < 2; ++s2) qf[jh][s2] = *(const bf16x8*)(IQ + rowq * 512 + jh * 64 + s2 * 32 + fq * 8);
            float w[8];
            { const f32x4 w0 = *(const f32x4*)(IW + rowq * 8), w1 = *(const f32x4*)(IW + rowq * 8 + 4);
              w[0] = w0[0]; w[1] = w0[1]; w[2] = w0[2]; w[3] = w0[3]; w[4] = w1[0]; w[5] = w1[1]; w[6] = w1[2]; w[7] = w1[3]; }
            const int ntile = qt + 1;
            const bf16x8 z8 = {0, 0, 0, 0, 0, 0, 0, 0};
            bf16x8 ka0 = z8, ka1 = z8, kb0 = z8, kb1 = z8, kc0 = z8, kc1 = z8;
            int kt = wid;
            if (kt < ntile) { const bf16_t* kp = IK + ((size_t)b * L + 16 * kt + fr) * 64 + fq * 8; ka0 = *(const bf16x8*)kp; ka1 = *(const bf16x8*)(kp + 32); }
            if (kt + 8 < ntile) { const bf16_t* kp = IK + ((size_t)b * L + 16 * (kt + 8) + fr) * 64 + fq * 8; kb0 = *(const bf16x8*)kp; kb1 = *(const bf16x8*)(kp + 32); }
            for (; kt < ntile; kt += 8) {
                if (kt + 16 < ntile) { const bf16_t* kp = IK + ((size_t)b * L + 16 * (kt + 16) + fr) * 64 + fq * 8; kc0 = *(const bf16x8*)kp; kc1 = *(const bf16x8*)(kp + 32); }
                f32x4 sc = {0.f, 0.f, 0.f, 0.f};
#pragma unroll
                for (int jh = 0; jh < 8; ++jh) {
                    f32x4 d = {0.f, 0.f, 0.f, 0.f};
                    d = __builtin_amdgcn_mfma_f32_16x16x32_bf16(ka0, qf[jh][0], d, 0, 0, 0);
                    d = __builtin_amdgcn_mfma_f32_16x16x32_bf16(ka1, qf[jh][1], d, 0, 0, 0);
#pragma unroll
                    for (int r = 0; r < 4; ++r) sc[r] = fmaf(w[jh], fmaxf(d[r], 0.f), sc[r]);
                }
                *(LAS f32x4*)(lds + DS_SC + (fr * 2064 + 16 * kt + 4 * fq) * 4) = sc;
                ka0 = kb0; ka1 = kb1; kb0 = kc0; kb1 = kc1;
            }
        }
        __syncthreads();
        for (int repB = 0; repB < PROBE_DSA_B; ++repB) {
            int lane = lane_; asm volatile("" : "+v"(lane));
            LAS unsigned* hist = (LAS unsigned*)(lds + DS_HIST + wid * 1040);
#pragma unroll 1
            for (int qq = 0; qq < 2; ++qq) {
                const int q = wid * 2 + qq;
                const int n = t0 + q + 1;
                const LAS unsigned* row = (const LAS unsigned*)(lds + DS_SC) + q * 2064;
                LAS unsigned* bits = (LAS unsigned*)(lds + DS_BITS) + q * 66;
                if (n <= TOPK) {
#pragma unroll 1
                    for (int i = 0; i < 33; ++i) {
                        const unsigned long long sm = __ballot(lane + 64 * i < n);
                        if (lane == 0) { bits[2 * i] = (unsigned)sm; bits[2 * i + 1] = (unsigned)(sm >> 32); }
                    }
                } else {
                    const int nr = (n + 63) >> 6;
                    LAS unsigned* cand = (LAS unsigned*)(lds + DS_CAND + wid * 512);
                    bool done;
                    if (nr <= 9) done = dsa_select_v<9>(row, bits, hist, cand, n, lane);
                    else if (nr <= 17) done = dsa_select_v<17>(row, bits, hist, cand, n, lane);
                    else if (nr <= 25) done = dsa_select_v<25>(row, bits, hist, cand, n, lane);
                    else done = dsa_select_v<33>(row, bits, hist, cand, n, lane);
                    if (!done) dsa_select<33>(row, bits, hist, n, lane);
                }
            }
        }
        __syncthreads();
        for (int repC = 0; repC < PROBE_DSA_C; ++repC) {
            if (repC > 0) __syncthreads();
            int fr = fr_, fq = fq_, lane = lane_; asm volatile("" : "+v"(fr), "+v"(fq), "+v"(lane));
            const size_t rowq = (size_t)b * L + t0 + fr;
            const int h = wid, g = h >> 2;
            const int nstep = (t0 + 16 + 63) >> 6;
            bf16x8 aqf[2];
            aqf[0] = *(const bf16x8*)(AQ + rowq * 512 + h * 64 + fq * 8);
            aqf[1] = *(const bf16x8*)(AQ + rowq * 512 + h * 64 + 32 + fq * 8);
            asm volatile("" : "+v"(aqf[0]), "+v"(aqf[1]));
            const int drow = 8 * wid + (lane >> 3);
            const int kch = (lane & 7) ^ (2 * ((drow >> 3) & 3) + ((drow >> 1) & 1)), vch = (lane & 7) ^ ((drow >> 1) & 7);
            const bf16_t* vsrc0 = AVT + ((size_t)b * 128 + drow) * LP + vch * 8;
#define DSA_DMA(st_, buf_) do { \
                int krow_ = b * L + 64 * (st_) + drow; krow_ = krow_ < T ? krow_ : T - 1; \
                const bf16_t* ks_ = AK + (size_t)krow_ * 128 + kch * 8; \
                LAS unsigned char* lb_ = lds + (buf_) * 32768 + wid * 1024; \
                __builtin_amdgcn_global_load_lds((const unsigned*)ks_, (LAS unsigned*)lb_, 16, 0, 0); \
                __builtin_amdgcn_global_load_lds((const unsigned*)(ks_ + 64), (LAS unsigned*)(lb_ + 8192), 16, 0, 0); \
                __builtin_amdgcn_global_load_lds((const unsigned*)(vsrc0 + 64 * (st_)), (LAS unsigned*)(lb_ + 16384), 16, 0, 0); \
                __builtin_amdgcn_global_load_lds((const unsigned*)(vsrc0 + (size_t)64 * LP + 64 * (st_)), (LAS unsigned*)(lb_ + 24576), 16, 0, 0); } while (0)
            DSA_DMA(0, 0);
            unsigned nb_lo = 0xC6EAu, nb_hi = 0xC6EA0000u; asm volatile("" : "+v"(nb_lo), "+v"(nb_hi));
            for (int key = tid; key < 2112; key += NT) {
                const int w32 = key & 31;
                const int R = (key >> 5) * 32 + ((w32 >> 2) & 1) * 16 + 4 * (w32 >> 3) + (w32 & 3);
                u32x4 lo, hi;
#pragma unroll
                for (int qp = 0; qp < 8; ++qp) {
                    const unsigned b0 = (*((const LAS unsigned*)(lds + DS_BITS) + (2 * qp) * 66 + (key >> 5)) >> w32) & 1u;
                    const unsigned b1 = (*((const LAS unsigned*)(lds + DS_BITS) + (2 * qp + 1) * 66 + (key >> 5)) >> w32) & 1u;
                    const unsigned v = (b0 ? 0u : nb_lo) | (b1 ? 0u : nb_hi);
                    if (qp < 4) lo[qp] = v; else hi[qp - 4] = v;
                }
                *(LAS u32x4*)(lds + DS_TAB + R * 32) = lo; *(LAS u32x4*)(lds + DS_TAB + R * 32 + 16) = hi;
            }
            if (tid < 8) *((LAS unsigned*)(lds + DS_CONST) + tid) = (tid == 0) ? 0x00003F80u : 0u;
            const int swzk = 2 * (fr >> 2) + ((fr >> 1) & 1);
            const int krow0 = 8 * (fr >> 2) + (fr & 3);
            const int tab_base = (fq < 2) ? DS_TAB + fr * 32 + 16 * fq : DS_CONST + 16 * (fq - 2);
            const int tab_mul = (fq < 2) ? 512 : 0;
            u32x4 bqw = {0u, 0u, 0u, 0u};
            if (fq < 2 && (fr >> 3) == fq) { const int j = fr & 7; bqw[j >> 1] = (j & 1) ? 0x3F800000u : 0x00003F80u; }
            u32x4 onw = {0u, 0u, 0u, 0u};
            if (fr == 0) onw = (u32x4){0x3F803F80u, 0x3F803F80u, 0x3F803F80u, 0x3F803F80u};
            const bf16x8 onesA = __builtin_bit_cast(bf16x8, onw);
            asm volatile("s_waitcnt vmcnt(0) lgkmcnt(0)" ::: "memory");
            __builtin_amdgcn_s_barrier();
            asm volatile("" ::: "memory");
            f32x4 O[4], O5 = {0.f, 0.f, 0.f, 0.f};
#pragma unroll
            for (int dt = 0; dt < 4; ++dt) O[dt] = (f32x4){0.f, 0.f, 0.f, 0.f};
            float mt = 0.f;
            for (int st = 0; st < nstep; ++st) {
                const int buf = st & 1;
                {
                    const int sn = (st + 1 < nstep) ? st + 1 : nstep - 1;
                    DSA_DMA(sn, buf ^ 1);
                }
                const LAS unsigned char* sb = lds + buf * 32768;
                const bf16x8 bq = __builtin_bit_cast(bf16x8, bqw);
                f32x4 S[4];
#pragma unroll
                for (int kt = 0; kt < 4; ++kt) {
                    const int rowk = krow0 + 32 * (kt >> 1) + 4 * (kt & 1);
                    const bf16x8 bias = *(const LAS bf16x8*)(lds + tab_base + (4 * st + kt) * tab_mul);
                    S[kt] = __builtin_amdgcn_mfma_f32_16x16x32_bf16(bias, bq, (f32x4){0.f, 0.f, 0.f, 0.f}, 0, 0, 0);
#pragma unroll
                    for (int s2 = 0; s2 < 2; ++s2) {
                        const bf16x8 kf = *(const LAS bf16x8*)(sb + g * 8192 + rowk * 128 + 16 * ((4 * s2 + fq) ^ swzk));
                        S[kt] = __builtin_amdgcn_mfma_f32_16x16x32_bf16(kf, aqf[s2], S[kt], 0, 0, 0);
                    }
                }
                float pmax = fmaxf(fmaxf(S[0][0], S[0][1]), S[0][2]);
                pmax = fmaxf(fmaxf(pmax, S[0][3]), S[1][0]); pmax = fmaxf(fmaxf(pmax, S[1][1]), S[1][2]); pmax = fmaxf(fmaxf(pmax, S[1][3]), S[2][0]);
                pmax = fmaxf(fmaxf(pmax, S[2][1]), S[2][2]); pmax = fmaxf(fmaxf(pmax, S[2][3]), S[3][0]); pmax = fmaxf(fmaxf(pmax, S[3][1]), S[3][2]);
                pmax = fmaxf(pmax, S[3][3]);
                if (st == 0 || __any(pmax > 11.5f)) {
                    float pm = fmaxf(pmax, __shfl_xor(pmax, 16)); pm = fmaxf(pm, __shfl_xor(pm, 32));
                    const float up = (st == 0) ? fmaxf(pm, -64.f) : fmaxf(pm, 0.f);
                    const float mn = __uint_as_float((unsigned)f2bf(mt + up) << 16);
                    const float dlt = mt - mn;
                    const float alpha = __builtin_amdgcn_exp2f(dlt);
#pragma unroll
                    for (int dt = 0; dt < 4; ++dt) O[dt] *= alpha;
                    O5 *= alpha;
#pragma unroll
                    for (int kt = 0; kt < 4; ++kt) S[kt] += dlt;
                    mt = mn;
                    if (fq == 2) bqw[0] = (unsigned)f2bf(-mt);
                }
                unsigned pk[4][2];
#pragma unroll
                for (int kt = 0; kt < 4; ++kt) {
                    const float e0 = __builtin_amdgcn_exp2f(S[kt][0]), e1 = __builtin_amdgcn_exp2f(S[kt][1]), e2 = __builtin_amdgcn_exp2f(S[kt][2]), e3 = __builtin_amdgcn_exp2f(S[kt][3]);
                    pk[kt][0] = cvt_pk_bf16(e0, e1); pk[kt][1] = cvt_pk_bf16(e2, e3);
                }
#pragma unroll
                for (int ks = 0; ks < 2; ++ks) {
                    u32x4 pw; pw[0] = pk[2 * ks][0]; pw[1] = pk[2 * ks][1]; pw[2] = pk[2 * ks + 1][0]; pw[3] = pk[2 * ks + 1][1];
                    const bf16x8 pf = __builtin_bit_cast(bf16x8, pw);
                    O5 = __builtin_amdgcn_mfma_f32_16x16x32_bf16(onesA, pf, O5, 0, 0, 0);
#pragma unroll
                    for (int dt = 0; dt < 4; ++dt) {
                        const int rowv = 16 * dt + fr;
                        const bf16x8 vf = *(const LAS bf16x8*)(sb + 16384 + g * 8192 + rowv * 128 + 16 * ((4 * ks + fq) ^ ((rowv >> 1) & 7)));
                        O[dt] = __builtin_amdgcn_mfma_f32_16x16x32_bf16(vf, pf, O[dt], 0, 0, 0);
                    }
                }
                asm volatile("s_waitcnt vmcnt(0)" ::: "memory");
                __builtin_amdgcn_s_barrier();
                asm volatile("" ::: "memory");
            }
#undef DSA_DMA
            const float l = __shfl(O5[0], fr);
            const float inv = 1.f / fmaxf(l, 1e-30f);
            bf16_t* mp = MIX + rowq * 1024 + 512 + h * 64 + 4 * fq;
            if (do_store && repC == PROBE_DSA_C - 1)
#pragma unroll
            for (int dt = 0; dt < 4; ++dt) {
                const uint2 gz = *(const uint2*)(mp + 16 * dt);
                const float g0 = __uint_as_float(gz.x << 16), g1 = __uint_as_float(gz.x & 0xFFFF0000u), g2 = __uint_as_float(gz.y << 16), g3 = __uint_as_float(gz.y & 0xFFFF0000u);
                uint2 o; o.x = cvt_pk_bf16(O[dt][0] * inv * g0, O[dt][1] * inv * g1); o.y = cvt_pk_bf16(O[dt][2] * inv * g2, O[dt][3] * inv * g3);
                *(uint2*)(mp + 16 * dt) = o;
            }
        }
    }
}

__device__ __forceinline__ void rope16(const u32x4 a, const u32x4 b, const float2* rp, u32x4& oa, u32x4& ob) {
    const f32x4 r0 = *(const f32x4*)(rp), r1 = *(const f32x4*)(rp + 2), r2 = *(const f32x4*)(rp + 4), r3 = *(const f32x4*)(rp + 6);
    const float cs[8] = {r0[0], r0[2], r1[0], r1[2], r2[0], r2[2], r3[0], r3[2]};
    const float sn[8] = {r0[1], r0[3], r1[1], r1[3], r2[1], r2[3], r3[1], r3[3]};
    float o1[8], o2[8];
#pragma unroll
    for (int i = 0; i < 4; ++i) {
        const float x1l = __uint_as_float(a[i] << 16), x1h = __uint_as_float(a[i] & 0xFFFF0000u);
        const float x2l = __uint_as_float(b[i] << 16), x2h = __uint_as_float(b[i] & 0xFFFF0000u);
        o1[2 * i] = x1l * cs[2 * i] - x2l * sn[2 * i]; o1[2 * i + 1] = x1h * cs[2 * i + 1] - x2h * sn[2 * i + 1];
        o2[2 * i] = x2l * cs[2 * i] + x1l * sn[2 * i]; o2[2 * i + 1] = x2h * cs[2 * i + 1] + x1h * sn[2 * i + 1];
    }
#pragma unroll
    for (int i = 0; i < 4; ++i) { oa[i] = cvt_pk_bf16(o1[2 * i], o1[2 * i + 1]); ob[i] = cvt_pk_bf16(o2[2 * i], o2[2 * i + 1]); }
}
__device__ __forceinline__ void phase_rope(const Params& p_in, int layer_in, char* smem) {
    const Params p = kparams(); const int layer = opaque_int(layer_in); (void)p_in;
    const int tid = opaque_tid();
    const float2* ROPE = (const float2*)(p.ws + OFF_ROPE);
    const int nthr = gridDim.x * NT, gid = opaque_bid() * NT + tid;
    for (int th = gid; th < T * 18; th += nthr) {
        const int t = th / 18, hh = th - t * 18, pos = t % L;
        bf16_t* base = (hh < 8) ? (bf16_t*)(p.ws + OFF_AQ) + (size_t)t * 512 + hh * 64
                     : (hh < 16) ? (bf16_t*)(p.ws + OFF_IQ) + (size_t)t * 512 + (hh - 8) * 64
                                 : (bf16_t*)(p.ws + OFF_AK) + (size_t)t * 128 + (hh - 16) * 64;
        const u32x4 a = *(const u32x4*)base, b = *(const u32x4*)(base + 8);
        u32x4 oa, ob; rope16(a, b, ROPE + pos * 8, oa, ob);
        *(u32x4*)base = oa; *(u32x4*)(base + 8) = ob;
    }
    const float* IKR = (const float*)(p.ws + OFF_IKR);
    bf16_t* IK = (bf16_t*)(p.ws + OFF_IK);
    const float* ikg = p.ikg + layer * 64; const float* ikb = p.ikb + layer * 64;
    for (int t = gid; t < T; t += nthr) {
        const int pos = t % L;
        f32x4 x[16];
#pragma unroll
        for (int i = 0; i < 16; ++i) x[i] = *(const f32x4*)(IKR + (size_t)t * 64 + 4 * i);
        float sm = 0.f;
#pragma unroll
        for (int i = 0; i < 16; ++i) sm += (x[i][0] + x[i][1]) + (x[i][2] + x[i][3]);
        const float mu = sm * (1.f / 64);
        float qq = 0.f;
#pragma unroll
        for (int i = 0; i < 16; ++i) { const f32x4 d = x[i] - mu; qq += (d[0] * d[0] + d[1] * d[1]) + (d[2] * d[2] + d[3] * d[3]); }
        const float rs = rsqrtf(qq * (1.f / 64) + LN_EPS);
#pragma unroll
        for (int i = 0; i < 16; ++i) { const f32x4 g = *(const f32x4*)(ikg + 4 * i), bb = *(const f32x4*)(ikb + 4 * i); x[i] = (x[i] - mu) * rs * g + bb; }
        const float2* rp = ROPE + pos * 8;
        const f32x4 r0 = *(const f32x4*)(rp), r1 = *(const f32x4*)(rp + 2), r2 = *(const f32x4*)(rp + 4), r3 = *(const f32x4*)(rp + 6);
        const float cs[8] = {r0[0], r0[2], r1[0], r1[2], r2[0], r2[2], r3[0], r3[2]};
        const float sn[8] = {r0[1], r0[3], r1[1], r1[3], r2[1], r2[3], r3[1], r3[3]};
#pragma unroll
        for (int i = 0; i < 8; ++i) {
            const float x1 = x[i >> 2][i & 3], x2 = x[2 + (i >> 2)][i & 3];
            x[i >> 2][i & 3] = x1 * cs[i] - x2 * sn[i];
            x[2 + (i >> 2)][i & 3] = x2 * cs[i] + x1 * sn[i];
        }
#pragma unroll
        for (int i = 0; i < 8; ++i) {
            u32x4 o; o[0] = cvt_pk_bf16(x[2 * i][0], x[2 * i][1]); o[1] = cvt_pk_bf16(x[2 * i][2], x[2 * i][3]); o[2] = cvt_pk_bf16(x[2 * i + 1][0], x[2 * i + 1][1]); o[3] = cvt_pk_bf16(x[2 * i + 1][2], x[2 * i + 1][3]);
            *(u32x4*)(IK + (size_t)t * 64 + 8 * i) = o;
        }
    }
}

constexpr int GL_QE = 0, GL_KN = 8192, GL_SEG = 16384, GL_PART = 18432;
__device__ __forceinline__ void gla_cumsum(const Params& p, int layer, int b, int h, int c, int tid, LAS unsigned char* lds, float (&bc)[8], float& blast) {
    const int d = tid & 63, seg = tid >> 6;
    const float* wg2 = p.wg2 + (size_t)layer * 16 * 256 + h * 64 + d;
    float w[16];
#pragma unroll
    for (int rr = 0; rr < 16; ++rr) w[rr] = wg2[rr * 256];
    const float bgd = p.bg[layer * 256 + h * 64 + d];
    const float* GLR = (const float*)(p.ws + OFF_GLR);
    float pb = 0.f;
#pragma unroll
    for (int i = 0; i < 8; ++i) {
        const int pos = 64 * c - 48 + 8 * seg + i;
        float gl = 0.f;
        if (pos >= 0) {
            const f32x4* gp = (const f32x4*)(GLR + ((size_t)b * L + pos) * 16);
            const f32x4 g0 = gp[0], g1 = gp[1], g2 = gp[2], g3 = gp[3];
            float x = bgd;
#pragma unroll
            for (int rr = 0; rr < 4; ++rr) { x = fmaf(g0[rr], w[rr], x); }
#pragma unroll
            for (int rr = 0; rr < 4; ++rr) { x = fmaf(g1[rr], w[4 + rr], x); }
#pragma unroll
            for (int rr = 0; rr < 4; ++rr) { x = fmaf(g2[rr], w[8 + rr], x); }
#pragma unroll
            for (int rr = 0; rr < 4; ++rr) { x = fmaf(g3[rr], w[12 + rr], x); }
            gl = logsigmoid_fast(x) * (1.f / 16.f);
        }
        pb += gl; bc[i] = pb;
    }
    LAS float* segs = (LAS float*)(lds + GL_SEG);
    segs[seg * 64 + d] = pb;
    __syncthreads();
    float base = 0.f, tot = 0.f;
#pragma unroll
    for (int sg = 0; sg < 8; ++sg) { const float v = segs[sg * 64 + d]; tot += v; base += (sg < seg) ? v : 0.f; }
#pragma unroll
    for (int i = 0; i < 8; ++i) bc[i] += base;
    blast = tot;
}

constexpr size_t OUTS_QE = 0, OUTS_KN = (size_t)T * 256 * 2;
__device__ __forceinline__ void phase_gla_a(const Params& p_in, int layer_in, char* smem) {
    const Params p = kparams(); const int layer = opaque_int(layer_in); (void)p_in;
    const int tid = opaque_tid(), wid = __builtin_amdgcn_readfirstlane(tid >> 6), lane = tid & 63, fr = lane & 15, fq = lane >> 4;
    LAS unsigned char* ldw = (LAS unsigned char*)smem + wid * 8192;
    const bf16_t* GQ = (const bf16_t*)(p.ws + OFF_GQ);
    const bf16_t* GK = (const bf16_t*)(p.ws + OFF_GK);
    const bf16_t* GVT = (const bf16_t*)(p.ws + OFF_GV);
    const float* GLR = (const float*)(p.ws + OFF_GLR);
    bf16_t* QE = (bf16_t*)((char*)p.out + OUTS_QE);
    bf16_t* KN = (bf16_t*)((char*)p.out + OUTS_KN);
    float* UT = (float*)(p.ws + OFF_UT);
    float* DL = (float*)(p.ws + OFF_DL);
    const int wstride = gridDim.x * 8;
    for (int task = wid * (int)gridDim.x + opaque_bid(); task < 32 * 33; task += wstride) {
        const int bh = task / 33, c = task - bh * 33, b = bh >> 2, h = bh & 3;
        const int d = lane;
        float w[16];
#pragma unroll
        for (int rr = 0; rr < 16; ++rr) w[rr] = p.wg2[(size_t)layer * 16 * 256 + rr * 256 + h * 64 + d];
        const float bgd = p.bg[layer * 256 + h * 64 + d];
        float bsum = 0.f;
        const int rowi0 = b * L + 64 * c - 48;
        f32x4 g4[4];
#pragma unroll
        for (int m = 0; m < 4; ++m) { int rr_ = rowi0 + ((lane + 64 * m) >> 2); rr_ = rr_ > 0 ? rr_ : 0; g4[m] = *(const f32x4*)(GLR + (size_t)rr_ * 16 + 4 * (lane & 3)); }
        LAS unsigned char* ldg = (LAS unsigned char*)smem + 65536 + wid * 4096;
#pragma unroll
        for (int m = 0; m < 4; ++m) *(LAS f32x4*)(ldg + (lane + 64 * m) * 16) = g4[m];
        unsigned qk[64];
#pragma unroll
        for (int t = 0; t < 64; ++t) { int rr_ = rowi0 + t; rr_ = rr_ > 0 ? rr_ : 0; const size_t o_ = (size_t)rr_ * 256 + h * 64 + d; qk[t] = (unsigned)GQ[o_] | ((unsigned)GK[o_] << 16); }
        float kn[8];
        __builtin_amdgcn_wave_barrier(); asm volatile("s_waitcnt lgkmcnt(0)" ::: "memory");
#pragma unroll
        for (int t = 0; t < 64; ++t) {
            const bool valid = (c > 0) || (t >= 48);
            float x = bgd;
            {
                const LAS f32x4* gp = (const LAS f32x4*)(ldg + t * 64);
                const f32x4 g0 = gp[0], g1 = gp[1], g2 = gp[2], g3 = gp[3];
#pragma unroll
                for (int rr = 0; rr < 4; ++rr) x = fmaf(g0[rr], w[rr], x);
#pragma unroll
                for (int rr = 0; rr < 4; ++rr) x = fmaf(g1[rr], w[4 + rr], x);
#pragma unroll
                for (int rr = 0; rr < 4; ++rr) x = fmaf(g2[rr], w[8 + rr], x);
#pragma unroll
                for (int rr = 0; rr < 4; ++rr) x = fmaf(g3[rr], w[12 + rr], x);
            }
            bsum += valid ? logsigmoid_fast(x) * (1.f / 16.f) : 0.f;
            const float eb = __expf(bsum);
            const float qv = __uint_as_float(qk[t] << 16), kv = __uint_as_float(qk[t] & 0xFFFF0000u);
            const float knv = valid ? kv * __builtin_amdgcn_rcpf(eb) : 0.f;
            kn[t & 7] = knv;
            if (valid) {
                const size_t o_ = (size_t)(rowi0 + t) * 256 + h * 64 + d;
                QE[o_] = f2bf(qv * eb);
                KN[o_] = f2bf(knv);
            }
            if ((t & 7) == 7 && c < 32) {
                u32x4 o; o[0] = cvt_pk_bf16(kn[0], kn[1]); o[1] = cvt_pk_bf16(kn[2], kn[3]); o[2] = cvt_pk_bf16(kn[4], kn[5]); o[3] = cvt_pk_bf16(kn[6], kn[7]);
                *(LAS u32x4*)(ldw + d * 128 + 16 * ((t >> 3) ^ (d & 7))) = o;
            }
        }
        if (c < 32) {
            const float dl = __expf(bsum);
            DL[((size_t)bh * 32 + c) * 64 + d] = dl;
            __builtin_amdgcn_wave_barrier(); asm volatile("s_waitcnt lgkmcnt(0)" ::: "memory");
            bf16x8 kf[4][2]; float dls[4];
#pragma unroll
            for (int dt = 0; dt < 4; ++dt) {
                const int rowd = 16 * dt + fr;
                dls[dt] = __shfl(dl, rowd);
#pragma unroll
                for (int ks = 0; ks < 2; ++ks) kf[dt][ks] = *(const LAS bf16x8*)(ldw + rowd * 128 + 16 * ((4 * ks + fq) ^ (rowd & 7)));
            }
            const bf16x8 z8 = {0, 0, 0, 0, 0, 0, 0, 0};
            bf16x8 vfa[8][2];
#pragma unroll
            for (int et = 0; et < 8; ++et) {
                const bf16_t* vp = GVT + ((size_t)bh * 128 + 16 * et + fr) * LPV + 64 * c + 8 * fq;
                vfa[et][0] = *(const bf16x8*)vp; vfa[et][1] = *(const bf16x8*)(vp + 32);
            }
            asm volatile("" ::: "memory");
#pragma unroll
            for (int et = 0; et < 8; ++et) {
                bf16x8 v0 = vfa[et][0], v1 = vfa[et][1];
                v0 = (c == 0) ? z8 : v0; v1 = (c == 0 && fq < 2) ? z8 : v1;
#pragma unroll
                for (int dt = 0; dt < 4; ++dt) {
                    f32x4 acc = {0.f, 0.f, 0.f, 0.f};
                    acc = __builtin_amdgcn_mfma_f32_16x16x32_bf16(v0, kf[dt][0], acc, 0, 0, 0);
                    acc = __builtin_amdgcn_mfma_f32_16x16x32_bf16(v1, kf[dt][1], acc, 0, 0, 0);
                    float* up = UT + (((size_t)bh * 32 + c) * 128 + 16 * et + 4 * fq) * 64 + 16 * dt + fr;
#pragma unroll
                    for (int r = 0; r < 4; ++r) up[r * 64] = acc[r] * dls[dt];
                }
            }
            __builtin_amdgcn_wave_barrier(); asm volatile("s_waitcnt lgkmcnt(0)" ::: "memory");
        }
    }
}

__device__ __forceinline__ void phase_gla_scan(const Params& p_in, int layer_in, char* smem) {
    const Params p = kparams(); const int layer = opaque_int(layer_in); (void)p_in;
    const int tid = opaque_tid();
    const float* UT = (const float*)(p.ws + OFF_UT);
    const float* DL = (const float*)(p.ws + OFF_DL);
    bf16_t* ST = (bf16_t*)(p.ws + OFF_ST);
    const int nthr = gridDim.x * NT;
    for (int el = opaque_bid() * NT + tid; el < 32 * 8192; el += nthr) {
        const int bh = el >> 13, ed = el & 8191, d = el & 63;
        float sacc = 0.f;
        ST[((size_t)bh * 33) * 8192 + ed] = 0;
#pragma unroll 1
        for (int c0 = 0; c0 < 32; c0 += 16) {
            float u[16], dl[16];
#pragma unroll
            for (int i = 0; i < 16; ++i) { u[i] = UT[((size_t)(bh * 32 + c0 + i)) * 8192 + ed]; dl[i] = DL[(size_t)(bh * 32 + c0 + i) * 64 + d]; }
#pragma unroll
            for (int i = 0; i < 16; ++i) { sacc = fmaf(dl[i], sacc, u[i]); ST[((size_t)bh * 33 + c0 + i + 1) * 8192 + ed] = f2bf(sacc); }
        }
    }
}

__device__ __forceinline__ void phase_gla_c(const Params& p_in, int layer_in, char* smem, bool do_store) {
    const Params p = kparams(); const int layer = opaque_int(layer_in); (void)p_in;
    const int tid = opaque_tid(), wid = __builtin_amdgcn_readfirstlane(tid >> 6), lane = tid & 63, fr = lane & 15, fq = lane >> 4;
    const bf16_t* QE = (const bf16_t*)((const char*)p.out + OUTS_QE);
    const bf16_t* KN = (const bf16_t*)((const char*)p.out + OUTS_KN);
    const bf16_t* GVT = (const bf16_t*)(p.ws + OFF_GV);
    const bf16_t* ST = (const bf16_t*)(p.ws + OFF_ST);
    bf16_t* MIX = (bf16_t*)(p.ws + OFF_MIX);
    const float* ng = p.norm_g + layer * 128;
    const bf16x8 z8 = {0, 0, 0, 0, 0, 0, 0, 0};
    const int nwt = 32 * 33 * 4, wstride = gridDim.x * 8;
    for (int wt = wid * (int)gridDim.x + opaque_bid(); wt < nwt; wt += wstride) {
        const int task = wt >> 2, tw = wt & 3;
        const int bh = task / 33, c = task - bh * 33, b = bh >> 2, h = bh & 3;
        const int pos_t = 64 * c - 48 + 16 * tw + fr;
        if (c == 0 && tw < 3) continue;
        bf16x8 qf[2], kf[4][2];
        {
            const bf16_t* qp = QE + ((size_t)b * L + pos_t) * 256 + h * 64 + 8 * fq;
            qf[0] = *(const bf16x8*)qp; qf[1] = *(const bf16x8*)(qp + 32);
#pragma unroll
            for (int st = 0; st < 4; ++st) {
                const int pos_s = 64 * c - 48 + 16 * st + fr;
                const bf16_t* kp = KN + ((size_t)b * L + (pos_s > 0 ? pos_s : 0)) * 256 + h * 64 + 8 * fq;
                kf[st][0] = *(const bf16x8*)kp; kf[st][1] = *(const bf16x8*)(kp + 32);
            }
        }
        bf16x8 sf[4][2]; u32x2 vv[4][4];
#define GLC_LOAD_HALF(hf) do { _Pragma("unroll") for (int e4 = 0; e4 < 4; ++e4) { const int e0 = 16 * (4 * (hf) + e4); \
                const bf16_t* sp = ST + (((size_t)bh * 33 + c) * 128 + e0 + fr) * 64 + 8 * fq; \
                const bf16_t* vp = GVT + ((size_t)bh * 128 + e0 + fr) * LPV + 64 * c + 4 * fq; \
                sf[e4][0] = *(const bf16x8*)sp; sf[e4][1] = *(const bf16x8*)(sp + 32); \
                vv[e4][0] = *(const u32x2*)vp; vv[e4][1] = *(const u32x2*)(vp + 16); vv[e4][2] = *(const u32x2*)(vp + 32); vv[e4][3] = *(const u32x2*)(vp + 48); } \
            asm volatile("" ::: "memory"); } while (0)
        GLC_LOAD_HALF(0);
        unsigned pk[4][2];
#pragma unroll
        for (int st = 0; st < 4; ++st) {
            f32x4 a = {0.f, 0.f, 0.f, 0.f};
            const int pos_s = 64 * c - 48 + 16 * st + fr;
            const bf16x8 k0 = (pos_s >= 0) ? kf[st][0] : z8, k1 = (pos_s >= 0) ? kf[st][1] : z8;
            a = __builtin_amdgcn_mfma_f32_16x16x32_bf16(k0, qf[0], a, 0, 0, 0);
            a = __builtin_amdgcn_mfma_f32_16x16x32_bf16(k1, qf[1], a, 0, 0, 0);
#pragma unroll
            for (int r = 0; r < 4; ++r) a[r] = (16 * st + 4 * fq + r > 16 * tw + fr) ? 0.f : a[r];
            pk[st][0] = cvt_pk_bf16(a[0], a[1]); pk[st][1] = cvt_pk_bf16(a[2], a[3]);
        }
        bf16x8 pf[2];
#pragma unroll
        for (int ks = 0; ks < 2; ++ks) { u32x4 pw; pw[0] = pk[2 * ks][0]; pw[1] = pk[2 * ks][1]; pw[2] = pk[2 * ks + 1][0]; pw[3] = pk[2 * ks + 1][1]; pf[ks] = __builtin_bit_cast(bf16x8, pw); }
        f32x4 O[8];
        float ss = 0.f;
        const u32x2 z2 = {0u, 0u};
#pragma unroll
        for (int hf = 0; hf < 2; ++hf) {
            if (hf == 1) GLC_LOAD_HALF(1);
#pragma unroll
            for (int e4 = 0; e4 < 4; ++e4) {
                f32x4 acc = {0.f, 0.f, 0.f, 0.f};
                acc = __builtin_amdgcn_mfma_f32_16x16x32_bf16(sf[e4][0], qf[0], acc, 0, 0, 0);
                acc = __builtin_amdgcn_mfma_f32_16x16x32_bf16(sf[e4][1], qf[1], acc, 0, 0, 0);
                u32x2 va = vv[e4][0], vb = vv[e4][1], vc = vv[e4][2], vd = vv[e4][3];
                va = (c == 0) ? z2 : va; vb = (c == 0) ? z2 : vb; vc = (c == 0) ? z2 : vc;
                u32x4 vw; vw[0] = va[0]; vw[1] = va[1]; vw[2] = vb[0]; vw[3] = vb[1];
                acc = __builtin_amdgcn_mfma_f32_16x16x32_bf16(__builtin_bit_cast(bf16x8, vw), pf[0], acc, 0, 0, 0);
                u32x4 vx; vx[0] = vc[0]; vx[1] = vc[1]; vx[2] = vd[0]; vx[3] = vd[1];
                acc = __builtin_amdgcn_mfma_f32_16x16x32_bf16(__builtin_bit_cast(bf16x8, vx), pf[1], acc, 0, 0, 0);
                O[4 * hf + e4] = acc;
                ss += acc[0] * acc[0] + acc[1] * acc[1] + acc[2] * acc[2] + acc[3] * acc[3];
            }
        }
#undef GLC_LOAD_HALF
        ss += __shfl_xor(ss, 16); ss += __shfl_xor(ss, 32);
        const float rinv = rsqrtf(ss * (1.f / 128) + LN_EPS);
        if (pos_t >= 0 && do_store) {
            bf16_t* mp = MIX + ((size_t)b * L + pos_t) * 1024 + h * 128 + 4 * fq;
#pragma unroll
            for (int et = 0; et < 8; ++et) {
                const uint2 gz = *(const uint2*)(mp + 16 * et);
                const f32x4 nv = *(const f32x4*)(ng + 16 * et + 4 * fq);
                const float g0 = __uint_as_float(gz.x << 16), g1 = __uint_as_float(gz.x & 0xFFFF0000u), g2 = __uint_as_float(gz.y << 16), g3 = __uint_as_float(gz.y & 0xFFFF0000u);
                uint2 o; o.x = cvt_pk_bf16(O[et][0] * rinv * nv[0] * g0, O[et][1] * rinv * nv[1] * g1); o.y = cvt_pk_bf16(O[et][2] * rinv * nv[2] * g2, O[et][3] * rinv * nv[3] * g3);
                *(uint2*)(mp + 16 * et) = o;
            }
        }
    }
}

__device__ __forceinline__ void phase_ln(const Params& p_in, int layer_in, char* smem) {
    const Params p = kparams(); const int layer = opaque_int(layer_in); (void)p_in;
    const int tid = opaque_tid(), wid = tid >> 6, lane = tid & 63;
    const float* Z = (const float*)(p.ws + OFF_GQ);
    float* H32 = (float*)(p.ws + OFF_H32);
    bf16_t* HB = (bf16_t*)(p.ws + OFF_HB);
    const float* g = p.ln_g + layer * D; const float* bb = p.ln_b + layer * D;
    const int nw = gridDim.x * 8;
    int t = opaque_bid() * 8 + wid;
    f32x4 v[4], vn[4];
    if (t < T) {
#pragma unroll
        for (int i = 0; i < 4; ++i) v[i] = *(const f32x4*)(Z + (size_t)t * D + 4 * lane + 256 * i);
    }
    for (; t < T; t += nw) {
        const int tn = t + nw;
        if (tn < T) {
#pragma unroll
            for (int i = 0; i < 4; ++i) vn[i] = *(const f32x4*)(Z + (size_t)tn * D + 4 * lane + 256 * i);
        }
        ln_row_wave(v, g, bb, lane);
        if (layer == DEPTH - 1) {
            const int b = t / L, pos = t - b * L;
            if (pos >= NMETA) {
#pragma unroll
                for (int i = 0; i < 4; ++i) *(f32x4*)(p.out + ((size_t)b * SEQ + (pos - NMETA)) * D + 4 * lane + 256 * i) = v[i];
            }
        } else {
#pragma unroll
            for (int i = 0; i < 4; ++i) {
                *(f32x4*)(H32 + (size_t)t * D + 4 * lane + 256 * i) = v[i];
                u32x2 o; o[0] = cvt_pk_bf16(v[i][0], v[i][1]); o[1] = cvt_pk_bf16(v[i][2], v[i][3]);
                *(u32x2*)(HB + (size_t)t * D + 4 * lane + 256 * i) = o;
            }
        }
#pragma unroll
        for (int i = 0; i < 4; ++i) v[i] = vn[i];
    }
}

#define XB_TMO      128
#define XB_XCNT(j)  (256  + 64 * (j))
#define XB_XSUB(j)  (1280 + 64 * (j))
#define XB_XGEN(j)  (2304 + 64 * (j))
#define XB_TOP      3328
#define XB_TOPGEN   3392
#define XCD_BAR_WORDS 3456
#define XB_SPIN_CAP (1u << 22)
__device__ __forceinline__ unsigned xb_ld(unsigned* p)              { return __hip_atomic_load(p, __ATOMIC_RELAXED, __HIP_MEMORY_SCOPE_AGENT); }
__device__ __forceinline__ unsigned xb_add(unsigned* p, unsigned v) { return __hip_atomic_fetch_add(p, v, __ATOMIC_RELAXED, __HIP_MEMORY_SCOPE_AGENT); }
__device__ __forceinline__ unsigned xb_xcc_id() { return (unsigned)__builtin_amdgcn_s_getreg((3 << 11) | 20) & 0xFu; }
#define XB_SPIN(cond, bar) do { unsigned _sp = 0; while (cond) { __builtin_amdgcn_s_sleep(1); \
    if ((++_sp & 255u) == 0u) { if (xb_ld(&(bar)[XB_TMO])) break; if (_sp > XB_SPIN_CAP) { atomicAdd(&(bar)[XB_TMO], 1u); break; } } } } while (0)
struct XcdBarrier { unsigned* bar; unsigned x; volatile LAS unsigned* st; };
__device__ __forceinline__ XcdBarrier xcd_barrier_post(unsigned* bar, volatile LAS unsigned* st) {
    XcdBarrier b; b.bar = bar; b.x = xb_xcc_id(); b.st = st;
    if (threadIdx.x == 0) (void)xb_add(&bar[XB_XCNT(b.x)], 1u);
    return b;
}
__device__ __forceinline__ void xcd_barrier_complete(unsigned* bar, unsigned x, unsigned& nloc, unsigned& nx) {
    const unsigned G = gridDim.x * gridDim.y * gridDim.z;
    unsigned sum, cnt, mine, sp = 0u;
    for (;;) {
        sum = 0u; cnt = 0u; mine = 0u;
#pragma unroll
        for (unsigned j = 0; j < 16; ++j) { const unsigned c = xb_ld(&bar[XB_XCNT(j)]); sum += c; cnt += (c > 0u) ? 1u : 0u; mine = (j == x) ? c : mine; }
        if (sum == G) break;
        __builtin_amdgcn_s_sleep(1);
        if ((++sp & 255u) == 0u) { if (xb_ld(&bar[XB_TMO])) break; if (sp > XB_SPIN_CAP) { atomicAdd(&bar[XB_TMO], 1u); break; } }
    }
    nloc = mine > 0u ? mine : 1u; nx = cnt > 0u ? cnt : 1u;
}
__device__ __forceinline__ void xcd_barrier(unsigned* bar_, volatile LAS unsigned* st_) {
    XcdBarrier b; b.bar = bar_; b.x = xb_xcc_id(); b.st = st_;
    asm volatile("s_waitcnt vmcnt(0)" ::: "memory");
    __syncthreads();
    if (opaque_tid() == 0) {
        unsigned* bar = b.bar;
        __builtin_amdgcn_s_waitcnt(0);
        unsigned nloc = b.st[0], nx = b.st[1];
        if (nloc == 0u) { xcd_barrier_complete(bar, b.x, nloc, nx); b.st[0] = nloc; b.st[1] = nx; }
        const unsigned old = xb_add(&bar[XB_XSUB(b.x)], 1u);
        const unsigned gen = old / nloc;
        if (old + 1u == (gen + 1u) * nloc) {
            __builtin_amdgcn_fence(__ATOMIC_RELEASE, "agent");
            asm volatile("s_waitcnt vmcnt(0)" ::: "memory");
            const unsigned og = xb_add(&bar[XB_TOP], 1u);
            const unsigned tg = og / nx;
            if (og + 1u == (tg + 1u) * nx) xb_add(&bar[XB_TOPGEN], 1u);
            else XB_SPIN(xb_ld(&bar[XB_TOPGEN]) == tg, bar);
            __builtin_amdgcn_fence(__ATOMIC_ACQUIRE, "agent");
            xb_add(&bar[XB_XGEN(b.x)], 1u);
            asm volatile("s_waitcnt vmcnt(0)" ::: "memory");
        } else {
            XB_SPIN(xb_ld(&bar[XB_XGEN(b.x)]) == gen, bar);
            __builtin_amdgcn_fence(__ATOMIC_ACQUIRE, "agent");
            asm volatile("s_waitcnt vmcnt(0)" ::: "memory");
        }
    }
    __syncthreads();
}

constexpr int SMEM_BYTES = 160 * 1024;
static_assert(DS_END <= SMEM_BYTES - 16 - 64, "dsa lds");
static_assert(WVTAB_OFF == SMEM_BYTES - 16 - 64, "wave table");

__global__ void __launch_bounds__(NT, 2) k_mega(Params p) {
    __shared__ __attribute__((aligned(16))) char smem[SMEM_BYTES];
    volatile LAS unsigned* xbw = (volatile LAS unsigned*)((LAS unsigned char*)smem + (SMEM_BYTES - 16));
    if (threadIdx.x == 0) { xbw[0] = 0u; xbw[1] = 0u; xbw[2] = 0u; xbw[3] = 0u; }
    {
        const unsigned slot = (unsigned)__builtin_amdgcn_s_getreg(((6 - 1) << 11) | 4) & 63u;
        if ((threadIdx.x & 63) == 0) *((volatile LAS unsigned char*)smem + WVTAB_OFF + slot) = (unsigned char)(threadIdx.x >> 6);
    }
    __syncthreads();
    if (p.ws == nullptr) cg::this_grid().sync();
    (void)xcd_barrier_post((unsigned*)(p.ws + OFF_BAR), xbw);
    for (int rep = 0; rep < PROBE_REP_PREP; ++rep) {
    phase_prep(p, smem);
    xcd_barrier((unsigned*)(p.ws + OFF_BAR), xbw);
    }
#pragma unroll 1
    for (int layer = 0; layer < DEPTH; ++layer) {
        for (int rep = 0; rep < PROBE_REP_PROJ; ++rep) {
        phase_proj(p, layer, smem);
        xcd_barrier((unsigned*)(p.ws + OFF_BAR), xbw);
        }
        phase_rope(p, layer, smem);
        for (int rep = 0; rep < PROBE_REP_GLAA; ++rep) {
        phase_gla_a(p, layer, smem);
        xcd_barrier((unsigned*)(p.ws + OFF_BAR), xbw);
        phase_gla_scan(p, layer, smem);
        xcd_barrier((unsigned*)(p.ws + OFF_BAR), xbw);
        }
        for (int rep = 0; rep < PROBE_REP_GLAC; ++rep) phase_gla_c(p, layer, smem, rep == PROBE_REP_GLAC - 1);
        for (int rep = 0; rep < PROBE_REP_DSA; ++rep) phase_dsa(p, layer, smem, rep == PROBE_REP_DSA - 1);
        xcd_barrier((unsigned*)(p.ws + OFF_BAR), xbw);
        for (int rep = 0; rep < PROBE_REP_OUT; ++rep) {
        phase_outproj(p, layer, smem);
        xcd_barrier((unsigned*)(p.ws + OFF_BAR), xbw);
        }
        for (int rep = 0; rep < PROBE_REP_LN; ++rep) {
        phase_ln(p, layer, smem);
        xcd_barrier((unsigned*)(p.ws + OFF_BAR), xbw);
        }
    }
}

extern "C" void kernel_launch(void* const* d_in, const int* in_sizes, int n_in, void* d_out, int out_size, void* d_ws, size_t ws_size,
                              hipStream_t stream) {
    Params p{};
    p.x = (const float*)d_in[0]; p.meta = (const float*)d_in[1]; p.ln_in_g = (const float*)d_in[2]; p.ln_in_b = (const float*)d_in[3];
    p.w_in = (const float*)d_in[4]; p.wg2 = (const float*)d_in[5]; p.bg = (const float*)d_in[6]; p.norm_g = (const float*)d_in[7];
    p.ikg = (const float*)d_in[8]; p.ikb = (const float*)d_in[9]; p.w_out = (const float*)d_in[10]; p.ln_g = (const float*)d_in[11];
    p.ln_b = (const float*)d_in[12];
    p.out = (float*)d_out; p.ws = (char*)d_ws;
    static int grid_blocks = 0;
    if (!grid_blocks) {
        int dev = 0, cus = 0, per_cu = 0;
        hipGetDevice(&dev);
        hipDeviceGetAttribute(&cus, hipDeviceAttributeMultiprocessorCount, dev);
        hipOccupancyMaxActiveBlocksPerMultiprocessor(&per_cu, k_mega, NT, 0);
        if (per_cu > 1) per_cu = 1;
        grid_blocks = cus * per_cu;
    }
    (void)hipMemsetAsync((char*)d_ws + OFF_BAR, 0, XCD_BAR_WORDS * 4, stream);
    void* args[] = {&p};
    (void)hipLaunchCooperativeKernel((void*)k_mega, dim3(grid_blocks), dim3(NT), args, 0, stream);
}
```

```cpp
#include <hip/hip_runtime.h>
#include <hip/hip_cooperative_groups.h>
#include <stdint.h>
namespace cg = cooperative_groups;
#ifndef PROBE_REP_PREP
#define PROBE_REP_PREP 1
#define PROBE_REP_PROJ 1
#define PROBE_REP_GLAA 1
#define PROBE_REP_GLAC 1
#define PROBE_REP_DSA 1
#define PROBE_REP_OUT 1
#define PROBE_REP_LN 1
#define PROBE_DSA_A 1
#define PROBE_DSA_B 1
#define PROBE_DSA_C 1
#endif

constexpr int D = 1024, NB = 8, SEQ = 2048, NMETA = 16, L = 2064, T = NB * L;
constexpr int DEPTH = 2;
constexpr int INW = 3416, INWP = 3584;
constexpr int TP = 16640;
constexpr int NT = 512;
constexpr int TOPK = 256;
constexpr float LN_EPS = 1e-5f;
constexpr float ALPHA = 1.41421356237309515f;

typedef unsigned short bf16_t;
typedef short bf16x8 __attribute__((ext_vector_type(8)));
typedef float f32x4 __attribute__((ext_vector_type(4)));
#define LAS __attribute__((address_space(3)))

constexpr size_t SZ_H32 = (size_t)T * D * 4;
constexpr size_t SZ_HB = (size_t)TP * D * 2;
constexpr size_t SZ_WIN = (size_t)DEPTH * INWP * D * 2;
constexpr size_t SZ_WOUT = (size_t)DEPTH * D * D * 2;
constexpr int LPV = 2112;
constexpr size_t SZ_GQ = (size_t)T * 256 * 2, SZ_GK = SZ_GQ, SZ_GV = (size_t)NB * 4 * 128 * LPV * 2;
constexpr size_t SZ_UT = (size_t)1024 * 128 * 64 * 4, SZ_ST = (size_t)32 * 33 * 128 * 64 * 2, SZ_DL = (size_t)1024 * 64 * 4;
constexpr size_t SZ_AQ = (size_t)T * 512 * 2, SZ_IQ = (size_t)T * 512 * 2;
constexpr size_t SZ_MIX = (size_t)TP * 1024 * 2;
constexpr int LP = 2112;
constexpr size_t SZ_AK = (size_t)T * 128 * 2, SZ_AV = (size_t)NB * 2 * 64 * LP * 2, SZ_IK = (size_t)T * 64 * 2, SZ_IW = (size_t)T * 8 * 4;
constexpr size_t SZ_GLR = (size_t)T * 16 * 4;
constexpr size_t SZ_ROPE = (size_t)L * 8 * 2 * 4;

constexpr size_t OFF_H32 = 0;
constexpr size_t OFF_HB = OFF_H32 + SZ_H32;
constexpr size_t OFF_WIN = OFF_HB + SZ_HB;
constexpr size_t OFF_WOUT = OFF_WIN + SZ_WIN;
constexpr size_t OFF_GQ = OFF_WOUT + SZ_WOUT;
constexpr size_t OFF_GK = OFF_GQ + SZ_GQ;
constexpr size_t OFF_GV = OFF_GK + SZ_GK;
constexpr size_t OFF_AQ = OFF_GV + SZ_GV;
constexpr size_t OFF_IQ = OFF_AQ + SZ_AQ;
constexpr size_t OFF_MIX = OFF_IQ + SZ_IQ;
constexpr size_t OFF_AK = OFF_MIX + SZ_MIX;
constexpr size_t OFF_AV = OFF_AK + SZ_AK;
constexpr size_t OFF_IK = OFF_AV + SZ_AV;
constexpr size_t OFF_IW = OFF_IK + SZ_IK;
constexpr size_t OFF_GLR = OFF_IW + SZ_IW;
constexpr size_t OFF_ROPE = OFF_GLR + SZ_GLR;
constexpr size_t OFF_ST = OFF_ROPE + SZ_ROPE;
constexpr size_t OFF_DL = OFF_ST + SZ_ST;
constexpr size_t OFF_BAR = OFF_DL + SZ_DL;
constexpr size_t OFF_IKR = OFF_BAR + 16384;
constexpr size_t OFF_END = OFF_IKR + (size_t)T * 64 * 4;
constexpr size_t OFF_UT = OFF_HB;
static_assert(SZ_UT <= SZ_HB, "UT alias");
static_assert(SZ_GQ + SZ_GK + SZ_GV + SZ_AQ + SZ_IQ >= SZ_H32, "Z alias size");
static_assert(OFF_END <= (size_t)256 * 1024 * 1024, "workspace too large");

struct Params {
    const float* x; const float* meta; const float* ln_in_g; const float* ln_in_b;
    const float* w_in; const float* wg2; const float* bg; const float* norm_g;
    const float* ikg; const float* ikb; const float* w_out; const float* ln_g; const float* ln_b;
    float* out; char* ws;
};
typedef const Params __attribute__((address_space(4))) * KParamsPtr;
__device__ __forceinline__ Params kparams() {
    unsigned long long a = (unsigned long long)__builtin_amdgcn_kernarg_segment_ptr();
    asm volatile("" : "+s"(a));
    KParamsPtr q = (KParamsPtr)a;
    Params r;
    r.x = q->x; r.meta = q->meta; r.ln_in_g = q->ln_in_g; r.ln_in_b = q->ln_in_b; r.w_in = q->w_in; r.wg2 = q->wg2; r.bg = q->bg; r.norm_g = q->norm_g;
    r.ikg = q->ikg; r.ikb = q->ikb; r.w_out = q->w_out; r.ln_g = q->ln_g; r.ln_b = q->ln_b; r.out = q->out; r.ws = q->ws;
    return r;
}

__device__ __forceinline__ bf16_t f2bf(float f) {
    unsigned u = __float_as_uint(f);
    u += 0x7FFFu + ((u >> 16) & 1u);
    return (bf16_t)(u >> 16);
}
__device__ __forceinline__ unsigned pack2bf(float lo, float hi) { return (unsigned)f2bf(lo) | ((unsigned)f2bf(hi) << 16); }
__device__ __forceinline__ unsigned cvt_pk_bf16(float lo, float hi) { unsigned r; asm volatile("v_cvt_pk_bf16_f32 %0, %1, %2" : "=v"(r) : "v"(lo), "v"(hi)); return r; }
typedef unsigned u32x4 __attribute__((ext_vector_type(4)));
typedef unsigned u32x2 __attribute__((ext_vector_type(2)));
__device__ __forceinline__ float bf2f(bf16_t h) { return __uint_as_float(((unsigned)h) << 16); }
constexpr int WVTAB_OFF = 160 * 1024 - 16 - 64;
__device__ __forceinline__ int opaque_tid() {
    const unsigned slot = (unsigned)__builtin_amdgcn_s_getreg(((6 - 1) << 11) | 4) & 63u;
    const unsigned wv = *((const volatile LAS unsigned char*)(size_t)WVTAB_OFF + slot);
    int t = (int)(wv << 6) | (int)__builtin_amdgcn_mbcnt_hi(~0u, __builtin_amdgcn_mbcnt_lo(~0u, 0u));
    asm volatile("" : "+v"(t)); return t;
}
__device__ __forceinline__ int opaque_int(int v) { asm volatile("" : "+s"(v)); return v; }
__device__ __forceinline__ int opaque_bid() { int t = blockIdx.x; asm volatile("" : "+s"(t)); return t; }
__device__ __forceinline__ float wave_sum(float v) {
#pragma unroll
    for (int o = 32; o > 0; o >>= 1) v += __shfl_xor(v, o);
    return v;
}
__device__ __forceinline__ float wave_max(float v) {
#pragma unroll
    for (int o = 32; o > 0; o >>= 1) v = fmaxf(v, __shfl_xor(v, o));
    return v;
}
__device__ __forceinline__ float block_sum(float v, float* red) {
    v = wave_sum(v);
    const int tq = opaque_tid();
    __syncthreads();
    if ((tq & 63) == 0) red[tq >> 6] = v;
    __syncthreads();
    return ((red[0] + red[1]) + (red[2] + red[3])) + ((red[4] + red[5]) + (red[6] + red[7]));
}
__device__ __forceinline__ float silu_f(float x) { return x / (1.f + __expf(-x)); }
__device__ __forceinline__ float logsigmoid_f(float x) { return fminf(x, 0.f) - log1pf(expf(-fabsf(x))); }
__device__ __forceinline__ float logsigmoid_fast(float x) { return fminf(x, 0.f) - __logf(1.f + __expf(-fabsf(x))); }

__device__ __forceinline__ int proj_src_col(int n) {
    if (n < 1024) return n;
    if (n < 1536) return n - 1024 + 1040;
    if (n < 2048) return n - 1536 + 1552;
    if (n < 2560) return n - 2048 + 2904;
    if (n < 3072) return n - 2560 + 2320;
    if (n < 3200) return n - 3072 + 2064;
    if (n < 3328) return n - 3200 + 2192;
    const int c = n - 3328;
    if (c < 32) return 2832 + c;
    if (c < 48) return 1024 + (c - 32);
    if (c < 56) return 2896 + (c - 48);
    if (c >= 128 && c < 160) return 2832 + 32 + (c - 128);
    return -1;
}

__device__ __forceinline__ void sincos_acc(float a, float& s, float& c) {
    double ad = (double)a;
    double kd = rint(ad * 0.63661977236758134308);
    double r = fma(-kd, 1.57079632679489655800, ad);
    r = fma(-kd, 6.12323399573676603587e-17, r);
    double r2 = r * r;
    double sp = r * (1.0 + r2 * (-1.0 / 6 + r2 * (1.0 / 120 + r2 * (-1.0 / 5040 + r2 * (1.0 / 362880 + r2 * (-1.0 / 39916800))))));
    double cp = 1.0 + r2 * (-0.5 + r2 * (1.0 / 24 + r2 * (-1.0 / 720 + r2 * (1.0 / 40320 + r2 * (-1.0 / 3628800 + r2 * (1.0 / 479001600))))));
    int q = ((int)kd) & 3;
    double ss = (q & 1) ? cp : sp, cc = (q & 1) ? sp : cp;
    if (q == 1 || q == 2) cc = -cc;
    if (q == 2 || q == 3) ss = -ss;
    s = (float)ss; c = (float)cc;
}

__device__ __forceinline__ void ln_row_wave(f32x4 (&v)[4], const float* g, const float* bb, int lane) {
    float sm = 0.f;
#pragma unroll
    for (int i = 0; i < 4; ++i) sm += (v[i][0] + v[i][1]) + (v[i][2] + v[i][3]);
    const float mu = wave_sum(sm) * (1.f / D);
    float qq = 0.f;
#pragma unroll
    for (int i = 0; i < 4; ++i) { v[i] = v[i] - mu; qq += (v[i][0] * v[i][0] + v[i][1] * v[i][1]) + (v[i][2] * v[i][2] + v[i][3] * v[i][3]); }
    const float rs = rsqrtf(wave_sum(qq) * (1.f / D) + LN_EPS);
#pragma unroll
    for (int i = 0; i < 4; ++i) { const f32x4 gg = *(const f32x4*)(g + 4 * lane + 256 * i), b4 = *(const f32x4*)(bb + 4 * lane + 256 * i); v[i] = v[i] * rs * gg + b4; }
}
__device__ __forceinline__ int proj_dst_col(int src) {
    if (src < 1024) return src;
    if (src < 1040) return 3328 + 32 + (src - 1024);
    if (src < 1552) return 1024 + (src - 1040);
    if (src < 2064) return 1536 + (src - 1552);
    if (src < 2192) return 3072 + (src - 2064);
    if (src < 2320) return 3200 + (src - 2192);
    if (src < 2832) return 2560 + (src - 2320);
    if (src < 2864) return 3328 + (src - 2832);
    if (src < 2896) return 3328 + 128 + (src - 2864);
    if (src < 2904) return 3328 + 48 + (src - 2896);
    return 2048 + (src - 2904);
}
__device__ __forceinline__ void phase_prep(const Params& p_in, char* smem) {
    const Params p = kparams(); (void)p_in;
    const int tid = opaque_tid(), wid = tid >> 6, lane = tid & 63;
    bf16_t* WIN = (bf16_t*)(p.ws + OFF_WIN);
    bf16_t* WOUT = (bf16_t*)(p.ws + OFF_WOUT);
    float* H32 = (float*)(p.ws + OFF_H32);
    bf16_t* HB = (bf16_t*)(p.ws + OFF_HB);
    bf16_t* MIX = (bf16_t*)(p.ws + OFF_MIX);
    float2* ROPE = (float2*)(p.ws + OFF_ROPE);
    float (*tile)[65] = (float (*)[65])smem;
    constexpr int NCT_IN = (INW + 63) / 64, NT_IN = DEPTH * 16 * NCT_IN, NT_OUT = DEPTH * 16 * 16;
    for (int item = opaque_bid(); item < NT_IN + NT_OUT; item += gridDim.x) {
        const bool is_in = item < NT_IN;
        const int it = is_in ? item : item - NT_IN;
        const int nct = is_in ? NCT_IN : 16, ldw = is_in ? INW : D;
        const int l = it / (16 * nct), rem = it - l * 16 * nct, kt = rem / nct, ct = rem - kt * nct;
        const float* W = (is_in ? p.w_in : p.w_out) + (size_t)l * D * ldw;
        __syncthreads();
#pragma unroll
        for (int i = 0; i < 8; ++i) {
            const int e = tid + NT * i, kk = e >> 6, nn = e & 63, col = ct * 64 + nn;
            tile[kk][nn] = (col < ldw) ? W[(size_t)(kt * 64 + kk) * ldw + col] : 0.f;
        }
        __syncthreads();
        {
            const int nn = tid >> 3, k8 = (tid & 7) * 8, src = ct * 64 + nn;
            if (src < ldw) {
                const int dst = is_in ? proj_dst_col(src) : src;
                u32x4 o;
#pragma unroll
                for (int q = 0; q < 4; ++q) o[q] = cvt_pk_bf16(tile[k8 + 2 * q][nn], tile[k8 + 2 * q + 1][nn]);
                bf16_t* dstp = (is_in ? WIN + ((size_t)l * INWP + dst) * D : WOUT + ((size_t)l * D + dst) * D) + kt * 64 + k8;
                *(u32x4*)dstp = o;
            }
        }
    }
    {
        const int nw = gridDim.x * 8;
        for (int t = opaque_bid() * 8 + wid; t < TP; t += nw) {
            if (t < T) {
                const int b = t / L, pos = t - b * L;
                const float* src = (pos < NMETA) ? (p.meta + (size_t)pos * D) : (p.x + ((size_t)b * SEQ + (pos - NMETA)) * D);
                f32x4 v[4];
#pragma unroll
                for (int i = 0; i < 4; ++i) v[i] = *(const f32x4*)(src + 4 * lane + 256 * i);
                ln_row_wave(v, p.ln_in_g, p.ln_in_b, lane);
#pragma unroll
                for (int i = 0; i < 4; ++i) {
                    *(f32x4*)(H32 + (size_t)t * D + 4 * lane + 256 * i) = v[i];
                    u32x2 o; o[0] = cvt_pk_bf16(v[i][0], v[i][1]); o[1] = cvt_pk_bf16(v[i][2], v[i][3]);
                    *(u32x2*)(HB + (size_t)t * D + 4 * lane + 256 * i) = o;
                }
            } else {
#pragma unroll
                for (int i = 0; i < 4; ++i) {
                    *(u32x2*)(HB + (size_t)t * D + 4 * lane + 256 * i) = (u32x2){0u, 0u};
                    *(u32x2*)(MIX + (size_t)t * D + 4 * lane + 256 * i) = (u32x2){0u, 0u};
                }
            }
        }
    }
    for (int e = opaque_bid() * NT + tid; e < L * 8; e += gridDim.x * NT) {
        const int pos = e >> 3, i = e & 7;
        const float inv[8] = {1.0f, 0.19392274f, 0.03760603f, 0.0072926646f, 0.0014142136f, 0.0002742482f, 5.3182957e-05f, 1.0313385e-05f};
        float iv = inv[0];
#pragma unroll
        for (int j = 1; j < 8; ++j) iv = (i == j) ? inv[j] : iv;
        const float ang = (float)pos * iv;
        float sn, cs; sincos_acc(ang, sn, cs);
        ROPE[e] = make_float2(cs, sn);
    }
}

namespace pg8 {
constexpr int BM = 256, BK = 64, HALF = 128, HTB = HALF * BK * 2  , STAGE_BYTES = 8 * HTB, NXCD = 8, WGM = 8;
__device__ __forceinline__ int lds_byte(int r, int c) { const int st = (r >> 4) * 2 + (c >> 5), rr = r & 15, cc = c & 31, ob = rr * 64 + cc * 2; return st * 1024 + (ob ^ (((ob >> 9) & 1) << 5)); }
__device__ __forceinline__ void stage_rc(int b, int& R, int& C) { const int st = b / 1024, sb = b % 1024, swz = sb ^ (((sb >> 9) & 1) << 5); R = (st >> 1) * 16 + swz / 64; C = (st & 1) * 32 + (swz % 64) / 2; }
__device__ __forceinline__ int perm32(int rho) { const int n = rho >> 4, i = rho & 15; return 8 * (i >> 2) + 4 * n + (i & 3); }

struct Unit { int pm, pn; };
struct Gemm { const bf16_t* A; const bf16_t* Bt; int M, N, K; };

struct StaticOrder {
    int nM, nN, nwg, G, c;
    __device__ void init(int M, int N, int G_, int c_) { nM = M / BM; nN = N / BM; nwg = nM * nN; G = G_; c = c_; }
    __device__ bool next(int i, Unit& u) const {
        const long Lx = (long)i * G + c; if (Lx >= nwg) return false;
        int wgid = (int)Lx; { const int q = nwg / NXCD, r = nwg % NXCD, xcd = wgid % NXCD, off = wgid / NXCD; wgid = (xcd < r ? xcd * (q + 1) : r * (q + 1) + (xcd - r) * q) + off; }
        const int nig = WGM * nN, gid = wgid / nig, fm = gid * WGM, gsz = (nM - fm) < WGM ? (nM - fm) : WGM;
        u.pm = fm + ((wgid % nig) % gsz); u.pn = (wgid % nig) / gsz; return true;
    }
    __device__ __forceinline__ void a_ready(const Unit&) const {}
    __device__ __forceinline__ void done(const Unit&) const {}
};

template <class Epi, class Sched>
__device__ __forceinline__ void gemm_phase(LAS unsigned char* lds, const Gemm g, const Sched& S, const Epi& E) {
    const int tid = opaque_tid(), wid = __builtin_amdgcn_readfirstlane(tid >> 6), lane = tid & 63, wr = wid >> 2, wc = wid & 3, fr = lane & 15, fq = lane >> 4;
    const int K = g.K, nt = K / BK;
    unsigned voffA[2], voffB[2];
#pragma unroll
    for (int i = 0; i < 2; ++i) { int R, C; stage_rc(tid * 16 + i * 8192, R, C); const int Rb = Epi::PERM ? ((R & ~31) + perm32(R & 31)) : R;
        voffA[i] = (unsigned)(R * K + C) * 2u; voffB[i] = (unsigned)(Rb * K + C) * 2u; }
    const size_t kstep = (size_t)(BK * 2);
    const size_t hstep = (size_t)HALF * K * 2;
    const size_t tstep = 2 * hstep;
    const unsigned ldsw = (unsigned)wid * 1024u;
    const int aoff = lds_byte(wr * 64 + fr, fq * 8), boff = lds_byte(wc * 32 + fr, fq * 8);
#define PG8_SA(b, h) (((b) * 2 + (h)) * HTB)
#define PG8_SB(b, h) ((4 + (b) * 2 + (h)) * HTB)
#define PG8_STAGE(bufoff, gbase, voff) do { _Pragma("unroll") for (int _i = 0; _i < 2; ++_i) \
        __builtin_amdgcn_global_load_lds((const unsigned*)((const char*)(gbase) + (voff)[_i]), (LAS unsigned*)(lds + (bufoff) + ldsw + _i * 8192), 16, 0, 0); } while (0)
    const LAS unsigned char* la_base = lds + aoff; asm volatile("" : "+v"(la_base));
    const LAS unsigned char* lb_base = lds + 4 * HTB + boff; asm volatile("" : "+v"(lb_base));
#define PG8_LDA(dst, b, h) do { _Pragma("unroll") for (int m = 0; m < 4; ++m) _Pragma("unroll") for (int k = 0; k < 2; ++k) dst[m][k] = *(const LAS bf16x8*)(la_base + PG8_SA(b, h) + m * 2048 + k * 1024); } while (0)
#define PG8_LDB(dst, b, h) do { _Pragma("unroll") for (int n = 0; n < 2; ++n) _Pragma("unroll") for (int k = 0; k < 2; ++k) dst[n][k] = *(const LAS bf16x8*)(lb_base + (PG8_SB(b, h) - 4 * HTB) + n * 2048 + k * 1024); } while (0)
#define PG8_MMA(ai, bj, At, Bt) do { __builtin_amdgcn_s_setprio(1); _Pragma("unroll") for (int m = 0; m < 4; ++m) _Pragma("unroll") for (int n = 0; n < 2; ++n) _Pragma("unroll") for (int k = 0; k < 2; ++k) \
        acc[ai][bj][m][n] = __builtin_amdgcn_mfma_f32_16x16x32_bf16(Bt[n][k], At[m][k], acc[ai][bj][m][n], 0, 0, 0); __builtin_amdgcn_s_setprio(0); } while (0)
#define PG8_WAIT_V(n) asm volatile("s_waitcnt vmcnt(" #n ")" ::: "memory")
#define PG8_WAIT_L(n) asm volatile("s_waitcnt lgkmcnt(" #n ")" ::: "memory")
#define PG8_BAR __builtin_amdgcn_s_barrier()
#define PG8_SCHED __builtin_amdgcn_sched_barrier(0)
    Unit cur, nxt; int ui = 0;
    if (!S.next(0, cur)) return;
    f32x4 acc[2][2][4][2];
#pragma unroll
    for (int a = 0; a < 2; ++a)
#pragma unroll
        for (int b = 0; b < 2; ++b)
#pragma unroll
            for (int m = 0; m < 4; ++m)
#pragma unroll
                for (int n = 0; n < 2; ++n) acc[a][b][m][n] = (f32x4){0.f, 0.f, 0.f, 0.f};
    bf16x8 At[4][2], B0[2][2], B1[2][2];
    const char* cA = (const char*)g.A + (size_t)cur.pm * tstep; const char* cB = (const char*)g.Bt + (size_t)cur.pn * tstep;
    S.a_ready(cur);
    PG8_STAGE(PG8_SB(0, 0), cB, voffB); PG8_STAGE(PG8_SA(0, 0), cA, voffA); PG8_STAGE(PG8_SB(0, 1), cB + hstep, voffB); PG8_STAGE(PG8_SA(0, 1), cA + hstep, voffA);
    if (wr == 1) PG8_BAR;
    PG8_WAIT_V(4); PG8_BAR;
    PG8_STAGE(PG8_SB(1, 0), cB + kstep, voffB); PG8_STAGE(PG8_SA(1, 0), cA + kstep, voffA); PG8_STAGE(PG8_SB(1, 1), cB + hstep + kstep, voffB);
    PG8_WAIT_V(6); PG8_BAR;
    for (;;) {
        const bool has_next = S.next(ui + 1, nxt);
        const char* nA = has_next ? (const char*)g.A + (size_t)nxt.pm * tstep : cA; const char* nB = has_next ? (const char*)g.Bt + (size_t)nxt.pn * tstep : cB;
        for (int t = 0; t < nt; t += 2) {
            const bool last = (t == nt - 2);
            const char* a1 = cA + (size_t)(t + 1) * kstep;
            const char* a2 = last ? nA : cA + (size_t)(t + 2) * kstep; const char* b2 = last ? nB : cB + (size_t)(t + 2) * kstep;
            const char* a3 = a2 + kstep; const char* b3 = b2 + kstep;
            if (last && has_next) S.a_ready(nxt);
            PG8_LDB(B0, 0, 0); PG8_SCHED; PG8_LDA(At, 0, 0); PG8_STAGE(PG8_SA(1, 1), a1 + hstep, voffA);
            PG8_WAIT_L(8); PG8_BAR; PG8_WAIT_L(0); PG8_MMA(0, 0, At, B0); PG8_BAR; PG8_SCHED;
            PG8_LDB(B1, 0, 1); PG8_STAGE(PG8_SB(0, 0), b2, voffB);
            PG8_BAR; PG8_WAIT_L(0); PG8_MMA(0, 1, At, B1); PG8_BAR;
            PG8_LDA(At, 0, 1); PG8_STAGE(PG8_SA(0, 0), a2, voffA);
            PG8_BAR; PG8_WAIT_L(0); PG8_MMA(1, 0, At, B0); PG8_BAR; PG8_SCHED;
            PG8_STAGE(PG8_SB(0, 1), b2 + hstep, voffB);
            PG8_WAIT_V(6); PG8_BAR; PG8_MMA(1, 1, At, B1); PG8_BAR;
            PG8_LDB(B0, 1, 0); PG8_SCHED; PG8_LDA(At, 1, 0); PG8_STAGE(PG8_SA(0, 1), a2 + hstep, voffA);
            PG8_WAIT_L(8); PG8_BAR; PG8_WAIT_L(0); PG8_MMA(0, 0, At, B0); PG8_BAR; PG8_SCHED;
            PG8_LDB(B1, 1, 1); PG8_STAGE(PG8_SB(1, 0), b3, voffB);
            PG8_BAR; PG8_WAIT_L(0); PG8_MMA(0, 1, At, B1); PG8_BAR;
            PG8_LDA(At, 1, 1); PG8_STAGE(PG8_SA(1, 0), a3, voffA);
            PG8_BAR; PG8_WAIT_L(0); PG8_MMA(1, 0, At, B0); PG8_BAR; PG8_SCHED;
            PG8_STAGE(PG8_SB(1, 1), b3 + hstep, voffB);
            PG8_WAIT_V(6); PG8_BAR; PG8_MMA(1, 1, At, B1); PG8_BAR;
        }
        E(acc, cur, wr, wc, fr, fq); S.done(cur);
        if (!has_next) break;
#pragma unroll
        for (int a = 0; a < 2; ++a)
#pragma unroll
            for (int b = 0; b < 2; ++b)
#pragma unroll
                for (int m = 0; m < 4; ++m)
#pragma unroll
                    for (int n = 0; n < 2; ++n) acc[a][b][m][n] = (f32x4){0.f, 0.f, 0.f, 0.f};
        cur = nxt; cA = nA; cB = nB; ++ui;
    }
    PG8_WAIT_V(0);
    if (wr == 0) PG8_BAR;
    PG8_BAR;
#undef PG8_SA
#undef PG8_SB
#undef PG8_STAGE
#undef PG8_LDA
#undef PG8_LDB
#undef PG8_MMA
#undef PG8_WAIT_V
#undef PG8_WAIT_L
#undef PG8_BAR
#undef PG8_SCHED
}
}

struct EpiProj {
    static constexpr bool PERM = true;
    char* ws;
    __device__ __forceinline__ void store8(bf16_t* dst, const f32x4& a, const f32x4& b, float sc) const {
        u32x4 o; o[0] = cvt_pk_bf16(a[0] * sc, a[1] * sc); o[1] = cvt_pk_bf16(a[2] * sc, a[3] * sc); o[2] = cvt_pk_bf16(b[0] * sc, b[1] * sc); o[3] = cvt_pk_bf16(b[2] * sc, b[3] * sc);
        *(u32x4*)dst = o;
    }
    __device__ __forceinline__ void operator()(const f32x4 (&acc)[2][2][4][2], const pg8::Unit& u, int wr, int wc, int fr, int fq) const {
        { int ln_ = (int)__builtin_amdgcn_mbcnt_hi(~0u, __builtin_amdgcn_mbcnt_lo(~0u, 0u)); asm volatile("" : "+v"(ln_)); fr = ln_ & 15; fq = ln_ >> 4; }
        if (u.pn < 13) {
#pragma unroll
            for (int bj = 0; bj < 2; ++bj) {
                const int hb = 4 * u.pn + 2 * bj + (wc >> 1);
                const int cc8 = 32 * (wc & 1) + 8 * fq;
#pragma unroll
                for (int ai = 0; ai < 2; ++ai)
#pragma unroll
                    for (int m = 0; m < 4; ++m) {
                        const int t = 256 * u.pm + 128 * ai + 64 * wr + 16 * m + fr;
                        const f32x4 v0 = acc[ai][bj][m][0], v1 = acc[ai][bj][m][1];
                        if (t < T) {
                            const size_t tt = (size_t)t;
                            if (hb < 4) store8((bf16_t*)(ws + OFF_GQ) + tt * 256 + hb * 64 + cc8, v0, v1, 0.125f);
                            else if (hb < 8) store8((bf16_t*)(ws + OFF_GK) + tt * 256 + (hb - 4) * 64 + cc8, v0, v1, 1.f);
                            else if (hb < 16) {
                                const int bq = t / L, pos = t - bq * L;
                                bf16_t* dst = (bf16_t*)(ws + OFF_GV) + ((size_t)(bq * 4 + ((hb - 8) >> 1)) * 128 + ((hb - 8) & 1) * 64 + cc8) * LPV + 48 + pos;
#pragma unroll
                                for (int j = 0; j < 4; ++j) { dst[(size_t)j * LPV] = f2bf(v0[j]); dst[(size_t)(4 + j) * LPV] = f2bf(v1[j]); }
                            }
                            else if (hb < 24 || (hb >= 32 && hb < 40)) {
                                f32x4 s0, s1;
#pragma unroll
                                for (int j = 0; j < 4; ++j) { s0[j] = silu_f(v0[j]); s1[j] = silu_f(v1[j]); }
                                const int col = (hb < 24) ? (hb - 16) * 64 : 512 + (hb - 32) * 64;
                                store8((bf16_t*)(ws + OFF_MIX) + tt * 1024 + col + cc8, s0, s1, 1.f);
                            }
                            else if (hb < 32) store8((bf16_t*)(ws + OFF_AQ) + tt * 512 + (hb - 24) * 64 + cc8, v0, v1, 0.125f * 1.44269504088896341f);
                            else if (hb < 48) store8((bf16_t*)(ws + OFF_IQ) + tt * 512 + (hb - 40) * 64 + cc8, v0, v1, 0.125f);
                            else if (hb < 50) store8((bf16_t*)(ws + OFF_AK) + tt * 128 + (hb - 48) * 64 + cc8, v0, v1, 1.f);
                            else {
                                const int bq = t / L, pos = t - bq * L;
                                bf16_t* dst = (bf16_t*)(ws + OFF_AV) + ((size_t)(bq * 2 + (hb - 50)) * 64 + cc8) * LP + pos;
#pragma unroll
                                for (int j = 0; j < 4; ++j) { dst[(size_t)j * LP] = f2bf(v0[j]); dst[(size_t)(4 + j) * LP] = f2bf(v1[j]); }
                            }
                        }
                        asm volatile("" ::: "memory");
                    }
            }
        } else {
#pragma unroll
            for (int ai = 0; ai < 2; ++ai)
#pragma unroll
                for (int m = 0; m < 4; ++m) {
                    const int t = 256 * u.pm + 128 * ai + 64 * wr + 16 * m + fr;
                    if (t < T) {
                        if (wc == 0) {
                            float* dst = (float*)(ws + OFF_IKR) + (size_t)t * 64 + 8 * fq;
                            *(f32x4*)dst = acc[ai][0][m][0]; *(f32x4*)(dst + 4) = acc[ai][0][m][1];
                            *(f32x4*)(dst + 32) = acc[ai][1][m][0]; *(f32x4*)(dst + 36) = acc[ai][1][m][1];
                        } else if (wc == 1) {
                            const f32x4 v0 = acc[ai][0][m][0], v1 = acc[ai][0][m][1];
                            if (fq < 2) {
                                float* dst = (float*)(ws + OFF_GLR) + (size_t)t * 16 + 8 * fq;
                                *(f32x4*)dst = v0; *(f32x4*)(dst + 4) = v1;
                            } else if (fq == 2) {
                                float* dst = (float*)(ws + OFF_IW) + (size_t)t * 8;
                                *(f32x4*)dst = v0 * 0.353553390593273762f; *(f32x4*)(dst + 4) = v1 * 0.353553390593273762f;
                            }
                        }
                    }
                    asm volatile("" ::: "memory");
                }
        }
    }
};

struct EpiOut {
    static constexpr bool PERM = false;
    const float* H32; float* Z;
    __device__ __forceinline__ void operator()(const f32x4 (&acc)[2][2][4][2], const pg8::Unit& u, int wr, int wc, int fr, int fq) const {
        { int ln_ = (int)__builtin_amdgcn_mbcnt_hi(~0u, __builtin_amdgcn_mbcnt_lo(~0u, 0u)); asm volatile("" : "+v"(ln_)); fr = ln_ & 15; fq = ln_ >> 4; }
        const int col0 = u.pn * 256 + wc * 32 + 4 * fq;
#pragma unroll
        for (int ai = 0; ai < 2; ++ai) {
            f32x4 hv[4][2][2];
#pragma unroll
            for (int m = 0; m < 4; ++m) {
                int t = 256 * u.pm + 128 * ai + 64 * wr + 16 * m + fr; t = t < T ? t : T - 1;
                const size_t off = (size_t)t * D + col0;
#pragma unroll
                for (int bj = 0; bj < 2; ++bj)
#pragma unroll
                    for (int n = 0; n < 2; ++n) hv[m][bj][n] = *(const f32x4*)(H32 + off + bj * 128 + n * 16);
            }
#pragma unroll
            for (int m = 0; m < 4; ++m) {
                const int t = 256 * u.pm + 128 * ai + 64 * wr + 16 * m + fr;
                if (t < T) {
                    const size_t off = (size_t)t * D + col0;
#pragma unroll
                    for (int bj = 0; bj < 2; ++bj)
#pragma unroll
                        for (int n = 0; n < 2; ++n) *(f32x4*)(Z + off + bj * 128 + n * 16) = acc[ai][bj][m][n] + hv[m][bj][n] * ALPHA;
                }
            }
            asm volatile("" ::: "memory");
        }
    }
};

__device__ __forceinline__ void phase_proj(const Params& p_in, int layer_in, char* smem) {
    const Params p = kparams(); const int layer = opaque_int(layer_in); (void)p_in;
    pg8::Gemm g; g.A = (const bf16_t*)(p.ws + OFF_HB); g.Bt = (const bf16_t*)(p.ws + OFF_WIN) + (size_t)layer * INWP * D; g.M = TP; g.N = INWP; g.K = D;
    pg8::StaticOrder S; S.init(TP, INWP, gridDim.x, opaque_bid());
    EpiProj E; E.ws = p.ws;
    pg8::gemm_phase((LAS unsigned char*)smem, g, S, E);
}
__device__ __forceinline__ void phase_outproj(const Params& p_in, int layer_in, char* smem) {
    const Params p = kparams(); const int layer = opaque_int(layer_in); (void)p_in;
    const bf16_t* MIXp = (const bf16_t*)(p.ws + OFF_MIX);
    const bf16_t* WOUT = (const bf16_t*)(p.ws + OFF_WOUT) + (size_t)layer * D * D;
    const float* H32 = (const float*)(p.ws + OFF_H32);
    float* Z = (float*)(p.ws + OFF_GQ);
    {
        pg8::Gemm g; g.A = MIXp; g.Bt = WOUT; g.M = 16384; g.N = D; g.K = D;
        pg8::StaticOrder S; S.init(16384, D, gridDim.x, opaque_bid());
        EpiOut E; E.H32 = H32; E.Z = Z;
        pg8::gemm_phase((LAS unsigned char*)smem, g, S, E);
    }
    const int tid = opaque_tid(), wid = __builtin_amdgcn_readfirstlane(tid >> 6), lane = tid & 63, fr = lane & 15, fq = lane >> 4;
    for (int task = opaque_bid(); task < 64; task += gridDim.x) {
        const int rg = task >> 3, cs = task & 7;
        const bf16_t* ap = MIXp + (size_t)(16384 + 16 * rg + fr) * D + 8 * fq;
        const bf16_t* bp = WOUT + (size_t)(128 * cs + 16 * wid + fr) * D + 8 * fq;
        f32x4 acc = {0.f, 0.f, 0.f, 0.f};
        bf16x8 a0[8], b0[8], a1[8], b1[8];
#pragma unroll
        for (int k = 0; k < 8; ++k) { a0[k] = *(const bf16x8*)(ap + 32 * k); b0[k] = *(const bf16x8*)(bp + 32 * k); }
#pragma unroll
        for (int ch = 0; ch < 4; ++ch) {
            if (ch < 3) {
#pragma unroll
                for (int k = 0; k < 8; ++k) { a1[k] = *(const bf16x8*)(ap + 256 * (ch + 1) + 32 * k); b1[k] = *(const bf16x8*)(bp + 256 * (ch + 1) + 32 * k); }
            }
#pragma unroll
            for (int k = 0; k < 8; ++k) acc = __builtin_amdgcn_mfma_f32_16x16x32_bf16(a0[k], b0[k], acc, 0, 0, 0);
#pragma unroll
            for (int k = 0; k < 8; ++k) { a0[k] = a1[k]; b0[k] = b1[k]; }
        }
#pragma unroll
        for (int r = 0; r < 4; ++r) {
            const size_t off = (size_t)(16384 + 16 * rg + 4 * fq + r) * D + 128 * cs + 16 * wid + fr;
            Z[off] = acc[r] + ALPHA * H32[off];
        }
    }
}

__device__ __forceinline__ void phase_gla_naive(const Params& p, int layer, char* smem) {
    float (*qs)[64] = (float (*)[64])smem;
    float (*ks)[64] = qs + 8;
    float (*es)[64] = ks + 8;
    float (*part)[8] = (float (*)[8])(es + 8);
    float (*os)[128] = (float (*)[128])(part + 2);
    const int tid = opaque_tid();
    const bf16_t* GQ = (const bf16_t*)(p.ws + OFF_GQ);
    const bf16_t* GK = (const bf16_t*)(p.ws + OFF_GK);
    const bf16_t* GV = (const bf16_t*)(p.ws + OFF_GV);
    const float* GLR = (const float*)(p.ws + OFF_GLR);
    bf16_t* MIX = (bf16_t*)(p.ws + OFF_MIX);
    const float* ng = p.norm_g + layer * 128;
    const float* wg2 = p.wg2 + (size_t)layer * 16 * 256; const float* bg = p.bg + layer * 256;
    for (int item = opaque_bid(); item < NB * 4; item += gridDim.x) {
        const int b = item >> 2, h = item & 3;
        float S[64];
#pragma unroll
        for (int d = 0; d < 64; ++d) S[d] = 0.f;
        const int e = tid & 127;
        const float nge = ng[e];
        const int ltt = tid >> 6, ld = tid & 63;
        float w[16];
#pragma unroll
        for (int rr = 0; rr < 16; ++rr) w[rr] = wg2[rr * 256 + h * 64 + ld];
        const float bgd = bg[h * 64 + ld];
        for (int t0 = 0; t0 < L; t0 += 8) {
            __syncthreads();
            {
                const size_t row = (size_t)b * L + t0 + ltt;
                qs[ltt][ld] = bf2f(GQ[row * 256 + h * 64 + ld]);
                ks[ltt][ld] = bf2f(GK[row * 256 + h * 64 + ld]);
                const float4* gp = (const float4*)&GLR[row * 16];
                const float4 g0 = gp[0], g1 = gp[1], g2 = gp[2], g3 = gp[3];
                float s = bgd;
                s = fmaf(g0.x, w[0], s); s = fmaf(g0.y, w[1], s); s = fmaf(g0.z, w[2], s); s = fmaf(g0.w, w[3], s);
                s = fmaf(g1.x, w[4], s); s = fmaf(g1.y, w[5], s); s = fmaf(g1.z, w[6], s); s = fmaf(g1.w, w[7], s);
                s = fmaf(g2.x, w[8], s); s = fmaf(g2.y, w[9], s); s = fmaf(g2.z, w[10], s); s = fmaf(g2.w, w[11], s);
                s = fmaf(g3.x, w[12], s); s = fmaf(g3.y, w[13], s); s = fmaf(g3.z, w[14], s); s = fmaf(g3.w, w[15], s);
                es[ltt][ld] = expf(logsigmoid_f(s) * (1.f / 16.f));
            }
            __syncthreads();
            if (tid < 128) {
#pragma unroll 1
                for (int tt = 0; tt < 8; ++tt) {
                    const size_t row = (size_t)b * L + t0 + tt;
                    const float v = bf2f(GV[row * 512 + h * 128 + e]);
                    float acc = 0.f;
#pragma unroll
                    for (int d = 0; d < 64; ++d) {
                        S[d] = fmaf(es[tt][d], S[d], ks[tt][d] * v);
                        acc = fmaf(qs[tt][d], S[d], acc);
                    }
                    os[tt][e] = acc;
                    const float ss = wave_sum(acc * acc);
                    if ((tid & 63) == 0) part[tid >> 6][tt] = ss;
                }
            }
            __syncthreads();
            if (tid < 128) {
#pragma unroll 1
                for (int tt = 0; tt < 8; ++tt) {
                    const size_t row = (size_t)b * L + t0 + tt;
                    const float tot = part[0][tt] + part[1][tt];
                    const float rinv = rsqrtf(tot * (1.f / 128) + LN_EPS);
                    const size_t idx = row * 1024 + h * 128 + e;
                    MIX[idx] = f2bf(os[tt][e] * rinv * nge * bf2f(MIX[idx]));
                }
            }
        }
    }
}

__device__ __forceinline__ unsigned okey(float x) {
    const unsigned u = __float_as_uint(x);
    return (u & 0x80000000u) ? ~u : (u | 0x80000000u);
}
__device__ __forceinline__ int wave_incl_scan(int v) {
    const int lane = opaque_tid() & 63;
#pragma unroll
    for (int o = 1; o < 64; o <<= 1) { const int n = __shfl_up(v, o); if (lane >= o) v += n; }
    return v;
}
__device__ __forceinline__ int block_excl_scan(int v, int* tmp) {
    const int incl = wave_incl_scan(v);
    const int tq = opaque_tid();
    __syncthreads();
    if ((tq & 63) == 63) tmp[tq >> 6] = incl;
    __syncthreads();
    const int w = tq >> 6;
    int base = 0;
    for (int i = 0; i < w; ++i) base += tmp[i];
    return base + incl - v;
}
__device__ __forceinline__ void unpack8(const uint4 u, float* kf) {
    kf[0] = __uint_as_float(u.x << 16); kf[1] = __uint_as_float(u.x & 0xFFFF0000u);
    kf[2] = __uint_as_float(u.y << 16); kf[3] = __uint_as_float(u.y & 0xFFFF0000u);
    kf[4] = __uint_as_float(u.z << 16); kf[5] = __uint_as_float(u.z & 0xFFFF0000u);
    kf[6] = __uint_as_float(u.w << 16); kf[7] = __uint_as_float(u.w & 0xFFFF0000u);
}

__device__ __forceinline__ void phase_dsa_naive(const Params& p, int layer, char* smem) {
    float* sc = (float*)smem;
    float (*iqs)[64] = (float (*)[64])(sc + 2080);
    float (*aqs)[64] = iqs + 8;
    float (*lg)[256] = (float (*)[256])(aqs + 8);
    unsigned* hist = (unsigned*)(lg + 8);
    int* sel = (int*)(hist + 256);
    int* misc = sel + 256;
    const int tid = opaque_tid();
    const bf16_t* IQ = (const bf16_t*)(p.ws + OFF_IQ);
    const bf16_t* IK = (const bf16_t*)(p.ws + OFF_IK);
    const float* IW = (const float*)(p.ws + OFF_IW);
    const bf16_t* AQ = (const bf16_t*)(p.ws + OFF_AQ);
    const bf16_t* AK = (const bf16_t*)(p.ws + OFF_AK);
    const bf16_t* AV = (const bf16_t*)(p.ws + OFF_AV);
    bf16_t* MIX = (bf16_t*)(p.ws + OFF_MIX);
    for (int item = opaque_bid(); item < T; item += gridDim.x) {
        const int b = item / L, t = item % L;
        const size_t row = (size_t)item;
        __syncthreads();
        iqs[tid >> 6][tid & 63] = bf2f(IQ[row * 512 + tid]); aqs[tid >> 6][tid & 63] = bf2f(AQ[row * 512 + tid]);
        __syncthreads();
        float w[8];
#pragma unroll
        for (int j = 0; j < 8; ++j) w[j] = IW[row * 8 + j];
        for (int s = tid; s <= t; s += NT) {
            const uint4* kp = (const uint4*)&IK[((size_t)b * L + s) * 64];
            float dd[8];
#pragma unroll
            for (int j = 0; j < 8; ++j) dd[j] = 0.f;
#pragma unroll 1
            for (int q = 0; q < 8; ++q) {
                float kf[8]; unpack8(kp[q], kf);
#pragma unroll
                for (int j = 0; j < 8; ++j) {
                    const float4 a0 = *(const float4*)&iqs[j][q * 8], a1 = *(const float4*)&iqs[j][q * 8 + 4];
                    dd[j] = fmaf(a0.x, kf[0], dd[j]); dd[j] = fmaf(a0.y, kf[1], dd[j]); dd[j] = fmaf(a0.z, kf[2], dd[j]); dd[j] = fmaf(a0.w, kf[3], dd[j]);
                    dd[j] = fmaf(a1.x, kf[4], dd[j]); dd[j] = fmaf(a1.y, kf[5], dd[j]); dd[j] = fmaf(a1.z, kf[6], dd[j]); dd[j] = fmaf(a1.w, kf[7], dd[j]);
                }
            }
            float score = 0.f;
#pragma unroll
            for (int j = 0; j < 8; ++j) score = fmaf(w[j], fmaxf(dd[j], 0.f), score);
            sc[s] = score;
        }
        __syncthreads();
        const int n = t + 1;
        int nsel;
        if (n <= TOPK) {
            if (tid < n) sel[tid] = tid;
            nsel = n;
        } else {
            unsigned prefix = 0; int remaining = TOPK;
            for (int pass = 0; pass < 4; ++pass) {
                const int shift = 24 - 8 * pass;
                if (tid < 256) hist[tid] = 0;
                __syncthreads();
                for (int s = tid; s < n; s += NT) {
                    const unsigned key = okey(sc[s]);
                    const bool match = (pass == 0) || ((key >> (shift + 8)) == prefix);
                    if (match) atomicAdd(&hist[(key >> shift) & 255u], 1u);
                }
                __syncthreads();
                if (tid == 0) {
                    int cum = 0, d = 255;
                    for (; d > 0; --d) { const int c = (int)hist[d]; if (cum + c >= remaining) break; cum += c; }
                    misc[0] = d; misc[1] = remaining - cum;
                }
                __syncthreads();
                prefix = (prefix << 8) | (unsigned)misc[0]; remaining = misc[1];
                __syncthreads();
            }
            const int s0 = tid * 5;
            int ceq = 0;
#pragma unroll
            for (int q = 0; q < 5; ++q) { const int s = s0 + q; if (s < n && okey(sc[s]) == prefix) ++ceq; }
            int eqrank = block_excl_scan(ceq, misc + 8);
            int csel = 0; unsigned selmask = 0;
#pragma unroll
            for (int q = 0; q < 5; ++q) {
                const int s = s0 + q;
                if (s < n) {
                    const unsigned key = okey(sc[s]);
                    bool take = key > prefix;
                    if (key == prefix) { take = eqrank < remaining; ++eqrank; }
                    if (take) { ++csel; selmask |= 1u << q; }
                }
            }
            int posn = block_excl_scan(csel, misc + 16);
#pragma unroll
            for (int q = 0; q < 5; ++q) if (selmask & (1u << q)) { if (posn < TOPK) sel[posn] = s0 + q; ++posn; }
            nsel = TOPK;
        }
        __syncthreads();
        {
            const int i = tid & 255, g = tid >> 8;
            if (i < nsel) {
                const int kidx = sel[i];
                const uint4* kp = (const uint4*)&AK[((size_t)b * L + kidx) * 128 + g * 64];
                float dd[4] = {0.f, 0.f, 0.f, 0.f};
#pragma unroll 1
                for (int q = 0; q < 8; ++q) {
                    float kf[8]; unpack8(kp[q], kf);
#pragma unroll
                    for (int r = 0; r < 4; ++r) {
                        const float4 a0 = *(const float4*)&aqs[g * 4 + r][q * 8], a1 = *(const float4*)&aqs[g * 4 + r][q * 8 + 4];
                        dd[r] = fmaf(a0.x, kf[0], dd[r]); dd[r] = fmaf(a0.y, kf[1], dd[r]); dd[r] = fmaf(a0.z, kf[2], dd[r]); dd[r] = fmaf(a0.w, kf[3], dd[r]);
                        dd[r] = fmaf(a1.x, kf[4], dd[r]); dd[r] = fmaf(a1.y, kf[5], dd[r]); dd[r] = fmaf(a1.z, kf[6], dd[r]); dd[r] = fmaf(a1.w, kf[7], dd[r]);
                    }
                }
#pragma unroll
                for (int r = 0; r < 4; ++r) lg[g * 4 + r][i] = dd[r];
            } else {
#pragma unroll
                for (int r = 0; r < 4; ++r) lg[g * 4 + r][i] = -INFINITY;
            }
        }
        __syncthreads();
        {
            const int h = tid >> 6, lane = tid & 63;
            float v0 = lg[h][lane], v1 = lg[h][lane + 64], v2 = lg[h][lane + 128], v3 = lg[h][lane + 192];
            const float m = wave_max(fmaxf(fmaxf(v0, v1), fmaxf(v2, v3)));
            v0 = expf(v0 - m); v1 = expf(v1 - m); v2 = expf(v2 - m); v3 = expf(v3 - m);
            const float inv = 1.f / wave_sum(v0 + v1 + v2 + v3);
            lg[h][lane] = v0 * inv; lg[h][lane + 64] = v1 * inv; lg[h][lane + 128] = v2 * inv; lg[h][lane + 192] = v3 * inv;
        }
        __syncthreads();
        {
            const int h = tid >> 6, d = tid & 63, g = h >> 2;
            float o = 0.f;
            for (int i = 0; i < nsel; ++i) o = fmaf(lg[h][i], bf2f(AV[((size_t)b * L + sel[i]) * 128 + g * 64 + d]), o);
            const size_t mi = row * 1024 + 512 + tid;
            MIX[mi] = f2bf(o * bf2f(MIX[mi]));
        }
    }
}


constexpr int DS_SC = 0, DS_BITS = 134144, DS_HIST = DS_BITS + 4224, DS_CAND = DS_HIST + 8 * 1040, DS_END = DS_CAND + 8 * 512;
constexpr int DS_TAB = 65536, DS_CONST = DS_TAB + 2112 * 32;
static_assert(DS_CONST + 32 <= DS_BITS, "bias table overlaps bitmask");


template <int NR>
__device__ __forceinline__ void dsa_select(const LAS unsigned* row, LAS unsigned* bits, LAS unsigned* hist, int n, int lane) {
    unsigned kreg[NR];
#pragma unroll
    for (int i = 0; i < NR; ++i) kreg[i] = (lane < n - 64 * i) ? okey(__uint_as_float(row[lane + 64 * i])) : 0u;
    unsigned prefix = 0; int remaining = TOPK;
#pragma unroll 1
    for (int pass = 0; pass < 4; ++pass) {
        const int shift = 24 - 8 * pass;
        *(LAS u32x4*)(hist + lane * 4) = (u32x4){0u, 0u, 0u, 0u};
        __builtin_amdgcn_wave_barrier(); asm volatile("" ::: "memory");
        const unsigned sh8 = (unsigned)(shift + 8) & 31u;
#pragma unroll
        for (int i = 0; i < NR; ++i) {
            const unsigned key = kreg[i];
            const bool match = (lane < n - 64 * i) && ((pass == 0) || ((key >> sh8) == prefix));
            if (match) __hip_atomic_fetch_add(hist + ((key >> shift) & 255u), 1u, __ATOMIC_RELAXED, __HIP_MEMORY_SCOPE_WAVEFRONT);
        }
        __builtin_amdgcn_wave_barrier(); asm volatile("s_waitcnt lgkmcnt(0)" ::: "memory");
        const u32x4 hv = *(const LAS u32x4*)(hist + (63 - lane) * 4);
        const int c0 = (int)hv[3], c1 = (int)hv[2], c2 = (int)hv[1], c3 = (int)hv[0];
        const int tot = c0 + c1 + c2 + c3;
        const int incl = wave_incl_scan(tot), excl = incl - tot;
        const bool found = (excl < remaining) && (remaining <= incl);
        int digit = 0, rem_new = 0;
        if (found) {
            int cum = excl;
            if (cum + c0 >= remaining) { digit = 255 - 4 * lane; rem_new = remaining - cum; }
            else { cum += c0;
                if (cum + c1 >= remaining) { digit = 254 - 4 * lane; rem_new = remaining - cum; }
                else { cum += c1;
                    if (cum + c2 >= remaining) { digit = 253 - 4 * lane; rem_new = remaining - cum; }
                    else { cum += c2; digit = 252 - 4 * lane; rem_new = remaining - cum; } } }
        }
        const unsigned long long fm = __ballot(found);
        const int src = (int)__builtin_ctzll(fm);
        digit = __builtin_amdgcn_readlane(digit, src); rem_new = __builtin_amdgcn_readlane(rem_new, src);
        prefix = (prefix << 8) | (unsigned)digit; remaining = rem_new;
    }
    const unsigned tkey = prefix;
    int eqcount = 0;
#pragma unroll
    for (int i = 0; i < 33; ++i) {
        if (i < NR) {
            const unsigned key = kreg[i < NR ? i : 0];
            const bool valid = lane < n - 64 * i;
            const bool gt = valid && (key > tkey), eq = valid && (key == tkey);
            const unsigned long long em = __ballot(eq);
            const int rank = eqcount + __popcll(em & ((1ull << lane) - 1ull));
            const bool sel = gt || (eq && rank < remaining);
            eqcount += __popcll(em);
            const unsigned long long sm = __ballot(sel);
            if (lane == 0) { bits[2 * i] = (unsigned)sm; bits[2 * i + 1] = (unsigned)(sm >> 32); }
        } else if (lane == 0) { bits[2 * i] = 0u; bits[2 * i + 1] = 0u; }
    }
}


template <int NR>
__device__ __forceinline__ bool dsa_select_v(const LAS unsigned* row, LAS unsigned* bits, LAS unsigned* hist, LAS unsigned* cand, int n, int lane) {
    float x[NR];
    const float qnan = __uint_as_float(0x7FC00000u);
#pragma unroll
    for (int i = 0; i < NR; ++i) x[i] = (lane < n - 64 * i) ? __uint_as_float(row[lane + 64 * i]) : qnan;
    float mn = x[0], mx = x[0];
#pragma unroll
    for (int i = 1; i < NR; ++i) { mn = fminf(mn, x[i]); mx = fmaxf(mx, x[i]); }
#pragma unroll
    for (int o = 32; o > 0; o >>= 1) { mn = fminf(mn, __shfl_xor(mn, o)); mx = fmaxf(mx, __shfl_xor(mx, o)); }
    bool ok = mx > mn;
    const float scale = 255.f / (mx - mn) * 0.99999f;
    int dstar = 0, rem = 0, cb = 0;
    if (ok) {
        *(LAS u32x4*)(hist + lane * 4) = (u32x4){0u, 0u, 0u, 0u};
        __builtin_amdgcn_wave_barrier(); asm volatile("" ::: "memory");
#pragma unroll
        for (int i = 0; i < NR; ++i) {
            const float xv = x[i];
            if (xv == xv) __hip_atomic_fetch_add(hist + (unsigned)(int)((xv - mn) * scale), 1u, __ATOMIC_RELAXED, __HIP_MEMORY_SCOPE_WAVEFRONT);
        }
        __builtin_amdgcn_wave_barrier(); asm volatile("s_waitcnt lgkmcnt(0)" ::: "memory");
        const u32x4 hv = *(const LAS u32x4*)(hist + (63 - lane) * 4);
        const int c0 = (int)hv[3], c1 = (int)hv[2], c2 = (int)hv[1], c3 = (int)hv[0];
        const int tot = c0 + c1 + c2 + c3;
        const int incl = wave_incl_scan(tot), excl = incl - tot;
        const bool found = (excl < TOPK) && (TOPK <= incl);
        int digit = 0, rem_new = 0, cnt = 0;
        if (found) {
            int cum = excl;
            if (cum + c0 >= TOPK) { digit = 255 - 4 * lane; rem_new = TOPK - cum; cnt = c0; }
            else { cum += c0;
                if (cum + c1 >= TOPK) { digit = 254 - 4 * lane; rem_new = TOPK - cum; cnt = c1; }
                else { cum += c1;
                    if (cum + c2 >= TOPK) { digit = 253 - 4 * lane; rem_new = TOPK - cum; cnt = c2; }
                    else { cum += c2; digit = 252 - 4 * lane; rem_new = TOPK - cum; cnt = c3; } } }
        }
        const unsigned long long fm = __ballot(found);
        const int src = (int)__builtin_ctzll(fm | (1ull << 63));
        dstar = __builtin_amdgcn_readlane(digit, src); rem = __builtin_amdgcn_readlane(rem_new, src); cb = __builtin_amdgcn_readlane(cnt, src);
        ok = (fm != 0ull) && (cb <= 64);
    }
    if (!ok) return false;
    int base = 0;
#pragma unroll
    for (int i = 0; i < NR; ++i) {
        const float xv = x[i];
        const bool inb = (xv == xv) && ((int)((xv - mn) * scale) == dstar);
        const unsigned long long bm = __ballot(inb);
        if (bm != 0ull) {
            if (inb) { const int pos = base + __popcll(bm & ((1ull << lane) - 1ull)); cand[2 * pos] = __float_as_uint(xv); cand[2 * pos + 1] = (unsigned)(lane + 64 * i); }
            base += __popcll(bm);
        }
    }
    __builtin_amdgcn_wave_barrier(); asm volatile("s_waitcnt lgkmcnt(0)" ::: "memory");
    float xc = qnan; int ic = 0x7fffffff;
    if (lane < cb) { xc = __uint_as_float(cand[2 * lane]); ic = (int)cand[2 * lane + 1]; }
    int rank = 0;
    for (int j = 0; j < cb; ++j) {
        const float xj = __builtin_bit_cast(float, __builtin_amdgcn_readlane(__builtin_bit_cast(int, xc), j));
        const int ij = __builtin_amdgcn_readlane(ic, j);
        rank += ((xj > xc) || (xj == xc && ij < ic)) ? 1 : 0;
    }
    const unsigned long long tm = __ballot((lane < cb) && (rank == rem - 1));
    const int tl = (int)__builtin_ctzll(tm | (1ull << 63));
    const float tx = __builtin_bit_cast(float, __builtin_amdgcn_readlane(__builtin_bit_cast(int, xc), tl));
    const int ti = __builtin_amdgcn_readlane(ic, tl);
#pragma unroll
    for (int i = 0; i < 33; ++i) {
        if (i < NR) {
            const float xv = x[i < NR ? i : 0];
            const bool sel = (xv > tx) || (xv == tx && (lane + 64 * i) <= ti);
            const unsigned long long sm = __ballot(sel);
            if (lane == 0) { bits[2 * i] = (unsigned)sm; bits[2 * i + 1] = (unsigned)(sm >> 32); }
        } else if (lane == 0) { bits[2 * i] = 0u; bits[2 * i + 1] = 0u; }
    }
    return true;
}

__device__ __forceinline__ void phase_dsa(const Params& p_in, int layer_in, char* smem, bool do_store) {
    const Params p = kparams(); const int layer = opaque_int(layer_in); (void)p_in;
    const int tid = opaque_tid(), wid = __builtin_amdgcn_readfirstlane(tid >> 6), lane_ = tid & 63, fr_ = lane_ & 15, fq_ = lane_ >> 4;
    LAS unsigned char* lds = (LAS unsigned char*)smem;
    const bf16_t* IQ = (const bf16_t*)(p.ws + OFF_IQ);
    const bf16_t* IK = (const bf16_t*)(p.ws + OFF_IK);
    const float* IW = (const float*)(p.ws + OFF_IW);
    const bf16_t* AQ = (const bf16_t*)(p.ws + OFF_AQ);
    const bf16_t* AK = (const bf16_t*)(p.ws + OFF_AK);
    const bf16_t* AVT = (const bf16_t*)(p.ws + OFF_AV);
    bf16_t* MIX = (bf16_t*)(p.ws + OFF_MIX);
    constexpr int NITEM = NB * 129;
    for (int idx = opaque_bid(); idx < NITEM; idx += gridDim.x) {
        const int b = idx & 7, mm = idx >> 3;
        int qr;
        { const int seg = mm >> 5, jj = mm & 31; qr = (seg == 0) ? jj : (seg == 1) ? 63 - jj : (seg == 2) ? 64 + jj : (seg == 3) ? 127 - jj : 128; }
        const int qt = 128 - qr, t0 = qt * 16;
        __syncthreads();
        for (int repA = 0; repA < PROBE_DSA_A; ++repA) {
            int fr = fr_, fq = fq_; asm volatile("" : "+v"(fr), "+v"(fq));
            const size_t rowq = (size_t)b * L + t0 + fr;
            bf16x8 qf[8][2];
#pragma unroll
            for (int jh = 0; jh < 8; ++jh)
#pragma unroll
                for (int s2 = 0; s2 < 2; ++s2) qf[jh][s2] = *(const bf16x8*)(IQ + rowq * 512 + jh * 64 + s2 * 32 + fq * 8);
            float w[8];
            { const f32x4 w0 = *(const f32x4*)(IW + rowq * 8), w1 = *(const f32x4*)(IW + rowq * 8 + 4);
              w[0] = w0[0]; w[1] = w0[1]; w[2] = w0[2]; w[3] = w0[3]; w[4] = w1[0]; w[5] = w1[1]; w[6] = w1[2]; w[7] = w1[3]; }
            const int ntile = qt + 1;
            const bf16x8 z8 = {0, 0, 0, 0, 0, 0, 0, 0};
            bf16x8 ka0 = z8, ka1 = z8, kb0 = z8, kb1 = z8, kc0 = z8, kc1 = z8;
            int kt = wid;
            if (kt < ntile) { const bf16_t* kp = IK + ((size_t)b * L + 16 * kt + fr) * 64 + fq * 8; ka0 = *(const bf16x8*)kp; ka1 = *(const bf16x8*)(kp + 32); }
            if (kt + 8 < ntile) { const bf16_t* kp = IK + ((size_t)b * L + 16 * (kt + 8) + fr) * 64 + fq * 8; kb0 = *(const bf16x8*)kp; kb1 = *(const bf16x8*)(kp + 32); }
            for (; kt < ntile; kt += 8) {
                if (kt + 16 < ntile) { const bf16_t* kp = IK + ((size_t)b * L + 16 * (kt + 16) + fr) * 64 + fq * 8; kc0 = *(const bf16x8*)kp; kc1 = *(const bf16x8*)(kp + 32); }
                f32x4 sc = {0.f, 0.f, 0.f, 0.f};
#pragma unroll
                for (int jh = 0; jh < 8; ++jh) {
                    f32x4 d = {0.f, 0.f, 0.f, 0.f};
                    d = __builtin_amdgcn_mfma_f32_16x16x32_bf16(ka0, qf[jh][0], d, 0, 0, 0);
                    d = __builtin_amdgcn_mfma_f32_16x16x32_bf16(ka1, qf[jh][1], d, 0, 0, 0);
#pragma unroll
                    for (int r = 0; r < 4; ++r) sc[r] = fmaf(w[jh], fmaxf(d[r], 0.f), sc[r]);
                }
                *(LAS f32x4*)(lds + DS_SC + (fr * 2064 + 16 * kt + 4 * fq) * 4) = sc;
                ka0 = kb0; ka1 = kb1; kb0 = kc0; kb1 = kc1;
            }
        }
        __syncthreads();
        for (int repB = 0; repB < PROBE_DSA_B; ++repB) {
            int lane = lane_; asm volatile("" : "+v"(lane));
            LAS unsigned* hist = (LAS unsigned*)(lds + DS_HIST + wid * 1040);
#pragma unroll 1
            for (int qq = 0; qq < 2; ++qq) {
                const int q = wid * 2 + qq;
                const int n = t0 + q + 1;
                const LAS unsigned* row = (const LAS unsigned*)(lds + DS_SC) + q * 2064;
                LAS unsigned* bits = (LAS unsigned*)(lds + DS_BITS) + q * 66;
                if (n <= TOPK) {
#pragma unroll 1
                    for (int i = 0; i < 33; ++i) {
                        const unsigned long long sm = __ballot(lane + 64 * i < n);
                        if (lane == 0) { bits[2 * i] = (unsigned)sm; bits[2 * i + 1] = (unsigned)(sm >> 32); }
                    }
                } else {
                    const int nr = (n + 63) >> 6;
                    LAS unsigned* cand = (LAS unsigned*)(lds + DS_CAND + wid * 512);
                    bool done;
                    if (nr <= 9) done = dsa_select_v<9>(row, bits, hist, cand, n, lane);
                    else if (nr <= 17) done = dsa_select_v<17>(row, bits, hist, cand, n, lane);
                    else if (nr <= 25) done = dsa_select_v<25>(row, bits, hist, cand, n, lane);
                    else done = dsa_select_v<33>(row, bits, hist, cand, n, lane);
                    if (!done) dsa_select<33>(row, bits, hist, n, lane);
                }
            }
        }
        __syncthreads();
        for (int repC = 0; repC < PROBE_DSA_C; ++repC) {
            if (repC > 0) __syncthreads();
            int fr = fr_, fq = fq_, lane = lane_; asm volatile("" : "+v"(fr), "+v"(fq), "+v"(lane));
            const size_t rowq = (size_t)b * L + t0 + fr;
            const int h = wid, g = h >> 2;
            const int nstep = (t0 + 16 + 63) >> 6;
            bf16x8 aqf[2];
            aqf[0] = *(const bf16x8*)(AQ + rowq * 512 + h * 64 + fq * 8);
            aqf[1] = *(const bf16x8*)(AQ + rowq * 512 + h * 64 + 32 + fq * 8);
            asm volatile("" : "+v"(aqf[0]), "+v"(aqf[1]));
            const int drow = 8 * wid + (lane >> 3);
            const int kch = (lane & 7) ^ (2 * ((drow >> 3) & 3) + ((drow >> 1) & 1)), vch = (lane & 7) ^ ((drow >> 1) & 7);
            const bf16_t* vsrc0 = AVT + ((size_t)b * 128 + drow) * LP + vch * 8;
#define DSA_DMA(st_, buf_) do { \
                int krow_ = b * L + 64 * (st_) + drow; krow_ = krow_ < T ? krow_ : T - 1; \
                const bf16_t* ks_ = AK + (size_t)krow_ * 128 + kch * 8; \
                LAS unsigned char* lb_ = lds + (buf_) * 32768 + wid * 1024; \
                __builtin_amdgcn_global_load_lds((const unsigned*)ks_, (LAS unsigned*)lb_, 16, 0, 0); \
                __builtin_amdgcn_global_load_lds((const unsigned*)(ks_ + 64), (LAS unsigned*)(lb_ + 8192), 16, 0, 0); \
                __builtin_amdgcn_global_load_lds((const unsigned*)(vsrc0 + 64 * (st_)), (LAS unsigned*)(lb_ + 16384), 16, 0, 0); \
                __builtin_amdgcn_global_load_lds((const unsigned*)(vsrc0 + (size_t)64 * LP + 64 * (st_)), (LAS unsigned*)(lb_ + 24576), 16, 0, 0); } while (0)
            DSA_DMA(0, 0);
            unsigned nb_lo = 0xC6EAu, nb_hi = 0xC6EA0000u; asm volatile("" : "+v"(nb_lo), "+v"(nb_hi));
            for (int key = tid; key < 2112; key += NT) {
                const int w32 = key & 31;
                const int R = (key >> 5) * 32 + ((w32 >> 2) & 1) * 16 + 4 * (w32 >> 3) + (w32 & 3);
                u32x4 lo, hi;
#pragma unroll
                for (int qp = 0; qp < 8; ++qp) {
                    const unsigned b0 = (*((const LAS unsigned*)(lds + DS_BITS) + (2 * qp) * 66 + (key >> 5)) >> w32) & 1u;
                    const unsigned b1 = (*((const LAS unsigned*)(lds + DS_BITS) + (2 * qp + 1) * 66 + (key >> 5)) >> w32) & 1u;
                    const unsigned v = (b0 ? 0u : nb_lo) | (b1 ? 0u : nb_hi);
                    if (qp < 4) lo[qp] = v; else hi[qp - 4] = v;
                }
                *(LAS u32x4*)(lds + DS_TAB + R * 32) = lo; *(LAS u32x4*)(lds + DS_TAB + R * 32 + 16) = hi;
            }
            if (tid < 8) *((LAS unsigned*)(lds + DS_CONST) + tid) = (tid == 0) ? 0x00003F80u : 0u;
            const int swzk = 2 * (fr >> 2) + ((fr >> 1) & 1);
            const int krow0 = 8 * (fr >> 2) + (fr & 3);
            const int tab_base = (fq < 2) ? DS_TAB + fr * 32 + 16 * fq : DS_CONST + 16 * (fq - 2);
            const int tab_mul = (fq < 2) ? 512 : 0;
            u32x4 bqw = {0u, 0u, 0u, 0u};
            if (fq < 2 && (fr >> 3) == fq) { const int j = fr & 7; bqw[j >> 1] = (j & 1) ? 0x3F800000u : 0x00003F80u; }
            u32x4 onw = {0u, 0u, 0u, 0u};
            if (fr == 0) onw = (u32x4){0x3F803F80u, 0x3F803F80u, 0x3F803F80u, 0x3F803F80u};
            const bf16x8 onesA = __builtin_bit_cast(bf16x8, onw);
            asm volatile("s_waitcnt vmcnt(0) lgkmcnt(0)" ::: "memory");
            __builtin_amdgcn_s_barrier();
            asm volatile("" ::: "memory");
            f32x4 O[4], O5 = {0.f, 0.f, 0.f, 0.f};
#pragma unroll
            for (int dt = 0; dt < 4; ++dt) O[dt] = (f32x4){0.f, 0.f, 0.f, 0.f};
            float mt = 0.f;
            for (int st = 0; st < nstep; ++st) {
                const int buf = st & 1;
                {
                    const int sn = (st + 1 < nstep) ? st + 1 : nstep - 1;
                    DSA_DMA(sn, buf ^ 1);
                }
                const LAS unsigned char* sb = lds + buf * 32768;
                const bf16x8 bq = __builtin_bit_cast(bf16x8, bqw);
                bf16x8 bfr[4], kfr[4][2];
#pragma unroll
                for (int kt = 0; kt < 4; ++kt) {
                    const int rowk = krow0 + 32 * (kt >> 1) + 4 * (kt & 1);
                    bfr[kt] = *(const LAS bf16x8*)(lds + tab_base + (4 * st + kt) * tab_mul);
#pragma unroll
                    for (int s2 = 0; s2 < 2; ++s2) kfr[kt][s2] = *(const LAS bf16x8*)(sb + g * 8192 + rowk * 128 + 16 * ((4 * s2 + fq) ^ swzk));
                }
                asm volatile("" ::: "memory");
                f32x4 S[4];
#pragma unroll
                for (int kt = 0; kt < 4; ++kt) {
                    S[kt] = __builtin_amdgcn_mfma_f32_16x16x32_bf16(bfr[kt], bq, (f32x4){0.f, 0.f, 0.f, 0.f}, 0, 0, 0);
                    S[kt] = __builtin_amdgcn_mfma_f32_16x16x32_bf16(kfr[kt][0], aqf[0], S[kt], 0, 0, 0);
                    S[kt] = __builtin_amdgcn_mfma_f32_16x16x32_bf16(kfr[kt][1], aqf[1], S[kt], 0, 0, 0);
                }
                bf16x8 vfr[2][4];
#pragma unroll
                for (int ks = 0; ks < 2; ++ks)
#pragma unroll
                    for (int dt = 0; dt < 4; ++dt) {
                        const int rowv = 16 * dt + fr;
                        vfr[ks][dt] = *(const LAS bf16x8*)(sb + 16384 + g * 8192 + rowv * 128 + 16 * ((4 * ks + fq) ^ ((rowv >> 1) & 7)));
                    }
                asm volatile("" ::: "memory");
                float pmax = fmaxf(fmaxf(S[0][0], S[0][1]), S[0][2]);
                pmax = fmaxf(fmaxf(pmax, S[0][3]), S[1][0]); pmax = fmaxf(fmaxf(pmax, S[1][1]), S[1][2]); pmax = fmaxf(fmaxf(pmax, S[1][3]), S[2][0]);
                pmax = fmaxf(fmaxf(pmax, S[2][1]), S[2][2]); pmax = fmaxf(fmaxf(pmax, S[2][3]), S[3][0]); pmax = fmaxf(fmaxf(pmax, S[3][1]), S[3][2]);
                pmax = fmaxf(pmax, S[3][3]);
                if (st == 0 || __any(pmax > 11.5f)) {
                    float pm = fmaxf(pmax, __shfl_xor(pmax, 16)); pm = fmaxf(pm, __shfl_xor(pm, 32));
                    const float up = (st == 0) ? fmaxf(pm, -64.f) : fmaxf(pm, 0.f);
                    const float mn = __uint_as_float((unsigned)f2bf(mt + up) << 16);
                    const float dlt = mt - mn;
                    const float alpha = __builtin_amdgcn_exp2f(dlt);
#pragma unroll
                    for (int dt = 0; dt < 4; ++dt) O[dt] *= alpha;
                    O5 *= alpha;
#pragma unroll
                    for (int kt = 0; kt < 4; ++kt) S[kt] += dlt;
                    mt = mn;
                    if (fq == 2) bqw[0] = (unsigned)f2bf(-mt);
                }
                unsigned pk[4][2];
#pragma unroll
                for (int kt = 0; kt < 4; ++kt) {
                    const float e0 = __builtin_amdgcn_exp2f(S[kt][0]), e1 = __builtin_amdgcn_exp2f(S[kt][1]), e2 = __builtin_amdgcn_exp2f(S[kt][2]), e3 = __builtin_amdgcn_exp2f(S[kt][3]);
                    pk[kt][0] = cvt_pk_bf16(e0, e1); pk[kt][1] = cvt_pk_bf16(e2, e3);
                }
#pragma unroll
                for (int ks = 0; ks < 2; ++ks) {
                    u32x4 pw; pw[0] = pk[2 * ks][0]; pw[1] = pk[2 * ks][1]; pw[2] = pk[2 * ks + 1][0]; pw[3] = pk[2 * ks + 1][1];
                    const bf16x8 pf = __builtin_bit_cast(bf16x8, pw);
                    O5 = __builtin_amdgcn_mfma_f32_16x16x32_bf16(onesA, pf, O5, 0, 0, 0);
#pragma unroll
                    for (int dt = 0; dt < 4; ++dt) O[dt] = __builtin_amdgcn_mfma_f32_16x16x32_bf16(vfr[ks][dt], pf, O[dt], 0, 0, 0);
                }
                asm volatile("s_waitcnt vmcnt(0)" ::: "memory");
                __builtin_amdgcn_s_barrier();
                asm volatile("" ::: "memory");
            }
#undef DSA_DMA
            const float l = __shfl(O5[0], fr);
            const float inv = 1.f / fmaxf(l, 1e-30f);
            bf16_t* mp = MIX + rowq * 1024 + 512 + h * 64 + 4 * fq;
            if (do_store && repC == PROBE_DSA_C - 1)
#pragma unroll
            for (int dt = 0; dt < 4; ++dt) {
                const uint2 gz = *(const uint2*)(mp + 16 * dt);
                const float g0 = __uint_as_float(gz.x << 16), g1 = __uint_as_float(gz.x & 0xFFFF0000u), g2 = __uint_as_float(gz.y << 16), g3 = __uint_as_float(gz.y & 0xFFFF0000u);
                uint2 o; o.x = cvt_pk_bf16(O[dt][0] * inv * g0, O[dt][1] * inv * g1); o.y = cvt_pk_bf16(O[dt][2] * inv * g2, O[dt][3] * inv * g3);
                *(uint2*)(mp + 16 * dt) = o;
            }
        }
    }
}

__device__ __forceinline__ void rope16(const u32x4 a, const u32x4 b, const float2* rp, u32x4& oa, u32x4& ob) {
    const f32x4 r0 = *(const f32x4*)(rp), r1 = *(const f32x4*)(rp + 2), r2 = *(const f32x4*)(rp + 4), r3 = *(const f32x4*)(rp + 6);
    const float cs[8] = {r0[0], r0[2], r1[0], r1[2], r2[0], r2[2], r3[0], r3[2]};
    const float sn[8] = {r0[1], r0[3], r1[1], r1[3], r2[1], r2[3], r3[1], r3[3]};
    float o1[8], o2[8];
#pragma unroll
    for (int i = 0; i < 4; ++i) {
        const float x1l = __uint_as_float(a[i] << 16), x1h = __uint_as_float(a[i] & 0xFFFF0000u);
        const float x2l = __uint_as_float(b[i] << 16), x2h = __uint_as_float(b[i] & 0xFFFF0000u);
        o1[2 * i] = x1l * cs[2 * i] - x2l * sn[2 * i]; o1[2 * i + 1] = x1h * cs[2 * i + 1] - x2h * sn[2 * i + 1];
        o2[2 * i] = x2l * cs[2 * i] + x1l * sn[2 * i]; o2[2 * i + 1] = x2h * cs[2 * i + 1] + x1h * sn[2 * i + 1];
    }
#pragma unroll
    for (int i = 0; i < 4; ++i) { oa[i] = cvt_pk_bf16(o1[2 * i], o1[2 * i + 1]); ob[i] = cvt_pk_bf16(o2[2 * i], o2[2 * i + 1]); }
}
__device__ __forceinline__ void phase_rope(const Params& p_in, int layer_in, char* smem) {
    const Params p = kparams(); const int layer = opaque_int(layer_in); (void)p_in;
    const int tid = opaque_tid();
    const float2* ROPE = (const float2*)(p.ws + OFF_ROPE);
    const int nthr = gridDim.x * NT, gid = opaque_bid() * NT + tid;
    for (int th = gid; th < T * 18; th += nthr) {
        const int t = th / 18, hh = th - t * 18, pos = t % L;
        bf16_t* base = (hh < 8) ? (bf16_t*)(p.ws + OFF_AQ) + (size_t)t * 512 + hh * 64
                     : (hh < 16) ? (bf16_t*)(p.ws + OFF_IQ) + (size_t)t * 512 + (hh - 8) * 64
                                 : (bf16_t*)(p.ws + OFF_AK) + (size_t)t * 128 + (hh - 16) * 64;
        const u32x4 a = *(const u32x4*)base, b = *(const u32x4*)(base + 8);
        u32x4 oa, ob; rope16(a, b, ROPE + pos * 8, oa, ob);
        *(u32x4*)base = oa; *(u32x4*)(base + 8) = ob;
    }
    const float* IKR = (const float*)(p.ws + OFF_IKR);
    bf16_t* IK = (bf16_t*)(p.ws + OFF_IK);
    const float* ikg = p.ikg + layer * 64; const float* ikb = p.ikb + layer * 64;
    for (int t = gid; t < T; t += nthr) {
        const int pos = t % L;
        f32x4 x[16];
#pragma unroll
        for (int i = 0; i < 16; ++i) x[i] = *(const f32x4*)(IKR + (size_t)t * 64 + 4 * i);
        float sm = 0.f;
#pragma unroll
        for (int i = 0; i < 16; ++i) sm += (x[i][0] + x[i][1]) + (x[i][2] + x[i][3]);
        const float mu = sm * (1.f / 64);
        float qq = 0.f;
#pragma unroll
        for (int i = 0; i < 16; ++i) { const f32x4 d = x[i] - mu; qq += (d[0] * d[0] + d[1] * d[1]) + (d[2] * d[2] + d[3] * d[3]); }
        const float rs = rsqrtf(qq * (1.f / 64) + LN_EPS);
#pragma unroll
        for (int i = 0; i < 16; ++i) { const f32x4 g = *(const f32x4*)(ikg + 4 * i), bb = *(const f32x4*)(ikb + 4 * i); x[i] = (x[i] - mu) * rs * g + bb; }
        const float2* rp = ROPE + pos * 8;
        const f32x4 r0 = *(const f32x4*)(rp), r1 = *(const f32x4*)(rp + 2), r2 = *(const f32x4*)(rp + 4), r3 = *(const f32x4*)(rp + 6);
        const float cs[8] = {r0[0], r0[2], r1[0], r1[2], r2[0], r2[2], r3[0], r3[2]};
        const float sn[8] = {r0[1], r0[3], r1[1], r1[3], r2[1], r2[3], r3[1], r3[3]};
#pragma unroll
        for (int i = 0; i < 8; ++i) {
            const float x1 = x[i >> 2][i & 3], x2 = x[2 + (i >> 2)][i & 3];
            x[i >> 2][i & 3] = x1 * cs[i] - x2 * sn[i];
            x[2 + (i >> 2)][i & 3] = x2 * cs[i] + x1 * sn[i];
        }
#pragma unroll
        for (int i = 0; i < 8; ++i) {
            u32x4 o; o[0] = cvt_pk_bf16(x[2 * i][0], x[2 * i][1]); o[1] = cvt_pk_bf16(x[2 * i][2], x[2 * i][3]); o[2] = cvt_pk_bf16(x[2 * i + 1][0], x[2 * i + 1][1]); o[3] = cvt_pk_bf16(x[2 * i + 1][2], x[2 * i + 1][3]);
            *(u32x4*)(IK + (size_t)t * 64 + 8 * i) = o;
        }
    }
}

constexpr int GL_QE = 0, GL_KN = 8192, GL_SEG = 16384, GL_PART = 18432;
__device__ __forceinline__ void gla_cumsum(const Params& p, int layer, int b, int h, int c, int tid, LAS unsigned char* lds, float (&bc)[8], float& blast) {
    const int d = tid & 63, seg = tid >> 6;
    const float* wg2 = p.wg2 + (size_t)layer * 16 * 256 + h * 64 + d;
    float w[16];
#pragma unroll
    for (int rr = 0; rr < 16; ++rr) w[rr] = wg2[rr * 256];
    const float bgd = p.bg[layer * 256 + h * 64 + d];
    const float* GLR = (const float*)(p.ws + OFF_GLR);
    float pb = 0.f;
#pragma unroll
    for (int i = 0; i < 8; ++i) {
        const int pos = 64 * c - 48 + 8 * seg + i;
        float gl = 0.f;
        if (pos >= 0) {
            const f32x4* gp = (const f32x4*)(GLR + ((size_t)b * L + pos) * 16);
            const f32x4 g0 = gp[0], g1 = gp[1], g2 = gp[2], g3 = gp[3];
            float x = bgd;
#pragma unroll
            for (int rr = 0; rr < 4; ++rr) { x = fmaf(g0[rr], w[rr], x); }
#pragma unroll
            for (int rr = 0; rr < 4; ++rr) { x = fmaf(g1[rr], w[4 + rr], x); }
#pragma unroll
            for (int rr = 0; rr < 4; ++rr) { x = fmaf(g2[rr], w[8 + rr], x); }
#pragma unroll
            for (int rr = 0; rr < 4; ++rr) { x = fmaf(g3[rr], w[12 + rr], x); }
            gl = logsigmoid_fast(x) * (1.f / 16.f);
        }
        pb += gl; bc[i] = pb;
    }
    LAS float* segs = (LAS float*)(lds + GL_SEG);
    segs[seg * 64 + d] = pb;
    __syncthreads();
    float base = 0.f, tot = 0.f;
#pragma unroll
    for (int sg = 0; sg < 8; ++sg) { const float v = segs[sg * 64 + d]; tot += v; base += (sg < seg) ? v : 0.f; }
#pragma unroll
    for (int i = 0; i < 8; ++i) bc[i] += base;
    blast = tot;
}

constexpr size_t OUTS_QE = 0, OUTS_KN = (size_t)T * 256 * 2;
__device__ __forceinline__ void phase_gla_a(const Params& p_in, int layer_in, char* smem) {
    const Params p = kparams(); const int layer = opaque_int(layer_in); (void)p_in;
    const int tid = opaque_tid(), wid = __builtin_amdgcn_readfirstlane(tid >> 6), lane = tid & 63, fr = lane & 15, fq = lane >> 4;
    LAS unsigned char* ldw = (LAS unsigned char*)smem + wid * 8192;
    const bf16_t* GQ = (const bf16_t*)(p.ws + OFF_GQ);
    const bf16_t* GK = (const bf16_t*)(p.ws + OFF_GK);
    const bf16_t* GVT = (const bf16_t*)(p.ws + OFF_GV);
    const float* GLR = (const float*)(p.ws + OFF_GLR);
    bf16_t* QE = (bf16_t*)((char*)p.out + OUTS_QE);
    bf16_t* KN = (bf16_t*)((char*)p.out + OUTS_KN);
    float* UT = (float*)(p.ws + OFF_UT);
    float* DL = (float*)(p.ws + OFF_DL);
    const int wstride = gridDim.x * 8;
    for (int task = wid * (int)gridDim.x + opaque_bid(); task < 32 * 33; task += wstride) {
        const int bh = task / 33, c = task - bh * 33, b = bh >> 2, h = bh & 3;
        const int d = lane;
        float w[16];
#pragma unroll
        for (int rr = 0; rr < 16; ++rr) w[rr] = p.wg2[(size_t)layer * 16 * 256 + rr * 256 + h * 64 + d];
        const float bgd = p.bg[layer * 256 + h * 64 + d];
        float bsum = 0.f;
        const int rowi0 = b * L + 64 * c - 48;
        f32x4 g4[4];
#pragma unroll
        for (int m = 0; m < 4; ++m) { int rr_ = rowi0 + ((lane + 64 * m) >> 2); rr_ = rr_ > 0 ? rr_ : 0; g4[m] = *(const f32x4*)(GLR + (size_t)rr_ * 16 + 4 * (lane & 3)); }
        LAS unsigned char* ldg = (LAS unsigned char*)smem + 65536 + wid * 4096;
#pragma unroll
        for (int m = 0; m < 4; ++m) *(LAS f32x4*)(ldg + (lane + 64 * m) * 16) = g4[m];
        unsigned qk[64];
#pragma unroll
        for (int t = 0; t < 64; ++t) { int rr_ = rowi0 + t; rr_ = rr_ > 0 ? rr_ : 0; const size_t o_ = (size_t)rr_ * 256 + h * 64 + d; qk[t] = (unsigned)GQ[o_] | ((unsigned)GK[o_] << 16); }
        float kn[8];
        __builtin_amdgcn_wave_barrier(); asm volatile("s_waitcnt lgkmcnt(0)" ::: "memory");
#pragma unroll
        for (int t = 0; t < 64; ++t) {
            const bool valid = (c > 0) || (t >= 48);
            float x = bgd;
            {
                const LAS f32x4* gp = (const LAS f32x4*)(ldg + t * 64);
                const f32x4 g0 = gp[0], g1 = gp[1], g2 = gp[2], g3 = gp[3];
#pragma unroll
                for (int rr = 0; rr < 4; ++rr) x = fmaf(g0[rr], w[rr], x);
#pragma unroll
                for (int rr = 0; rr < 4; ++rr) x = fmaf(g1[rr], w[4 + rr], x);
#pragma unroll
                for (int rr = 0; rr < 4; ++rr) x = fmaf(g2[rr], w[8 + rr], x);
#pragma unroll
                for (int rr = 0; rr < 4; ++rr) x = fmaf(g3[rr], w[12 + rr], x);
            }
            bsum += valid ? logsigmoid_fast(x) * (1.f / 16.f) : 0.f;
            const float eb = __expf(bsum);
            const float qv = __uint_as_float(qk[t] << 16), kv = __uint_as_float(qk[t] & 0xFFFF0000u);
            const float knv = valid ? kv * __builtin_amdgcn_rcpf(eb) : 0.f;
            kn[t & 7] = knv;
            if (valid) {
                const size_t o_ = (size_t)(rowi0 + t) * 256 + h * 64 + d;
                QE[o_] = f2bf(qv * eb);
                KN[o_] = f2bf(knv);
            }
            if ((t & 7) == 7 && c < 32) {
                u32x4 o; o[0] = cvt_pk_bf16(kn[0], kn[1]); o[1] = cvt_pk_bf16(kn[2], kn[3]); o[2] = cvt_pk_bf16(kn[4], kn[5]); o[3] = cvt_pk_bf16(kn[6], kn[7]);
                *(LAS u32x4*)(ldw + d * 128 + 16 * ((t >> 3) ^ (d & 7))) = o;
            }
        }
        if (c < 32) {
            const float dl = __expf(bsum);
            DL[((size_t)bh * 32 + c) * 64 + d] = dl;
            __builtin_amdgcn_wave_barrier(); asm volatile("s_waitcnt lgkmcnt(0)" ::: "memory");
            bf16x8 kf[4][2]; float dls[4];
#pragma unroll
            for (int dt = 0; dt < 4; ++dt) {
                const int rowd = 16 * dt + fr;
                dls[dt] = __shfl(dl, rowd);
#pragma unroll
                for (int ks = 0; ks < 2; ++ks) kf[dt][ks] = *(const LAS bf16x8*)(ldw + rowd * 128 + 16 * ((4 * ks + fq) ^ (rowd & 7)));
            }
            const bf16x8 z8 = {0, 0, 0, 0, 0, 0, 0, 0};
            bf16x8 vfa[8][2];
#pragma unroll
            for (int et = 0; et < 8; ++et) {
                const bf16_t* vp = GVT + ((size_t)bh * 128 + 16 * et + fr) * LPV + 64 * c + 8 * fq;
                vfa[et][0] = *(const bf16x8*)vp; vfa[et][1] = *(const bf16x8*)(vp + 32);
            }
            asm volatile("" ::: "memory");
#pragma unroll
            for (int et = 0; et < 8; ++et) {
                bf16x8 v0 = vfa[et][0], v1 = vfa[et][1];
                v0 = (c == 0) ? z8 : v0; v1 = (c == 0 && fq < 2) ? z8 : v1;
#pragma unroll
                for (int dt = 0; dt < 4; ++dt) {
                    f32x4 acc = {0.f, 0.f, 0.f, 0.f};
                    acc = __builtin_amdgcn_mfma_f32_16x16x32_bf16(v0, kf[dt][0], acc, 0, 0, 0);
                    acc = __builtin_amdgcn_mfma_f32_16x16x32_bf16(v1, kf[dt][1], acc, 0, 0, 0);
                    float* up = UT + (((size_t)bh * 32 + c) * 128 + 16 * et + 4 * fq) * 64 + 16 * dt + fr;
#pragma unroll
                    for (int r = 0; r < 4; ++r) up[r * 64] = acc[r] * dls[dt];
                }
            }
            __builtin_amdgcn_wave_barrier(); asm volatile("s_waitcnt lgkmcnt(0)" ::: "memory");
        }
    }
}

__device__ __forceinline__ void phase_gla_scan(const Params& p_in, int layer_in, char* smem) {
    const Params p = kparams(); const int layer = opaque_int(layer_in); (void)p_in;
    const int tid = opaque_tid();
    const float* UT = (const float*)(p.ws + OFF_UT);
    const float* DL = (const float*)(p.ws + OFF_DL);
    bf16_t* ST = (bf16_t*)(p.ws + OFF_ST);
    const int nthr = gridDim.x * NT;
    for (int el = opaque_bid() * NT + tid; el < 32 * 8192; el += nthr) {
        const int bh = el >> 13, ed = el & 8191, d = el & 63;
        float sacc = 0.f;
        ST[((size_t)bh * 33) * 8192 + ed] = 0;
#pragma unroll 1
        for (int c0 = 0; c0 < 32; c0 += 16) {
            float u[16], dl[16];
#pragma unroll
            for (int i = 0; i < 16; ++i) { u[i] = UT[((size_t)(bh * 32 + c0 + i)) * 8192 + ed]; dl[i] = DL[(size_t)(bh * 32 + c0 + i) * 64 + d]; }
#pragma unroll
            for (int i = 0; i < 16; ++i) { sacc = fmaf(dl[i], sacc, u[i]); ST[((size_t)bh * 33 + c0 + i + 1) * 8192 + ed] = f2bf(sacc); }
        }
    }
}

__device__ __forceinline__ void phase_gla_c(const Params& p_in, int layer_in, char* smem, bool do_store) {
    const Params p = kparams(); const int layer = opaque_int(layer_in); (void)p_in;
    const int tid = opaque_tid(), wid = __builtin_amdgcn_readfirstlane(tid >> 6), lane = tid & 63, fr = lane & 15, fq = lane >> 4;
    const bf16_t* QE = (const bf16_t*)((const char*)p.out + OUTS_QE);
    const bf16_t* KN = (const bf16_t*)((const char*)p.out + OUTS_KN);
    const bf16_t* GVT = (const bf16_t*)(p.ws + OFF_GV);
    const bf16_t* ST = (const bf16_t*)(p.ws + OFF_ST);
    bf16_t* MIX = (bf16_t*)(p.ws + OFF_MIX);
    const float* ng = p.norm_g + layer * 128;
    const bf16x8 z8 = {0, 0, 0, 0, 0, 0, 0, 0};
    const int nwt = 32 * 33 * 4, wstride = gridDim.x * 8;
    for (int wt = wid * (int)gridDim.x + opaque_bid(); wt < nwt; wt += wstride) {
        const int task = wt >> 2, tw = wt & 3;
        const int bh = task / 33, c = task - bh * 33, b = bh >> 2, h = bh & 3;
        const int pos_t = 64 * c - 48 + 16 * tw + fr;
        if (c == 0 && tw < 3) continue;
        bf16x8 qf[2], kf[4][2];
        {
            const bf16_t* qp = QE + ((size_t)b * L + pos_t) * 256 + h * 64 + 8 * fq;
            qf[0] = *(const bf16x8*)qp; qf[1] = *(const bf16x8*)(qp + 32);
#pragma unroll
            for (int st = 0; st < 4; ++st) {
                const int pos_s = 64 * c - 48 + 16 * st + fr;
                const bf16_t* kp = KN + ((size_t)b * L + (pos_s > 0 ? pos_s : 0)) * 256 + h * 64 + 8 * fq;
                kf[st][0] = *(const bf16x8*)kp; kf[st][1] = *(const bf16x8*)(kp + 32);
            }
        }
        bf16x8 sf[4][2]; u32x2 vv[4][4];
#define GLC_LOAD_HALF(hf) do { _Pragma("unroll") for (int e4 = 0; e4 < 4; ++e4) { const int e0 = 16 * (4 * (hf) + e4); \
                const bf16_t* sp = ST + (((size_t)bh * 33 + c) * 128 + e0 + fr) * 64 + 8 * fq; \
                const bf16_t* vp = GVT + ((size_t)bh * 128 + e0 + fr) * LPV + 64 * c + 4 * fq; \
                sf[e4][0] = *(const bf16x8*)sp; sf[e4][1] = *(const bf16x8*)(sp + 32); \
                vv[e4][0] = *(const u32x2*)vp; vv[e4][1] = *(const u32x2*)(vp + 16); vv[e4][2] = *(const u32x2*)(vp + 32); vv[e4][3] = *(const u32x2*)(vp + 48); } \
            asm volatile("" ::: "memory"); } while (0)
        GLC_LOAD_HALF(0);
        unsigned pk[4][2];
#pragma unroll
        for (int st = 0; st < 4; ++st) {
            f32x4 a = {0.f, 0.f, 0.f, 0.f};
            const int pos_s = 64 * c - 48 + 16 * st + fr;
            const bf16x8 k0 = (pos_s >= 0) ? kf[st][0] : z8, k1 = (pos_s >= 0) ? kf[st][1] : z8;
            a = __builtin_amdgcn_mfma_f32_16x16x32_bf16(k0, qf[0], a, 0, 0, 0);
            a = __builtin_amdgcn_mfma_f32_16x16x32_bf16(k1, qf[1], a, 0, 0, 0);
#pragma unroll
            for (int r = 0; r < 4; ++r) a[r] = (16 * st + 4 * fq + r > 16 * tw + fr) ? 0.f : a[r];
            pk[st][0] = cvt_pk_bf16(a[0], a[1]); pk[st][1] = cvt_pk_bf16(a[2], a[3]);
        }
        bf16x8 pf[2];
#pragma unroll
        for (int ks = 0; ks < 2; ++ks) { u32x4 pw; pw[0] = pk[2 * ks][0]; pw[1] = pk[2 * ks][1]; pw[2] = pk[2 * ks + 1][0]; pw[3] = pk[2 * ks + 1][1]; pf[ks] = __builtin_bit_cast(bf16x8, pw); }
        f32x4 O[8];
        float ss = 0.f;
        const u32x2 z2 = {0u, 0u};
#pragma unroll
        for (int hf = 0; hf < 2; ++hf) {
            if (hf == 1) GLC_LOAD_HALF(1);
#pragma unroll
            for (int e4 = 0; e4 < 4; ++e4) {
                f32x4 acc = {0.f, 0.f, 0.f, 0.f};
                acc = __builtin_amdgcn_mfma_f32_16x16x32_bf16(sf[e4][0], qf[0], acc, 0, 0, 0);
                acc = __builtin_amdgcn_mfma_f32_16x16x32_bf16(sf[e4][1], qf[1], acc, 0, 0, 0);
                u32x2 va = vv[e4][0], vb = vv[e4][1], vc = vv[e4][2], vd = vv[e4][3];
                va = (c == 0) ? z2 : va; vb = (c == 0) ? z2 : vb; vc = (c == 0) ? z2 : vc;
                u32x4 vw; vw[0] = va[0]; vw[1] = va[1]; vw[2] = vb[0]; vw[3] = vb[1];
                acc = __builtin_amdgcn_mfma_f32_16x16x32_bf16(__builtin_bit_cast(bf16x8, vw), pf[0], acc, 0, 0, 0);
                u32x4 vx; vx[0] = vc[0]; vx[1] = vc[1]; vx[2] = vd[0]; vx[3] = vd[1];
                acc = __builtin_amdgcn_mfma_f32_16x16x32_bf16(__builtin_bit_cast(bf16x8, vx), pf[1], acc, 0, 0, 0);
                O[4 * hf + e4] = acc;
                ss += acc[0] * acc[0] + acc[1] * acc[1] + acc[2] * acc[2] + acc[3] * acc[3];
            }
        }
#undef GLC_LOAD_HALF
        ss += __shfl_xor(ss, 16); ss += __shfl_xor(ss, 32);
        const float rinv = rsqrtf(ss * (1.f / 128) + LN_EPS);
        if (pos_t >= 0 && do_store) {
            bf16_t* mp = MIX + ((size_t)b * L + pos_t) * 1024 + h * 128 + 4 * fq;
#pragma unroll
            for (int et = 0; et < 8; ++et) {
                const uint2 gz = *(const uint2*)(mp + 16 * et);
                const f32x4 nv = *(const f32x4*)(ng + 16 * et + 4 * fq);
                const float g0 = __uint_as_float(gz.x << 16), g1 = __uint_as_float(gz.x & 0xFFFF0000u), g2 = __uint_as_float(gz.y << 16), g3 = __uint_as_float(gz.y & 0xFFFF0000u);
                uint2 o; o.x = cvt_pk_bf16(O[et][0] * rinv * nv[0] * g0, O[et][1] * rinv * nv[1] * g1); o.y = cvt_pk_bf16(O[et][2] * rinv * nv[2] * g2, O[et][3] * rinv * nv[3] * g3);
                *(uint2*)(mp + 16 * et) = o;
            }
        }
    }
}

__device__ __forceinline__ void phase_ln(const Params& p_in, int layer_in, char* smem) {
    const Params p = kparams(); const int layer = opaque_int(layer_in); (void)p_in;
    const int tid = opaque_tid(), wid = tid >> 6, lane = tid & 63;
    const float* Z = (const float*)(p.ws + OFF_GQ);
    float* H32 = (float*)(p.ws + OFF_H32);
    bf16_t* HB = (bf16_t*)(p.ws + OFF_HB);
    const float* g = p.ln_g + layer * D; const float* bb = p.ln_b + layer * D;
    const int nw = gridDim.x * 8;
    int t = opaque_bid() * 8 + wid;
    f32x4 v[4], vn[4];
    if (t < T) {
#pragma unroll
        for (int i = 0; i < 4; ++i) v[i] = *(const f32x4*)(Z + (size_t)t * D + 4 * lane + 256 * i);
    }
    for (; t < T; t += nw) {
        const int tn = t + nw;
        if (tn < T) {
#pragma unroll
            for (int i = 0; i < 4; ++i) vn[i] = *(const f32x4*)(Z + (size_t)tn * D + 4 * lane + 256 * i);
        }
        ln_row_wave(v, g, bb, lane);
        if (layer == DEPTH - 1) {
            const int b = t / L, pos = t - b * L;
            if (pos >= NMETA) {
#pragma unroll
                for (int i = 0; i < 4; ++i) *(f32x4*)(p.out + ((size_t)b * SEQ + (pos - NMETA)) * D + 4 * lane + 256 * i) = v[i];
            }
        } else {
#pragma unroll
            for (int i = 0; i < 4; ++i) {
                *(f32x4*)(H32 + (size_t)t * D + 4 * lane + 256 * i) = v[i];
                u32x2 o; o[0] = cvt_pk_bf16(v[i][0], v[i][1]); o[1] = cvt_pk_bf16(v[i][2], v[i][3]);
                *(u32x2*)(HB + (size_t)t * D + 4 * lane + 256 * i) = o;
            }
        }
#pragma unroll
        for (int i = 0; i < 4; ++i) v[i] = vn[i];
    }
}

#define XB_TMO      128
#define XB_XCNT(j)  (256  + 64 * (j))
#define XB_XSUB(j)  (1280 + 64 * (j))
#define XB_XGEN(j)  (2304 + 64 * (j))
#define XB_TOP      3328
#define XB_TOPGEN   3392
#define XCD_BAR_WORDS 3456
#define XB_SPIN_CAP (1u << 22)
__device__ __forceinline__ unsigned xb_ld(unsigned* p)              { return __hip_atomic_load(p, __ATOMIC_RELAXED, __HIP_MEMORY_SCOPE_AGENT); }
__device__ __forceinline__ unsigned xb_add(unsigned* p, unsigned v) { return __hip_atomic_fetch_add(p, v, __ATOMIC_RELAXED, __HIP_MEMORY_SCOPE_AGENT); }
__device__ __forceinline__ unsigned xb_xcc_id() { return (unsigned)__builtin_amdgcn_s_getreg((3 << 11) | 20) & 0xFu; }
#define XB_SPIN(cond, bar) do { unsigned _sp = 0; while (cond) { __builtin_amdgcn_s_sleep(1); \
    if ((++_sp & 255u) == 0u) { if (xb_ld(&(bar)[XB_TMO])) break; if (_sp > XB_SPIN_CAP) { atomicAdd(&(bar)[XB_TMO], 1u); break; } } } } while (0)
struct XcdBarrier { unsigned* bar; unsigned x; volatile LAS unsigned* st; };
__device__ __forceinline__ XcdBarrier xcd_barrier_post(unsigned* bar, volatile LAS unsigned* st) {
    XcdBarrier b; b.bar = bar; b.x = xb_xcc_id(); b.st = st;
    if (threadIdx.x == 0) (void)xb_add(&bar[XB_XCNT(b.x)], 1u);
    return b;
}
__device__ __forceinline__ void xcd_barrier_complete(unsigned* bar, unsigned x, unsigned& nloc, unsigned& nx) {
    const unsigned G = gridDim.x * gridDim.y * gridDim.z;
    unsigned sum, cnt, mine, sp = 0u;
    for (;;) {
        sum = 0u; cnt = 0u; mine = 0u;
#pragma unroll
        for (unsigned j = 0; j < 16; ++j) { const unsigned c = xb_ld(&bar[XB_XCNT(j)]); sum += c; cnt += (c > 0u) ? 1u : 0u; mine = (j == x) ? c : mine; }
        if (sum == G) break;
        __builtin_amdgcn_s_sleep(1);
        if ((++sp & 255u) == 0u) { if (xb_ld(&bar[XB_TMO])) break; if (sp > XB_SPIN_CAP) { atomicAdd(&bar[XB_TMO], 1u); break; } }
    }
    nloc = mine > 0u ? mine : 1u; nx = cnt > 0u ? cnt : 1u;
}
__device__ __forceinline__ void xcd_barrier(unsigned* bar_, volatile LAS unsigned* st_) {
    XcdBarrier b; b.bar = bar_; b.x = xb_xcc_id(); b.st = st_;
    asm volatile("s_waitcnt vmcnt(0)" ::: "memory");
    __syncthreads();
    if (opaque_tid() == 0) {
        unsigned* bar = b.bar;
        __builtin_amdgcn_s_waitcnt(0);
        unsigned nloc = b.st[0], nx = b.st[1];
        if (nloc == 0u) { xcd_barrier_complete(bar, b.x, nloc, nx); b.st[0] = nloc; b.st[1] = nx; }
        const unsigned old = xb_add(&bar[XB_XSUB(b.x)], 1u);
        const unsigned gen = old / nloc;
        if (old + 1u == (gen + 1u) * nloc) {
            __builtin_amdgcn_fence(__ATOMIC_RELEASE, "agent");
            asm volatile("s_waitcnt vmcnt(0)" ::: "memory");
            const unsigned og = xb_add(&bar[XB_TOP], 1u);
            const unsigned tg = og / nx;
            if (og + 1u == (tg + 1u) * nx) xb_add(&bar[XB_TOPGEN], 1u);
            else XB_SPIN(xb_ld(&bar[XB_TOPGEN]) == tg, bar);
            __builtin_amdgcn_fence(__ATOMIC_ACQUIRE, "agent");
            xb_add(&bar[XB_XGEN(b.x)], 1u);
            asm volatile("s_waitcnt vmcnt(0)" ::: "memory");
        } else {
            XB_SPIN(xb_ld(&bar[XB_XGEN(b.x)]) == gen, bar);
            __builtin_amdgcn_fence(__ATOMIC_ACQUIRE, "agent");
            asm volatile("s_waitcnt vmcnt(0)" ::: "memory");
        }
    }
    __syncthreads();
}

constexpr int SMEM_BYTES = 160 * 1024;
static_assert(DS_END <= SMEM_BYTES - 16 - 64, "dsa lds");
static_assert(WVTAB_OFF == SMEM_BYTES - 16 - 64, "wave table");

__global__ void __launch_bounds__(NT, 2) k_mega(Params p) {
    __shared__ __attribute__((aligned(16))) char smem[SMEM_BYTES];
    volatile LAS unsigned* xbw = (volatile LAS unsigned*)((LAS unsigned char*)smem + (SMEM_BYTES - 16));
    if (threadIdx.x == 0) { xbw[0] = 0u; xbw[1] = 0u; xbw[2] = 0u; xbw[3] = 0u; }
    {
        const unsigned slot = (unsigned)__builtin_amdgcn_s_getreg(((6 - 1) << 11) | 4) & 63u;
        if ((threadIdx.x & 63) == 0) *((volatile LAS unsigned char*)smem + WVTAB_OFF + slot) = (unsigned char)(threadIdx.x >> 6);
    }
    __syncthreads();
    if (p.ws == nullptr) cg::this_grid().sync();
    (void)xcd_barrier_post((unsigned*)(p.ws + OFF_BAR), xbw);
    for (int rep = 0; rep < PROBE_REP_PREP; ++rep) {
    phase_prep(p, smem);
    xcd_barrier((unsigned*)(p.ws + OFF_BAR), xbw);
    }
#pragma unroll 1
    for (int layer = 0; layer < DEPTH; ++layer) {
        for (int rep = 0; rep < PROBE_REP_PROJ; ++rep) {
        phase_proj(p, layer, smem);
        xcd_barrier((unsigned*)(p.ws + OFF_BAR), xbw);
        }
        phase_rope(p, layer, smem);
        for (int rep = 0; rep < PROBE_REP_GLAA; ++rep) {
        phase_gla_a(p, layer, smem);
        xcd_barrier((unsigned*)(p.ws + OFF_BAR), xbw);
        phase_gla_scan(p, layer, smem);
        xcd_barrier((unsigned*)(p.ws + OFF_BAR), xbw);
        }
        for (int rep = 0; rep < PROBE_REP_GLAC; ++rep) phase_gla_c(p, layer, smem, rep == PROBE_REP_GLAC - 1);
        for (int rep = 0; rep < PROBE_REP_DSA; ++rep) phase_dsa(p, layer, smem, rep == PROBE_REP_DSA - 1);
        xcd_barrier((unsigned*)(p.ws + OFF_BAR), xbw);
        for (int rep = 0; rep < PROBE_REP_OUT; ++rep) {
        phase_outproj(p, layer, smem);
        xcd_barrier((unsigned*)(p.ws + OFF_BAR), xbw);
        }
        for (int rep = 0; rep < PROBE_REP_LN; ++rep) {
        phase_ln(p, layer, smem);
        xcd_barrier((unsigned*)(p.ws + OFF_BAR), xbw);
        }
    }
}

extern "C" void kernel_launch(void* const* d_in, const int* in_sizes, int n_in, void* d_out, int out_size, void* d_ws, size_t ws_size,
                              hipStream_t stream) {
    Params p{};
    p.x = (const float*)d_in[0]; p.meta = (const float*)d_in[1]; p.ln_in_g = (const float*)d_in[2]; p.ln_in_b = (const float*)d_in[3];
    p.w_in = (const float*)d_in[4]; p.wg2 = (const float*)d_in[5]; p.bg = (const float*)d_in[6]; p.norm_g = (const float*)d_in[7];
    p.ikg = (const float*)d_in[8]; p.ikb = (const float*)d_in[9]; p.w_out = (const float*)d_in[10]; p.ln_g = (const float*)d_in[11];
    p.ln_b = (const float*)d_in[12];
    p.out = (float*)d_out; p.ws = (char*)d_ws;
    static int grid_blocks = 0;
    if (!grid_blocks) {
        int dev = 0, cus = 0, per_cu = 0;
        hipGetDevice(&dev);
        hipDeviceGetAttribute(&cus, hipDeviceAttributeMultiprocessorCount, dev);
        hipOccupancyMaxActiveBlocksPerMultiprocessor(&per_cu, k_mega, NT, 0);
        if (per_cu > 1) per_cu = 1;
        grid_blocks = cus * per_cu;
    }
    (void)hipMemsetAsync((char*)d_ws + OFF_BAR, 0, XCD_BAR_WORDS * 4, stream);
    void* args[] = {&p};
    (void)hipLaunchCooperativeKernel((void*)k_mega, dim3(grid_blocks), dim3(NT), args, 0, stream);
}
```

```cpp
#include <hip/hip_runtime.h>
#include <hip/hip_cooperative_groups.h>
#include <stdint.h>
namespace cg = cooperative_groups;
#ifndef PROBE_REP_PREP
#define PROBE_REP_PREP 1
#define PROBE_REP_PROJ 1
#define PROBE_REP_GLAA 1
#define PROBE_REP_GLAC 1
#define PROBE_REP_DSA 1
#define PROBE_REP_OUT 1
#define PROBE_REP_LN 1
#define PROBE_DSA_A 1
#define PROBE_DSA_B 1
#define PROBE_DSA_C 1
#endif

constexpr int D = 1024, NB = 8, SEQ = 2048, NMETA = 16, L = 2064, T = NB * L;
constexpr int DEPTH = 2;
constexpr int INW = 3416, INWP = 3584;
constexpr int TP = 16640;
constexpr int NT = 512;
constexpr int TOPK = 256;
constexpr float LN_EPS = 1e-5f;
constexpr float ALPHA = 1.41421356237309515f;

typedef unsigned short bf16_t;
typedef short bf16x8 __attribute__((ext_vector_type(8)));
typedef float f32x4 __attribute__((ext_vector_type(4)));
#define LAS __attribute__((address_space(3)))

constexpr size_t SZ_H32 = (size_t)T * D * 4;
constexpr size_t SZ_HB = (size_t)TP * D * 2;
constexpr size_t SZ_WIN = (size_t)DEPTH * INWP * D * 2;
constexpr size_t SZ_WOUT = (size_t)DEPTH * D * D * 2;
constexpr int LPV = 2112;
constexpr size_t SZ_GQ = (size_t)T * 256 * 2, SZ_GK = SZ_GQ, SZ_GV = (size_t)NB * 4 * 128 * LPV * 2;
constexpr size_t SZ_UT = (size_t)1024 * 128 * 64 * 4, SZ_ST = (size_t)32 * 33 * 128 * 64 * 2, SZ_DL = (size_t)1024 * 64 * 4;
constexpr size_t SZ_AQ = (size_t)T * 512 * 2, SZ_IQ = (size_t)T * 512 * 2;
constexpr size_t SZ_MIX = (size_t)TP * 1024 * 2;
constexpr int LP = 2112;
constexpr size_t SZ_AK = (size_t)T * 128 * 2, SZ_AV = (size_t)NB * 2 * 64 * LP * 2, SZ_IK = (size_t)T * 64 * 2, SZ_IW = (size_t)T * 8 * 4;
constexpr size_t SZ_GLR = (size_t)T * 16 * 4;
constexpr size_t SZ_ROPE = (size_t)L * 8 * 2 * 4;

constexpr size_t OFF_H32 = 0;
constexpr size_t OFF_HB = OFF_H32 + SZ_H32;
constexpr size_t OFF_WIN = OFF_HB + SZ_HB;
constexpr size_t OFF_WOUT = OFF_WIN + SZ_WIN;
constexpr size_t OFF_GQ = OFF_WOUT + SZ_WOUT;
constexpr size_t OFF_GK = OFF_GQ + SZ_GQ;
constexpr size_t OFF_GV = OFF_GK + SZ_GK;
constexpr size_t OFF_AQ = OFF_GV + SZ_GV;
constexpr size_t OFF_IQ = OFF_AQ + SZ_AQ;
constexpr size_t OFF_MIX = OFF_IQ + SZ_IQ;
constexpr size_t OFF_AK = OFF_MIX + SZ_MIX;
constexpr size_t OFF_AV = OFF_AK + SZ_AK;
constexpr size_t OFF_IK = OFF_AV + SZ_AV;
constexpr size_t OFF_IW = OFF_IK + SZ_IK;
constexpr size_t OFF_GLR = OFF_IW + SZ_IW;
constexpr size_t OFF_ROPE = OFF_GLR + SZ_GLR;
constexpr size_t OFF_ST = OFF_ROPE + SZ_ROPE;
constexpr size_t OFF_DL = OFF_ST + SZ_ST;
constexpr size_t OFF_BAR = OFF_DL + SZ_DL;
constexpr size_t OFF_IKR = OFF_BAR + 16384;
constexpr size_t OFF_END = OFF_IKR + (size_t)T * 64 * 4;
constexpr size_t OFF_UT = OFF_HB;
static_assert(SZ_UT <= SZ_HB, "UT alias");
static_assert(SZ_GQ + SZ_GK + SZ_GV + SZ_AQ + SZ_IQ >= SZ_H32, "Z alias size");
static_assert(OFF_END <= (size_t)256 * 1024 * 1024, "workspace too large");

struct Params {
    const float* x; const float* meta; const float* ln_in_g; const float* ln_in_b;
    const float* w_in; const float* wg2; const float* bg; const float* norm_g;
    const float* ikg; const float* ikb; const float* w_out; const float* ln_g; const float* ln_b;
    float* out; char* ws;
};
typedef const Params __attribute__((address_space(4))) * KParamsPtr;
__device__ __forceinline__ Params kparams() {
    unsigned long long a = (unsigned long long)__builtin_amdgcn_kernarg_segment_ptr();
    asm volatile("" : "+s"(a));
    KParamsPtr q = (KParamsPtr)a;
    Params r;
    r.x = q->x; r.meta = q->meta; r.ln_in_g = q->ln_in_g; r.ln_in_b = q->ln_in_b; r.w_in = q->w_in; r.wg2 = q->wg2; r.bg = q->bg; r.norm_g = q->norm_g;
    r.ikg = q->ikg; r.ikb = q->ikb; r.w_out = q->w_out; r.ln_g = q->ln_g; r.ln_b = q->ln_b; r.out = q->out; r.ws = q->ws;
    return r;
}

__device__ __forceinline__ bf16_t f2bf(float f) {
    unsigned u = __float_as_uint(f);
    u += 0x7FFFu + ((u >> 16) & 1u);
    return (bf16_t)(u >> 16);
}
__device__ __forceinline__ unsigned pack2bf(float lo, float hi) { return (unsigned)f2bf(lo) | ((unsigned)f2bf(hi) << 16); }
__device__ __forceinline__ unsigned cvt_pk_bf16(float lo, float hi) { unsigned r; asm volatile("v_cvt_pk_bf16_f32 %0, %1, %2" : "=v"(r) : "v"(lo), "v"(hi)); return r; }
typedef unsigned u32x4 __attribute__((ext_vector_type(4)));
typedef unsigned u32x2 __attribute__((ext_vector_type(2)));
__device__ __forceinline__ float bf2f(bf16_t h) { return __uint_as_float(((unsigned)h) << 16); }
constexpr int WVTAB_OFF = 160 * 1024 - 16 - 64;
__device__ __forceinline__ int opaque_tid() {
    const unsigned slot = (unsigned)__builtin_amdgcn_s_getreg(((6 - 1) << 11) | 4) & 63u;
    const unsigned wv = *((const volatile LAS unsigned char*)(size_t)WVTAB_OFF + slot);
    int t = (int)(wv << 6) | (int)__builtin_amdgcn_mbcnt_hi(~0u, __builtin_amdgcn_mbcnt_lo(~0u, 0u));
    asm volatile("" : "+v"(t)); return t;
}
__device__ __forceinline__ int opaque_int(int v) { asm volatile("" : "+s"(v)); return v; }
__device__ __forceinline__ int opaque_bid() { int t = blockIdx.x; asm volatile("" : "+s"(t)); return t; }
__device__ __forceinline__ float wave_sum(float v) {
#pragma unroll
    for (int o = 32; o > 0; o >>= 1) v += __shfl_xor(v, o);
    return v;
}
__device__ __forceinline__ float wave_max(float v) {
#pragma unroll
    for (int o = 32; o > 0; o >>= 1) v = fmaxf(v, __shfl_xor(v, o));
    return v;
}
__device__ __forceinline__ float block_sum(float v, float* red) {
    v = wave_sum(v);
    const int tq = opaque_tid();
    __syncthreads();
    if ((tq & 63) == 0) red[tq >> 6] = v;
    __syncthreads();
    return ((red[0] + red[1]) + (red[2] + red[3])) + ((red[4] + red[5]) + (red[6] + red[7]));
}
__device__ __forceinline__ float silu_f(float x) { return x / (1.f + __expf(-x)); }
__device__ __forceinline__ float logsigmoid_f(float x) { return fminf(x, 0.f) - log1pf(expf(-fabsf(x))); }
__device__ __forceinline__ float logsigmoid_fast(float x) { return fminf(x, 0.f) - __logf(1.f + __expf(-fabsf(x))); }

__device__ __forceinline__ int proj_src_col(int n) {
    if (n < 1024) return n;
    if (n < 1536) return n - 1024 + 1040;
    if (n < 2048) return n - 1536 + 1552;
    if (n < 2560) return n - 2048 + 2904;
    if (n < 3072) return n - 2560 + 2320;
    if (n < 3200) return n - 3072 + 2064;
    if (n < 3328) return n - 3200 + 2192;
    const int c = n - 3328;
    if (c < 32) return 2832 + c;
    if (c < 48) return 1024 + (c - 32);
    if (c < 56) return 2896 + (c - 48);
    if (c >= 128 && c < 160) return 2832 + 32 + (c - 128);
    return -1;
}

__device__ __forceinline__ void sincos_acc(float a, float& s, float& c) {
    double ad = (double)a;
    double kd = rint(ad * 0.63661977236758134308);
    double r = fma(-kd, 1.57079632679489655800, ad);
    r = fma(-kd, 6.12323399573676603587e-17, r);
    double r2 = r * r;
    double sp = r * (1.0 + r2 * (-1.0 / 6 + r2 * (1.0 / 120 + r2 * (-1.0 / 5040 + r2 * (1.0 / 362880 + r2 * (-1.0 / 39916800))))));
    double cp = 1.0 + r2 * (-0.5 + r2 * (1.0 / 24 + r2 * (-1.0 / 720 + r2 * (1.0 / 40320 + r2 * (-1.0 / 3628800 + r2 * (1.0 / 479001600))))));
    int q = ((int)kd) & 3;
    double ss = (q & 1) ? cp : sp, cc = (q & 1) ? sp : cp;
    if (q == 1 || q == 2) cc = -cc;
    if (q == 2 || q == 3) ss = -ss;
    s = (float)ss; c = (float)cc;
}

__device__ __forceinline__ void ln_row_wave(f32x4 (&v)[4], const float* g, const float* bb, int lane) {
    float sm = 0.f;
#pragma unroll
    for (int i = 0; i < 4; ++i) sm += (v[i][0] + v[i][1]) + (v[i][2] + v[i][3]);
    const float mu = wave_sum(sm) * (1.f / D);
    float qq = 0.f;
#pragma unroll
    for (int i = 0; i < 4; ++i) { v[i] = v[i] - mu; qq += (v[i][0] * v[i][0] + v[i][1] * v[i][1]) + (v[i][2] * v[i][2] + v[i][3] * v[i][3]); }
    const float rs = rsqrtf(wave_sum(qq) * (1.f / D) + LN_EPS);
#pragma unroll
    for (int i = 0; i < 4; ++i) { const f32x4 gg = *(const f32x4*)(g + 4 * lane + 256 * i), b4 = *(const f32x4*)(bb + 4 * lane + 256 * i); v[i] = v[i] * rs * gg + b4; }
}
__device__ __forceinline__ int proj_dst_col(int src) {
    if (src < 1024) return src;
    if (src < 1040) return 3328 + 32 + (src - 1024);
    if (src < 1552) return 1024 + (src - 1040);
    if (src < 2064) return 1536 + (src - 1552);
    if (src < 2192) return 3072 + (src - 2064);
    if (src < 2320) return 3200 + (src - 2192);
    if (src < 2832) return 2560 + (src - 2320);
    if (src < 2864) return 3328 + (src - 2832);
    if (src < 2896) return 3328 + 128 + (src - 2864);
    if (src < 2904) return 3328 + 48 + (src - 2896);
    return 2048 + (src - 2904);
}
__device__ __forceinline__ void phase_prep(const Params& p_in, char* smem) {
    const Params p = kparams(); (void)p_in;
    const int tid = opaque_tid(), wid = tid >> 6, lane = tid & 63;
    bf16_t* WIN = (bf16_t*)(p.ws + OFF_WIN);
    bf16_t* WOUT = (bf16_t*)(p.ws + OFF_WOUT);
    float* H32 = (float*)(p.ws + OFF_H32);
    bf16_t* HB = (bf16_t*)(p.ws + OFF_HB);
    bf16_t* MIX = (bf16_t*)(p.ws + OFF_MIX);
    float2* ROPE = (float2*)(p.ws + OFF_ROPE);
    float (*tile)[65] = (float (*)[65])smem;
    constexpr int NCT_IN = (INW + 63) / 64, NT_IN = DEPTH * 16 * NCT_IN, NT_OUT = DEPTH * 16 * 16;
    for (int item = opaque_bid(); item < NT_IN + NT_OUT; item += gridDim.x) {
        const bool is_in = item < NT_IN;
        const int it = is_in ? item : item - NT_IN;
        const int nct = is_in ? NCT_IN : 16, ldw = is_in ? INW : D;
        const int l = it / (16 * nct), rem = it - l * 16 * nct, kt = rem / nct, ct = rem - kt * nct;
        const float* W = (is_in ? p.w_in : p.w_out) + (size_t)l * D * ldw;
        __syncthreads();
#pragma unroll
        for (int i = 0; i < 8; ++i) {
            const int e = tid + NT * i, kk = e >> 6, nn = e & 63, col = ct * 64 + nn;
            tile[kk][nn] = (col < ldw) ? W[(size_t)(kt * 64 + kk) * ldw + col] : 0.f;
        }
        __syncthreads();
        {
            const int nn = tid >> 3, k8 = (tid & 7) * 8, src = ct * 64 + nn;
            if (src < ldw) {
                const int dst = is_in ? proj_dst_col(src) : src;
                u32x4 o;
#pragma unroll
                for (int q = 0; q < 4; ++q) o[q] = cvt_pk_bf16(tile[k8 + 2 * q][nn], tile[k8 + 2 * q + 1][nn]);
                bf16_t* dstp = (is_in ? WIN + ((size_t)l * INWP + dst) * D : WOUT + ((size_t)l * D + dst) * D) + kt * 64 + k8;
                *(u32x4*)dstp = o;
            }
        }
    }
    {
        const int nw = gridDim.x * 8;
        for (int t = opaque_bid() * 8 + wid; t < TP; t += nw) {
            if (t < T) {
                const int b = t / L, pos = t - b * L;
                const float* src = (pos < NMETA) ? (p.meta + (size_t)pos * D) : (p.x + ((size_t)b * SEQ + (pos - NMETA)) * D);
                f32x4 v[4];
#pragma unroll
                for (int i = 0; i < 4; ++i) v[i] = *(const f32x4*)(src + 4 * lane + 256 * i);
                ln_row_wave(v, p.ln_in_g, p.ln_in_b, lane);
#pragma unroll
                for (int i = 0; i < 4; ++i) {
                    *(f32x4*)(H32 + (size_t)t * D + 4 * lane + 256 * i) = v[i];
                    u32x2 o; o[0] = cvt_pk_bf16(v[i][0], v[i][1]); o[1] = cvt_pk_bf16(v[i][2], v[i][3]);
                    *(u32x2*)(HB + (size_t)t * D + 4 * lane + 256 * i) = o;
                }
            } else {
#pragma unroll
                for (int i = 0; i < 4; ++i) {
                    *(u32x2*)(HB + (size_t)t * D + 4 * lane + 256 * i) = (u32x2){0u, 0u};
                    *(u32x2*)(MIX + (size_t)t * D + 4 * lane + 256 * i) = (u32x2){0u, 0u};
                }
            }
        }
    }
    for (int e = opaque_bid() * NT + tid; e < L * 8; e += gridDim.x * NT) {
        const int pos = e >> 3, i = e & 7;
        const float inv[8] = {1.0f, 0.19392274f, 0.03760603f, 0.0072926646f, 0.0014142136f, 0.0002742482f, 5.3182957e-05f, 1.0313385e-05f};
        float iv = inv[0];
#pragma unroll
        for (int j = 1; j < 8; ++j) iv = (i == j) ? inv[j] : iv;
        const float ang = (float)pos * iv;
        float sn, cs; sincos_acc(ang, sn, cs);
        ROPE[e] = make_float2(cs, sn);
    }
}

namespace pg8 {
constexpr int BM = 256, BK = 64, HALF = 128, HTB = HALF * BK * 2  , STAGE_BYTES = 8 * HTB, NXCD = 8, WGM = 8;
__device__ __forceinline__ int lds_byte(int r, int c) { const int st = (r >> 4) * 2 + (c >> 5), rr = r & 15, cc = c & 31, ob = rr * 64 + cc * 2; return st * 1024 + (ob ^ (((ob >> 9) & 1) << 5)); }
__device__ __forceinline__ void stage_rc(int b, int& R, int& C) { const int st = b / 1024, sb = b % 1024, swz = sb ^ (((sb >> 9) & 1) << 5); R = (st >> 1) * 16 + swz / 64; C = (st & 1) * 32 + (swz % 64) / 2; }
__device__ __forceinline__ int perm32(int rho) { const int n = rho >> 4, i = rho & 15; return 8 * (i >> 2) + 4 * n + (i & 3); }

struct Unit { int pm, pn; };
struct Gemm { const bf16_t* A; const bf16_t* Bt; int M, N, K; };

struct StaticOrder {
    int nM, nN, nwg, G, c;
    __device__ void init(int M, int N, int G_, int c_) { nM = M / BM; nN = N / BM; nwg = nM * nN; G = G_; c = c_; }
    __device__ bool next(int i, Unit& u) const {
        const long Lx = (long)i * G + c; if (Lx >= nwg) return false;
        int wgid = (int)Lx; { const int q = nwg / NXCD, r = nwg % NXCD, xcd = wgid % NXCD, off = wgid / NXCD; wgid = (xcd < r ? xcd * (q + 1) : r * (q + 1) + (xcd - r) * q) + off; }
        const int nig = WGM * nN, gid = wgid / nig, fm = gid * WGM, gsz = (nM - fm) < WGM ? (nM - fm) : WGM;
        u.pm = fm + ((wgid % nig) % gsz); u.pn = (wgid % nig) / gsz; return true;
    }
    __device__ __forceinline__ void a_ready(const Unit&) const {}
    __device__ __forceinline__ void done(const Unit&) const {}
};

template <class Epi, class Sched>
__device__ __forceinline__ void gemm_phase(LAS unsigned char* lds, const Gemm g, const Sched& S, const Epi& E) {
    const int tid = opaque_tid(), wid = __builtin_amdgcn_readfirstlane(tid >> 6), lane = tid & 63, wr = wid >> 2, wc = wid & 3, fr = lane & 15, fq = lane >> 4;
    const int K = g.K, nt = K / BK;
    unsigned voffA[2], voffB[2];
#pragma unroll
    for (int i = 0; i < 2; ++i) { int R, C; stage_rc(tid * 16 + i * 8192, R, C); const int Rb = Epi::PERM ? ((R & ~31) + perm32(R & 31)) : R;
        voffA[i] = (unsigned)(R * K + C) * 2u; voffB[i] = (unsigned)(Rb * K + C) * 2u; }
    const size_t kstep = (size_t)(BK * 2);
    const size_t hstep = (size_t)HALF * K * 2;
    const size_t tstep = 2 * hstep;
    const unsigned ldsw = (unsigned)wid * 1024u;
    const int aoff = lds_byte(wr * 64 + fr, fq * 8), boff = lds_byte(wc * 32 + fr, fq * 8);
#define PG8_SA(b, h) (((b) * 2 + (h)) * HTB)
#define PG8_SB(b, h) ((4 + (b) * 2 + (h)) * HTB)
#define PG8_STAGE(bufoff, gbase, voff) do { _Pragma("unroll") for (int _i = 0; _i < 2; ++_i) \
        __builtin_amdgcn_global_load_lds((const unsigned*)((const char*)(gbase) + (voff)[_i]), (LAS unsigned*)(lds + (bufoff) + ldsw + _i * 8192), 16, 0, 0); } while (0)
    const LAS unsigned char* la_base = lds + aoff; asm volatile("" : "+v"(la_base));
    const LAS unsigned char* lb_base = lds + 4 * HTB + boff; asm volatile("" : "+v"(lb_base));
#define PG8_LDA(dst, b, h) do { _Pragma("unroll") for (int m = 0; m < 4; ++m) _Pragma("unroll") for (int k = 0; k < 2; ++k) dst[m][k] = *(const LAS bf16x8*)(la_base + PG8_SA(b, h) + m * 2048 + k * 1024); } while (0)
#define PG8_LDB(dst, b, h) do { _Pragma("unroll") for (int n = 0; n < 2; ++n) _Pragma("unroll") for (int k = 0; k < 2; ++k) dst[n][k] = *(const LAS bf16x8*)(lb_base + (PG8_SB(b, h) - 4 * HTB) + n * 2048 + k * 1024); } while (0)
#define PG8_MMA(ai, bj, At, Bt) do { __builtin_amdgcn_s_setprio(1); _Pragma("unroll") for (int m = 0; m < 4; ++m) _Pragma("unroll") for (int n = 0; n < 2; ++n) _Pragma("unroll") for (int k = 0; k < 2; ++k) \
        acc[ai][bj][m][n] = __builtin_amdgcn_mfma_f32_16x16x32_bf16(Bt[n][k], At[m][k], acc[ai][bj][m][n], 0, 0, 0); __builtin_amdgcn_s_setprio(0); } while (0)
#define PG8_WAIT_V(n) asm volatile("s_waitcnt vmcnt(" #n ")" ::: "memory")
#define PG8_WAIT_L(n) asm volatile("s_waitcnt lgkmcnt(" #n ")" ::: "memory")
#define PG8_BAR __builtin_amdgcn_s_barrier()
#define PG8_SCHED __builtin_amdgcn_sched_barrier(0)
    Unit cur, nxt; int ui = 0;
    if (!S.next(0, cur)) return;
    f32x4 acc[2][2][4][2];
#pragma unroll
    for (int a = 0; a < 2; ++a)
#pragma unroll
        for (int b = 0; b < 2; ++b)
#pragma unroll
            for (int m = 0; m < 4; ++m)
#pragma unroll
                for (int n = 0; n < 2; ++n) acc[a][b][m][n] = (f32x4){0.f, 0.f, 0.f, 0.f};
    bf16x8 At[4][2], B0[2][2], B1[2][2];
    const char* cA = (const char*)g.A + (size_t)cur.pm * tstep; const char* cB = (const char*)g.Bt + (size_t)cur.pn * tstep;
    S.a_ready(cur);
    PG8_STAGE(PG8_SB(0, 0), cB, voffB); PG8_STAGE(PG8_SA(0, 0), cA, voffA); PG8_STAGE(PG8_SB(0, 1), cB + hstep, voffB); PG8_STAGE(PG8_SA(0, 1), cA + hstep, voffA);
    if (wr == 1) PG8_BAR;
    PG8_WAIT_V(4); PG8_BAR;
    PG8_STAGE(PG8_SB(1, 0), cB + kstep, voffB); PG8_STAGE(PG8_SA(1, 0), cA + kstep, voffA); PG8_STAGE(PG8_SB(1, 1), cB + hstep + kstep, voffB);
    PG8_WAIT_V(6); PG8_BAR;
    for (;;) {
        const bool has_next = S.next(ui + 1, nxt);
        const char* nA = has_next ? (const char*)g.A + (size_t)nxt.pm * tstep : cA; const char* nB = has_next ? (const char*)g.Bt + (size_t)nxt.pn * tstep : cB;
        for (int t = 0; t < nt; t += 2) {
            const bool last = (t == nt - 2);
            const char* a1 = cA + (size_t)(t + 1) * kstep;
            const char* a2 = last ? nA : cA + (size_t)(t + 2) * kstep; const char* b2 = last ? nB : cB + (size_t)(t + 2) * kstep;
            const char* a3 = a2 + kstep; const char* b3 = b2 + kstep;
            if (last && has_next) S.a_ready(nxt);
            PG8_LDB(B0, 0, 0); PG8_SCHED; PG8_LDA(At, 0, 0); PG8_STAGE(PG8_SA(1, 1), a1 + hstep, voffA);
            PG8_WAIT_L(8); PG8_BAR; PG8_WAIT_L(0); PG8_MMA(0, 0, At, B0); PG8_BAR; PG8_SCHED;
            PG8_LDB(B1, 0, 1); PG8_STAGE(PG8_SB(0, 0), b2, voffB);
            PG8_BAR; PG8_WAIT_L(0); PG8_MMA(0, 1, At, B1); PG8_BAR;
            PG8_LDA(At, 0, 1); PG8_STAGE(PG8_SA(0, 0), a2, voffA);
            PG8_BAR; PG8_WAIT_L(0); PG8_MMA(1, 0, At, B0); PG8_BAR; PG8_SCHED;
            PG8_STAGE(PG8_SB(0, 1), b2 + hstep, voffB);
            PG8_WAIT_V(6); PG8_BAR; PG8_MMA(1, 1, At, B1); PG8_BAR;
            PG8_LDB(B0, 1, 0); PG8_SCHED; PG8_LDA(At, 1, 0); PG8_STAGE(PG8_SA(0, 1), a2 + hstep, voffA);
            PG8_WAIT_L(8); PG8_BAR; PG8_WAIT_L(0); PG8_MMA(0, 0, At, B0); PG8_BAR; PG8_SCHED;
            PG8_LDB(B1, 1, 1); PG8_STAGE(PG8_SB(1, 0), b3, voffB);
            PG8_BAR; PG8_WAIT_L(0); PG8_MMA(0, 1, At, B1); PG8_BAR;
            PG8_LDA(At, 1, 1); PG8_STAGE(PG8_SA(1, 0), a3, voffA);
            PG8_BAR; PG8_WAIT_L(0); PG8_MMA(1, 0, At, B0); PG8_BAR; PG8_SCHED;
            PG8_STAGE(PG8_SB(1, 1), b3 + hstep, voffB);
            PG8_WAIT_V(6); PG8_BAR; PG8_MMA(1, 1, At, B1); PG8_BAR;
        }
        E(acc, cur, wr, wc, fr, fq); S.done(cur);
        if (!has_next) break;
#pragma unroll
        for (int a = 0; a < 2; ++a)
#pragma unroll
            for (int b = 0; b < 2; ++b)
#pragma unroll
                for (int m = 0; m < 4; ++m)
#pragma unroll
                    for (int n = 0; n < 2; ++n) acc[a][b][m][n] = (f32x4){0.f, 0.f, 0.f, 0.f};
        cur = nxt; cA = nA; cB = nB; ++ui;
    }
    PG8_WAIT_V(0);
    if (wr == 0) PG8_BAR;
    PG8_BAR;
#undef PG8_SA
#undef PG8_SB
#undef PG8_STAGE
#undef PG8_LDA
#undef PG8_LDB
#undef PG8_MMA
#undef PG8_WAIT_V
#undef PG8_WAIT_L
#undef PG8_BAR
#undef PG8_SCHED
}
}

struct EpiProj {
    static constexpr bool PERM = true;
    char* ws;
    __device__ __forceinline__ void store8(bf16_t* dst, const f32x4& a, const f32x4& b, float sc) const {
        u32x4 o; o[0] = cvt_pk_bf16(a[0] * sc, a[1] * sc); o[1] = cvt_pk_bf16(a[2] * sc, a[3] * sc); o[2] = cvt_pk_bf16(b[0] * sc, b[1] * sc); o[3] = cvt_pk_bf16(b[2] * sc, b[3] * sc);
        *(u32x4*)dst = o;
    }
    __device__ __forceinline__ void operator()(const f32x4 (&acc)[2][2][4][2], const pg8::Unit& u, int wr, int wc, int fr, int fq) const {
        { int ln_ = (int)__builtin_amdgcn_mbcnt_hi(~0u, __builtin_amdgcn_mbcnt_lo(~0u, 0u)); asm volatile("" : "+v"(ln_)); fr = ln_ & 15; fq = ln_ >> 4; }
        if (u.pn < 13) {
#pragma unroll
            for (int bj = 0; bj < 2; ++bj) {
                const int hb = 4 * u.pn + 2 * bj + (wc >> 1);
                const int cc8 = 32 * (wc & 1) + 8 * fq;
#pragma unroll
                for (int ai = 0; ai < 2; ++ai)
#pragma unroll
                    for (int m = 0; m < 4; ++m) {
                        const int t = 256 * u.pm + 128 * ai + 64 * wr + 16 * m + fr;
                        const f32x4 v0 = acc[ai][bj][m][0], v1 = acc[ai][bj][m][1];
                        if (t < T) {
                            const size_t tt = (size_t)t;
                            if (hb < 4) store8((bf16_t*)(ws + OFF_GQ) + tt * 256 + hb * 64 + cc8, v0, v1, 0.125f);
                            else if (hb < 8) store8((bf16_t*)(ws + OFF_GK) + tt * 256 + (hb - 4) * 64 + cc8, v0, v1, 1.f);
                            else if (hb < 16) {
                                const int bq = t / L, pos = t - bq * L;
                                bf16_t* dst = (bf16_t*)(ws + OFF_GV) + ((size_t)(bq * 4 + ((hb - 8) >> 1)) * 128 + ((hb - 8) & 1) * 64 + cc8) * LPV + 48 + pos;
#pragma unroll
                                for (int j = 0; j < 4; ++j) { dst[(size_t)j * LPV] = f2bf(v0[j]); dst[(size_t)(4 + j) * LPV] = f2bf(v1[j]); }
                            }
                            else if (hb < 24 || (hb >= 32 && hb < 40)) {
                                f32x4 s0, s1;
#pragma unroll
                                for (int j = 0; j < 4; ++j) { s0[j] = silu_f(v0[j]); s1[j] = silu_f(v1[j]); }
                                const int col = (hb < 24) ? (hb - 16) * 64 : 512 + (hb - 32) * 64;
                                store8((bf16_t*)(ws + OFF_MIX) + tt * 1024 + col + cc8, s0, s1, 1.f);
                            }
                            else if (hb < 32) store8((bf16_t*)(ws + OFF_AQ) + tt * 512 + (hb - 24) * 64 + cc8, v0, v1, 0.125f * 1.44269504088896341f);
                            else if (hb < 48) store8((bf16_t*)(ws + OFF_IQ) + tt * 512 + (hb - 40) * 64 + cc8, v0, v1, 0.125f);
                            else if (hb < 50) store8((bf16_t*)(ws + OFF_AK) + tt * 128 + (hb - 48) * 64 + cc8, v0, v1, 1.f);
                            else {
                                const int bq = t / L, pos = t - bq * L;
                                bf16_t* dst = (bf16_t*)(ws + OFF_AV) + ((size_t)(bq * 2 + (hb - 50)) * 64 + cc8) * LP + pos;
#pragma unroll
                                for (int j = 0; j < 4; ++j) { dst[(size_t)j * LP] = f2bf(v0[j]); dst[(size_t)(4 + j) * LP] = f2bf(v1[j]); }
                            }
                        }
                        asm volatile("" ::: "memory");
                    }
            }
        } else {
#pragma unroll
            for (int ai = 0; ai < 2; ++ai)
#pragma unroll
                for (int m = 0; m < 4; ++m) {
                    const int t = 256 * u.pm + 128 * ai + 64 * wr + 16 * m + fr;
                    if (t < T) {
                        if (wc == 0) {
                            float* dst = (float*)(ws + OFF_IKR) + (size_t)t * 64 + 8 * fq;
                            *(f32x4*)dst = acc[ai][0][m][0]; *(f32x4*)(dst + 4) = acc[ai][0][m][1];
                            *(f32x4*)(dst + 32) = acc[ai][1][m][0]; *(f32x4*)(dst + 36) = acc[ai][1][m][1];
                        } else if (wc == 1) {
                            const f32x4 v0 = acc[ai][0][m][0], v1 = acc[ai][0][m][1];
                            if (fq < 2) {
                                float* dst = (float*)(ws + OFF_GLR) + (size_t)t * 16 + 8 * fq;
                                *(f32x4*)dst = v0; *(f32x4*)(dst + 4) = v1;
                            } else if (fq == 2) {
                                float* dst = (float*)(ws + OFF_IW) + (size_t)t * 8;
                                *(f32x4*)dst = v0 * 0.353553390593273762f; *(f32x4*)(dst + 4) = v1 * 0.353553390593273762f;
                            }
                        }
                    }
                    asm volatile("" ::: "memory");
                }
        }
    }
};

struct EpiOut {
    static constexpr bool PERM = false;
    const float* H32; float* Z;
    __device__ __forceinline__ void operator()(const f32x4 (&acc)[2][2][4][2], const pg8::Unit& u, int wr, int wc, int fr, int fq) const {
        { int ln_ = (int)__builtin_amdgcn_mbcnt_hi(~0u, __builtin_amdgcn_mbcnt_lo(~0u, 0u)); asm volatile("" : "+v"(ln_)); fr = ln_ & 15; fq = ln_ >> 4; }
        const int col0 = u.pn * 256 + wc * 32 + 4 * fq;
#pragma unroll
        for (int ai = 0; ai < 2; ++ai) {
            f32x4 hv[4][2][2];
#pragma unroll
            for (int m = 0; m < 4; ++m) {
                int t = 256 * u.pm + 128 * ai + 64 * wr + 16 * m + fr; t = t < T ? t : T - 1;
                const size_t off = (size_t)t * D + col0;
#pragma unroll
                for (int bj = 0; bj < 2; ++bj)
#pragma unroll
                    for (int n = 0; n < 2; ++n) hv[m][bj][n] = *(const f32x4*)(H32 + off + bj * 128 + n * 16);
            }
#pragma unroll
            for (int m = 0; m < 4; ++m) {
                const int t = 256 * u.pm + 128 * ai + 64 * wr + 16 * m + fr;
                if (t < T) {
                    const size_t off = (size_t)t * D + col0;
#pragma unroll
                    for (int bj = 0; bj < 2; ++bj)
#pragma unroll
                        for (int n = 0; n < 2; ++n) *(f32x4*)(Z + off + bj * 128 + n * 16) = acc[ai][bj][m][n] + hv[m][bj][n] * ALPHA;
                }
            }
            asm volatile("" ::: "memory");
        }
    }
};

__device__ __forceinline__ void phase_proj(const Params& p_in, int layer_in, char* smem) {
    const Params p = kparams(); const int layer = opaque_int(layer_in); (void)p_in;
    pg8::Gemm g; g.A = (const bf16_t*)(p.ws + OFF_HB); g.Bt = (const bf16_t*)(p.ws + OFF_WIN) + (size_t)layer * INWP * D; g.M = TP; g.N = INWP; g.K = D;
    pg8::StaticOrder S; S.init(TP, INWP, gridDim.x, opaque_bid());
    EpiProj E; E.ws = p.ws;
    pg8::gemm_phase((LAS unsigned char*)smem, g, S, E);
}
__device__ __forceinline__ void phase_outproj(const Params& p_in, int layer_in, char* smem) {
    const Params p = kparams(); const int layer = opaque_int(layer_in); (void)p_in;
    const bf16_t* MIXp = (const bf16_t*)(p.ws + OFF_MIX);
    const bf16_t* WOUT = (const bf16_t*)(p.ws + OFF_WOUT) + (size_t)layer * D * D;
    const float* H32 = (const float*)(p.ws + OFF_H32);
    float* Z = (float*)(p.ws + OFF_GQ);
    {
        pg8::Gemm g; g.A = MIXp; g.Bt = WOUT; g.M = 16384; g.N = D; g.K = D;
        pg8::StaticOrder S; S.init(16384, D, gridDim.x, opaque_bid());
        EpiOut E; E.H32 = H32; E.Z = Z;
        pg8::gemm_phase((LAS unsigned char*)smem, g, S, E);
    }
    const int tid = opaque_tid(), wid = __builtin_amdgcn_readfirstlane(tid >> 6), lane = tid & 63, fr = lane & 15, fq = lane >> 4;
    for (int task = opaque_bid(); task < 64; task += gridDim.x) {
        const int rg = task >> 3, cs = task & 7;
        const bf16_t* ap = MIXp + (size_t)(16384 + 16 * rg + fr) * D + 8 * fq;
        const bf16_t* bp = WOUT + (size_t)(128 * cs + 16 * wid + fr) * D + 8 * fq;
        f32x4 acc = {0.f, 0.f, 0.f, 0.f};
        bf16x8 a0[8], b0[8], a1[8], b1[8];
#pragma unroll
        for (int k = 0; k < 8; ++k) { a0[k] = *(const bf16x8*)(ap + 32 * k); b0[k] = *(const bf16x8*)(bp + 32 * k); }
#pragma unroll
        for (int ch = 0; ch < 4; ++ch) {
            if (ch < 3) {
#pragma unroll
                for (int k = 0; k < 8; ++k) { a1[k] = *(const bf16x8*)(ap + 256 * (ch + 1) + 32 * k); b1[k] = *(const bf16x8*)(bp + 256 * (ch + 1) + 32 * k); }
            }
#pragma unroll
            for (int k = 0; k < 8; ++k) acc = __builtin_amdgcn_mfma_f32_16x16x32_bf16(a0[k], b0[k], acc, 0, 0, 0);
#pragma unroll
            for (int k = 0; k < 8; ++k) { a0[k] = a1[k]; b0[k] = b1[k]; }
        }
#pragma unroll
        for (int r = 0; r < 4; ++r) {
            const size_t off = (size_t)(16384 + 16 * rg + 4 * fq + r) * D + 128 * cs + 16 * wid + fr;
            Z[off] = acc[r] + ALPHA * H32[off];
        }
    }
}

__device__ __forceinline__ void phase_gla_naive(const Params& p, int layer, char* smem) {
    float (*qs)[64] = (float (*)[64])smem;
    float (*ks)[64] = qs + 8;
    float (*es)[64] = ks + 8;
    float (*part)[8] = (float (*)[8])(es + 8);
    float (*os)[128] = (float (*)[128])(part + 2);
    const int tid = opaque_tid();
    const bf16_t* GQ = (const bf16_t*)(p.ws + OFF_GQ);
    const bf16_t* GK = (const bf16_t*)(p.ws + OFF_GK);
    const bf16_t* GV = (const bf16_t*)(p.ws + OFF_GV);
    const float* GLR = (const float*)(p.ws + OFF_GLR);
    bf16_t* MIX = (bf16_t*)(p.ws + OFF_MIX);
    const float* ng = p.norm_g + layer * 128;
    const float* wg2 = p.wg2 + (size_t)layer * 16 * 256; const float* bg = p.bg + layer * 256;
    for (int item = opaque_bid(); item < NB * 4; item += gridDim.x) {
        const int b = item >> 2, h = item & 3;
        float S[64];
#pragma unroll
        for (int d = 0; d < 64; ++d) S[d] = 0.f;
        const int e = tid & 127;
        const float nge = ng[e];
        const int ltt = tid >> 6, ld = tid & 63;
        float w[16];
#pragma unroll
        for (int rr = 0; rr < 16; ++rr) w[rr] = wg2[rr * 256 + h * 64 + ld];
        const float bgd = bg[h * 64 + ld];
        for (int t0 = 0; t0 < L; t0 += 8) {
            __syncthreads();
            {
                const size_t row = (size_t)b * L + t0 + ltt;
                qs[ltt][ld] = bf2f(GQ[row * 256 + h * 64 + ld]);
                ks[ltt][ld] = bf2f(GK[row * 256 + h * 64 + ld]);
                const float4* gp = (const float4*)&GLR[row * 16];
                const float4 g0 = gp[0], g1 = gp[1], g2 = gp[2], g3 = gp[3];
                float s = bgd;
                s = fmaf(g0.x, w[0], s); s = fmaf(g0.y, w[1], s); s = fmaf(g0.z, w[2], s); s = fmaf(g0.w, w[3], s);
                s = fmaf(g1.x, w[4], s); s = fmaf(g1.y, w[5], s); s = fmaf(g1.z, w[6], s); s = fmaf(g1.w, w[7], s);
                s = fmaf(g2.x, w[8], s); s = fmaf(g2.y, w[9], s); s = fmaf(g2.z, w[10], s); s = fmaf(g2.w, w[11], s);
                s = fmaf(g3.x, w[12], s); s = fmaf(g3.y, w[13], s); s = fmaf(g3.z, w[14], s); s = fmaf(g3.w, w[15], s);
                es[ltt][ld] = expf(logsigmoid_f(s) * (1.f / 16.f));
            }
            __syncthreads();
            if (tid < 128) {
#pragma unroll 1
                for (int tt = 0; tt < 8; ++tt) {
                    const size_t row = (size_t)b * L + t0 + tt;
                    const float v = bf2f(GV[row * 512 + h * 128 + e]);
                    float acc = 0.f;
#pragma unroll
                    for (int d = 0; d < 64; ++d) {
                        S[d] = fmaf(es[tt][d], S[d], ks[tt][d] * v);
                        acc = fmaf(qs[tt][d], S[d], acc);
                    }
                    os[tt][e] = acc;
                    const float ss = wave_sum(acc * acc);
                    if ((tid & 63) == 0) part[tid >> 6][tt] = ss;
                }
            }
            __syncthreads();
            if (tid < 128) {
#pragma unroll 1
                for (int tt = 0; tt < 8; ++tt) {
                    const size_t row = (size_t)b * L + t0 + tt;
                    const float tot = part[0][tt] + part[1][tt];
                    const float rinv = rsqrtf(tot * (1.f / 128) + LN_EPS);
                    const size_t idx = row * 1024 + h * 128 + e;
                    MIX[idx] = f2bf(os[tt][e] * rinv * nge * bf2f(MIX[idx]));
                }
            }
        }
    }
}

__device__ __forceinline__ unsigned okey(float x) {
    const unsigned u = __float_as_uint(x);
    return (u & 0x80000000u) ? ~u : (u | 0x80000000u);
}
__device__ __forceinline__ int wave_incl_scan(int v) {
    const int lane = opaque_tid() & 63;
#pragma unroll
    for (int o = 1; o < 64; o <<= 1) { const int n = __shfl_up(v, o); if (lane >= o) v += n; }
    return v;
}
__device__ __forceinline__ int block_excl_scan(int v, int* tmp) {
    const int incl = wave_incl_scan(v);
    const int tq = opaque_tid();
    __syncthreads();
    if ((tq & 63) == 63) tmp[tq >> 6] = incl;
    __syncthreads();
    const int w = tq >> 6;
    int base = 0;
    for (int i = 0; i < w; ++i) base += tmp[i];
    return base + incl - v;
}
__device__ __forceinline__ void unpack8(const uint4 u, float* kf) {
    kf[0] = __uint_as_float(u.x << 16); kf[1] = __uint_as_float(u.x & 0xFFFF0000u);
    kf[2] = __uint_as_float(u.y << 16); kf[3] = __uint_as_float(u.y & 0xFFFF0000u);
    kf[4] = __uint_as_float(u.z << 16); kf[5] = __uint_as_float(u.z & 0xFFFF0000u);
    kf[6] = __uint_as_float(u.w << 16); kf[7] = __uint_as_float(u.w & 0xFFFF0000u);
}

__device__ __forceinline__ void phase_dsa_naive(const Params& p, int layer, char* smem) {
    float* sc = (float*)smem;
    float (*iqs)[64] = (float (*)[64])(sc + 2080);
    float (*aqs)[64] = iqs + 8;
    float (*lg)[256] = (float (*)[256])(aqs + 8);
    unsigned* hist = (unsigned*)(lg + 8);
    int* sel = (int*)(hist + 256);
    int* misc = sel + 256;
    const int tid = opaque_tid();
    const bf16_t* IQ = (const bf16_t*)(p.ws + OFF_IQ);
    const bf16_t* IK = (const bf16_t*)(p.ws + OFF_IK);
    const float* IW = (const float*)(p.ws + OFF_IW);
    const bf16_t* AQ = (const bf16_t*)(p.ws + OFF_AQ);
    const bf16_t* AK = (const bf16_t*)(p.ws + OFF_AK);
    const bf16_t* AV = (const bf16_t*)(p.ws + OFF_AV);
    bf16_t* MIX = (bf16_t*)(p.ws + OFF_MIX);
    for (int item = opaque_bid(); item < T; item += gridDim.x) {
        const int b = item / L, t = item % L;
        const size_t row = (size_t)item;
        __syncthreads();
        iqs[tid >> 6][tid & 63] = bf2f(IQ[row * 512 + tid]); aqs[tid >> 6][tid & 63] = bf2f(AQ[row * 512 + tid]);
        __syncthreads();
        float w[8];
#pragma unroll
        for (int j = 0; j < 8; ++j) w[j] = IW[row * 8 + j];
        for (int s = tid; s <= t; s += NT) {
            const uint4* kp = (const uint4*)&IK[((size_t)b * L + s) * 64];
            float dd[8];
#pragma unroll
            for (int j = 0; j < 8; ++j) dd[j] = 0.f;
#pragma unroll 1
            for (int q = 0; q < 8; ++q) {
                float kf[8]; unpack8(kp[q], kf);
#pragma unroll
                for (int j = 0; j < 8; ++j) {
                    const float4 a0 = *(const float4*)&iqs[j][q * 8], a1 = *(const float4*)&iqs[j][q * 8 + 4];
                    dd[j] = fmaf(a0.x, kf[0], dd[j]); dd[j] = fmaf(a0.y, kf[1], dd[j]); dd[j] = fmaf(a0.z, kf[2], dd[j]); dd[j] = fmaf(a0.w, kf[3], dd[j]);
                    dd[j] = fmaf(a1.x, kf[4], dd[j]); dd[j] = fmaf(a1.y, kf[5], dd[j]); dd[j] = fmaf(a1.z, kf[6], dd[j]); dd[j] = fmaf(a1.w, kf[7], dd[j]);
                }
            }
            float score = 0.f;
#pragma unroll
            for (int j = 0; j < 8; ++j) score = fmaf(w[j], fmaxf(dd[j], 0.f), score);
            sc[s] = score;
        }
        __syncthreads();
        const int n = t + 1;
        int nsel;
        if (n <= TOPK) {
            if (tid < n) sel[tid] = tid;
            nsel = n;
        } else {
            unsigned prefix = 0; int remaining = TOPK;
            for (int pass = 0; pass < 4; ++pass) {
                const int shift = 24 - 8 * pass;
                if (tid < 256) hist[tid] = 0;
                __syncthreads();
                for (int s = tid; s < n; s += NT) {
                    const unsigned key = okey(sc[s]);
                    const bool match = (pass == 0) || ((key >> (shift + 8)) == prefix);
                    if (match) atomicAdd(&hist[(key >> shift) & 255u], 1u);
                }
                __syncthreads();
                if (tid == 0) {
                    int cum = 0, d = 255;
                    for (; d > 0; --d) { const int c = (int)hist[d]; if (cum + c >= remaining) break; cum += c; }
                    misc[0] = d; misc[1] = remaining - cum;
                }
                __syncthreads();
                prefix = (prefix << 8) | (unsigned)misc[0]; remaining = misc[1];
                __syncthreads();
            }
            const int s0 = tid * 5;
            int ceq = 0;
#pragma unroll
            for (int q = 0; q < 5; ++q) { const int s = s0 + q; if (s < n && okey(sc[s]) == prefix) ++ceq; }
            int eqrank = block_excl_scan(ceq, misc + 8);
            int csel = 0; unsigned selmask = 0;
#pragma unroll
            for (int q = 0; q < 5; ++q) {
                const int s = s0 + q;
                if (s < n) {
                    const unsigned key = okey(sc[s]);
                    bool take = key > prefix;
                    if (key == prefix) { take = eqrank < remaining; ++eqrank; }
                    if (take) { ++csel; selmask |= 1u << q; }
                }
            }
            int posn = block_excl_scan(csel, misc + 16);
#pragma unroll
            for (int q = 0; q < 5; ++q) if (selmask & (1u << q)) { if (posn < TOPK) sel[posn] = s0 + q; ++posn; }
            nsel = TOPK;
        }
        __syncthreads();
        {
            const int i = tid & 255, g = tid >> 8;
            if (i < nsel) {
                const int kidx = sel[i];
                const uint4* kp = (const uint4*)&AK[((size_t)b * L + kidx) * 128 + g * 64];
                float dd[4] = {0.f, 0.f, 0.f, 0.f};
#pragma unroll 1
                for (int q = 0; q < 8; ++q) {
                    float kf[8]; unpack8(kp[q], kf);
#pragma unroll
                    for (int r = 0; r < 4; ++r) {
                        const float4 a0 = *(const float4*)&aqs[g * 4 + r][q * 8], a1 = *(const float4*)&aqs[g * 4 + r][q * 8 + 4];
                        dd[r] = fmaf(a0.x, kf[0], dd[r]); dd[r] = fmaf(a0.y, kf[1], dd[r]); dd[r] = fmaf(a0.z, kf[2], dd[r]); dd[r] = fmaf(a0.w, kf[3], dd[r]);
                        dd[r] = fmaf(a1.x, kf[4], dd[r]); dd[r] = fmaf(a1.y, kf[5], dd[r]); dd[r] = fmaf(a1.z, kf[6], dd[r]); dd[r] = fmaf(a1.w, kf[7], dd[r]);
                    }
                }
#pragma unroll
                for (int r = 0; r < 4; ++r) lg[g * 4 + r][i] = dd[r];
            } else {
#pragma unroll
                for (int r = 0; r < 4; ++r) lg[g * 4 + r][i] = -INFINITY;
            }
        }
        __syncthreads();
        {
            const int h = tid >> 6, lane = tid & 63;
            float v0 = lg[h][lane], v1 = lg[h][lane + 64], v2 = lg[h][lane + 128], v3 = lg[h][lane + 192];
            const float m = wave_max(fmaxf(fmaxf(v0, v1), fmaxf(v2, v3)));
            v0 = expf(v0 - m); v1 = expf(v1 - m); v2 = expf(v2 - m); v3 = expf(v3 - m);
            const float inv = 1.f / wave_sum(v0 + v1 + v2 + v3);
            lg[h][lane] = v0 * inv; lg[h][lane + 64] = v1 * inv; lg[h][lane + 128] = v2 * inv; lg[h][lane + 192] = v3 * inv;
        }
        __syncthreads();
        {
            const int h = tid >> 6, d = tid & 63, g = h >> 2;
            float o = 0.f;
            for (int i = 0; i < nsel; ++i) o = fmaf(lg[h][i], bf2f(AV[((size_t)b * L + sel[i]) * 128 + g * 64 + d]), o);
            const size_t mi = row * 1024 + 512 + tid;
            MIX[mi] = f2bf(o * bf2f(MIX[mi]));
        }
    }
}


constexpr int DS_SC = 0, DS_BITS = 134144, DS_HIST = DS_BITS + 4224, DS_CAND = DS_HIST + 8 * 1040, DS_END = DS_CAND + 8 * 512;
constexpr int DS_TAB = 65536, DS_CONST = DS_TAB + 2112 * 32;
static_assert(DS_CONST + 32 <= DS_BITS, "bias table overlaps bitmask");


template <int NR>
__device__ __forceinline__ void dsa_select(const LAS unsigned* row, LAS unsigned* bits, LAS unsigned* hist, int n, int lane) {
    unsigned kreg[NR];
#pragma unroll
    for (int i = 0; i < NR; ++i) kreg[i] = (lane < n - 64 * i) ? okey(__uint_as_float(row[lane + 64 * i])) : 0u;
    unsigned prefix = 0; int remaining = TOPK;
#pragma unroll 1
    for (int pass = 0; pass < 4; ++pass) {
        const int shift = 24 - 8 * pass;
        *(LAS u32x4*)(hist + lane * 4) = (u32x4){0u, 0u, 0u, 0u};
        __builtin_amdgcn_wave_barrier(); asm volatile("" ::: "memory");
        const unsigned sh8 = (unsigned)(shift + 8) & 31u;
#pragma unroll
        for (int i = 0; i < NR; ++i) {
            const unsigned key = kreg[i];
            const bool match = (lane < n - 64 * i) && ((pass == 0) || ((key >> sh8) == prefix));
            if (match) __hip_atomic_fetch_add(hist + ((key >> shift) & 255u), 1u, __ATOMIC_RELAXED, __HIP_MEMORY_SCOPE_WAVEFRONT);
        }
        __builtin_amdgcn_wave_barrier(); asm volatile("s_waitcnt lgkmcnt(0)" ::: "memory");
        const u32x4 hv = *(const LAS u32x4*)(hist + (63 - lane) * 4);
        const int c0 = (int)hv[3], c1 = (int)hv[2], c2 = (int)hv[1], c3 = (int)hv[0];
        const int tot = c0 + c1 + c2 + c3;
        const int incl = wave_incl_scan(tot), excl = incl - tot;
        const bool found = (excl < remaining) && (remaining <= incl);
        int digit = 0, rem_new = 0;
        if (found) {
            int cum = excl;
            if (cum + c0 >= remaining) { digit = 255 - 4 * lane; rem_new = remaining - cum; }
            else { cum += c0;
                if (cum + c1 >= remaining) { digit = 254 - 4 * lane; rem_new = remaining - cum; }
                else { cum += c1;
                    if (cum + c2 >= remaining) { digit = 253 - 4 * lane; rem_new = remaining - cum; }
                    else { cum += c2; digit = 252 - 4 * lane; rem_new = remaining - cum; } } }
        }
        const unsigned long long fm = __ballot(found);
        const int src = (int)__builtin_ctzll(fm);
        digit = __builtin_amdgcn_readlane(digit, src); rem_new = __builtin_amdgcn_readlane(rem_new, src);
        prefix = (prefix << 8) | (unsigned)digit; remaining = rem_new;
    }
    const unsigned tkey = prefix;
    int eqcount = 0;
#pragma unroll
    for (int i = 0; i < 33; ++i) {
        if (i < NR) {
            const unsigned key = kreg[i < NR ? i : 0];
            const bool valid = lane < n - 64 * i;
            const bool gt = valid && (key > tkey), eq = valid && (key == tkey);
            const unsigned long long em = __ballot(eq);
            const int rank = eqcount + __popcll(em & ((1ull << lane) - 1ull));
            const bool sel = gt || (eq && rank < remaining);
            eqcount += __popcll(em);
            const unsigned long long sm = __ballot(sel);
            if (lane == 0) { bits[2 * i] = (unsigned)sm; bits[2 * i + 1] = (unsigned)(sm >> 32); }
        } else if (lane == 0) { bits[2 * i] = 0u; bits[2 * i + 1] = 0u; }
    }
}


template <int NR>
__device__ __forceinline__ bool dsa_select_v(const LAS unsigned* row, LAS unsigned* bits, LAS unsigned* hist, LAS unsigned* cand, int n, int lane) {
    float x[NR];
    const float qnan = __uint_as_float(0x7FC00000u);
#pragma unroll
    for (int i = 0; i < NR; ++i) x[i] = (lane < n - 64 * i) ? __uint_as_float(row[lane + 64 * i]) : qnan;
    float mn = x[0], mx = x[0];
#pragma unroll
    for (int i = 1; i < NR; ++i) { mn = fminf(mn, x[i]); mx = fmaxf(mx, x[i]); }
#pragma unroll
    for (int o = 32; o > 0; o >>= 1) { mn = fminf(mn, __shfl_xor(mn, o)); mx = fmaxf(mx, __shfl_xor(mx, o)); }
    bool ok = mx > mn;
    const float scale = 255.f / (mx - mn) * 0.99999f;
    int dstar = 0, rem = 0, cb = 0;
    if (ok) {
        *(LAS u32x4*)(hist + lane * 4) = (u32x4){0u, 0u, 0u, 0u};
        __builtin_amdgcn_wave_barrier(); asm volatile("" ::: "memory");
#pragma unroll
        for (int i = 0; i < NR; ++i) {
            const float xv = x[i];
            if (xv == xv) __hip_atomic_fetch_add(hist + (unsigned)(int)((xv - mn) * scale), 1u, __ATOMIC_RELAXED, __HIP_MEMORY_SCOPE_WAVEFRONT);
        }
        __builtin_amdgcn_wave_barrier(); asm volatile("s_waitcnt lgkmcnt(0)" ::: "memory");
        const u32x4 hv = *(const LAS u32x4*)(hist + (63 - lane) * 4);
        const int c0 = (int)hv[3], c1 = (int)hv[2], c2 = (int)hv[1], c3 = (int)hv[0];
        const int tot = c0 + c1 + c2 + c3;
        const int incl = wave_incl_scan(tot), excl = incl - tot;
        const bool found = (excl < TOPK) && (TOPK <= incl);
        int digit = 0, rem_new = 0, cnt = 0;
        if (found) {
            int cum = excl;
            if (cum + c0 >= TOPK) { digit = 255 - 4 * lane; rem_new = TOPK - cum; cnt = c0; }
            else { cum += c0;
                if (cum + c1 >= TOPK) { digit = 254 - 4 * lane; rem_new = TOPK - cum; cnt = c1; }
                else { cum += c1;
                    if (cum + c2 >= TOPK) { digit = 253 - 4 * lane; rem_new = TOPK - cum; cnt = c2; }
                    else { cum += c2; digit = 252 - 4 * lane; rem_new = TOPK - cum; cnt = c3; } } }
        }
        const unsigned long long fm = __ballot(found);
        const int src = (int)__builtin_ctzll(fm | (1ull << 63));
        dstar = __builtin_amdgcn_readlane(digit, src); rem = __builtin_amdgcn_readlane(rem_new, src); cb = __builtin_amdgcn_readlane(cnt, src);
        ok = (fm != 0ull) && (cb <= 64);
    }
    if (!ok) return false;
    int base = 0;
#pragma unroll
    for (int i = 0; i < NR; ++i) {
        const float xv = x[i];
        const bool inb = (xv == xv) && ((int)((xv - mn) * scale) == dstar);
        const unsigned long long bm = __ballot(inb);
        if (bm != 0ull) {
            if (inb) { const int pos = base + __popcll(bm & ((1ull << lane) - 1ull)); cand[2 * pos] = __float_as_uint(xv); cand[2 * pos + 1] = (unsigned)(lane + 64 * i); }
            base += __popcll(bm);
        }
    }
    __builtin_amdgcn_wave_barrier(); asm volatile("s_waitcnt lgkmcnt(0)" ::: "memory");
    float xc = qnan; int ic = 0x7fffffff;
    if (lane < cb) { xc = __uint_as_float(cand[2 * lane]); ic = (int)cand[2 * lane + 1]; }
    int rank = 0;
    for (int j = 0; j < cb; ++j) {
        const float xj = __builtin_bit_cast(float, __builtin_amdgcn_readlane(__builtin_bit_cast(int, xc), j));
        const int ij = __builtin_amdgcn_readlane(ic, j);
        rank += ((xj > xc) || (xj == xc && ij < ic)) ? 1 : 0;
    }
    const unsigned long long tm = __ballot((lane < cb) && (rank == rem - 1));
    const int tl = (int)__builtin_ctzll(tm | (1ull << 63));
    const float tx = __builtin_bit_cast(float, __builtin_amdgcn_readlane(__builtin_bit_cast(int, xc), tl));
    const int ti = __builtin_amdgcn_readlane(ic, tl);
#pragma unroll
    for (int i = 0; i < 33; ++i) {
        if (i < NR) {
            const float xv = x[i < NR ? i : 0];
            const bool sel = (xv > tx) || (xv == tx && (lane + 64 * i) <= ti);
            const unsigned long long sm = __ballot(sel);
            if (lane == 0) { bits[2 * i] = (unsigned)sm; bits[2 * i + 1] = (unsigned)(sm >> 32); }
        } else if (lane == 0) { bits[2 * i] = 0u; bits[2 * i + 1] = 0u; }
    }
    return true;
}

__device__ __forceinline__ void phase_dsa(const Params& p_in, int layer_in, char* smem, bool do_store) {
    const Params p = kparams(); const int layer = opaque_int(layer_in); (void)p_in;
    const int tid = opaque_tid(), wid = __builtin_amdgcn_readfirstlane(tid >> 6), lane_ = tid & 63, fr_ = lane_ & 15, fq_ = lane_ >> 4;
    LAS unsigned char* lds = (LAS unsigned char*)smem;
    const bf16_t* IQ = (const bf16_t*)(p.ws + OFF_IQ);
    const bf16_t* IK = (const bf16_t*)(p.ws + OFF_IK);
    const float* IW = (const float*)(p.ws + OFF_IW);
    const bf16_t* AQ = (const bf16_t*)(p.ws + OFF_AQ);
    const bf16_t* AK = (const bf16_t*)(p.ws + OFF_AK);
    const bf16_t* AVT = (const bf16_t*)(p.ws + OFF_AV);
    bf16_t* MIX = (bf16_t*)(p.ws + OFF_MIX);
    constexpr int NITEM = NB * 129;
    for (int idx = opaque_bid(); idx < NITEM; idx += gridDim.x) {
        const int b = idx & 7, mm = idx >> 3;
        int qr;
        { const int seg = mm >> 5, jj = mm & 31; qr = (seg == 0) ? jj : (seg == 1) ? 63 - jj : (seg == 2) ? 64 + jj : (seg == 3) ? 127 - jj : 128; }
        const int qt = 128 - qr, t0 = qt * 16;
        __syncthreads();
        for (int repA = 0; repA < PROBE_DSA_A; ++repA) {
            int fr = fr_, fq = fq_; asm volatile("" : "+v"(fr), "+v"(fq));
            const size_t rowq = (size_t)b * L + t0 + fr;
            bf16x8 qf[8][2];
#pragma unroll
            for (int jh = 0; jh < 8; ++jh)
#pragma unroll
                for (int s2 = 0; s2 < 2; ++s2) qf[jh][s2] = *(const bf16x8*)(IQ + rowq * 512 + jh * 64 + s2 * 32 + fq * 8);
            float w[8];
            { const f32x4 w0 = *(const f32x4*)(IW + rowq * 8), w1 = *(const f32x4*)(IW + rowq * 8 + 4);
              w[0] = w0[0]; w[1] = w0[1]; w[2] = w0[2]; w[3] = w0[3]; w[4] = w1[0]; w[5] = w1[1]; w[6] = w1[2]; w[7] = w1[3]; }
            const int ntile = qt + 1;
            const bf16x8 z8 = {0, 0, 0, 0, 0, 0, 0, 0};
            bf16x8 ka0 = z8, ka1 = z8, kb0 = z8, kb1 = z8, kc0 = z8, kc1 = z8;
            int kt = wid;
            if (kt < ntile) { const bf16_t* kp = IK + ((size_t)b * L + 16 * kt + fr) * 64 + fq * 8; ka0 = *(const bf16x8*)kp; ka1 = *(const bf16x8*)(kp + 32); }
            if (kt + 8 < ntile) { const bf16_t* kp = IK + ((size_t)b * L + 16 * (kt + 8) + fr) * 64 + fq * 8; kb0 = *(const bf16x8*)kp; kb1 = *(const bf16x8*)(kp + 32); }
            for (; kt < ntile; kt += 8) {
                if (kt + 16 < ntile) { const bf16_t* kp = IK + ((size_t)b * L + 16 * (kt + 16) + fr) * 64 + fq * 8; kc0 = *(const bf16x8*)kp; kc1 = *(const bf16x8*)(kp + 32); }
                f32x4 sc = {0.f, 0.f, 0.f, 0.f};
#pragma unroll
                for (int jh = 0; jh < 8; ++jh) {
                    f32x4 d = {0.f, 0.f, 0.f, 0.f};
                    d = __builtin_amdgcn_mfma_f32_16x16x32_bf16(ka0, qf[jh][0], d, 0, 0, 0);
                    d = __builtin_amdgcn_mfma_f32_16x16x32_bf16(ka1, qf[jh][1], d, 0, 0, 0);
#pragma unroll
                    for (int r = 0; r < 4; ++r) sc[r] = fmaf(w[jh], fmaxf(d[r], 0.f), sc[r]);
                }
                *(LAS f32x4*)(lds + DS_SC + (fr * 2064 + 16 * kt + 4 * fq) * 4) = sc;
                ka0 = kb0; ka1 = kb1; kb0 = kc0; kb1 = kc1;
            }
        }
        __syncthreads();
        for (int repB = 0; repB < PROBE_DSA_B; ++repB) {
            int lane = lane_; asm volatile("" : "+v"(lane));
            LAS unsigned* hist = (LAS unsigned*)(lds + DS_HIST + wid * 1040);
#pragma unroll 1
            for (int qq = 0; qq < 2; ++qq) {
                const int q = wid * 2 + qq;
                const int n = t0 + q + 1;
                const LAS unsigned* row = (const LAS unsigned*)(lds + DS_SC) + q * 2064;
                LAS unsigned* bits = (LAS unsigned*)(lds + DS_BITS) + q * 66;
                if (n <= TOPK) {
#pragma unroll 1
                    for (int i = 0; i < 33; ++i) {
                        const unsigned long long sm = __ballot(lane + 64 * i < n);
                        if (lane == 0) { bits[2 * i] = (unsigned)sm; bits[2 * i + 1] = (unsigned)(sm >> 32); }
                    }
                } else {
                    const int nr = (n + 63) >> 6;
                    LAS unsigned* cand = (LAS unsigned*)(lds + DS_CAND + wid * 512);
                    bool done;
                    if (nr <= 9) done = dsa_select_v<9>(row, bits, hist, cand, n, lane);
                    else if (nr <= 17) done = dsa_select_v<17>(row, bits, hist, cand, n, lane);
                    else if (nr <= 25) done = dsa_select_v<25>(row, bits, hist, cand, n, lane);
                    else done = dsa_select_v<33>(row, bits, hist, cand, n, lane);
                    if (!done) dsa_select<33>(row, bits, hist, n, lane);
                }
            }
        }
        __syncthreads();
        for (int repC = 0; repC < PROBE_DSA_C; ++repC) {
            if (repC > 0) __syncthreads();
            int fr = fr_, fq = fq_, lane = lane_; asm volatile("" : "+v"(fr), "+v"(fq), "+v"(lane));
            const size_t rowq = (size_t)b * L + t0 + fr;
            const int h = wid, g = h >> 2;
            const int nstep = (t0 + 16 + 63) >> 6;
            bf16x8 aqf[2];
            aqf[0] = *(const bf16x8*)(AQ + rowq * 512 + h * 64 + fq * 8);
            aqf[1] = *(const bf16x8*)(AQ + rowq * 512 + h * 64 + 32 + fq * 8);
            asm volatile("" : "+v"(aqf[0]), "+v"(aqf[1]));
            const int drow = 8 * wid + (lane >> 3);
            const int kch = (lane & 7) ^ (2 * ((drow >> 3) & 3) + ((drow >> 1) & 1)), vch = (lane & 7) ^ ((drow >> 1) & 7);
            const bf16_t* vsrc0 = AVT + ((size_t)b * 128 + drow) * LP + vch * 8;
#define DSA_DMA(st_, buf_) do { \
                int krow_ = b * L + 64 * (st_) + drow; krow_ = krow_ < T ? krow_ : T - 1; \
                const bf16_t* ks_ = AK + (size_t)krow_ * 128 + kch * 8; \
                LAS unsigned char* lb_ = lds + (buf_) * 32768 + wid * 1024; \
                __builtin_amdgcn_global_load_lds((const unsigned*)ks_, (LAS unsigned*)lb_, 16, 0, 0); \
                __builtin_amdgcn_global_load_lds((const unsigned*)(ks_ + 64), (LAS unsigned*)(lb_ + 8192), 16, 0, 0); \
                __builtin_amdgcn_global_load_lds((const unsigned*)(vsrc0 + 64 * (st_)), (LAS unsigned*)(lb_ + 16384), 16, 0, 0); \
                __builtin_amdgcn_global_load_lds((const unsigned*)(vsrc0 + (size_t)64 * LP + 64 * (st_)), (LAS unsigned*)(lb_ + 24576), 16, 0, 0); } while (0)
            DSA_DMA(0, 0);
            unsigned nb_lo = 0xC6EAu, nb_hi = 0xC6EA0000u; asm volatile("" : "+v"(nb_lo), "+v"(nb_hi));
            for (int key = tid; key < 2112; key += NT) {
                const int w32 = key & 31;
                const int R = (key >> 5) * 32 + ((w32 >> 2) & 1) * 16 + 4 * (w32 >> 3) + (w32 & 3);
                u32x4 lo, hi;
#pragma unroll
                for (int qp = 0; qp < 8; ++qp) {
                    const unsigned b0 = (*((const LAS unsigned*)(lds + DS_BITS) + (2 * qp) * 66 + (key >> 5)) >> w32) & 1u;
                    const unsigned b1 = (*((const LAS unsigned*)(lds + DS_BITS) + (2 * qp + 1) * 66 + (key >> 5)) >> w32) & 1u;
                    const unsigned v = (b0 ? 0u : nb_lo) | (b1 ? 0u : nb_hi);
                    if (qp < 4) lo[qp] = v; else hi[qp - 4] = v;
                }
                *(LAS u32x4*)(lds + DS_TAB + R * 32) = lo; *(LAS u32x4*)(lds + DS_TAB + R * 32 + 16) = hi;
            }
            if (tid < 8) *((LAS unsigned*)(lds + DS_CONST) + tid) = (tid == 0) ? 0x00003F80u : 0u;
            const int swzk = 2 * (fr >> 2) + ((fr >> 1) & 1);
            const int krow0 = 8 * (fr >> 2) + (fr & 3);
            const int tab_base = (fq < 2) ? DS_TAB + fr * 32 + 16 * fq : DS_CONST + 16 * (fq - 2);
            const int tab_mul = (fq < 2) ? 512 : 0;
            u32x4 bqw = {0u, 0u, 0u, 0u};
            if (fq < 2 && (fr >> 3) == fq) { const int j = fr & 7; bqw[j >> 1] = (j & 1) ? 0x3F800000u : 0x00003F80u; }
            u32x4 onw = {0u, 0u, 0u, 0u};
            if (fr == 0) onw = (u32x4){0x3F803F80u, 0x3F803F80u, 0x3F803F80u, 0x3F803F80u};
            const bf16x8 onesA = __builtin_bit_cast(bf16x8, onw);
            asm volatile("s_waitcnt vmcnt(0) lgkmcnt(0)" ::: "memory");
            __builtin_amdgcn_s_barrier();
            asm volatile("" ::: "memory");
            f32x4 O[4], O5 = {0.f, 0.f, 0.f, 0.f};
#pragma unroll
            for (int dt = 0; dt < 4; ++dt) O[dt] = (f32x4){0.f, 0.f, 0.f, 0.f};
            float mt = 0.f;
            for (int st = 0; st < nstep; ++st) {
                const int buf = st & 1;
                {
                    const int sn = (st + 1 < nstep) ? st + 1 : nstep - 1;
                    DSA_DMA(sn, buf ^ 1);
                }
                const LAS unsigned char* sb = lds + buf * 32768;
                const bf16x8 bq = __builtin_bit_cast(bf16x8, bqw);
                bf16x8 bfr[4], kfr[4][2];
#pragma unroll
                for (int kt = 0; kt < 4; ++kt) {
                    const int rowk = krow0 + 32 * (kt >> 1) + 4 * (kt & 1);
                    bfr[kt] = *(const LAS bf16x8*)(lds + tab_base + (4 * st + kt) * tab_mul);
#pragma unroll
                    for (int s2 = 0; s2 < 2; ++s2) kfr[kt][s2] = *(const LAS bf16x8*)(sb + g * 8192 + rowk * 128 + 16 * ((4 * s2 + fq) ^ swzk));
                }
                __builtin_amdgcn_sched_barrier(0);
                f32x4 S[4];
#pragma unroll
                for (int kt = 0; kt < 4; ++kt) {
                    S[kt] = __builtin_amdgcn_mfma_f32_16x16x32_bf16(bfr[kt], bq, (f32x4){0.f, 0.f, 0.f, 0.f}, 0, 0, 0);
                    S[kt] = __builtin_amdgcn_mfma_f32_16x16x32_bf16(kfr[kt][0], aqf[0], S[kt], 0, 0, 0);
                    S[kt] = __builtin_amdgcn_mfma_f32_16x16x32_bf16(kfr[kt][1], aqf[1], S[kt], 0, 0, 0);
                }
                bf16x8 vfr[2][4];
#pragma unroll
                for (int ks = 0; ks < 2; ++ks)
#pragma unroll
                    for (int dt = 0; dt < 4; ++dt) {
                        const int rowv = 16 * dt + fr;
                        vfr[ks][dt] = *(const LAS bf16x8*)(sb + 16384 + g * 8192 + rowv * 128 + 16 * ((4 * ks + fq) ^ ((rowv >> 1) & 7)));
                    }
                __builtin_amdgcn_sched_barrier(0);
                float pmax = fmaxf(fmaxf(S[0][0], S[0][1]), S[0][2]);
                pmax = fmaxf(fmaxf(pmax, S[0][3]), S[1][0]); pmax = fmaxf(fmaxf(pmax, S[1][1]), S[1][2]); pmax = fmaxf(fmaxf(pmax, S[1][3]), S[2][0]);
                pmax = fmaxf(fmaxf(pmax, S[2][1]), S[2][2]); pmax = fmaxf(fmaxf(pmax, S[2][3]), S[3][0]); pmax = fmaxf(fmaxf(pmax, S[3][1]), S[3][2]);
                pmax = fmaxf(pmax, S[3][3]);
                if (st == 0 || __any(pmax > 11.5f)) {
                    float pm = fmaxf(pmax, __shfl_xor(pmax, 16)); pm = fmaxf(pm, __shfl_xor(pm, 32));
                    const float up = (st == 0) ? fmaxf(pm, -64.f) : fmaxf(pm, 0.f);
                    const float mn = __uint_as_float((unsigned)f2bf(mt + up) << 16);
                    const float dlt = mt - mn;
                    const float alpha = __builtin_amdgcn_exp2f(dlt);
#pragma unroll
                    for (int dt = 0; dt < 4; ++dt) O[dt] *= alpha;
                    O5 *= alpha;
#pragma unroll
                    for (int kt = 0; kt < 4; ++kt) S[kt] += dlt;
                    mt = mn;
                    if (fq == 2) bqw[0] = (unsigned)f2bf(-mt);
                }
                unsigned pk[4][2];
#pragma unroll
                for (int kt = 0; kt < 4; ++kt) {
                    const float e0 = __builtin_amdgcn_exp2f(S[kt][0]), e1 = __builtin_amdgcn_exp2f(S[kt][1]), e2 = __builtin_amdgcn_exp2f(S[kt][2]), e3 = __builtin_amdgcn_exp2f(S[kt][3]);
                    pk[kt][0] = cvt_pk_bf16(e0, e1); pk[kt][1] = cvt_pk_bf16(e2, e3);
                }
#pragma unroll
                for (int ks = 0; ks < 2; ++ks) {
                    u32x4 pw; pw[0] = pk[2 * ks][0]; pw[1] = pk[2 * ks][1]; pw[2] = pk[2 * ks + 1][0]; pw[3] = pk[2 * ks + 1][1];
                    const bf16x8 pf = __builtin_bit_cast(bf16x8, pw);
                    O5 = __builtin_amdgcn_mfma_f32_16x16x32_bf16(onesA, pf, O5, 0, 0, 0);
#pragma unroll
                    for (int dt = 0; dt < 4; ++dt) O[dt] = __builtin_amdgcn_mfma_f32_16x16x32_bf16(vfr[ks][dt], pf, O[dt], 0, 0, 0);
                }
                asm volatile("s_waitcnt vmcnt(0)" ::: "memory");
                __builtin_amdgcn_s_barrier();
                asm volatile("" ::: "memory");
            }
#undef DSA_DMA
            const float l = __shfl(O5[0], fr);
            const float inv = 1.f / fmaxf(l, 1e-30f);
            bf16_t* mp = MIX + rowq * 1024 + 512 + h * 64 + 4 * fq;
            if (do_store && repC == PROBE_DSA_C - 1)
#pragma unroll
            for (int dt = 0; dt < 4; ++dt) {
                const uint2 gz = *(const uint2*)(mp + 16 * dt);
                const float g0 = __uint_as_float(gz.x << 16), g1 = __uint_as_float(gz.x & 0xFFFF0000u), g2 = __uint_as_float(gz.y << 16), g3 = __uint_as_float(gz.y & 0xFFFF0000u);
                uint2 o; o.x = cvt_pk_bf16(O[dt][0] * inv * g0, O[dt][1] * inv * g1); o.y = cvt_pk_bf16(O[dt][2] * inv * g2, O[dt][3] * inv * g3);
                *(uint2*)(mp + 16 * dt) = o;
            }
        }
    }
}

__device__ __forceinline__ void rope16(const u32x4 a, const u32x4 b, const float2* rp, u32x4& oa, u32x4& ob) {
    const f32x4 r0 = *(const f32x4*)(rp), r1 = *(const f32x4*)(rp + 2), r2 = *(const f32x4*)(rp + 4), r3 = *(const f32x4*)(rp + 6);
    const float cs[8] = {r0[0], r0[2], r1[0], r1[2], r2[0], r2[2], r3[0], r3[2]};
    const float sn[8] = {r0[1], r0[3], r1[1], r1[3], r2[1], r2[3], r3[1], r3[3]};
    float o1[8], o2[8];
#pragma unroll
    for (int i = 0; i < 4; ++i) {
        const float x1l = __uint_as_float(a[i] << 16), x1h = __uint_as_float(a[i] & 0xFFFF0000u);
        const float x2l = __uint_as_float(b[i] << 16), x2h = __uint_as_float(b[i] & 0xFFFF0000u);
        o1[2 * i] = x1l * cs[2 * i] - x2l * sn[2 * i]; o1[2 * i + 1] = x1h * cs[2 * i + 1] - x2h * sn[2 * i + 1];
        o2[2 * i] = x2l * cs[2 * i] + x1l * sn[2 * i]; o2[2 * i + 1] = x2h * cs[2 * i + 1] + x1h * sn[2 * i + 1];
    }
#pragma unroll
    for (int i = 0; i < 4; ++i) { oa[i] = cvt_pk_bf16(o1[2 * i], o1[2 * i + 1]); ob[i] = cvt_pk_bf16(o2[2 * i], o2[2 * i + 1]); }
}
__device__ __forceinline__ void phase_rope(const Params& p_in, int layer_in, char* smem) {
    const Params p = kparams(); const int layer = opaque_int(layer_in); (void)p_in;
    const int tid = opaque_tid();
    const float2* ROPE = (const float2*)(p.ws + OFF_ROPE);
    const int nthr = gridDim.x * NT, gid = opaque_bid() * NT + tid;
    for (int th = gid; th < T * 18; th += nthr) {
        const int t = th / 18, hh = th - t * 18, pos = t % L;
        bf16_t* base = (hh < 8) ? (bf16_t*)(p.ws + OFF_AQ) + (size_t)t * 512 + hh * 64
                     : (hh < 16) ? (bf16_t*)(p.ws + OFF_IQ) + (size_t)t * 512 + (hh - 8) * 64
                                 : (bf16_t*)(p.ws + OFF_AK) + (size_t)t * 128 + (hh - 16) * 64;
        const u32x4 a = *(const u32x4*)base, b = *(const u32x4*)(base + 8);
        u32x4 oa, ob; rope16(a, b, ROPE + pos * 8, oa, ob);
        *(u32x4*)base = oa; *(u32x4*)(base + 8) = ob;
    }
    const float* IKR = (const float*)(p.ws + OFF_IKR);
    bf16_t* IK = (bf16_t*)(p.ws + OFF_IK);
    const float* ikg = p.ikg + layer * 64; const float* ikb = p.ikb + layer * 64;
    for (int t = gid; t < T; t += nthr) {
        const int pos = t % L;
        f32x4 x[16];
#pragma unroll
        for (int i = 0; i < 16; ++i) x[i] = *(const f32x4*)(IKR + (size_t)t * 64 + 4 * i);
        float sm = 0.f;
#pragma unroll
        for (int i = 0; i < 16; ++i) sm += (x[i][0] + x[i][1]) + (x[i][2] + x[i][3]);
        const float mu = sm * (1.f / 64);
        float qq = 0.f;
#pragma unroll
        for (int i = 0; i < 16; ++i) { const f32x4 d = x[i] - mu; qq += (d[0] * d[0] + d[1] * d[1]) + (d[2] * d[2] + d[3] * d[3]); }
        const float rs = rsqrtf(qq * (1.f / 64) + LN_EPS);
#pragma unroll
        for (int i = 0; i < 16; ++i) { const f32x4 g = *(const f32x4*)(ikg + 4 * i), bb = *(const f32x4*)(ikb + 4 * i); x[i] = (x[i] - mu) * rs * g + bb; }
        const float2* rp = ROPE + pos * 8;
        const f32x4 r0 = *(const f32x4*)(rp), r1 = *(const f32x4*)(rp + 2), r2 = *(const f32x4*)(rp + 4), r3 = *(const f32x4*)(rp + 6);
        const float cs[8] = {r0[0], r0[2], r1[0], r1[2], r2[0], r2[2], r3[0], r3[2]};
        const float sn[8] = {r0[1], r0[3], r1[1], r1[3], r2[1], r2[3], r3[1], r3[3]};
#pragma unroll
        for (int i = 0; i < 8; ++i) {
            const float x1 = x[i >> 2][i & 3], x2 = x[2 + (i >> 2)][i & 3];
            x[i >> 2][i & 3] = x1 * cs[i] - x2 * sn[i];
            x[2 + (i >> 2)][i & 3] = x2 * cs[i] + x1 * sn[i];
        }
#pragma unroll
        for (int i = 0; i < 8; ++i) {
            u32x4 o; o[0] = cvt_pk_bf16(x[2 * i][0], x[2 * i][1]); o[1] = cvt_pk_bf16(x[2 * i][2], x[2 * i][3]); o[2] = cvt_pk_bf16(x[2 * i + 1][0], x[2 * i + 1][1]); o[3] = cvt_pk_bf16(x[2 * i + 1][2], x[2 * i + 1][3]);
            *(u32x4*)(IK + (size_t)t * 64 + 8 * i) = o;
        }
    }
}

constexpr int GL_QE = 0, GL_KN = 8192, GL_SEG = 16384, GL_PART = 18432;
__device__ __forceinline__ void gla_cumsum(const Params& p, int layer, int b, int h, int c, int tid, LAS unsigned char* lds, float (&bc)[8], float& blast) {
    const int d = tid & 63, seg = tid >> 6;
    const float* wg2 = p.wg2 + (size_t)layer * 16 * 256 + h * 64 + d;
    float w[16];
#pragma unroll
    for (int rr = 0; rr < 16; ++rr) w[rr] = wg2[rr * 256];
    const float bgd = p.bg[layer * 256 + h * 64 + d];
    const float* GLR = (const float*)(p.ws + OFF_GLR);
    float pb = 0.f;
#pragma unroll
    for (int i = 0; i < 8; ++i) {
        const int pos = 64 * c - 48 + 8 * seg + i;
        float gl = 0.f;
        if (pos >= 0) {
            const f32x4* gp = (const f32x4*)(GLR + ((size_t)b * L + pos) * 16);
            const f32x4 g0 = gp[0], g1 = gp[1], g2 = gp[2], g3 = gp[3];
            float x = bgd;
#pragma unroll
            for (int rr = 0; rr < 4; ++rr) { x = fmaf(g0[rr], w[rr], x); }
#pragma unroll
            for (int rr = 0; rr < 4; ++rr) { x = fmaf(g1[rr], w[4 + rr], x); }
#pragma unroll
            for (int rr = 0; rr < 4; ++rr) { x = fmaf(g2[rr], w[8 + rr], x); }
#pragma unroll
            for (int rr = 0; rr < 4; ++rr) { x = fmaf(g3[rr], w[12 + rr], x); }
            gl = logsigmoid_fast(x) * (1.f / 16.f);
        }
        pb += gl; bc[i] = pb;
    }
    LAS float* segs = (LAS float*)(lds + GL_SEG);
    segs[seg * 64 + d] = pb;
    __syncthreads();
    float base = 0.f, tot = 0.f;
#pragma unroll
    for (int sg = 0; sg < 8; ++sg) { const float v = segs[sg * 64 + d]; tot += v; base += (sg < seg) ? v : 0.f; }
#pragma unroll
    for (int i = 0; i < 8; ++i) bc[i] += base;
    blast = tot;
}

constexpr size_t OUTS_QE = 0, OUTS_KN = (size_t)T * 256 * 2;
__device__ __forceinline__ void phase_gla_a(const Params& p_in, int layer_in, char* smem) {
    const Params p = kparams(); const int layer = opaque_int(layer_in); (void)p_in;
    const int tid = opaque_tid(), wid = __builtin_amdgcn_readfirstlane(tid >> 6), lane = tid & 63, fr = lane & 15, fq = lane >> 4;
    LAS unsigned char* ldw = (LAS unsigned char*)smem + wid * 8192;
    const bf16_t* GQ = (const bf16_t*)(p.ws + OFF_GQ);
    const bf16_t* GK = (const bf16_t*)(p.ws + OFF_GK);
    const bf16_t* GVT = (const bf16_t*)(p.ws + OFF_GV);
    const float* GLR = (const float*)(p.ws + OFF_GLR);
    bf16_t* QE = (bf16_t*)((char*)p.out + OUTS_QE);
    bf16_t* KN = (bf16_t*)((char*)p.out + OUTS_KN);
    float* UT = (float*)(p.ws + OFF_UT);
    float* DL = (float*)(p.ws + OFF_DL);
    const int wstride = gridDim.x * 8;
    for (int task = wid * (int)gridDim.x + opaque_bid(); task < 32 * 33; task += wstride) {
        const int bh = task / 33, c = task - bh * 33, b = bh >> 2, h = bh & 3;
        const int d = lane;
        float w[16];
#pragma unroll
        for (int rr = 0; rr < 16; ++rr) w[rr] = p.wg2[(size_t)layer * 16 * 256 + rr * 256 + h * 64 + d];
        const float bgd = p.bg[layer * 256 + h * 64 + d];
        float bsum = 0.f;
        const int rowi0 = b * L + 64 * c - 48;
        f32x4 g4[4];
#pragma unroll
        for (int m = 0; m < 4; ++m) { int rr_ = rowi0 + ((lane + 64 * m) >> 2); rr_ = rr_ > 0 ? rr_ : 0; g4[m] = *(const f32x4*)(GLR + (size_t)rr_ * 16 + 4 * (lane & 3)); }
        LAS unsigned char* ldg = (LAS unsigned char*)smem + 65536 + wid * 4096;
#pragma unroll
        for (int m = 0; m < 4; ++m) *(LAS f32x4*)(ldg + (lane + 64 * m) * 16) = g4[m];
        unsigned qk[64];
#pragma unroll
        for (int t = 0; t < 64; ++t) { int rr_ = rowi0 + t; rr_ = rr_ > 0 ? rr_ : 0; const size_t o_ = (size_t)rr_ * 256 + h * 64 + d; qk[t] = (unsigned)GQ[o_] | ((unsigned)GK[o_] << 16); }
        float kn[8];
        __builtin_amdgcn_wave_barrier(); asm volatile("s_waitcnt lgkmcnt(0)" ::: "memory");
#pragma unroll
        for (int t = 0; t < 64; ++t) {
            const bool valid = (c > 0) || (t >= 48);
            float x = bgd;
            {
                const LAS f32x4* gp = (const LAS f32x4*)(ldg + t * 64);
                const f32x4 g0 = gp[0], g1 = gp[1], g2 = gp[2], g3 = gp[3];
#pragma unroll
                for (int rr = 0; rr < 4; ++rr) x = fmaf(g0[rr], w[rr], x);
#pragma unroll
                for (int rr = 0; rr < 4; ++rr) x = fmaf(g1[rr], w[4 + rr], x);
#pragma unroll
                for (int rr = 0; rr < 4; ++rr) x = fmaf(g2[rr], w[8 + rr], x);
#pragma unroll
                for (int rr = 0; rr < 4; ++rr) x = fmaf(g3[rr], w[12 + rr], x);
            }
            bsum += valid ? logsigmoid_fast(x) * (1.f / 16.f) : 0.f;
            const float eb = __expf(bsum);
            const float qv = __uint_as_float(qk[t] << 16), kv = __uint_as_float(qk[t] & 0xFFFF0000u);
            const float knv = valid ? kv * __builtin_amdgcn_rcpf(eb) : 0.f;
            kn[t & 7] = knv;
            if (valid) {
                const size_t o_ = (size_t)(rowi0 + t) * 256 + h * 64 + d;
                QE[o_] = f2bf(qv * eb);
                KN[o_] = f2bf(knv);
            }
            if ((t & 7) == 7 && c < 32) {
                u32x4 o; o[0] = cvt_pk_bf16(kn[0], kn[1]); o[1] = cvt_pk_bf16(kn[2], kn[3]); o[2] = cvt_pk_bf16(kn[4], kn[5]); o[3] = cvt_pk_bf16(kn[6], kn[7]);
                *(LAS u32x4*)(ldw + d * 128 + 16 * ((t >> 3) ^ (d & 7))) = o;
            }
        }
        if (c < 32) {
            const float dl = __expf(bsum);
            DL[((size_t)bh * 32 + c) * 64 + d] = dl;
            __builtin_amdgcn_wave_barrier(); asm volatile("s_waitcnt lgkmcnt(0)" ::: "memory");
            bf16x8 kf[4][2]; float dls[4];
#pragma unroll
            for (int dt = 0; dt < 4; ++dt) {
                const int rowd = 16 * dt + fr;
                dls[dt] = __shfl(dl, rowd);
#pragma unroll
                for (int ks = 0; ks < 2; ++ks) kf[dt][ks] = *(const LAS bf16x8*)(ldw + rowd * 128 + 16 * ((4 * ks + fq) ^ (rowd & 7)));
            }
            const bf16x8 z8 = {0, 0, 0, 0, 0, 0, 0, 0};
            bf16x8 vfa[8][2];
#pragma unroll
            for (int et = 0; et < 8; ++et) {
                const bf16_t* vp = GVT + ((size_t)bh * 128 + 16 * et + fr) * LPV + 64 * c + 8 * fq;
                vfa[et][0] = *(const bf16x8*)vp; vfa[et][1] = *(const bf16x8*)(vp + 32);
            }
            asm volatile("" ::: "memory");
#pragma unroll
            for (int et = 0; et < 8; ++et) {
                bf16x8 v0 = vfa[et][0], v1 = vfa[et][1];
                v0 = (c == 0) ? z8 : v0; v1 = (c == 0 && fq < 2) ? z8 : v1;
#pragma unroll
                for (int dt = 0; dt < 4; ++dt) {
                    f32x4 acc = {0.f, 0.f, 0.f, 0.f};
                    acc = __builtin_amdgcn_mfma_f32_16x16x32_bf16(v0, kf[dt][0], acc, 0, 0, 0);
                    acc = __builtin_amdgcn_mfma_f32_16x16x32_bf16(v1, kf[dt][1], acc, 0, 0, 0);
                    float* up = UT + (((size_t)bh * 32 + c) * 128 + 16 * et + 4 * fq) * 64 + 16 * dt + fr;
#pragma unroll
                    for (int r = 0; r < 4; ++r) up[r * 64] = acc[r] * dls[dt];
                }
            }
            __builtin_amdgcn_wave_barrier(); asm volatile("s_waitcnt lgkmcnt(0)" ::: "memory");
        }
    }
}

__device__ __forceinline__ void phase_gla_scan(const Params& p_in, int layer_in, char* smem) {
    const Params p = kparams(); const int layer = opaque_int(layer_in); (void)p_in;
    const int tid = opaque_tid();
    const float* UT = (const float*)(p.ws + OFF_UT);
    const float* DL = (const float*)(p.ws + OFF_DL);
    bf16_t* ST = (bf16_t*)(p.ws + OFF_ST);
    const int nthr = gridDim.x * NT;
    for (int el = opaque_bid() * NT + tid; el < 32 * 8192; el += nthr) {
        const int bh = el >> 13, ed = el & 8191, d = el & 63;
        float sacc = 0.f;
        ST[((size_t)bh * 33) * 8192 + ed] = 0;
#pragma unroll 1
        for (int c0 = 0; c0 < 32; c0 += 16) {
            float u[16], dl[16];
#pragma unroll
            for (int i = 0; i < 16; ++i) { u[i] = UT[((size_t)(bh * 32 + c0 + i)) * 8192 + ed]; dl[i] = DL[(size_t)(bh * 32 + c0 + i) * 64 + d]; }
#pragma unroll
            for (int i = 0; i < 16; ++i) { sacc = fmaf(dl[i], sacc, u[i]); ST[((size_t)bh * 33 + c0 + i + 1) * 8192 + ed] = f2bf(sacc); }
        }
    }
}

__device__ __forceinline__ void phase_gla_c(const Params& p_in, int layer_in, char* smem, bool do_store) {
    const Params p = kparams(); const int layer = opaque_int(layer_in); (void)p_in;
    const int tid = opaque_tid(), wid = __builtin_amdgcn_readfirstlane(tid >> 6), lane = tid & 63, fr = lane & 15, fq = lane >> 4;
    const bf16_t* QE = (const bf16_t*)((const char*)p.out + OUTS_QE);
    const bf16_t* KN = (const bf16_t*)((const char*)p.out + OUTS_KN);
    const bf16_t* GVT = (const bf16_t*)(p.ws + OFF_GV);
    const bf16_t* ST = (const bf16_t*)(p.ws + OFF_ST);
    bf16_t* MIX = (bf16_t*)(p.ws + OFF_MIX);
    const float* ng = p.norm_g + layer * 128;
    const bf16x8 z8 = {0, 0, 0, 0, 0, 0, 0, 0};
    const int nwt = 32 * 33 * 4, wstride = gridDim.x * 8;
    for (int wt = wid * (int)gridDim.x + opaque_bid(); wt < nwt; wt += wstride) {
        const int task = wt >> 2, tw = wt & 3;
        const int bh = task / 33, c = task - bh * 33, b = bh >> 2, h = bh & 3;
        const int pos_t = 64 * c - 48 + 16 * tw + fr;
        if (c == 0 && tw < 3) continue;
        bf16x8 qf[2], kf[4][2];
        {
            const bf16_t* qp = QE + ((size_t)b * L + pos_t) * 256 + h * 64 + 8 * fq;
            qf[0] = *(const bf16x8*)qp; qf[1] = *(const bf16x8*)(qp + 32);
#pragma unroll
            for (int st = 0; st < 4; ++st) {
                const int pos_s = 64 * c - 48 + 16 * st + fr;
                const bf16_t* kp = KN + ((size_t)b * L + (pos_s > 0 ? pos_s : 0)) * 256 + h * 64 + 8 * fq;
                kf[st][0] = *(const bf16x8*)kp; kf[st][1] = *(const bf16x8*)(kp + 32);
            }
        }
        bf16x8 sf[4][2]; u32x2 vv[4][4];
#define GLC_LOAD_HALF(hf) do { _Pragma("unroll") for (int e4 = 0; e4 < 4; ++e4) { const int e0 = 16 * (4 * (hf) + e4); \
                const bf16_t* sp = ST + (((size_t)bh * 33 + c) * 128 + e0 + fr) * 64 + 8 * fq; \
                const bf16_t* vp = GVT + ((size_t)bh * 128 + e0 + fr) * LPV + 64 * c + 4 * fq; \
                sf[e4][0] = *(const bf16x8*)sp; sf[e4][1] = *(const bf16x8*)(sp + 32); \
                vv[e4][0] = *(const u32x2*)vp; vv[e4][1] = *(const u32x2*)(vp + 16); vv[e4][2] = *(const u32x2*)(vp + 32); vv[e4][3] = *(const u32x2*)(vp + 48); } \
            asm volatile("" ::: "memory"); } while (0)
        GLC_LOAD_HALF(0);
        unsigned pk[4][2];
#pragma unroll
        for (int st = 0; st < 4; ++st) {
            f32x4 a = {0.f, 0.f, 0.f, 0.f};
            const int pos_s = 64 * c - 48 + 16 * st + fr;
            const bf16x8 k0 = (pos_s >= 0) ? kf[st][0] : z8, k1 = (pos_s >= 0) ? kf[st][1] : z8;
            a = __builtin_amdgcn_mfma_f32_16x16x32_bf16(k0, qf[0], a, 0, 0, 0);
            a = __builtin_amdgcn_mfma_f32_16x16x32_bf16(k1, qf[1], a, 0, 0, 0);
#pragma unroll
            for (int r = 0; r < 4; ++r) a[r] = (16 * st + 4 * fq + r > 16 * tw + fr) ? 0.f : a[r];
            pk[st][0] = cvt_pk_bf16(a[0], a[1]); pk[st][1] = cvt_pk_bf16(a[2], a[3]);
        }
        bf16x8 pf[2];
#pragma unroll
        for (int ks = 0; ks < 2; ++ks) { u32x4 pw; pw[0] = pk[2 * ks][0]; pw[1] = pk[2 * ks][1]; pw[2] = pk[2 * ks + 1][0]; pw[3] = pk[2 * ks + 1][1]; pf[ks] = __builtin_bit_cast(bf16x8, pw); }
        f32x4 O[8];
        float ss = 0.f;
        const u32x2 z2 = {0u, 0u};
#pragma unroll
        for (int hf = 0; hf < 2; ++hf) {
            if (hf == 1) GLC_LOAD_HALF(1);
#pragma unroll
            for (int e4 = 0; e4 < 4; ++e4) {
                f32x4 acc = {0.f, 0.f, 0.f, 0.f};
                acc = __builtin_amdgcn_mfma_f32_16x16x32_bf16(sf[e4][0], qf[0], acc, 0, 0, 0);
                acc = __builtin_amdgcn_mfma_f32_16x16x32_bf16(sf[e4][1], qf[1], acc, 0, 0, 0);
                u32x2 va = vv[e4][0], vb = vv[e4][1], vc = vv[e4][2], vd = vv[e4][3];
                va = (c == 0) ? z2 : va; vb = (c == 0) ? z2 : vb; vc = (c == 0) ? z2 : vc;
                u32x4 vw; vw[0] = va[0]; vw[1] = va[1]; vw[2] = vb[0]; vw[3] = vb[1];
                acc = __builtin_amdgcn_mfma_f32_16x16x32_bf16(__builtin_bit_cast(bf16x8, vw), pf[0], acc, 0, 0, 0);
                u32x4 vx; vx[0] = vc[0]; vx[1] = vc[1]; vx[2] = vd[0]; vx[3] = vd[1];
                acc = __builtin_amdgcn_mfma_f32_16x16x32_bf16(__builtin_bit_cast(bf16x8, vx), pf[1], acc, 0, 0, 0);
                O[4 * hf + e4] = acc;
                ss += acc[0] * acc[0] + acc[1] * acc[1] + acc[2] * acc[2] + acc[3] * acc[3];
            }
        }
#undef GLC_LOAD_HALF
        ss += __shfl_xor(ss, 16); ss += __shfl_xor(ss, 32);
        const float rinv = rsqrtf(ss * (1.f / 128) + LN_EPS);
        if (pos_t >= 0 && do_store) {
            bf16_t* mp = MIX + ((size_t)b * L + pos_t) * 1024 + h * 128 + 4 * fq;
#pragma unroll
            for (int et = 0; et < 8; ++et) {
                const uint2 gz = *(const uint2*)(mp + 16 * et);
                const f32x4 nv = *(const f32x4*)(ng + 16 * et + 4 * fq);
                const float g0 = __uint_as_float(gz.x << 16), g1 = __uint_as_float(gz.x & 0xFFFF0000u), g2 = __uint_as_float(gz.y << 16), g3 = __uint_as_float(gz.y & 0xFFFF0000u);
                uint2 o; o.x = cvt_pk_bf16(O[et][0] * rinv * nv[0] * g0, O[et][1] * rinv * nv[1] * g1); o.y = cvt_pk_bf16(O[et][2] * rinv * nv[2] * g2, O[et][3] * rinv * nv[3] * g3);
                *(uint2*)(mp + 16 * et) = o;
            }
        }
    }
}

__device__ __forceinline__ void phase_ln(const Params& p_in, int layer_in, char* smem) {
    const Params p = kparams(); const int layer = opaque_int(layer_in); (void)p_in;
    const int tid = opaque_tid(), wid = tid >> 6, lane = tid & 63;
    const float* Z = (const float*)(p.ws + OFF_GQ);
    float* H32 = (float*)(p.ws + OFF_H32);
    bf16_t* HB = (bf16_t*)(p.ws + OFF_HB);
    const float* g = p.ln_g + layer * D; const float* bb = p.ln_b + layer * D;
    const int nw = gridDim.x * 8;
    int t = opaque_bid() * 8 + wid;
    f32x4 v[4], vn[4];
    if (t < T) {
#pragma unroll
        for (int i = 0; i < 4; ++i) v[i] = *(const f32x4*)(Z + (size_t)t * D + 4 * lane + 256 * i);
    }
    for (; t < T; t += nw) {
        const int tn = t + nw;
        if (tn < T) {
#pragma unroll
            for (int i = 0; i < 4; ++i) vn[i] = *(const f32x4*)(Z + (size_t)tn * D + 4 * lane + 256 * i);
        }
        ln_row_wave(v, g, bb, lane);
        if (layer == DEPTH - 1) {
            const int b = t / L, pos = t - b * L;
            if (pos >= NMETA) {
#pragma unroll
                for (int i = 0; i < 4; ++i) *(f32x4*)(p.out + ((size_t)b * SEQ + (pos - NMETA)) * D + 4 * lane + 256 * i) = v[i];
            }
        } else {
#pragma unroll
            for (int i = 0; i < 4; ++i) {
                *(f32x4*)(H32 + (size_t)t * D + 4 * lane + 256 * i) = v[i];
                u32x2 o; o[0] = cvt_pk_bf16(v[i][0], v[i][1]); o[1] = cvt_pk_bf16(v[i][2], v[i][3]);
                *(u32x2*)(HB + (size_t)t * D + 4 * lane + 256 * i) = o;
            }
        }
#pragma unroll
        for (int i = 0; i < 4; ++i) v[i] = vn[i];
    }
}

#define XB_TMO      128
#define XB_XCNT(j)  (256  + 64 * (j))
#define XB_XSUB(j)  (1280 + 64 * (j))
#define XB_XGEN(j)  (2304 + 64 * (j))
#define XB_TOP      3328
#define XB_TOPGEN   3392
#define XCD_BAR_WORDS 3456
#define XB_SPIN_CAP (1u << 22)
__device__ __forceinline__ unsigned xb_ld(unsigned* p)              { return __hip_atomic_load(p, __ATOMIC_RELAXED, __HIP_MEMORY_SCOPE_AGENT); }
__device__ __forceinline__ unsigned xb_add(unsigned* p, unsigned v) { return __hip_atomic_fetch_add(p, v, __ATOMIC_RELAXED, __HIP_MEMORY_SCOPE_AGENT); }
__device__ __forceinline__ unsigned xb_xcc_id() { return (unsigned)__builtin_amdgcn_s_getreg((3 << 11) | 20) & 0xFu; }
#define XB_SPIN(cond, bar) do { unsigned _sp = 0; while (cond) { __builtin_amdgcn_s_sleep(1); \
    if ((++_sp & 255u) == 0u) { if (xb_ld(&(bar)[XB_TMO])) break; if (_sp > XB_SPIN_CAP) { atomicAdd(&(bar)[XB_TMO], 1u); break; } } } } while (0)
struct XcdBarrier { unsigned* bar; unsigned x; volatile LAS unsigned* st; };
__device__ __forceinline__ XcdBarrier xcd_barrier_post(unsigned* bar, volatile LAS unsigned* st) {
    XcdBarrier b; b.bar = bar; b.x = xb_xcc_id(); b.st = st;
    if (threadIdx.x == 0) (void)xb_add(&bar[XB_XCNT(b.x)], 1u);
    return b;
}
__device__ __forceinline__ void xcd_barrier_complete(unsigned* bar, unsigned x, unsigned& nloc, unsigned& nx) {
    const unsigned G = gridDim.x * gridDim.y * gridDim.z;
    unsigned sum, cnt, mine, sp = 0u;
    for (;;) {
        sum = 0u; cnt = 0u; mine = 0u;
#pragma unroll
        for (unsigned j = 0; j < 16; ++j) { const unsigned c = xb_ld(&bar[XB_XCNT(j)]); sum += c; cnt += (c > 0u) ? 1u : 0u; mine = (j == x) ? c : mine; }
        if (sum == G) break;
        __builtin_amdgcn_s_sleep(1);
        if ((++sp & 255u) == 0u) { if (xb_ld(&bar[XB_TMO])) break; if (sp > XB_SPIN_CAP) { atomicAdd(&bar[XB_TMO], 1u); break; } }
    }
    nloc = mine > 0u ? mine : 1u; nx = cnt > 0u ? cnt : 1u;
}
__device__ __forceinline__ void xcd_barrier(unsigned* bar_, volatile LAS unsigned* st_) {
    XcdBarrier b; b.bar = bar_; b.x = xb_xcc_id(); b.st = st_;
    asm volatile("s_waitcnt vmcnt(0)" ::: "memory");
    __syncthreads();
    if (opaque_tid() == 0) {
        unsigned* bar = b.bar;
        __builtin_amdgcn_s_waitcnt(0);
        unsigned nloc = b.st[0], nx = b.st[1];
        if (nloc == 0u) { xcd_barrier_complete(bar, b.x, nloc, nx); b.st[0] = nloc; b.st[1] = nx; }
        const unsigned old = xb_add(&bar[XB_XSUB(b.x)], 1u);
        const unsigned gen = old / nloc;
        if (old + 1u == (gen + 1u) * nloc) {
            __builtin_amdgcn_fence(__ATOMIC_RELEASE, "agent");
            asm volatile("s_waitcnt vmcnt(0)" ::: "memory");
            const unsigned og = xb_add(&bar[XB_TOP], 1u);
            const unsigned tg = og / nx;
            if (og + 1u == (tg + 1u) * nx) xb_add(&bar[XB_TOPGEN], 1u);
            else XB_SPIN(xb_ld(&bar[XB_TOPGEN]) == tg, bar);
            __builtin_amdgcn_fence(__ATOMIC_ACQUIRE, "agent");
            xb_add(&bar[XB_XGEN(b.x)], 1u);
            asm volatile("s_waitcnt vmcnt(0)" ::: "memory");
        } else {
            XB_SPIN(xb_ld(&bar[XB_XGEN(b.x)]) == gen, bar);
            __builtin_amdgcn_fence(__ATOMIC_ACQUIRE, "agent");
            asm volatile("s_waitcnt vmcnt(0)" ::: "memory");
        }
    }
    __syncthreads();
}

constexpr int SMEM_BYTES = 160 * 1024;
static_assert(DS_END <= SMEM_BYTES - 16 - 64, "dsa lds");
static_assert(WVTAB_OFF == SMEM_BYTES - 16 - 64, "wave table");

__global__ void __launch_bounds__(NT, 2) k_mega(Params p) {
    __shared__ __attribute__((aligned(16))) char smem[SMEM_BYTES];
    volatile LAS unsigned* xbw = (volatile LAS unsigned*)((LAS unsigned char*)smem + (SMEM_BYTES - 16));
    if (threadIdx.x == 0) { xbw[0] = 0u; xbw[1] = 0u; xbw[2] = 0u; xbw[3] = 0u; }
    {
        const unsigned slot = (unsigned)__builtin_amdgcn_s_getreg(((6 - 1) << 11) | 4) & 63u;
        if ((threadIdx.x & 63) == 0) *((volatile LAS unsigned char*)smem + WVTAB_OFF + slot) = (unsigned char)(threadIdx.x >> 6);
    }
    __syncthreads();
    if (p.ws == nullptr) cg::this_grid().sync();
    (void)xcd_barrier_post((unsigned*)(p.ws + OFF_BAR), xbw);
    for (int rep = 0; rep < PROBE_REP_PREP; ++rep) {
    phase_prep(p, smem);
    xcd_barrier((unsigned*)(p.ws + OFF_BAR), xbw);
    }
#pragma unroll 1
    for (int layer = 0; layer < DEPTH; ++layer) {
        for (int rep = 0; rep < PROBE_REP_PROJ; ++rep) {
        phase_proj(p, layer, smem);
        xcd_barrier((unsigned*)(p.ws + OFF_BAR), xbw);
        }
        phase_rope(p, layer, smem);
        for (int rep = 0; rep < PROBE_REP_GLAA; ++rep) {
        phase_gla_a(p, layer, smem);
        xcd_barrier((unsigned*)(p.ws + OFF_BAR), xbw);
        phase_gla_scan(p, layer, smem);
        xcd_barrier((unsigned*)(p.ws + OFF_BAR), xbw);
        }
        for (int rep = 0; rep < PROBE_REP_GLAC; ++rep) phase_gla_c(p, layer, smem, rep == PROBE_REP_GLAC - 1);
        for (int rep = 0; rep < PROBE_REP_DSA; ++rep) phase_dsa(p, layer, smem, rep == PROBE_REP_DSA - 1);
        xcd_barrier((unsigned*)(p.ws + OFF_BAR), xbw);
        for (int rep = 0; rep < PROBE_REP_OUT; ++rep) {
        phase_outproj(p, layer, smem);
        xcd_barrier((unsigned*)(p.ws + OFF_BAR), xbw);
        }
        for (int rep = 0; rep < PROBE_REP_LN; ++rep) {
        phase_ln(p, layer, smem);
        xcd_barrier((unsigned*)(p.ws + OFF_BAR), xbw);
        }
    }
}

extern "C" void kernel_launch(void* const* d_in, const int* in_sizes, int n_in, void* d_out, int out_size, void* d_ws, size_t ws_size,
                              hipStream_t stream) {
    Params p{};
    p.x = (const float*)d_in[0]; p.meta = (const float*)d_in[1]; p.ln_in_g = (const float*)d_in[2]; p.ln_in_b = (const float*)d_in[3];
    p.w_in = (const float*)d_in[4]; p.wg2 = (const float*)d_in[5]; p.bg = (const float*)d_in[6]; p.norm_g = (const float*)d_in[7];
    p.ikg = (const float*)d_in[8]; p.ikb = (const float*)d_in[9]; p.w_out = (const float*)d_in[10]; p.ln_g = (const float*)d_in[11];
    p.ln_b = (const float*)d_in[12];
    p.out = (float*)d_out; p.ws = (char*)d_ws;
    static int grid_blocks = 0;
    if (!grid_blocks) {
        int dev = 0, cus = 0, per_cu = 0;
        hipGetDevice(&dev);
        hipDeviceGetAttribute(&cus, hipDeviceAttributeMultiprocessorCount, dev);
        hipOccupancyMaxActiveBlocksPerMultiprocessor(&per_cu, k_mega, NT, 0);
        if (per_cu > 1) per_cu = 1;
        grid_blocks = cus * per_cu;
    }
    (void)hipMemsetAsync((char*)d_ws + OFF_BAR, 0, XCD_BAR_WORDS * 4, stream);
    void* args[] = {&p};
    (void)hipLaunchCooperativeKernel((void*)k_mega, dim3(grid_blocks), dim3(NT), args, 0, stream);
}
```

```cpp
#include <hip/hip_runtime.h>
#include <hip/hip_cooperative_groups.h>
#include <stdint.h>
namespace cg = cooperative_groups;
#ifndef PROBE_REP_PREP
#define PROBE_REP_PREP 1
#define PROBE_REP_PROJ 1
#define PROBE_REP_GLAA 1
#define PROBE_REP_GLAC 1
#define PROBE_REP_DSA 1
#define PROBE_REP_OUT 1
#define PROBE_REP_LN 1
#define PROBE_DSA_A 1
#define PROBE_DSA_B 1
#define PROBE_DSA_C 1
#endif

constexpr int D = 1024, NB = 8, SEQ = 2048, NMETA = 16, L = 2064, T = NB * L;
constexpr int DEPTH = 2;
constexpr int INW = 3416, INWP = 3584;
constexpr int TP = 16640;
constexpr int NT = 512;
constexpr int TOPK = 256;
constexpr float LN_EPS = 1e-5f;
constexpr float ALPHA = 1.41421356237309515f;

typedef unsigned short bf16_t;
typedef short bf16x8 __attribute__((ext_vector_type(8)));
typedef float f32x4 __attribute__((ext_vector_type(4)));
#define LAS __attribute__((address_space(3)))

constexpr size_t SZ_H32 = (size_t)T * D * 4;
constexpr size_t SZ_HB = (size_t)TP * D * 2;
constexpr size_t SZ_WIN = (size_t)DEPTH * INWP * D * 2;
constexpr size_t SZ_WOUT = (size_t)DEPTH * D * D * 2;
constexpr int LPV = 2112;
constexpr size_t SZ_GQ = (size_t)T * 256 * 2, SZ_GK = SZ_GQ, SZ_GV = (size_t)NB * 4 * 128 * LPV * 2;
constexpr size_t SZ_UT = (size_t)1024 * 128 * 64 * 4, SZ_ST = (size_t)32 * 33 * 128 * 64 * 2, SZ_DL = (size_t)1024 * 64 * 4;
constexpr size_t SZ_AQ = (size_t)T * 512 * 2, SZ_IQ = (size_t)T * 512 * 2;
constexpr size_t SZ_MIX = (size_t)TP * 1024 * 2;
constexpr int LP = 2112;
constexpr size_t SZ_AK = (size_t)T * 128 * 2, SZ_AV = (size_t)NB * 2 * 64 * LP * 2, SZ_IK = (size_t)T * 64 * 2, SZ_IW = (size_t)T * 8 * 4;
constexpr size_t SZ_GLR = (size_t)T * 16 * 4;
constexpr size_t SZ_ROPE = (size_t)L * 8 * 2 * 4;

constexpr size_t OFF_H32 = 0;
constexpr size_t OFF_HB = OFF_H32 + SZ_H32;
constexpr size_t OFF_WIN = OFF_HB + SZ_HB;
constexpr size_t OFF_WOUT = OFF_WIN + SZ_WIN;
constexpr size_t OFF_GQ = OFF_WOUT + SZ_WOUT;
constexpr size_t OFF_GK = OFF_GQ + SZ_GQ;
constexpr size_t OFF_GV = OFF_GK + SZ_GK;
constexpr size_t OFF_AQ = OFF_GV + SZ_GV;
constexpr size_t OFF_IQ = OFF_AQ + SZ_AQ;
constexpr size_t OFF_MIX = OFF_IQ + SZ_IQ;
constexpr size_t OFF_AK = OFF_MIX + SZ_MIX;
constexpr size_t OFF_AV = OFF_AK + SZ_AK;
constexpr size_t OFF_IK = OFF_AV + SZ_AV;
constexpr size_t OFF_IW = OFF_IK + SZ_IK;
constexpr size_t OFF_GLR = OFF_IW + SZ_IW;
constexpr size_t OFF_ROPE = OFF_GLR + SZ_GLR;
constexpr size_t OFF_ST = OFF_ROPE + SZ_ROPE;
constexpr size_t OFF_DL = OFF_ST + SZ_ST;
constexpr size_t OFF_BAR = OFF_DL + SZ_DL;
constexpr size_t OFF_IKR = OFF_BAR + 16384;
constexpr size_t OFF_END = OFF_IKR + (size_t)T * 64 * 4;
constexpr size_t OFF_UT = OFF_HB;
static_assert(SZ_UT <= SZ_HB, "UT alias");
static_assert(SZ_GQ + SZ_GK + SZ_GV + SZ_AQ + SZ_IQ >= SZ_H32, "Z alias size");
static_assert(OFF_END <= (size_t)256 * 1024 * 1024, "workspace too large");

struct Params {
    const float* x; const float* meta; const float* ln_in_g; const float* ln_in_b;
    const float* w_in; const float* wg2; const float* bg; const float* norm_g;
    const float* ikg; const float* ikb; const float* w_out; const float* ln_g; const float* ln_b;
    float* out; char* ws;
};
typedef const Params __attribute__((address_space(4))) * KParamsPtr;
__device__ __forceinline__ Params kparams() {
    unsigned long long a = (unsigned long long)__builtin_amdgcn_kernarg_segment_ptr();
    asm volatile("" : "+s"(a));
    KParamsPtr q = (KParamsPtr)a;
    Params r;
    r.x = q->x; r.meta = q->meta; r.ln_in_g = q->ln_in_g; r.ln_in_b = q->ln_in_b; r.w_in = q->w_in; r.wg2 = q->wg2; r.bg = q->bg; r.norm_g = q->norm_g;
    r.ikg = q->ikg; r.ikb = q->ikb; r.w_out = q->w_out; r.ln_g = q->ln_g; r.ln_b = q->ln_b; r.out = q->out; r.ws = q->ws;
    return r;
}

__device__ __forceinline__ bf16_t f2bf(float f) {
    unsigned u = __float_as_uint(f);
    u += 0x7FFFu + ((u >> 16) & 1u);
    return (bf16_t)(u >> 16);
}
__device__ __forceinline__ unsigned pack2bf(float lo, float hi) { return (unsigned)f2bf(lo) | ((unsigned)f2bf(hi) << 16); }
typedef float f32x2cv __attribute__((ext_vector_type(2)));
typedef __bf16 bf16x2cv __attribute__((ext_vector_type(2)));
__device__ __forceinline__ unsigned cvt_pk_bf16(float lo, float hi) { const f32x2cv v = {lo, hi}; return __builtin_bit_cast(unsigned, __builtin_convertvector(v, bf16x2cv)); }
typedef unsigned u32x4 __attribute__((ext_vector_type(4)));
typedef unsigned u32x2 __attribute__((ext_vector_type(2)));
__device__ __forceinline__ float bf2f(bf16_t h) { return __uint_as_float(((unsigned)h) << 16); }
constexpr int WVTAB_OFF = 160 * 1024 - 16 - 64;
__device__ __forceinline__ int opaque_tid() {
    const unsigned slot = (unsigned)__builtin_amdgcn_s_getreg(((6 - 1) << 11) | 4) & 63u;
    const unsigned wv = *((const volatile LAS unsigned char*)(size_t)WVTAB_OFF + slot);
    int t = (int)(wv << 6) | (int)__builtin_amdgcn_mbcnt_hi(~0u, __builtin_amdgcn_mbcnt_lo(~0u, 0u));
    asm volatile("" : "+v"(t)); return t;
}
__device__ __forceinline__ int opaque_int(int v) { asm volatile("" : "+s"(v)); return v; }
__device__ __forceinline__ int opaque_bid() { int t = blockIdx.x; asm volatile("" : "+s"(t)); return t; }
__device__ __forceinline__ float wave_sum(float v) {
#pragma unroll
    for (int o = 32; o > 0; o >>= 1) v += __shfl_xor(v, o);
    return v;
}
__device__ __forceinline__ float wave_max(float v) {
#pragma unroll
    for (int o = 32; o > 0; o >>= 1) v = fmaxf(v, __shfl_xor(v, o));
    return v;
}
__device__ __forceinline__ float block_sum(float v, float* red) {
    v = wave_sum(v);
    const int tq = opaque_tid();
    __syncthreads();
    if ((tq & 63) == 0) red[tq >> 6] = v;
    __syncthreads();
    return ((red[0] + red[1]) + (red[2] + red[3])) + ((red[4] + red[5]) + (red[6] + red[7]));
}
__device__ __forceinline__ float silu_f(float x) { return x / (1.f + __expf(-x)); }
__device__ __forceinline__ float logsigmoid_f(float x) { return fminf(x, 0.f) - log1pf(expf(-fabsf(x))); }
__device__ __forceinline__ float logsigmoid_fast(float x) { return fminf(x, 0.f) - __logf(1.f + __expf(-fabsf(x))); }

__device__ __forceinline__ int proj_src_col(int n) {
    if (n < 1024) return n;
    if (n < 1536) return n - 1024 + 1040;
    if (n < 2048) return n - 1536 + 1552;
    if (n < 2560) return n - 2048 + 2904;
    if (n < 3072) return n - 2560 + 2320;
    if (n < 3200) return n - 3072 + 2064;
    if (n < 3328) return n - 3200 + 2192;
    const int c = n - 3328;
    if (c < 32) return 2832 + c;
    if (c < 48) return 1024 + (c - 32);
    if (c < 56) return 2896 + (c - 48);
    if (c >= 128 && c < 160) return 2832 + 32 + (c - 128);
    return -1;
}

__device__ __forceinline__ void sincos_acc(float a, float& s, float& c) {
    double ad = (double)a;
    double kd = rint(ad * 0.63661977236758134308);
    double r = fma(-kd, 1.57079632679489655800, ad);
    r = fma(-kd, 6.12323399573676603587e-17, r);
    double r2 = r * r;
    double sp = r * (1.0 + r2 * (-1.0 / 6 + r2 * (1.0 / 120 + r2 * (-1.0 / 5040 + r2 * (1.0 / 362880 + r2 * (-1.0 / 39916800))))));
    double cp = 1.0 + r2 * (-0.5 + r2 * (1.0 / 24 + r2 * (-1.0 / 720 + r2 * (1.0 / 40320 + r2 * (-1.0 / 3628800 + r2 * (1.0 / 479001600))))));
    int q = ((int)kd) & 3;
    double ss = (q & 1) ? cp : sp, cc = (q & 1) ? sp : cp;
    if (q == 1 || q == 2) cc = -cc;
    if (q == 2 || q == 3) ss = -ss;
    s = (float)ss; c = (float)cc;
}

__device__ __forceinline__ void ln_row_wave(f32x4 (&v)[4], const float* g, const float* bb, int lane) {
    float sm = 0.f;
#pragma unroll
    for (int i = 0; i < 4; ++i) sm += (v[i][0] + v[i][1]) + (v[i][2] + v[i][3]);
    const float mu = wave_sum(sm) * (1.f / D);
    float qq = 0.f;
#pragma unroll
    for (int i = 0; i < 4; ++i) { v[i] = v[i] - mu; qq += (v[i][0] * v[i][0] + v[i][1] * v[i][1]) + (v[i][2] * v[i][2] + v[i][3] * v[i][3]); }
    const float rs = rsqrtf(wave_sum(qq) * (1.f / D) + LN_EPS);
#pragma unroll
    for (int i = 0; i < 4; ++i) { const f32x4 gg = *(const f32x4*)(g + 4 * lane + 256 * i), b4 = *(const f32x4*)(bb + 4 * lane + 256 * i); v[i] = v[i] * rs * gg + b4; }
}
__device__ __forceinline__ int proj_dst_col(int src) {
    if (src < 1024) return src;
    if (src < 1040) return 3328 + 32 + (src - 1024);
    if (src < 1552) return 1024 + (src - 1040);
    if (src < 2064) return 1536 + (src - 1552);
    if (src < 2192) return 3072 + (src - 2064);
    if (src < 2320) return 3200 + (src - 2192);
    if (src < 2832) return 2560 + (src - 2320);
    if (src < 2864) return 3328 + (src - 2832);
    if (src < 2896) return 3328 + 128 + (src - 2864);
    if (src < 2904) return 3328 + 48 + (src - 2896);
    return 2048 + (src - 2904);
}
__device__ __forceinline__ void phase_prep(const Params& p_in, char* smem) {
    const Params p = kparams(); (void)p_in;
    const int tid = opaque_tid(), wid = tid >> 6, lane = tid & 63;
    bf16_t* WIN = (bf16_t*)(p.ws + OFF_WIN);
    bf16_t* WOUT = (bf16_t*)(p.ws + OFF_WOUT);
    float* H32 = (float*)(p.ws + OFF_H32);
    bf16_t* HB = (bf16_t*)(p.ws + OFF_HB);
    bf16_t* MIX = (bf16_t*)(p.ws + OFF_MIX);
    float2* ROPE = (float2*)(p.ws + OFF_ROPE);
    float (*tile)[65] = (float (*)[65])smem;
    constexpr int NCT_IN = (INW + 63) / 64, NT_IN = DEPTH * 16 * NCT_IN, NT_OUT = DEPTH * 16 * 16;
    for (int item = opaque_bid(); item < NT_IN + NT_OUT; item += gridDim.x) {
        const bool is_in = item < NT_IN;
        const int it = is_in ? item : item - NT_IN;
        const int nct = is_in ? NCT_IN : 16, ldw = is_in ? INW : D;
        const int l = it / (16 * nct), rem = it - l * 16 * nct, kt = rem / nct, ct = rem - kt * nct;
        const float* W = (is_in ? p.w_in : p.w_out) + (size_t)l * D * ldw;
        __syncthreads();
#pragma unroll
        for (int i = 0; i < 8; ++i) {
            const int e = tid + NT * i, kk = e >> 6, nn = e & 63, col = ct * 64 + nn;
            tile[kk][nn] = (col < ldw) ? W[(size_t)(kt * 64 + kk) * ldw + col] : 0.f;
        }
        __syncthreads();
        {
            const int nn = tid >> 3, k8 = (tid & 7) * 8, src = ct * 64 + nn;
            if (src < ldw) {
                const int dst = is_in ? proj_dst_col(src) : src;
                u32x4 o;
#pragma unroll
                for (int q = 0; q < 4; ++q) o[q] = cvt_pk_bf16(tile[k8 + 2 * q][nn], tile[k8 + 2 * q + 1][nn]);
                bf16_t* dstp = (is_in ? WIN + ((size_t)l * INWP + dst) * D : WOUT + ((size_t)l * D + dst) * D) + kt * 64 + k8;
                *(u32x4*)dstp = o;
            }
        }
    }
    {
        const int nw = gridDim.x * 8;
        for (int t = opaque_bid() * 8 + wid; t < TP; t += nw) {
            if (t < T) {
                const int b = t / L, pos = t - b * L;
                const float* src = (pos < NMETA) ? (p.meta + (size_t)pos * D) : (p.x + ((size_t)b * SEQ + (pos - NMETA)) * D);
                f32x4 v[4];
#pragma unroll
                for (int i = 0; i < 4; ++i) v[i] = *(const f32x4*)(src + 4 * lane + 256 * i);
                ln_row_wave(v, p.ln_in_g, p.ln_in_b, lane);
#pragma unroll
                for (int i = 0; i < 4; ++i) {
                    *(f32x4*)(H32 + (size_t)t * D + 4 * lane + 256 * i) = v[i];
                    u32x2 o; o[0] = cvt_pk_bf16(v[i][0], v[i][1]); o[1] = cvt_pk_bf16(v[i][2], v[i][3]);
                    *(u32x2*)(HB + (size_t)t * D + 4 * lane + 256 * i) = o;
                }
            } else {
#pragma unroll
                for (int i = 0; i < 4; ++i) {
                    *(u32x2*)(HB + (size_t)t * D + 4 * lane + 256 * i) = (u32x2){0u, 0u};
                    *(u32x2*)(MIX + (size_t)t * D + 4 * lane + 256 * i) = (u32x2){0u, 0u};
                }
            }
        }
    }
    for (int e = opaque_bid() * NT + tid; e < L * 8; e += gridDim.x * NT) {
        const int pos = e >> 3, i = e & 7;
        const float inv[8] = {1.0f, 0.19392274f, 0.03760603f, 0.0072926646f, 0.0014142136f, 0.0002742482f, 5.3182957e-05f, 1.0313385e-05f};
        float iv = inv[0];
#pragma unroll
        for (int j = 1; j < 8; ++j) iv = (i == j) ? inv[j] : iv;
        const float ang = (float)pos * iv;
        float sn, cs; sincos_acc(ang, sn, cs);
        ROPE[e] = make_float2(cs, sn);
    }
}

namespace pg8 {
constexpr int BM = 256, BK = 64, HALF = 128, HTB = HALF * BK * 2  , STAGE_BYTES = 8 * HTB, NXCD = 8, WGM = 8;
__device__ __forceinline__ int lds_byte(int r, int c) { const int st = (r >> 4) * 2 + (c >> 5), rr = r & 15, cc = c & 31, ob = rr * 64 + cc * 2; return st * 1024 + (ob ^ (((ob >> 9) & 1) << 5)); }
__device__ __forceinline__ void stage_rc(int b, int& R, int& C) { const int st = b / 1024, sb = b % 1024, swz = sb ^ (((sb >> 9) & 1) << 5); R = (st >> 1) * 16 + swz / 64; C = (st & 1) * 32 + (swz % 64) / 2; }
__device__ __forceinline__ int perm32(int rho) { const int n = rho >> 4, i = rho & 15; return 8 * (i >> 2) + 4 * n + (i & 3); }

struct Unit { int pm, pn; };
struct Gemm { const bf16_t* A; const bf16_t* Bt; int M, N, K; };

struct StaticOrder {
    int nM, nN, nwg, G, c;
    __device__ void init(int M, int N, int G_, int c_) { nM = M / BM; nN = N / BM; nwg = nM * nN; G = G_; c = c_; }
    __device__ bool next(int i, Unit& u) const {
        const long Lx = (long)i * G + c; if (Lx >= nwg) return false;
        int wgid = (int)Lx; { const int q = nwg / NXCD, r = nwg % NXCD, xcd = wgid % NXCD, off = wgid / NXCD; wgid = (xcd < r ? xcd * (q + 1) : r * (q + 1) + (xcd - r) * q) + off; }
        const int nig = WGM * nN, gid = wgid / nig, fm = gid * WGM, gsz = (nM - fm) < WGM ? (nM - fm) : WGM;
        u.pm = fm + ((wgid % nig) % gsz); u.pn = (wgid % nig) / gsz; return true;
    }
    __device__ __forceinline__ void a_ready(const Unit&) const {}
    __device__ __forceinline__ void done(const Unit&) const {}
};

template <class Epi, class Sched>
__device__ __forceinline__ void gemm_phase(LAS unsigned char* lds, const Gemm g, const Sched& S, const Epi& E) {
    const int tid = opaque_tid(), wid = __builtin_amdgcn_readfirstlane(tid >> 6), lane = tid & 63, wr = wid >> 2, wc = wid & 3, fr = lane & 15, fq = lane >> 4;
    const int K = g.K, nt = K / BK;
    unsigned voffA[2], voffB[2];
#pragma unroll
    for (int i = 0; i < 2; ++i) { int R, C; stage_rc(tid * 16 + i * 8192, R, C); const int Rb = Epi::PERM ? ((R & ~31) + perm32(R & 31)) : R;
        voffA[i] = (unsigned)(R * K + C) * 2u; voffB[i] = (unsigned)(Rb * K + C) * 2u; }
    const size_t kstep = (size_t)(BK * 2);
    const size_t hstep = (size_t)HALF * K * 2;
    const size_t tstep = 2 * hstep;
    const unsigned ldsw = (unsigned)wid * 1024u;
    const int aoff = lds_byte(wr * 64 + fr, fq * 8), boff = lds_byte(wc * 32 + fr, fq * 8);
#define PG8_SA(b, h) (((b) * 2 + (h)) * HTB)
#define PG8_SB(b, h) ((4 + (b) * 2 + (h)) * HTB)
#define PG8_STAGE(bufoff, gbase, voff) do { _Pragma("unroll") for (int _i = 0; _i < 2; ++_i) \
        __builtin_amdgcn_global_load_lds((const unsigned*)((const char*)(gbase) + (voff)[_i]), (LAS unsigned*)(lds + (bufoff) + ldsw + _i * 8192), 16, 0, 0); } while (0)
    const LAS unsigned char* la_base = lds + aoff; asm volatile("" : "+v"(la_base));
    const LAS unsigned char* lb_base = lds + 4 * HTB + boff; asm volatile("" : "+v"(lb_base));
#define PG8_LDA(dst, b, h) do { _Pragma("unroll") for (int m = 0; m < 4; ++m) _Pragma("unroll") for (int k = 0; k < 2; ++k) dst[m][k] = *(const LAS bf16x8*)(la_base + PG8_SA(b, h) + m * 2048 + k * 1024); } while (0)
#define PG8_LDB(dst, b, h) do { _Pragma("unroll") for (int n = 0; n < 2; ++n) _Pragma("unroll") for (int k = 0; k < 2; ++k) dst[n][k] = *(const LAS bf16x8*)(lb_base + (PG8_SB(b, h) - 4 * HTB) + n * 2048 + k * 1024); } while (0)
#define PG8_MMA(ai, bj, At, Bt) do { __builtin_amdgcn_s_setprio(1); _Pragma("unroll") for (int m = 0; m < 4; ++m) _Pragma("unroll") for (int n = 0; n < 2; ++n) _Pragma("unroll") for (int k = 0; k < 2; ++k) \
        acc[ai][bj][m][n] = __builtin_amdgcn_mfma_f32_16x16x32_bf16(Bt[n][k], At[m][k], acc[ai][bj][m][n], 0, 0, 0); __builtin_amdgcn_s_setprio(0); } while (0)
#define PG8_WAIT_V(n) asm volatile("s_waitcnt vmcnt(" #n ")" ::: "memory")
#define PG8_WAIT_L(n) asm volatile("s_waitcnt lgkmcnt(" #n ")" ::: "memory")
#define PG8_BAR __builtin_amdgcn_s_barrier()
#define PG8_SCHED __builtin_amdgcn_sched_barrier(0)
    Unit cur, nxt; int ui = 0;
    if (!S.next(0, cur)) return;
    f32x4 acc[2][2][4][2];
#pragma unroll
    for (int a = 0; a < 2; ++a)
#pragma unroll
        for (int b = 0; b < 2; ++b)
#pragma unroll
            for (int m = 0; m < 4; ++m)
#pragma unroll
                for (int n = 0; n < 2; ++n) acc[a][b][m][n] = (f32x4){0.f, 0.f, 0.f, 0.f};
    bf16x8 At[4][2], B0[2][2], B1[2][2];
    const char* cA = (const char*)g.A + (size_t)cur.pm * tstep; const char* cB = (const char*)g.Bt + (size_t)cur.pn * tstep;
    S.a_ready(cur);
    PG8_STAGE(PG8_SB(0, 0), cB, voffB); PG8_STAGE(PG8_SA(0, 0), cA, voffA); PG8_STAGE(PG8_SB(0, 1), cB + hstep, voffB); PG8_STAGE(PG8_SA(0, 1), cA + hstep, voffA);
    if (wr == 1) PG8_BAR;
    PG8_WAIT_V(4); PG8_BAR;
    PG8_STAGE(PG8_SB(1, 0), cB + kstep, voffB); PG8_STAGE(PG8_SA(1, 0), cA + kstep, voffA); PG8_STAGE(PG8_SB(1, 1), cB + hstep + kstep, voffB);
    PG8_WAIT_V(6); PG8_BAR;
    for (;;) {
        const bool has_next = S.next(ui + 1, nxt);
        const char* nA = has_next ? (const char*)g.A + (size_t)nxt.pm * tstep : cA; const char* nB = has_next ? (const char*)g.Bt + (size_t)nxt.pn * tstep : cB;
        for (int t = 0; t < nt; t += 2) {
            const bool last = (t == nt - 2);
            const char* a1 = cA + (size_t)(t + 1) * kstep;
            const char* a2 = last ? nA : cA + (size_t)(t + 2) * kstep; const char* b2 = last ? nB : cB + (size_t)(t + 2) * kstep;
            const char* a3 = a2 + kstep; const char* b3 = b2 + kstep;
            if (last && has_next) S.a_ready(nxt);
            PG8_LDB(B0, 0, 0); PG8_SCHED; PG8_LDA(At, 0, 0); PG8_STAGE(PG8_SA(1, 1), a1 + hstep, voffA);
            PG8_WAIT_L(8); PG8_BAR; PG8_WAIT_L(0); PG8_MMA(0, 0, At, B0); PG8_BAR; PG8_SCHED;
            PG8_LDB(B1, 0, 1); PG8_STAGE(PG8_SB(0, 0), b2, voffB);
            PG8_BAR; PG8_WAIT_L(0); PG8_MMA(0, 1, At, B1); PG8_BAR;
            PG8_LDA(At, 0, 1); PG8_STAGE(PG8_SA(0, 0), a2, voffA);
            PG8_BAR; PG8_WAIT_L(0); PG8_MMA(1, 0, At, B0); PG8_BAR; PG8_SCHED;
            PG8_STAGE(PG8_SB(0, 1), b2 + hstep, voffB);
            PG8_WAIT_V(6); PG8_BAR; PG8_MMA(1, 1, At, B1); PG8_BAR;
            PG8_LDB(B0, 1, 0); PG8_SCHED; PG8_LDA(At, 1, 0); PG8_STAGE(PG8_SA(0, 1), a2 + hstep, voffA);
            PG8_WAIT_L(8); PG8_BAR; PG8_WAIT_L(0); PG8_MMA(0, 0, At, B0); PG8_BAR; PG8_SCHED;
            PG8_LDB(B1, 1, 1); PG8_STAGE(PG8_SB(1, 0), b3, voffB);
            PG8_BAR; PG8_WAIT_L(0); PG8_MMA(0, 1, At, B1); PG8_BAR;
            PG8_LDA(At, 1, 1); PG8_STAGE(PG8_SA(1, 0), a3, voffA);
            PG8_BAR; PG8_WAIT_L(0); PG8_MMA(1, 0, At, B0); PG8_BAR; PG8_SCHED;
            PG8_STAGE(PG8_SB(1, 1), b3 + hstep, voffB);
            PG8_WAIT_V(6); PG8_BAR; PG8_MMA(1, 1, At, B1); PG8_BAR;
        }
        E(acc, cur, wr, wc, fr, fq); S.done(cur);
        if (!has_next) break;
#pragma unroll
        for (int a = 0; a < 2; ++a)
#pragma unroll
            for (int b = 0; b < 2; ++b)
#pragma unroll
                for (int m = 0; m < 4; ++m)
#pragma unroll
                    for (int n = 0; n < 2; ++n) acc[a][b][m][n] = (f32x4){0.f, 0.f, 0.f, 0.f};
        cur = nxt; cA = nA; cB = nB; ++ui;
    }
    PG8_WAIT_V(0);
    if (wr == 0) PG8_BAR;
    PG8_BAR;
#undef PG8_SA
#undef PG8_SB
#undef PG8_STAGE
#undef PG8_LDA
#undef PG8_LDB
#undef PG8_MMA
#undef PG8_WAIT_V
#undef PG8_WAIT_L
#undef PG8_BAR
#undef PG8_SCHED
}
}

struct EpiProj {
    static constexpr bool PERM = true;
    char* ws;
    __device__ __forceinline__ void store8(bf16_t* dst, const f32x4& a, const f32x4& b, float sc) const {
        u32x4 o; o[0] = cvt_pk_bf16(a[0] * sc, a[1] * sc); o[1] = cvt_pk_bf16(a[2] * sc, a[3] * sc); o[2] = cvt_pk_bf16(b[0] * sc, b[1] * sc); o[3] = cvt_pk_bf16(b[2] * sc, b[3] * sc);
        *(u32x4*)dst = o;
    }
    __device__ __forceinline__ void operator()(const f32x4 (&acc)[2][2][4][2], const pg8::Unit& u, int wr, int wc, int fr, int fq) const {
        { int ln_ = (int)__builtin_amdgcn_mbcnt_hi(~0u, __builtin_amdgcn_mbcnt_lo(~0u, 0u)); asm volatile("" : "+v"(ln_)); fr = ln_ & 15; fq = ln_ >> 4; }
        if (u.pn < 13) {
#pragma unroll
            for (int bj = 0; bj < 2; ++bj) {
                const int hb = 4 * u.pn + 2 * bj + (wc >> 1);
                const int cc8 = 32 * (wc & 1) + 8 * fq;
#pragma unroll
                for (int ai = 0; ai < 2; ++ai)
#pragma unroll
                    for (int m = 0; m < 4; ++m) {
                        const int t = 256 * u.pm + 128 * ai + 64 * wr + 16 * m + fr;
                        const f32x4 v0 = acc[ai][bj][m][0], v1 = acc[ai][bj][m][1];
                        if (t < T) {
                            const size_t tt = (size_t)t;
                            if (hb < 4) store8((bf16_t*)(ws + OFF_GQ) + tt * 256 + hb * 64 + cc8, v0, v1, 0.125f);
                            else if (hb < 8) store8((bf16_t*)(ws + OFF_GK) + tt * 256 + (hb - 4) * 64 + cc8, v0, v1, 1.f);
                            else if (hb < 16) {
                                const int bq = t / L, pos = t - bq * L;
                                bf16_t* dst = (bf16_t*)(ws + OFF_GV) + ((size_t)(bq * 4 + ((hb - 8) >> 1)) * 128 + ((hb - 8) & 1) * 64 + cc8) * LPV + 48 + pos;
#pragma unroll
                                for (int j = 0; j < 4; ++j) { dst[(size_t)j * LPV] = f2bf(v0[j]); dst[(size_t)(4 + j) * LPV] = f2bf(v1[j]); }
                            }
                            else if (hb < 24 || (hb >= 32 && hb < 40)) {
                                f32x4 s0, s1;
#pragma unroll
                                for (int j = 0; j < 4; ++j) { s0[j] = silu_f(v0[j]); s1[j] = silu_f(v1[j]); }
                                const int col = (hb < 24) ? (hb - 16) * 64 : 512 + (hb - 32) * 64;
                                store8((bf16_t*)(ws + OFF_MIX) + tt * 1024 + col + cc8, s0, s1, 1.f);
                            }
                            else if (hb < 32) store8((bf16_t*)(ws + OFF_AQ) + tt * 512 + (hb - 24) * 64 + cc8, v0, v1, 0.125f * 1.44269504088896341f);
                            else if (hb < 48) store8((bf16_t*)(ws + OFF_IQ) + tt * 512 + (hb - 40) * 64 + cc8, v0, v1, 0.125f);
                            else if (hb < 50) store8((bf16_t*)(ws + OFF_AK) + tt * 128 + (hb - 48) * 64 + cc8, v0, v1, 1.f);
                            else {
                                const int bq = t / L, pos = t - bq * L;
                                bf16_t* dst = (bf16_t*)(ws + OFF_AV) + ((size_t)(bq * 2 + (hb - 50)) * 64 + cc8) * LP + pos;
#pragma unroll
                                for (int j = 0; j < 4; ++j) { dst[(size_t)j * LP] = f2bf(v0[j]); dst[(size_t)(4 + j) * LP] = f2bf(v1[j]); }
                            }
                        }
                        asm volatile("" ::: "memory");
                    }
            }
        } else {
#pragma unroll
            for (int ai = 0; ai < 2; ++ai)
#pragma unroll
                for (int m = 0; m < 4; ++m) {
                    const int t = 256 * u.pm + 128 * ai + 64 * wr + 16 * m + fr;
                    if (t < T) {
                        if (wc == 0) {
                            float* dst = (float*)(ws + OFF_IKR) + (size_t)t * 64 + 8 * fq;
                            *(f32x4*)dst = acc[ai][0][m][0]; *(f32x4*)(dst + 4) = acc[ai][0][m][1];
                            *(f32x4*)(dst + 32) = acc[ai][1][m][0]; *(f32x4*)(dst + 36) = acc[ai][1][m][1];
                        } else if (wc == 1) {
                            const f32x4 v0 = acc[ai][0][m][0], v1 = acc[ai][0][m][1];
                            if (fq < 2) {
                                float* dst = (float*)(ws + OFF_GLR) + (size_t)t * 16 + 8 * fq;
                                *(f32x4*)dst = v0; *(f32x4*)(dst + 4) = v1;
                            } else if (fq == 2) {
                                float* dst = (float*)(ws + OFF_IW) + (size_t)t * 8;
                                *(f32x4*)dst = v0 * 0.353553390593273762f; *(f32x4*)(dst + 4) = v1 * 0.353553390593273762f;
                            }
                        }
                    }
                    asm volatile("" ::: "memory");
                }
        }
    }
};

struct EpiOut {
    static constexpr bool PERM = false;
    const float* H32; float* Z;
    __device__ __forceinline__ void operator()(const f32x4 (&acc)[2][2][4][2], const pg8::Unit& u, int wr, int wc, int fr, int fq) const {
        { int ln_ = (int)__builtin_amdgcn_mbcnt_hi(~0u, __builtin_amdgcn_mbcnt_lo(~0u, 0u)); asm volatile("" : "+v"(ln_)); fr = ln_ & 15; fq = ln_ >> 4; }
        const int col0 = u.pn * 256 + wc * 32 + 4 * fq;
#pragma unroll
        for (int ai = 0; ai < 2; ++ai) {
            f32x4 hv[4][2][2];
#pragma unroll
            for (int m = 0; m < 4; ++m) {
                int t = 256 * u.pm + 128 * ai + 64 * wr + 16 * m + fr; t = t < T ? t : T - 1;
                const size_t off = (size_t)t * D + col0;
#pragma unroll
                for (int bj = 0; bj < 2; ++bj)
#pragma unroll
                    for (int n = 0; n < 2; ++n) hv[m][bj][n] = *(const f32x4*)(H32 + off + bj * 128 + n * 16);
            }
#pragma unroll
            for (int m = 0; m < 4; ++m) {
                const int t = 256 * u.pm + 128 * ai + 64 * wr + 16 * m + fr;
                if (t < T) {
                    const size_t off = (size_t)t * D + col0;
#pragma unroll
                    for (int bj = 0; bj < 2; ++bj)
#pragma unroll
                        for (int n = 0; n < 2; ++n) *(f32x4*)(Z + off + bj * 128 + n * 16) = acc[ai][bj][m][n] + hv[m][bj][n] * ALPHA;
                }
            }
            asm volatile("" ::: "memory");
        }
    }
};

__device__ __forceinline__ void phase_proj(const Params& p_in, int layer_in, char* smem) {
    const Params p = kparams(); const int layer = opaque_int(layer_in); (void)p_in;
    pg8::Gemm g; g.A = (const bf16_t*)(p.ws + OFF_HB); g.Bt = (const bf16_t*)(p.ws + OFF_WIN) + (size_t)layer * INWP * D; g.M = TP; g.N = INWP; g.K = D;
    pg8::StaticOrder S; S.init(TP, INWP, gridDim.x, opaque_bid());
    EpiProj E; E.ws = p.ws;
    pg8::gemm_phase((LAS unsigned char*)smem, g, S, E);
}
__device__ __forceinline__ void phase_outproj(const Params& p_in, int layer_in, char* smem) {
    const Params p = kparams(); const int layer = opaque_int(layer_in); (void)p_in;
    const bf16_t* MIXp = (const bf16_t*)(p.ws + OFF_MIX);
    const bf16_t* WOUT = (const bf16_t*)(p.ws + OFF_WOUT) + (size_t)layer * D * D;
    const float* H32 = (const float*)(p.ws + OFF_H32);
    float* Z = (float*)(p.ws + OFF_GQ);
    {
        pg8::Gemm g; g.A = MIXp; g.Bt = WOUT; g.M = 16384; g.N = D; g.K = D;
        pg8::StaticOrder S; S.init(16384, D, gridDim.x, opaque_bid());
        EpiOut E; E.H32 = H32; E.Z = Z;
        pg8::gemm_phase((LAS unsigned char*)smem, g, S, E);
    }
    const int tid = opaque_tid(), wid = __builtin_amdgcn_readfirstlane(tid >> 6), lane = tid & 63, fr = lane & 15, fq = lane >> 4;
    for (int task = opaque_bid(); task < 64; task += gridDim.x) {
        const int rg = task >> 3, cs = task & 7;
        const bf16_t* ap = MIXp + (size_t)(16384 + 16 * rg + fr) * D + 8 * fq;
        const bf16_t* bp = WOUT + (size_t)(128 * cs + 16 * wid + fr) * D + 8 * fq;
        f32x4 acc = {0.f, 0.f, 0.f, 0.f};
        bf16x8 a0[8], b0[8], a1[8], b1[8];
#pragma unroll
        for (int k = 0; k < 8; ++k) { a0[k] = *(const bf16x8*)(ap + 32 * k); b0[k] = *(const bf16x8*)(bp + 32 * k); }
#pragma unroll
        for (int ch = 0; ch < 4; ++ch) {
            if (ch < 3) {
#pragma unroll
                for (int k = 0; k < 8; ++k) { a1[k] = *(const bf16x8*)(ap + 256 * (ch + 1) + 32 * k); b1[k] = *(const bf16x8*)(bp + 256 * (ch + 1) + 32 * k); }
            }
#pragma unroll
            for (int k = 0; k < 8; ++k) acc = __builtin_amdgcn_mfma_f32_16x16x32_bf16(a0[k], b0[k], acc, 0, 0, 0);
#pragma unroll
            for (int k = 0; k < 8; ++k) { a0[k] = a1[k]; b0[k] = b1[k]; }
        }
#pragma unroll
        for (int r = 0; r < 4; ++r) {
            const size_t off = (size_t)(16384 + 16 * rg + 4 * fq + r) * D + 128 * cs + 16 * wid + fr;
            Z[off] = acc[r] + ALPHA * H32[off];
        }
    }
}

__device__ __forceinline__ void phase_gla_naive(const Params& p, int layer, char* smem) {
    float (*qs)[64] = (float (*)[64])smem;
    float (*ks)[64] = qs + 8;
    float (*es)[64] = ks + 8;
    float (*part)[8] = (float (*)[8])(es + 8);
    float (*os)[128] = (float (*)[128])(part + 2);
    const int tid = opaque_tid();
    const bf16_t* GQ = (const bf16_t*)(p.ws + OFF_GQ);
    const bf16_t* GK = (const bf16_t*)(p.ws + OFF_GK);
    const bf16_t* GV = (const bf16_t*)(p.ws + OFF_GV);
    const float* GLR = (const float*)(p.ws + OFF_GLR);
    bf16_t* MIX = (bf16_t*)(p.ws + OFF_MIX);
    const float* ng = p.norm_g + layer * 128;
    const float* wg2 = p.wg2 + (size_t)layer * 16 * 256; const float* bg = p.bg + layer * 256;
    for (int item = opaque_bid(); item < NB * 4; item += gridDim.x) {
        const int b = item >> 2, h = item & 3;
        float S[64];
#pragma unroll
        for (int d = 0; d < 64; ++d) S[d] = 0.f;
        const int e = tid & 127;
        const float nge = ng[e];
        const int ltt = tid >> 6, ld = tid & 63;
        float w[16];
#pragma unroll
        for (int rr = 0; rr < 16; ++rr) w[rr] = wg2[rr * 256 + h * 64 + ld];
        const float bgd = bg[h * 64 + ld];
        for (int t0 = 0; t0 < L; t0 += 8) {
            __syncthreads();
            {
                const size_t row = (size_t)b * L + t0 + ltt;
                qs[ltt][ld] = bf2f(GQ[row * 256 + h * 64 + ld]);
                ks[ltt][ld] = bf2f(GK[row * 256 + h * 64 + ld]);
                const float4* gp = (const float4*)&GLR[row * 16];
                const float4 g0 = gp[0], g1 = gp[1], g2 = gp[2], g3 = gp[3];
                float s = bgd;
                s = fmaf(g0.x, w[0], s); s = fmaf(g0.y, w[1], s); s = fmaf(g0.z, w[2], s); s = fmaf(g0.w, w[3], s);
                s = fmaf(g1.x, w[4], s); s = fmaf(g1.y, w[5], s); s = fmaf(g1.z, w[6], s); s = fmaf(g1.w, w[7], s);
                s = fmaf(g2.x, w[8], s); s = fmaf(g2.y, w[9], s); s = fmaf(g2.z, w[10], s); s = fmaf(g2.w, w[11], s);
                s = fmaf(g3.x, w[12], s); s = fmaf(g3.y, w[13], s); s = fmaf(g3.z, w[14], s); s = fmaf(g3.w, w[15], s);
                es[ltt][ld] = expf(logsigmoid_f(s) * (1.f / 16.f));
            }
            __syncthreads();
            if (tid < 128) {
#pragma unroll 1
                for (int tt = 0; tt < 8; ++tt) {
                    const size_t row = (size_t)b * L + t0 + tt;
                    const float v = bf2f(GV[row * 512 + h * 128 + e]);
                    float acc = 0.f;
#pragma unroll
                    for (int d = 0; d < 64; ++d) {
                        S[d] = fmaf(es[tt][d], S[d], ks[tt][d] * v);
                        acc = fmaf(qs[tt][d], S[d], acc);
                    }
                    os[tt][e] = acc;
                    const float ss = wave_sum(acc * acc);
                    if ((tid & 63) == 0) part[tid >> 6][tt] = ss;
                }
            }
            __syncthreads();
            if (tid < 128) {
#pragma unroll 1
                for (int tt = 0; tt < 8; ++tt) {
                    const size_t row = (size_t)b * L + t0 + tt;
                    const float tot = part[0][tt] + part[1][tt];
                    const float rinv = rsqrtf(tot * (1.f / 128) + LN_EPS);
                    const size_t idx = row * 1024 + h * 128 + e;
                    MIX[idx] = f2bf(os[tt][e] * rinv * nge * bf2f(MIX[idx]));
                }
            }
        }
    }
}

__device__ __forceinline__ unsigned okey(float x) {
    const unsigned u = __float_as_uint(x);
    return (u & 0x80000000u) ? ~u : (u | 0x80000000u);
}
__device__ __forceinline__ int wave_incl_scan(int v) {
    const int lane = opaque_tid() & 63;
#pragma unroll
    for (int o = 1; o < 64; o <<= 1) { const int n = __shfl_up(v, o); if (lane >= o) v += n; }
    return v;
}
__device__ __forceinline__ int block_excl_scan(int v, int* tmp) {
    const int incl = wave_incl_scan(v);
    const int tq = opaque_tid();
    __syncthreads();
    if ((tq & 63) == 63) tmp[tq >> 6] = incl;
    __syncthreads();
    const int w = tq >> 6;
    int base = 0;
    for (int i = 0; i < w; ++i) base += tmp[i];
    return base + incl - v;
}
__device__ __forceinline__ void unpack8(const uint4 u, float* kf) {
    kf[0] = __uint_as_float(u.x << 16); kf[1] = __uint_as_float(u.x & 0xFFFF0000u);
    kf[2] = __uint_as_float(u.y << 16); kf[3] = __uint_as_float(u.y & 0xFFFF0000u);
    kf[4] = __uint_as_float(u.z << 16); kf[5] = __uint_as_float(u.z & 0xFFFF0000u);
    kf[6] = __uint_as_float(u.w << 16); kf[7] = __uint_as_float(u.w & 0xFFFF0000u);
}

__device__ __forceinline__ void phase_dsa_naive(const Params& p, int layer, char* smem) {
    float* sc = (float*)smem;
    float (*iqs)[64] = (float (*)[64])(sc + 2080);
    float (*aqs)[64] = iqs + 8;
    float (*lg)[256] = (float (*)[256])(aqs + 8);
    unsigned* hist = (unsigned*)(lg + 8);
    int* sel = (int*)(hist + 256);
    int* misc = sel + 256;
    const int tid = opaque_tid();
    const bf16_t* IQ = (const bf16_t*)(p.ws + OFF_IQ);
    const bf16_t* IK = (const bf16_t*)(p.ws + OFF_IK);
    const float* IW = (const float*)(p.ws + OFF_IW);
    const bf16_t* AQ = (const bf16_t*)(p.ws + OFF_AQ);
    const bf16_t* AK = (const bf16_t*)(p.ws + OFF_AK);
    const bf16_t* AV = (const bf16_t*)(p.ws + OFF_AV);
    bf16_t* MIX = (bf16_t*)(p.ws + OFF_MIX);
    for (int item = opaque_bid(); item < T; item += gridDim.x) {
        const int b = item / L, t = item % L;
        const size_t row = (size_t)item;
        __syncthreads();
        iqs[tid >> 6][tid & 63] = bf2f(IQ[row * 512 + tid]); aqs[tid >> 6][tid & 63] = bf2f(AQ[row * 512 + tid]);
        __syncthreads();
        float w[8];
#pragma unroll
        for (int j = 0; j < 8; ++j) w[j] = IW[row * 8 + j];
        for (int s = tid; s <= t; s += NT) {
            const uint4* kp = (const uint4*)&IK[((size_t)b * L + s) * 64];
            float dd[8];
#pragma unroll
            for (int j = 0; j < 8; ++j) dd[j] = 0.f;
#pragma unroll 1
            for (int q = 0; q < 8; ++q) {
                float kf[8]; unpack8(kp[q], kf);
#pragma unroll
                for (int j = 0; j < 8; ++j) {
                    const float4 a0 = *(const float4*)&iqs[j][q * 8], a1 = *(const float4*)&iqs[j][q * 8 + 4];
                    dd[j] = fmaf(a0.x, kf[0], dd[j]); dd[j] = fmaf(a0.y, kf[1], dd[j]); dd[j] = fmaf(a0.z, kf[2], dd[j]); dd[j] = fmaf(a0.w, kf[3], dd[j]);
                    dd[j] = fmaf(a1.x, kf[4], dd[j]); dd[j] = fmaf(a1.y, kf[5], dd[j]); dd[j] = fmaf(a1.z, kf[6], dd[j]); dd[j] = fmaf(a1.w, kf[7], dd[j]);
                }
            }
            float score = 0.f;
#pragma unroll
            for (int j = 0; j < 8; ++j) score = fmaf(w[j], fmaxf(dd[j], 0.f), score);
            sc[s] = score;
        }
        __syncthreads();
        const int n = t + 1;
        int nsel;
        if (n <= TOPK) {
            if (tid < n) sel[tid] = tid;
            nsel = n;
        } else {
            unsigned prefix = 0; int remaining = TOPK;
            for (int pass = 0; pass < 4; ++pass) {
                const int shift = 24 - 8 * pass;
                if (tid < 256) hist[tid] = 0;
                __syncthreads();
                for (int s = tid; s < n; s += NT) {
                    const unsigned key = okey(sc[s]);
                    const bool match = (pass == 0) || ((key >> (shift + 8)) == prefix);
                    if (match) atomicAdd(&hist[(key >> shift) & 255u], 1u);
                }
                __syncthreads();
                if (tid == 0) {
                    int cum = 0, d = 255;
                    for (; d > 0; --d) { const int c = (int)hist[d]; if (cum + c >= remaining) break; cum += c; }
                    misc[0] = d; misc[1] = remaining - cum;
                }
                __syncthreads();
                prefix = (prefix << 8) | (unsigned)misc[0]; remaining = misc[1];
                __syncthreads();
            }
            const int s0 = tid * 5;
            int ceq = 0;
#pragma unroll
            for (int q = 0; q < 5; ++q) { const int s = s0 + q; if (s < n && okey(sc[s]) == prefix) ++ceq; }
            int eqrank = block_excl_scan(ceq, misc + 8);
            int csel = 0; unsigned selmask = 0;
#pragma unroll
            for (int q = 0; q < 5; ++q) {
                const int s = s0 + q;
                if (s < n) {
                    const unsigned key = okey(sc[s]);
                    bool take = key > prefix;
                    if (key == prefix) { take = eqrank < remaining; ++eqrank; }
                    if (take) { ++csel; selmask |= 1u << q; }
                }
            }
            int posn = block_excl_scan(csel, misc + 16);
#pragma unroll
            for (int q = 0; q < 5; ++q) if (selmask & (1u << q)) { if (posn < TOPK) sel[posn] = s0 + q; ++posn; }
            nsel = TOPK;
        }
        __syncthreads();
        {
            const int i = tid & 255, g = tid >> 8;
            if (i < nsel) {
                const int kidx = sel[i];
                const uint4* kp = (const uint4*)&AK[((size_t)b * L + kidx) * 128 + g * 64];
                float dd[4] = {0.f, 0.f, 0.f, 0.f};
#pragma unroll 1
                for (int q = 0; q < 8; ++q) {
                    float kf[8]; unpack8(kp[q], kf);
#pragma unroll
                    for (int r = 0; r < 4; ++r) {
                        const float4 a0 = *(const float4*)&aqs[g * 4 + r][q * 8], a1 = *(const float4*)&aqs[g * 4 + r][q * 8 + 4];
                        dd[r] = fmaf(a0.x, kf[0], dd[r]); dd[r] = fmaf(a0.y, kf[1], dd[r]); dd[r] = fmaf(a0.z, kf[2], dd[r]); dd[r] = fmaf(a0.w, kf[3], dd[r]);
                        dd[r] = fmaf(a1.x, kf[4], dd[r]); dd[r] = fmaf(a1.y, kf[5], dd[r]); dd[r] = fmaf(a1.z, kf[6], dd[r]); dd[r] = fmaf(a1.w, kf[7], dd[r]);
                    }
                }
#pragma unroll
                for (int r = 0; r < 4; ++r) lg[g * 4 + r][i] = dd[r];
            } else {
#pragma unroll
                for (int r = 0; r < 4; ++r) lg[g * 4 + r][i] = -INFINITY;
            }
        }
        __syncthreads();
        {
            const int h = tid >> 6, lane = tid & 63;
            float v0 = lg[h][lane], v1 = lg[h][lane + 64], v2 = lg[h][lane + 128], v3 = lg[h][lane + 192];
            const float m = wave_max(fmaxf(fmaxf(v0, v1), fmaxf(v2, v3)));
            v0 = expf(v0 - m); v1 = expf(v1 - m); v2 = expf(v2 - m); v3 = expf(v3 - m);
            const float inv = 1.f / wave_sum(v0 + v1 + v2 + v3);
            lg[h][lane] = v0 * inv; lg[h][lane + 64] = v1 * inv; lg[h][lane + 128] = v2 * inv; lg[h][lane + 192] = v3 * inv;
        }
        __syncthreads();
        {
            const int h = tid >> 6, d = tid & 63, g = h >> 2;
            float o = 0.f;
            for (int i = 0; i < nsel; ++i) o = fmaf(lg[h][i], bf2f(AV[((size_t)b * L + sel[i]) * 128 + g * 64 + d]), o);
            const size_t mi = row * 1024 + 512 + tid;
            MIX[mi] = f2bf(o * bf2f(MIX[mi]));
        }
    }
}


constexpr int DS_SC = 0, DS_BITS = 134144, DS_HIST = DS_BITS + 4224, DS_CAND = DS_HIST + 8 * 1040, DS_END = DS_CAND + 8 * 512;
constexpr int DS_TAB = 65536, DS_CONST = DS_TAB + 2112 * 32;
static_assert(DS_CONST + 32 <= DS_BITS, "bias table overlaps bitmask");


template <int NR>
__device__ __forceinline__ void dsa_select(const LAS unsigned* row, LAS unsigned* bits, LAS unsigned* hist, int n, int lane) {
    unsigned kreg[NR];
#pragma unroll
    for (int i = 0; i < NR; ++i) kreg[i] = (lane < n - 64 * i) ? okey(__uint_as_float(row[lane + 64 * i])) : 0u;
    unsigned prefix = 0; int remaining = TOPK;
#pragma unroll 1
    for (int pass = 0; pass < 4; ++pass) {
        const int shift = 24 - 8 * pass;
        *(LAS u32x4*)(hist + lane * 4) = (u32x4){0u, 0u, 0u, 0u};
        __builtin_amdgcn_wave_barrier(); asm volatile("" ::: "memory");
        const unsigned sh8 = (unsigned)(shift + 8) & 31u;
#pragma unroll
        for (int i = 0; i < NR; ++i) {
            const unsigned key = kreg[i];
            const bool match = (lane < n - 64 * i) && ((pass == 0) || ((key >> sh8) == prefix));
            if (match) __hip_atomic_fetch_add(hist + ((key >> shift) & 255u), 1u, __ATOMIC_RELAXED, __HIP_MEMORY_SCOPE_WAVEFRONT);
        }
        __builtin_amdgcn_wave_barrier(); asm volatile("s_waitcnt lgkmcnt(0)" ::: "memory");
        const u32x4 hv = *(const LAS u32x4*)(hist + (63 - lane) * 4);
        const int c0 = (int)hv[3], c1 = (int)hv[2], c2 = (int)hv[1], c3 = (int)hv[0];
        const int tot = c0 + c1 + c2 + c3;
        const int incl = wave_incl_scan(tot), excl = incl - tot;
        const bool found = (excl < remaining) && (remaining <= incl);
        int digit = 0, rem_new = 0;
        if (found) {
            int cum = excl;
            if (cum + c0 >= remaining) { digit = 255 - 4 * lane; rem_new = remaining - cum; }
            else { cum += c0;
                if (cum + c1 >= remaining) { digit = 254 - 4 * lane; rem_new = remaining - cum; }
                else { cum += c1;
                    if (cum + c2 >= remaining) { digit = 253 - 4 * lane; rem_new = remaining - cum; }
                    else { cum += c2; digit = 252 - 4 * lane; rem_new = remaining - cum; } } }
        }
        const unsigned long long fm = __ballot(found);
        const int src = (int)__builtin_ctzll(fm);
        digit = __builtin_amdgcn_readlane(digit, src); rem_new = __builtin_amdgcn_readlane(rem_new, src);
        prefix = (prefix << 8) | (unsigned)digit; remaining = rem_new;
    }
    const unsigned tkey = prefix;
    int eqcount = 0;
#pragma unroll
    for (int i = 0; i < 33; ++i) {
        if (i < NR) {
            const unsigned key = kreg[i < NR ? i : 0];
            const bool valid = lane < n - 64 * i;
            const bool gt = valid && (key > tkey), eq = valid && (key == tkey);
            const unsigned long long em = __ballot(eq);
            const int rank = eqcount + __popcll(em & ((1ull << lane) - 1ull));
            const bool sel = gt || (eq && rank < remaining);
            eqcount += __popcll(em);
            const unsigned long long sm = __ballot(sel);
            if (lane == 0) { bits[2 * i] = (unsigned)sm; bits[2 * i + 1] = (unsigned)(sm >> 32); }
        } else if (lane == 0) { bits[2 * i] = 0u; bits[2 * i + 1] = 0u; }
    }
}


template <int NR>
__device__ __forceinline__ bool dsa_select_v(const LAS unsigned* row, LAS unsigned* bits, LAS unsigned* hist, LAS unsigned* cand, int n, int lane) {
    float x[NR];
    const float qnan = __uint_as_float(0x7FC00000u);
#pragma unroll
    for (int i = 0; i < NR; ++i) x[i] = (lane < n - 64 * i) ? __uint_as_float(row[lane + 64 * i]) : qnan;
    float mn = x[0], mx = x[0];
#pragma unroll
    for (int i = 1; i < NR; ++i) { mn = fminf(mn, x[i]); mx = fmaxf(mx, x[i]); }
#pragma unroll
    for (int o = 32; o > 0; o >>= 1) { mn = fminf(mn, __shfl_xor(mn, o)); mx = fmaxf(mx, __shfl_xor(mx, o)); }
    bool ok = mx > mn;
    const float scale = 255.f / (mx - mn) * 0.99999f;
    int dstar = 0, rem = 0, cb = 0;
    if (ok) {
        *(LAS u32x4*)(hist + lane * 4) = (u32x4){0u, 0u, 0u, 0u};
        __builtin_amdgcn_wave_barrier(); asm volatile("" ::: "memory");
#pragma unroll
        for (int i = 0; i < NR; ++i) {
            const float xv = x[i];
            if (xv == xv) __hip_atomic_fetch_add(hist + (unsigned)(int)((xv - mn) * scale), 1u, __ATOMIC_RELAXED, __HIP_MEMORY_SCOPE_WAVEFRONT);
        }
        __builtin_amdgcn_wave_barrier(); asm volatile("s_waitcnt lgkmcnt(0)" ::: "memory");
        const u32x4 hv = *(const LAS u32x4*)(hist + (63 - lane) * 4);
        const int c0 = (int)hv[3], c1 = (int)hv[2], c2 = (int)hv[1], c3 = (int)hv[0];
        const int tot = c0 + c1 + c2 + c3;
        const int incl = wave_incl_scan(tot), excl = incl - tot;
        const bool found = (excl < TOPK) && (TOPK <= incl);
        int digit = 0, rem_new = 0, cnt = 0;
        if (found) {
            int cum = excl;
            if (cum + c0 >= TOPK) { digit = 255 - 4 * lane; rem_new = TOPK - cum; cnt = c0; }
            else { cum += c0;
                if (cum + c1 >= TOPK) { digit = 254 - 4 * lane; rem_new = TOPK - cum; cnt = c1; }
                else { cum += c1;
                    if (cum + c2 >= TOPK) { digit = 253 - 4 * lane; rem_new = TOPK - cum; cnt = c2; }
                    else { cum += c2; digit = 252 - 4 * lane; rem_new = TOPK - cum; cnt = c3; } } }
        }
        const unsigned long long fm = __ballot(found);
        const int src = (int)__builtin_ctzll(fm | (1ull << 63));
        dstar = __builtin_amdgcn_readlane(digit, src); rem = __builtin_amdgcn_readlane(rem_new, src); cb = __builtin_amdgcn_readlane(cnt, src);
        ok = (fm != 0ull) && (cb <= 64);
    }
    if (!ok) return false;
    int base = 0;
#pragma unroll
    for (int i = 0; i < NR; ++i) {
        const float xv = x[i];
        const bool inb = (xv == xv) && ((int)((xv - mn) * scale) == dstar);
        const unsigned long long bm = __ballot(inb);
        if (bm != 0ull) {
            if (inb) { const int pos = base + __popcll(bm & ((1ull << lane) - 1ull)); cand[2 * pos] = __float_as_uint(xv); cand[2 * pos + 1] = (unsigned)(lane + 64 * i); }
            base += __popcll(bm);
        }
    }
    __builtin_amdgcn_wave_barrier(); asm volatile("s_waitcnt lgkmcnt(0)" ::: "memory");
    float xc = qnan; int ic = 0x7fffffff;
    if (lane < cb) { xc = __uint_as_float(cand[2 * lane]); ic = (int)cand[2 * lane + 1]; }
    int rank = 0;
    for (int j = 0; j < cb; ++j) {
        const float xj = __builtin_bit_cast(float, __builtin_amdgcn_readlane(__builtin_bit_cast(int, xc), j));
        const int ij = __builtin_amdgcn_readlane(ic, j);
        rank += ((xj > xc) || (xj == xc && ij < ic)) ? 1 : 0;
    }
    const unsigned long long tm = __ballot((lane < cb) && (rank == rem - 1));
    const int tl = (int)__builtin_ctzll(tm | (1ull << 63));
    const float tx = __builtin_bit_cast(float, __builtin_amdgcn_readlane(__builtin_bit_cast(int, xc), tl));
    const int ti = __builtin_amdgcn_readlane(ic, tl);
#pragma unroll
    for (int i = 0; i < 33; ++i) {
        if (i < NR) {
            const float xv = x[i < NR ? i : 0];
            const bool sel = (xv > tx) || (xv == tx && (lane + 64 * i) <= ti);
            const unsigned long long sm = __ballot(sel);
            if (lane == 0) { bits[2 * i] = (unsigned)sm; bits[2 * i + 1] = (unsigned)(sm >> 32); }
        } else if (lane == 0) { bits[2 * i] = 0u; bits[2 * i + 1] = 0u; }
    }
    return true;
}

__device__ __forceinline__ void phase_dsa(const Params& p_in, int layer_in, char* smem, bool do_store) {
    const Params p = kparams(); const int layer = opaque_int(layer_in); (void)p_in;
    const int tid = opaque_tid(), wid = __builtin_amdgcn_readfirstlane(tid >> 6), lane_ = tid & 63, fr_ = lane_ & 15, fq_ = lane_ >> 4;
    LAS unsigned char* lds = (LAS unsigned char*)smem;
    const bf16_t* IQ = (const bf16_t*)(p.ws + OFF_IQ);
    const bf16_t* IK = (const bf16_t*)(p.ws + OFF_IK);
    const float* IW = (const float*)(p.ws + OFF_IW);
    const bf16_t* AQ = (const bf16_t*)(p.ws + OFF_AQ);
    const bf16_t* AK = (const bf16_t*)(p.ws + OFF_AK);
    const bf16_t* AVT = (const bf16_t*)(p.ws + OFF_AV);
    bf16_t* MIX = (bf16_t*)(p.ws + OFF_MIX);
    constexpr int NITEM = NB * 129;
    for (int idx = opaque_bid(); idx < NITEM; idx += gridDim.x) {
        const int b = idx & 7, mm = idx >> 3;
        int qr;
        { const int seg = mm >> 5, jj = mm & 31; qr = (seg == 0) ? jj : (seg == 1) ? 63 - jj : (seg == 2) ? 64 + jj : (seg == 3) ? 127 - jj : 128; }
        const int qt = 128 - qr, t0 = qt * 16;
        __syncthreads();
        for (int repA = 0; repA < PROBE_DSA_A; ++repA) {
            int fr = fr_, fq = fq_; asm volatile("" : "+v"(fr), "+v"(fq));
            const size_t rowq = (size_t)b * L + t0 + fr;
            bf16x8 qf[8][2];
#pragma unroll
            for (int jh = 0; jh < 8; ++jh)
#pragma unroll
                for (int s2 = 0; s2 < 2; ++s2) qf[jh][s2] = *(const bf16x8*)(IQ + rowq * 512 + jh * 64 + s2 * 32 + fq * 8);
            float w[8];
            { const f32x4 w0 = *(const f32x4*)(IW + rowq * 8), w1 = *(const f32x4*)(IW + rowq * 8 + 4);
              w[0] = w0[0]; w[1] = w0[1]; w[2] = w0[2]; w[3] = w0[3]; w[4] = w1[0]; w[5] = w1[1]; w[6] = w1[2]; w[7] = w1[3]; }
            const int ntile = qt + 1;
            const bf16x8 z8 = {0, 0, 0, 0, 0, 0, 0, 0};
            bf16x8 ka0 = z8, ka1 = z8, kb0 = z8, kb1 = z8, kc0 = z8, kc1 = z8;
            int kt = wid;
            if (kt < ntile) { const bf16_t* kp = IK + ((size_t)b * L + 16 * kt + fr) * 64 + fq * 8; ka0 = *(const bf16x8*)kp; ka1 = *(const bf16x8*)(kp + 32); }
            if (kt + 8 < ntile) { const bf16_t* kp = IK + ((size_t)b * L + 16 * (kt + 8) + fr) * 64 + fq * 8; kb0 = *(const bf16x8*)kp; kb1 = *(const bf16x8*)(kp + 32); }
            for (; kt < ntile; kt += 8) {
                if (kt + 16 < ntile) { const bf16_t* kp = IK + ((size_t)b * L + 16 * (kt + 16) + fr) * 64 + fq * 8; kc0 = *(const bf16x8*)kp; kc1 = *(const bf16x8*)(kp + 32); }
                f32x4 sc = {0.f, 0.f, 0.f, 0.f};
#pragma unroll
                for (int jh = 0; jh < 8; ++jh) {
                    f32x4 d = {0.f, 0.f, 0.f, 0.f};
                    d = __builtin_amdgcn_mfma_f32_16x16x32_bf16(ka0, qf[jh][0], d, 0, 0, 0);
                    d = __builtin_amdgcn_mfma_f32_16x16x32_bf16(ka1, qf[jh][1], d, 0, 0, 0);
#pragma unroll
                    for (int r = 0; r < 4; ++r) sc[r] = fmaf(w[jh], fmaxf(d[r], 0.f), sc[r]);
                }
                *(LAS f32x4*)(lds + DS_SC + (fr * 2064 + 16 * kt + 4 * fq) * 4) = sc;
                ka0 = kb0; ka1 = kb1; kb0 = kc0; kb1 = kc1;
            }
        }
        __syncthreads();
        for (int repB = 0; repB < PROBE_DSA_B; ++repB) {
            int lane = lane_; asm volatile("" : "+v"(lane));
            LAS unsigned* hist = (LAS unsigned*)(lds + DS_HIST + wid * 1040);
#pragma unroll 1
            for (int qq = 0; qq < 2; ++qq) {
                const int q = wid * 2 + qq;
                const int n = t0 + q + 1;
                const LAS unsigned* row = (const LAS unsigned*)(lds + DS_SC) + q * 2064;
                LAS unsigned* bits = (LAS unsigned*)(lds + DS_BITS) + q * 66;
                if (n <= TOPK) {
#pragma unroll 1
                    for (int i = 0; i < 33; ++i) {
                        const unsigned long long sm = __ballot(lane + 64 * i < n);
                        if (lane == 0) { bits[2 * i] = (unsigned)sm; bits[2 * i + 1] = (unsigned)(sm >> 32); }
                    }
                } else {
                    const int nr = (n + 63) >> 6;
                    LAS unsigned* cand = (LAS unsigned*)(lds + DS_CAND + wid * 512);
                    bool done;
                    if (nr <= 9) done = dsa_select_v<9>(row, bits, hist, cand, n, lane);
                    else if (nr <= 17) done = dsa_select_v<17>(row, bits, hist, cand, n, lane);
                    else if (nr <= 25) done = dsa_select_v<25>(row, bits, hist, cand, n, lane);
                    else done = dsa_select_v<33>(row, bits, hist, cand, n, lane);
                    if (!done) dsa_select<33>(row, bits, hist, n, lane);
                }
            }
        }
        __syncthreads();
        for (int repC = 0; repC < PROBE_DSA_C; ++repC) {
            if (repC > 0) __syncthreads();
            int fr = fr_, fq = fq_, lane = lane_; asm volatile("" : "+v"(fr), "+v"(fq), "+v"(lane));
            const size_t rowq = (size_t)b * L + t0 + fr;
            const int h = wid, g = h >> 2;
            const int nstep = (t0 + 16 + 63) >> 6;
            bf16x8 aqf[2];
            aqf[0] = *(const bf16x8*)(AQ + rowq * 512 + h * 64 + fq * 8);
            aqf[1] = *(const bf16x8*)(AQ + rowq * 512 + h * 64 + 32 + fq * 8);
            asm volatile("" : "+v"(aqf[0]), "+v"(aqf[1]));
            const int drow = 8 * wid + (lane >> 3);
            const int kch = (lane & 7) ^ (2 * ((drow >> 3) & 3) + ((drow >> 1) & 1)), vch = (lane & 7) ^ ((drow >> 1) & 7);
            const bf16_t* vsrc0 = AVT + ((size_t)b * 128 + drow) * LP + vch * 8;
#define DSA_DMA(st_, buf_) do { \
                int krow_ = b * L + 64 * (st_) + drow; krow_ = krow_ < T ? krow_ : T - 1; \
                const bf16_t* ks_ = AK + (size_t)krow_ * 128 + kch * 8; \
                LAS unsigned char* lb_ = lds + (buf_) * 32768 + wid * 1024; \
                __builtin_amdgcn_global_load_lds((const unsigned*)ks_, (LAS unsigned*)lb_, 16, 0, 0); \
                __builtin_amdgcn_global_load_lds((const unsigned*)(ks_ + 64), (LAS unsigned*)(lb_ + 8192), 16, 0, 0); \
                __builtin_amdgcn_global_load_lds((const unsigned*)(vsrc0 + 64 * (st_)), (LAS unsigned*)(lb_ + 16384), 16, 0, 0); \
                __builtin_amdgcn_global_load_lds((const unsigned*)(vsrc0 + (size_t)64 * LP + 64 * (st_)), (LAS unsigned*)(lb_ + 24576), 16, 0, 0); } while (0)
            DSA_DMA(0, 0);
            unsigned nb_lo = 0xC6EAu, nb_hi = 0xC6EA0000u; asm volatile("" : "+v"(nb_lo), "+v"(nb_hi));
            for (int key = tid; key < 2112; key += NT) {
                const int w32 = key & 31;
                const int R = (key >> 5) * 32 + ((w32 >> 2) & 1) * 16 + 4 * (w32 >> 3) + (w32 & 3);
                u32x4 lo, hi;
#pragma unroll
                for (int qp = 0; qp < 8; ++qp) {
                    const unsigned b0 = (*((const LAS unsigned*)(lds + DS_BITS) + (2 * qp) * 66 + (key >> 5)) >> w32) & 1u;
                    const unsigned b1 = (*((const LAS unsigned*)(lds + DS_BITS) + (2 * qp + 1) * 66 + (key >> 5)) >> w32) & 1u;
                    const unsigned v = (b0 ? 0u : nb_lo) | (b1 ? 0u : nb_hi);
                    if (qp < 4) lo[qp] = v; else hi[qp - 4] = v;
                }
                *(LAS u32x4*)(lds + DS_TAB + R * 32) = lo; *(LAS u32x4*)(lds + DS_TAB + R * 32 + 16) = hi;
            }
            if (tid < 8) *((LAS unsigned*)(lds + DS_CONST) + tid) = (tid == 0) ? 0x00003F80u : 0u;
            const int swzk = 2 * (fr >> 2) + ((fr >> 1) & 1);
            const int krow0 = 8 * (fr >> 2) + (fr & 3);
            const int tab_base = (fq < 2) ? DS_TAB + fr * 32 + 16 * fq : DS_CONST + 16 * (fq - 2);
            const int tab_mul = (fq < 2) ? 512 : 0;
            u32x4 bqw = {0u, 0u, 0u, 0u};
            if (fq < 2 && (fr >> 3) == fq) { const int j = fr & 7; bqw[j >> 1] = (j & 1) ? 0x3F800000u : 0x00003F80u; }
            u32x4 onw = {0u, 0u, 0u, 0u};
            if (fr == 0) onw = (u32x4){0x3F803F80u, 0x3F803F80u, 0x3F803F80u, 0x3F803F80u};
            const bf16x8 onesA = __builtin_bit_cast(bf16x8, onw);
            asm volatile("s_waitcnt vmcnt(0) lgkmcnt(0)" ::: "memory");
            __builtin_amdgcn_s_barrier();
            asm volatile("" ::: "memory");
            f32x4 O[4], O5 = {0.f, 0.f, 0.f, 0.f};
#pragma unroll
            for (int dt = 0; dt < 4; ++dt) O[dt] = (f32x4){0.f, 0.f, 0.f, 0.f};
            float mt = 0.f;
            for (int st = 0; st < nstep; ++st) {
                const int buf = st & 1;
                {
                    const int sn = (st + 1 < nstep) ? st + 1 : nstep - 1;
                    DSA_DMA(sn, buf ^ 1);
                }
                const LAS unsigned char* sb = lds + buf * 32768;
                const bf16x8 bq = __builtin_bit_cast(bf16x8, bqw);
                bf16x8 bfr[4], kfr[4][2];
#pragma unroll
                for (int kt = 0; kt < 4; ++kt) {
                    const int rowk = krow0 + 32 * (kt >> 1) + 4 * (kt & 1);
                    bfr[kt] = *(const LAS bf16x8*)(lds + tab_base + (4 * st + kt) * tab_mul);
#pragma unroll
                    for (int s2 = 0; s2 < 2; ++s2) kfr[kt][s2] = *(const LAS bf16x8*)(sb + g * 8192 + rowk * 128 + 16 * ((4 * s2 + fq) ^ swzk));
                }
                __builtin_amdgcn_sched_barrier(0);
                f32x4 S[4];
#pragma unroll
                for (int kt = 0; kt < 4; ++kt) {
                    S[kt] = __builtin_amdgcn_mfma_f32_16x16x32_bf16(bfr[kt], bq, (f32x4){0.f, 0.f, 0.f, 0.f}, 0, 0, 0);
                    S[kt] = __builtin_amdgcn_mfma_f32_16x16x32_bf16(kfr[kt][0], aqf[0], S[kt], 0, 0, 0);
                    S[kt] = __builtin_amdgcn_mfma_f32_16x16x32_bf16(kfr[kt][1], aqf[1], S[kt], 0, 0, 0);
                }
                bf16x8 vfr[2][4];
#pragma unroll
                for (int ks = 0; ks < 2; ++ks)
#pragma unroll
                    for (int dt = 0; dt < 4; ++dt) {
                        const int rowv = 16 * dt + fr;
                        vfr[ks][dt] = *(const LAS bf16x8*)(sb + 16384 + g * 8192 + rowv * 128 + 16 * ((4 * ks + fq) ^ ((rowv >> 1) & 7)));
                    }
                __builtin_amdgcn_sched_barrier(0);
                float pmax = fmaxf(fmaxf(S[0][0], S[0][1]), S[0][2]);
                pmax = fmaxf(fmaxf(pmax, S[0][3]), S[1][0]); pmax = fmaxf(fmaxf(pmax, S[1][1]), S[1][2]); pmax = fmaxf(fmaxf(pmax, S[1][3]), S[2][0]);
                pmax = fmaxf(fmaxf(pmax, S[2][1]), S[2][2]); pmax = fmaxf(fmaxf(pmax, S[2][3]), S[3][0]); pmax = fmaxf(fmaxf(pmax, S[3][1]), S[3][2]);
                pmax = fmaxf(pmax, S[3][3]);
                if (st == 0 || __any(pmax > 11.5f)) {
                    float pm = fmaxf(pmax, __shfl_xor(pmax, 16)); pm = fmaxf(pm, __shfl_xor(pm, 32));
                    const float up = (st == 0) ? fmaxf(pm, -64.f) : fmaxf(pm, 0.f);
                    const float mn = __uint_as_float((unsigned)f2bf(mt + up) << 16);
                    const float dlt = mt - mn;
                    const float alpha = __builtin_amdgcn_exp2f(dlt);
#pragma unroll
                    for (int dt = 0; dt < 4; ++dt) O[dt] *= alpha;
                    O5 *= alpha;
#pragma unroll
                    for (int kt = 0; kt < 4; ++kt) S[kt] += dlt;
                    mt = mn;
                    if (fq == 2) bqw[0] = (unsigned)f2bf(-mt);
                }
                unsigned pk[4][2];
#pragma unroll
                for (int kt = 0; kt < 4; ++kt) {
                    const float e0 = __builtin_amdgcn_exp2f(S[kt][0]), e1 = __builtin_amdgcn_exp2f(S[kt][1]), e2 = __builtin_amdgcn_exp2f(S[kt][2]), e3 = __builtin_amdgcn_exp2f(S[kt][3]);
                    pk[kt][0] = cvt_pk_bf16(e0, e1); pk[kt][1] = cvt_pk_bf16(e2, e3);
                }
#pragma unroll
                for (int ks = 0; ks < 2; ++ks) {
                    u32x4 pw; pw[0] = pk[2 * ks][0]; pw[1] = pk[2 * ks][1]; pw[2] = pk[2 * ks + 1][0]; pw[3] = pk[2 * ks + 1][1];
                    const bf16x8 pf = __builtin_bit_cast(bf16x8, pw);
                    O5 = __builtin_amdgcn_mfma_f32_16x16x32_bf16(onesA, pf, O5, 0, 0, 0);
#pragma unroll
                    for (int dt = 0; dt < 4; ++dt) O[dt] = __builtin_amdgcn_mfma_f32_16x16x32_bf16(vfr[ks][dt], pf, O[dt], 0, 0, 0);
                }
                asm volatile("s_waitcnt vmcnt(0)" ::: "memory");
                __builtin_amdgcn_s_barrier();
                asm volatile("" ::: "memory");
            }
#undef DSA_DMA
            const float l = __shfl(O5[0], fr);
            const float inv = 1.f / fmaxf(l, 1e-30f);
            bf16_t* mp = MIX + rowq * 1024 + 512 + h * 64 + 4 * fq;
            if (do_store && repC == PROBE_DSA_C - 1)
#pragma unroll
            for (int dt = 0; dt < 4; ++dt) {
                const uint2 gz = *(const uint2*)(mp + 16 * dt);
                const float g0 = __uint_as_float(gz.x << 16), g1 = __uint_as_float(gz.x & 0xFFFF0000u), g2 = __uint_as_float(gz.y << 16), g3 = __uint_as_float(gz.y & 0xFFFF0000u);
                uint2 o; o.x = cvt_pk_bf16(O[dt][0] * inv * g0, O[dt][1] * inv * g1); o.y = cvt_pk_bf16(O[dt][2] * inv * g2, O[dt][3] * inv * g3);
                *(uint2*)(mp + 16 * dt) = o;
            }
        }
    }
}

__device__ __forceinline__ void rope16(const u32x4 a, const u32x4 b, const float2* rp, u32x4& oa, u32x4& ob) {
    const f32x4 r0 = *(const f32x4*)(rp), r1 = *(const f32x4*)(rp + 2), r2 = *(const f32x4*)(rp + 4), r3 = *(const f32x4*)(rp + 6);
    const float cs[8] = {r0[0], r0[2], r1[0], r1[2], r2[0], r2[2], r3[0], r3[2]};
    const float sn[8] = {r0[1], r0[3], r1[1], r1[3], r2[1], r2[3], r3[1], r3[3]};
    float o1[8], o2[8];
#pragma unroll
    for (int i = 0; i < 4; ++i) {
        const float x1l = __uint_as_float(a[i] << 16), x1h = __uint_as_float(a[i] & 0xFFFF0000u);
        const float x2l = __uint_as_float(b[i] << 16), x2h = __uint_as_float(b[i] & 0xFFFF0000u);
        o1[2 * i] = x1l * cs[2 * i] - x2l * sn[2 * i]; o1[2 * i + 1] = x1h * cs[2 * i + 1] - x2h * sn[2 * i + 1];
        o2[2 * i] = x2l * cs[2 * i] + x1l * sn[2 * i]; o2[2 * i + 1] = x2h * cs[2 * i + 1] + x1h * sn[2 * i + 1];
    }
#pragma unroll
    for (int i = 0; i < 4; ++i) { oa[i] = cvt_pk_bf16(o1[2 * i], o1[2 * i + 1]); ob[i] = cvt_pk_bf16(o2[2 * i], o2[2 * i + 1]); }
}
__device__ __forceinline__ void phase_rope(const Params& p_in, int layer_in, char* smem) {
    const Params p = kparams(); const int layer = opaque_int(layer_in); (void)p_in;
    const int tid = opaque_tid();
    const float2* ROPE = (const float2*)(p.ws + OFF_ROPE);
    const int nthr = gridDim.x * NT, gid = opaque_bid() * NT + tid;
    for (int th = gid; th < T * 18; th += nthr) {
        const int t = th / 18, hh = th - t * 18, pos = t % L;
        bf16_t* base = (hh < 8) ? (bf16_t*)(p.ws + OFF_AQ) + (size_t)t * 512 + hh * 64
                     : (hh < 16) ? (bf16_t*)(p.ws + OFF_IQ) + (size_t)t * 512 + (hh - 8) * 64
                                 : (bf16_t*)(p.ws + OFF_AK) + (size_t)t * 128 + (hh - 16) * 64;
        const u32x4 a = *(const u32x4*)base, b = *(const u32x4*)(base + 8);
        u32x4 oa, ob; rope16(a, b, ROPE + pos * 8, oa, ob);
        *(u32x4*)base = oa; *(u32x4*)(base + 8) = ob;
    }
    const float* IKR = (const float*)(p.ws + OFF_IKR);
    bf16_t* IK = (bf16_t*)(p.ws + OFF_IK);
    const float* ikg = p.ikg + layer * 64; const float* ikb = p.ikb + layer * 64;
    for (int t = gid; t < T; t += nthr) {
        const int pos = t % L;
        f32x4 x[16];
#pragma unroll
        for (int i = 0; i < 16; ++i) x[i] = *(const f32x4*)(IKR + (size_t)t * 64 + 4 * i);
        float sm = 0.f;
#pragma unroll
        for (int i = 0; i < 16; ++i) sm += (x[i][0] + x[i][1]) + (x[i][2] + x[i][3]);
        const float mu = sm * (1.f / 64);
        float qq = 0.f;
#pragma unroll
        for (int i = 0; i < 16; ++i) { const f32x4 d = x[i] - mu; qq += (d[0] * d[0] + d[1] * d[1]) + (d[2] * d[2] + d[3] * d[3]); }
        const float rs = rsqrtf(qq * (1.f / 64) + LN_EPS);
#pragma unroll
        for (int i = 0; i < 16; ++i) { const f32x4 g = *(const f32x4*)(ikg + 4 * i), bb = *(const f32x4*)(ikb + 4 * i); x[i] = (x[i] - mu) * rs * g + bb; }
        const float2* rp = ROPE + pos * 8;
        const f32x4 r0 = *(const f32x4*)(rp), r1 = *(const f32x4*)(rp + 2), r2 = *(const f32x4*)(rp + 4), r3 = *(const f32x4*)(rp + 6);
        const float cs[8] = {r0[0], r0[2], r1[0], r1[2], r2[0], r2[2], r3[0], r3[2]};
        const float sn[8] = {r0[1], r0[3], r1[1], r1[3], r2[1], r2[3], r3[1], r3[3]};
#pragma unroll
        for (int i = 0; i < 8; ++i) {
            const float x1 = x[i >> 2][i & 3], x2 = x[2 + (i >> 2)][i & 3];
            x[i >> 2][i & 3] = x1 * cs[i] - x2 * sn[i];
            x[2 + (i >> 2)][i & 3] = x2 * cs[i] + x1 * sn[i];
        }
#pragma unroll
        for (int i = 0; i < 8; ++i) {
            u32x4 o; o[0] = cvt_pk_bf16(x[2 * i][0], x[2 * i][1]); o[1] = cvt_pk_bf16(x[2 * i][2], x[2 * i][3]); o[2] = cvt_pk_bf16(x[2 * i + 1][0], x[2 * i + 1][1]); o[3] = cvt_pk_bf16(x[2 * i + 1][2], x[2 * i + 1][3]);
            *(u32x4*)(IK + (size_t)t * 64 + 8 * i) = o;
        }
    }
}

constexpr int GL_QE = 0, GL_KN = 8192, GL_SEG = 16384, GL_PART = 18432;
__device__ __forceinline__ void gla_cumsum(const Params& p, int layer, int b, int h, int c, int tid, LAS unsigned char* lds, float (&bc)[8], float& blast) {
    const int d = tid & 63, seg = tid >> 6;
    const float* wg2 = p.wg2 + (size_t)layer * 16 * 256 + h * 64 + d;
    float w[16];
#pragma unroll
    for (int rr = 0; rr < 16; ++rr) w[rr] = wg2[rr * 256];
    const float bgd = p.bg[layer * 256 + h * 64 + d];
    const float* GLR = (const float*)(p.ws + OFF_GLR);
    float pb = 0.f;
#pragma unroll
    for (int i = 0; i < 8; ++i) {
        const int pos = 64 * c - 48 + 8 * seg + i;
        float gl = 0.f;
        if (pos >= 0) {
            const f32x4* gp = (const f32x4*)(GLR + ((size_t)b * L + pos) * 16);
            const f32x4 g0 = gp[0], g1 = gp[1], g2 = gp[2], g3 = gp[3];
            float x = bgd;
#pragma unroll
            for (int rr = 0; rr < 4; ++rr) { x = fmaf(g0[rr], w[rr], x); }
#pragma unroll
            for (int rr = 0; rr < 4; ++rr) { x = fmaf(g1[rr], w[4 + rr], x); }
#pragma unroll
            for (int rr = 0; rr < 4; ++rr) { x = fmaf(g2[rr], w[8 + rr], x); }
#pragma unroll
            for (int rr = 0; rr < 4; ++rr) { x = fmaf(g3[rr], w[12 + rr], x); }
            gl = logsigmoid_fast(x) * (1.f / 16.f);
        }
        pb += gl; bc[i] = pb;
    }
    LAS float* segs = (LAS float*)(lds + GL_SEG);
    segs[seg * 64 + d] = pb;
    __syncthreads();
    float base = 0.f, tot = 0.f;
#pragma unroll
    for (int sg = 0; sg < 8; ++sg) { const float v = segs[sg * 64 + d]; tot += v; base += (sg < seg) ? v : 0.f; }
#pragma unroll
    for (int i = 0; i < 8; ++i) bc[i] += base;
    blast = tot;
}

constexpr size_t OUTS_QE = 0, OUTS_KN = (size_t)T * 256 * 2;
__device__ __forceinline__ void phase_gla_a(const Params& p_in, int layer_in, char* smem) {
    const Params p = kparams(); const int layer = opaque_int(layer_in); (void)p_in;
    const int tid = opaque_tid(), wid = __builtin_amdgcn_readfirstlane(tid >> 6), lane = tid & 63, fr = lane & 15, fq = lane >> 4;
    LAS unsigned char* ldw = (LAS unsigned char*)smem + wid * 8192;
    const bf16_t* GQ = (const bf16_t*)(p.ws + OFF_GQ);
    const bf16_t* GK = (const bf16_t*)(p.ws + OFF_GK);
    const bf16_t* GVT = (const bf16_t*)(p.ws + OFF_GV);
    const float* GLR = (const float*)(p.ws + OFF_GLR);
    bf16_t* QE = (bf16_t*)((char*)p.out + OUTS_QE);
    bf16_t* KN = (bf16_t*)((char*)p.out + OUTS_KN);
    float* UT = (float*)(p.ws + OFF_UT);
    float* DL = (float*)(p.ws + OFF_DL);
    const int wstride = gridDim.x * 8;
    for (int task = wid * (int)gridDim.x + opaque_bid(); task < 32 * 33; task += wstride) {
        const int bh = task / 33, c = task - bh * 33, b = bh >> 2, h = bh & 3;
        const int d = lane;
        float w[16];
#pragma unroll
        for (int rr = 0; rr < 16; ++rr) w[rr] = p.wg2[(size_t)layer * 16 * 256 + rr * 256 + h * 64 + d];
        const float bgd = p.bg[layer * 256 + h * 64 + d];
        float bsum = 0.f;
        const int rowi0 = b * L + 64 * c - 48;
        f32x4 g4[4];
#pragma unroll
        for (int m = 0; m < 4; ++m) { int rr_ = rowi0 + ((lane + 64 * m) >> 2); rr_ = rr_ > 0 ? rr_ : 0; g4[m] = *(const f32x4*)(GLR + (size_t)rr_ * 16 + 4 * (lane & 3)); }
        LAS unsigned char* ldg = (LAS unsigned char*)smem + 65536 + wid * 4096;
#pragma unroll
        for (int m = 0; m < 4; ++m) *(LAS f32x4*)(ldg + (lane + 64 * m) * 16) = g4[m];
        unsigned qk[64];
#pragma unroll
        for (int t = 0; t < 64; ++t) { int rr_ = rowi0 + t; rr_ = rr_ > 0 ? rr_ : 0; const size_t o_ = (size_t)rr_ * 256 + h * 64 + d; qk[t] = (unsigned)GQ[o_] | ((unsigned)GK[o_] << 16); }
        float kn[8];
        __builtin_amdgcn_wave_barrier(); asm volatile("s_waitcnt lgkmcnt(0)" ::: "memory");
#pragma unroll
        for (int t = 0; t < 64; ++t) {
            const bool valid = (c > 0) || (t >= 48);
            float x = bgd;
            {
                const LAS f32x4* gp = (const LAS f32x4*)(ldg + t * 64);
                const f32x4 g0 = gp[0], g1 = gp[1], g2 = gp[2], g3 = gp[3];
#pragma unroll
                for (int rr = 0; rr < 4; ++rr) x = fmaf(g0[rr], w[rr], x);
#pragma unroll
                for (int rr = 0; rr < 4; ++rr) x = fmaf(g1[rr], w[4 + rr], x);
#pragma unroll
                for (int rr = 0; rr < 4; ++rr) x = fmaf(g2[rr], w[8 + rr], x);
#pragma unroll
                for (int rr = 0; rr < 4; ++rr) x = fmaf(g3[rr], w[12 + rr], x);
            }
            bsum += valid ? logsigmoid_fast(x) * (1.f / 16.f) : 0.f;
            const float eb = __expf(bsum);
            const float qv = __uint_as_float(qk[t] << 16), kv = __uint_as_float(qk[t] & 0xFFFF0000u);
            const float knv = valid ? kv * __builtin_amdgcn_rcpf(eb) : 0.f;
            kn[t & 7] = knv;
            if (valid) {
                const size_t o_ = (size_t)(rowi0 + t) * 256 + h * 64 + d;
                QE[o_] = f2bf(qv * eb);
                KN[o_] = f2bf(knv);
            }
            if ((t & 7) == 7 && c < 32) {
                u32x4 o; o[0] = cvt_pk_bf16(kn[0], kn[1]); o[1] = cvt_pk_bf16(kn[2], kn[3]); o[2] = cvt_pk_bf16(kn[4], kn[5]); o[3] = cvt_pk_bf16(kn[6], kn[7]);
                *(LAS u32x4*)(ldw + d * 128 + 16 * ((t >> 3) ^ (d & 7))) = o;
            }
        }
        if (c < 32) {
            const float dl = __expf(bsum);
            DL[((size_t)bh * 32 + c) * 64 + d] = dl;
            __builtin_amdgcn_wave_barrier(); asm volatile("s_waitcnt lgkmcnt(0)" ::: "memory");
            bf16x8 kf[4][2]; float dls[4];
#pragma unroll
            for (int dt = 0; dt < 4; ++dt) {
                const int rowd = 16 * dt + fr;
                dls[dt] = __shfl(dl, rowd);
#pragma unroll
                for (int ks = 0; ks < 2; ++ks) kf[dt][ks] = *(const LAS bf16x8*)(ldw + rowd * 128 + 16 * ((4 * ks + fq) ^ (rowd & 7)));
            }
            const bf16x8 z8 = {0, 0, 0, 0, 0, 0, 0, 0};
            bf16x8 vfa[8][2];
#pragma unroll
            for (int et = 0; et < 8; ++et) {
                const bf16_t* vp = GVT + ((size_t)bh * 128 + 16 * et + fr) * LPV + 64 * c + 8 * fq;
                vfa[et][0] = *(const bf16x8*)vp; vfa[et][1] = *(const bf16x8*)(vp + 32);
            }
            asm volatile("" ::: "memory");
#pragma unroll
            for (int et = 0; et < 8; ++et) {
                bf16x8 v0 = vfa[et][0], v1 = vfa[et][1];
                v0 = (c == 0) ? z8 : v0; v1 = (c == 0 && fq < 2) ? z8 : v1;
#pragma unroll
                for (int dt = 0; dt < 4; ++dt) {
                    f32x4 acc = {0.f, 0.f, 0.f, 0.f};
                    acc = __builtin_amdgcn_mfma_f32_16x16x32_bf16(v0, kf[dt][0], acc, 0, 0, 0);
                    acc = __builtin_amdgcn_mfma_f32_16x16x32_bf16(v1, kf[dt][1], acc, 0, 0, 0);
                    float* up = UT + (((size_t)bh * 32 + c) * 128 + 16 * et + 4 * fq) * 64 + 16 * dt + fr;
#pragma unroll
                    for (int r = 0; r < 4; ++r) up[r * 64] = acc[r] * dls[dt];
                }
            }
            __builtin_amdgcn_wave_barrier(); asm volatile("s_waitcnt lgkmcnt(0)" ::: "memory");
        }
    }
}

__device__ __forceinline__ void phase_gla_scan(const Params& p_in, int layer_in, char* smem) {
    const Params p = kparams(); const int layer = opaque_int(layer_in); (void)p_in;
    const int tid = opaque_tid();
    const float* UT = (const float*)(p.ws + OFF_UT);
    const float* DL = (const float*)(p.ws + OFF_DL);
    bf16_t* ST = (bf16_t*)(p.ws + OFF_ST);
    const int nthr = gridDim.x * NT;
    for (int el = opaque_bid() * NT + tid; el < 32 * 8192; el += nthr) {
        const int bh = el >> 13, ed = el & 8191, d = el & 63;
        float sacc = 0.f;
        ST[((size_t)bh * 33) * 8192 + ed] = 0;
#pragma unroll 1
        for (int c0 = 0; c0 < 32; c0 += 16) {
            float u[16], dl[16];
#pragma unroll
            for (int i = 0; i < 16; ++i) { u[i] = UT[((size_t)(bh * 32 + c0 + i)) * 8192 + ed]; dl[i] = DL[(size_t)(bh * 32 + c0 + i) * 64 + d]; }
#pragma unroll
            for (int i = 0; i < 16; ++i) { sacc = fmaf(dl[i], sacc, u[i]); ST[((size_t)bh * 33 + c0 + i + 1) * 8192 + ed] = f2bf(sacc); }
        }
    }
}

__device__ __forceinline__ void phase_gla_c(const Params& p_in, int layer_in, char* smem, bool do_store) {
    const Params p = kparams(); const int layer = opaque_int(layer_in); (void)p_in;
    const int tid = opaque_tid(), wid = __builtin_amdgcn_readfirstlane(tid >> 6), lane = tid & 63, fr = lane & 15, fq = lane >> 4;
    const bf16_t* QE = (const bf16_t*)((const char*)p.out + OUTS_QE);
    const bf16_t* KN = (const bf16_t*)((const char*)p.out + OUTS_KN);
    const bf16_t* GVT = (const bf16_t*)(p.ws + OFF_GV);
    const bf16_t* ST = (const bf16_t*)(p.ws + OFF_ST);
    bf16_t* MIX = (bf16_t*)(p.ws + OFF_MIX);
    const float* ng = p.norm_g + layer * 128;
    const bf16x8 z8 = {0, 0, 0, 0, 0, 0, 0, 0};
    const int nwt = 32 * 33 * 4, wstride = gridDim.x * 8;
    for (int wt = wid * (int)gridDim.x + opaque_bid(); wt < nwt; wt += wstride) {
        const int task = wt >> 2, tw = wt & 3;
        const int bh = task / 33, c = task - bh * 33, b = bh >> 2, h = bh & 3;
        const int pos_t = 64 * c - 48 + 16 * tw + fr;
        if (c == 0 && tw < 3) continue;
        bf16x8 qf[2], kf[4][2];
        {
            const bf16_t* qp = QE + ((size_t)b * L + pos_t) * 256 + h * 64 + 8 * fq;
            qf[0] = *(const bf16x8*)qp; qf[1] = *(const bf16x8*)(qp + 32);
#pragma unroll
            for (int st = 0; st < 4; ++st) {
                const int pos_s = 64 * c - 48 + 16 * st + fr;
                const bf16_t* kp = KN + ((size_t)b * L + (pos_s > 0 ? pos_s : 0)) * 256 + h * 64 + 8 * fq;
                kf[st][0] = *(const bf16x8*)kp; kf[st][1] = *(const bf16x8*)(kp + 32);
            }
        }
        bf16x8 sf[4][2]; u32x2 vv[4][4];
#define GLC_LOAD_HALF(hf) do { _Pragma("unroll") for (int e4 = 0; e4 < 4; ++e4) { const int e0 = 16 * (4 * (hf) + e4); \
                const bf16_t* sp = ST + (((size_t)bh * 33 + c) * 128 + e0 + fr) * 64 + 8 * fq; \
                const bf16_t* vp = GVT + ((size_t)bh * 128 + e0 + fr) * LPV + 64 * c + 4 * fq; \
                sf[e4][0] = *(const bf16x8*)sp; sf[e4][1] = *(const bf16x8*)(sp + 32); \
                vv[e4][0] = *(const u32x2*)vp; vv[e4][1] = *(const u32x2*)(vp + 16); vv[e4][2] = *(const u32x2*)(vp + 32); vv[e4][3] = *(const u32x2*)(vp + 48); } \
            asm volatile("" ::: "memory"); } while (0)
        GLC_LOAD_HALF(0);
        unsigned pk[4][2];
#pragma unroll
        for (int st = 0; st < 4; ++st) {
            f32x4 a = {0.f, 0.f, 0.f, 0.f};
            const int pos_s = 64 * c - 48 + 16 * st + fr;
            const bf16x8 k0 = (pos_s >= 0) ? kf[st][0] : z8, k1 = (pos_s >= 0) ? kf[st][1] : z8;
            a = __builtin_amdgcn_mfma_f32_16x16x32_bf16(k0, qf[0], a, 0, 0, 0);
            a = __builtin_amdgcn_mfma_f32_16x16x32_bf16(k1, qf[1], a, 0, 0, 0);
#pragma unroll
            for (int r = 0; r < 4; ++r) a[r] = (16 * st + 4 * fq + r > 16 * tw + fr) ? 0.f : a[r];
            pk[st][0] = cvt_pk_bf16(a[0], a[1]); pk[st][1] = cvt_pk_bf16(a[2], a[3]);
        }
        bf16x8 pf[2];
#pragma unroll
        for (int ks = 0; ks < 2; ++ks) { u32x4 pw; pw[0] = pk[2 * ks][0]; pw[1] = pk[2 * ks][1]; pw[2] = pk[2 * ks + 1][0]; pw[3] = pk[2 * ks + 1][1]; pf[ks] = __builtin_bit_cast(bf16x8, pw); }
        f32x4 O[8];
        float ss = 0.f;
        const u32x2 z2 = {0u, 0u};
#pragma unroll
        for (int hf = 0; hf < 2; ++hf) {
            if (hf == 1) GLC_LOAD_HALF(1);
#pragma unroll
            for (int e4 = 0; e4 < 4; ++e4) {
                f32x4 acc = {0.f, 0.f, 0.f, 0.f};
                acc = __builtin_amdgcn_mfma_f32_16x16x32_bf16(sf[e4][0], qf[0], acc, 0, 0, 0);
                acc = __builtin_amdgcn_mfma_f32_16x16x32_bf16(sf[e4][1], qf[1], acc, 0, 0, 0);
                u32x2 va = vv[e4][0], vb = vv[e4][1], vc = vv[e4][2], vd = vv[e4][3];
                va = (c == 0) ? z2 : va; vb = (c == 0) ? z2 : vb; vc = (c == 0) ? z2 : vc;
                u32x4 vw; vw[0] = va[0]; vw[1] = va[1]; vw[2] = vb[0]; vw[3] = vb[1];
                acc = __builtin_amdgcn_mfma_f32_16x16x32_bf16(__builtin_bit_cast(bf16x8, vw), pf[0], acc, 0, 0, 0);
                u32x4 vx; vx[0] = vc[0]; vx[1] = vc[1]; vx[2] = vd[0]; vx[3] = vd[1];
                acc = __builtin_amdgcn_mfma_f32_16x16x32_bf16(__builtin_bit_cast(bf16x8, vx), pf[1], acc, 0, 0, 0);
                O[4 * hf + e4] = acc;
                ss += acc[0] * acc[0] + acc[1] * acc[1] + acc[2] * acc[2] + acc[3] * acc[3];
            }
        }
#undef GLC_LOAD_HALF
        ss += __shfl_xor(ss, 16); ss += __shfl_xor(ss, 32);
        const float rinv = rsqrtf(ss * (1.f / 128) + LN_EPS);
        if (pos_t >= 0 && do_store) {
            bf16_t* mp = MIX + ((size_t)b * L + pos_t) * 1024 + h * 128 + 4 * fq;
#pragma unroll
            for (int et = 0; et < 8; ++et) {
                const uint2 gz = *(const uint2*)(mp + 16 * et);
                const f32x4 nv = *(const f32x4*)(ng + 16 * et + 4 * fq);
                const float g0 = __uint_as_float(gz.x << 16), g1 = __uint_as_float(gz.x & 0xFFFF0000u), g2 = __uint_as_float(gz.y << 16), g3 = __uint_as_float(gz.y & 0xFFFF0000u);
                uint2 o; o.x = cvt_pk_bf16(O[et][0] * rinv * nv[0] * g0, O[et][1] * rinv * nv[1] * g1); o.y = cvt_pk_bf16(O[et][2] * rinv * nv[2] * g2, O[et][3] * rinv * nv[3] * g3);
                *(uint2*)(mp + 16 * et) = o;
            }
        }
    }
}

__device__ __forceinline__ void phase_ln(const Params& p_in, int layer_in, char* smem) {
    const Params p = kparams(); const int layer = opaque_int(layer_in); (void)p_in;
    const int tid = opaque_tid(), wid = tid >> 6, lane = tid & 63;
    const float* Z = (const float*)(p.ws + OFF_GQ);
    float* H32 = (float*)(p.ws + OFF_H32);
    bf16_t* HB = (bf16_t*)(p.ws + OFF_HB);
    const float* g = p.ln_g + layer * D; const float* bb = p.ln_b + layer * D;
    const int nw = gridDim.x * 8;
    int t = opaque_bid() * 8 + wid;
    f32x4 v[4], vn[4];
    if (t < T) {
#pragma unroll
        for (int i = 0; i < 4; ++i) v[i] = *(const f32x4*)(Z + (size_t)t * D + 4 * lane + 256 * i);
    }
    for (; t < T; t += nw) {
        const int tn = t + nw;
        if (tn < T) {
#pragma unroll
            for (int i = 0; i < 4; ++i) vn[i] = *(const f32x4*)(Z + (size_t)tn * D + 4 * lane + 256 * i);
        }
        ln_row_wave(v, g, bb, lane);
        if (layer == DEPTH - 1) {
            const int b = t / L, pos = t - b * L;
            if (pos >= NMETA) {
#pragma unroll
                for (int i = 0; i < 4; ++i) *(f32x4*)(p.out + ((size_t)b * SEQ + (pos - NMETA)) * D + 4 * lane + 256 * i) = v[i];
            }
        } else {
#pragma unroll
            for (int i = 0; i < 4; ++i) {
                *(f32x4*)(H32 + (size_t)t * D + 4 * lane + 256 * i) = v[i];
                u32x2 o; o[0] = cvt_pk_bf16(v[i][0], v[i][1]); o[1] = cvt_pk_bf16(v[i][2], v[i][3]);
                *(u32x2*)(HB + (size_t)t * D + 4 * lane + 256 * i) = o;
            }
        }
#pragma unroll
        for (int i = 0; i < 4; ++i) v[i] = vn[i];
    }
}

#define XB_TMO      128
#define XB_XCNT(j)  (256  + 64 * (j))
#define XB_XSUB(j)  (1280 + 64 * (j))
#define XB_XGEN(j)  (2304 + 64 * (j))
#define XB_TOP      3328
#define XB_TOPGEN   3392
#define XCD_BAR_WORDS 3456
#define XB_SPIN_CAP (1u << 22)
__device__ __forceinline__ unsigned xb_ld(unsigned* p)              { return __hip_atomic_load(p, __ATOMIC_RELAXED, __HIP_MEMORY_SCOPE_AGENT); }
__device__ __forceinline__ unsigned xb_add(unsigned* p, unsigned v) { return __hip_atomic_fetch_add(p, v, __ATOMIC_RELAXED, __HIP_MEMORY_SCOPE_AGENT); }
__device__ __forceinline__ unsigned xb_xcc_id() { return (unsigned)__builtin_amdgcn_s_getreg((3 << 11) | 20) & 0xFu; }
#define XB_SPIN(cond, bar) do { unsigned _sp = 0; while (cond) { __builtin_amdgcn_s_sleep(1); \
    if ((++_sp & 255u) == 0u) { if (xb_ld(&(bar)[XB_TMO])) break; if (_sp > XB_SPIN_CAP) { atomicAdd(&(bar)[XB_TMO], 1u); break; } } } } while (0)
struct XcdBarrier { unsigned* bar; unsigned x; volatile LAS unsigned* st; };
__device__ __forceinline__ XcdBarrier xcd_barrier_post(unsigned* bar, volatile LAS unsigned* st) {
    XcdBarrier b; b.bar = bar; b.x = xb_xcc_id(); b.st = st;
    if (threadIdx.x == 0) (void)xb_add(&bar[XB_XCNT(b.x)], 1u);
    return b;
}
__device__ __forceinline__ void xcd_barrier_complete(unsigned* bar, unsigned x, unsigned& nloc, unsigned& nx) {
    const unsigned G = gridDim.x * gridDim.y * gridDim.z;
    unsigned sum, cnt, mine, sp = 0u;
    for (;;) {
        sum = 0u; cnt = 0u; mine = 0u;
#pragma unroll
        for (unsigned j = 0; j < 16; ++j) { const unsigned c = xb_ld(&bar[XB_XCNT(j)]); sum += c; cnt += (c > 0u) ? 1u : 0u; mine = (j == x) ? c : mine; }
        if (sum == G) break;
        __builtin_amdgcn_s_sleep(1);
        if ((++sp & 255u) == 0u) { if (xb_ld(&bar[XB_TMO])) break; if (sp > XB_SPIN_CAP) { atomicAdd(&bar[XB_TMO], 1u); break; } }
    }
    nloc = mine > 0u ? mine : 1u; nx = cnt > 0u ? cnt : 1u;
}
__device__ __forceinline__ void xcd_barrier(unsigned* bar_, volatile LAS unsigned* st_) {
    XcdBarrier b; b.bar = bar_; b.x = xb_xcc_id(); b.st = st_;
    asm volatile("s_waitcnt vmcnt(0)" ::: "memory");
    __syncthreads();
    if (opaque_tid() == 0) {
        unsigned* bar = b.bar;
        __builtin_amdgcn_s_waitcnt(0);
        unsigned nloc = b.st[0], nx = b.st[1];
        if (nloc == 0u) { xcd_barrier_complete(bar, b.x, nloc, nx); b.st[0] = nloc; b.st[1] = nx; }
        const unsigned old = xb_add(&bar[XB_XSUB(b.x)], 1u);
        const unsigned gen = old / nloc;
        if (old + 1u == (gen + 1u) * nloc) {
            __builtin_amdgcn_fence(__ATOMIC_RELEASE, "agent");
            asm volatile("s_waitcnt vmcnt(0)" ::: "memory");
            const unsigned og = xb_add(&bar[XB_TOP], 1u);
            const unsigned tg = og / nx;
            if (og + 1u == (tg + 1u) * nx) xb_add(&bar[XB_TOPGEN], 1u);
            else XB_SPIN(xb_ld(&bar[XB_TOPGEN]) == tg, bar);
            __builtin_amdgcn_fence(__ATOMIC_ACQUIRE, "agent");
            xb_add(&bar[XB_XGEN(b.x)], 1u);
            asm volatile("s_waitcnt vmcnt(0)" ::: "memory");
        } else {
            XB_SPIN(xb_ld(&bar[XB_XGEN(b.x)]) == gen, bar);
            __builtin_amdgcn_fence(__ATOMIC_ACQUIRE, "agent");
            asm volatile("s_waitcnt vmcnt(0)" ::: "memory");
        }
    }
    __syncthreads();
}

constexpr int SMEM_BYTES = 160 * 1024;
static_assert(DS_END <= SMEM_BYTES - 16 - 64, "dsa lds");
static_assert(WVTAB_OFF == SMEM_BYTES - 16 - 64, "wave table");

__global__ void __launch_bounds__(NT, 2) k_mega(Params p) {
    __shared__ __attribute__((aligned(16))) char smem[SMEM_BYTES];
    volatile LAS unsigned* xbw = (volatile LAS unsigned*)((LAS unsigned char*)smem + (SMEM_BYTES - 16));
    if (threadIdx.x == 0) { xbw[0] = 0u; xbw[1] = 0u; xbw[2] = 0u; xbw[3] = 0u; }
    {
        const unsigned slot = (unsigned)__builtin_amdgcn_s_getreg(((6 - 1) << 11) | 4) & 63u;
        if ((threadIdx.x & 63) == 0) *((volatile LAS unsigned char*)smem + WVTAB_OFF + slot) = (unsigned char)(threadIdx.x >> 6);
    }
    __syncthreads();
    if (p.ws == nullptr) cg::this_grid().sync();
    (void)xcd_barrier_post((unsigned*)(p.ws + OFF_BAR), xbw);
    for (int rep = 0; rep < PROBE_REP_PREP; ++rep) {
    phase_prep(p, smem);
    xcd_barrier((unsigned*)(p.ws + OFF_BAR), xbw);
    }
#pragma unroll 1
    for (int layer = 0; layer < DEPTH; ++layer) {
        for (int rep = 0; rep < PROBE_REP_PROJ; ++rep) {
        phase_proj(p, layer, smem);
        xcd_barrier((unsigned*)(p.ws + OFF_BAR), xbw);
        }
        phase_rope(p, layer, smem);
        for (int rep = 0; rep < PROBE_REP_GLAA; ++rep) {
        phase_gla_a(p, layer, smem);
        xcd_barrier((unsigned*)(p.ws + OFF_BAR), xbw);
        phase_gla_scan(p, layer, smem);
        xcd_barrier((unsigned*)(p.ws + OFF_BAR), xbw);
        }
        for (int rep = 0; rep < PROBE_REP_GLAC; ++rep) phase_gla_c(p, layer, smem, rep == PROBE_REP_GLAC - 1);
        for (int rep = 0; rep < PROBE_REP_DSA; ++rep) phase_dsa(p, layer, smem, rep == PROBE_REP_DSA - 1);
        xcd_barrier((unsigned*)(p.ws + OFF_BAR), xbw);
        for (int rep = 0; rep < PROBE_REP_OUT; ++rep) {
        phase_outproj(p, layer, smem);
        xcd_barrier((unsigned*)(p.ws + OFF_BAR), xbw);
        }
        for (int rep = 0; rep < PROBE_REP_LN; ++rep) {
        phase_ln(p, layer, smem);
        xcd_barrier((unsigned*)(p.ws + OFF_BAR), xbw);
        }
    }
}

extern "C" void kernel_launch(void* const* d_in, const int* in_sizes, int n_in, void* d_out, int out_size, void* d_ws, size_t ws_size,
                              hipStream_t stream) {
    Params p{};
    p.x = (const float*)d_in[0]; p.meta = (const float*)d_in[1]; p.ln_in_g = (const float*)d_in[2]; p.ln_in_b = (const float*)d_in[3];
    p.w_in = (const float*)d_in[4]; p.wg2 = (const float*)d_in[5]; p.bg = (const float*)d_in[6]; p.norm_g = (const float*)d_in[7];
    p.ikg = (const float*)d_in[8]; p.ikb = (const float*)d_in[9]; p.w_out = (const float*)d_in[10]; p.ln_g = (const float*)d_in[11];
    p.ln_b = (const float*)d_in[12];
    p.out = (float*)d_out; p.ws = (char*)d_ws;
    static int grid_blocks = 0;
    if (!grid_blocks) {
        int dev = 0, cus = 0, per_cu = 0;
        hipGetDevice(&dev);
        hipDeviceGetAttribute(&cus, hipDeviceAttributeMultiprocessorCount, dev);
        hipOccupancyMaxActiveBlocksPerMultiprocessor(&per_cu, k_mega, NT, 0);
        if (per_cu > 1) per_cu = 1;
        grid_blocks = cus * per_cu;
    }
    (void)hipMemsetAsync((char*)d_ws + OFF_BAR, 0, XCD_BAR_WORDS * 4, stream);
    void* args[] = {&p};
    (void)hipLaunchCooperativeKernel((void*)k_mega, dim3(grid_blocks), dim3(NT), args, 0, stream);
}
```
